# Optimizing an MI355X kernel written in HIP

```python
import jax, jax.numpy as jnp
from jax import lax
import numpy as np

D_MODEL = 1024
BATCH = 8
SEQ = 4096
DEPTH = 2

D_MIX = D_MODEL
HEAD_DIM = 64
D_CONV_A = 3 * D_MIX // 8
D_CONV_B = 3 * D_MIX // 8
D_POOL = D_MIX - D_CONV_A - D_CONV_B
POOL_WINDOWS = (2, 4, 8, 16)
N_POOL_GROUPS = len(POOL_WINDOWS)
POOL_GROUP = D_POOL // N_POOL_GROUPS
CONV_A_WIDTH = 3
CONV_B_WIDTH = 31
D_IN = 3 * D_CONV_A + 2 * D_CONV_B + D_POOL
N_EXPERTS = 32
N_EXPERT_GROUPS = 8
EXPERTS_PER_GROUP = N_EXPERTS // N_EXPERT_GROUPS
TOP_K = 2
D_EXPERT = D_MODEL // 2
EXPERT_BLOCK = 256
LN_EPS = 1e-5
DEEPNORM_ALPHA = (2 * DEPTH) ** 0.25
DEEPNORM_BETA = (8 * DEPTH) ** -0.25

kernel_name = "hybrid_conv_pool_deepnorm_grouped_moe"


def layer_norm(x, g, b):
    xf = x.astype(jnp.float32)
    mu = jnp.mean(xf, axis=-1, keepdims=True)
    var = jnp.mean(jnp.square(xf - mu), axis=-1, keepdims=True)
    return ((xf - mu) * lax.rsqrt(var + LN_EPS)).astype(x.dtype) * g + b


def causal_depthwise_conv(x, w):
    k, c = w.shape
    return lax.conv_general_dilated(
        x, w[:, None, :].astype(x.dtype), window_strides=(1,), padding=[(k - 1, 0)],
        dimension_numbers=("NWC", "WIO", "NWC"), feature_group_count=c)


def multiscale_pool(u, pool_w, pool_scale):
    b, s, _ = u.shape
    uf = u.astype(jnp.float32)
    cs = jnp.concatenate([jnp.zeros((b, 1, D_POOL), jnp.float32), jnp.cumsum(uf, axis=1)], axis=1)
    pos = jnp.arange(1, s + 1, dtype=jnp.float32)
    outs = []
    for g, w in enumerate(POOL_WINDOWS):
        sl = slice(g * POOL_GROUP, (g + 1) * POOL_GROUP)
        csg = cs[:, :, sl]
        lower = jnp.concatenate([jnp.zeros((b, w - 1, POOL_GROUP), jnp.float32), csg[:, : s + 1 - w]], axis=1)
        mean = (csg[:, 1:] - lower) / jnp.minimum(pos, float(w))[None, :, None]
        outs.append(mean - uf[:, :, sl])
    d = jnp.stack(outs, axis=2).astype(u.dtype)
    y = jnp.einsum("bsgc,gcd->bsgd", d, pool_w).reshape(b, s, D_POOL)
    return y * pool_scale


def hybrid_mixer(h, w_in, conv_a_w, conv_b_w, conv_b_b, ln_conv_g, ln_conv_b, pool_w, pool_scale, w_out):
    z = h @ w_in
    cuts = np.cumsum([D_CONV_A, D_CONV_A, D_CONV_A, D_CONV_B, D_CONV_B]).tolist()
    a_gate_b, a_gate_c, a_val, b_val, b_gate, p_in = jnp.split(z, cuts, axis=-1)
    y_a = a_gate_b * causal_depthwise_conv(a_gate_c * a_val, conv_a_w)
    v = b_val * jax.nn.sigmoid(b_gate)
    v = causal_depthwise_conv(v, conv_b_w) + conv_b_b
    y_b = jax.nn.silu(layer_norm(v, ln_conv_g, ln_conv_b))
    y_c = multiscale_pool(p_in, pool_w, pool_scale)
    return jnp.concatenate([y_a, y_b, y_c], axis=-1) @ w_out


def shared_router(h, router_w, router_b):
    t = h.shape[0]
    logits = (h @ router_w).astype(jnp.float32) + router_b.astype(jnp.float32)
    probs = jax.nn.softmax(logits, axis=-1)
    grouped = probs.reshape(t, N_EXPERT_GROUPS, EXPERTS_PER_GROUP)
    group_score = jnp.sum(lax.top_k(grouped, TOP_K)[0], axis=-1)
    best_group = jnp.argmax(group_score, axis=-1)
    in_group = jnp.take_along_axis(grouped, best_group[:, None, None], axis=1)[:, 0]
    top_p, top_local = lax.top_k(in_group, TOP_K)
    expert_idx = best_group[:, None].astype(jnp.int32) * EXPERTS_PER_GROUP + top_local.astype(jnp.int32)
    gates = top_p / jnp.sum(top_p, axis=-1, keepdims=True)
    return expert_idx, gates


def grouped_moe(h, expert_idx, gates, w_gate, w_up, w_down):
    t, d = h.shape
    a = t * TOP_K
    flat_e = expert_idx.reshape(a)
    order = jnp.argsort(flat_e)
    sorted_e = flat_e[order]
    counts = jnp.bincount(flat_e, length=N_EXPERTS)
    starts = jnp.cumsum(counts) - counts
    padded = (counts + EXPERT_BLOCK - 1) // EXPERT_BLOCK * EXPERT_BLOCK
    padded_end = jnp.cumsum(padded)
    padded_start = padded_end - padded
    dest = (padded_start[sorted_e] + jnp.arange(a, dtype=jnp.int32) - starts[sorted_e]).astype(jnp.int32)
    n_blocks = -(-(a + N_EXPERTS * (EXPERT_BLOCK - 1)) // EXPERT_BLOCK)
    rows = n_blocks * EXPERT_BLOCK
    row_token = jnp.full((rows,), t, jnp.int32).at[dest].set((order // TOP_K).astype(jnp.int32))
    h_pad = jnp.concatenate([h, jnp.zeros((1, d), h.dtype)], axis=0)
    xb = h_pad[row_token].reshape(n_blocks, EXPERT_BLOCK, d)
    block_start = jnp.arange(n_blocks, dtype=padded_end.dtype) * EXPERT_BLOCK
    block_expert = jnp.minimum(jnp.searchsorted(padded_end, block_start, side="right"), N_EXPERTS - 1)

    def expert_block(args):
        xblk, e = args
        return (jax.nn.silu(xblk @ w_gate[e]) * (xblk @ w_up[e])) @ w_down[e]

    yb = lax.map(expert_block, (xb, block_expert)).reshape(rows, d)
    dest_orig = jnp.zeros((a,), jnp.int32).at[order].set(dest)
    y = yb[dest_orig].reshape(t, TOP_K, d)
    return jnp.einsum("tk,tkd->td", gates.astype(h.dtype), y)


def setup_inputs(seed: int = 0) -> dict:
    key = jax.random.key(seed)
    ks = jax.random.split(key, 24)
    f32 = jnp.float32
    nrm = lambda k, shape, s: jax.random.normal(k, shape, f32) * s
    L = DEPTH
    return {
        "x": nrm(ks[0], (BATCH, SEQ, D_MODEL), 1.0),
        "ln_in_g": 1.0 + nrm(ks[1], (D_MODEL,), 0.02),
        "ln_in_b": nrm(ks[2], (D_MODEL,), 0.02),
        "router_w": nrm(ks[3], (D_MODEL, N_EXPERTS), D_MODEL ** -0.5),
        "router_b": nrm(ks[4], (N_EXPERTS,), 0.01),
        "w_in": nrm(ks[5], (L, D_MODEL, D_IN), D_MODEL ** -0.5),
        "conv_a_w": nrm(ks[6], (L, CONV_A_WIDTH, D_CONV_A), CONV_A_WIDTH ** -0.5),
        "conv_b_w": nrm(ks[7], (L, CONV_B_WIDTH, D_CONV_B), CONV_B_WIDTH ** -0.5),
        "conv_b_b": nrm(ks[8], (L, D_CONV_B), 0.02),
        "ln_conv_g": 1.0 + nrm(ks[9], (L, D_CONV_B), 0.02),
        "ln_conv_b": nrm(ks[10], (L, D_CONV_B), 0.02),
        "pool_w": nrm(ks[11], (L, N_POOL_GROUPS, POOL_GROUP, POOL_GROUP), POOL_GROUP ** -0.5),
        "pool_scale": 1.0 + nrm(ks[12], (L, D_POOL), 0.02),
        "w_out": nrm(ks[13], (L, D_MIX, D_MODEL), DEEPNORM_BETA * D_MIX ** -0.5),
        "ln_mix_g": 1.0 + nrm(ks[14], (L, D_MODEL), 0.02),
        "ln_mix_b": nrm(ks[15], (L, D_MODEL), 0.02),
        "w_gate": nrm(ks[16], (L, N_EXPERTS, D_MODEL, D_EXPERT), D_MODEL ** -0.5),
        "w_up": nrm(ks[17], (L, N_EXPERTS, D_MODEL, D_EXPERT), D_MODEL ** -0.5),
        "w_down": nrm(ks[18], (L, N_EXPERTS, D_EXPERT, D_MODEL), DEEPNORM_BETA * D_EXPERT ** -0.5),
        "ln_ffn_g": 1.0 + nrm(ks[19], (L, D_MODEL), 0.02),
        "ln_ffn_b": nrm(ks[20], (L, D_MODEL), 0.02),
    }


def reference(x, ln_in_g, ln_in_b, router_w, router_b, w_in, conv_a_w, conv_b_w, conv_b_b,
              ln_conv_g, ln_conv_b, pool_w, pool_scale, w_out, ln_mix_g, ln_mix_b,
              w_gate, w_up, w_down, ln_ffn_g, ln_ffn_b):
    b, s, d = x.shape
    h = layer_norm(x, ln_in_g, ln_in_b)
    for l in range(DEPTH):
        mix = hybrid_mixer(h, w_in[l], conv_a_w[l], conv_b_w[l], conv_b_b[l], ln_conv_g[l],
                           ln_conv_b[l], pool_w[l], pool_scale[l], w_out[l])
        h = layer_norm(DEEPNORM_ALPHA * h + mix, ln_mix_g[l], ln_mix_b[l])
        flat = h.reshape(b * s, d)
        expert_idx, gates = shared_router(flat, router_w, router_b)
        f = grouped_moe(flat, expert_idx, gates, w_gate[l], w_up[l], w_down[l])
        h = layer_norm(DEEPNORM_ALPHA * flat + f, ln_ffn_g[l], ln_ffn_b[l]).reshape(b, s, d)
    return h
```

```cpp
#include <hip/hip_runtime.h>
#include <cstdio>
#include <cstdint>

#ifndef MK_N_LAUNCHES
#define MK_N_LAUNCHES 1
#endif
#ifndef PH_MASK
#define PH_MASK 0xff
#endif
#ifndef GEMM_SIMPLE_MASK
#define GEMM_SIMPLE_MASK 0
#endif

#define GAS __attribute__((address_space(1)))
#define LAS __attribute__((address_space(3)))
typedef unsigned short bf16;
typedef unsigned v4u __attribute__((ext_vector_type(4)));
typedef unsigned v2u __attribute__((ext_vector_type(2)));
typedef float f32x4 __attribute__((ext_vector_type(4)));
typedef float f32x2 __attribute__((ext_vector_type(2)));
typedef short bf16x8 __attribute__((ext_vector_type(8)));
#define RLX_AGENT __ATOMIC_RELAXED, __HIP_MEMORY_SCOPE_AGENT
#define LDS_WAIT() asm volatile("s_waitcnt lgkmcnt(0)" ::: "memory")
#define VM_WAIT() asm volatile("s_waitcnt vmcnt(0)" ::: "memory")

constexpr int T_ = 32768, D_ = 1024, SEQ_ = 4096, NL = 2, NE = 32, DE = 512;
constexpr int DIN = 2176, N1 = 2304, NZ = 1408;
constexpr float ALPHA = 1.41421356237f, LN_EPS = 1e-5f;
constexpr int NPH = 1 + 7 * NL;

constexpr size_t MiB = 1u << 20;
constexpr size_t WS_CTL = 0, CTL_ZERO_BYTES = 1 * MiB;
constexpr size_t WS_ROUTE = 1 * MiB;
constexpr size_t WS_WRT = 2 * MiB;
constexpr size_t WS_LISTS = 3 * MiB;
constexpr size_t WS_WIN = 11 * MiB;
constexpr size_t WS_WOUT = 20 * MiB;
constexpr size_t WS_WGU = 24 * MiB;
constexpr size_t WS_WD = 152 * MiB;
constexpr size_t WS_HB = 216 * MiB;
constexpr size_t WS_Z = 280 * MiB;
constexpr size_t WS_Y = 368 * MiB;
constexpr size_t WS_U = 280 * MiB;
constexpr size_t WS_HID = 280 * MiB;
constexpr size_t WS_Y2S = 352 * MiB;
constexpr size_t WS_END = 496 * MiB;
constexpr int CW_TMO = 0, CW_BAR = 4096, CW_CNT = 16384;

constexpr int RING_BYTES = 131072, LDSCTL_OFF = RING_BYTES, MISC_OFF = LDSCTL_OFF + 320, TAB_OFF = LDSCTL_OFF + 1024;
constexpr int LDS_BYTES = 147456;

__device__ __forceinline__ unsigned f2bf(float f) { unsigned u = __builtin_bit_cast(unsigned, f); return (u + 0x7fffu + ((u >> 16) & 1u)) >> 16; }
__device__ __forceinline__ unsigned pk2(float lo, float hi) { return f2bf(lo) | (f2bf(hi) << 16); }
__device__ __forceinline__ float bflo(unsigned u) { return __builtin_bit_cast(float, u << 16); }
__device__ __forceinline__ float bfhi(unsigned u) { return __builtin_bit_cast(float, u & 0xffff0000u); }
__device__ __forceinline__ float wave_sum(float v) {
#pragma unroll
    for (int o = 1; o < 64; o <<= 1) v += __shfl_xor(v, o);
    return v;
}
__device__ __forceinline__ float sigmoidf_(float x) { return __builtin_amdgcn_rcpf(1.0f + __expf(-x)); }

namespace pg8 {
#define PG8_LAS __attribute__((address_space(3)))
constexpr int BM = 256, BK = 64, HALF = 128, HTB = HALF * BK * 2, STAGE_BYTES = 8 * HTB, NXCD = 8, WGM = 8;
__host__ __device__ __forceinline__ int lds_byte(int r, int c) { const int st = (r >> 4) * 2 + (c >> 5), rr = r & 15, cc = c & 31, ob = rr * 64 + cc * 2; return st * 1024 + (ob ^ (((ob >> 9) & 1) << 5)); }
__host__ __device__ __forceinline__ void stage_rc(int b, int& R, int& C) { const int st = b / 1024, sb = b % 1024, swz = sb ^ (((sb >> 9) & 1) << 5); R = (st >> 1) * 16 + swz / 64; C = (st & 1) * 32 + (swz % 64) / 2; }
__host__ __device__ __forceinline__ int perm32(int rho) { const int n = rho >> 4, i = rho & 15; return 8 * (i >> 2) + 4 * n + (i & 3); }

struct Unit { int pm, pn, e, j; };

__device__ __forceinline__ int xcd_remap(int wgid, int nwg) { const int q = nwg / NXCD, r = nwg % NXCD, xcd = wgid % NXCD, off = wgid / NXCD; return (xcd < r ? xcd * (q + 1) : r * (q + 1) + (xcd - r) * q) + off; }

struct DenseOrder {
    static constexpr bool GATHER = false;
    const char* A; const char* Bt; int K, nM, nN, nwg, G, c;
    __device__ void init(const void* A_, const void* Bt_, int M, int N, int K_, int G_, int c_) { A = (const char*)A_; Bt = (const char*)Bt_; K = K_; nM = M / BM; nN = N / BM; nwg = nM * nN; G = G_; c = c_; }
    __device__ bool next(int i, Unit& u) const {
        const long L = (long)i * G + c; if (L >= nwg) return false;
        const int wgid = xcd_remap((int)L, nwg);
        const int nig = WGM * nN, gid = wgid / nig, fm = gid * WGM, gsz = (nM - fm) < WGM ? (nM - fm) : WGM;
        u.pm = fm + ((wgid % nig) % gsz); u.pn = (wgid % nig) / gsz; u.e = 0; u.j = 0; return true;
    }
    __device__ __forceinline__ const char* a_tile(const Unit& u) const { return A + (size_t)u.pm * BM * K * 2; }
    __device__ __forceinline__ const char* b_tile(const Unit& u) const { return Bt + (size_t)u.pn * BM * K * 2; }
    __device__ __forceinline__ unsigned a_row_off(const Unit&, int r) const { return (unsigned)(r * K * 2); }
};
struct MoeOrder {
    const char* A; const char* Bt; size_t bexp; int K, nN, nwg, G, c; const PG8_LAS int* tab; const int* lists;
    __device__ bool next(int i, Unit& u) const {
        const long L = (long)i * G + c; if (L >= nwg) return false;
        const int wgid = xcd_remap((int)L, nwg);
        const int t = wgid / nN; u.pn = wgid % nN; u.pm = t;
        int e = 0; while (e < 31 && tab[e + 1] <= t) ++e;
        u.e = e; u.j = t - tab[e]; return true;
    }
    __device__ __forceinline__ const char* b_tile(const Unit& u) const { return Bt + (size_t)u.e * bexp + (size_t)u.pn * BM * K * 2; }
};
struct MoeGatherOrder : MoeOrder {
    static constexpr bool GATHER = true;
    __device__ __forceinline__ const char* a_tile(const Unit&) const { return A; }
    __device__ __forceinline__ unsigned a_row_off(const Unit& u, int r) const {
        const int idx = u.j * BM + r, cnt = tab[40 + u.e];
        const int ii = idx < cnt ? idx : cnt - 1;
        const int tok = lists[(size_t)u.e * 65536 + ii] >> 1;
        return (unsigned)tok * (unsigned)(K * 2);
    }
};
struct MoeDenseOrder : MoeOrder {
    static constexpr bool GATHER = false;
    __device__ __forceinline__ const char* a_tile(const Unit& u) const { return A + (size_t)u.pm * BM * K * 2; }
    __device__ __forceinline__ unsigned a_row_off(const Unit&, int r) const { return (unsigned)(r * K * 2); }
};

__device__ __forceinline__ unsigned cvt_pk_bf16(float lo, float hi) { unsigned r; asm volatile("v_cvt_pk_bf16_f32 %0, %1, %2" : "=v"(r) : "v"(lo), "v"(hi)); return r; }

struct EpiZ {
    static constexpr bool PERM = true;
    bf16* Z;
    __device__ __forceinline__ void operator()(const f32x4 (&acc)[2][2][4][2], const Unit& u, int wr, int wc, int fr, int fq) const {
        const int row0 = u.pm * BM + wr * 64 + fr, cl = wc * 32 + 8 * fq;
        if (u.pn < 6) {
            const bool sg = u.pn >= 3;
            const int zc = (sg ? 768 + (u.pn - 3) * 128 : 384 + u.pn * 128) + cl;
#pragma unroll
            for (int ai = 0; ai < 2; ++ai)
#pragma unroll
                for (int m = 0; m < 4; ++m) {
                    f32x4 a0 = acc[ai][0][m][0], a1 = acc[ai][0][m][1], g0 = acc[ai][1][m][0], g1 = acc[ai][1][m][1];
                    if (sg) {
#pragma unroll
                        for (int q = 0; q < 4; ++q) { g0[q] = sigmoidf_(g0[q]); g1[q] = sigmoidf_(g1[q]); }
                    }
                    a0 = a0 * g0; a1 = a1 * g1;
                    v4u w; w.x = cvt_pk_bf16(a0[0], a0[1]); w.y = cvt_pk_bf16(a0[2], a0[3]); w.z = cvt_pk_bf16(a1[0], a1[1]); w.w = cvt_pk_bf16(a1[2], a1[3]);
                    *(v4u*)(Z + (size_t)(row0 + ai * HALF + m * 16) * NZ + zc) = w;
                }
        } else {
            int zb0, zb1;
            if (u.pn == 6) { zb0 = 0; zb1 = 128; } else if (u.pn == 7) { zb0 = 256; zb1 = 1152; } else { zb0 = 1280; zb1 = -1; }
#pragma unroll
            for (int ai = 0; ai < 2; ++ai)
#pragma unroll
                for (int m = 0; m < 4; ++m) {
                    bf16* rowp = Z + (size_t)(row0 + ai * HALF + m * 16) * NZ + cl;
#pragma unroll
                    for (int bj = 0; bj < 2; ++bj) {
                        const int zb = bj ? zb1 : zb0;
                        if (zb >= 0) { const f32x4 a0 = acc[ai][bj][m][0], a1 = acc[ai][bj][m][1];
                            v4u w; w.x = cvt_pk_bf16(a0[0], a0[1]); w.y = cvt_pk_bf16(a0[2], a0[3]); w.z = cvt_pk_bf16(a1[0], a1[1]); w.w = cvt_pk_bf16(a1[2], a1[3]);
                            *(v4u*)(rowp + zb) = w; }
                    }
                }
        }
    }
};
struct EpiU {
    static constexpr bool PERM = true;
    const bf16* H; bf16* U;
    __device__ __forceinline__ void operator()(const f32x4 (&acc)[2][2][4][2], const Unit& u, int wr, int wc, int fr, int fq) const {
        const int row0 = u.pm * BM + wr * 64 + fr, col0 = u.pn * BM + wc * 32 + 8 * fq;
#pragma unroll
        for (int ai = 0; ai < 2; ++ai)
#pragma unroll
            for (int m = 0; m < 4; ++m) {
                const size_t off = (size_t)(row0 + ai * HALF + m * 16) * D_ + col0;
#pragma unroll
                for (int bj = 0; bj < 2; ++bj) {
                    const v4u h = *(const v4u*)(H + off + bj * HALF);
                    const f32x4 a0 = acc[ai][bj][m][0], a1 = acc[ai][bj][m][1];
                    v4u w;
                    w.x = cvt_pk_bf16(ALPHA * bflo(h.x) + a0[0], ALPHA * bfhi(h.x) + a0[1]); w.y = cvt_pk_bf16(ALPHA * bflo(h.y) + a0[2], ALPHA * bfhi(h.y) + a0[3]);
                    w.z = cvt_pk_bf16(ALPHA * bflo(h.z) + a1[0], ALPHA * bfhi(h.z) + a1[1]); w.w = cvt_pk_bf16(ALPHA * bflo(h.w) + a1[2], ALPHA * bfhi(h.w) + a1[3]);
                    *(v4u*)(U + off + bj * HALF) = w;
                }
            }
    }
};
struct EpiHid {
    static constexpr bool PERM = true;
    bf16* HID;
    __device__ __forceinline__ void operator()(const f32x4 (&acc)[2][2][4][2], const Unit& u, int wr, int wc, int fr, int fq) const {
        const int row0 = u.pm * BM + wr * 64 + fr, col0 = u.pn * 128 + wc * 32 + 8 * fq;
#pragma unroll
        for (int ai = 0; ai < 2; ++ai)
#pragma unroll
            for (int m = 0; m < 4; ++m) {
                f32x4 g0 = acc[ai][0][m][0], g1 = acc[ai][0][m][1]; const f32x4 u0 = acc[ai][1][m][0], u1 = acc[ai][1][m][1];
#pragma unroll
                for (int q = 0; q < 4; ++q) { g0[q] = g0[q] * sigmoidf_(g0[q]); g1[q] = g1[q] * sigmoidf_(g1[q]); }
                g0 = g0 * u0; g1 = g1 * u1;
                v4u w; w.x = cvt_pk_bf16(g0[0], g0[1]); w.y = cvt_pk_bf16(g0[2], g0[3]); w.z = cvt_pk_bf16(g1[0], g1[1]); w.w = cvt_pk_bf16(g1[2], g1[3]);
                *(v4u*)(HID + (size_t)(row0 + ai * HALF + m * 16) * DE + col0) = w;
            }
    }
};
struct EpiPlain {
    static constexpr bool PERM = true;
    bf16* O; int ldc;
    __device__ __forceinline__ void operator()(const f32x4 (&acc)[2][2][4][2], const Unit& u, int wr, int wc, int fr, int fq) const {
        const int row0 = u.pm * BM + wr * 64 + fr, col0 = u.pn * BM + wc * 32 + 8 * fq;
#pragma unroll
        for (int ai = 0; ai < 2; ++ai)
#pragma unroll
            for (int m = 0; m < 4; ++m) {
                bf16* rowp = O + (size_t)(row0 + ai * HALF + m * 16) * ldc + col0;
#pragma unroll
                for (int bj = 0; bj < 2; ++bj) { const f32x4 a0 = acc[ai][bj][m][0], a1 = acc[ai][bj][m][1];
                    v4u w; w.x = cvt_pk_bf16(a0[0], a0[1]); w.y = cvt_pk_bf16(a0[2], a0[3]); w.z = cvt_pk_bf16(a1[0], a1[1]); w.w = cvt_pk_bf16(a1[2], a1[3]);
                    *(v4u*)(rowp + bj * HALF) = w; }
            }
    }
};

template <class Epi, class Sched>
__device__ __forceinline__ void gemm_phase_simple(const Sched& S, const Epi& E) {
    int tid = threadIdx.x; asm volatile("" : "+v"(tid));
    const int wid = __builtin_amdgcn_readfirstlane(tid >> 6), lane = tid & 63, wr = wid >> 2, wc = wid & 3, fr = lane & 15, fq = lane >> 4;
    const int K = S.K;
    Unit cur;
    for (int ui = 0; S.next(ui, cur); ++ui) {
        f32x4 acc[2][2][4][2];
#pragma unroll
        for (int a = 0; a < 2; ++a)
#pragma unroll
            for (int b = 0; b < 2; ++b)
#pragma unroll
                for (int m = 0; m < 4; ++m)
#pragma unroll
                    for (int n = 0; n < 2; ++n) acc[a][b][m][n] = (f32x4){0.f, 0.f, 0.f, 0.f};
        const char* at = S.a_tile(cur); const char* bt = S.b_tile(cur);
        const char* ap[2][4]; const char* bp[2][2];
#pragma unroll
        for (int ai = 0; ai < 2; ++ai)
#pragma unroll
            for (int m = 0; m < 4; ++m) ap[ai][m] = at + S.a_row_off(cur, ai * HALF + wr * 64 + m * 16 + fr) + fq * 16;
#pragma unroll
        for (int bj = 0; bj < 2; ++bj)
#pragma unroll
            for (int n = 0; n < 2; ++n) { const int rho = n * 16 + fr; bp[bj][n] = bt + (size_t)(bj * HALF + wc * 32 + (Epi::PERM ? perm32(rho) : rho)) * K * 2 + fq * 16; }
        for (int k0 = 0; k0 < K; k0 += 32) {
            bf16x8 a[2][4], b[2][2];
#pragma unroll
            for (int ai = 0; ai < 2; ++ai)
#pragma unroll
                for (int m = 0; m < 4; ++m) a[ai][m] = *(const bf16x8*)(ap[ai][m] + k0 * 2);
#pragma unroll
            for (int bj = 0; bj < 2; ++bj)
#pragma unroll
                for (int n = 0; n < 2; ++n) b[bj][n] = *(const bf16x8*)(bp[bj][n] + k0 * 2);
#pragma unroll
            for (int ai = 0; ai < 2; ++ai)
#pragma unroll
                for (int bj = 0; bj < 2; ++bj)
#pragma unroll
                    for (int m = 0; m < 4; ++m)
#pragma unroll
                        for (int n = 0; n < 2; ++n) acc[ai][bj][m][n] = __builtin_amdgcn_mfma_f32_16x16x32_bf16(b[bj][n], a[ai][m], acc[ai][bj][m][n], 0, 0, 0);
        }
        E(acc, cur, wr, wc, fr, fq);
    }
}

__device__ __forceinline__ void glds16(const char* base, unsigned voff, unsigned lds_dst) {
    asm volatile("s_mov_b32 m0, %2\n\ts_nop 0\n\tglobal_load_lds_dwordx4 %0, %1" :: "v"(voff), "s"(base), "s"(lds_dst) : "memory", "m0");
}
template <class Epi, class Sched>
__device__ __forceinline__ void gemm_phase(PG8_LAS unsigned char* lds, const Sched& S, const Epi& E) {
    constexpr bool GATHER = Sched::GATHER;
    int tid = threadIdx.x; asm volatile("" : "+v"(tid));
    const int wid = __builtin_amdgcn_readfirstlane(tid >> 6), lane = tid & 63, wr = wid >> 2, wc = wid & 3, fr = lane & 15, fq = lane >> 4;
    const int K = S.K, nt = K / BK;
    unsigned voffB[2], offA[4], nxA[4];
#pragma unroll
    for (int i = 0; i < 2; ++i) { int R, C; stage_rc(tid * 16 + i * 8192, R, C); const int Rb = Epi::PERM ? ((R & ~31) + perm32(R & 31)) : R;
        voffB[i] = (unsigned)(Rb * K + C) * 2u; offA[i] = (unsigned)(R * K + C) * 2u; offA[2 + i] = 0u; nxA[i] = 0u; nxA[2 + i] = 0u; }
    const size_t kstep = (size_t)(BK * 2);
    const size_t hstep = (size_t)HALF * K * 2;
    const unsigned ldsw = (unsigned)wid * 1024u;
    const unsigned ldsb = (unsigned)(size_t)lds;
    const int aoff = lds_byte(wr * 64 + fr, fq * 8), boff = lds_byte(wc * 32 + fr, fq * 8);
#define PG8_SA(b, h) (((b) * 2 + (h)) * HTB)
#define PG8_SB(b, h) ((4 + (b) * 2 + (h)) * HTB)
#define PG8_STAGE_B(bufoff, gbase) do { _Pragma("unroll") for (int _i = 0; _i < 2; ++_i) \
        glds16((const char*)(gbase), voffB[_i], ldsb + (unsigned)(bufoff) + ldsw + _i * 8192u); } while (0)
#define PG8_STAGE_A(bufoff, gbase, h) do { _Pragma("unroll") for (int _i = 0; _i < 2; ++_i) { \
        if constexpr (GATHER) glds16((const char*)(gbase), offA[(h) * 2 + _i], ldsb + (unsigned)(bufoff) + ldsw + _i * 8192u); \
        else glds16((const char*)(gbase) + (h) * hstep, offA[_i], ldsb + (unsigned)(bufoff) + ldsw + _i * 8192u); } } while (0)
#define PG8_LDA(dst, b, h) do { _Pragma("unroll") for (int m = 0; m < 4; ++m) _Pragma("unroll") for (int k = 0; k < 2; ++k) dst[m][k] = *(const PG8_LAS bf16x8*)(lds + PG8_SA(b, h) + aoff + m * 2048 + k * 1024); } while (0)
#define PG8_LDB(dst, b, h) do { _Pragma("unroll") for (int n = 0; n < 2; ++n) _Pragma("unroll") for (int k = 0; k < 2; ++k) dst[n][k] = *(const PG8_LAS bf16x8*)(lds + PG8_SB(b, h) + boff + n * 2048 + k * 1024); } while (0)
#define PG8_MMA(ai, bj, At, Bt) do { __builtin_amdgcn_s_setprio(1); _Pragma("unroll") for (int m = 0; m < 4; ++m) _Pragma("unroll") for (int n = 0; n < 2; ++n) _Pragma("unroll") for (int k = 0; k < 2; ++k) \
        acc[ai][bj][m][n] = __builtin_amdgcn_mfma_f32_16x16x32_bf16(Bt[n][k], At[m][k], acc[ai][bj][m][n], 0, 0, 0); __builtin_amdgcn_s_setprio(0); } while (0)
#define PG8_WAIT_V(n) asm volatile("s_waitcnt vmcnt(" #n ")" ::: "memory")
#define PG8_WAIT_L(n) asm volatile("s_waitcnt lgkmcnt(" #n ")" ::: "memory")
#define PG8_BAR __builtin_amdgcn_s_barrier()
#define PG8_SCHED __builtin_amdgcn_sched_barrier(0)
#define PG8_OFFS(dst, u) do { if constexpr (GATHER) { _Pragma("unroll") for (int _h = 0; _h < 2; ++_h) _Pragma("unroll") for (int _i = 0; _i < 2; ++_i) { \
        int _R, _C; stage_rc(tid * 16 + _i * 8192, _R, _C); dst[_h * 2 + _i] = S.a_row_off(u, _h * HALF + _R) + (unsigned)(_C * 2); } } } while (0)
    Unit cur, nxt; int ui = 0;
    if (!S.next(0, cur)) return;
    f32x4 acc[2][2][4][2];
#pragma unroll
    for (int a = 0; a < 2; ++a)
#pragma unroll
        for (int b = 0; b < 2; ++b)
#pragma unroll
            for (int m = 0; m < 4; ++m)
#pragma unroll
                for (int n = 0; n < 2; ++n) acc[a][b][m][n] = (f32x4){0.f, 0.f, 0.f, 0.f};
    bf16x8 At[4][2], B0[2][2], B1[2][2];
    const char* cA = S.a_tile(cur); const char* cB = S.b_tile(cur);
    PG8_OFFS(offA, cur);
    PG8_STAGE_B(PG8_SB(0, 0), cB); PG8_STAGE_B(PG8_SB(0, 1), cB + hstep); PG8_STAGE_A(PG8_SA(0, 0), cA, 0); PG8_STAGE_A(PG8_SA(0, 1), cA, 1);
    if (wr == 1) PG8_BAR;
    PG8_WAIT_V(2); PG8_BAR;
    PG8_STAGE_B(PG8_SB(1, 0), cB + kstep); PG8_STAGE_A(PG8_SA(1, 0), cA + kstep, 0); PG8_STAGE_B(PG8_SB(1, 1), cB + hstep + kstep);
    PG8_WAIT_V(6); PG8_BAR;
    for (;;) {
        const bool has_next = S.next(ui + 1, nxt);
        const char* nA = has_next ? S.a_tile(nxt) : cA; const char* nB = has_next ? S.b_tile(nxt) : cB;
        if constexpr (GATHER) { if (has_next) { PG8_OFFS(nxA, nxt); } }
        for (int t = 0; t < nt; t += 2) {
            const bool last = (t == nt - 2);
            const char* a1 = cA + (size_t)(t + 1) * kstep;
            const char* a2 = last ? nA : cA + (size_t)(t + 2) * kstep; const char* b2 = last ? nB : cB + (size_t)(t + 2) * kstep;
            const char* a3 = a2 + kstep; const char* b3 = b2 + kstep;
            PG8_LDB(B0, 0, 0); PG8_LDB(B1, 0, 1); PG8_SCHED; PG8_LDA(At, 0, 0); PG8_STAGE_A(PG8_SA(1, 1), a1, 1);
            if constexpr (GATHER) { if (last && has_next) {
#pragma unroll
                for (int q = 0; q < 4; ++q) offA[q] = nxA[q]; } }
            PG8_WAIT_V(8); PG8_WAIT_L(0); PG8_BAR; PG8_MMA(0, 0, At, B0); PG8_MMA(0, 1, At, B1); PG8_BAR; PG8_SCHED;
            PG8_LDA(At, 0, 1); PG8_STAGE_B(PG8_SB(0, 0), b2); PG8_STAGE_B(PG8_SB(0, 1), b2 + hstep); PG8_STAGE_A(PG8_SA(0, 0), a2, 0);
            PG8_WAIT_V(8); PG8_WAIT_L(0); PG8_BAR; PG8_MMA(1, 0, At, B0); PG8_MMA(1, 1, At, B1); PG8_BAR; PG8_SCHED;
            PG8_LDB(B0, 1, 0); PG8_LDB(B1, 1, 1); PG8_SCHED; PG8_LDA(At, 1, 0); PG8_STAGE_A(PG8_SA(0, 1), a2, 1);
            PG8_WAIT_V(8); PG8_WAIT_L(0); PG8_BAR; PG8_MMA(0, 0, At, B0); PG8_MMA(0, 1, At, B1); PG8_BAR; PG8_SCHED;
            PG8_LDA(At, 1, 1); PG8_STAGE_B(PG8_SB(1, 0), b3); PG8_STAGE_B(PG8_SB(1, 1), b3 + hstep); PG8_STAGE_A(PG8_SA(1, 0), a3, 0);
            PG8_WAIT_V(8); PG8_WAIT_L(0); PG8_BAR; PG8_MMA(1, 0, At, B0); PG8_MMA(1, 1, At, B1); PG8_BAR; PG8_SCHED;
        }
        if (wr == 0) PG8_BAR;
        E(acc, cur, wr, wc, fr, fq);
        if (!has_next) break;
#pragma unroll
        for (int a = 0; a < 2; ++a)
#pragma unroll
            for (int b = 0; b < 2; ++b)
#pragma unroll
                for (int m = 0; m < 4; ++m)
#pragma unroll
                    for (int n = 0; n < 2; ++n) acc[a][b][m][n] = (f32x4){0.f, 0.f, 0.f, 0.f};
        cur = nxt; cA = nA; cB = nB; ++ui;
        if (wr == 1) PG8_BAR;
    }
    PG8_WAIT_V(0);
    PG8_BAR;
#undef PG8_SA
#undef PG8_SB
#undef PG8_STAGE_A
#undef PG8_STAGE_B
#undef PG8_LDA
#undef PG8_LDB
#undef PG8_MMA
#undef PG8_WAIT_V
#undef PG8_WAIT_L
#undef PG8_BAR
#undef PG8_SCHED
#undef PG8_OFFS
}
}

#define XB_TMO      128
#define XB_XCNT(j)  (256  + 64 * (j))
#define XB_XSUB(j)  (1280 + 64 * (j))
#define XB_XGEN(j)  (2304 + 64 * (j))
#define XB_TOP      3328
#define XB_TOPGEN   3392
#define XCD_BAR_WORDS 3456
#define XB_SPIN_CAP (1u << 18)
__device__ __forceinline__ unsigned xb_ld(unsigned* p)              { return __hip_atomic_load(p, __ATOMIC_RELAXED, __HIP_MEMORY_SCOPE_AGENT); }
__device__ __forceinline__ unsigned xb_add(unsigned* p, unsigned v) { return __hip_atomic_fetch_add(p, v, __ATOMIC_RELAXED, __HIP_MEMORY_SCOPE_AGENT); }
__device__ __forceinline__ unsigned xb_xcc_id() { return (unsigned)__builtin_amdgcn_s_getreg((3 << 11) | 20) & 0xFu; }
#define XB_SPIN(cond, bar) do { unsigned _sp = 0; while (cond) { __builtin_amdgcn_s_sleep(1); \
    if ((++_sp & 255u) == 0u) { if (xb_ld(&(bar)[XB_TMO])) break; if (_sp > XB_SPIN_CAP) { atomicAdd(&(bar)[XB_TMO], 1u); break; } } } } while (0)
struct XcdBarrier { unsigned* bar; unsigned x; volatile LAS unsigned* st; };
__device__ __forceinline__ XcdBarrier xcd_barrier_post(unsigned* bar, volatile LAS unsigned* st) {
    XcdBarrier b; b.bar = bar; b.x = xb_xcc_id(); b.st = st;
    if (threadIdx.x == 0) (void)xb_add(&bar[XB_XCNT(b.x)], 1u);
    return b;
}
__device__ __forceinline__ void xcd_barrier_complete(unsigned* bar, unsigned x, unsigned& nloc, unsigned& nx) {
    const unsigned G = gridDim.x * gridDim.y * gridDim.z;
    unsigned sum, cnt, mine, sp = 0u;
    for (;;) {
        sum = 0u; cnt = 0u; mine = 0u;
#pragma unroll
        for (unsigned j = 0; j < 16; ++j) { const unsigned c = xb_ld(&bar[XB_XCNT(j)]); sum += c; cnt += (c > 0u) ? 1u : 0u; mine = (j == x) ? c : mine; }
        if (sum == G) break;
        __builtin_amdgcn_s_sleep(1);
        if ((++sp & 255u) == 0u) { if (xb_ld(&bar[XB_TMO])) break; if (sp > XB_SPIN_CAP) { atomicAdd(&bar[XB_TMO], 1u); break; } }
    }
    nloc = mine > 0u ? mine : 1u; nx = cnt > 0u ? cnt : 1u;
}
__device__ __forceinline__ void xcd_barrier(const XcdBarrier& b) {
    asm volatile("s_waitcnt vmcnt(0)" ::: "memory");
    __syncthreads();
    if (threadIdx.x == 0) {
        unsigned* bar = b.bar;
        __builtin_amdgcn_s_waitcnt(0);
        unsigned nloc = b.st[0], nx = b.st[1];
        if (nloc == 0u) { xcd_barrier_complete(bar, b.x, nloc, nx); b.st[0] = nloc; b.st[1] = nx; }
        const unsigned old = xb_add(&bar[XB_XSUB(b.x)], 1u);
        const unsigned gen = old / nloc;
        if (old + 1u == (gen + 1u) * nloc) {
            __builtin_amdgcn_fence(__ATOMIC_RELEASE, "agent");
            asm volatile("s_waitcnt vmcnt(0)" ::: "memory");
            const unsigned og = xb_add(&bar[XB_TOP], 1u);
            const unsigned tg = og / nx;
            if (og + 1u == (tg + 1u) * nx) xb_add(&bar[XB_TOPGEN], 1u);
            else XB_SPIN(xb_ld(&bar[XB_TOPGEN]) == tg, bar);
            __builtin_amdgcn_fence(__ATOMIC_ACQUIRE, "agent");
            xb_add(&bar[XB_XGEN(b.x)], 1u);
            asm volatile("s_waitcnt vmcnt(0)" ::: "memory");
        } else {
            XB_SPIN(xb_ld(&bar[XB_XGEN(b.x)]) == gen, bar);
            __builtin_amdgcn_fence(__ATOMIC_ACQUIRE, "agent");
            asm volatile("s_waitcnt vmcnt(0)" ::: "memory");
        }
    }
    __syncthreads();
}

constexpr int NWAVES = 8;
struct Args { const float* in[21]; float* out; unsigned char* ws; int ph_lo, ph_hi; };
struct Frame {
    LAS unsigned char* lds;
    unsigned* ctl;
    int tid, lane, wave, vcu, G;
    unsigned char* ws;
};
enum { I_X = 0, I_LNIG, I_LNIB, I_RW, I_RB, I_WIN, I_CAW, I_CBW, I_CBB, I_LCG, I_LCB, I_PW, I_PS, I_WOUT, I_LMG, I_LMB, I_WG, I_WU, I_WDN, I_LFG, I_LFB };

__device__ __forceinline__ void tr_item(const float* src, int srcN, int srccol0, bf16* dst, int dstK, int dstrow0, int k0, LAS float* scr, int lane) {
#pragma unroll 8
    for (int i = 0; i < 32; ++i) { const int kk = 2 * i + (lane >> 5); scr[kk * 33 + (lane & 31)] = src[(size_t)(k0 + kk) * srcN + srccol0 + (lane & 31)]; }
    LDS_WAIT(); asm volatile("" ::: "memory");
    const int c = lane & 7;
#pragma unroll
    for (int j = 0; j < 4; ++j) { const int n = (lane >> 3) + 8 * j; const LAS float* s = scr + (8 * c) * 33 + n;
        v4u o; o.x = pk2(s[0 * 33], s[1 * 33]); o.y = pk2(s[2 * 33], s[3 * 33]); o.z = pk2(s[4 * 33], s[5 * 33]); o.w = pk2(s[6 * 33], s[7 * 33]);
        *(GAS v4u*)(dst + (size_t)(dstrow0 + n) * dstK + k0 + 8 * c) = o; }
    LDS_WAIT(); asm volatile("" ::: "memory");
}
__device__ __forceinline__ int win_src(int c0) {
    const int pn = c0 >> 8, j = c0 & 255, half = j >> 7, jj = j & 127;
    if (pn < 3) { const int ch = pn * 128 + jj; return half == 0 ? 384 + ch : 768 + ch; }
    if (pn < 6) { const int ch = (pn - 3) * 128 + jj; return half == 0 ? 1152 + ch : 1536 + ch; }
    if (pn < 8) { const int q = (pn - 6) * 256 + j; return q < 384 ? q : 1920 + (q - 384); }
    return j < 128 ? 1920 + 128 + j : -1;
}
__device__ __forceinline__ void p0_prologue(Frame& F, const Args& A) {
    LAS float* scr = (LAS float*)(F.lds + F.wave * 16384);
    const int gw = F.vcu * NWAVES + F.wave, NGW = F.G * NWAVES, lane = F.lane;
    bf16* WIN = (bf16*)(F.ws + WS_WIN); bf16* WOUT = (bf16*)(F.ws + WS_WOUT); bf16* WGU = (bf16*)(F.ws + WS_WGU); bf16* WD = (bf16*)(F.ws + WS_WD); bf16* WRT = (bf16*)(F.ws + WS_WRT);
    constexpr int I_A = NL * 16 * 72, I_B = NL * 12 * 32, I_C = NL * NE * 512, I_D = NL * NE * 256, I_E = 16, I_F = NL * 4 * 16;
    constexpr int NITEMS = I_A + I_B + I_C + I_D + I_E + I_F;
    for (int it = gw; it < NITEMS; it += NGW) {
        int r = it;
        if (r < I_C) {
            const int le = r >> 9, q = r & 511, kb = q >> 5, nb = q & 31, n0 = nb * 32, pn = n0 >> 8, half = (n0 & 255) >> 7, jj0 = n0 & 127;
            const float* src = (half ? A.in[I_WU] : A.in[I_WG]) + (size_t)le * 1024 * 512;
            tr_item(src, 512, pn * 128 + jj0, WGU + (size_t)le * 1024 * 1024, 1024, n0, kb * 64, scr, lane); continue; }
        r -= I_C;
        if (r < I_D) {
            const int le = r >> 8, q = r & 255, kb = q >> 5, nb = q & 31;
            tr_item(A.in[I_WDN] + (size_t)le * 512 * 1024, 1024, nb * 32, WD + (size_t)le * 1024 * 512, 512, nb * 32, kb * 64, scr, lane); continue; }
        r -= I_D;
        if (r < I_A) {
            const int l = r / 1152, q = r % 1152, kb = q / 72, nb = q % 72, c0 = nb * 32, sc = win_src(c0);
            bf16* dst = WIN + (size_t)l * N1 * 1024;
            if (sc >= 0) tr_item(A.in[I_WIN] + (size_t)l * 1024 * DIN, DIN, sc, dst, 1024, c0, kb * 64, scr, lane);
            else { const int c = lane & 7;
#pragma unroll
                for (int j = 0; j < 4; ++j) { const int n = (lane >> 3) + 8 * j; *(GAS v4u*)(dst + (size_t)(c0 + n) * 1024 + kb * 64 + 8 * c) = (v4u){0u, 0u, 0u, 0u}; } }
            continue; }
        r -= I_A;
        if (r < I_B) {
            const int l = r / 384, q = r % 384, kb = q >> 5, nb = q & 31;
            tr_item(A.in[I_WOUT] + (size_t)l * 1024 * 1024, 1024, nb * 32, WOUT + (size_t)l * 1024 * 1024, 1024, nb * 32, kb * 64, scr, lane); continue; }
        r -= I_B;
        if (r < I_E) { tr_item(A.in[I_RW], 32, 0, WRT, 1024, 0, r * 64, scr, lane); continue; }
        r -= I_E;
        {
            const int l = r >> 6, g = (r >> 4) & 3, n = (r & 15) * 64 + lane;
            const float* wo = A.in[I_WOUT] + (size_t)l * 1024 * 1024 + (size_t)(768 + g * 64) * 1024 + n;
            const float* ps = A.in[I_PS] + l * 256 + g * 64;
            const float* pw = A.in[I_PW] + (size_t)(l * 4 + g) * 64 * 64;
            float wv[64];
#pragma unroll
            for (int d = 0; d < 64; ++d) wv[d] = wo[(size_t)d * 1024] * ps[d];
            bf16* dst = WOUT + (size_t)l * 1024 * 1024 + (size_t)n * 1024 + 768 + g * 64;
#pragma unroll 1
            for (int c = 0; c < 64; ++c) { const float* pr = pw + c * 64; float a = 0.f;
#pragma unroll
                for (int d = 0; d < 64; ++d) a += pr[d] * wv[d];
                dst[c] = (bf16)f2bf(a);
                asm volatile("" ::: "memory"); }
        }
    }
    bf16* HB = (bf16*)(F.ws + WS_HB);
    const float* g = A.in[I_LNIG]; const float* b = A.in[I_LNIB];
    f32x4 gv[4], bv[4];
#pragma unroll
    for (int j = 0; j < 4; ++j) { gv[j] = *(const f32x4*)(g + 4 * lane + 256 * j); bv[j] = *(const f32x4*)(b + 4 * lane + 256 * j); }
    for (int m = gw; m < T_; m += NGW) {
        const GAS f32x4* xr = (const GAS f32x4*)(A.in[I_X] + (size_t)m * D_) + lane;
        f32x4 v[4]; float s = 0.f;
#pragma unroll
        for (int j = 0; j < 4; ++j) { v[j] = xr[64 * j]; s += (v[j].x + v[j].y) + (v[j].z + v[j].w); }
        const float mean = wave_sum(s) * (1.f / D_); float s2 = 0.f;
#pragma unroll
        for (int j = 0; j < 4; ++j) { v[j] = v[j] - mean; s2 += (v[j].x * v[j].x + v[j].y * v[j].y) + (v[j].z * v[j].z + v[j].w * v[j].w); }
        const float rstd = 1.f / sqrtf(wave_sum(s2) * (1.f / D_) + LN_EPS);
        GAS v2u* o8 = (GAS v2u*)(HB + (size_t)m * D_) + lane;
#pragma unroll
        for (int j = 0; j < 4; ++j) { const f32x4 o = v[j] * rstd * gv[j] + bv[j]; v2u w; w.x = pk2(o.x, o.y); w.y = pk2(o.z, o.w); o8[64 * j] = w; }
    }
}

__device__ __forceinline__ void p2_mixer(Frame& F, const Args& A, int l) {
    LAS unsigned* BV = (LAS unsigned*)F.lds;
    LAS unsigned* PB = (LAS unsigned*)(F.lds + 47616);
    LAS float* V = (LAS float*)(F.lds + 71680);
    const bf16* Z = (const bf16*)(F.ws + WS_Z); bf16* Y = (bf16*)(F.ws + WS_Y);
    const float* wB = A.in[I_CBW] + l * 31 * 384; const float* bB = A.in[I_CBB] + l * 384;
    const float* lg = A.in[I_LCG] + l * 384; const float* lb = A.in[I_LCB] + l * 384; const float* wA = A.in[I_CAW] + l * 3 * 384;
    int tid = F.tid; asm volatile("" : "+v"(tid));
    const int lane = tid & 63, wave = F.wave;
    const bool convt = tid < 384; const int cp = tid % 192, tg = tid / 192;
    f32x2 w[31]; f32x2 bias = (f32x2){0.f, 0.f};
#pragma unroll
    for (int j = 0; j < 31; ++j) w[j] = (f32x2){0.f, 0.f};
    if (convt) {
#pragma unroll
        for (int j = 0; j < 31; ++j) w[j] = *(const f32x2*)(wB + j * 384 + 2 * cp);
        bias = *(const f32x2*)(bB + 2 * cp); }
    for (int ci = F.vcu; ci < T_ / 32; ci += F.G) {
        const int t0 = ci * 32, s0 = t0 & (SEQ_ - 1);
        for (int q = tid; q < 62 * 48; q += 512) { const int r = q / 48, c = q % 48; v4u v = (v4u){0u, 0u, 0u, 0u};
            if (s0 - 30 + r >= 0) v = *(const GAS v4u*)(Z + (size_t)(t0 - 30 + r) * NZ + 768 + c * 8);
            *(LAS v4u*)(BV + r * 192 + c * 4) = v; }
        for (int q = tid; q < 47 * 32; q += 512) { const int r = q >> 5, c = q & 31; v4u v = (v4u){0u, 0u, 0u, 0u};
            if (s0 - 15 + r >= 0) v = *(const GAS v4u*)(Z + (size_t)(t0 - 15 + r) * NZ + 1152 + c * 8);
            *(LAS v4u*)(PB + r * 128 + c * 4) = v; }
        __syncthreads();
        if (convt) {
#pragma unroll 1
            for (int hh = 0; hh < 2; ++hh) { const int tb = tg * 16 + hh * 8;
                f32x2 x[38];
#pragma unroll
                for (int i = 0; i < 38; ++i) { const unsigned u = BV[(tb + i) * 192 + cp]; x[i] = (f32x2){bflo(u), bfhi(u)}; }
#pragma unroll
                for (int tt = 0; tt < 8; ++tt) { f32x2 a = bias;
#pragma unroll
                    for (int j = 0; j < 31; ++j) a += w[j] * x[tt + j];
                    *(LAS f32x2*)(V + (tb + tt) * 384 + 2 * cp) = a; }
            }
        } else {
            const int p = tid - 384, wd = 2 << (p >> 5);
            f32x2 s = (f32x2){0.f, 0.f};
            for (int i = 1; i < wd; ++i) { const unsigned u = PB[(15 - i) * 128 + p]; s += (f32x2){bflo(u), bfhi(u)}; }
            for (int tt = 0; tt < 32; ++tt) { const int row = 15 + tt; const unsigned u = PB[row * 128 + p]; const f32x2 xv = (f32x2){bflo(u), bfhi(u)};
                s += xv; const int n = (s0 + tt + 1) < wd ? (s0 + tt + 1) : wd; const float inv = 1.0f / (float)n;
                const f32x2 dd = s * inv - xv;
                *(GAS unsigned*)(Y + (size_t)(t0 + tt) * D_ + 768 + 2 * p) = pk2(dd.x, dd.y);
                const unsigned uo = PB[(row - wd + 1) * 128 + p]; s -= (f32x2){bflo(uo), bfhi(uo)}; }
        }
        __syncthreads();
#pragma unroll 1
        for (int tk = 0; tk < 4; ++tk) { const int tt = wave * 4 + tk;
            f32x2 v[3]; float s = 0.f;
#pragma unroll
            for (int i = 0; i < 3; ++i) { v[i] = *(const LAS f32x2*)(V + tt * 384 + 2 * lane + 128 * i); s += v[i].x + v[i].y; }
            const float mean = wave_sum(s) * (1.f / 384.f); float q = 0.f;
#pragma unroll
            for (int i = 0; i < 3; ++i) { v[i] = v[i] - mean; q += v[i].x * v[i].x + v[i].y * v[i].y; }
            const float rstd = 1.f / sqrtf(wave_sum(q) * (1.f / 384.f) + LN_EPS);
#pragma unroll
            for (int i = 0; i < 3; ++i) { const int c = 2 * lane + 128 * i; const f32x2 gg = *(const f32x2*)(lg + c), bb = *(const f32x2*)(lb + c);
                f32x2 o = v[i] * rstd * gg + bb; o.x = o.x * sigmoidf_(o.x); o.y = o.y * sigmoidf_(o.y);
                *(GAS unsigned*)(Y + (size_t)(t0 + tt) * D_ + 384 + c) = pk2(o.x, o.y); }
        }
        for (int q = tid; q < 32 * 48; q += 512) { const int tt = q / 48, o8 = q % 48, pos = s0 + tt; const size_t row = (size_t)(t0 + tt);
            const v4u gb = *(const GAS v4u*)(Z + row * NZ + o8 * 8);
            const v4u x0 = *(const GAS v4u*)(Z + row * NZ + 384 + o8 * 8);
            v4u x1 = (v4u){0u, 0u, 0u, 0u}, x2 = (v4u){0u, 0u, 0u, 0u};
            if (pos >= 1) x1 = *(const GAS v4u*)(Z + (row - 1) * NZ + 384 + o8 * 8);
            if (pos >= 2) x2 = *(const GAS v4u*)(Z + (row - 2) * NZ + 384 + o8 * 8);
            const f32x4 w2a = *(const f32x4*)(wA + 2 * 384 + o8 * 8), w2b = *(const f32x4*)(wA + 2 * 384 + o8 * 8 + 4);
            const f32x4 w1a = *(const f32x4*)(wA + 1 * 384 + o8 * 8), w1b = *(const f32x4*)(wA + 1 * 384 + o8 * 8 + 4);
            const f32x4 w0a = *(const f32x4*)(wA + o8 * 8), w0b = *(const f32x4*)(wA + o8 * 8 + 4);
            float o[8];
            const unsigned gbw[4] = {gb.x, gb.y, gb.z, gb.w}, x0w[4] = {x0.x, x0.y, x0.z, x0.w}, x1w[4] = {x1.x, x1.y, x1.z, x1.w}, x2w[4] = {x2.x, x2.y, x2.z, x2.w};
            const float w2[8] = {w2a.x, w2a.y, w2a.z, w2a.w, w2b.x, w2b.y, w2b.z, w2b.w}, w1[8] = {w1a.x, w1a.y, w1a.z, w1a.w, w1b.x, w1b.y, w1b.z, w1b.w}, w0[8] = {w0a.x, w0a.y, w0a.z, w0a.w, w0b.x, w0b.y, w0b.z, w0b.w};
#pragma unroll
            for (int e = 0; e < 4; ++e) {
                o[2 * e] = bflo(gbw[e]) * (w2[2 * e] * bflo(x0w[e]) + w1[2 * e] * bflo(x1w[e]) + w0[2 * e] * bflo(x2w[e]));
                o[2 * e + 1] = bfhi(gbw[e]) * (w2[2 * e + 1] * bfhi(x0w[e]) + w1[2 * e + 1] * bfhi(x1w[e]) + w0[2 * e + 1] * bfhi(x2w[e])); }
            v4u ov; ov.x = pk2(o[0], o[1]); ov.y = pk2(o[2], o[3]); ov.z = pk2(o[4], o[5]); ov.w = pk2(o[6], o[7]);
            *(GAS v4u*)(Y + row * D_ + o8 * 8) = ov; }
        __syncthreads();
    }
}

__device__ __forceinline__ void top2of4(float q0, float q1, float q2, float q3, float& a1, int& i1, float& a2, int& i2) {
    a1 = q0; i1 = 0; a2 = -1.f; i2 = 1;
#define T2STEP(qv, r) { const bool gt = (qv) > a1; const bool g2 = (qv) > a2; const float na2 = gt ? a1 : (g2 ? (qv) : a2); const int ni2 = gt ? i1 : (g2 ? (r) : i2); \
        a1 = gt ? (qv) : a1; i1 = gt ? (r) : i1; a2 = na2; i2 = ni2; }
    T2STEP(q1, 1) T2STEP(q2, 2) T2STEP(q3, 3)
#undef T2STEP
}
__device__ __forceinline__ void p4_ln_router(Frame& F, const Args& A, int l) {
    LAS unsigned char* lds = F.lds;
    LAS int* cntl = (LAS int*)(lds + 66048); LAS int* basel = cntl + 32; LAS int* sel = cntl + 64; LAS int* lpos = cntl + 64 + 256;
    const bf16* U = (const bf16*)(F.ws + WS_U); bf16* HB = (bf16*)(F.ws + WS_HB); const bf16* WRT = (const bf16*)(F.ws + WS_WRT);
    int* route = (int*)(F.ws + WS_ROUTE); int* lists = (int*)(F.ws + WS_LISTS);
    unsigned* counts = F.ctl + CW_CNT + l * 32 * 64;
    const float* g = A.in[I_LMG] + l * D_; const float* b = A.in[I_LMB] + l * D_; const float* rb = A.in[I_RB];
    int tid = F.tid; asm volatile("" : "+v"(tid));
    const int lane = tid & 63, wave = F.wave, fr = lane & 15, fq = lane >> 4;
    for (int q = tid; q < 32 * 128; q += 512) { const int e = q >> 7, c = q & 127; *(LAS v4u*)(lds + e * 2064 + c * 16) = *(const GAS v4u*)(WRT + e * 1024 + c * 8); }
    if (tid < 32) cntl[tid] = 0;
    f32x4 gv[4], bv[4];
#pragma unroll
    for (int j = 0; j < 4; ++j) { gv[j] = *(const f32x4*)(g + 4 * lane + 256 * j); bv[j] = *(const f32x4*)(b + 4 * lane + 256 * j); }
    __syncthreads();
    for (int blk = F.vcu; blk < T_ / 128; blk += F.G) {
#pragma unroll 1
        for (int i = 0; i < 16; ++i) { const size_t m = (size_t)(blk * 128 + wave * 16 + i);
            const GAS v2u* up = (const GAS v2u*)(U + m * D_) + lane;
            f32x4 v[4]; float s = 0.f;
#pragma unroll
            for (int j = 0; j < 4; ++j) { const v2u q = up[64 * j]; v[j] = (f32x4){bflo(q.x), bfhi(q.x), bflo(q.y), bfhi(q.y)}; s += (v[j].x + v[j].y) + (v[j].z + v[j].w); }
            const float mean = wave_sum(s) * (1.f / D_); float s2 = 0.f;
#pragma unroll
            for (int j = 0; j < 4; ++j) { v[j] = v[j] - mean; s2 += (v[j].x * v[j].x + v[j].y * v[j].y) + (v[j].z * v[j].z + v[j].w * v[j].w); }
            const float rstd = 1.f / sqrtf(wave_sum(s2) * (1.f / D_) + LN_EPS);
            GAS v2u* o8 = (GAS v2u*)(HB + m * D_) + lane;
#pragma unroll
            for (int j = 0; j < 4; ++j) { const f32x4 o = v[j] * rstd * gv[j] + bv[j]; v2u w; w.x = pk2(o.x, o.y); w.y = pk2(o.z, o.w); o8[64 * j] = w; }
        }
        VM_WAIT(); asm volatile("" ::: "memory");
        const int token = blk * 128 + wave * 16 + fr;
        f32x4 acc0 = (f32x4){0.f, 0.f, 0.f, 0.f}, acc1 = (f32x4){0.f, 0.f, 0.f, 0.f};
        const bf16* hrow = HB + (size_t)token * D_ + fq * 8;
#pragma unroll 8
        for (int k = 0; k < 32; ++k) { const int kk = k * 32 + fq * 8;
            const bf16x8 hf = *(const GAS bf16x8*)(hrow + k * 32);
            const bf16x8 w0 = *(const LAS bf16x8*)(lds + fr * 2064 + kk * 2), w1 = *(const LAS bf16x8*)(lds + (16 + fr) * 2064 + kk * 2);
            acc0 = __builtin_amdgcn_mfma_f32_16x16x32_bf16(w0, hf, acc0, 0, 0, 0);
            acc1 = __builtin_amdgcn_mfma_f32_16x16x32_bf16(w1, hf, acc1, 0, 0, 0);
        }
        float p0[4], p1[4]; float mx = -3.0e38f;
#pragma unroll
        for (int r = 0; r < 4; ++r) { p0[r] = acc0[r] + rb[4 * fq + r]; p1[r] = acc1[r] + rb[16 + 4 * fq + r]; mx = fmaxf(mx, fmaxf(p0[r], p1[r])); }
        mx = fmaxf(mx, __shfl_xor(mx, 16)); mx = fmaxf(mx, __shfl_xor(mx, 32));
#pragma unroll
        for (int r = 0; r < 4; ++r) { p0[r] = __expf(p0[r] - mx); p1[r] = __expf(p1[r] - mx); }
        float a1, a2, c1, c2; int ia1, ia2, ic1, ic2;
        top2of4(p0[0], p0[1], p0[2], p0[3], a1, ia1, a2, ia2); top2of4(p1[0], p1[1], p1[2], p1[3], c1, ic1, c2, ic2);
        const float sc0 = a1 + a2, sc1 = c1 + c2;
        float bs = sc0; int bg = fq; if (sc1 > sc0) { bs = sc1; bg = 4 + fq; }
#pragma unroll
        for (int off = 16; off <= 32; off <<= 1) { const float os = __shfl_xor(bs, off); const int og = __shfl_xor(bg, off); if (os > bs || (os == bs && og < bg)) { bs = os; bg = og; } }
        if ((bg & 3) == fq) {
            const bool hi = bg >= 4;
            const float pa = hi ? c1 : a1, pb = hi ? c2 : a2; const int ia = hi ? ic1 : ia1, ib = hi ? ic2 : ia2;
            const int ea = bg * 4 + ia, eb = bg * 4 + ib; const float inv = 1.0f / (pa + pb);
            const int tokl = wave * 16 + fr;
            const int la = atomicAdd((int*)&cntl[ea], 1), lb2 = atomicAdd((int*)&cntl[eb], 1);
            sel[tokl * 2] = ea; sel[tokl * 2 + 1] = eb; lpos[tokl * 2] = la; lpos[tokl * 2 + 1] = lb2;
            int* rt = route + (size_t)token * 8; rt[0] = ea; rt[2] = eb; rt[4] = __float_as_int(pa * inv); rt[5] = __float_as_int(pb * inv);
        }
        __syncthreads();
        if (tid < 32) { const int c = cntl[tid]; basel[tid] = c ? (int)__hip_atomic_fetch_add(counts + tid * 64, (unsigned)c, RLX_AGENT) : 0; }
        __syncthreads();
        if (tid < 256) { const int tokl = tid >> 1, k = tid & 1, e = sel[tid], pos = basel[e] + lpos[tid], tok = blk * 128 + tokl;
            lists[(size_t)e * 65536 + pos] = tok * 2 + k; route[(size_t)tok * 8 + 1 + 2 * k] = pos; }
        __syncthreads();
        if (tid < 32) cntl[tid] = 0;
        __syncthreads();
    }
}

__device__ __forceinline__ void moe_table(Frame& F, int l) {
    LAS int* tab = (LAS int*)(F.lds + TAB_OFF);
    __syncthreads();
    if (F.tid < 32) tab[40 + F.tid] = (int)__hip_atomic_load(F.ctl + CW_CNT + (l * 32 + F.tid) * 64, RLX_AGENT);
    __syncthreads();
    if (F.tid == 0) { int s = 0; for (int e = 0; e < 32; ++e) { tab[e] = s; s += (tab[40 + e] + 255) >> 8; } tab[32] = s; }
    __syncthreads();
}

__device__ __forceinline__ void p7_combine_ln(Frame& F, const Args& A, int l) {
    const LAS int* tab = (const LAS int*)(F.lds + TAB_OFF);
    bf16* HB = (bf16*)(F.ws + WS_HB); const bf16* Y2S = (const bf16*)(F.ws + WS_Y2S); const int* route = (const int*)(F.ws + WS_ROUTE);
    const float* g = A.in[I_LFG] + l * D_; const float* b = A.in[I_LFB] + l * D_;
    int lane = F.lane; asm volatile("" : "+v"(lane));
    const int gw = F.vcu * NWAVES + F.wave, NGW = F.G * NWAVES;
    f32x4 gv[4], bv[4];
#pragma unroll
    for (int j = 0; j < 4; ++j) { gv[j] = *(const f32x4*)(g + 4 * lane + 256 * j); bv[j] = *(const f32x4*)(b + 4 * lane + 256 * j); }
    const bool last = (l == NL - 1);
    for (int m = gw; m < T_; m += NGW) {
        const int* rt = route + (size_t)m * 8;
        const int e0 = rt[0], q0 = rt[1], e1 = rt[2], q1 = rt[3]; const float g0 = __int_as_float(rt[4]), g1 = __int_as_float(rt[5]);
        const size_t r0 = (size_t)tab[e0] * 256 + q0, r1 = (size_t)tab[e1] * 256 + q1;
        const GAS v2u* hp = (const GAS v2u*)(HB + (size_t)m * D_) + lane; const GAS v2u* ya = (const GAS v2u*)(Y2S + r0 * D_) + lane; const GAS v2u* yb = (const GAS v2u*)(Y2S + r1 * D_) + lane;
        f32x4 v[4]; float s = 0.f;
#pragma unroll
        for (int j = 0; j < 4; ++j) { const v2u h = hp[64 * j], a = ya[64 * j], c = yb[64 * j];
            v[j].x = ALPHA * bflo(h.x) + g0 * bflo(a.x) + g1 * bflo(c.x); v[j].y = ALPHA * bfhi(h.x) + g0 * bfhi(a.x) + g1 * bfhi(c.x);
            v[j].z = ALPHA * bflo(h.y) + g0 * bflo(a.y) + g1 * bflo(c.y); v[j].w = ALPHA * bfhi(h.y) + g0 * bfhi(a.y) + g1 * bfhi(c.y);
            s += (v[j].x + v[j].y) + (v[j].z + v[j].w); }
        const float mean = wave_sum(s) * (1.f / D_); float s2 = 0.f;
#pragma unroll
        for (int j = 0; j < 4; ++j) { v[j] = v[j] - mean; s2 += (v[j].x * v[j].x + v[j].y * v[j].y) + (v[j].z * v[j].z + v[j].w * v[j].w); }
        const float rstd = 1.f / sqrtf(wave_sum(s2) * (1.f / D_) + LN_EPS);
        if (last) { GAS f32x4* o = (GAS f32x4*)(A.out + (size_t)m * D_) + lane;
#pragma unroll
            for (int j = 0; j < 4; ++j) o[64 * j] = v[j] * rstd * gv[j] + bv[j];
        } else { GAS v2u* o8 = (GAS v2u*)(HB + (size_t)m * D_) + lane;
#pragma unroll
            for (int j = 0; j < 4; ++j) { const f32x4 o = v[j] * rstd * gv[j] + bv[j]; v2u w; w.x = pk2(o.x, o.y); w.y = pk2(o.z, o.w); o8[64 * j] = w; } }
    }
}

#ifndef PH_NOINLINE
#define PH_NOINLINE __forceinline__
#endif
PH_NOINLINE __device__ void run_gemm1(LAS unsigned char* lds, unsigned char* ws, int l, int G, int c) {
    pg8::DenseOrder S; S.init(ws + WS_HB, ws + WS_WIN + (size_t)l * N1 * 1024 * 2, T_, N1, D_, G, c);
    pg8::EpiZ E{(bf16*)(ws + WS_Z)};
    if (GEMM_SIMPLE_MASK & 1) pg8::gemm_phase_simple(S, E); else pg8::gemm_phase(lds, S, E);
}
PH_NOINLINE __device__ void run_gemm2(LAS unsigned char* lds, unsigned char* ws, int l, int G, int c) {
    pg8::DenseOrder S; S.init(ws + WS_Y, ws + WS_WOUT + (size_t)l * 1024 * 1024 * 2, T_, D_, D_, G, c);
    pg8::EpiU E{(const bf16*)(ws + WS_HB), (bf16*)(ws + WS_U)};
    if (GEMM_SIMPLE_MASK & 2) pg8::gemm_phase_simple(S, E); else pg8::gemm_phase(lds, S, E);
}
PH_NOINLINE __device__ void run_gemm5(LAS unsigned char* lds, unsigned char* ws, int l, int G, int c) {
    const LAS int* tab = (const LAS int*)(lds + TAB_OFF);
    pg8::MoeGatherOrder S; S.A = (const char*)(ws + WS_HB); S.Bt = (const char*)(ws + WS_WGU + (size_t)l * NE * 1024 * 1024 * 2); S.bexp = (size_t)1024 * 1024 * 2;
    S.K = D_; S.nN = 4; S.nwg = tab[32] * 4; S.G = G; S.c = c; S.tab = tab; S.lists = (const int*)(ws + WS_LISTS);
    pg8::EpiHid E{(bf16*)(ws + WS_HID)};
    if (GEMM_SIMPLE_MASK & 4) pg8::gemm_phase_simple(S, E); else pg8::gemm_phase(lds, S, E);
}
PH_NOINLINE __device__ void run_gemm6(LAS unsigned char* lds, unsigned char* ws, int l, int G, int c) {
    const LAS int* tab = (const LAS int*)(lds + TAB_OFF);
    pg8::MoeDenseOrder S; S.A = (const char*)(ws + WS_HID); S.Bt = (const char*)(ws + WS_WD + (size_t)l * NE * 1024 * 512 * 2); S.bexp = (size_t)1024 * 512 * 2;
    S.K = DE; S.nN = 4; S.nwg = tab[32] * 4; S.G = G; S.c = c; S.tab = tab; S.lists = nullptr;
    pg8::EpiPlain E{(bf16*)(ws + WS_Y2S), D_};
    if (GEMM_SIMPLE_MASK & 8) pg8::gemm_phase_simple(S, E); else pg8::gemm_phase(lds, S, E);
}

__global__ void __launch_bounds__(NWAVES * 64, 2) mk_fwd(Args args) {
    extern __shared__ __attribute__((aligned(16))) unsigned char lds_raw[];
    Frame F;
    F.lds = (LAS unsigned char*)lds_raw;
    F.tid = threadIdx.x; F.lane = F.tid & 63; F.wave = __builtin_amdgcn_readfirstlane(F.tid >> 6);
    F.G = gridDim.x; { const int bx = blockIdx.x; F.vcu = (F.G % 8 == 0) ? (bx % 8) * (F.G / 8) + bx / 8 : bx; }
    F.ws = args.ws; F.ctl = (unsigned*)(args.ws + WS_CTL);
    for (int u = F.tid; u < (LDS_BYTES - LDSCTL_OFF) / 4; u += NWAVES * 64) ((LAS unsigned*)(F.lds + LDSCTL_OFF))[u] = 0u;
    __syncthreads();
    volatile LAS unsigned* MISC = (volatile LAS unsigned*)(F.lds + MISC_OFF);
    XcdBarrier bar; bar.bar = F.ctl + CW_BAR; bar.x = 0; bar.st = nullptr;
    if (MK_N_LAUNCHES == 1) bar = xcd_barrier_post(F.ctl + CW_BAR, MISC + 8);
    const int lo = args.ph_lo, hi = args.ph_hi;
#define IN(k) (lo <= (k) && (k) < hi)
#define SEAM(k) do { if (MK_N_LAUNCHES == 1 && (k) + 1 < hi) xcd_barrier(bar); } while (0)
    if ((PH_MASK & 1) && IN(0)) { p0_prologue(F, args); SEAM(0); }
#pragma unroll 1
    for (int l = 0; l < NL; ++l) {
        const int pb = 1 + 7 * l;
        if ((PH_MASK & 2) && IN(pb + 0)) { run_gemm1(F.lds, F.ws, l, F.G, (int)blockIdx.x); SEAM(pb + 0); }
        if ((PH_MASK & 4) && IN(pb + 1)) { p2_mixer(F, args, l); SEAM(pb + 1); }
        if ((PH_MASK & 8) && IN(pb + 2)) { run_gemm2(F.lds, F.ws, l, F.G, (int)blockIdx.x); SEAM(pb + 2); }
        if ((PH_MASK & 16) && IN(pb + 3)) { p4_ln_router(F, args, l); SEAM(pb + 3); }
        if ((PH_MASK & 32) && IN(pb + 4)) { moe_table(F, l); run_gemm5(F.lds, F.ws, l, F.G, (int)blockIdx.x); SEAM(pb + 4); }
        if ((PH_MASK & 64) && IN(pb + 5)) { moe_table(F, l); run_gemm6(F.lds, F.ws, l, F.G, (int)blockIdx.x); SEAM(pb + 5); }
        if ((PH_MASK & 128) && IN(pb + 6)) { moe_table(F, l); p7_combine_ln(F, args, l); SEAM(pb + 6); }
    }
#undef IN
#undef SEAM
}

extern "C" void kernel_launch(void* const* d_in, const int* in_sizes, int n_in, void* d_out, int out_size, void* d_ws, size_t ws_size, hipStream_t stream) {
    static int grid = 0;
    if (grid == 0) {
        if (n_in != 21 || out_size != T_ * D_ || ws_size < WS_END) { fprintf(stderr, "kernel_launch: unexpected problem (n_in %d, out %d, ws %zu); nothing launched\n", n_in, out_size, ws_size); grid = -1; return; }
        int dev = 0, cus = 0, per_cu = 0;
        if (hipGetDevice(&dev) != hipSuccess || hipDeviceGetAttribute(&cus, hipDeviceAttributeMultiprocessorCount, dev) != hipSuccess) { grid = -1; return; }
        if (hipFuncSetAttribute((const void*)mk_fwd, hipFuncAttributeMaxDynamicSharedMemorySize, LDS_BYTES) != hipSuccess) { fprintf(stderr, "kernel_launch: hipFuncSetAttribute failed\n"); grid = -1; return; }
        if (hipOccupancyMaxActiveBlocksPerMultiprocessor(&per_cu, (const void*)mk_fwd, NWAVES * 64, LDS_BYTES) != hipSuccess || per_cu < 1) { fprintf(stderr, "kernel_launch: occupancy query says %d\n", per_cu); }
        (void)hipGetLastError();
        grid = cus;
    }
    if (grid < 0) return;
    (void)hipMemsetAsync((char*)d_ws + WS_CTL, 0, CTL_ZERO_BYTES, stream);
    Args a{};
    for (int i = 0; i < 21; ++i) a.in[i] = (const float*)d_in[i];
    a.out = (float*)d_out; a.ws = (unsigned char*)d_ws;
    if (MK_N_LAUNCHES == 1) { a.ph_lo = 0; a.ph_hi = NPH; hipLaunchKernelGGL(mk_fwd, dim3(grid), dim3(NWAVES * 64), LDS_BYTES, stream, a); }
    else for (int p = 0; p < NPH; ++p) { a.ph_lo = p; a.ph_hi = p + 1; hipLaunchKernelGGL(mk_fwd, dim3(grid), dim3(NWAVES * 64), LDS_BYTES, stream, a); }
}
```

```cpp
#include <hip/hip_runtime.h>
#include <cstdio>
#include <cstdint>

#ifndef MK_N_LAUNCHES
#define MK_N_LAUNCHES 1
#endif
#ifndef PH_MASK
#define PH_MASK 0xff
#endif
#ifndef REPEAT_MASK
#define REPEAT_MASK 0
#endif
#ifndef PROBE_EXTRA_NN
#define PROBE_EXTRA_NN 0
#endif
#ifndef GEMM_SIMPLE_MASK
#define GEMM_SIMPLE_MASK 0
#endif

#define GAS __attribute__((address_space(1)))
#define LAS __attribute__((address_space(3)))
typedef unsigned short bf16;
typedef unsigned v4u __attribute__((ext_vector_type(4)));
typedef unsigned v2u __attribute__((ext_vector_type(2)));
typedef float f32x4 __attribute__((ext_vector_type(4)));
typedef float f32x2 __attribute__((ext_vector_type(2)));
typedef short bf16x8 __attribute__((ext_vector_type(8)));
#define RLX_AGENT __ATOMIC_RELAXED, __HIP_MEMORY_SCOPE_AGENT
#define LDS_WAIT() asm volatile("s_waitcnt lgkmcnt(0)" ::: "memory")
#define VM_WAIT() asm volatile("s_waitcnt vmcnt(0)" ::: "memory")

constexpr int T_ = 32768, D_ = 1024, SEQ_ = 4096, NL = 2, NE = 32, DE = 512;
constexpr int DIN = 2176, N1 = 2304, NZ = 1408;
constexpr float ALPHA = 1.41421356237f, LN_EPS = 1e-5f;
constexpr int NPH = 1 + 7 * NL;

constexpr size_t MiB = 1u << 20;
constexpr size_t WS_CTL = 0, CTL_ZERO_BYTES = 1 * MiB;
constexpr size_t WS_ROUTE = 1 * MiB;
constexpr size_t WS_WRT = 2 * MiB;
constexpr size_t WS_LISTS = 3 * MiB;
constexpr size_t WS_WIN = 11 * MiB;
constexpr size_t WS_WOUT = 20 * MiB;
constexpr size_t WS_WGU = 24 * MiB;
constexpr size_t WS_H8 = 88 * MiB;
constexpr size_t WS_WD = 152 * MiB;
constexpr size_t WS_HB = 216 * MiB;
constexpr size_t WS_Z = 280 * MiB;
constexpr size_t WS_Y = 368 * MiB;
constexpr size_t WS_U = 280 * MiB;
constexpr size_t WS_HID = 280 * MiB;
constexpr size_t WS_Y2S = 352 * MiB;
constexpr size_t WS_END = 496 * MiB;
constexpr int CW_TMO = 0, CW_BAR = 4096, CW_CNT = 16384;

constexpr int RING_BYTES = 131072, LDSCTL_OFF = RING_BYTES, MISC_OFF = LDSCTL_OFF + 320, TAB_OFF = LDSCTL_OFF + 1024;
constexpr int LDS_BYTES = 147456;

__device__ __forceinline__ unsigned f2bf(float f) { unsigned u = __builtin_bit_cast(unsigned, f); return (u + 0x7fffu + ((u >> 16) & 1u)) >> 16; }
__device__ __forceinline__ unsigned pk2(float lo, float hi) { return f2bf(lo) | (f2bf(hi) << 16); }
__device__ __forceinline__ float bflo(unsigned u) { return __builtin_bit_cast(float, u << 16); }
__device__ __forceinline__ float bfhi(unsigned u) { return __builtin_bit_cast(float, u & 0xffff0000u); }
__device__ __forceinline__ float wave_sum(float v) {
#pragma unroll
    for (int o = 1; o < 64; o <<= 1) v += __shfl_xor(v, o);
    return v;
}
__device__ __forceinline__ unsigned pk4_fp8(float a, float b, float c, float d) {
    int v = 0; v = __builtin_amdgcn_cvt_pk_fp8_f32(a, b, v, false); v = __builtin_amdgcn_cvt_pk_fp8_f32(c, d, v, true); return (unsigned)v; }
__device__ __forceinline__ float sigmoidf_(float x) { return __builtin_amdgcn_rcpf(1.0f + __expf(-x)); }

namespace pg8 {
#define PG8_LAS __attribute__((address_space(3)))
typedef int v8i __attribute__((ext_vector_type(8)));
typedef int v4i __attribute__((ext_vector_type(4)));
constexpr int BM = 256, BK = 64, HALF = 128, HTB = HALF * BK * 2, STAGE_BYTES = 8 * HTB, NXCD = 8, WGM = 8;
__host__ __device__ __forceinline__ int lds_byte(int r, int c) { const int st = (r >> 4) * 2 + (c >> 5), rr = r & 15, cc = c & 31, ob = rr * 64 + cc * 2; return st * 1024 + (ob ^ (((ob >> 9) & 1) << 5)); }
__host__ __device__ __forceinline__ void stage_rc(int b, int& R, int& C) { const int st = b / 1024, sb = b % 1024, swz = sb ^ (((sb >> 9) & 1) << 5); R = (st >> 1) * 16 + swz / 64; C = (st & 1) * 32 + (swz % 64) / 2; }
__host__ __device__ __forceinline__ int perm32(int rho) { const int n = rho >> 4, i = rho & 15; return 8 * (i >> 2) + 4 * n + (i & 3); }

struct Unit { int pm, pn, e, j; };

__device__ __forceinline__ int xcd_remap(int wgid, int nwg) { const int q = nwg / NXCD, r = nwg % NXCD, xcd = wgid % NXCD, off = wgid / NXCD; return (xcd < r ? xcd * (q + 1) : r * (q + 1) + (xcd - r) * q) + off; }

struct DenseOrder {
    static constexpr bool GATHER = false;
    const char* A; const char* Bt; int K, nM, nN, nwg, G, c;
    __device__ void init(const void* A_, const void* Bt_, int M, int N, int K_, int G_, int c_) { A = (const char*)A_; Bt = (const char*)Bt_; K = K_; nM = M / BM; nN = N / BM; nwg = nM * nN; G = G_; c = c_; }
    __device__ bool next(int i, Unit& u) const {
        const long L = (long)i * G + c; if (L >= nwg) return false;
        const int wgid = xcd_remap((int)L, nwg);
        const int nig = WGM * nN, gid = wgid / nig, fm = gid * WGM, gsz = (nM - fm) < WGM ? (nM - fm) : WGM;
        u.pm = fm + ((wgid % nig) % gsz); u.pn = (wgid % nig) / gsz; u.e = 0; u.j = 0; return true;
    }
    __device__ __forceinline__ const char* a_tile(const Unit& u) const { return A + (size_t)u.pm * BM * K * 2; }
    __device__ __forceinline__ const char* b_tile(const Unit& u) const { return Bt + (size_t)u.pn * BM * K * 2; }
    __device__ __forceinline__ unsigned a_row_off(const Unit&, int r) const { return (unsigned)(r * K * 2); }
};
struct MoeOrder {
    const char* A; const char* Bt; size_t bexp; int K, nN, nwg, G, c; const PG8_LAS int* tab; const int* lists;
    __device__ bool next(int i, Unit& u) const {
        const long L = (long)i * G + c; if (L >= nwg) return false;
        const int wgid = xcd_remap((int)L, nwg);
        const int t = wgid / nN; u.pn = wgid % nN; u.pm = t;
        int e = 0; while (e < 31 && tab[e + 1] <= t) ++e;
        u.e = e; u.j = t - tab[e]; return true;
    }
    __device__ __forceinline__ const char* b_tile(const Unit& u) const { return Bt + (size_t)u.e * bexp + (size_t)u.pn * BM * K * 2; }
};
struct MoeGatherOrder : MoeOrder {
    static constexpr bool GATHER = true;
    __device__ __forceinline__ const char* a_tile(const Unit&) const { return A; }
    __device__ __forceinline__ unsigned a_row_off(const Unit& u, int r) const {
        const int idx = u.j * BM + r, cnt = tab[40 + u.e];
        const int ii = idx < cnt ? idx : cnt - 1;
        const int tok = lists[(size_t)u.e * 65536 + ii] >> 1;
        return (unsigned)tok * (unsigned)(K * 2);
    }
};
struct MoeRowsOrder : MoeOrder {
    static constexpr bool GATHER = true;
    __device__ __forceinline__ const char* a_tile(const Unit&) const { return A; }
    __device__ __forceinline__ unsigned a_row_off(const Unit& u, int r) const { return (unsigned)(u.pm * BM + r) * (unsigned)(K * 2); }
};
struct MoeDenseOrder : MoeOrder {
    static constexpr bool GATHER = false;
    __device__ __forceinline__ const char* a_tile(const Unit& u) const { return A + (size_t)u.pm * BM * K * 2; }
    __device__ __forceinline__ unsigned a_row_off(const Unit&, int r) const { return (unsigned)(r * K * 2); }
};

__device__ __forceinline__ unsigned cvt_pk_bf16(float lo, float hi) { unsigned r; asm volatile("v_cvt_pk_bf16_f32 %0, %1, %2" : "=v"(r) : "v"(lo), "v"(hi)); return r; }

struct EpiZ {
    static constexpr bool PERM = true;
    bf16* Z;
    __device__ __forceinline__ void operator()(const f32x4 (&acc)[2][2][4][2], const Unit& u, int wr, int wc, int fr, int fq) const {
        const int row0 = u.pm * BM + wr * 64 + fr, cl = wc * 32 + 8 * fq;
        if (u.pn < 6) {
            const bool sg = u.pn >= 3;
            const int zc = (sg ? 768 + (u.pn - 3) * 128 : 384 + u.pn * 128) + cl;
#pragma unroll
            for (int ai = 0; ai < 2; ++ai)
#pragma unroll
                for (int m = 0; m < 4; ++m) {
                    f32x4 a0 = acc[ai][0][m][0], a1 = acc[ai][0][m][1], g0 = acc[ai][1][m][0], g1 = acc[ai][1][m][1];
                    if (sg) {
#pragma unroll
                        for (int q = 0; q < 4; ++q) { g0[q] = sigmoidf_(g0[q]); g1[q] = sigmoidf_(g1[q]); }
                    }
                    a0 = a0 * g0; a1 = a1 * g1;
                    v4u w; w.x = cvt_pk_bf16(a0[0], a0[1]); w.y = cvt_pk_bf16(a0[2], a0[3]); w.z = cvt_pk_bf16(a1[0], a1[1]); w.w = cvt_pk_bf16(a1[2], a1[3]);
                    *(v4u*)(Z + (size_t)(row0 + ai * HALF + m * 16) * NZ + zc) = w;
                }
        } else {
            int zb0, zb1;
            if (u.pn == 6) { zb0 = 0; zb1 = 128; } else if (u.pn == 7) { zb0 = 256; zb1 = 1152; } else { zb0 = 1280; zb1 = -1; }
#pragma unroll
            for (int ai = 0; ai < 2; ++ai)
#pragma unroll
                for (int m = 0; m < 4; ++m) {
                    bf16* rowp = Z + (size_t)(row0 + ai * HALF + m * 16) * NZ + cl;
#pragma unroll
                    for (int bj = 0; bj < 2; ++bj) {
                        const int zb = bj ? zb1 : zb0;
                        if (zb >= 0) { const f32x4 a0 = acc[ai][bj][m][0], a1 = acc[ai][bj][m][1];
                            v4u w; w.x = cvt_pk_bf16(a0[0], a0[1]); w.y = cvt_pk_bf16(a0[2], a0[3]); w.z = cvt_pk_bf16(a1[0], a1[1]); w.w = cvt_pk_bf16(a1[2], a1[3]);
                            *(v4u*)(rowp + zb) = w; }
                    }
                }
        }
    }
};
struct EpiU {
    static constexpr bool PERM = true;
    const bf16* H; bf16* U;
    __device__ __forceinline__ void operator()(const f32x4 (&acc)[2][2][4][2], const Unit& u, int wr, int wc, int fr, int fq) const {
        const int row0 = u.pm * BM + wr * 64 + fr, col0 = u.pn * BM + wc * 32 + 8 * fq;
#pragma unroll
        for (int ai = 0; ai < 2; ++ai)
#pragma unroll
            for (int m = 0; m < 4; ++m) {
                const size_t off = (size_t)(row0 + ai * HALF + m * 16) * D_ + col0;
#pragma unroll
                for (int bj = 0; bj < 2; ++bj) {
                    const v4u h = *(const v4u*)(H + off + bj * HALF);
                    const f32x4 a0 = acc[ai][bj][m][0], a1 = acc[ai][bj][m][1];
                    v4u w;
                    w.x = cvt_pk_bf16(ALPHA * bflo(h.x) + a0[0], ALPHA * bfhi(h.x) + a0[1]); w.y = cvt_pk_bf16(ALPHA * bflo(h.y) + a0[2], ALPHA * bfhi(h.y) + a0[3]);
                    w.z = cvt_pk_bf16(ALPHA * bflo(h.z) + a1[0], ALPHA * bfhi(h.z) + a1[1]); w.w = cvt_pk_bf16(ALPHA * bflo(h.w) + a1[2], ALPHA * bfhi(h.w) + a1[3]);
                    *(v4u*)(U + off + bj * HALF) = w;
                }
            }
    }
};
struct EpiHid {
    static constexpr bool PERM = true;
    unsigned char* HID;
    __device__ __forceinline__ void operator()(const f32x4 (&acc)[2][2][4][2], const Unit& u, int wr, int wc, int fr, int fq) const {
        const int row0 = u.pm * BM + wr * 64 + fr, col0 = u.pn * 128 + wc * 32 + 8 * fq;
#pragma unroll
        for (int ai = 0; ai < 2; ++ai)
#pragma unroll
            for (int m = 0; m < 4; ++m) {
                f32x4 g0 = acc[ai][0][m][0], g1 = acc[ai][0][m][1]; const f32x4 u0 = acc[ai][1][m][0], u1 = acc[ai][1][m][1];
#pragma unroll
                for (int q = 0; q < 4; ++q) { g0[q] = g0[q] * sigmoidf_(g0[q]); g1[q] = g1[q] * sigmoidf_(g1[q]); }
                g0 = g0 * u0; g1 = g1 * u1;
                v2u w; w.x = pk4_fp8(g0[0], g0[1], g0[2], g0[3]); w.y = pk4_fp8(g1[0], g1[1], g1[2], g1[3]);
                *(v2u*)(HID + (size_t)(row0 + ai * HALF + m * 16) * DE + col0) = w;
            }
    }
};
struct EpiPlain {
    static constexpr bool PERM = true;
    bf16* O; int ldc;
    __device__ __forceinline__ void operator()(const f32x4 (&acc)[2][2][4][2], const Unit& u, int wr, int wc, int fr, int fq) const {
        const int row0 = u.pm * BM + wr * 64 + fr, col0 = u.pn * BM + wc * 32 + 8 * fq;
#pragma unroll
        for (int ai = 0; ai < 2; ++ai)
#pragma unroll
            for (int m = 0; m < 4; ++m) {
                bf16* rowp = O + (size_t)(row0 + ai * HALF + m * 16) * ldc + col0;
#pragma unroll
                for (int bj = 0; bj < 2; ++bj) { const f32x4 a0 = acc[ai][bj][m][0], a1 = acc[ai][bj][m][1];
                    v4u w; w.x = cvt_pk_bf16(a0[0], a0[1]); w.y = cvt_pk_bf16(a0[2], a0[3]); w.z = cvt_pk_bf16(a1[0], a1[1]); w.w = cvt_pk_bf16(a1[2], a1[3]);
                    *(v4u*)(rowp + bj * HALF) = w; }
            }
    }
};

template <class Epi, class Sched>
__device__ __forceinline__ void gemm_phase_simple(const Sched& S, const Epi& E) {
    int tid = threadIdx.x; asm volatile("" : "+v"(tid));
    const int wid = __builtin_amdgcn_readfirstlane(tid >> 6), lane = tid & 63, wr = wid >> 2, wc = wid & 3, fr = lane & 15, fq = lane >> 4;
    const int K = S.K;
    Unit cur;
    for (int ui = 0; S.next(ui, cur); ++ui) {
        f32x4 acc[2][2][4][2];
#pragma unroll
        for (int a = 0; a < 2; ++a)
#pragma unroll
            for (int b = 0; b < 2; ++b)
#pragma unroll
                for (int m = 0; m < 4; ++m)
#pragma unroll
                    for (int n = 0; n < 2; ++n) acc[a][b][m][n] = (f32x4){0.f, 0.f, 0.f, 0.f};
        const char* at = S.a_tile(cur); const char* bt = S.b_tile(cur);
        const char* ap[2][4]; const char* bp[2][2];
#pragma unroll
        for (int ai = 0; ai < 2; ++ai)
#pragma unroll
            for (int m = 0; m < 4; ++m) ap[ai][m] = at + S.a_row_off(cur, ai * HALF + wr * 64 + m * 16 + fr) + fq * 16;
#pragma unroll
        for (int bj = 0; bj < 2; ++bj)
#pragma unroll
            for (int n = 0; n < 2; ++n) { const int rho = n * 16 + fr; bp[bj][n] = bt + (size_t)(bj * HALF + wc * 32 + (Epi::PERM ? perm32(rho) : rho)) * K * 2 + fq * 16; }
        for (int k0 = 0; k0 < K; k0 += 32) {
            bf16x8 a[2][4], b[2][2];
#pragma unroll
            for (int ai = 0; ai < 2; ++ai)
#pragma unroll
                for (int m = 0; m < 4; ++m) a[ai][m] = *(const bf16x8*)(ap[ai][m] + k0 * 2);
#pragma unroll
            for (int bj = 0; bj < 2; ++bj)
#pragma unroll
                for (int n = 0; n < 2; ++n) b[bj][n] = *(const bf16x8*)(bp[bj][n] + k0 * 2);
#pragma unroll
            for (int ai = 0; ai < 2; ++ai)
#pragma unroll
                for (int bj = 0; bj < 2; ++bj)
#pragma unroll
                    for (int m = 0; m < 4; ++m)
#pragma unroll
                        for (int n = 0; n < 2; ++n) acc[ai][bj][m][n] = __builtin_amdgcn_mfma_f32_16x16x32_bf16(b[bj][n], a[ai][m], acc[ai][bj][m][n], 0, 0, 0);
        }
        E(acc, cur, wr, wc, fr, fq);
    }
}

__device__ __forceinline__ void glds16(const char* base, unsigned voff, unsigned lds_dst) {
    asm volatile("s_mov_b32 m0, %2\n\ts_nop 0\n\tglobal_load_lds_dwordx4 %0, %1" :: "v"(voff), "s"(base), "s"(lds_dst) : "memory", "m0");
}
template <class Epi, class Sched, bool FP8 = false>
__device__ __forceinline__ void gemm_phase(PG8_LAS unsigned char* lds, const Sched& S, const Epi& E) {
    constexpr bool GATHER = Sched::GATHER;
    int tid = threadIdx.x; asm volatile("" : "+v"(tid));
    const int wid = __builtin_amdgcn_readfirstlane(tid >> 6), lane = tid & 63, wr = wid >> 2, wc = wid & 3, fr = lane & 15, fq = lane >> 4;
    const int K = S.K, nt = K / BK;
    unsigned voffB[2], offA[4], nxA[4];
#pragma unroll
    for (int i = 0; i < 2; ++i) { int R, C; stage_rc(tid * 16 + i * 8192, R, C); const int Rb = Epi::PERM ? ((R & ~31) + perm32(R & 31)) : R;
        voffB[i] = (unsigned)(Rb * K + C) * 2u; offA[i] = (unsigned)(R * K + C) * 2u; offA[2 + i] = (unsigned)((R + HALF) * K + C) * 2u; nxA[i] = 0u; nxA[2 + i] = 0u; }
    const size_t kstep = (size_t)(BK * 2);
    const size_t hstep = (size_t)HALF * K * 2;
    const unsigned ldsw = (unsigned)wid * 1024u;
    const unsigned ldsb = (unsigned)(size_t)lds;
    const int aoff = lds_byte(wr * 64 + fr, fq * 8), boff = lds_byte(wc * 32 + fr, fq * 8);
#define PG8_SA(b, h) (((b) * 2 + (h)) * HTB)
#define PG8_SB(b, h) ((4 + (b) * 2 + (h)) * HTB)
#define PG8_STAGE_B(bufoff, gbase) do { _Pragma("unroll") for (int _i = 0; _i < 2; ++_i) \
        glds16((const char*)(gbase), voffB[_i], ldsb + (unsigned)(bufoff) + ldsw + _i * 8192u); } while (0)
#define PG8_STAGE_A(bufoff, gbase, h) do { _Pragma("unroll") for (int _i = 0; _i < 2; ++_i) \
        glds16((const char*)(gbase), offA[(h) * 2 + _i], ldsb + (unsigned)(bufoff) + ldsw + _i * 8192u); } while (0)
#define PG8_LDA(dst, b, h) do { _Pragma("unroll") for (int m = 0; m < 4; ++m) _Pragma("unroll") for (int k = 0; k < 2; ++k) dst[m][k] = *(const PG8_LAS bf16x8*)(lds + PG8_SA(b, h) + aoff + m * 2048 + k * 1024); } while (0)
#define PG8_LDB(dst, b, h) do { _Pragma("unroll") for (int n = 0; n < 2; ++n) _Pragma("unroll") for (int k = 0; k < 2; ++k) dst[n][k] = *(const PG8_LAS bf16x8*)(lds + PG8_SB(b, h) + boff + n * 2048 + k * 1024); } while (0)
#define PG8_MMA(ai, bj, At, Bt) do { __builtin_amdgcn_s_setprio(1); if constexpr (FP8) { _Pragma("unroll") for (int m = 0; m < 4; ++m) _Pragma("unroll") for (int n = 0; n < 2; ++n) { \
            const v8i _b = __builtin_shufflevector(__builtin_bit_cast(v4i, Bt[n][0]), __builtin_bit_cast(v4i, Bt[n][1]), 0, 1, 2, 3, 4, 5, 6, 7); \
            const v8i _a = __builtin_shufflevector(__builtin_bit_cast(v4i, At[m][0]), __builtin_bit_cast(v4i, At[m][1]), 0, 1, 2, 3, 4, 5, 6, 7); \
            acc[ai][bj][m][n] = __builtin_amdgcn_mfma_scale_f32_16x16x128_f8f6f4(_b, _a, acc[ai][bj][m][n], 0, 0, 0, 0x7A7A7A7A, 0, 0x7F7F7F7F); } } \
        else { _Pragma("unroll") for (int m = 0; m < 4; ++m) _Pragma("unroll") for (int n = 0; n < 2; ++n) _Pragma("unroll") for (int k = 0; k < 2; ++k) \
        acc[ai][bj][m][n] = __builtin_amdgcn_mfma_f32_16x16x32_bf16(Bt[n][k], At[m][k], acc[ai][bj][m][n], 0, 0, 0); } __builtin_amdgcn_s_setprio(0); } while (0)
#define PG8_WAIT_V(n) asm volatile("s_waitcnt vmcnt(" #n ")" ::: "memory")
#define PG8_WAIT_L(n) asm volatile("s_waitcnt lgkmcnt(" #n ")" ::: "memory")
#define PG8_BAR __builtin_amdgcn_s_barrier()
#define PG8_SCHED __builtin_amdgcn_sched_barrier(0)
#define PG8_OFFS(dst, u) do { if constexpr (GATHER) { _Pragma("unroll") for (int _h = 0; _h < 2; ++_h) _Pragma("unroll") for (int _i = 0; _i < 2; ++_i) { \
        int _R, _C; stage_rc(tid * 16 + _i * 8192, _R, _C); dst[_h * 2 + _i] = S.a_row_off(u, _h * HALF + _R) + (unsigned)(_C * 2); } } } while (0)
    Unit cur, nxt; int ui = 0;
    if (!S.next(0, cur)) return;
    f32x4 acc[2][2][4][2];
#pragma unroll
    for (int a = 0; a < 2; ++a)
#pragma unroll
        for (int b = 0; b < 2; ++b)
#pragma unroll
            for (int m = 0; m < 4; ++m)
#pragma unroll
                for (int n = 0; n < 2; ++n) acc[a][b][m][n] = (f32x4){0.f, 0.f, 0.f, 0.f};
    bf16x8 At[4][2], B0[2][2], B1[2][2];
    const char* cA = S.a_tile(cur); const char* cB = S.b_tile(cur);
    PG8_OFFS(offA, cur);
    PG8_STAGE_B(PG8_SB(0, 0), cB); PG8_STAGE_B(PG8_SB(0, 1), cB + hstep); PG8_STAGE_A(PG8_SA(0, 0), cA, 0); PG8_STAGE_A(PG8_SA(0, 1), cA, 1);
    if (wr == 1) PG8_BAR;
    PG8_WAIT_V(2); PG8_BAR;
    PG8_STAGE_B(PG8_SB(1, 0), cB + kstep); PG8_STAGE_A(PG8_SA(1, 0), cA + kstep, 0); PG8_STAGE_B(PG8_SB(1, 1), cB + hstep + kstep);
    PG8_WAIT_V(6); PG8_BAR;
    for (;;) {
        const bool has_next = S.next(ui + 1, nxt);
        const char* nA = has_next ? S.a_tile(nxt) : cA; const char* nB = has_next ? S.b_tile(nxt) : cB;
        if constexpr (GATHER) { if (has_next) { PG8_OFFS(nxA, nxt); } }
#pragma unroll 1
        for (int t = 0; t < nt; t += 2) {
            const bool last = (t == nt - 2);
            const char* a1 = cA + (size_t)(t + 1) * kstep;
            const char* a2 = last ? nA : cA + (size_t)(t + 2) * kstep; const char* b2 = last ? nB : cB + (size_t)(t + 2) * kstep;
            const char* a3 = a2 + kstep; const char* b3 = b2 + kstep;
            PG8_LDB(B0, 0, 0); PG8_LDB(B1, 0, 1); PG8_SCHED; PG8_LDA(At, 0, 0); PG8_STAGE_A(PG8_SA(1, 1), a1, 1);
            if constexpr (GATHER) { if (last && has_next) {
#pragma unroll
                for (int q = 0; q < 4; ++q) offA[q] = nxA[q]; } }
            PG8_WAIT_V(8); PG8_WAIT_L(0); PG8_BAR; PG8_MMA(0, 0, At, B0); PG8_MMA(0, 1, At, B1); PG8_BAR; PG8_SCHED;
            PG8_LDA(At, 0, 1); PG8_STAGE_B(PG8_SB(0, 0), b2); PG8_STAGE_B(PG8_SB(0, 1), b2 + hstep); PG8_STAGE_A(PG8_SA(0, 0), a2, 0);
            PG8_WAIT_V(8); PG8_WAIT_L(0); PG8_BAR; PG8_MMA(1, 0, At, B0); PG8_MMA(1, 1, At, B1); PG8_BAR; PG8_SCHED;
            PG8_LDB(B0, 1, 0); PG8_LDB(B1, 1, 1); PG8_SCHED; PG8_LDA(At, 1, 0); PG8_STAGE_A(PG8_SA(0, 1), a2, 1);
            PG8_WAIT_V(8); PG8_WAIT_L(0); PG8_BAR; PG8_MMA(0, 0, At, B0); PG8_MMA(0, 1, At, B1); PG8_BAR; PG8_SCHED;
            PG8_LDA(At, 1, 1); PG8_STAGE_B(PG8_SB(1, 0), b3); PG8_STAGE_B(PG8_SB(1, 1), b3 + hstep); PG8_STAGE_A(PG8_SA(1, 0), a3, 0);
            PG8_WAIT_V(8); PG8_WAIT_L(0); PG8_BAR; PG8_MMA(1, 0, At, B0); PG8_MMA(1, 1, At, B1); PG8_BAR; PG8_SCHED;
        }
        if (wr == 0) PG8_BAR;
        E(acc, cur, wr, wc, fr, fq);
        if (!has_next) break;
#pragma unroll
        for (int a = 0; a < 2; ++a)
#pragma unroll
            for (int b = 0; b < 2; ++b)
#pragma unroll
                for (int m = 0; m < 4; ++m)
#pragma unroll
                    for (int n = 0; n < 2; ++n) acc[a][b][m][n] = (f32x4){0.f, 0.f, 0.f, 0.f};
        cur = nxt; cA = nA; cB = nB; ++ui;
        if (wr == 1) PG8_BAR;
    }
    PG8_WAIT_V(0);
    PG8_BAR;
#undef PG8_SA
#undef PG8_SB
#undef PG8_STAGE_A
#undef PG8_STAGE_B
#undef PG8_LDA
#undef PG8_LDB
#undef PG8_MMA
#undef PG8_WAIT_V
#undef PG8_WAIT_L
#undef PG8_BAR
#undef PG8_SCHED
#undef PG8_OFFS
}
}

#define XB_TMO      128
#define XB_XCNT(j)  (256  + 64 * (j))
#define XB_XSUB(j)  (1280 + 64 * (j))
#define XB_XGEN(j)  (2304 + 64 * (j))
#define XB_TOP      3328
#define XB_TOPGEN   3392
#define XCD_BAR_WORDS 3456
#define XB_SPIN_CAP (1u << 18)
__device__ __forceinline__ unsigned xb_ld(unsigned* p)              { return __hip_atomic_load(p, __ATOMIC_RELAXED, __HIP_MEMORY_SCOPE_AGENT); }
__device__ __forceinline__ unsigned xb_add(unsigned* p, unsigned v) { return __hip_atomic_fetch_add(p, v, __ATOMIC_RELAXED, __HIP_MEMORY_SCOPE_AGENT); }
__device__ __forceinline__ unsigned xb_xcc_id() { return (unsigned)__builtin_amdgcn_s_getreg((3 << 11) | 20) & 0xFu; }
#define XB_SPIN(cond, bar) do { unsigned _sp = 0; while (cond) { __builtin_amdgcn_s_sleep(1); \
    if ((++_sp & 255u) == 0u) { if (xb_ld(&(bar)[XB_TMO])) break; if (_sp > XB_SPIN_CAP) { atomicAdd(&(bar)[XB_TMO], 1u); break; } } } } while (0)
struct XcdBarrier { unsigned* bar; unsigned x; volatile LAS unsigned* st; };
__device__ __forceinline__ XcdBarrier xcd_barrier_post(unsigned* bar, volatile LAS unsigned* st) {
    XcdBarrier b; b.bar = bar; b.x = xb_xcc_id(); b.st = st;
    if (threadIdx.x == 0) (void)xb_add(&bar[XB_XCNT(b.x)], 1u);
    return b;
}
__device__ __forceinline__ void xcd_barrier_complete(unsigned* bar, unsigned x, unsigned& nloc, unsigned& nx) {
    const unsigned G = gridDim.x * gridDim.y * gridDim.z;
    unsigned sum, cnt, mine, sp = 0u;
    for (;;) {
        sum = 0u; cnt = 0u; mine = 0u;
#pragma unroll
        for (unsigned j = 0; j < 16; ++j) { const unsigned c = xb_ld(&bar[XB_XCNT(j)]); sum += c; cnt += (c > 0u) ? 1u : 0u; mine = (j == x) ? c : mine; }
        if (sum == G) break;
        __builtin_amdgcn_s_sleep(1);
        if ((++sp & 255u) == 0u) { if (xb_ld(&bar[XB_TMO])) break; if (sp > XB_SPIN_CAP) { atomicAdd(&bar[XB_TMO], 1u); break; } }
    }
    nloc = mine > 0u ? mine : 1u; nx = cnt > 0u ? cnt : 1u;
}
__device__ __forceinline__ void xcd_barrier(const XcdBarrier& b) {
    asm volatile("s_waitcnt vmcnt(0)" ::: "memory");
    __syncthreads();
    if (threadIdx.x == 0) {
        unsigned* bar = b.bar;
        __builtin_amdgcn_s_waitcnt(0);
        unsigned nloc = b.st[0], nx = b.st[1];
        if (nloc == 0u) { xcd_barrier_complete(bar, b.x, nloc, nx); b.st[0] = nloc; b.st[1] = nx; }
        const unsigned old = xb_add(&bar[XB_XSUB(b.x)], 1u);
        const unsigned gen = old / nloc;
        if (old + 1u == (gen + 1u) * nloc) {
            __builtin_amdgcn_fence(__ATOMIC_RELEASE, "agent");
            asm volatile("s_waitcnt vmcnt(0)" ::: "memory");
            const unsigned og = xb_add(&bar[XB_TOP], 1u);
            const unsigned tg = og / nx;
            if (og + 1u == (tg + 1u) * nx) xb_add(&bar[XB_TOPGEN], 1u);
            else XB_SPIN(xb_ld(&bar[XB_TOPGEN]) == tg, bar);
            __builtin_amdgcn_fence(__ATOMIC_ACQUIRE, "agent");
            xb_add(&bar[XB_XGEN(b.x)], 1u);
            asm volatile("s_waitcnt vmcnt(0)" ::: "memory");
        } else {
            XB_SPIN(xb_ld(&bar[XB_XGEN(b.x)]) == gen, bar);
            __builtin_amdgcn_fence(__ATOMIC_ACQUIRE, "agent");
            asm volatile("s_waitcnt vmcnt(0)" ::: "memory");
        }
    }
    __syncthreads();
}

constexpr int NWAVES = 8;
struct Args { const float* in[21]; float* out; unsigned char* ws; int ph_lo, ph_hi; };
struct Frame {
    LAS unsigned char* lds;
    unsigned* ctl;
    int tid, lane, wave, vcu, G;
    unsigned char* ws;
};
enum { I_X = 0, I_LNIG, I_LNIB, I_RW, I_RB, I_WIN, I_CAW, I_CBW, I_CBB, I_LCG, I_LCB, I_PW, I_PS, I_WOUT, I_LMG, I_LMB, I_WG, I_WU, I_WDN, I_LFG, I_LFB };

__device__ __forceinline__ void tr_item(const float* src, int srcN, int srccol0, bf16* dst, int dstK, int dstrow0, int k0, LAS float* scr, int lane) {
#pragma unroll 8
    for (int i = 0; i < 32; ++i) { const int kk = 2 * i + (lane >> 5); scr[kk * 33 + (lane & 31)] = src[(size_t)(k0 + kk) * srcN + srccol0 + (lane & 31)]; }
    LDS_WAIT(); asm volatile("" ::: "memory");
    const int c = lane & 7;
#pragma unroll
    for (int j = 0; j < 4; ++j) { const int n = (lane >> 3) + 8 * j; const LAS float* s = scr + (8 * c) * 33 + n;
        v4u o; o.x = pk2(s[0 * 33], s[1 * 33]); o.y = pk2(s[2 * 33], s[3 * 33]); o.z = pk2(s[4 * 33], s[5 * 33]); o.w = pk2(s[6 * 33], s[7 * 33]);
        *(GAS v4u*)(dst + (size_t)(dstrow0 + n) * dstK + k0 + 8 * c) = o; }
    LDS_WAIT(); asm volatile("" ::: "memory");
}
__device__ __forceinline__ void tr_item64(const float* src, int srcN, int srccol0, bf16* dst, int dstK, int dstrow0, int k0, LAS unsigned* scr, int lane) {
    const int kr = lane >> 4, c4 = lane & 15;
    const float* sp = src + (size_t)(k0 + 2 * kr) * srcN + srccol0 + 4 * c4;
    f32x4 A[8], B[8];
#pragma unroll
    for (int i = 0; i < 8; ++i) { A[i] = *(const GAS f32x4*)(sp + (size_t)(8 * i) * srcN); B[i] = *(const GAS f32x4*)(sp + (size_t)(8 * i + 1) * srcN); }
#pragma unroll
    for (int i = 0; i < 8; ++i) { LAS unsigned* w = scr + (4 * i + kr) * 65 + 4 * c4;
        w[0] = pk2(A[i].x, B[i].x); w[1] = pk2(A[i].y, B[i].y); w[2] = pk2(A[i].z, B[i].z); w[3] = pk2(A[i].w, B[i].w); }
    LDS_WAIT(); asm volatile("" ::: "memory");
    const int q = lane & 7, nn = lane >> 3;
#pragma unroll
    for (int j = 0; j < 8; ++j) { const int n = nn + 8 * j; const LAS unsigned* r = scr + (4 * q) * 65 + n;
        v4u o; o.x = r[0]; o.y = r[65]; o.z = r[130]; o.w = r[195];
        *(GAS v4u*)(dst + (size_t)(dstrow0 + n) * dstK + k0 + 8 * q) = o; }
    LDS_WAIT(); asm volatile("" ::: "memory");
}
__device__ __forceinline__ void tr_item64_f8(const float* src, int srcN, int srccol0, unsigned char* dst, int dstKB, int dstrow0, int k0, float scale, LAS unsigned* scr, int lane) {
    const int kr = lane >> 4, c4 = lane & 15;
    const float* sp = src + (size_t)(k0 + 4 * kr) * srcN + srccol0 + 4 * c4;
    f32x4 A[4][4];
#pragma unroll
    for (int i = 0; i < 4; ++i)
#pragma unroll
        for (int t = 0; t < 4; ++t) A[i][t] = *(const GAS f32x4*)(sp + (size_t)(16 * i + t) * srcN);
#pragma unroll
    for (int i = 0; i < 4; ++i) { LAS unsigned* w = scr + (4 * i + kr) * 65 + 4 * c4;
        w[0] = pk4_fp8(A[i][0].x * scale, A[i][1].x * scale, A[i][2].x * scale, A[i][3].x * scale); w[1] = pk4_fp8(A[i][0].y * scale, A[i][1].y * scale, A[i][2].y * scale, A[i][3].y * scale);
        w[2] = pk4_fp8(A[i][0].z * scale, A[i][1].z * scale, A[i][2].z * scale, A[i][3].z * scale); w[3] = pk4_fp8(A[i][0].w * scale, A[i][1].w * scale, A[i][2].w * scale, A[i][3].w * scale); }
    LDS_WAIT(); asm volatile("" ::: "memory");
    const int q = lane & 3, nn = lane >> 2;
#pragma unroll
    for (int j = 0; j < 4; ++j) { const int n = nn + 16 * j; const LAS unsigned* r = scr + (4 * q) * 65 + n;
        v4u o; o.x = r[0]; o.y = r[65]; o.z = r[130]; o.w = r[195];
        *(GAS v4u*)(dst + (size_t)(dstrow0 + n) * dstKB + k0 + 16 * q) = o; }
    LDS_WAIT(); asm volatile("" ::: "memory");
}
__device__ __forceinline__ int win_src(int c0) {
    const int pn = c0 >> 8, j = c0 & 255, half = j >> 7, jj = j & 127;
    if (pn < 3) { const int ch = pn * 128 + jj; return half == 0 ? 384 + ch : 768 + ch; }
    if (pn < 6) { const int ch = (pn - 3) * 128 + jj; return half == 0 ? 1152 + ch : 1536 + ch; }
    if (pn < 8) { const int q = (pn - 6) * 256 + j; return q < 384 ? q : 1920 + (q - 384); }
    return j < 128 ? 1920 + 128 + j : -1;
}
__device__ __forceinline__ void p0_prologue(Frame& F, const Args& A) {
    LAS float* scr = (LAS float*)(F.lds + F.wave * 8448);
    LAS unsigned* scu = (LAS unsigned*)scr;
    const int gw = F.vcu * NWAVES + F.wave, NGW = F.G * NWAVES, lane = F.lane;
    bf16* WIN = (bf16*)(F.ws + WS_WIN); bf16* WOUT = (bf16*)(F.ws + WS_WOUT); unsigned char* WGU = F.ws + WS_WGU; unsigned char* WD = F.ws + WS_WD; bf16* WRT = (bf16*)(F.ws + WS_WRT);
    constexpr int I_A = NL * 16 * 36, I_B = NL * 12 * 16, I_C = NL * NE * 256, I_D = NL * NE * 128, I_E = 16, I_F = NL * 4 * 16 * 2;
    constexpr int NITEMS = I_A + I_B + I_C + I_D + I_E + I_F;
    const int lane0 = lane;
    for (int it = gw; it < NITEMS; it += NGW) {
        int lane = lane0; asm volatile("" : "+v"(lane));
        int r = it;
        if (r < I_C) {
            const int le = r >> 8, q = r & 255, kb = q >> 4, nb = q & 15, n0 = nb * 64, pn = n0 >> 8, half = (n0 & 255) >> 7, jj0 = n0 & 127;
            const float* src = (half ? A.in[I_WU] : A.in[I_WG]) + (size_t)le * 1024 * 512;
            tr_item64_f8(src, 512, pn * 128 + jj0, WGU + (size_t)le * 1024 * 1024, 1024, n0, kb * 64, 32.0f, scu, lane); continue; }
        r -= I_C;
        if (r < I_D) {
            const int le = r >> 7, q = r & 127, kb = q >> 4, nb = q & 15;
            tr_item64_f8(A.in[I_WDN] + (size_t)le * 512 * 1024, 1024, nb * 64, WD + (size_t)le * 1024 * 512, 512, nb * 64, kb * 64, 32.0f, scu, lane); continue; }
        r -= I_D;
        if (r < I_A) {
            const int l = r / 576, q = r % 576, kb = q / 36, nb = q % 36, c0 = nb * 64, sc = win_src(c0);
            bf16* dst = WIN + (size_t)l * N1 * 1024;
            if (sc >= 0) tr_item64(A.in[I_WIN] + (size_t)l * 1024 * DIN, DIN, sc, dst, 1024, c0, kb * 64, scu, lane);
            else { const int c = lane & 7;
#pragma unroll
                for (int j = 0; j < 8; ++j) { const int n = (lane >> 3) + 8 * j; *(GAS v4u*)(dst + (size_t)(c0 + n) * 1024 + kb * 64 + 8 * c) = (v4u){0u, 0u, 0u, 0u}; } }
            continue; }
        r -= I_A;
        if (r < I_B) {
            const int l = r / 192, q = r % 192, kb = q >> 4, nb = q & 15;
            tr_item64(A.in[I_WOUT] + (size_t)l * 1024 * 1024, 1024, nb * 64, WOUT + (size_t)l * 1024 * 1024, 1024, nb * 64, kb * 64, scu, lane); continue; }
        r -= I_B;
        if (r < I_E) { tr_item(A.in[I_RW], 32, 0, WRT, 1024, 0, r * 64, scr, lane); continue; }
        r -= I_E;
        {
            const int l = r >> 7, g = (r >> 5) & 3, nb = (r >> 1) & 15, cb = r & 1, n = nb * 64 + lane;
            const float* wo = A.in[I_WOUT] + (size_t)l * 1024 * 1024 + (size_t)(768 + g * 64) * 1024 + n;
            const float* ps = A.in[I_PS] + l * 256 + g * 64;
            const float* pw = A.in[I_PW] + (size_t)(l * 4 + g) * 64 * 64 + cb * 32 * 64;
#pragma unroll
            for (int i = 0; i < 8; ++i) *(LAS f32x4*)(scr + (i * 64 + lane) * 4) = *(const GAS f32x4*)(pw + (i * 64 + lane) * 4);
            float wv[64];
#pragma unroll
            for (int d = 0; d < 64; ++d) wv[d] = wo[(size_t)d * 1024] * ps[d];
            LDS_WAIT(); asm volatile("" ::: "memory");
            bf16* dst = WOUT + (size_t)l * 1024 * 1024 + (size_t)n * 1024 + 768 + g * 64 + cb * 32;
#pragma unroll 1
            for (int c2 = 0; c2 < 16; ++c2) { float o[2];
#pragma unroll
                for (int cc = 0; cc < 2; ++cc) { const LAS f32x4* pr = (const LAS f32x4*)(scr + (c2 * 2 + cc) * 64); float a = 0.f;
#pragma unroll
                    for (int d4 = 0; d4 < 16; ++d4) { const f32x4 p = pr[d4]; a += p.x * wv[4 * d4] + p.y * wv[4 * d4 + 1] + p.z * wv[4 * d4 + 2] + p.w * wv[4 * d4 + 3]; }
                    o[cc] = a; }
                *(GAS unsigned*)(dst + c2 * 2) = pk2(o[0], o[1]); }
            LDS_WAIT(); asm volatile("" ::: "memory");
        }
    }
    bf16* HB = (bf16*)(F.ws + WS_HB);
    const float* g = A.in[I_LNIG]; const float* b = A.in[I_LNIB];
    f32x4 gv[4], bv[4];
#pragma unroll
    for (int j = 0; j < 4; ++j) { gv[j] = *(const f32x4*)(g + 4 * lane + 256 * j); bv[j] = *(const f32x4*)(b + 4 * lane + 256 * j); }
    for (int m0 = gw * 2; m0 < T_; m0 += NGW * 2) {
        f32x4 v[2][4];
#pragma unroll
        for (int u = 0; u < 2; ++u) { const GAS f32x4* xr = (const GAS f32x4*)(A.in[I_X] + (size_t)(m0 + u) * D_) + lane;
#pragma unroll
            for (int j = 0; j < 4; ++j) v[u][j] = xr[64 * j]; }
#pragma unroll
        for (int u = 0; u < 2; ++u) { float s = 0.f;
#pragma unroll
            for (int j = 0; j < 4; ++j) s += (v[u][j].x + v[u][j].y) + (v[u][j].z + v[u][j].w);
            const float mean = wave_sum(s) * (1.f / D_); float s2 = 0.f;
#pragma unroll
            for (int j = 0; j < 4; ++j) { v[u][j] = v[u][j] - mean; s2 += (v[u][j].x * v[u][j].x + v[u][j].y * v[u][j].y) + (v[u][j].z * v[u][j].z + v[u][j].w * v[u][j].w); }
            const float rstd = 1.f / sqrtf(wave_sum(s2) * (1.f / D_) + LN_EPS);
            GAS v2u* o8 = (GAS v2u*)(HB + (size_t)(m0 + u) * D_) + lane;
#pragma unroll
            for (int j = 0; j < 4; ++j) { const f32x4 o = v[u][j] * rstd * gv[j] + bv[j]; v2u w; w.x = pk2(o.x, o.y); w.y = pk2(o.z, o.w); o8[64 * j] = w; } }
    }
}

__device__ __forceinline__ void p2_mixer(Frame& F, const Args& A, int l) {
    LAS unsigned* BV = (LAS unsigned*)F.lds;
    LAS unsigned* PB = (LAS unsigned*)(F.lds + 47616);
    LAS float* V = (LAS float*)(F.lds + 71680);
    const bf16* Z = (const bf16*)(F.ws + WS_Z); bf16* Y = (bf16*)(F.ws + WS_Y);
    const float* wB = A.in[I_CBW] + l * 31 * 384; const float* bB = A.in[I_CBB] + l * 384;
    const float* lg = A.in[I_LCG] + l * 384; const float* lb = A.in[I_LCB] + l * 384; const float* wA = A.in[I_CAW] + l * 3 * 384;
    int tid = F.tid; asm volatile("" : "+v"(tid));
    const int lane = tid & 63, wave = F.wave;
    const bool convt = tid < 384; const int cp = tid % 192, tg = tid / 192;
    f32x2 w[31]; f32x2 bias = (f32x2){0.f, 0.f};
#pragma unroll
    for (int j = 0; j < 31; ++j) w[j] = (f32x2){0.f, 0.f};
    if (convt) {
#pragma unroll
        for (int j = 0; j < 31; ++j) w[j] = *(const f32x2*)(wB + j * 384 + 2 * cp);
        bias = *(const f32x2*)(bB + 2 * cp); }
    v4u pre[9];
#define MIX_PREFETCH(ci_, tid_) do { const int _t0 = (ci_) * 32, _s0 = _t0 & (SEQ_ - 1); \
        _Pragma("unroll") for (int _i = 0; _i < 6; ++_i) { const int _q = (tid_) + 512 * _i; const int _qq = _q < 62 * 48 ? _q : 0; const int _r = _qq / 48, _c = _qq % 48; \
            const int _rr = (_s0 - 30 + _r >= 0) ? _r : 30; pre[_i] = *(const GAS v4u*)(Z + (size_t)(_t0 - 30 + _rr) * NZ + 768 + _c * 8); } \
        _Pragma("unroll") for (int _i = 0; _i < 3; ++_i) { const int _q = (tid_) + 512 * _i; const int _qq = _q < 47 * 32 ? _q : 0; const int _r = _qq >> 5, _c = _qq & 31; \
            const int _rr = (_s0 - 15 + _r >= 0) ? _r : 15; pre[6 + _i] = *(const GAS v4u*)(Z + (size_t)(_t0 - 15 + _rr) * NZ + 1152 + _c * 8); } } while (0)
    if (F.vcu < T_ / 32) MIX_PREFETCH(F.vcu, tid);
    for (int ci = F.vcu; ci < T_ / 32; ci += F.G) {
        const int t0 = ci * 32, s0 = t0 & (SEQ_ - 1);
#pragma unroll
        for (int i = 0; i < 6; ++i) { const int q = tid + 512 * i; if (q < 62 * 48) { const int r = q / 48, c = q % 48;
            *(LAS v4u*)(BV + r * 192 + c * 4) = (s0 - 30 + r >= 0) ? pre[i] : (v4u){0u, 0u, 0u, 0u}; } }
#pragma unroll
        for (int i = 0; i < 3; ++i) { const int q = tid + 512 * i; if (q < 47 * 32) { const int r = q >> 5, c = q & 31;
            *(LAS v4u*)(PB + r * 128 + c * 4) = (s0 - 15 + r >= 0) ? pre[6 + i] : (v4u){0u, 0u, 0u, 0u}; } }
        __syncthreads();
        if (convt) {
#pragma unroll 1
            for (int hh = 0; hh < 2; ++hh) { const int tb = tg * 16 + hh * 8;
                f32x2 x[38];
#pragma unroll
                for (int i = 0; i < 38; ++i) { const unsigned u = BV[(tb + i) * 192 + cp]; x[i] = (f32x2){bflo(u), bfhi(u)}; }
#pragma unroll
                for (int tt = 0; tt < 8; ++tt) { f32x2 a = bias;
#pragma unroll
                    for (int j = 0; j < 31; ++j) a += w[j] * x[tt + j];
                    *(LAS f32x2*)(V + (tb + tt) * 384 + 2 * cp) = a; }
            }
        } else {
            const int p = tid - 384, wd = 2 << (p >> 5);
            f32x2 s = (f32x2){0.f, 0.f};
            for (int i = 1; i < wd; ++i) { const unsigned u = PB[(15 - i) * 128 + p]; s += (f32x2){bflo(u), bfhi(u)}; }
            for (int tt = 0; tt < 32; ++tt) { const int row = 15 + tt; const unsigned u = PB[row * 128 + p]; const f32x2 xv = (f32x2){bflo(u), bfhi(u)};
                s += xv; const int n = (s0 + tt + 1) < wd ? (s0 + tt + 1) : wd; const float inv = 1.0f / (float)n;
                const f32x2 dd = s * inv - xv;
                *(GAS unsigned*)(Y + (size_t)(t0 + tt) * D_ + 768 + 2 * p) = pk2(dd.x, dd.y);
                const unsigned uo = PB[(row - wd + 1) * 128 + p]; s -= (f32x2){bflo(uo), bfhi(uo)}; }
        }
        __syncthreads();
        v4u ya[3][4];
        int t0o = t0; asm volatile("" : "+s"(t0o));
        int tidl = tid; asm volatile("" : "+v"(tidl));
#pragma unroll
        for (int i = 0; i < 3; ++i) { const int q = tidl + 512 * i, tt = q / 48, o8 = q % 48, pos = (t0o & (SEQ_ - 1)) + tt; const size_t row = (size_t)(t0o + tt);
            ya[i][0] = *(const GAS v4u*)(Z + row * NZ + o8 * 8);
            ya[i][1] = *(const GAS v4u*)(Z + row * NZ + 384 + o8 * 8);
            ya[i][2] = *(const GAS v4u*)(Z + (row - (pos >= 1 ? 1 : 0)) * NZ + 384 + o8 * 8);
            ya[i][3] = *(const GAS v4u*)(Z + (row - (pos >= 2 ? 2 : 0)) * NZ + 384 + o8 * 8); }
        { int cn = ci + F.G; asm volatile("" : "+s"(cn));
          if (cn < T_ / 32) MIX_PREFETCH(cn, tidl); }
#pragma unroll 1
        for (int tk = 0; tk < 4; ++tk) { const int tt = wave * 4 + tk;
            f32x2 v[3]; float s = 0.f;
#pragma unroll
            for (int i = 0; i < 3; ++i) { v[i] = *(const LAS f32x2*)(V + tt * 384 + 2 * lane + 128 * i); s += v[i].x + v[i].y; }
            const float mean = wave_sum(s) * (1.f / 384.f); float q = 0.f;
#pragma unroll
            for (int i = 0; i < 3; ++i) { v[i] = v[i] - mean; q += v[i].x * v[i].x + v[i].y * v[i].y; }
            const float rstd = 1.f / sqrtf(wave_sum(q) * (1.f / 384.f) + LN_EPS);
#pragma unroll
            for (int i = 0; i < 3; ++i) { const int c = 2 * lane + 128 * i; const f32x2 gg = *(const f32x2*)(lg + c), bb = *(const f32x2*)(lb + c);
                f32x2 o = v[i] * rstd * gg + bb; o.x = o.x * sigmoidf_(o.x); o.y = o.y * sigmoidf_(o.y);
                *(GAS unsigned*)(Y + (size_t)(t0 + tt) * D_ + 384 + c) = pk2(o.x, o.y); }
        }
#pragma unroll
        for (int i = 0; i < 3; ++i) { const int q = tid + 512 * i, tt = q / 48, o8 = q % 48, pos = s0 + tt; const size_t row = (size_t)(t0 + tt);
            const v4u gb = ya[i][0], x0 = ya[i][1]; v4u x1 = ya[i][2], x2 = ya[i][3];
            if (pos < 1) x1 = (v4u){0u, 0u, 0u, 0u};
            if (pos < 2) x2 = (v4u){0u, 0u, 0u, 0u};
            const f32x4 w2a = *(const f32x4*)(wA + 2 * 384 + o8 * 8), w2b = *(const f32x4*)(wA + 2 * 384 + o8 * 8 + 4);
            const f32x4 w1a = *(const f32x4*)(wA + 1 * 384 + o8 * 8), w1b = *(const f32x4*)(wA + 1 * 384 + o8 * 8 + 4);
            const f32x4 w0a = *(const f32x4*)(wA + o8 * 8), w0b = *(const f32x4*)(wA + o8 * 8 + 4);
            float o[8];
            const unsigned gbw[4] = {gb.x, gb.y, gb.z, gb.w}, x0w[4] = {x0.x, x0.y, x0.z, x0.w}, x1w[4] = {x1.x, x1.y, x1.z, x1.w}, x2w[4] = {x2.x, x2.y, x2.z, x2.w};
            const float w2[8] = {w2a.x, w2a.y, w2a.z, w2a.w, w2b.x, w2b.y, w2b.z, w2b.w}, w1[8] = {w1a.x, w1a.y, w1a.z, w1a.w, w1b.x, w1b.y, w1b.z, w1b.w}, w0[8] = {w0a.x, w0a.y, w0a.z, w0a.w, w0b.x, w0b.y, w0b.z, w0b.w};
#pragma unroll
            for (int e = 0; e < 4; ++e) {
                o[2 * e] = bflo(gbw[e]) * (w2[2 * e] * bflo(x0w[e]) + w1[2 * e] * bflo(x1w[e]) + w0[2 * e] * bflo(x2w[e]));
                o[2 * e + 1] = bfhi(gbw[e]) * (w2[2 * e + 1] * bfhi(x0w[e]) + w1[2 * e + 1] * bfhi(x1w[e]) + w0[2 * e + 1] * bfhi(x2w[e])); }
            v4u ov; ov.x = pk2(o[0], o[1]); ov.y = pk2(o[2], o[3]); ov.z = pk2(o[4], o[5]); ov.w = pk2(o[6], o[7]);
            *(GAS v4u*)(Y + row * D_ + o8 * 8) = ov; }
        __syncthreads();
    }
#undef MIX_PREFETCH
}

__device__ __forceinline__ void top2of4(float q0, float q1, float q2, float q3, float& a1, int& i1, float& a2, int& i2) {
    a1 = q0; i1 = 0; a2 = -1.f; i2 = 1;
#define T2STEP(qv, r) { const bool gt = (qv) > a1; const bool g2 = (qv) > a2; const float na2 = gt ? a1 : (g2 ? (qv) : a2); const int ni2 = gt ? i1 : (g2 ? (r) : i2); \
        a1 = gt ? (qv) : a1; i1 = gt ? (r) : i1; a2 = na2; i2 = ni2; }
    T2STEP(q1, 1) T2STEP(q2, 2) T2STEP(q3, 3)
#undef T2STEP
}
__device__ __forceinline__ void p4_ln_router(Frame& F, const Args& A, int l) {
    LAS unsigned char* lds = F.lds;
    LAS int* cntl = (LAS int*)(lds + 66048); LAS int* basel = cntl + 32; LAS int* sel = cntl + 64; LAS int* lpos = cntl + 64 + 256;
    const bf16* U = (const bf16*)(F.ws + WS_U); bf16* HB = (bf16*)(F.ws + WS_HB); unsigned char* H8 = F.ws + WS_H8; const bf16* WRT = (const bf16*)(F.ws + WS_WRT);
    int* route = (int*)(F.ws + WS_ROUTE); int* lists = (int*)(F.ws + WS_LISTS);
    unsigned* counts = F.ctl + CW_CNT + l * 32 * 64;
    const float* g = A.in[I_LMG] + l * D_; const float* b = A.in[I_LMB] + l * D_; const float* rb = A.in[I_RB];
    int tid = F.tid; asm volatile("" : "+v"(tid));
    const int lane = tid & 63, wave = F.wave, fr = lane & 15, fq = lane >> 4;
    for (int q = tid; q < 32 * 128; q += 512) { const int e = q >> 7, c = q & 127; *(LAS v4u*)(lds + e * 2064 + c * 16) = *(const GAS v4u*)(WRT + e * 1024 + c * 8); }
    if (tid < 32) cntl[tid] = 0;
    f32x4 gv[4], bv[4];
#pragma unroll
    for (int j = 0; j < 4; ++j) { gv[j] = *(const f32x4*)(g + 4 * lane + 256 * j); bv[j] = *(const f32x4*)(b + 4 * lane + 256 * j); }
    __syncthreads();
    for (int blk = F.vcu; blk < T_ / 128; blk += F.G) {
#pragma unroll 1
        for (int i = 0; i < 16; i += 4) { const size_t m = (size_t)(blk * 128 + wave * 16 + i);
            v2u q[4][4];
#pragma unroll
            for (int u = 0; u < 4; ++u) { const GAS v2u* up = (const GAS v2u*)(U + (m + u) * D_) + lane;
#pragma unroll
                for (int j = 0; j < 4; ++j) q[u][j] = up[64 * j]; }
#pragma unroll
            for (int u = 0; u < 4; ++u) { f32x4 v[4]; float s = 0.f;
#pragma unroll
                for (int j = 0; j < 4; ++j) { v[j] = (f32x4){bflo(q[u][j].x), bfhi(q[u][j].x), bflo(q[u][j].y), bfhi(q[u][j].y)}; s += (v[j].x + v[j].y) + (v[j].z + v[j].w); }
                const float mean = wave_sum(s) * (1.f / D_); float s2 = 0.f;
#pragma unroll
                for (int j = 0; j < 4; ++j) { v[j] = v[j] - mean; s2 += (v[j].x * v[j].x + v[j].y * v[j].y) + (v[j].z * v[j].z + v[j].w * v[j].w); }
                const float rstd = 1.f / sqrtf(wave_sum(s2) * (1.f / D_) + LN_EPS);
                GAS v2u* o8 = (GAS v2u*)(HB + (m + u) * D_) + lane; GAS unsigned* o4 = (GAS unsigned*)(H8 + (m + u) * D_) + lane;
#pragma unroll
                for (int j = 0; j < 4; ++j) { const f32x4 o = v[j] * rstd * gv[j] + bv[j]; v2u w; w.x = pk2(o.x, o.y); w.y = pk2(o.z, o.w); o8[64 * j] = w; o4[64 * j] = pk4_fp8(o.x, o.y, o.z, o.w); } }
        }
        VM_WAIT(); asm volatile("" ::: "memory");
        const int token = blk * 128 + wave * 16 + fr;
        f32x4 acc0 = (f32x4){0.f, 0.f, 0.f, 0.f}, acc1 = (f32x4){0.f, 0.f, 0.f, 0.f};
        const bf16* hrow = HB + (size_t)token * D_ + fq * 8;
#pragma unroll 16
        for (int k = 0; k < 32; ++k) { const int kk = k * 32 + fq * 8;
            const bf16x8 hf = *(const GAS bf16x8*)(hrow + k * 32);
            const bf16x8 w0 = *(const LAS bf16x8*)(lds + fr * 2064 + kk * 2), w1 = *(const LAS bf16x8*)(lds + (16 + fr) * 2064 + kk * 2);
            acc0 = __builtin_amdgcn_mfma_f32_16x16x32_bf16(w0, hf, acc0, 0, 0, 0);
            acc1 = __builtin_amdgcn_mfma_f32_16x16x32_bf16(w1, hf, acc1, 0, 0, 0);
        }
        float p0[4], p1[4]; float mx = -3.0e38f;
#pragma unroll
        for (int r = 0; r < 4; ++r) { p0[r] = acc0[r] + rb[4 * fq + r]; p1[r] = acc1[r] + rb[16 + 4 * fq + r]; mx = fmaxf(mx, fmaxf(p0[r], p1[r])); }
        mx = fmaxf(mx, __shfl_xor(mx, 16)); mx = fmaxf(mx, __shfl_xor(mx, 32));
#pragma unroll
        for (int r = 0; r < 4; ++r) { p0[r] = __expf(p0[r] - mx); p1[r] = __expf(p1[r] - mx); }
        float a1, a2, c1, c2; int ia1, ia2, ic1, ic2;
        top2of4(p0[0], p0[1], p0[2], p0[3], a1, ia1, a2, ia2); top2of4(p1[0], p1[1], p1[2], p1[3], c1, ic1, c2, ic2);
        const float sc0 = a1 + a2, sc1 = c1 + c2;
        float bs = sc0; int bg = fq; if (sc1 > sc0) { bs = sc1; bg = 4 + fq; }
#pragma unroll
        for (int off = 16; off <= 32; off <<= 1) { const float os = __shfl_xor(bs, off); const int og = __shfl_xor(bg, off); if (os > bs || (os == bs && og < bg)) { bs = os; bg = og; } }
        if ((bg & 3) == fq) {
            const bool hi = bg >= 4;
            const float pa = hi ? c1 : a1, pb = hi ? c2 : a2; const int ia = hi ? ic1 : ia1, ib = hi ? ic2 : ia2;
            const int ea = bg * 4 + ia, eb = bg * 4 + ib; const float inv = 1.0f / (pa + pb);
            const int tokl = wave * 16 + fr;
            const int la = atomicAdd((int*)&cntl[ea], 1), lb2 = atomicAdd((int*)&cntl[eb], 1);
            sel[tokl * 2] = ea; sel[tokl * 2 + 1] = eb; lpos[tokl * 2] = la; lpos[tokl * 2 + 1] = lb2;
            int* rt = route + (size_t)token * 8; rt[0] = ea; rt[2] = eb; rt[4] = __float_as_int(pa * inv); rt[5] = __float_as_int(pb * inv);
        }
        __syncthreads();
        if (tid < 32) { const int c = cntl[tid]; basel[tid] = c ? (int)__hip_atomic_fetch_add(counts + tid * 64, (unsigned)c, RLX_AGENT) : 0; }
        __syncthreads();
        if (tid < 256) { const int tokl = tid >> 1, k = tid & 1, e = sel[tid], pos = basel[e] + lpos[tid], tok = blk * 128 + tokl;
            lists[(size_t)e * 65536 + pos] = tok * 2 + k; route[(size_t)tok * 8 + 1 + 2 * k] = pos; }
        __syncthreads();
        if (tid < 32) cntl[tid] = 0;
        __syncthreads();
    }
}

__device__ __forceinline__ void moe_table(Frame& F, int l) {
    LAS int* tab = (LAS int*)(F.lds + TAB_OFF);
    __syncthreads();
    if (F.tid < 32) tab[40 + F.tid] = (int)__hip_atomic_load(F.ctl + CW_CNT + (l * 32 + F.tid) * 64, RLX_AGENT);
    __syncthreads();
    if (F.tid == 0) { int s = 0; for (int e = 0; e < 32; ++e) { tab[e] = s; s += (tab[40 + e] + 255) >> 8; } tab[32] = s; }
    __syncthreads();
}

__device__ __forceinline__ void p7_combine_ln(Frame& F, const Args& A, int l) {
    const LAS int* tab = (const LAS int*)(F.lds + TAB_OFF);
    bf16* HB = (bf16*)(F.ws + WS_HB); const bf16* Y2S = (const bf16*)(F.ws + WS_Y2S); const int* route = (const int*)(F.ws + WS_ROUTE);
    const float* g = A.in[I_LFG] + l * D_; const float* b = A.in[I_LFB] + l * D_;
    int lane = F.lane; asm volatile("" : "+v"(lane));
    const int gw = F.vcu * NWAVES + F.wave, NGW = F.G * NWAVES;
    f32x4 gv[4], bv[4];
#pragma unroll
    for (int j = 0; j < 4; ++j) { gv[j] = *(const f32x4*)(g + 4 * lane + 256 * j); bv[j] = *(const f32x4*)(b + 4 * lane + 256 * j); }
    const bool last = (l == NL - 1);
    for (int m0 = gw * 2; m0 < T_; m0 += NGW * 2) {
        v2u hq[2][4], aq[2][4], cq[2][4]; float g0[2], g1[2];
#pragma unroll
        for (int u = 0; u < 2; ++u) { const int m = m0 + u; const int* rt = route + (size_t)m * 8;
            const int e0 = rt[0], q0 = rt[1], e1 = rt[2], q1 = rt[3]; g0[u] = __int_as_float(rt[4]); g1[u] = __int_as_float(rt[5]);
            const size_t r0 = (size_t)tab[e0] * 256 + q0, r1 = (size_t)tab[e1] * 256 + q1;
            const GAS v2u* hp = (const GAS v2u*)(HB + (size_t)m * D_) + lane; const GAS v2u* ya = (const GAS v2u*)(Y2S + r0 * D_) + lane; const GAS v2u* yb = (const GAS v2u*)(Y2S + r1 * D_) + lane;
#pragma unroll
            for (int j = 0; j < 4; ++j) { hq[u][j] = hp[64 * j]; aq[u][j] = ya[64 * j]; cq[u][j] = yb[64 * j]; } }
#pragma unroll
        for (int u = 0; u < 2; ++u) { const int m = m0 + u; f32x4 v[4]; float s = 0.f;
#pragma unroll
            for (int j = 0; j < 4; ++j) { const v2u h = hq[u][j], a = aq[u][j], c = cq[u][j];
                v[j].x = ALPHA * bflo(h.x) + g0[u] * bflo(a.x) + g1[u] * bflo(c.x); v[j].y = ALPHA * bfhi(h.x) + g0[u] * bfhi(a.x) + g1[u] * bfhi(c.x);
                v[j].z = ALPHA * bflo(h.y) + g0[u] * bflo(a.y) + g1[u] * bflo(c.y); v[j].w = ALPHA * bfhi(h.y) + g0[u] * bfhi(a.y) + g1[u] * bfhi(c.y);
                s += (v[j].x + v[j].y) + (v[j].z + v[j].w); }
            const float mean = wave_sum(s) * (1.f / D_); float s2 = 0.f;
#pragma unroll
            for (int j = 0; j < 4; ++j) { v[j] = v[j] - mean; s2 += (v[j].x * v[j].x + v[j].y * v[j].y) + (v[j].z * v[j].z + v[j].w * v[j].w); }
            const float rstd = 1.f / sqrtf(wave_sum(s2) * (1.f / D_) + LN_EPS);
            if (last) { GAS f32x4* o = (GAS f32x4*)(A.out + (size_t)m * D_) + lane;
#pragma unroll
                for (int j = 0; j < 4; ++j) o[64 * j] = v[j] * rstd * gv[j] + bv[j];
            } else { GAS v2u* o8 = (GAS v2u*)(HB + (size_t)m * D_) + lane;
#pragma unroll
                for (int j = 0; j < 4; ++j) { const f32x4 o = v[j] * rstd * gv[j] + bv[j]; v2u w; w.x = pk2(o.x, o.y); w.y = pk2(o.z, o.w); o8[64 * j] = w; } }
        }
    }
}

#ifndef PH_NOINLINE
#define PH_NOINLINE __forceinline__
#endif
PH_NOINLINE __device__ void run_gemm1(LAS unsigned char* lds, unsigned char* ws, int l, int G, int c) {
    pg8::DenseOrder S; S.init(ws + WS_HB, ws + WS_WIN + (size_t)l * N1 * 1024 * 2, T_, N1, D_, G, c);
    pg8::EpiZ E{(bf16*)(ws + WS_Z)};
    if (GEMM_SIMPLE_MASK & 1) pg8::gemm_phase_simple(S, E); else pg8::gemm_phase(lds, S, E);
}
PH_NOINLINE __device__ void run_gemm_probe(LAS unsigned char* lds, unsigned char* ws, int G, int c) {
    pg8::DenseOrder S; S.init(ws + WS_HB, ws + WS_WIN, T_, 256 * (PROBE_EXTRA_NN ? PROBE_EXTRA_NN : 1), D_, G, c);
    pg8::EpiPlain E{(bf16*)(ws + WS_Y), 2048};
    pg8::gemm_phase(lds, S, E);
}
PH_NOINLINE __device__ void run_gemm2(LAS unsigned char* lds, unsigned char* ws, int l, int G, int c) {
    pg8::DenseOrder S; S.init(ws + WS_Y, ws + WS_WOUT + (size_t)l * 1024 * 1024 * 2, T_, D_, D_, G, c);
    pg8::EpiU E{(const bf16*)(ws + WS_HB), (bf16*)(ws + WS_U)};
    if (GEMM_SIMPLE_MASK & 2) pg8::gemm_phase_simple(S, E); else pg8::gemm_phase(lds, S, E);
}
PH_NOINLINE __device__ void run_gemm5(LAS unsigned char* lds, unsigned char* ws, int l, int G, int c) {
    const LAS int* tab = (const LAS int*)(lds + TAB_OFF);
    pg8::MoeGatherOrder S; S.A = (const char*)(ws + WS_H8); S.Bt = (const char*)(ws + WS_WGU + (size_t)l * NE * 1024 * 1024); S.bexp = (size_t)1024 * 1024;
    int kq = D_ / 2; asm volatile("" : "+s"(kq));
    S.K = kq; S.nN = 4; S.nwg = tab[32] * 4; S.G = G; S.c = c; S.tab = tab; S.lists = (const int*)(ws + WS_LISTS);
    pg8::EpiHid E{ws + WS_HID};
    pg8::gemm_phase<pg8::EpiHid, pg8::MoeGatherOrder, true>(lds, S, E);
}
PH_NOINLINE __device__ void run_gemm6(LAS unsigned char* lds, unsigned char* ws, int l, int G, int c) {
    const LAS int* tab = (const LAS int*)(lds + TAB_OFF);
    pg8::MoeRowsOrder S; S.A = (const char*)(ws + WS_HID); S.Bt = (const char*)(ws + WS_WD + (size_t)l * NE * 1024 * 512); S.bexp = (size_t)1024 * 512;
    int kq = DE / 2; asm volatile("" : "+s"(kq));
    S.K = kq; S.nN = 4; S.nwg = tab[32] * 4; S.G = G; S.c = c; S.tab = tab; S.lists = nullptr;
    pg8::EpiPlain E{(bf16*)(ws + WS_Y2S), D_};
    pg8::gemm_phase<pg8::EpiPlain, pg8::MoeRowsOrder, true>(lds, S, E);
}

__global__ void __launch_bounds__(NWAVES * 64, 2) mk_fwd(Args args) {
    extern __shared__ __attribute__((aligned(16))) unsigned char lds_raw[];
    Frame F;
    F.lds = (LAS unsigned char*)lds_raw;
    F.tid = threadIdx.x; F.lane = F.tid & 63; F.wave = __builtin_amdgcn_readfirstlane(F.tid >> 6);
    F.G = gridDim.x; { const int bx = blockIdx.x; F.vcu = (F.G % 8 == 0) ? (bx % 8) * (F.G / 8) + bx / 8 : bx; }
    F.ws = args.ws; F.ctl = (unsigned*)(args.ws + WS_CTL);
    for (int u = F.tid; u < (LDS_BYTES - LDSCTL_OFF) / 4; u += NWAVES * 64) ((LAS unsigned*)(F.lds + LDSCTL_OFF))[u] = 0u;
    __syncthreads();
    volatile LAS unsigned* MISC = (volatile LAS unsigned*)(F.lds + MISC_OFF);
    XcdBarrier bar; bar.bar = F.ctl + CW_BAR; bar.x = 0; bar.st = nullptr;
    if (MK_N_LAUNCHES == 1) bar = xcd_barrier_post(F.ctl + CW_BAR, MISC + 8);
    const int lo = args.ph_lo, hi = args.ph_hi;
#define IN(k) (lo <= (k) && (k) < hi)
#define SEAM(k) do { if (MK_N_LAUNCHES == 1 && (k) + 1 < hi) xcd_barrier(bar); } while (0)
    if ((PH_MASK & 1) && IN(0)) { for (int rep = 0; rep < ((REPEAT_MASK & 1) ? 2 : 1); ++rep) { p0_prologue(F, args); SEAM(0); } }
#pragma unroll 1
    for (int l = 0; l < NL; ++l) {
        const int pb = 1 + 7 * l;
        if ((PH_MASK & 2) && IN(pb + 0)) { for (int rep = 0; rep < ((REPEAT_MASK & 2) ? 2 : 1); ++rep) { run_gemm1(F.lds, F.ws, l, F.G, (int)blockIdx.x); SEAM(pb + 0); }
            if (PROBE_EXTRA_NN && l == 0) { run_gemm_probe(F.lds, F.ws, F.G, (int)blockIdx.x); xcd_barrier(bar); } }
        if ((PH_MASK & 4) && IN(pb + 1)) { for (int rep = 0; rep < ((REPEAT_MASK & 4) ? 2 : 1); ++rep) { p2_mixer(F, args, l); SEAM(pb + 1); } }
        if ((PH_MASK & 8) && IN(pb + 2)) { for (int rep = 0; rep < ((REPEAT_MASK & 8) ? 2 : 1); ++rep) { run_gemm2(F.lds, F.ws, l, F.G, (int)blockIdx.x); SEAM(pb + 2); } }
        if ((PH_MASK & 16) && IN(pb + 3)) {
            if (REPEAT_MASK & 16) { p4_ln_router(F, args, l); SEAM(pb + 3);
                if (blockIdx.x == 0 && F.tid < 32) __hip_atomic_store(F.ctl + CW_CNT + (l * 32 + F.tid) * 64, 0u, RLX_AGENT);
                SEAM(pb + 3); }
            p4_ln_router(F, args, l); SEAM(pb + 3); }
        if ((PH_MASK & 32) && IN(pb + 4)) { for (int rep = 0; rep < ((REPEAT_MASK & 32) ? 2 : 1); ++rep) { moe_table(F, l); run_gemm5(F.lds, F.ws, l, F.G, (int)blockIdx.x); SEAM(pb + 4); } }
        if ((PH_MASK & 64) && IN(pb + 5)) { for (int rep = 0; rep < ((REPEAT_MASK & 64) ? 2 : 1); ++rep) { moe_table(F, l); run_gemm6(F.lds, F.ws, l, F.G, (int)blockIdx.x); SEAM(pb + 5); } }
        if ((PH_MASK & 128) && IN(pb + 6)) { for (int rep = 0; rep < (((REPEAT_MASK & 128) && l == NL - 1) ? 2 : 1); ++rep) { moe_table(F, l); p7_combine_ln(F, args, l); if (rep == 0) SEAM(pb + 6); else xcd_barrier(bar); } }
    }
#undef IN
#undef SEAM
}

extern "C" void kernel_launch(void* const* d_in, const int* in_sizes, int n_in, void* d_out, int out_size, void* d_ws, size_t ws_size, hipStream_t stream) {
    static int grid = 0;
    if (grid == 0) {
        if (n_in != 21 || out_size != T_ * D_ || ws_size < WS_END) { fprintf(stderr, "kernel_launch: unexpected problem (n_in %d, out %d, ws %zu); nothing launched\n", n_in, out_size, ws_size); grid = -1; return; }
        int dev = 0, cus = 0, per_cu = 0;
        if (hipGetDevice(&dev) != hipSuccess || hipDeviceGetAttribute(&cus, hipDeviceAttributeMultiprocessorCount, dev) != hipSuccess) { grid = -1; return; }
        if (hipFuncSetAttribute((const void*)mk_fwd, hipFuncAttributeMaxDynamicSharedMemorySize, LDS_BYTES) != hipSuccess) { fprintf(stderr, "kernel_launch: hipFuncSetAttribute failed\n"); grid = -1; return; }
        if (hipOccupancyMaxActiveBlocksPerMultiprocessor(&per_cu, (const void*)mk_fwd, NWAVES * 64, LDS_BYTES) != hipSuccess || per_cu < 1) { fprintf(stderr, "kernel_launch: occupancy query says %d\n", per_cu); }
        (void)hipGetLastError();
        grid = cus;
    }
    if (grid < 0) return;
    (void)hipMemsetAsync((char*)d_ws + WS_CTL, 0, CTL_ZERO_BYTES, stream);
    Args a{};
    for (int i = 0; i < 21; ++i) a.in[i] = (const float*)d_in[i];
    a.out = (float*)d_out; a.ws = (unsigned char*)d_ws;
    if (MK_N_LAUNCHES == 1) { a.ph_lo = 0; a.ph_hi = NPH; hipLaunchKernelGGL(mk_fwd, dim3(grid), dim3(NWAVES * 64), LDS_BYTES, stream, a); }
    else for (int p = 0; p < NPH; ++p) { a.ph_lo = p; a.ph_hi = p + 1; hipLaunchKernelGGL(mk_fwd, dim3(grid), dim3(NWAVES * 64), LDS_BYTES, stream, a); }
}
```

```cpp
#include <hip/hip_runtime.h>
#include <cstdio>
#include <cstdint>

#ifndef MK_N_LAUNCHES
#define MK_N_LAUNCHES 1
#endif
#ifndef PH_MASK
#define PH_MASK 0xff
#endif
#ifndef REPEAT_MASK
#define REPEAT_MASK 0
#endif
#ifndef PROBE_P0
#define PROBE_P0 0
#endif
#ifndef PROBE_MIX
#define PROBE_MIX 0
#endif
#ifndef PROBE_EXTRA_NN
#define PROBE_EXTRA_NN 0
#endif
#ifndef GEMM_SIMPLE_MASK
#define GEMM_SIMPLE_MASK 0
#endif

#define GAS __attribute__((address_space(1)))
#define LAS __attribute__((address_space(3)))
typedef unsigned short bf16;
typedef unsigned v4u __attribute__((ext_vector_type(4)));
typedef unsigned v2u __attribute__((ext_vector_type(2)));
typedef float f32x4 __attribute__((ext_vector_type(4)));
typedef float f32x2 __attribute__((ext_vector_type(2)));
typedef short bf16x8 __attribute__((ext_vector_type(8)));
#define RLX_AGENT __ATOMIC_RELAXED, __HIP_MEMORY_SCOPE_AGENT
#define LDS_WAIT() asm volatile("s_waitcnt lgkmcnt(0)" ::: "memory")
#define VM_WAIT() asm volatile("s_waitcnt vmcnt(0)" ::: "memory")

constexpr int T_ = 32768, D_ = 1024, SEQ_ = 4096, NL = 2, NE = 32, DE = 512;
constexpr int DIN = 2176, N1 = 2304, NZ = 1408;
constexpr float ALPHA = 1.41421356237f, LN_EPS = 1e-5f;
constexpr int NPH = 1 + 7 * NL;

constexpr size_t MiB = 1u << 20;
constexpr size_t WS_CTL = 0, CTL_ZERO_BYTES = 1 * MiB;
constexpr size_t WS_ROUTE = 1 * MiB;
constexpr size_t WS_WRT = 2 * MiB;
constexpr size_t WS_LISTS = 3 * MiB;
constexpr size_t WS_WIN = 11 * MiB;
constexpr size_t WS_WOUT = 20 * MiB;
constexpr size_t WS_WGU = 24 * MiB;
constexpr size_t WS_H8 = 88 * MiB;
constexpr size_t WS_WD = 152 * MiB;
constexpr size_t WS_HB = 216 * MiB;
constexpr size_t WS_Z = 280 * MiB;
constexpr size_t WS_Y = 368 * MiB;
constexpr size_t WS_U = 280 * MiB;
constexpr size_t WS_HID = 280 * MiB;
constexpr size_t WS_Y2S = 352 * MiB;
constexpr size_t WS_END = 496 * MiB;
constexpr int CW_TMO = 0, CW_BAR = 4096, CW_CNT = 16384;

constexpr int RING_BYTES = 131072, LDSCTL_OFF = RING_BYTES, MISC_OFF = LDSCTL_OFF + 320, TAB_OFF = LDSCTL_OFF + 1024;
constexpr int LDS_BYTES = 147456;

__device__ __forceinline__ unsigned f2bf(float f) { unsigned u = __builtin_bit_cast(unsigned, f); return (u + 0x7fffu + ((u >> 16) & 1u)) >> 16; }
__device__ __forceinline__ unsigned pk2(float lo, float hi) { return f2bf(lo) | (f2bf(hi) << 16); }
__device__ __forceinline__ float bflo(unsigned u) { return __builtin_bit_cast(float, u << 16); }
__device__ __forceinline__ float bfhi(unsigned u) { return __builtin_bit_cast(float, u & 0xffff0000u); }
__device__ __forceinline__ float wave_sum(float v) {
#pragma unroll
    for (int o = 1; o < 64; o <<= 1) v += __shfl_xor(v, o);
    return v;
}
__device__ __forceinline__ unsigned pk4_fp8(float a, float b, float c, float d) {
    int v = 0; v = __builtin_amdgcn_cvt_pk_fp8_f32(a, b, v, false); v = __builtin_amdgcn_cvt_pk_fp8_f32(c, d, v, true); return (unsigned)v; }
__device__ __forceinline__ float sigmoidf_(float x) { return __builtin_amdgcn_rcpf(1.0f + __expf(-x)); }

namespace pg8 {
#define PG8_LAS __attribute__((address_space(3)))
typedef int v8i __attribute__((ext_vector_type(8)));
typedef int v4i __attribute__((ext_vector_type(4)));
constexpr int BM = 256, BK = 64, HALF = 128, HTB = HALF * BK * 2, STAGE_BYTES = 8 * HTB, NXCD = 8, WGM = 8;
__host__ __device__ __forceinline__ int lds_byte(int r, int c) { const int st = (r >> 4) * 2 + (c >> 5), rr = r & 15, cc = c & 31, ob = rr * 64 + cc * 2; return st * 1024 + (ob ^ (((ob >> 9) & 1) << 5)); }
__host__ __device__ __forceinline__ void stage_rc(int b, int& R, int& C) { const int st = b / 1024, sb = b % 1024, swz = sb ^ (((sb >> 9) & 1) << 5); R = (st >> 1) * 16 + swz / 64; C = (st & 1) * 32 + (swz % 64) / 2; }
__host__ __device__ __forceinline__ int perm32(int rho) { const int n = rho >> 4, i = rho & 15; return 8 * (i >> 2) + 4 * n + (i & 3); }

struct Unit { int pm, pn, e, j; };

__device__ __forceinline__ int xcd_remap(int wgid, int nwg) { const int q = nwg / NXCD, r = nwg % NXCD, xcd = wgid % NXCD, off = wgid / NXCD; return (xcd < r ? xcd * (q + 1) : r * (q + 1) + (xcd - r) * q) + off; }

struct DenseOrder {
    static constexpr bool GATHER = false, HAS_HALF = true;
    const char* A; const char* Bt; int K, nM, nN, nwg, G, c, nhalf;
    __device__ void init(const void* A_, const void* Bt_, int M, int N, int K_, int G_, int c_, int half_tile = 0) { A = (const char*)A_; Bt = (const char*)Bt_; K = K_; nM = M / BM; nN = N / BM - half_tile; nwg = nM * nN; G = G_; c = c_; nhalf = half_tile ? nM : 0; }
    __device__ bool next(int i, Unit& u) const {
        const long L = (long)i * G + c; if (L >= nwg + nhalf) return false;
        u.e = 0; u.j = 0;
        if (L >= nwg) { u.pm = (int)(L - nwg); u.pn = nN; return true; }
        const int wgid = xcd_remap((int)L, nwg);
        const int nig = WGM * nN, gid = wgid / nig, fm = gid * WGM, gsz = (nM - fm) < WGM ? (nM - fm) : WGM;
        u.pm = fm + ((wgid % nig) % gsz); u.pn = (wgid % nig) / gsz; return true;
    }
    __device__ __forceinline__ bool is_half(const Unit& u) const { return u.pn >= nN; }
    __device__ __forceinline__ const char* a_tile(const Unit& u) const { return A + (size_t)u.pm * BM * K * 2; }
    __device__ __forceinline__ const char* b_tile(const Unit& u) const { return Bt + (size_t)u.pn * BM * K * 2; }
    __device__ __forceinline__ unsigned a_row_off(const Unit&, int r) const { return (unsigned)(r * K * 2); }
};
struct MoeOrder {
    static constexpr bool HAS_HALF = false;
    __device__ __forceinline__ bool is_half(const Unit&) const { return false; }
    const char* A; const char* Bt; size_t bexp; int K, nN, nwg, G, c; const PG8_LAS int* tab; const int* lists;
    __device__ bool next(int i, Unit& u) const {
        const long L = (long)i * G + c; if (L >= nwg) return false;
        const int wgid = xcd_remap((int)L, nwg);
        const int t = wgid / nN; u.pn = wgid % nN; u.pm = t;
        int e = 0; while (e < 31 && tab[e + 1] <= t) ++e;
        u.e = e; u.j = t - tab[e]; return true;
    }
    __device__ __forceinline__ const char* b_tile(const Unit& u) const { return Bt + (size_t)u.e * bexp + (size_t)u.pn * BM * K * 2; }
};
struct MoeGatherOrder : MoeOrder {
    static constexpr bool GATHER = true;
    __device__ __forceinline__ const char* a_tile(const Unit&) const { return A; }
    __device__ __forceinline__ unsigned a_row_off(const Unit& u, int r) const {
        const int idx = u.j * BM + r, cnt = tab[40 + u.e];
        const int ii = idx < cnt ? idx : cnt - 1;
        const int tok = lists[(size_t)u.e * 65536 + ii] >> 1;
        return (unsigned)tok * (unsigned)(K * 2);
    }
};
struct MoeRowsOrder : MoeOrder {
    static constexpr bool GATHER = true;
    __device__ __forceinline__ const char* a_tile(const Unit&) const { return A; }
    __device__ __forceinline__ unsigned a_row_off(const Unit& u, int r) const { return (unsigned)(u.pm * BM + r) * (unsigned)(K * 2); }
};
struct MoeDenseOrder : MoeOrder {
    static constexpr bool GATHER = false;
    __device__ __forceinline__ const char* a_tile(const Unit& u) const { return A + (size_t)u.pm * BM * K * 2; }
    __device__ __forceinline__ unsigned a_row_off(const Unit&, int r) const { return (unsigned)(r * K * 2); }
};

__device__ __forceinline__ unsigned cvt_pk_bf16(float lo, float hi) { unsigned r; asm volatile("v_cvt_pk_bf16_f32 %0, %1, %2" : "=v"(r) : "v"(lo), "v"(hi)); return r; }

struct EpiZ {
    static constexpr bool PERM = true;
    bf16* Z;
    __device__ __forceinline__ void operator()(const f32x4 (&acc)[2][2][4][2], const Unit& u, int wr, int wc, int fr, int fq) const {
        const int row0 = u.pm * BM + wr * 64 + fr, cl = wc * 32 + 8 * fq;
        if (u.pn < 6) {
            const bool sg = u.pn >= 3;
            const int zc = (sg ? 768 + (u.pn - 3) * 128 : 384 + u.pn * 128) + cl;
#pragma unroll
            for (int ai = 0; ai < 2; ++ai)
#pragma unroll
                for (int m = 0; m < 4; ++m) {
                    f32x4 a0 = acc[ai][0][m][0], a1 = acc[ai][0][m][1], g0 = acc[ai][1][m][0], g1 = acc[ai][1][m][1];
                    if (sg) {
#pragma unroll
                        for (int q = 0; q < 4; ++q) { g0[q] = sigmoidf_(g0[q]); g1[q] = sigmoidf_(g1[q]); }
                    }
                    a0 = a0 * g0; a1 = a1 * g1;
                    v4u w; w.x = cvt_pk_bf16(a0[0], a0[1]); w.y = cvt_pk_bf16(a0[2], a0[3]); w.z = cvt_pk_bf16(a1[0], a1[1]); w.w = cvt_pk_bf16(a1[2], a1[3]);
                    *(v4u*)(Z + (size_t)(row0 + ai * HALF + m * 16) * NZ + zc) = w;
                }
        } else {
            int zb0, zb1;
            if (u.pn == 6) { zb0 = 0; zb1 = 128; } else if (u.pn == 7) { zb0 = 256; zb1 = 1152; } else { zb0 = 1280; zb1 = -1; }
#pragma unroll
            for (int ai = 0; ai < 2; ++ai)
#pragma unroll
                for (int m = 0; m < 4; ++m) {
                    bf16* rowp = Z + (size_t)(row0 + ai * HALF + m * 16) * NZ + cl;
#pragma unroll
                    for (int bj = 0; bj < 2; ++bj) {
                        const int zb = bj ? zb1 : zb0;
                        if (zb >= 0) { const f32x4 a0 = acc[ai][bj][m][0], a1 = acc[ai][bj][m][1];
                            v4u w; w.x = cvt_pk_bf16(a0[0], a0[1]); w.y = cvt_pk_bf16(a0[2], a0[3]); w.z = cvt_pk_bf16(a1[0], a1[1]); w.w = cvt_pk_bf16(a1[2], a1[3]);
                            *(v4u*)(rowp + zb) = w; }
                    }
                }
        }
    }
};
struct EpiU {
    static constexpr bool PERM = true;
    const bf16* H; bf16* U;
    __device__ __forceinline__ void operator()(const f32x4 (&acc)[2][2][4][2], const Unit& u, int wr, int wc, int fr, int fq) const {
        const int row0 = u.pm * BM + wr * 64 + fr, col0 = u.pn * BM + wc * 32 + 8 * fq;
#pragma unroll
        for (int ai = 0; ai < 2; ++ai)
#pragma unroll
            for (int m = 0; m < 4; ++m) {
                const size_t off = (size_t)(row0 + ai * HALF + m * 16) * D_ + col0;
#pragma unroll
                for (int bj = 0; bj < 2; ++bj) {
                    const v4u h = *(const v4u*)(H + off + bj * HALF);
                    const f32x4 a0 = acc[ai][bj][m][0], a1 = acc[ai][bj][m][1];
                    v4u w;
                    w.x = cvt_pk_bf16(ALPHA * bflo(h.x) + a0[0], ALPHA * bfhi(h.x) + a0[1]); w.y = cvt_pk_bf16(ALPHA * bflo(h.y) + a0[2], ALPHA * bfhi(h.y) + a0[3]);
                    w.z = cvt_pk_bf16(ALPHA * bflo(h.z) + a1[0], ALPHA * bfhi(h.z) + a1[1]); w.w = cvt_pk_bf16(ALPHA * bflo(h.w) + a1[2], ALPHA * bfhi(h.w) + a1[3]);
                    *(v4u*)(U + off + bj * HALF) = w;
                }
            }
    }
};
struct EpiHid {
    static constexpr bool PERM = true;
    unsigned char* HID;
    __device__ __forceinline__ void operator()(const f32x4 (&acc)[2][2][4][2], const Unit& u, int wr, int wc, int fr, int fq) const {
        const int row0 = u.pm * BM + wr * 64 + fr, col0 = u.pn * 128 + wc * 32 + 8 * fq;
#pragma unroll
        for (int ai = 0; ai < 2; ++ai)
#pragma unroll
            for (int m = 0; m < 4; ++m) {
                f32x4 g0 = acc[ai][0][m][0], g1 = acc[ai][0][m][1]; const f32x4 u0 = acc[ai][1][m][0], u1 = acc[ai][1][m][1];
#pragma unroll
                for (int q = 0; q < 4; ++q) { g0[q] = g0[q] * sigmoidf_(g0[q]); g1[q] = g1[q] * sigmoidf_(g1[q]); }
                g0 = g0 * u0; g1 = g1 * u1;
                v2u w; w.x = pk4_fp8(g0[0], g0[1], g0[2], g0[3]); w.y = pk4_fp8(g1[0], g1[1], g1[2], g1[3]);
                *(v2u*)(HID + (size_t)(row0 + ai * HALF + m * 16) * DE + col0) = w;
            }
    }
};
struct EpiPlain8 {
    static constexpr bool PERM = true;
    unsigned char* O; int ldc;
    __device__ __forceinline__ void operator()(const f32x4 (&acc)[2][2][4][2], const Unit& u, int wr, int wc, int fr, int fq) const {
        const int row0 = u.pm * BM + wr * 64 + fr, col0 = u.pn * BM + wc * 32 + 8 * fq;
#pragma unroll
        for (int ai = 0; ai < 2; ++ai)
#pragma unroll
            for (int m = 0; m < 4; ++m) {
                unsigned char* rowp = O + (size_t)(row0 + ai * HALF + m * 16) * ldc + col0;
#pragma unroll
                for (int bj = 0; bj < 2; ++bj) { const f32x4 a0 = acc[ai][bj][m][0], a1 = acc[ai][bj][m][1];
                    v2u w; w.x = pk4_fp8(a0[0], a0[1], a0[2], a0[3]); w.y = pk4_fp8(a1[0], a1[1], a1[2], a1[3]);
                    *(v2u*)(rowp + bj * HALF) = w; }
            }
    }
};
struct EpiPlain {
    static constexpr bool PERM = true;
    bf16* O; int ldc;
    __device__ __forceinline__ void operator()(const f32x4 (&acc)[2][2][4][2], const Unit& u, int wr, int wc, int fr, int fq) const {
        const int row0 = u.pm * BM + wr * 64 + fr, col0 = u.pn * BM + wc * 32 + 8 * fq;
#pragma unroll
        for (int ai = 0; ai < 2; ++ai)
#pragma unroll
            for (int m = 0; m < 4; ++m) {
                bf16* rowp = O + (size_t)(row0 + ai * HALF + m * 16) * ldc + col0;
#pragma unroll
                for (int bj = 0; bj < 2; ++bj) { const f32x4 a0 = acc[ai][bj][m][0], a1 = acc[ai][bj][m][1];
                    v4u w; w.x = cvt_pk_bf16(a0[0], a0[1]); w.y = cvt_pk_bf16(a0[2], a0[3]); w.z = cvt_pk_bf16(a1[0], a1[1]); w.w = cvt_pk_bf16(a1[2], a1[3]);
                    *(v4u*)(rowp + bj * HALF) = w; }
            }
    }
};

template <class Epi, class Sched>
__device__ __forceinline__ void gemm_phase_simple(const Sched& S, const Epi& E) {
    int tid = threadIdx.x; asm volatile("" : "+v"(tid));
    const int wid = __builtin_amdgcn_readfirstlane(tid >> 6), lane = tid & 63, wr = wid >> 2, wc = wid & 3, fr = lane & 15, fq = lane >> 4;
    const int K = S.K;
    Unit cur;
    for (int ui = 0; S.next(ui, cur); ++ui) {
        f32x4 acc[2][2][4][2];
#pragma unroll
        for (int a = 0; a < 2; ++a)
#pragma unroll
            for (int b = 0; b < 2; ++b)
#pragma unroll
                for (int m = 0; m < 4; ++m)
#pragma unroll
                    for (int n = 0; n < 2; ++n) acc[a][b][m][n] = (f32x4){0.f, 0.f, 0.f, 0.f};
        const char* at = S.a_tile(cur); const char* bt = S.b_tile(cur);
        const char* ap[2][4]; const char* bp[2][2];
#pragma unroll
        for (int ai = 0; ai < 2; ++ai)
#pragma unroll
            for (int m = 0; m < 4; ++m) ap[ai][m] = at + S.a_row_off(cur, ai * HALF + wr * 64 + m * 16 + fr) + fq * 16;
#pragma unroll
        for (int bj = 0; bj < 2; ++bj)
#pragma unroll
            for (int n = 0; n < 2; ++n) { const int rho = n * 16 + fr; bp[bj][n] = bt + (size_t)(bj * HALF + wc * 32 + (Epi::PERM ? perm32(rho) : rho)) * K * 2 + fq * 16; }
        for (int k0 = 0; k0 < K; k0 += 32) {
            bf16x8 a[2][4], b[2][2];
#pragma unroll
            for (int ai = 0; ai < 2; ++ai)
#pragma unroll
                for (int m = 0; m < 4; ++m) a[ai][m] = *(const bf16x8*)(ap[ai][m] + k0 * 2);
#pragma unroll
            for (int bj = 0; bj < 2; ++bj)
#pragma unroll
                for (int n = 0; n < 2; ++n) b[bj][n] = *(const bf16x8*)(bp[bj][n] + k0 * 2);
#pragma unroll
            for (int ai = 0; ai < 2; ++ai)
#pragma unroll
                for (int bj = 0; bj < 2; ++bj)
#pragma unroll
                    for (int m = 0; m < 4; ++m)
#pragma unroll
                        for (int n = 0; n < 2; ++n) acc[ai][bj][m][n] = __builtin_amdgcn_mfma_f32_16x16x32_bf16(b[bj][n], a[ai][m], acc[ai][bj][m][n], 0, 0, 0);
        }
        E(acc, cur, wr, wc, fr, fq);
    }
}

template <int OFF> __device__ __forceinline__ void glds16(const char* base, unsigned voff, unsigned lds_base) {
    asm volatile("s_add_u32 m0, %2, %3\n\ts_nop 0\n\tglobal_load_lds_dwordx4 %0, %1" :: "v"(voff), "s"(base), "s"(lds_base), "n"(OFF) : "memory", "m0", "scc");
}
template <class Epi, class Sched, bool FP8 = false>
__device__ __forceinline__ void gemm_phase(PG8_LAS unsigned char* lds, const Sched& S, const Epi& E) {
    constexpr bool GATHER = Sched::GATHER;
    int tid = threadIdx.x; asm volatile("" : "+v"(tid));
    const int wid = __builtin_amdgcn_readfirstlane(tid >> 6), lane = tid & 63, wr = wid >> 2, wc = wid & 3, fr = lane & 15, fq = lane >> 4;
    const int K = S.K, nt = K / BK;
    unsigned voffB[2], offA[4], nxA[4];
#pragma unroll
    for (int i = 0; i < 2; ++i) { int R, C; stage_rc(tid * 16 + i * 8192, R, C); const int Rb = Epi::PERM ? ((R & ~31) + perm32(R & 31)) : R;
        voffB[i] = (unsigned)(Rb * K + C) * 2u; offA[i] = (unsigned)(R * K + C) * 2u; offA[2 + i] = (unsigned)((R + HALF) * K + C) * 2u; nxA[i] = 0u; nxA[2 + i] = 0u; }
    const size_t kstep = (size_t)(BK * 2);
    const size_t hstep = (size_t)HALF * K * 2;
    const unsigned ldsw = (unsigned)wid * 1024u;
    const unsigned ldsbw = (unsigned)(size_t)lds + ldsw;
    const int aoff = lds_byte(wr * 64 + fr, fq * 8), boff = lds_byte(wc * 32 + fr, fq * 8);
#define PG8_SA(b, h) (((b) * 2 + (h)) * HTB)
#define PG8_SB(b, h) ((4 + (b) * 2 + (h)) * HTB)
#define PG8_STAGE_B(bufoff, gbase) do { glds16<(bufoff)>((const char*)(gbase), voffB[0], ldsbw); glds16<(bufoff) + 8192>((const char*)(gbase), voffB[1], ldsbw); } while (0)
#define PG8_STAGE_A(bufoff, gbase, h) do { glds16<(bufoff)>((const char*)(gbase), offA[(h) * 2], ldsbw); glds16<(bufoff) + 8192>((const char*)(gbase), offA[(h) * 2 + 1], ldsbw); } while (0)
#define PG8_LDA(dst, b, h) do { _Pragma("unroll") for (int m = 0; m < 4; ++m) _Pragma("unroll") for (int k = 0; k < 2; ++k) dst[m][k] = *(const PG8_LAS bf16x8*)(lds + PG8_SA(b, h) + aoff + m * 2048 + k * 1024); } while (0)
#define PG8_LDB(dst, b, h) do { _Pragma("unroll") for (int n = 0; n < 2; ++n) _Pragma("unroll") for (int k = 0; k < 2; ++k) dst[n][k] = *(const PG8_LAS bf16x8*)(lds + PG8_SB(b, h) + boff + n * 2048 + k * 1024); } while (0)
#define PG8_MMA(ai, bj, At, Bt) do { __builtin_amdgcn_s_setprio(1); if constexpr (FP8) { _Pragma("unroll") for (int m = 0; m < 4; ++m) _Pragma("unroll") for (int n = 0; n < 2; ++n) { \
            const v8i _b = __builtin_shufflevector(__builtin_bit_cast(v4i, Bt[n][0]), __builtin_bit_cast(v4i, Bt[n][1]), 0, 1, 2, 3, 4, 5, 6, 7); \
            const v8i _a = __builtin_shufflevector(__builtin_bit_cast(v4i, At[m][0]), __builtin_bit_cast(v4i, At[m][1]), 0, 1, 2, 3, 4, 5, 6, 7); \
            acc[ai][bj][m][n] = __builtin_amdgcn_mfma_scale_f32_16x16x128_f8f6f4(_b, _a, acc[ai][bj][m][n], 0, 0, 0, 0x7A7A7A7A, 0, 0x7F7F7F7F); } } \
        else { _Pragma("unroll") for (int m = 0; m < 4; ++m) _Pragma("unroll") for (int n = 0; n < 2; ++n) _Pragma("unroll") for (int k = 0; k < 2; ++k) \
        acc[ai][bj][m][n] = __builtin_amdgcn_mfma_f32_16x16x32_bf16(Bt[n][k], At[m][k], acc[ai][bj][m][n], 0, 0, 0); } __builtin_amdgcn_s_setprio(0); } while (0)
#define PG8_WAIT_V(n) asm volatile("s_waitcnt vmcnt(" #n ")" ::: "memory")
#define PG8_WAIT_L(n) asm volatile("s_waitcnt lgkmcnt(" #n ")" ::: "memory")
#define PG8_BAR __builtin_amdgcn_s_barrier()
#define PG8_SCHED __builtin_amdgcn_sched_barrier(0)
#define PG8_OFFS(dst, u) do { if constexpr (GATHER) { _Pragma("unroll") for (int _h = 0; _h < 2; ++_h) _Pragma("unroll") for (int _i = 0; _i < 2; ++_i) { \
        int _R, _C; stage_rc(tid * 16 + _i * 8192, _R, _C); dst[_h * 2 + _i] = S.a_row_off(u, _h * HALF + _R) + (unsigned)(_C * 2); } } } while (0)
    Unit cur, nxt; int ui = 0;
    if (!S.next(0, cur)) return;
    f32x4 acc[2][2][4][2];
#pragma unroll
    for (int a = 0; a < 2; ++a)
#pragma unroll
        for (int b = 0; b < 2; ++b)
#pragma unroll
            for (int m = 0; m < 4; ++m)
#pragma unroll
                for (int n = 0; n < 2; ++n) acc[a][b][m][n] = (f32x4){0.f, 0.f, 0.f, 0.f};
    bf16x8 At[4][2], B0[2][2], B1[2][2];
    const char* cA = S.a_tile(cur); const char* cB = S.b_tile(cur);
    PG8_OFFS(offA, cur);
    PG8_STAGE_B(PG8_SB(0, 0), cB); PG8_STAGE_B(PG8_SB(0, 1), cB + hstep); PG8_STAGE_A(PG8_SA(0, 0), cA, 0); PG8_STAGE_A(PG8_SA(0, 1), cA, 1);
    if (wr == 1) PG8_BAR;
    PG8_WAIT_V(2); PG8_BAR;
    PG8_STAGE_B(PG8_SB(1, 0), cB + kstep); PG8_STAGE_A(PG8_SA(1, 0), cA + kstep, 0); PG8_STAGE_B(PG8_SB(1, 1), cB + hstep + kstep);
    PG8_WAIT_V(6); PG8_BAR;
    for (;;) {
        const bool has_next = S.next(ui + 1, nxt);
        const char* nA = has_next ? S.a_tile(nxt) : cA; const char* nB = has_next ? S.b_tile(nxt) : cB;
        if constexpr (GATHER) { if (has_next) { PG8_OFFS(nxA, nxt); } }
#pragma unroll 1
        for (int t = 0; t < nt; t += 2) {
            const bool last = (t == nt - 2);
            const char* a1 = cA + (size_t)(t + 1) * kstep;
            const char* a2 = last ? nA : cA + (size_t)(t + 2) * kstep; const char* b2 = last ? nB : cB + (size_t)(t + 2) * kstep;
            const char* a3 = a2 + kstep; const char* b3 = b2 + kstep;
            PG8_LDB(B0, 0, 0); PG8_LDB(B1, 0, 1); PG8_SCHED; PG8_LDA(At, 0, 0); PG8_STAGE_A(PG8_SA(1, 1), a1, 1);
            if constexpr (GATHER) { if (last && has_next) {
#pragma unroll
                for (int q = 0; q < 4; ++q) offA[q] = nxA[q]; } }
            PG8_WAIT_V(8); PG8_WAIT_L(0); PG8_BAR; PG8_MMA(0, 0, At, B0); if (!(Sched::HAS_HALF && S.is_half(cur))) PG8_MMA(0, 1, At, B1); PG8_BAR; PG8_SCHED;
            PG8_LDA(At, 0, 1); PG8_STAGE_B(PG8_SB(0, 0), b2); PG8_STAGE_B(PG8_SB(0, 1), b2 + hstep); PG8_STAGE_A(PG8_SA(0, 0), a2, 0);
            PG8_WAIT_V(8); PG8_WAIT_L(0); PG8_BAR; PG8_MMA(1, 0, At, B0); if (!(Sched::HAS_HALF && S.is_half(cur))) PG8_MMA(1, 1, At, B1); PG8_BAR; PG8_SCHED;
            PG8_LDB(B0, 1, 0); PG8_LDB(B1, 1, 1); PG8_SCHED; PG8_LDA(At, 1, 0); PG8_STAGE_A(PG8_SA(0, 1), a2, 1);
            PG8_WAIT_V(8); PG8_WAIT_L(0); PG8_BAR; PG8_MMA(0, 0, At, B0); if (!(Sched::HAS_HALF && S.is_half(cur))) PG8_MMA(0, 1, At, B1); PG8_BAR; PG8_SCHED;
            PG8_LDA(At, 1, 1); PG8_STAGE_B(PG8_SB(1, 0), b3); PG8_STAGE_B(PG8_SB(1, 1), b3 + hstep); PG8_STAGE_A(PG8_SA(1, 0), a3, 0);
            PG8_WAIT_V(8); PG8_WAIT_L(0); PG8_BAR; PG8_MMA(1, 0, At, B0); if (!(Sched::HAS_HALF && S.is_half(cur))) PG8_MMA(1, 1, At, B1); PG8_BAR; PG8_SCHED;
        }
        if (wr == 0) PG8_BAR;
        E(acc, cur, wr, wc, fr, fq);
        if (!has_next) break;
#pragma unroll
        for (int a = 0; a < 2; ++a)
#pragma unroll
            for (int b = 0; b < 2; ++b)
#pragma unroll
                for (int m = 0; m < 4; ++m)
#pragma unroll
                    for (int n = 0; n < 2; ++n) acc[a][b][m][n] = (f32x4){0.f, 0.f, 0.f, 0.f};
        cur = nxt; cA = nA; cB = nB; ++ui;
        if (wr == 1) PG8_BAR;
    }
    PG8_WAIT_V(0);
    PG8_BAR;
#undef PG8_SA
#undef PG8_SB
#undef PG8_STAGE_A
#undef PG8_STAGE_B
#undef PG8_LDA
#undef PG8_LDB
#undef PG8_MMA
#undef PG8_WAIT_V
#undef PG8_WAIT_L
#undef PG8_BAR
#undef PG8_SCHED
#undef PG8_OFFS
}
}

#define XB_TMO      128
#define XB_XCNT(j)  (256  + 64 * (j))
#define XB_XSUB(j)  (1280 + 64 * (j))
#define XB_XGEN(j)  (2304 + 64 * (j))
#define XB_TOP      3328
#define XB_TOPGEN   3392
#define XCD_BAR_WORDS 3456
#define XB_SPIN_CAP (1u << 18)
__device__ __forceinline__ unsigned xb_ld(unsigned* p)              { return __hip_atomic_load(p, __ATOMIC_RELAXED, __HIP_MEMORY_SCOPE_AGENT); }
__device__ __forceinline__ unsigned xb_add(unsigned* p, unsigned v) { return __hip_atomic_fetch_add(p, v, __ATOMIC_RELAXED, __HIP_MEMORY_SCOPE_AGENT); }
__device__ __forceinline__ unsigned xb_xcc_id() { return (unsigned)__builtin_amdgcn_s_getreg((3 << 11) | 20) & 0xFu; }
#define XB_SPIN(cond, bar) do { unsigned _sp = 0; while (cond) { __builtin_amdgcn_s_sleep(1); \
    if ((++_sp & 255u) == 0u) { if (xb_ld(&(bar)[XB_TMO])) break; if (_sp > XB_SPIN_CAP) { atomicAdd(&(bar)[XB_TMO], 1u); break; } } } } while (0)
struct XcdBarrier { unsigned* bar; unsigned x; volatile LAS unsigned* st; };
__device__ __forceinline__ XcdBarrier xcd_barrier_post(unsigned* bar, volatile LAS unsigned* st) {
    XcdBarrier b; b.bar = bar; b.x = xb_xcc_id(); b.st = st;
    if (threadIdx.x == 0) (void)xb_add(&bar[XB_XCNT(b.x)], 1u);
    return b;
}
__device__ __forceinline__ void xcd_barrier_complete(unsigned* bar, unsigned x, unsigned& nloc, unsigned& nx) {
    const unsigned G = gridDim.x * gridDim.y * gridDim.z;
    unsigned sum, cnt, mine, sp = 0u;
    for (;;) {
        sum = 0u; cnt = 0u; mine = 0u;
#pragma unroll
        for (unsigned j = 0; j < 16; ++j) { const unsigned c = xb_ld(&bar[XB_XCNT(j)]); sum += c; cnt += (c > 0u) ? 1u : 0u; mine = (j == x) ? c : mine; }
        if (sum == G) break;
        __builtin_amdgcn_s_sleep(1);
        if ((++sp & 255u) == 0u) { if (xb_ld(&bar[XB_TMO])) break; if (sp > XB_SPIN_CAP) { atomicAdd(&bar[XB_TMO], 1u); break; } }
    }
    nloc = mine > 0u ? mine : 1u; nx = cnt > 0u ? cnt : 1u;
}
__device__ __forceinline__ void xcd_barrier(const XcdBarrier& b) {
    asm volatile("s_waitcnt vmcnt(0)" ::: "memory");
    __syncthreads();
    if (threadIdx.x == 0) {
        unsigned* bar = b.bar;
        __builtin_amdgcn_s_waitcnt(0);
        unsigned nloc = b.st[0], nx = b.st[1];
        if (nloc == 0u) { xcd_barrier_complete(bar, b.x, nloc, nx); b.st[0] = nloc; b.st[1] = nx; }
        const unsigned old = xb_add(&bar[XB_XSUB(b.x)], 1u);
        const unsigned gen = old / nloc;
        if (old + 1u == (gen + 1u) * nloc) {
            __builtin_amdgcn_fence(__ATOMIC_RELEASE, "agent");
            asm volatile("s_waitcnt vmcnt(0)" ::: "memory");
            const unsigned og = xb_add(&bar[XB_TOP], 1u);
            const unsigned tg = og / nx;
            if (og + 1u == (tg + 1u) * nx) xb_add(&bar[XB_TOPGEN], 1u);
            else XB_SPIN(xb_ld(&bar[XB_TOPGEN]) == tg, bar);
            __builtin_amdgcn_fence(__ATOMIC_ACQUIRE, "agent");
            xb_add(&bar[XB_XGEN(b.x)], 1u);
            asm volatile("s_waitcnt vmcnt(0)" ::: "memory");
        } else {
            XB_SPIN(xb_ld(&bar[XB_XGEN(b.x)]) == gen, bar);
            __builtin_amdgcn_fence(__ATOMIC_ACQUIRE, "agent");
            asm volatile("s_waitcnt vmcnt(0)" ::: "memory");
        }
    }
    __syncthreads();
}

constexpr int NWAVES = 8;
struct Args { const float* in[21]; float* out; unsigned char* ws; int ph_lo, ph_hi; };
struct Frame {
    LAS unsigned char* lds;
    unsigned* ctl;
    int tid, lane, wave, vcu, G;
    unsigned char* ws;
};
enum { I_X = 0, I_LNIG, I_LNIB, I_RW, I_RB, I_WIN, I_CAW, I_CBW, I_CBB, I_LCG, I_LCB, I_PW, I_PS, I_WOUT, I_LMG, I_LMB, I_WG, I_WU, I_WDN, I_LFG, I_LFB };

__device__ __forceinline__ void tr_item(const float* src, int srcN, int srccol0, bf16* dst, int dstK, int dstrow0, int k0, LAS float* scr, int lane) {
#pragma unroll 8
    for (int i = 0; i < 32; ++i) { const int kk = 2 * i + (lane >> 5); scr[kk * 33 + (lane & 31)] = src[(size_t)(k0 + kk) * srcN + srccol0 + (lane & 31)]; }
    LDS_WAIT(); asm volatile("" ::: "memory");
    const int c = lane & 7;
#pragma unroll
    for (int j = 0; j < 4; ++j) { const int n = (lane >> 3) + 8 * j; const LAS float* s = scr + (8 * c) * 33 + n;
        v4u o; o.x = pk2(s[0 * 33], s[1 * 33]); o.y = pk2(s[2 * 33], s[3 * 33]); o.z = pk2(s[4 * 33], s[5 * 33]); o.w = pk2(s[6 * 33], s[7 * 33]);
        *(GAS v4u*)(dst + (size_t)(dstrow0 + n) * dstK + k0 + 8 * c) = o; }
    LDS_WAIT(); asm volatile("" ::: "memory");
}
__device__ __forceinline__ void tr_item64(const float* src, int srcN, int srccol0, bf16* dst, int dstK, int dstrow0, int k0, LAS unsigned* scr, int lane) {
    const int kr = lane >> 4, c4 = lane & 15;
    const float* sp = src + (size_t)(k0 + 2 * kr) * srcN + srccol0 + 4 * c4;
    f32x4 A[8], B[8];
#pragma unroll
    for (int i = 0; i < 8; ++i) { A[i] = *(const GAS f32x4*)(sp + (size_t)(8 * i) * srcN); B[i] = *(const GAS f32x4*)(sp + (size_t)(8 * i + 1) * srcN); }
#pragma unroll
    for (int i = 0; i < 8; ++i) { LAS unsigned* w = scr + (4 * i + kr) * 65 + 4 * c4;
        w[0] = pk2(A[i].x, B[i].x); w[1] = pk2(A[i].y, B[i].y); w[2] = pk2(A[i].z, B[i].z); w[3] = pk2(A[i].w, B[i].w); }
    LDS_WAIT(); asm volatile("" ::: "memory");
    const int q = lane & 7, nn = lane >> 3;
#pragma unroll
    for (int j = 0; j < 8; ++j) { const int n = nn + 8 * j; const LAS unsigned* r = scr + (4 * q) * 65 + n;
        v4u o; o.x = r[0]; o.y = r[65]; o.z = r[130]; o.w = r[195];
        *(GAS v4u*)(dst + (size_t)(dstrow0 + n) * dstK + k0 + 8 * q) = o; }
    LDS_WAIT(); asm volatile("" ::: "memory");
}
template <int NS>
__device__ __forceinline__ void tr_item64_f8(const float* src, int srcN, int srccol0, unsigned char* dst, int dstKB, int dstrow0, int k0, float scale, LAS unsigned* scr, int lane, bool nostore = false) {
    const int kr = lane >> 4, c4 = lane & 15;
    const float* sp = src + (size_t)(k0 + 4 * kr) * srcN + srccol0 + 4 * c4;
    f32x4 A[NS][4][4];
#pragma unroll
    for (int s = 0; s < NS; ++s)
#pragma unroll
        for (int i = 0; i < 4; ++i)
#pragma unroll
            for (int t = 0; t < 4; ++t) A[s][i][t] = *(const GAS f32x4*)(sp + (size_t)(64 * s + 16 * i + t) * srcN);
    const int q = lane & 3, nn = lane >> 2;
#pragma unroll
    for (int s = 0; s < NS; ++s) {
#pragma unroll
        for (int i = 0; i < 4; ++i) { LAS unsigned* w = scr + (4 * i + kr) * 65 + 4 * c4;
            w[0] = pk4_fp8(A[s][i][0].x * scale, A[s][i][1].x * scale, A[s][i][2].x * scale, A[s][i][3].x * scale); w[1] = pk4_fp8(A[s][i][0].y * scale, A[s][i][1].y * scale, A[s][i][2].y * scale, A[s][i][3].y * scale);
            w[2] = pk4_fp8(A[s][i][0].z * scale, A[s][i][1].z * scale, A[s][i][2].z * scale, A[s][i][3].z * scale); w[3] = pk4_fp8(A[s][i][0].w * scale, A[s][i][1].w * scale, A[s][i][2].w * scale, A[s][i][3].w * scale); }
        LDS_WAIT(); asm volatile("" ::: "memory");
#pragma unroll
        for (int j = 0; j < 4; ++j) { const int n = nn + 16 * j; const LAS unsigned* r = scr + (4 * q) * 65 + n;
            v4u o; o.x = r[0]; o.y = r[65]; o.z = r[130]; o.w = r[195];
            if (nostore) asm volatile("" :: "v"(o)); else *(GAS v4u*)(dst + (size_t)(dstrow0 + n) * dstKB + k0 + 64 * s + 16 * q) = o; }
        LDS_WAIT(); asm volatile("" ::: "memory");
    }
}
__device__ __forceinline__ int win_src(int c0) {
    const int pn = c0 >> 8, j = c0 & 255, half = j >> 7, jj = j & 127;
    if (pn < 3) { const int ch = pn * 128 + jj; return half == 0 ? 384 + ch : 768 + ch; }
    if (pn < 6) { const int ch = (pn - 3) * 128 + jj; return half == 0 ? 1152 + ch : 1536 + ch; }
    if (pn < 8) { const int q = (pn - 6) * 256 + j; return q < 384 ? q : 1920 + (q - 384); }
    return j < 128 ? 1920 + 128 + j : -1;
}
__device__ __forceinline__ void p0_prologue(Frame& F, const Args& A) {
    LAS float* scr = (LAS float*)(F.lds + F.wave * 8448);
    LAS unsigned* scu = (LAS unsigned*)scr;
    const int gw = F.vcu * NWAVES + F.wave, NGW = F.G * NWAVES, lane = F.lane;
    bf16* WIN = (bf16*)(F.ws + WS_WIN); bf16* WOUT = (bf16*)(F.ws + WS_WOUT); unsigned char* WGU = F.ws + WS_WGU; unsigned char* WD = F.ws + WS_WD; bf16* WRT = (bf16*)(F.ws + WS_WRT);
    constexpr int I_A = NL * 16 * 36, I_B = NL * 12 * 16, I_C = NL * NE * 128, I_D = NL * NE * 64, I_E = 16, I_F = NL * 4 * 16 * 2;
    constexpr int NITEMS = I_A + I_B + I_C + I_D + I_E + I_F;
    const int lane0 = lane;
#pragma unroll 1
    for (int prep = 0; prep < ((PROBE_P0 == 1 || PROBE_P0 == 3) ? 2 : 1); ++prep)
    for (int it = gw; it < NITEMS; it += NGW) {
        int lane = lane0; asm volatile("" : "+v"(lane));
        int r = it;
        if (r < I_C) {
            const int le = r >> 7, q = r & 127, kb = q >> 4, nb = q & 15, n0 = nb * 64, pn = n0 >> 8, half = (n0 & 255) >> 7, jj0 = n0 & 127;
            const float* src = (half ? A.in[I_WU] : A.in[I_WG]) + (size_t)le * 1024 * 512;
            tr_item64_f8<2>(src, 512, pn * 128 + jj0, WGU + (size_t)le * 1024 * 1024, 1024, n0, kb * 128, 32.0f, scu, lane, PROBE_P0 == 3 && prep == 1); continue; }
        r -= I_C;
        if (r < I_D) {
            const int le = r >> 6, q = r & 63, kb = q >> 4, nb = q & 15;
            tr_item64_f8<2>(A.in[I_WDN] + (size_t)le * 512 * 1024, 1024, nb * 64, WD + (size_t)le * 1024 * 512, 512, nb * 64, kb * 128, 32.0f, scu, lane, PROBE_P0 == 3 && prep == 1); continue; }
        r -= I_D;
        if (r < I_A) {
            const int l = r / 576, q = r % 576, kb = q / 36, nb = q % 36, c0 = nb * 64, sc = win_src(c0);
            bf16* dst = WIN + (size_t)l * N1 * 1024;
            if (sc >= 0) tr_item64(A.in[I_WIN] + (size_t)l * 1024 * DIN, DIN, sc, dst, 1024, c0, kb * 64, scu, lane);
            else { const int c = lane & 7;
#pragma unroll
                for (int j = 0; j < 8; ++j) { const int n = (lane >> 3) + 8 * j; *(GAS v4u*)(dst + (size_t)(c0 + n) * 1024 + kb * 64 + 8 * c) = (v4u){0u, 0u, 0u, 0u}; } }
            continue; }
        r -= I_A;
        if (r < I_B) {
            const int l = r / 192, q = r % 192, kb = q >> 4, nb = q & 15;
            tr_item64(A.in[I_WOUT] + (size_t)l * 1024 * 1024, 1024, nb * 64, WOUT + (size_t)l * 1024 * 1024, 1024, nb * 64, kb * 64, scu, lane); continue; }
        r -= I_B;
        if (r < I_E) { tr_item(A.in[I_RW], 32, 0, WRT, 1024, 0, r * 64, scr, lane); continue; }
        r -= I_E;
        {
            const int l = r >> 7, g = (r >> 5) & 3, nb = (r >> 1) & 15, cb = r & 1, n = nb * 64 + lane;
            const float* wo = A.in[I_WOUT] + (size_t)l * 1024 * 1024 + (size_t)(768 + g * 64) * 1024 + n;
            const float* ps = A.in[I_PS] + l * 256 + g * 64;
            const float* pw = A.in[I_PW] + (size_t)(l * 4 + g) * 64 * 64 + cb * 32 * 64;
#pragma unroll
            for (int i = 0; i < 8; ++i) *(LAS f32x4*)(scr + (i * 64 + lane) * 4) = *(const GAS f32x4*)(pw + (i * 64 + lane) * 4);
            float wv[64];
#pragma unroll
            for (int d = 0; d < 64; ++d) wv[d] = wo[(size_t)d * 1024] * ps[d];
            LDS_WAIT(); asm volatile("" ::: "memory");
            bf16* dst = WOUT + (size_t)l * 1024 * 1024 + (size_t)n * 1024 + 768 + g * 64 + cb * 32;
#pragma unroll 1
            for (int c2 = 0; c2 < 16; ++c2) { float o[2];
#pragma unroll
                for (int cc = 0; cc < 2; ++cc) { const LAS f32x4* pr = (const LAS f32x4*)(scr + (c2 * 2 + cc) * 64); float a = 0.f;
#pragma unroll
                    for (int d4 = 0; d4 < 16; ++d4) { const f32x4 p = pr[d4]; a += p.x * wv[4 * d4] + p.y * wv[4 * d4 + 1] + p.z * wv[4 * d4 + 2] + p.w * wv[4 * d4 + 3]; }
                    o[cc] = a; }
                *(GAS unsigned*)(dst + c2 * 2) = pk2(o[0], o[1]); }
            LDS_WAIT(); asm volatile("" ::: "memory");
        }
    }
    bf16* HB = (bf16*)(F.ws + WS_HB);
    const float* g = A.in[I_LNIG]; const float* b = A.in[I_LNIB];
    f32x4 gv[4], bv[4];
#pragma unroll
    for (int j = 0; j < 4; ++j) { gv[j] = *(const f32x4*)(g + 4 * lane + 256 * j); bv[j] = *(const f32x4*)(b + 4 * lane + 256 * j); }
#pragma unroll 1
    for (int prep2 = 0; prep2 < ((PROBE_P0 == 2) ? 2 : 1); ++prep2)
    for (int m0 = gw * 2; m0 < T_; m0 += NGW * 2) {
        f32x4 v[2][4];
#pragma unroll
        for (int u = 0; u < 2; ++u) { const GAS f32x4* xr = (const GAS f32x4*)(A.in[I_X] + (size_t)(m0 + u) * D_) + lane;
#pragma unroll
            for (int j = 0; j < 4; ++j) v[u][j] = xr[64 * j]; }
#pragma unroll
        for (int u = 0; u < 2; ++u) { float s = 0.f;
#pragma unroll
            for (int j = 0; j < 4; ++j) s += (v[u][j].x + v[u][j].y) + (v[u][j].z + v[u][j].w);
            const float mean = wave_sum(s) * (1.f / D_); float s2 = 0.f;
#pragma unroll
            for (int j = 0; j < 4; ++j) { v[u][j] = v[u][j] - mean; s2 += (v[u][j].x * v[u][j].x + v[u][j].y * v[u][j].y) + (v[u][j].z * v[u][j].z + v[u][j].w * v[u][j].w); }
            const float rstd = 1.f / sqrtf(wave_sum(s2) * (1.f / D_) + LN_EPS);
            GAS v2u* o8 = (GAS v2u*)(HB + (size_t)(m0 + u) * D_) + lane;
#pragma unroll
            for (int j = 0; j < 4; ++j) { const f32x4 o = v[u][j] * rstd * gv[j] + bv[j]; v2u w; w.x = pk2(o.x, o.y); w.y = pk2(o.z, o.w); o8[64 * j] = w; } }
    }
}

__device__ __forceinline__ void p2_mixer(Frame& F, const Args& A, int l) {
    LAS unsigned* BV = (LAS unsigned*)F.lds;
    LAS unsigned* PB = (LAS unsigned*)(F.lds + 47616);
    LAS float* V = (LAS float*)(F.lds + 71680);
    const bf16* Z = (const bf16*)(F.ws + WS_Z); bf16* Y = (bf16*)(F.ws + WS_Y);
    const float* wB = A.in[I_CBW] + l * 31 * 384; const float* bB = A.in[I_CBB] + l * 384;
    const float* lg = A.in[I_LCG] + l * 384; const float* lb = A.in[I_LCB] + l * 384; const float* wA = A.in[I_CAW] + l * 3 * 384;
    int tid = F.tid; asm volatile("" : "+v"(tid));
    const int lane = tid & 63, wave = F.wave;
    const bool convt = tid < 384; const int cp = tid % 192, tg = tid / 192;
    f32x2 w[31]; f32x2 bias = (f32x2){0.f, 0.f};
#pragma unroll
    for (int j = 0; j < 31; ++j) w[j] = (f32x2){0.f, 0.f};
    if (convt) {
#pragma unroll
        for (int j = 0; j < 31; ++j) w[j] = *(const f32x2*)(wB + j * 384 + 2 * cp);
        bias = *(const f32x2*)(bB + 2 * cp); }
    v4u pre[9];
#define MIX_PREFETCH(ci_, tid_) do { const int _t0 = (ci_) * 32, _s0 = _t0 & (SEQ_ - 1); \
        _Pragma("unroll") for (int _i = 0; _i < 6; ++_i) { const int _q = (tid_) + 512 * _i; const int _qq = _q < 62 * 48 ? _q : 0; const int _r = _qq / 48, _c = _qq % 48; \
            const int _rr = (_s0 - 30 + _r >= 0) ? _r : 30; pre[_i] = *(const GAS v4u*)(Z + (size_t)(_t0 - 30 + _rr) * NZ + 768 + _c * 8); } \
        _Pragma("unroll") for (int _i = 0; _i < 3; ++_i) { const int _q = (tid_) + 512 * _i; const int _qq = _q < 47 * 32 ? _q : 0; const int _r = _qq >> 5, _c = _qq & 31; \
            const int _rr = (_s0 - 15 + _r >= 0) ? _r : 15; pre[6 + _i] = *(const GAS v4u*)(Z + (size_t)(_t0 - 15 + _rr) * NZ + 1152 + _c * 8); } } while (0)
    if (F.vcu < T_ / 32) MIX_PREFETCH(F.vcu, tid);
    for (int ci = F.vcu; ci < T_ / 32; ci += F.G) {
        const int t0 = ci * 32, s0 = t0 & (SEQ_ - 1);
#pragma unroll
        for (int i = 0; i < 6; ++i) { const int q = tid + 512 * i; if (q < 62 * 48) { const int r = q / 48, c = q % 48;
            *(LAS v4u*)(BV + r * 192 + c * 4) = (s0 - 30 + r >= 0) ? pre[i] : (v4u){0u, 0u, 0u, 0u}; } }
#pragma unroll
        for (int i = 0; i < 3; ++i) { const int q = tid + 512 * i; if (q < 47 * 32) { const int r = q >> 5, c = q & 31;
            *(LAS v4u*)(PB + r * 128 + c * 4) = (s0 - 15 + r >= 0) ? pre[6 + i] : (v4u){0u, 0u, 0u, 0u}; } }
        __syncthreads();
#pragma unroll 1
        for (int prep = 0; prep < ((PROBE_MIX == 1) ? 2 : 1); ++prep)
        if (convt) {
#pragma unroll 1
            for (int hh = 0; hh < 2; ++hh) { const int tb = tg * 16 + hh * 8;
                f32x2 x[38];
#pragma unroll
                for (int i = 0; i < 38; ++i) { const unsigned u = BV[(tb + i) * 192 + cp]; x[i] = (f32x2){bflo(u), bfhi(u)}; }
#pragma unroll
                for (int tt = 0; tt < 8; ++tt) { f32x2 a = bias;
#pragma unroll
                    for (int j = 0; j < 31; ++j) a += w[j] * x[tt + j];
                    *(LAS f32x2*)(V + (tb + tt) * 384 + 2 * cp) = a; }
            }
        } else {
            const int p = tid - 384, wd = 2 << (p >> 5);
            f32x2 s = (f32x2){0.f, 0.f};
            for (int i = 1; i < wd; ++i) { const unsigned u = PB[(15 - i) * 128 + p]; s += (f32x2){bflo(u), bfhi(u)}; }
            for (int tt = 0; tt < 32; ++tt) { const int row = 15 + tt; const unsigned u = PB[row * 128 + p]; const f32x2 xv = (f32x2){bflo(u), bfhi(u)};
                s += xv; const int n = (s0 + tt + 1) < wd ? (s0 + tt + 1) : wd; const float inv = 1.0f / (float)n;
                const f32x2 dd = s * inv - xv;
                *(GAS unsigned*)(Y + (size_t)(t0 + tt) * D_ + 768 + 2 * p) = pk2(dd.x, dd.y);
                const unsigned uo = PB[(row - wd + 1) * 128 + p]; s -= (f32x2){bflo(uo), bfhi(uo)}; }
        }
        __syncthreads();
        v4u ya[3][4];
        int t0o = t0; asm volatile("" : "+s"(t0o));
        int tidl = tid; asm volatile("" : "+v"(tidl));
#pragma unroll
        for (int i = 0; i < 3; ++i) { const int q = tidl + 512 * i, tt = q / 48, o8 = q % 48, pos = (t0o & (SEQ_ - 1)) + tt; const size_t row = (size_t)(t0o + tt);
            ya[i][0] = *(const GAS v4u*)(Z + row * NZ + o8 * 8);
            ya[i][1] = *(const GAS v4u*)(Z + row * NZ + 384 + o8 * 8);
            ya[i][2] = *(const GAS v4u*)(Z + (row - (pos >= 1 ? 1 : 0)) * NZ + 384 + o8 * 8);
            ya[i][3] = *(const GAS v4u*)(Z + (row - (pos >= 2 ? 2 : 0)) * NZ + 384 + o8 * 8); }
        { int cn = ci + F.G; asm volatile("" : "+s"(cn));
          if (cn < T_ / 32) MIX_PREFETCH(cn, tidl); }
#pragma unroll 1
        for (int tk = 0; tk < ((PROBE_MIX == 2) ? 8 : 4); ++tk) { const int tt = wave * 4 + (tk & 3);
            f32x2 v[3]; float s = 0.f;
#pragma unroll
            for (int i = 0; i < 3; ++i) { v[i] = *(const LAS f32x2*)(V + tt * 384 + 2 * lane + 128 * i); s += v[i].x + v[i].y; }
            const float mean = wave_sum(s) * (1.f / 384.f); float q = 0.f;
#pragma unroll
            for (int i = 0; i < 3; ++i) { v[i] = v[i] - mean; q += v[i].x * v[i].x + v[i].y * v[i].y; }
            const float rstd = 1.f / sqrtf(wave_sum(q) * (1.f / 384.f) + LN_EPS);
#pragma unroll
            for (int i = 0; i < 3; ++i) { const int c = 2 * lane + 128 * i; const f32x2 gg = *(const f32x2*)(lg + c), bb = *(const f32x2*)(lb + c);
                f32x2 o = v[i] * rstd * gg + bb; o.x = o.x * sigmoidf_(o.x); o.y = o.y * sigmoidf_(o.y);
                *(GAS unsigned*)(Y + (size_t)(t0 + tt) * D_ + 384 + c) = pk2(o.x, o.y); }
        }
#pragma unroll
        for (int i = 0; i < 3; ++i) { const int q = tid + 512 * i, tt = q / 48, o8 = q % 48, pos = s0 + tt; const size_t row = (size_t)(t0 + tt);
            const v4u gb = ya[i][0], x0 = ya[i][1]; v4u x1 = ya[i][2], x2 = ya[i][3];
            if (pos < 1) x1 = (v4u){0u, 0u, 0u, 0u};
            if (pos < 2) x2 = (v4u){0u, 0u, 0u, 0u};
            const f32x4 w2a = *(const f32x4*)(wA + 2 * 384 + o8 * 8), w2b = *(const f32x4*)(wA + 2 * 384 + o8 * 8 + 4);
            const f32x4 w1a = *(const f32x4*)(wA + 1 * 384 + o8 * 8), w1b = *(const f32x4*)(wA + 1 * 384 + o8 * 8 + 4);
            const f32x4 w0a = *(const f32x4*)(wA + o8 * 8), w0b = *(const f32x4*)(wA + o8 * 8 + 4);
            float o[8];
            const unsigned gbw[4] = {gb.x, gb.y, gb.z, gb.w}, x0w[4] = {x0.x, x0.y, x0.z, x0.w}, x1w[4] = {x1.x, x1.y, x1.z, x1.w}, x2w[4] = {x2.x, x2.y, x2.z, x2.w};
            const float w2[8] = {w2a.x, w2a.y, w2a.z, w2a.w, w2b.x, w2b.y, w2b.z, w2b.w}, w1[8] = {w1a.x, w1a.y, w1a.z, w1a.w, w1b.x, w1b.y, w1b.z, w1b.w}, w0[8] = {w0a.x, w0a.y, w0a.z, w0a.w, w0b.x, w0b.y, w0b.z, w0b.w};
#pragma unroll
            for (int e = 0; e < 4; ++e) {
                o[2 * e] = bflo(gbw[e]) * (w2[2 * e] * bflo(x0w[e]) + w1[2 * e] * bflo(x1w[e]) + w0[2 * e] * bflo(x2w[e]));
                o[2 * e + 1] = bfhi(gbw[e]) * (w2[2 * e + 1] * bfhi(x0w[e]) + w1[2 * e + 1] * bfhi(x1w[e]) + w0[2 * e + 1] * bfhi(x2w[e])); }
            v4u ov; ov.x = pk2(o[0], o[1]); ov.y = pk2(o[2], o[3]); ov.z = pk2(o[4], o[5]); ov.w = pk2(o[6], o[7]);
            *(GAS v4u*)(Y + row * D_ + o8 * 8) = ov; }
        __syncthreads();
    }
#undef MIX_PREFETCH
}

__device__ __forceinline__ void top2of4(float q0, float q1, float q2, float q3, float& a1, int& i1, float& a2, int& i2) {
    a1 = q0; i1 = 0; a2 = -1.f; i2 = 1;
#define T2STEP(qv, r) { const bool gt = (qv) > a1; const bool g2 = (qv) > a2; const float na2 = gt ? a1 : (g2 ? (qv) : a2); const int ni2 = gt ? i1 : (g2 ? (r) : i2); \
        a1 = gt ? (qv) : a1; i1 = gt ? (r) : i1; a2 = na2; i2 = ni2; }
    T2STEP(q1, 1) T2STEP(q2, 2) T2STEP(q3, 3)
#undef T2STEP
}
__device__ __forceinline__ void p4_ln_router(Frame& F, const Args& A, int l) {
    LAS unsigned char* lds = F.lds;
    LAS int* cntl = (LAS int*)(lds + 66048); LAS int* basel = cntl + 32; LAS int* sel = cntl + 64; LAS int* lpos = cntl + 64 + 256;
    const bf16* U = (const bf16*)(F.ws + WS_U); bf16* HB = (bf16*)(F.ws + WS_HB); unsigned char* H8 = F.ws + WS_H8; const bf16* WRT = (const bf16*)(F.ws + WS_WRT);
    int* route = (int*)(F.ws + WS_ROUTE); int* lists = (int*)(F.ws + WS_LISTS);
    unsigned* counts = F.ctl + CW_CNT + l * 32 * 64;
    const float* g = A.in[I_LMG] + l * D_; const float* b = A.in[I_LMB] + l * D_; const float* rb = A.in[I_RB];
    int tid = F.tid; asm volatile("" : "+v"(tid));
    const int lane = tid & 63, wave = F.wave, fr = lane & 15, fq = lane >> 4;
    for (int q = tid; q < 32 * 128; q += 512) { const int e = q >> 7, c = q & 127; *(LAS v4u*)(lds + e * 2064 + c * 16) = *(const GAS v4u*)(WRT + e * 1024 + c * 8); }
    if (tid < 32) cntl[tid] = 0;
    f32x4 gv[4], bv[4];
#pragma unroll
    for (int j = 0; j < 4; ++j) { gv[j] = *(const f32x4*)(g + 4 * lane + 256 * j); bv[j] = *(const f32x4*)(b + 4 * lane + 256 * j); }
    __syncthreads();
    for (int blk = F.vcu; blk < T_ / 128; blk += F.G) {
#pragma unroll 1
        for (int i = 0; i < 16; i += 4) { const size_t m = (size_t)(blk * 128 + wave * 16 + i);
            v2u q[4][4];
#pragma unroll
            for (int u = 0; u < 4; ++u) { const GAS v2u* up = (const GAS v2u*)(U + (m + u) * D_) + lane;
#pragma unroll
                for (int j = 0; j < 4; ++j) q[u][j] = up[64 * j]; }
#pragma unroll
            for (int u = 0; u < 4; ++u) { f32x4 v[4]; float s = 0.f;
#pragma unroll
                for (int j = 0; j < 4; ++j) { v[j] = (f32x4){bflo(q[u][j].x), bfhi(q[u][j].x), bflo(q[u][j].y), bfhi(q[u][j].y)}; s += (v[j].x + v[j].y) + (v[j].z + v[j].w); }
                const float mean = wave_sum(s) * (1.f / D_); float s2 = 0.f;
#pragma unroll
                for (int j = 0; j < 4; ++j) { v[j] = v[j] - mean; s2 += (v[j].x * v[j].x + v[j].y * v[j].y) + (v[j].z * v[j].z + v[j].w * v[j].w); }
                const float rstd = 1.f / sqrtf(wave_sum(s2) * (1.f / D_) + LN_EPS);
                GAS v2u* o8 = (GAS v2u*)(HB + (m + u) * D_) + lane; GAS unsigned* o4 = (GAS unsigned*)(H8 + (m + u) * D_) + lane;
#pragma unroll
                for (int j = 0; j < 4; ++j) { const f32x4 o = v[j] * rstd * gv[j] + bv[j]; v2u w; w.x = pk2(o.x, o.y); w.y = pk2(o.z, o.w); o8[64 * j] = w; o4[64 * j] = pk4_fp8(o.x, o.y, o.z, o.w); } }
        }
        VM_WAIT(); asm volatile("" ::: "memory");
        const int token = blk * 128 + wave * 16 + fr;
        f32x4 acc0 = (f32x4){0.f, 0.f, 0.f, 0.f}, acc1 = (f32x4){0.f, 0.f, 0.f, 0.f};
        const bf16* hrow = HB + (size_t)token * D_ + fq * 8;
#pragma unroll 16
        for (int k = 0; k < 32; ++k) { const int kk = k * 32 + fq * 8;
            const bf16x8 hf = *(const GAS bf16x8*)(hrow + k * 32);
            const bf16x8 w0 = *(const LAS bf16x8*)(lds + fr * 2064 + kk * 2), w1 = *(const LAS bf16x8*)(lds + (16 + fr) * 2064 + kk * 2);
            acc0 = __builtin_amdgcn_mfma_f32_16x16x32_bf16(w0, hf, acc0, 0, 0, 0);
            acc1 = __builtin_amdgcn_mfma_f32_16x16x32_bf16(w1, hf, acc1, 0, 0, 0);
        }
        float p0[4], p1[4]; float mx = -3.0e38f;
#pragma unroll
        for (int r = 0; r < 4; ++r) { p0[r] = acc0[r] + rb[4 * fq + r]; p1[r] = acc1[r] + rb[16 + 4 * fq + r]; mx = fmaxf(mx, fmaxf(p0[r], p1[r])); }
        mx = fmaxf(mx, __shfl_xor(mx, 16)); mx = fmaxf(mx, __shfl_xor(mx, 32));
#pragma unroll
        for (int r = 0; r < 4; ++r) { p0[r] = __expf(p0[r] - mx); p1[r] = __expf(p1[r] - mx); }
        float a1, a2, c1, c2; int ia1, ia2, ic1, ic2;
        top2of4(p0[0], p0[1], p0[2], p0[3], a1, ia1, a2, ia2); top2of4(p1[0], p1[1], p1[2], p1[3], c1, ic1, c2, ic2);
        const float sc0 = a1 + a2, sc1 = c1 + c2;
        float bs = sc0; int bg = fq; if (sc1 > sc0) { bs = sc1; bg = 4 + fq; }
#pragma unroll
        for (int off = 16; off <= 32; off <<= 1) { const float os = __shfl_xor(bs, off); const int og = __shfl_xor(bg, off); if (os > bs || (os == bs && og < bg)) { bs = os; bg = og; } }
        if ((bg & 3) == fq) {
            const bool hi = bg >= 4;
            const float pa = hi ? c1 : a1, pb = hi ? c2 : a2; const int ia = hi ? ic1 : ia1, ib = hi ? ic2 : ia2;
            const int ea = bg * 4 + ia, eb = bg * 4 + ib; const float inv = 1.0f / (pa + pb);
            const int tokl = wave * 16 + fr;
            const int la = atomicAdd((int*)&cntl[ea], 1), lb2 = atomicAdd((int*)&cntl[eb], 1);
            sel[tokl * 2] = ea; sel[tokl * 2 + 1] = eb; lpos[tokl * 2] = la; lpos[tokl * 2 + 1] = lb2;
            int* rt = route + (size_t)token * 8; rt[0] = ea; rt[2] = eb; rt[4] = __float_as_int(pa * inv); rt[5] = __float_as_int(pb * inv);
        }
        __syncthreads();
        if (tid < 32) { const int c = cntl[tid]; basel[tid] = c ? (int)__hip_atomic_fetch_add(counts + tid * 64, (unsigned)c, RLX_AGENT) : 0; }
        __syncthreads();
        if (tid < 256) { const int tokl = tid >> 1, k = tid & 1, e = sel[tid], pos = basel[e] + lpos[tid], tok = blk * 128 + tokl;
            lists[(size_t)e * 65536 + pos] = tok * 2 + k; route[(size_t)tok * 8 + 1 + 2 * k] = pos; }
        __syncthreads();
        if (tid < 32) cntl[tid] = 0;
        __syncthreads();
    }
}

__device__ __forceinline__ void moe_table(Frame& F, int l) {
    LAS int* tab = (LAS int*)(F.lds + TAB_OFF);
    __syncthreads();
    if (F.tid < 32) tab[40 + F.tid] = (int)__hip_atomic_load(F.ctl + CW_CNT + (l * 32 + F.tid) * 64, RLX_AGENT);
    __syncthreads();
    if (F.tid == 0) { int s = 0; for (int e = 0; e < 32; ++e) { tab[e] = s; s += (tab[40 + e] + 255) >> 8; } tab[32] = s; }
    __syncthreads();
}

__device__ __forceinline__ void p7_combine_ln(Frame& F, const Args& A, int l) {
    const LAS int* tab = (const LAS int*)(F.lds + TAB_OFF);
    bf16* HB = (bf16*)(F.ws + WS_HB); const unsigned char* Y2S = F.ws + WS_Y2S; const int* route = (const int*)(F.ws + WS_ROUTE);
    const float* g = A.in[I_LFG] + l * D_; const float* b = A.in[I_LFB] + l * D_;
    int lane = F.lane; asm volatile("" : "+v"(lane));
    const int gw = F.vcu * NWAVES + F.wave, NGW = F.G * NWAVES;
    f32x4 gv[4], bv[4];
#pragma unroll
    for (int j = 0; j < 4; ++j) { gv[j] = *(const f32x4*)(g + 4 * lane + 256 * j); bv[j] = *(const f32x4*)(b + 4 * lane + 256 * j); }
    const bool last = (l == NL - 1);
    for (int m0 = gw * 2; m0 < T_; m0 += NGW * 2) {
        v2u hq[2][4]; unsigned aq[2][4], cq[2][4]; float g0[2], g1[2];
#pragma unroll
        for (int u = 0; u < 2; ++u) { const int m = m0 + u; const int* rt = route + (size_t)m * 8;
            const int e0 = rt[0], q0 = rt[1], e1 = rt[2], q1 = rt[3]; g0[u] = __int_as_float(rt[4]); g1[u] = __int_as_float(rt[5]);
            const size_t r0 = (size_t)tab[e0] * 256 + q0, r1 = (size_t)tab[e1] * 256 + q1;
            const GAS v2u* hp = (const GAS v2u*)(HB + (size_t)m * D_) + lane; const GAS unsigned* ya = (const GAS unsigned*)(Y2S + r0 * D_) + lane; const GAS unsigned* yb = (const GAS unsigned*)(Y2S + r1 * D_) + lane;
#pragma unroll
            for (int j = 0; j < 4; ++j) { hq[u][j] = hp[64 * j]; aq[u][j] = ya[64 * j]; cq[u][j] = yb[64 * j]; } }
#pragma unroll
        for (int u = 0; u < 2; ++u) { const int m = m0 + u; f32x4 v[4]; float s = 0.f;
#pragma unroll
            for (int j = 0; j < 4; ++j) { const v2u h = hq[u][j]; const unsigned a = aq[u][j], c = cq[u][j];
                const f32x2 a01 = __builtin_amdgcn_cvt_pk_f32_fp8((int)a, false), a23 = __builtin_amdgcn_cvt_pk_f32_fp8((int)a, true), c01 = __builtin_amdgcn_cvt_pk_f32_fp8((int)c, false), c23 = __builtin_amdgcn_cvt_pk_f32_fp8((int)c, true);
                v[j].x = ALPHA * bflo(h.x) + g0[u] * a01.x + g1[u] * c01.x; v[j].y = ALPHA * bfhi(h.x) + g0[u] * a01.y + g1[u] * c01.y;
                v[j].z = ALPHA * bflo(h.y) + g0[u] * a23.x + g1[u] * c23.x; v[j].w = ALPHA * bfhi(h.y) + g0[u] * a23.y + g1[u] * c23.y;
                s += (v[j].x + v[j].y) + (v[j].z + v[j].w); }
            const float mean = wave_sum(s) * (1.f / D_); float s2 = 0.f;
#pragma unroll
            for (int j = 0; j < 4; ++j) { v[j] = v[j] - mean; s2 += (v[j].x * v[j].x + v[j].y * v[j].y) + (v[j].z * v[j].z + v[j].w * v[j].w); }
            const float rstd = 1.f / sqrtf(wave_sum(s2) * (1.f / D_) + LN_EPS);
            if (last) { GAS f32x4* o = (GAS f32x4*)(A.out + (size_t)m * D_) + lane;
#pragma unroll
                for (int j = 0; j < 4; ++j) o[64 * j] = v[j] * rstd * gv[j] + bv[j];
            } else { GAS v2u* o8 = (GAS v2u*)(HB + (size_t)m * D_) + lane;
#pragma unroll
                for (int j = 0; j < 4; ++j) { const f32x4 o = v[j] * rstd * gv[j] + bv[j]; v2u w; w.x = pk2(o.x, o.y); w.y = pk2(o.z, o.w); o8[64 * j] = w; } }
        }
    }
}

#ifndef PH_NOINLINE
#define PH_NOINLINE __forceinline__
#endif
PH_NOINLINE __device__ void run_gemm1(LAS unsigned char* lds, unsigned char* ws, int l, int G, int c) {
    pg8::DenseOrder S; S.init(ws + WS_HB, ws + WS_WIN + (size_t)l * N1 * 1024 * 2, T_, N1, D_, G, c, 1);
    pg8::EpiZ E{(bf16*)(ws + WS_Z)};
    if (GEMM_SIMPLE_MASK & 1) pg8::gemm_phase_simple(S, E); else pg8::gemm_phase(lds, S, E);
}
PH_NOINLINE __device__ void run_gemm_probe(LAS unsigned char* lds, unsigned char* ws, int G, int c) {
    pg8::DenseOrder S; S.init(ws + WS_HB, ws + WS_WIN, T_, 256 * (PROBE_EXTRA_NN ? PROBE_EXTRA_NN : 1), D_, G, c);
    pg8::EpiPlain E{(bf16*)(ws + WS_Y), 2048};
    pg8::gemm_phase(lds, S, E);
}
PH_NOINLINE __device__ void run_gemm2(LAS unsigned char* lds, unsigned char* ws, int l, int G, int c) {
    pg8::DenseOrder S; S.init(ws + WS_Y, ws + WS_WOUT + (size_t)l * 1024 * 1024 * 2, T_, D_, D_, G, c);
    pg8::EpiU E{(const bf16*)(ws + WS_HB), (bf16*)(ws + WS_U)};
    if (GEMM_SIMPLE_MASK & 2) pg8::gemm_phase_simple(S, E); else pg8::gemm_phase(lds, S, E);
}
PH_NOINLINE __device__ void run_gemm5(LAS unsigned char* lds, unsigned char* ws, int l, int G, int c) {
    const LAS int* tab = (const LAS int*)(lds + TAB_OFF);
    pg8::MoeGatherOrder S; S.A = (const char*)(ws + WS_H8); S.Bt = (const char*)(ws + WS_WGU + (size_t)l * NE * 1024 * 1024); S.bexp = (size_t)1024 * 1024;
    int kq = D_ / 2; asm volatile("" : "+s"(kq));
    S.K = kq; S.nN = 4; S.nwg = tab[32] * 4; S.G = G; S.c = c; S.tab = tab; S.lists = (const int*)(ws + WS_LISTS);
    pg8::EpiHid E{ws + WS_HID};
    pg8::gemm_phase<pg8::EpiHid, pg8::MoeGatherOrder, true>(lds, S, E);
}
PH_NOINLINE __device__ void run_gemm6(LAS unsigned char* lds, unsigned char* ws, int l, int G, int c) {
    const LAS int* tab = (const LAS int*)(lds + TAB_OFF);
    pg8::MoeRowsOrder S; S.A = (const char*)(ws + WS_HID); S.Bt = (const char*)(ws + WS_WD + (size_t)l * NE * 1024 * 512); S.bexp = (size_t)1024 * 512;
    int kq = DE / 2; asm volatile("" : "+s"(kq));
    S.K = kq; S.nN = 4; S.nwg = tab[32] * 4; S.G = G; S.c = c; S.tab = tab; S.lists = nullptr;
    pg8::EpiPlain8 E{ws + WS_Y2S, D_};
    pg8::gemm_phase<pg8::EpiPlain8, pg8::MoeRowsOrder, true>(lds, S, E);
}

__global__ void __launch_bounds__(NWAVES * 64, 2) mk_fwd(Args args) {
    extern __shared__ __attribute__((aligned(16))) unsigned char lds_raw[];
    Frame F;
    F.lds = (LAS unsigned char*)lds_raw;
    F.tid = threadIdx.x; F.lane = F.tid & 63; F.wave = __builtin_amdgcn_readfirstlane(F.tid >> 6);
    F.G = gridDim.x; { const int bx = blockIdx.x; F.vcu = (F.G % 8 == 0) ? (bx % 8) * (F.G / 8) + bx / 8 : bx; }
    F.ws = args.ws; F.ctl = (unsigned*)(args.ws + WS_CTL);
    for (int u = F.tid; u < (LDS_BYTES - LDSCTL_OFF) / 4; u += NWAVES * 64) ((LAS unsigned*)(F.lds + LDSCTL_OFF))[u] = 0u;
    __syncthreads();
    volatile LAS unsigned* MISC = (volatile LAS unsigned*)(F.lds + MISC_OFF);
    XcdBarrier bar; bar.bar = F.ctl + CW_BAR; bar.x = 0; bar.st = nullptr;
    if (MK_N_LAUNCHES == 1) bar = xcd_barrier_post(F.ctl + CW_BAR, MISC + 8);
    const int lo = args.ph_lo, hi = args.ph_hi;
#define IN(k) (lo <= (k) && (k) < hi)
#define SEAM(k) do { if (MK_N_LAUNCHES == 1 && (k) + 1 < hi) xcd_barrier(bar); } while (0)
    if (REPEAT_MASK & 256) { for (int rep = 0; rep < 10; ++rep) xcd_barrier(bar); }
    if ((PH_MASK & 1) && IN(0)) { for (int rep = 0; rep < ((REPEAT_MASK & 1) ? 2 : 1); ++rep) { p0_prologue(F, args); SEAM(0); } }
#pragma unroll 1
    for (int l = 0; l < NL; ++l) {
        const int pb = 1 + 7 * l;
        if ((PH_MASK & 2) && IN(pb + 0)) { for (int rep = 0; rep < ((REPEAT_MASK & 2) ? 2 : 1); ++rep) { run_gemm1(F.lds, F.ws, l, F.G, (int)blockIdx.x); SEAM(pb + 0); }
            if (PROBE_EXTRA_NN && l == 0) { run_gemm_probe(F.lds, F.ws, F.G, (int)blockIdx.x); xcd_barrier(bar); } }
        if ((PH_MASK & 4) && IN(pb + 1)) { for (int rep = 0; rep < ((REPEAT_MASK & 4) ? 2 : 1); ++rep) { p2_mixer(F, args, l); SEAM(pb + 1); } }
        if ((PH_MASK & 8) && IN(pb + 2)) { for (int rep = 0; rep < ((REPEAT_MASK & 8) ? 2 : 1); ++rep) { run_gemm2(F.lds, F.ws, l, F.G, (int)blockIdx.x); SEAM(pb + 2); } }
        if ((PH_MASK & 16) && IN(pb + 3)) {
            if (REPEAT_MASK & 16) { p4_ln_router(F, args, l); SEAM(pb + 3);
                if (blockIdx.x == 0 && F.tid < 32) __hip_atomic_store(F.ctl + CW_CNT + (l * 32 + F.tid) * 64, 0u, RLX_AGENT);
                SEAM(pb + 3); }
            p4_ln_router(F, args, l); SEAM(pb + 3); }
        if ((PH_MASK & 32) && IN(pb + 4)) { for (int rep = 0; rep < ((REPEAT_MASK & 32) ? 2 : 1); ++rep) { moe_table(F, l); run_gemm5(F.lds, F.ws, l, F.G, (int)blockIdx.x); SEAM(pb + 4); } }
        if ((PH_MASK & 64) && IN(pb + 5)) { for (int rep = 0; rep < ((REPEAT_MASK & 64) ? 2 : 1); ++rep) { moe_table(F, l); run_gemm6(F.lds, F.ws, l, F.G, (int)blockIdx.x); SEAM(pb + 5); } }
        if ((PH_MASK & 128) && IN(pb + 6)) { for (int rep = 0; rep < (((REPEAT_MASK & 128) && l == NL - 1) ? 2 : 1); ++rep) { moe_table(F, l); p7_combine_ln(F, args, l); if (rep == 0) SEAM(pb + 6); else xcd_barrier(bar); } }
    }
#undef IN
#undef SEAM
}

extern "C" void kernel_launch(void* const* d_in, const int* in_sizes, int n_in, void* d_out, int out_size, void* d_ws, size_t ws_size, hipStream_t stream) {
    static int grid = 0;
    if (grid == 0) {
        if (n_in != 21 || out_size != T_ * D_ || ws_size < WS_END) { fprintf(stderr, "kernel_launch: unexpected problem (n_in %d, out %d, ws %zu); nothing launched\n", n_in, out_size, ws_size); grid = -1; return; }
        int dev = 0, cus = 0, per_cu = 0;
        if (hipGetDevice(&dev) != hipSuccess || hipDeviceGetAttribute(&cus, hipDeviceAttributeMultiprocessorCount, dev) != hipSuccess) { grid = -1; return; }
        if (hipFuncSetAttribute((const void*)mk_fwd, hipFuncAttributeMaxDynamicSharedMemorySize, LDS_BYTES) != hipSuccess) { fprintf(stderr, "kernel_launch: hipFuncSetAttribute failed\n"); grid = -1; return; }
        if (hipOccupancyMaxActiveBlocksPerMultiprocessor(&per_cu, (const void*)mk_fwd, NWAVES * 64, LDS_BYTES) != hipSuccess || per_cu < 1) { fprintf(stderr, "kernel_launch: occupancy query says %d\n", per_cu); }
        (void)hipGetLastError();
        grid = cus;
    }
    if (grid < 0) return;
    (void)hipMemsetAsync((char*)d_ws + WS_CTL, 0, CTL_ZERO_BYTES, stream);
    Args a{};
    for (int i = 0; i < 21; ++i) a.in[i] = (const float*)d_in[i];
    a.out = (float*)d_out; a.ws = (unsigned char*)d_ws;
    if (MK_N_LAUNCHES == 1) { a.ph_lo = 0; a.ph_hi = NPH; hipLaunchKernelGGL(mk_fwd, dim3(grid), dim3(NWAVES * 64), LDS_BYTES, stream, a); }
    else for (int p = 0; p < NPH; ++p) { a.ph_lo = p; a.ph_hi = p + 1; hipLaunchKernelGGL(mk_fwd, dim3(grid), dim3(NWAVES * 64), LDS_BYTES, stream, a); }
}
```

```cpp
#include <hip/hip_runtime.h>
#include <cstdio>
#include <cstdint>

#ifndef MK_N_LAUNCHES
#define MK_N_LAUNCHES 1
#endif
#ifndef PH_MASK
#define PH_MASK 0xff
#endif
#ifndef REPEAT_MASK
#define REPEAT_MASK 0
#endif
#ifndef GEMM2_FP8
#define GEMM2_FP8 1
#endif
#ifndef PROBE_P0
#define PROBE_P0 0
#endif
#ifndef PROBE_MIX
#define PROBE_MIX 0
#endif
#ifndef PROBE_EXTRA_NN
#define PROBE_EXTRA_NN 0
#endif
#ifndef GEMM_SIMPLE_MASK
#define GEMM_SIMPLE_MASK 0
#endif

#define GAS __attribute__((address_space(1)))
#define LAS __attribute__((address_space(3)))
typedef unsigned short bf16;
typedef unsigned v4u __attribute__((ext_vector_type(4)));
typedef unsigned v2u __attribute__((ext_vector_type(2)));
typedef float f32x4 __attribute__((ext_vector_type(4)));
typedef float f32x2 __attribute__((ext_vector_type(2)));
typedef short bf16x8 __attribute__((ext_vector_type(8)));
#define RLX_AGENT __ATOMIC_RELAXED, __HIP_MEMORY_SCOPE_AGENT
#define LDS_WAIT() asm volatile("s_waitcnt lgkmcnt(0)" ::: "memory")
#define VM_WAIT() asm volatile("s_waitcnt vmcnt(0)" ::: "memory")

constexpr int T_ = 32768, D_ = 1024, SEQ_ = 4096, NL = 2, NE = 32, DE = 512;
constexpr int DIN = 2176, N1 = 2304, NZ = 1408;
constexpr float ALPHA = 1.41421356237f, LN_EPS = 1e-5f;
constexpr int NPH = 1 + 7 * NL;

constexpr size_t MiB = 1u << 20;
constexpr size_t WS_CTL = 0, CTL_ZERO_BYTES = 1 * MiB;
constexpr size_t WS_ROUTE = 1 * MiB;
constexpr size_t WS_WRT = 2 * MiB;
constexpr size_t WS_LISTS = 3 * MiB;
constexpr size_t WS_WIN = 11 * MiB;
constexpr size_t WS_WOUT = 20 * MiB;
constexpr size_t WS_WGU = 24 * MiB;
constexpr size_t WS_H8 = 88 * MiB;
constexpr size_t WS_WD = 152 * MiB;
constexpr size_t WS_HB = 216 * MiB;
constexpr size_t WS_Z = 280 * MiB;
constexpr size_t WS_Y = 368 * MiB;
constexpr size_t WS_U = 280 * MiB;
constexpr size_t WS_HID = 280 * MiB;
constexpr size_t WS_Y2S = 352 * MiB;
constexpr size_t WS_END = 496 * MiB;
constexpr int CW_TMO = 0, CW_BAR = 4096, CW_CNT = 16384;

constexpr int RING_BYTES = 131072, LDSCTL_OFF = RING_BYTES, MISC_OFF = LDSCTL_OFF + 320, TAB_OFF = LDSCTL_OFF + 1024;
constexpr int LDS_BYTES = 147456;

__device__ __forceinline__ unsigned f2bf(float f) { unsigned u = __builtin_bit_cast(unsigned, f); return (u + 0x7fffu + ((u >> 16) & 1u)) >> 16; }
__device__ __forceinline__ unsigned pk2(float lo, float hi) { return f2bf(lo) | (f2bf(hi) << 16); }
__device__ __forceinline__ float bflo(unsigned u) { return __builtin_bit_cast(float, u << 16); }
__device__ __forceinline__ float bfhi(unsigned u) { return __builtin_bit_cast(float, u & 0xffff0000u); }
__device__ __forceinline__ float wave_sum(float v) {
#pragma unroll
    for (int o = 1; o < 64; o <<= 1) v += __shfl_xor(v, o);
    return v;
}
__device__ __forceinline__ unsigned pk4_fp8(float a, float b, float c, float d) {
    int v = 0; v = __builtin_amdgcn_cvt_pk_fp8_f32(a, b, v, false); v = __builtin_amdgcn_cvt_pk_fp8_f32(c, d, v, true); return (unsigned)v; }
__device__ __forceinline__ float sigmoidf_(float x) { return __builtin_amdgcn_rcpf(1.0f + __expf(-x)); }

namespace pg8 {
#define PG8_LAS __attribute__((address_space(3)))
typedef int v8i __attribute__((ext_vector_type(8)));
typedef int v4i __attribute__((ext_vector_type(4)));
constexpr int BM = 256, BK = 64, HALF = 128, HTB = HALF * BK * 2, STAGE_BYTES = 8 * HTB, NXCD = 8, WGM = 8;
__host__ __device__ __forceinline__ int lds_byte(int r, int c) { const int st = (r >> 4) * 2 + (c >> 5), rr = r & 15, cc = c & 31, ob = rr * 64 + cc * 2; return st * 1024 + (ob ^ (((ob >> 9) & 1) << 5)); }
__host__ __device__ __forceinline__ void stage_rc(int b, int& R, int& C) { const int st = b / 1024, sb = b % 1024, swz = sb ^ (((sb >> 9) & 1) << 5); R = (st >> 1) * 16 + swz / 64; C = (st & 1) * 32 + (swz % 64) / 2; }
__host__ __device__ __forceinline__ int perm32(int rho) { const int n = rho >> 4, i = rho & 15; return 8 * (i >> 2) + 4 * n + (i & 3); }

struct Unit { int pm, pn, e, j, rh; };

__device__ __forceinline__ int xcd_remap(int wgid, int nwg) { const int q = nwg / NXCD, r = nwg % NXCD, xcd = wgid % NXCD, off = wgid / NXCD; return (xcd < r ? xcd * (q + 1) : r * (q + 1) + (xcd - r) * q) + off; }

struct DenseOrder {
    static constexpr bool GATHER = false, HAS_HALF = true, HAS_RH = false;
    const char* A; const char* Bt; int K, nM, nN, nwg, G, c, nhalf;
    __device__ void init(const void* A_, const void* Bt_, int M, int N, int K_, int G_, int c_, int half_tile = 0) { A = (const char*)A_; Bt = (const char*)Bt_; K = K_; nM = M / BM; nN = N / BM - half_tile; nwg = nM * nN; G = G_; c = c_; nhalf = half_tile ? nM : 0; }
    __device__ bool next(int i, Unit& u) const {
        const long L = (long)i * G + c; if (L >= nwg + nhalf) return false;
        u.e = 0; u.j = 0; u.rh = -1;
        if (L >= nwg) { u.pm = (int)(L - nwg); u.pn = nN; return true; }
        const int wgid = xcd_remap((int)L, nwg);
        const int nig = WGM * nN, gid = wgid / nig, fm = gid * WGM, gsz = (nM - fm) < WGM ? (nM - fm) : WGM;
        u.pm = fm + ((wgid % nig) % gsz); u.pn = (wgid % nig) / gsz; return true;
    }
    __device__ __forceinline__ bool is_half(const Unit& u) const { return u.pn >= nN; }
    __device__ __forceinline__ int row_half(const Unit&) const { return -1; }
    __device__ __forceinline__ const char* a_tile(const Unit& u) const { return A + (size_t)u.pm * BM * K * 2; }
    __device__ __forceinline__ const char* b_tile(const Unit& u) const { return Bt + (size_t)u.pn * BM * K * 2; }
    __device__ __forceinline__ unsigned a_row_off(const Unit&, int r) const { return (unsigned)(r * K * 2); }
};
struct DenseRowsOrder : DenseOrder {
    static constexpr bool GATHER = true, HAS_HALF = false;
    __device__ __forceinline__ const char* a_tile(const Unit&) const { return A; }
    __device__ __forceinline__ unsigned a_row_off(const Unit& u, int r) const { return (unsigned)(u.pm * BM + r) * (unsigned)(K * 2); }
};
struct MoeOrder {
    static constexpr bool HAS_HALF = false, HAS_RH = true;
    __device__ __forceinline__ bool is_half(const Unit&) const { return false; }
    const char* A; const char* Bt; size_t bexp; int K, nN, nwg, G, c; const PG8_LAS int* tab; const int* lists;
    __device__ bool next(int i, Unit& u) const {
        const int L = i * G + c, nfull = (nwg / G) * G, rem = nwg - nfull;
        int uidx = L; u.rh = -1;
        if (L >= nfull) { if (2 * rem <= G) { if (L >= nfull + 2 * rem) return false; uidx = nfull + ((L - nfull) >> 1); u.rh = (L - nfull) & 1; } else if (L >= nwg) return false; }
        const int wgid = xcd_remap(uidx, nwg);
        const int t = wgid / nN; u.pn = wgid % nN; u.pm = t;
        int e = 0; while (e < 31 && tab[e + 1] <= t) ++e;
        u.e = e; u.j = t - tab[e]; return true;
    }
    __device__ __forceinline__ int row_half(const Unit& u) const { return u.rh; }
    __device__ __forceinline__ const char* b_tile(const Unit& u) const { return Bt + (size_t)u.e * bexp + (size_t)u.pn * BM * K * 2; }
};
struct MoeGatherOrder : MoeOrder {
    static constexpr bool GATHER = true;
    __device__ __forceinline__ const char* a_tile(const Unit&) const { return A; }
    __device__ __forceinline__ unsigned a_row_off(const Unit& u, int r) const {
        const int idx = u.j * BM + r, cnt = tab[40 + u.e];
        const int ii = idx < cnt ? idx : cnt - 1;
        const int tok = lists[(size_t)u.e * 65536 + ii] >> 1;
        return (unsigned)tok * (unsigned)(K * 2);
    }
};
struct MoeRowsOrder : MoeOrder {
    static constexpr bool GATHER = true;
    __device__ __forceinline__ const char* a_tile(const Unit&) const { return A; }
    __device__ __forceinline__ unsigned a_row_off(const Unit& u, int r) const { return (unsigned)(u.pm * BM + r) * (unsigned)(K * 2); }
};
struct MoeDenseOrder : MoeOrder {
    static constexpr bool GATHER = false;
    __device__ __forceinline__ const char* a_tile(const Unit& u) const { return A + (size_t)u.pm * BM * K * 2; }
    __device__ __forceinline__ unsigned a_row_off(const Unit&, int r) const { return (unsigned)(r * K * 2); }
};

__device__ __forceinline__ unsigned cvt_pk_bf16(float lo, float hi) { unsigned r; asm volatile("v_cvt_pk_bf16_f32 %0, %1, %2" : "=v"(r) : "v"(lo), "v"(hi)); return r; }

struct EpiZ {
    static constexpr bool PERM = true;
    bf16* Z;
    __device__ __forceinline__ void operator()(const f32x4 (&acc)[2][2][4][2], const Unit& u, int wr, int wc, int fr, int fq) const {
        const int row0 = u.pm * BM + wr * 64 + fr, cl = wc * 32 + 8 * fq;
        if (u.pn < 6) {
            const bool sg = u.pn >= 3;
            const int zc = (sg ? 768 + (u.pn - 3) * 128 : 384 + u.pn * 128) + cl;
#pragma unroll
            for (int ai = 0; ai < 2; ++ai)
#pragma unroll
                for (int m = 0; m < 4; ++m) {
                    f32x4 a0 = acc[ai][0][m][0], a1 = acc[ai][0][m][1], g0 = acc[ai][1][m][0], g1 = acc[ai][1][m][1];
                    if (sg) {
#pragma unroll
                        for (int q = 0; q < 4; ++q) { g0[q] = sigmoidf_(g0[q]); g1[q] = sigmoidf_(g1[q]); }
                    }
                    a0 = a0 * g0; a1 = a1 * g1;
                    v4u w; w.x = cvt_pk_bf16(a0[0], a0[1]); w.y = cvt_pk_bf16(a0[2], a0[3]); w.z = cvt_pk_bf16(a1[0], a1[1]); w.w = cvt_pk_bf16(a1[2], a1[3]);
                    *(v4u*)(Z + (size_t)(row0 + ai * HALF + m * 16) * NZ + zc) = w;
                }
        } else {
            int zb0, zb1;
            if (u.pn == 6) { zb0 = 0; zb1 = 128; } else if (u.pn == 7) { zb0 = 256; zb1 = 1152; } else { zb0 = 1280; zb1 = -1; }
#pragma unroll
            for (int ai = 0; ai < 2; ++ai)
#pragma unroll
                for (int m = 0; m < 4; ++m) {
                    bf16* rowp = Z + (size_t)(row0 + ai * HALF + m * 16) * NZ + cl;
#pragma unroll
                    for (int bj = 0; bj < 2; ++bj) {
                        const int zb = bj ? zb1 : zb0;
                        if (zb >= 0) { const f32x4 a0 = acc[ai][bj][m][0], a1 = acc[ai][bj][m][1];
                            v4u w; w.x = cvt_pk_bf16(a0[0], a0[1]); w.y = cvt_pk_bf16(a0[2], a0[3]); w.z = cvt_pk_bf16(a1[0], a1[1]); w.w = cvt_pk_bf16(a1[2], a1[3]);
                            *(v4u*)(rowp + zb) = w; }
                    }
                }
        }
    }
};
struct EpiU {
    static constexpr bool PERM = true;
    const bf16* H; bf16* U;
    __device__ __forceinline__ void operator()(const f32x4 (&acc)[2][2][4][2], const Unit& u, int wr, int wc, int fr, int fq) const {
        const int row0 = u.pm * BM + wr * 64 + fr, col0 = u.pn * BM + wc * 32 + 8 * fq;
#pragma unroll
        for (int ai = 0; ai < 2; ++ai)
#pragma unroll
            for (int m = 0; m < 4; ++m) {
                const size_t off = (size_t)(row0 + ai * HALF + m * 16) * D_ + col0;
#pragma unroll
                for (int bj = 0; bj < 2; ++bj) {
                    const v4u h = *(const v4u*)(H + off + bj * HALF);
                    const f32x4 a0 = acc[ai][bj][m][0], a1 = acc[ai][bj][m][1];
                    v4u w;
                    w.x = cvt_pk_bf16(ALPHA * bflo(h.x) + a0[0], ALPHA * bfhi(h.x) + a0[1]); w.y = cvt_pk_bf16(ALPHA * bflo(h.y) + a0[2], ALPHA * bfhi(h.y) + a0[3]);
                    w.z = cvt_pk_bf16(ALPHA * bflo(h.z) + a1[0], ALPHA * bfhi(h.z) + a1[1]); w.w = cvt_pk_bf16(ALPHA * bflo(h.w) + a1[2], ALPHA * bfhi(h.w) + a1[3]);
                    *(v4u*)(U + off + bj * HALF) = w;
                }
                if (m & 1) asm volatile("" ::: "memory");
            }
    }
};
struct EpiHid {
    static constexpr bool PERM = true;
    unsigned char* HID;
    __device__ __forceinline__ void operator()(const f32x4 (&acc)[2][2][4][2], const Unit& u, int wr, int wc, int fr, int fq) const {
        const int row0 = u.pm * BM + wr * 64 + fr, col0 = u.pn * 128 + wc * 32 + 8 * fq;
#pragma unroll
        for (int ai = 0; ai < 2; ++ai) { if (u.rh >= 0 && u.rh != ai) continue;
#pragma unroll
            for (int m = 0; m < 4; ++m) {
                f32x4 g0 = acc[ai][0][m][0], g1 = acc[ai][0][m][1]; const f32x4 u0 = acc[ai][1][m][0], u1 = acc[ai][1][m][1];
#pragma unroll
                for (int q = 0; q < 4; ++q) { g0[q] = g0[q] * sigmoidf_(g0[q]); g1[q] = g1[q] * sigmoidf_(g1[q]); }
                g0 = g0 * u0; g1 = g1 * u1;
                v2u w; w.x = pk4_fp8(g0[0], g0[1], g0[2], g0[3]); w.y = pk4_fp8(g1[0], g1[1], g1[2], g1[3]);
                *(v2u*)(HID + (size_t)(row0 + ai * HALF + m * 16) * DE + col0) = w;
            } }
    }
};
struct EpiPlain8 {
    static constexpr bool PERM = true;
    unsigned char* O; int ldc;
    __device__ __forceinline__ void operator()(const f32x4 (&acc)[2][2][4][2], const Unit& u, int wr, int wc, int fr, int fq) const {
        const int row0 = u.pm * BM + wr * 64 + fr, col0 = u.pn * BM + wc * 32 + 8 * fq;
#pragma unroll
        for (int ai = 0; ai < 2; ++ai) { if (u.rh >= 0 && u.rh != ai) continue;
#pragma unroll
            for (int m = 0; m < 4; ++m) {
                unsigned char* rowp = O + (size_t)(row0 + ai * HALF + m * 16) * ldc + col0;
#pragma unroll
                for (int bj = 0; bj < 2; ++bj) { const f32x4 a0 = acc[ai][bj][m][0], a1 = acc[ai][bj][m][1];
                    v2u w; w.x = pk4_fp8(a0[0], a0[1], a0[2], a0[3]); w.y = pk4_fp8(a1[0], a1[1], a1[2], a1[3]);
                    *(v2u*)(rowp + bj * HALF) = w; }
            } }
    }
};
struct EpiPlain {
    static constexpr bool PERM = true;
    bf16* O; int ldc;
    __device__ __forceinline__ void operator()(const f32x4 (&acc)[2][2][4][2], const Unit& u, int wr, int wc, int fr, int fq) const {
        const int row0 = u.pm * BM + wr * 64 + fr, col0 = u.pn * BM + wc * 32 + 8 * fq;
#pragma unroll
        for (int ai = 0; ai < 2; ++ai)
#pragma unroll
            for (int m = 0; m < 4; ++m) {
                bf16* rowp = O + (size_t)(row0 + ai * HALF + m * 16) * ldc + col0;
#pragma unroll
                for (int bj = 0; bj < 2; ++bj) { const f32x4 a0 = acc[ai][bj][m][0], a1 = acc[ai][bj][m][1];
                    v4u w; w.x = cvt_pk_bf16(a0[0], a0[1]); w.y = cvt_pk_bf16(a0[2], a0[3]); w.z = cvt_pk_bf16(a1[0], a1[1]); w.w = cvt_pk_bf16(a1[2], a1[3]);
                    *(v4u*)(rowp + bj * HALF) = w; }
            }
    }
};

template <class Epi, class Sched>
__device__ __forceinline__ void gemm_phase_simple(const Sched& S, const Epi& E) {
    int tid = threadIdx.x; asm volatile("" : "+v"(tid));
    const int wid = __builtin_amdgcn_readfirstlane(tid >> 6), lane = tid & 63, wr = wid >> 2, wc = wid & 3, fr = lane & 15, fq = lane >> 4;
    const int K = S.K;
    Unit cur;
    for (int ui = 0; S.next(ui, cur); ++ui) {
        f32x4 acc[2][2][4][2];
#pragma unroll
        for (int a = 0; a < 2; ++a)
#pragma unroll
            for (int b = 0; b < 2; ++b)
#pragma unroll
                for (int m = 0; m < 4; ++m)
#pragma unroll
                    for (int n = 0; n < 2; ++n) acc[a][b][m][n] = (f32x4){0.f, 0.f, 0.f, 0.f};
        const char* at = S.a_tile(cur); const char* bt = S.b_tile(cur);
        const char* ap[2][4]; const char* bp[2][2];
#pragma unroll
        for (int ai = 0; ai < 2; ++ai)
#pragma unroll
            for (int m = 0; m < 4; ++m) ap[ai][m] = at + S.a_row_off(cur, ai * HALF + wr * 64 + m * 16 + fr) + fq * 16;
#pragma unroll
        for (int bj = 0; bj < 2; ++bj)
#pragma unroll
            for (int n = 0; n < 2; ++n) { const int rho = n * 16 + fr; bp[bj][n] = bt + (size_t)(bj * HALF + wc * 32 + (Epi::PERM ? perm32(rho) : rho)) * K * 2 + fq * 16; }
        for (int k0 = 0; k0 < K; k0 += 32) {
            bf16x8 a[2][4], b[2][2];
#pragma unroll
            for (int ai = 0; ai < 2; ++ai)
#pragma unroll
                for (int m = 0; m < 4; ++m) a[ai][m] = *(const bf16x8*)(ap[ai][m] + k0 * 2);
#pragma unroll
            for (int bj = 0; bj < 2; ++bj)
#pragma unroll
                for (int n = 0; n < 2; ++n) b[bj][n] = *(const bf16x8*)(bp[bj][n] + k0 * 2);
#pragma unroll
            for (int ai = 0; ai < 2; ++ai)
#pragma unroll
                for (int bj = 0; bj < 2; ++bj)
#pragma unroll
                    for (int m = 0; m < 4; ++m)
#pragma unroll
                        for (int n = 0; n < 2; ++n) acc[ai][bj][m][n] = __builtin_amdgcn_mfma_f32_16x16x32_bf16(b[bj][n], a[ai][m], acc[ai][bj][m][n], 0, 0, 0);
        }
        E(acc, cur, wr, wc, fr, fq);
    }
}

template <int OFF> __device__ __forceinline__ void glds16(const char* base, unsigned voff, unsigned lds_base) {
    asm volatile("s_add_u32 m0, %2, %3\n\ts_nop 0\n\tglobal_load_lds_dwordx4 %0, %1" :: "v"(voff), "s"(base), "s"(lds_base), "n"(OFF) : "memory", "m0", "scc");
}
template <class Epi, class Sched, bool FP8 = false>
__device__ __forceinline__ void gemm_phase(PG8_LAS unsigned char* lds, const Sched& S, const Epi& E) {
    constexpr bool GATHER = Sched::GATHER;
    int tid = threadIdx.x; asm volatile("" : "+v"(tid));
    const int wid = __builtin_amdgcn_readfirstlane(tid >> 6), lane = tid & 63, wr = wid >> 2, wc = wid & 3, fr = lane & 15, fq = lane >> 4;
    const int K = S.K, nt = K / BK;
    unsigned voffB[2], offA[4], nxA[4];
#pragma unroll
    for (int i = 0; i < 2; ++i) { int R, C; stage_rc(tid * 16 + i * 8192, R, C); const int Rb = Epi::PERM ? ((R & ~31) + perm32(R & 31)) : R;
        voffB[i] = (unsigned)(Rb * K + C) * 2u; offA[i] = (unsigned)(R * K + C) * 2u; offA[2 + i] = (unsigned)((R + HALF) * K + C) * 2u; nxA[i] = 0u; nxA[2 + i] = 0u; }
    const size_t kstep = (size_t)(BK * 2);
    const size_t hstep = (size_t)HALF * K * 2;
    const unsigned ldsw = (unsigned)wid * 1024u;
    const unsigned ldsbw = (unsigned)(size_t)lds + ldsw;
    const int aoff = lds_byte(wr * 64 + fr, fq * 8), boff = lds_byte(wc * 32 + fr, fq * 8);
#define PG8_SA(b, h) (((b) * 2 + (h)) * HTB)
#define PG8_SB(b, h) ((4 + (b) * 2 + (h)) * HTB)
#define PG8_STAGE_B(bufoff, gbase) do { glds16<(bufoff)>((const char*)(gbase), voffB[0], ldsbw); glds16<(bufoff) + 8192>((const char*)(gbase), voffB[1], ldsbw); } while (0)
#define PG8_STAGE_A(bufoff, gbase, h) do { glds16<(bufoff)>((const char*)(gbase), offA[(h) * 2], ldsbw); glds16<(bufoff) + 8192>((const char*)(gbase), offA[(h) * 2 + 1], ldsbw); } while (0)
#define PG8_LDA(dst, b, h) do { _Pragma("unroll") for (int m = 0; m < 4; ++m) _Pragma("unroll") for (int k = 0; k < 2; ++k) dst[m][k] = *(const PG8_LAS bf16x8*)(lds + PG8_SA(b, h) + aoff + m * 2048 + k * 1024); } while (0)
#define PG8_LDB(dst, b, h) do { _Pragma("unroll") for (int n = 0; n < 2; ++n) _Pragma("unroll") for (int k = 0; k < 2; ++k) dst[n][k] = *(const PG8_LAS bf16x8*)(lds + PG8_SB(b, h) + boff + n * 2048 + k * 1024); } while (0)
#define PG8_MMA(ai, bj, At, Bt) do { __builtin_amdgcn_s_setprio(1); if constexpr (FP8) { _Pragma("unroll") for (int m = 0; m < 4; ++m) _Pragma("unroll") for (int n = 0; n < 2; ++n) { \
            const v8i _b = __builtin_shufflevector(__builtin_bit_cast(v4i, Bt[n][0]), __builtin_bit_cast(v4i, Bt[n][1]), 0, 1, 2, 3, 4, 5, 6, 7); \
            const v8i _a = __builtin_shufflevector(__builtin_bit_cast(v4i, At[m][0]), __builtin_bit_cast(v4i, At[m][1]), 0, 1, 2, 3, 4, 5, 6, 7); \
            acc[ai][bj][m][n] = __builtin_amdgcn_mfma_scale_f32_16x16x128_f8f6f4(_b, _a, acc[ai][bj][m][n], 0, 0, 0, 0x7A7A7A7A, 0, 0x7F7F7F7F); } } \
        else { _Pragma("unroll") for (int m = 0; m < 4; ++m) _Pragma("unroll") for (int n = 0; n < 2; ++n) _Pragma("unroll") for (int k = 0; k < 2; ++k) \
        acc[ai][bj][m][n] = __builtin_amdgcn_mfma_f32_16x16x32_bf16(Bt[n][k], At[m][k], acc[ai][bj][m][n], 0, 0, 0); } __builtin_amdgcn_s_setprio(0); } while (0)
#define PG8_WAIT_V(n) asm volatile("s_waitcnt vmcnt(" #n ")" ::: "memory")
#define PG8_WAIT_L(n) asm volatile("s_waitcnt lgkmcnt(" #n ")" ::: "memory")
#define PG8_BAR __builtin_amdgcn_s_barrier()
#define PG8_SCHED __builtin_amdgcn_sched_barrier(0)
#define PG8_OFFS(dst, u) do { if constexpr (GATHER) { _Pragma("unroll") for (int _h = 0; _h < 2; ++_h) _Pragma("unroll") for (int _i = 0; _i < 2; ++_i) { \
        int _R, _C; stage_rc(tid * 16 + _i * 8192, _R, _C); dst[_h * 2 + _i] = S.a_row_off(u, _h * HALF + _R) + (unsigned)(_C * 2); } } } while (0)
    Unit cur, nxt; int ui = 0;
    if (!S.next(0, cur)) return;
    f32x4 acc[2][2][4][2];
#pragma unroll
    for (int a = 0; a < 2; ++a)
#pragma unroll
        for (int b = 0; b < 2; ++b)
#pragma unroll
            for (int m = 0; m < 4; ++m)
#pragma unroll
                for (int n = 0; n < 2; ++n) acc[a][b][m][n] = (f32x4){0.f, 0.f, 0.f, 0.f};
    bf16x8 At[4][2], B0[2][2], B1[2][2];
    const char* cA = S.a_tile(cur); const char* cB = S.b_tile(cur);
    PG8_OFFS(offA, cur);
    PG8_STAGE_B(PG8_SB(0, 0), cB); PG8_STAGE_B(PG8_SB(0, 1), cB + hstep); PG8_STAGE_A(PG8_SA(0, 0), cA, 0); PG8_STAGE_A(PG8_SA(0, 1), cA, 1);
    if (wr == 1) PG8_BAR;
    PG8_WAIT_V(2); PG8_BAR;
    PG8_STAGE_B(PG8_SB(1, 0), cB + kstep); PG8_STAGE_A(PG8_SA(1, 0), cA + kstep, 0); PG8_STAGE_B(PG8_SB(1, 1), cB + hstep + kstep);
    PG8_WAIT_V(6); PG8_BAR;
    for (;;) {
        const bool has_next = S.next(ui + 1, nxt);
        const char* nA = has_next ? S.a_tile(nxt) : cA; const char* nB = has_next ? S.b_tile(nxt) : cB;
        if constexpr (GATHER) { if (has_next) { PG8_OFFS(nxA, nxt); } }
#pragma unroll 1
        for (int t = 0; t < nt; t += 2) {
            const bool last = (t == nt - 2);
            const char* a1 = cA + (size_t)(t + 1) * kstep;
            const char* a2 = last ? nA : cA + (size_t)(t + 2) * kstep; const char* b2 = last ? nB : cB + (size_t)(t + 2) * kstep;
            const char* a3 = a2 + kstep; const char* b3 = b2 + kstep;
            PG8_LDB(B0, 0, 0); PG8_LDB(B1, 0, 1); PG8_SCHED; PG8_LDA(At, 0, 0); PG8_STAGE_A(PG8_SA(1, 1), a1, 1);
            if constexpr (GATHER) { if (last && has_next) {
#pragma unroll
                for (int q = 0; q < 4; ++q) offA[q] = nxA[q]; } }
            PG8_WAIT_V(8); PG8_WAIT_L(0); PG8_BAR; if (!(Sched::HAS_RH && cur.rh == 1)) { PG8_MMA(0, 0, At, B0); if (!(Sched::HAS_HALF && S.is_half(cur))) PG8_MMA(0, 1, At, B1); } PG8_BAR; PG8_SCHED;
            PG8_LDA(At, 0, 1); PG8_STAGE_B(PG8_SB(0, 0), b2); PG8_STAGE_B(PG8_SB(0, 1), b2 + hstep); PG8_STAGE_A(PG8_SA(0, 0), a2, 0);
            PG8_WAIT_V(8); PG8_WAIT_L(0); PG8_BAR; if (!(Sched::HAS_RH && cur.rh == 0)) { PG8_MMA(1, 0, At, B0); if (!(Sched::HAS_HALF && S.is_half(cur))) PG8_MMA(1, 1, At, B1); } PG8_BAR; PG8_SCHED;
            PG8_LDB(B0, 1, 0); PG8_LDB(B1, 1, 1); PG8_SCHED; PG8_LDA(At, 1, 0); PG8_STAGE_A(PG8_SA(0, 1), a2, 1);
            PG8_WAIT_V(8); PG8_WAIT_L(0); PG8_BAR; if (!(Sched::HAS_RH && cur.rh == 1)) { PG8_MMA(0, 0, At, B0); if (!(Sched::HAS_HALF && S.is_half(cur))) PG8_MMA(0, 1, At, B1); } PG8_BAR; PG8_SCHED;
            PG8_LDA(At, 1, 1); PG8_STAGE_B(PG8_SB(1, 0), b3); PG8_STAGE_B(PG8_SB(1, 1), b3 + hstep); PG8_STAGE_A(PG8_SA(1, 0), a3, 0);
            PG8_WAIT_V(8); PG8_WAIT_L(0); PG8_BAR; if (!(Sched::HAS_RH && cur.rh == 0)) { PG8_MMA(1, 0, At, B0); if (!(Sched::HAS_HALF && S.is_half(cur))) PG8_MMA(1, 1, At, B1); } PG8_BAR; PG8_SCHED;
        }
        if (wr == 0) PG8_BAR;
        E(acc, cur, wr, wc, fr, fq);
        if (!has_next) break;
#pragma unroll
        for (int a = 0; a < 2; ++a)
#pragma unroll
            for (int b = 0; b < 2; ++b)
#pragma unroll
                for (int m = 0; m < 4; ++m)
#pragma unroll
                    for (int n = 0; n < 2; ++n) acc[a][b][m][n] = (f32x4){0.f, 0.f, 0.f, 0.f};
        cur = nxt; cA = nA; cB = nB; ++ui;
        if (wr == 1) PG8_BAR;
    }
    PG8_WAIT_V(0);
    PG8_BAR;
#undef PG8_SA
#undef PG8_SB
#undef PG8_STAGE_A
#undef PG8_STAGE_B
#undef PG8_LDA
#undef PG8_LDB
#undef PG8_MMA
#undef PG8_WAIT_V
#undef PG8_WAIT_L
#undef PG8_BAR
#undef PG8_SCHED
#undef PG8_OFFS
}
}

#define XB_TMO      128
#define XB_XCNT(j)  (256  + 64 * (j))
#define XB_XSUB(j)  (1280 + 64 * (j))
#define XB_XGEN(j)  (2304 + 64 * (j))
#define XB_TOP      3328
#define XB_TOPGEN   3392
#define XCD_BAR_WORDS 3456
#define XB_SPIN_CAP (1u << 18)
__device__ __forceinline__ unsigned xb_ld(unsigned* p)              { return __hip_atomic_load(p, __ATOMIC_RELAXED, __HIP_MEMORY_SCOPE_AGENT); }
__device__ __forceinline__ unsigned xb_add(unsigned* p, unsigned v) { return __hip_atomic_fetch_add(p, v, __ATOMIC_RELAXED, __HIP_MEMORY_SCOPE_AGENT); }
__device__ __forceinline__ unsigned xb_xcc_id() { return (unsigned)__builtin_amdgcn_s_getreg((3 << 11) | 20) & 0xFu; }
#define XB_SPIN(cond, bar) do { unsigned _sp = 0; while (cond) { __builtin_amdgcn_s_sleep(1); \
    if ((++_sp & 255u) == 0u) { if (xb_ld(&(bar)[XB_TMO])) break; if (_sp > XB_SPIN_CAP) { atomicAdd(&(bar)[XB_TMO], 1u); break; } } } } while (0)
struct XcdBarrier { unsigned* bar; unsigned x; volatile LAS unsigned* st; };
__device__ __forceinline__ XcdBarrier xcd_barrier_post(unsigned* bar, volatile LAS unsigned* st) {
    XcdBarrier b; b.bar = bar; b.x = xb_xcc_id(); b.st = st;
    if (threadIdx.x == 0) (void)xb_add(&bar[XB_XCNT(b.x)], 1u);
    return b;
}
__device__ __forceinline__ void xcd_barrier_complete(unsigned* bar, unsigned x, unsigned& nloc, unsigned& nx) {
    const unsigned G = gridDim.x * gridDim.y * gridDim.z;
    unsigned sum, cnt, mine, sp = 0u;
    for (;;) {
        sum = 0u; cnt = 0u; mine = 0u;
#pragma unroll
        for (unsigned j = 0; j < 16; ++j) { const unsigned c = xb_ld(&bar[XB_XCNT(j)]); sum += c; cnt += (c > 0u) ? 1u : 0u; mine = (j == x) ? c : mine; }
        if (sum == G) break;
        __builtin_amdgcn_s_sleep(1);
        if ((++sp & 255u) == 0u) { if (xb_ld(&bar[XB_TMO])) break; if (sp > XB_SPIN_CAP) { atomicAdd(&bar[XB_TMO], 1u); break; } }
    }
    nloc = mine > 0u ? mine : 1u; nx = cnt > 0u ? cnt : 1u;
}
__device__ __forceinline__ void xcd_barrier(const XcdBarrier& b) {
    asm volatile("s_waitcnt vmcnt(0)" ::: "memory");
    __syncthreads();
    if (threadIdx.x == 0) {
        unsigned* bar = b.bar;
        __builtin_amdgcn_s_waitcnt(0);
        unsigned nloc = b.st[0], nx = b.st[1];
        if (nloc == 0u) { xcd_barrier_complete(bar, b.x, nloc, nx); b.st[0] = nloc; b.st[1] = nx; }
        const unsigned old = xb_add(&bar[XB_XSUB(b.x)], 1u);
        const unsigned gen = old / nloc;
        if (old + 1u == (gen + 1u) * nloc) {
            __builtin_amdgcn_fence(__ATOMIC_RELEASE, "agent");
            asm volatile("s_waitcnt vmcnt(0)" ::: "memory");
            const unsigned og = xb_add(&bar[XB_TOP], 1u);
            const unsigned tg = og / nx;
            if (og + 1u == (tg + 1u) * nx) xb_add(&bar[XB_TOPGEN], 1u);
            else XB_SPIN(xb_ld(&bar[XB_TOPGEN]) == tg, bar);
            __builtin_amdgcn_fence(__ATOMIC_ACQUIRE, "agent");
            xb_add(&bar[XB_XGEN(b.x)], 1u);
            asm volatile("s_waitcnt vmcnt(0)" ::: "memory");
        } else {
            XB_SPIN(xb_ld(&bar[XB_XGEN(b.x)]) == gen, bar);
            __builtin_amdgcn_fence(__ATOMIC_ACQUIRE, "agent");
            asm volatile("s_waitcnt vmcnt(0)" ::: "memory");
        }
    }
    __syncthreads();
}

constexpr int NWAVES = 8;
struct Args { const float* in[21]; float* out; unsigned char* ws; int ph_lo, ph_hi; };
struct Frame {
    LAS unsigned char* lds;
    unsigned* ctl;
    int tid, lane, wave, vcu, G;
    unsigned char* ws;
};
enum { I_X = 0, I_LNIG, I_LNIB, I_RW, I_RB, I_WIN, I_CAW, I_CBW, I_CBB, I_LCG, I_LCB, I_PW, I_PS, I_WOUT, I_LMG, I_LMB, I_WG, I_WU, I_WDN, I_LFG, I_LFB };

__device__ __forceinline__ void tr_item(const float* src, int srcN, int srccol0, bf16* dst, int dstK, int dstrow0, int k0, LAS float* scr, int lane) {
#pragma unroll 8
    for (int i = 0; i < 32; ++i) { const int kk = 2 * i + (lane >> 5); scr[kk * 33 + (lane & 31)] = src[(size_t)(k0 + kk) * srcN + srccol0 + (lane & 31)]; }
    LDS_WAIT(); asm volatile("" ::: "memory");
    const int c = lane & 7;
#pragma unroll
    for (int j = 0; j < 4; ++j) { const int n = (lane >> 3) + 8 * j; const LAS float* s = scr + (8 * c) * 33 + n;
        v4u o; o.x = pk2(s[0 * 33], s[1 * 33]); o.y = pk2(s[2 * 33], s[3 * 33]); o.z = pk2(s[4 * 33], s[5 * 33]); o.w = pk2(s[6 * 33], s[7 * 33]);
        *(GAS v4u*)(dst + (size_t)(dstrow0 + n) * dstK + k0 + 8 * c) = o; }
    LDS_WAIT(); asm volatile("" ::: "memory");
}
__device__ __forceinline__ void tr_item64(const float* src, int srcN, int srccol0, bf16* dst, int dstK, int dstrow0, int k0, LAS unsigned* scr, int lane) {
    const int kr = lane >> 4, c4 = lane & 15;
    const float* sp = src + (size_t)(k0 + 2 * kr) * srcN + srccol0 + 4 * c4;
    f32x4 A[8], B[8];
#pragma unroll
    for (int i = 0; i < 8; ++i) { A[i] = *(const GAS f32x4*)(sp + (size_t)(8 * i) * srcN); B[i] = *(const GAS f32x4*)(sp + (size_t)(8 * i + 1) * srcN); }
#pragma unroll
    for (int i = 0; i < 8; ++i) { LAS unsigned* w = scr + (4 * i + kr) * 65 + 4 * c4;
        w[0] = pk2(A[i].x, B[i].x); w[1] = pk2(A[i].y, B[i].y); w[2] = pk2(A[i].z, B[i].z); w[3] = pk2(A[i].w, B[i].w); }
    LDS_WAIT(); asm volatile("" ::: "memory");
    const int q = lane & 7, nn = lane >> 3;
#pragma unroll
    for (int j = 0; j < 8; ++j) { const int n = nn + 8 * j; const LAS unsigned* r = scr + (4 * q) * 65 + n;
        v4u o; o.x = r[0]; o.y = r[65]; o.z = r[130]; o.w = r[195];
        *(GAS v4u*)(dst + (size_t)(dstrow0 + n) * dstK + k0 + 8 * q) = o; }
    LDS_WAIT(); asm volatile("" ::: "memory");
}
template <int NS>
__device__ __forceinline__ void tr_item64_f8(const float* src, int srcN, int srccol0, unsigned char* dst, int dstKB, int dstrow0, int k0, float scale, LAS unsigned* scr, int lane, bool nostore = false) {
    const int kr = lane >> 4, c4 = lane & 15;
    const float* sp = src + (size_t)(k0 + 4 * kr) * srcN + srccol0 + 4 * c4;
    f32x4 A[NS][4][4];
#pragma unroll
    for (int s = 0; s < NS; ++s)
#pragma unroll
        for (int i = 0; i < 4; ++i)
#pragma unroll
            for (int t = 0; t < 4; ++t) A[s][i][t] = *(const GAS f32x4*)(sp + (size_t)(64 * s + 16 * i + t) * srcN);
    const int q = lane & 3, nn = lane >> 2;
#pragma unroll
    for (int s = 0; s < NS; ++s) {
#pragma unroll
        for (int i = 0; i < 4; ++i) { LAS unsigned* w = scr + (4 * i + kr) * 65 + 4 * c4;
            w[0] = pk4_fp8(A[s][i][0].x * scale, A[s][i][1].x * scale, A[s][i][2].x * scale, A[s][i][3].x * scale); w[1] = pk4_fp8(A[s][i][0].y * scale, A[s][i][1].y * scale, A[s][i][2].y * scale, A[s][i][3].y * scale);
            w[2] = pk4_fp8(A[s][i][0].z * scale, A[s][i][1].z * scale, A[s][i][2].z * scale, A[s][i][3].z * scale); w[3] = pk4_fp8(A[s][i][0].w * scale, A[s][i][1].w * scale, A[s][i][2].w * scale, A[s][i][3].w * scale); }
        LDS_WAIT(); asm volatile("" ::: "memory");
#pragma unroll
        for (int j = 0; j < 4; ++j) { const int n = nn + 16 * j; const LAS unsigned* r = scr + (4 * q) * 65 + n;
            v4u o; o.x = r[0]; o.y = r[65]; o.z = r[130]; o.w = r[195];
            if (nostore) asm volatile("" :: "v"(o)); else *(GAS v4u*)(dst + (size_t)(dstrow0 + n) * dstKB + k0 + 64 * s + 16 * q) = o; }
        LDS_WAIT(); asm volatile("" ::: "memory");
    }
}
__device__ __forceinline__ int win_src(int c0) {
    const int pn = c0 >> 8, j = c0 & 255, half = j >> 7, jj = j & 127;
    if (pn < 3) { const int ch = pn * 128 + jj; return half == 0 ? 384 + ch : 768 + ch; }
    if (pn < 6) { const int ch = (pn - 3) * 128 + jj; return half == 0 ? 1152 + ch : 1536 + ch; }
    if (pn < 8) { const int q = (pn - 6) * 256 + j; return q < 384 ? q : 1920 + (q - 384); }
    return j < 128 ? 1920 + 128 + j : -1;
}
__device__ __forceinline__ void p0_prologue(Frame& F, const Args& A) {
    LAS float* scr = (LAS float*)(F.lds + F.wave * 8448);
    LAS unsigned* scu = (LAS unsigned*)scr;
    const int gw = F.vcu * NWAVES + F.wave, NGW = F.G * NWAVES, lane = F.lane;
    bf16* WIN = (bf16*)(F.ws + WS_WIN); bf16* WOUT = (bf16*)(F.ws + WS_WOUT); unsigned char* WGU = F.ws + WS_WGU; unsigned char* WD = F.ws + WS_WD; bf16* WRT = (bf16*)(F.ws + WS_WRT);
    constexpr int I_A = NL * 16 * 36, I_B = NL * 12 * 16, I_C = NL * NE * 128, I_D = NL * NE * 64, I_E = 16, I_F = NL * 4 * 16 * 2;
    constexpr int NITEMS = I_A + I_B + I_C + I_D + I_E + I_F;
    const int lane0 = lane;
#pragma unroll 1
    for (int prep = 0; prep < ((PROBE_P0 == 1 || PROBE_P0 == 3) ? 2 : 1); ++prep)
    for (int it = gw; it < NITEMS; it += NGW) {
        int lane = lane0; asm volatile("" : "+v"(lane));
        int r = it;
        if (r < I_C) {
            const int le = r >> 7, q = r & 127, kb = q >> 4, nb = q & 15, n0 = nb * 64, pn = n0 >> 8, half = (n0 & 255) >> 7, jj0 = n0 & 127;
            const float* src = (half ? A.in[I_WU] : A.in[I_WG]) + (size_t)le * 1024 * 512;
            tr_item64_f8<2>(src, 512, pn * 128 + jj0, WGU + (size_t)le * 1024 * 1024, 1024, n0, kb * 128, 32.0f, scu, lane, PROBE_P0 == 3 && prep == 1); continue; }
        r -= I_C;
        if (r < I_D) {
            const int le = r >> 6, q = r & 63, kb = q >> 4, nb = q & 15;
            tr_item64_f8<2>(A.in[I_WDN] + (size_t)le * 512 * 1024, 1024, nb * 64, WD + (size_t)le * 1024 * 512, 512, nb * 64, kb * 128, 32.0f, scu, lane, PROBE_P0 == 3 && prep == 1); continue; }
        r -= I_D;
        if (r < I_A) {
            const int l = r / 576, q = r % 576, kb = q / 36, nb = q % 36, c0 = nb * 64, sc = win_src(c0);
            bf16* dst = WIN + (size_t)l * N1 * 1024;
            if (sc >= 0) tr_item64(A.in[I_WIN] + (size_t)l * 1024 * DIN, DIN, sc, dst, 1024, c0, kb * 64, scu, lane);
            else { const int c = lane & 7;
#pragma unroll
                for (int j = 0; j < 8; ++j) { const int n = (lane >> 3) + 8 * j; *(GAS v4u*)(dst + (size_t)(c0 + n) * 1024 + kb * 64 + 8 * c) = (v4u){0u, 0u, 0u, 0u}; } }
            continue; }
        r -= I_A;
        if (r < I_B) {
            const int l = r / 192, q = r % 192, kb = q >> 4, nb = q & 15;
            if (GEMM2_FP8) tr_item64_f8<1>(A.in[I_WOUT] + (size_t)l * 1024 * 1024, 1024, nb * 64, (unsigned char*)WOUT + (size_t)l * 1024 * 1024, 1024, nb * 64, kb * 64, 32.0f, scu, lane);
            else tr_item64(A.in[I_WOUT] + (size_t)l * 1024 * 1024, 1024, nb * 64, WOUT + (size_t)l * 1024 * 1024, 1024, nb * 64, kb * 64, scu, lane);
            continue; }
        r -= I_B;
        if (r < I_E) { tr_item(A.in[I_RW], 32, 0, WRT, 1024, 0, r * 64, scr, lane); continue; }
        r -= I_E;
        {
            const int l = r >> 7, g = (r >> 5) & 3, nb = (r >> 1) & 15, cb = r & 1, n = nb * 64 + lane;
            const float* wo = A.in[I_WOUT] + (size_t)l * 1024 * 1024 + (size_t)(768 + g * 64) * 1024 + n;
            const float* ps = A.in[I_PS] + l * 256 + g * 64;
            const float* pw = A.in[I_PW] + (size_t)(l * 4 + g) * 64 * 64 + cb * 32 * 64;
#pragma unroll
            for (int i = 0; i < 8; ++i) *(LAS f32x4*)(scr + (i * 64 + lane) * 4) = *(const GAS f32x4*)(pw + (i * 64 + lane) * 4);
            float wv[64];
#pragma unroll
            for (int d = 0; d < 64; ++d) wv[d] = wo[(size_t)d * 1024] * ps[d];
            LDS_WAIT(); asm volatile("" ::: "memory");
            bf16* dst = WOUT + (size_t)l * 1024 * 1024 + (size_t)n * 1024 + 768 + g * 64 + cb * 32;
#pragma unroll 1
            for (int c2 = 0; c2 < 16; ++c2) { float o[2];
#pragma unroll
                for (int cc = 0; cc < 2; ++cc) { const LAS f32x4* pr = (const LAS f32x4*)(scr + (c2 * 2 + cc) * 64); float a = 0.f;
#pragma unroll
                    for (int d4 = 0; d4 < 16; ++d4) { const f32x4 p = pr[d4]; a += p.x * wv[4 * d4] + p.y * wv[4 * d4 + 1] + p.z * wv[4 * d4 + 2] + p.w * wv[4 * d4 + 3]; }
                    o[cc] = a; }
                if (GEMM2_FP8) *(GAS unsigned short*)((unsigned char*)WOUT + (size_t)l * 1024 * 1024 + (size_t)n * 1024 + 768 + g * 64 + cb * 32 + c2 * 2) = (unsigned short)pk4_fp8(o[0] * 32.0f, o[1] * 32.0f, 0.f, 0.f);
                else *(GAS unsigned*)(dst + c2 * 2) = pk2(o[0], o[1]); }
            LDS_WAIT(); asm volatile("" ::: "memory");
        }
    }
    bf16* HB = (bf16*)(F.ws + WS_HB);
    const float* g = A.in[I_LNIG]; const float* b = A.in[I_LNIB];
    f32x4 gv[4], bv[4];
#pragma unroll
    for (int j = 0; j < 4; ++j) { gv[j] = *(const f32x4*)(g + 4 * lane + 256 * j); bv[j] = *(const f32x4*)(b + 4 * lane + 256 * j); }
#pragma unroll 1
    for (int prep2 = 0; prep2 < ((PROBE_P0 == 2) ? 2 : 1); ++prep2)
    for (int m0 = gw * 2; m0 < T_; m0 += NGW * 2) {
        f32x4 v[2][4];
#pragma unroll
        for (int u = 0; u < 2; ++u) { const GAS f32x4* xr = (const GAS f32x4*)(A.in[I_X] + (size_t)(m0 + u) * D_) + lane;
#pragma unroll
            for (int j = 0; j < 4; ++j) v[u][j] = xr[64 * j]; }
#pragma unroll
        for (int u = 0; u < 2; ++u) { float s = 0.f;
#pragma unroll
            for (int j = 0; j < 4; ++j) s += (v[u][j].x + v[u][j].y) + (v[u][j].z + v[u][j].w);
            const float mean = wave_sum(s) * (1.f / D_); float s2 = 0.f;
#pragma unroll
            for (int j = 0; j < 4; ++j) { v[u][j] = v[u][j] - mean; s2 += (v[u][j].x * v[u][j].x + v[u][j].y * v[u][j].y) + (v[u][j].z * v[u][j].z + v[u][j].w * v[u][j].w); }
            const float rstd = 1.f / sqrtf(wave_sum(s2) * (1.f / D_) + LN_EPS);
            GAS v2u* o8 = (GAS v2u*)(HB + (size_t)(m0 + u) * D_) + lane;
#pragma unroll
            for (int j = 0; j < 4; ++j) { const f32x4 o = v[u][j] * rstd * gv[j] + bv[j]; v2u w; w.x = pk2(o.x, o.y); w.y = pk2(o.z, o.w); o8[64 * j] = w; } }
    }
}

__device__ __forceinline__ void p2_mixer(Frame& F, const Args& A, int l) {
    LAS unsigned* BV = (LAS unsigned*)F.lds;
    LAS unsigned* PB = (LAS unsigned*)(F.lds + 47616);
    LAS float* V = (LAS float*)(F.lds + 71680);
    const bf16* Z = (const bf16*)(F.ws + WS_Z); bf16* Y = (bf16*)(F.ws + WS_Y);
    const float* wB = A.in[I_CBW] + l * 31 * 384; const float* bB = A.in[I_CBB] + l * 384;
    const float* lg = A.in[I_LCG] + l * 384; const float* lb = A.in[I_LCB] + l * 384; const float* wA = A.in[I_CAW] + l * 3 * 384;
    int tid = F.tid; asm volatile("" : "+v"(tid));
    const int lane = tid & 63, wave = F.wave;
    const bool convt = tid < 384; const int cp = tid % 192, tg = tid / 192;
    f32x2 w[31]; f32x2 bias = (f32x2){0.f, 0.f};
#pragma unroll
    for (int j = 0; j < 31; ++j) w[j] = (f32x2){0.f, 0.f};
    if (convt) {
#pragma unroll
        for (int j = 0; j < 31; ++j) w[j] = *(const f32x2*)(wB + j * 384 + 2 * cp);
        bias = *(const f32x2*)(bB + 2 * cp); }
    v4u pre[9];
#define MIX_PREFETCH(ci_, tid_) do { const int _t0 = (ci_) * 32, _s0 = _t0 & (SEQ_ - 1); \
        _Pragma("unroll") for (int _i = 0; _i < 6; ++_i) { const int _q = (tid_) + 512 * _i; const int _qq = _q < 62 * 48 ? _q : 0; const int _r = _qq / 48, _c = _qq % 48; \
            const int _rr = (_s0 - 30 + _r >= 0) ? _r : 30; pre[_i] = *(const GAS v4u*)(Z + (size_t)(_t0 - 30 + _rr) * NZ + 768 + _c * 8); } \
        _Pragma("unroll") for (int _i = 0; _i < 3; ++_i) { const int _q = (tid_) + 512 * _i; const int _qq = _q < 47 * 32 ? _q : 0; const int _r = _qq >> 5, _c = _qq & 31; \
            const int _rr = (_s0 - 15 + _r >= 0) ? _r : 15; pre[6 + _i] = *(const GAS v4u*)(Z + (size_t)(_t0 - 15 + _rr) * NZ + 1152 + _c * 8); } } while (0)
    if (F.vcu < T_ / 32) MIX_PREFETCH(F.vcu, tid);
    for (int ci = F.vcu; ci < T_ / 32; ci += F.G) {
        const int t0 = ci * 32, s0 = t0 & (SEQ_ - 1);
#pragma unroll
        for (int i = 0; i < 6; ++i) { const int q = tid + 512 * i; if (q < 62 * 48) { const int r = q / 48, c = q % 48;
            *(LAS v4u*)(BV + r * 192 + c * 4) = (s0 - 30 + r >= 0) ? pre[i] : (v4u){0u, 0u, 0u, 0u}; } }
#pragma unroll
        for (int i = 0; i < 3; ++i) { const int q = tid + 512 * i; if (q < 47 * 32) { const int r = q >> 5, c = q & 31;
            *(LAS v4u*)(PB + r * 128 + c * 4) = (s0 - 15 + r >= 0) ? pre[6 + i] : (v4u){0u, 0u, 0u, 0u}; } }
        __syncthreads();
#pragma unroll 1
        for (int prep = 0; prep < ((PROBE_MIX == 1) ? 2 : 1); ++prep)
        if (convt) {
#pragma unroll 1
            for (int hh = 0; hh < 2; ++hh) { const int tb = tg * 16 + hh * 8;
                f32x2 x[38];
#pragma unroll
                for (int i = 0; i < 38; ++i) { const unsigned u = BV[(tb + i) * 192 + cp]; x[i] = (f32x2){bflo(u), bfhi(u)}; }
#pragma unroll
                for (int tt = 0; tt < 8; ++tt) { f32x2 a = bias;
#pragma unroll
                    for (int j = 0; j < 31; ++j) a += w[j] * x[tt + j];
                    *(LAS f32x2*)(V + (tb + tt) * 384 + 2 * cp) = a; }
            }
        } else {
            const int p = tid - 384, wd = 2 << (p >> 5);
            f32x2 s = (f32x2){0.f, 0.f};
            for (int i = 1; i < wd; ++i) { const unsigned u = PB[(15 - i) * 128 + p]; s += (f32x2){bflo(u), bfhi(u)}; }
            for (int tt = 0; tt < 32; ++tt) { const int row = 15 + tt; const unsigned u = PB[row * 128 + p]; const f32x2 xv = (f32x2){bflo(u), bfhi(u)};
                s += xv; const int n = (s0 + tt + 1) < wd ? (s0 + tt + 1) : wd; const float inv = 1.0f / (float)n;
                const f32x2 dd = s * inv - xv;
                if (GEMM2_FP8) *(GAS unsigned short*)((unsigned char*)Y + (size_t)(t0 + tt) * D_ + 768 + 2 * p) = (unsigned short)pk4_fp8(dd.x, dd.y, 0.f, 0.f);
                else *(GAS unsigned*)(Y + (size_t)(t0 + tt) * D_ + 768 + 2 * p) = pk2(dd.x, dd.y);
                const unsigned uo = PB[(row - wd + 1) * 128 + p]; s -= (f32x2){bflo(uo), bfhi(uo)}; }
        }
        __syncthreads();
        v4u ya[3][4];
        int t0o = t0; asm volatile("" : "+s"(t0o));
        int tidl = tid; asm volatile("" : "+v"(tidl));
#pragma unroll
        for (int i = 0; i < 3; ++i) { const int q = tidl + 512 * i, tt = q / 48, o8 = q % 48, pos = (t0o & (SEQ_ - 1)) + tt; const size_t row = (size_t)(t0o + tt);
            ya[i][0] = *(const GAS v4u*)(Z + row * NZ + o8 * 8);
            ya[i][1] = *(const GAS v4u*)(Z + row * NZ + 384 + o8 * 8);
            ya[i][2] = *(const GAS v4u*)(Z + (row - (pos >= 1 ? 1 : 0)) * NZ + 384 + o8 * 8);
            ya[i][3] = *(const GAS v4u*)(Z + (row - (pos >= 2 ? 2 : 0)) * NZ + 384 + o8 * 8); }
        { int cn = ci + F.G; asm volatile("" : "+s"(cn));
          if (cn < T_ / 32) MIX_PREFETCH(cn, tidl); }
#pragma unroll 1
        for (int tk = 0; tk < ((PROBE_MIX == 2) ? 8 : 4); ++tk) { const int tt = wave * 4 + (tk & 3);
            f32x2 v[3]; float s = 0.f;
#pragma unroll
            for (int i = 0; i < 3; ++i) { v[i] = *(const LAS f32x2*)(V + tt * 384 + 2 * lane + 128 * i); s += v[i].x + v[i].y; }
            const float mean = wave_sum(s) * (1.f / 384.f); float q = 0.f;
#pragma unroll
            for (int i = 0; i < 3; ++i) { v[i] = v[i] - mean; q += v[i].x * v[i].x + v[i].y * v[i].y; }
            const float rstd = 1.f / sqrtf(wave_sum(q) * (1.f / 384.f) + LN_EPS);
#pragma unroll
            for (int i = 0; i < 3; ++i) { const int c = 2 * lane + 128 * i; const f32x2 gg = *(const f32x2*)(lg + c), bb = *(const f32x2*)(lb + c);
                f32x2 o = v[i] * rstd * gg + bb; o.x = o.x * sigmoidf_(o.x); o.y = o.y * sigmoidf_(o.y);
                if (GEMM2_FP8) *(GAS unsigned short*)((unsigned char*)Y + (size_t)(t0 + tt) * D_ + 384 + c) = (unsigned short)pk4_fp8(o.x, o.y, 0.f, 0.f);
                else *(GAS unsigned*)(Y + (size_t)(t0 + tt) * D_ + 384 + c) = pk2(o.x, o.y); }
        }
#pragma unroll
        for (int i = 0; i < 3; ++i) { const int q = tid + 512 * i, tt = q / 48, o8 = q % 48, pos = s0 + tt; const size_t row = (size_t)(t0 + tt);
            const v4u gb = ya[i][0], x0 = ya[i][1]; v4u x1 = ya[i][2], x2 = ya[i][3];
            if (pos < 1) x1 = (v4u){0u, 0u, 0u, 0u};
            if (pos < 2) x2 = (v4u){0u, 0u, 0u, 0u};
            const f32x4 w2a = *(const f32x4*)(wA + 2 * 384 + o8 * 8), w2b = *(const f32x4*)(wA + 2 * 384 + o8 * 8 + 4);
            const f32x4 w1a = *(const f32x4*)(wA + 1 * 384 + o8 * 8), w1b = *(const f32x4*)(wA + 1 * 384 + o8 * 8 + 4);
            const f32x4 w0a = *(const f32x4*)(wA + o8 * 8), w0b = *(const f32x4*)(wA + o8 * 8 + 4);
            float o[8];
            const unsigned gbw[4] = {gb.x, gb.y, gb.z, gb.w}, x0w[4] = {x0.x, x0.y, x0.z, x0.w}, x1w[4] = {x1.x, x1.y, x1.z, x1.w}, x2w[4] = {x2.x, x2.y, x2.z, x2.w};
            const float w2[8] = {w2a.x, w2a.y, w2a.z, w2a.w, w2b.x, w2b.y, w2b.z, w2b.w}, w1[8] = {w1a.x, w1a.y, w1a.z, w1a.w, w1b.x, w1b.y, w1b.z, w1b.w}, w0[8] = {w0a.x, w0a.y, w0a.z, w0a.w, w0b.x, w0b.y, w0b.z, w0b.w};
#pragma unroll
            for (int e = 0; e < 4; ++e) {
                o[2 * e] = bflo(gbw[e]) * (w2[2 * e] * bflo(x0w[e]) + w1[2 * e] * bflo(x1w[e]) + w0[2 * e] * bflo(x2w[e]));
                o[2 * e + 1] = bfhi(gbw[e]) * (w2[2 * e + 1] * bfhi(x0w[e]) + w1[2 * e + 1] * bfhi(x1w[e]) + w0[2 * e + 1] * bfhi(x2w[e])); }
            if (GEMM2_FP8) { v2u ov; ov.x = pk4_fp8(o[0], o[1], o[2], o[3]); ov.y = pk4_fp8(o[4], o[5], o[6], o[7]); *(GAS v2u*)((unsigned char*)Y + row * D_ + o8 * 8) = ov; }
            else { v4u ov; ov.x = pk2(o[0], o[1]); ov.y = pk2(o[2], o[3]); ov.z = pk2(o[4], o[5]); ov.w = pk2(o[6], o[7]);
            *(GAS v4u*)(Y + row * D_ + o8 * 8) = ov; } }
        __syncthreads();
    }
#undef MIX_PREFETCH
}

__device__ __forceinline__ void top2of4(float q0, float q1, float q2, float q3, float& a1, int& i1, float& a2, int& i2) {
    a1 = q0; i1 = 0; a2 = -1.f; i2 = 1;
#define T2STEP(qv, r) { const bool gt = (qv) > a1; const bool g2 = (qv) > a2; const float na2 = gt ? a1 : (g2 ? (qv) : a2); const int ni2 = gt ? i1 : (g2 ? (r) : i2); \
        a1 = gt ? (qv) : a1; i1 = gt ? (r) : i1; a2 = na2; i2 = ni2; }
    T2STEP(q1, 1) T2STEP(q2, 2) T2STEP(q3, 3)
#undef T2STEP
}
__device__ __forceinline__ void p4_ln_router(Frame& F, const Args& A, int l) {
    LAS unsigned char* lds = F.lds;
    LAS int* cntl = (LAS int*)(lds + 66048); LAS int* basel = cntl + 32; LAS int* sel = cntl + 64; LAS int* lpos = cntl + 64 + 256;
    const bf16* U = (const bf16*)(F.ws + WS_U); bf16* HB = (bf16*)(F.ws + WS_HB); unsigned char* H8 = F.ws + WS_H8; const bf16* WRT = (const bf16*)(F.ws + WS_WRT);
    int* route = (int*)(F.ws + WS_ROUTE); int* lists = (int*)(F.ws + WS_LISTS);
    unsigned* counts = F.ctl + CW_CNT + l * 32 * 64;
    const float* g = A.in[I_LMG] + l * D_; const float* b = A.in[I_LMB] + l * D_; const float* rb = A.in[I_RB];
    int tid = F.tid; asm volatile("" : "+v"(tid));
    const int lane = tid & 63, wave = F.wave, fr = lane & 15, fq = lane >> 4;
    for (int q = tid; q < 32 * 128; q += 512) { const int e = q >> 7, c = q & 127; *(LAS v4u*)(lds + e * 2064 + c * 16) = *(const GAS v4u*)(WRT + e * 1024 + c * 8); }
    if (tid < 32) cntl[tid] = 0;
    f32x4 gv[4], bv[4];
#pragma unroll
    for (int j = 0; j < 4; ++j) { gv[j] = *(const f32x4*)(g + 4 * lane + 256 * j); bv[j] = *(const f32x4*)(b + 4 * lane + 256 * j); }
    __syncthreads();
    for (int blk = F.vcu; blk < T_ / 128; blk += F.G) {
#pragma unroll 1
        for (int i = 0; i < 16; i += 4) { const size_t m = (size_t)(blk * 128 + wave * 16 + i);
            v2u q[4][4];
#pragma unroll
            for (int u = 0; u < 4; ++u) { const GAS v2u* up = (const GAS v2u*)(U + (m + u) * D_) + lane;
#pragma unroll
                for (int j = 0; j < 4; ++j) q[u][j] = up[64 * j]; }
#pragma unroll
            for (int u = 0; u < 4; ++u) { f32x4 v[4]; float s = 0.f;
#pragma unroll
                for (int j = 0; j < 4; ++j) { v[j] = (f32x4){bflo(q[u][j].x), bfhi(q[u][j].x), bflo(q[u][j].y), bfhi(q[u][j].y)}; s += (v[j].x + v[j].y) + (v[j].z + v[j].w); }
                const float mean = wave_sum(s) * (1.f / D_); float s2 = 0.f;
#pragma unroll
                for (int j = 0; j < 4; ++j) { v[j] = v[j] - mean; s2 += (v[j].x * v[j].x + v[j].y * v[j].y) + (v[j].z * v[j].z + v[j].w * v[j].w); }
                const float rstd = 1.f / sqrtf(wave_sum(s2) * (1.f / D_) + LN_EPS);
                GAS v2u* o8 = (GAS v2u*)(HB + (m + u) * D_) + lane; GAS unsigned* o4 = (GAS unsigned*)(H8 + (m + u) * D_) + lane;
#pragma unroll
                for (int j = 0; j < 4; ++j) { const f32x4 o = v[j] * rstd * gv[j] + bv[j]; v2u w; w.x = pk2(o.x, o.y); w.y = pk2(o.z, o.w); o8[64 * j] = w; o4[64 * j] = pk4_fp8(o.x, o.y, o.z, o.w); } }
        }
        VM_WAIT(); asm volatile("" ::: "memory");
        const int token = blk * 128 + wave * 16 + fr;
        f32x4 acc0 = (f32x4){0.f, 0.f, 0.f, 0.f}, acc1 = (f32x4){0.f, 0.f, 0.f, 0.f};
        const bf16* hrow = HB + (size_t)token * D_ + fq * 8;
#pragma unroll 16
        for (int k = 0; k < 32; ++k) { const int kk = k * 32 + fq * 8;
            const bf16x8 hf = *(const GAS bf16x8*)(hrow + k * 32);
            const bf16x8 w0 = *(const LAS bf16x8*)(lds + fr * 2064 + kk * 2), w1 = *(const LAS bf16x8*)(lds + (16 + fr) * 2064 + kk * 2);
            acc0 = __builtin_amdgcn_mfma_f32_16x16x32_bf16(w0, hf, acc0, 0, 0, 0);
            acc1 = __builtin_amdgcn_mfma_f32_16x16x32_bf16(w1, hf, acc1, 0, 0, 0);
        }
        float p0[4], p1[4]; float mx = -3.0e38f;
#pragma unroll
        for (int r = 0; r < 4; ++r) { p0[r] = acc0[r] + rb[4 * fq + r]; p1[r] = acc1[r] + rb[16 + 4 * fq + r]; mx = fmaxf(mx, fmaxf(p0[r], p1[r])); }
        mx = fmaxf(mx, __shfl_xor(mx, 16)); mx = fmaxf(mx, __shfl_xor(mx, 32));
#pragma unroll
        for (int r = 0; r < 4; ++r) { p0[r] = __expf(p0[r] - mx); p1[r] = __expf(p1[r] - mx); }
        float a1, a2, c1, c2; int ia1, ia2, ic1, ic2;
        top2of4(p0[0], p0[1], p0[2], p0[3], a1, ia1, a2, ia2); top2of4(p1[0], p1[1], p1[2], p1[3], c1, ic1, c2, ic2);
        const float sc0 = a1 + a2, sc1 = c1 + c2;
        float bs = sc0; int bg = fq; if (sc1 > sc0) { bs = sc1; bg = 4 + fq; }
#pragma unroll
        for (int off = 16; off <= 32; off <<= 1) { const float os = __shfl_xor(bs, off); const int og = __shfl_xor(bg, off); if (os > bs || (os == bs && og < bg)) { bs = os; bg = og; } }
        if ((bg & 3) == fq) {
            const bool hi = bg >= 4;
            const float pa = hi ? c1 : a1, pb = hi ? c2 : a2; const int ia = hi ? ic1 : ia1, ib = hi ? ic2 : ia2;
            const int ea = bg * 4 + ia, eb = bg * 4 + ib; const float inv = 1.0f / (pa + pb);
            const int tokl = wave * 16 + fr;
            const int la = atomicAdd((int*)&cntl[ea], 1), lb2 = atomicAdd((int*)&cntl[eb], 1);
            sel[tokl * 2] = ea; sel[tokl * 2 + 1] = eb; lpos[tokl * 2] = la; lpos[tokl * 2 + 1] = lb2;
            int* rt = route + (size_t)token * 8; rt[0] = ea; rt[2] = eb; rt[4] = __float_as_int(pa * inv); rt[5] = __float_as_int(pb * inv);
        }
        __syncthreads();
        if (tid < 32) { const int c = cntl[tid]; basel[tid] = c ? (int)__hip_atomic_fetch_add(counts + tid * 64, (unsigned)c, RLX_AGENT) : 0; }
        __syncthreads();
        if (tid < 256) { const int tokl = tid >> 1, k = tid & 1, e = sel[tid], pos = basel[e] + lpos[tid], tok = blk * 128 + tokl;
            lists[(size_t)e * 65536 + pos] = tok * 2 + k; route[(size_t)tok * 8 + 1 + 2 * k] = pos; }
        __syncthreads();
        if (tid < 32) cntl[tid] = 0;
        __syncthreads();
    }
}

__device__ __forceinline__ void moe_table(Frame& F, int l) {
    LAS int* tab = (LAS int*)(F.lds + TAB_OFF);
    __syncthreads();
    if (F.tid < 32) tab[40 + F.tid] = (int)__hip_atomic_load(F.ctl + CW_CNT + (l * 32 + F.tid) * 64, RLX_AGENT);
    __syncthreads();
    if (F.tid == 0) { int s = 0; for (int e = 0; e < 32; ++e) { tab[e] = s; s += (tab[40 + e] + 255) >> 8; } tab[32] = s; }
    __syncthreads();
}

__device__ __forceinline__ void p7_combine_ln(Frame& F, const Args& A, int l) {
    const LAS int* tab = (const LAS int*)(F.lds + TAB_OFF);
    bf16* HB = (bf16*)(F.ws + WS_HB); const unsigned char* Y2S = F.ws + WS_Y2S; const int* route = (const int*)(F.ws + WS_ROUTE);
    const float* g = A.in[I_LFG] + l * D_; const float* b = A.in[I_LFB] + l * D_;
    int lane = F.lane; asm volatile("" : "+v"(lane));
    const int gw = F.vcu * NWAVES + F.wave, NGW = F.G * NWAVES;
    f32x4 gv[4], bv[4];
#pragma unroll
    for (int j = 0; j < 4; ++j) { gv[j] = *(const f32x4*)(g + 4 * lane + 256 * j); bv[j] = *(const f32x4*)(b + 4 * lane + 256 * j); }
    const bool last = (l == NL - 1);
    for (int m0 = gw * 2; m0 < T_; m0 += NGW * 2) {
        v2u hq[2][4]; unsigned aq[2][4], cq[2][4]; float g0[2], g1[2];
#pragma unroll
        for (int u = 0; u < 2; ++u) { const int m = m0 + u; const int* rt = route + (size_t)m * 8;
            const int e0 = rt[0], q0 = rt[1], e1 = rt[2], q1 = rt[3]; g0[u] = __int_as_float(rt[4]); g1[u] = __int_as_float(rt[5]);
            const size_t r0 = (size_t)tab[e0] * 256 + q0, r1 = (size_t)tab[e1] * 256 + q1;
            const GAS v2u* hp = (const GAS v2u*)(HB + (size_t)m * D_) + lane; const GAS unsigned* ya = (const GAS unsigned*)(Y2S + r0 * D_) + lane; const GAS unsigned* yb = (const GAS unsigned*)(Y2S + r1 * D_) + lane;
#pragma unroll
            for (int j = 0; j < 4; ++j) { hq[u][j] = hp[64 * j]; aq[u][j] = ya[64 * j]; cq[u][j] = yb[64 * j]; } }
#pragma unroll
        for (int u = 0; u < 2; ++u) { const int m = m0 + u; f32x4 v[4]; float s = 0.f;
#pragma unroll
            for (int j = 0; j < 4; ++j) { const v2u h = hq[u][j]; const unsigned a = aq[u][j], c = cq[u][j];
                const f32x2 a01 = __builtin_amdgcn_cvt_pk_f32_fp8((int)a, false), a23 = __builtin_amdgcn_cvt_pk_f32_fp8((int)a, true), c01 = __builtin_amdgcn_cvt_pk_f32_fp8((int)c, false), c23 = __builtin_amdgcn_cvt_pk_f32_fp8((int)c, true);
                v[j].x = ALPHA * bflo(h.x) + g0[u] * a01.x + g1[u] * c01.x; v[j].y = ALPHA * bfhi(h.x) + g0[u] * a01.y + g1[u] * c01.y;
                v[j].z = ALPHA * bflo(h.y) + g0[u] * a23.x + g1[u] * c23.x; v[j].w = ALPHA * bfhi(h.y) + g0[u] * a23.y + g1[u] * c23.y;
                s += (v[j].x + v[j].y) + (v[j].z + v[j].w); }
            const float mean = wave_sum(s) * (1.f / D_); float s2 = 0.f;
#pragma unroll
            for (int j = 0; j < 4; ++j) { v[j] = v[j] - mean; s2 += (v[j].x * v[j].x + v[j].y * v[j].y) + (v[j].z * v[j].z + v[j].w * v[j].w); }
            const float rstd = 1.f / sqrtf(wave_sum(s2) * (1.f / D_) + LN_EPS);
            if (last) { GAS f32x4* o = (GAS f32x4*)(A.out + (size_t)m * D_) + lane;
#pragma unroll
                for (int j = 0; j < 4; ++j) o[64 * j] = v[j] * rstd * gv[j] + bv[j];
            } else { GAS v2u* o8 = (GAS v2u*)(HB + (size_t)m * D_) + lane;
#pragma unroll
                for (int j = 0; j < 4; ++j) { const f32x4 o = v[j] * rstd * gv[j] + bv[j]; v2u w; w.x = pk2(o.x, o.y); w.y = pk2(o.z, o.w); o8[64 * j] = w; } }
        }
    }
}

#ifndef PH_NOINLINE
#define PH_NOINLINE __forceinline__
#endif
PH_NOINLINE __device__ void run_gemm1(LAS unsigned char* lds, unsigned char* ws, int l, int G, int c) {
    pg8::DenseOrder S; S.init(ws + WS_HB, ws + WS_WIN + (size_t)l * N1 * 1024 * 2, T_, N1, D_, G, c, 1);
    pg8::EpiZ E{(bf16*)(ws + WS_Z)};
    if (GEMM_SIMPLE_MASK & 1) pg8::gemm_phase_simple(S, E); else pg8::gemm_phase(lds, S, E);
}
PH_NOINLINE __device__ void run_gemm_probe(LAS unsigned char* lds, unsigned char* ws, int G, int c) {
    pg8::DenseOrder S; S.init(ws + WS_HB, ws + WS_WIN, T_, 256 * (PROBE_EXTRA_NN ? PROBE_EXTRA_NN : 1), D_, G, c);
    pg8::EpiPlain E{(bf16*)(ws + WS_Y), 2048};
    pg8::gemm_phase(lds, S, E);
}
PH_NOINLINE __device__ void run_gemm2(LAS unsigned char* lds, unsigned char* ws, int l, int G, int c) {
    pg8::EpiU E{(const bf16*)(ws + WS_HB), (bf16*)(ws + WS_U)};
    if (GEMM2_FP8) { pg8::DenseRowsOrder S; int kq = D_ / 2; asm volatile("" : "+s"(kq)); S.init(ws + WS_Y, ws + WS_WOUT + (size_t)l * 1024 * 1024, T_, D_, kq, G, c); pg8::gemm_phase<pg8::EpiU, pg8::DenseRowsOrder, true>(lds, S, E); }
    else { pg8::DenseOrder S; S.init(ws + WS_Y, ws + WS_WOUT + (size_t)l * 1024 * 1024 * 2, T_, D_, D_, G, c); pg8::gemm_phase(lds, S, E); }
}
PH_NOINLINE __device__ void run_gemm5(LAS unsigned char* lds, unsigned char* ws, int l, int G, int c) {
    const LAS int* tab = (const LAS int*)(lds + TAB_OFF);
    pg8::MoeGatherOrder S; S.A = (const char*)(ws + WS_H8); S.Bt = (const char*)(ws + WS_WGU + (size_t)l * NE * 1024 * 1024); S.bexp = (size_t)1024 * 1024;
    int kq = D_ / 2; asm volatile("" : "+s"(kq));
    S.K = kq; S.nN = 4; S.nwg = tab[32] * 4; S.G = G; S.c = c; S.tab = tab; S.lists = (const int*)(ws + WS_LISTS);
    pg8::EpiHid E{ws + WS_HID};
    pg8::gemm_phase<pg8::EpiHid, pg8::MoeGatherOrder, true>(lds, S, E);
}
PH_NOINLINE __device__ void run_gemm6(LAS unsigned char* lds, unsigned char* ws, int l, int G, int c) {
    const LAS int* tab = (const LAS int*)(lds + TAB_OFF);
    pg8::MoeRowsOrder S; S.A = (const char*)(ws + WS_HID); S.Bt = (const char*)(ws + WS_WD + (size_t)l * NE * 1024 * 512); S.bexp = (size_t)1024 * 512;
    int kq = DE / 2; asm volatile("" : "+s"(kq));
    S.K = kq; S.nN = 4; S.nwg = tab[32] * 4; S.G = G; S.c = c; S.tab = tab; S.lists = nullptr;
    pg8::EpiPlain8 E{ws + WS_Y2S, D_};
    pg8::gemm_phase<pg8::EpiPlain8, pg8::MoeRowsOrder, true>(lds, S, E);
}

__global__ void __launch_bounds__(NWAVES * 64, 2) mk_fwd(Args args) {
    extern __shared__ __attribute__((aligned(16))) unsigned char lds_raw[];
    Frame F;
    F.lds = (LAS unsigned char*)lds_raw;
    F.tid = threadIdx.x; F.lane = F.tid & 63; F.wave = __builtin_amdgcn_readfirstlane(F.tid >> 6);
    F.G = gridDim.x; { const int bx = blockIdx.x; F.vcu = (F.G % 8 == 0) ? (bx % 8) * (F.G / 8) + bx / 8 : bx; }
    F.ws = args.ws; F.ctl = (unsigned*)(args.ws + WS_CTL);
    for (int u = F.tid; u < (LDS_BYTES - LDSCTL_OFF) / 4; u += NWAVES * 64) ((LAS unsigned*)(F.lds + LDSCTL_OFF))[u] = 0u;
    __syncthreads();
    volatile LAS unsigned* MISC = (volatile LAS unsigned*)(F.lds + MISC_OFF);
    XcdBarrier bar; bar.bar = F.ctl + CW_BAR; bar.x = 0; bar.st = nullptr;
    if (MK_N_LAUNCHES == 1) bar = xcd_barrier_post(F.ctl + CW_BAR, MISC + 8);
    const int lo = args.ph_lo, hi = args.ph_hi;
#define IN(k) (lo <= (k) && (k) < hi)
#define SEAM(k) do { if (MK_N_LAUNCHES == 1 && (k) + 1 < hi) xcd_barrier(bar); } while (0)
    if (REPEAT_MASK & 256) { for (int rep = 0; rep < 10; ++rep) xcd_barrier(bar); }
    if ((PH_MASK & 1) && IN(0)) { for (int rep = 0; rep < ((REPEAT_MASK & 1) ? 2 : 1); ++rep) { p0_prologue(F, args); SEAM(0); } }
#pragma unroll 1
    for (int l = 0; l < NL; ++l) {
        const int pb = 1 + 7 * l;
        if ((PH_MASK & 2) && IN(pb + 0)) { for (int rep = 0; rep < ((REPEAT_MASK & 2) ? 2 : 1); ++rep) { run_gemm1(F.lds, F.ws, l, F.G, (int)blockIdx.x); SEAM(pb + 0); }
            if (PROBE_EXTRA_NN && l == 0) { run_gemm_probe(F.lds, F.ws, F.G, (int)blockIdx.x); xcd_barrier(bar); } }
        if ((PH_MASK & 4) && IN(pb + 1)) { for (int rep = 0; rep < ((REPEAT_MASK & 4) ? 2 : 1); ++rep) { p2_mixer(F, args, l); SEAM(pb + 1); } }
        if ((PH_MASK & 8) && IN(pb + 2)) { for (int rep = 0; rep < ((REPEAT_MASK & 8) ? 2 : 1); ++rep) { run_gemm2(F.lds, F.ws, l, F.G, (int)blockIdx.x); SEAM(pb + 2); } }
        if ((PH_MASK & 16) && IN(pb + 3)) {
            if (REPEAT_MASK & 16) { p4_ln_router(F, args, l); SEAM(pb + 3);
                if (blockIdx.x == 0 && F.tid < 32) __hip_atomic_store(F.ctl + CW_CNT + (l * 32 + F.tid) * 64, 0u, RLX_AGENT);
                SEAM(pb + 3); }
            p4_ln_router(F, args, l); SEAM(pb + 3); }
        if ((PH_MASK & 32) && IN(pb + 4)) { for (int rep = 0; rep < ((REPEAT_MASK & 32) ? 2 : 1); ++rep) { moe_table(F, l); run_gemm5(F.lds, F.ws, l, F.G, (int)blockIdx.x); SEAM(pb + 4); } }
        if ((PH_MASK & 64) && IN(pb + 5)) { for (int rep = 0; rep < ((REPEAT_MASK & 64) ? 2 : 1); ++rep) { moe_table(F, l); run_gemm6(F.lds, F.ws, l, F.G, (int)blockIdx.x); SEAM(pb + 5); } }
        if ((PH_MASK & 128) && IN(pb + 6)) { for (int rep = 0; rep < (((REPEAT_MASK & 128) && l == NL - 1) ? 2 : 1); ++rep) { moe_table(F, l); p7_combine_ln(F, args, l); if (rep == 0) SEAM(pb + 6); else xcd_barrier(bar); } }
    }
#undef IN
#undef SEAM
}

extern "C" void kernel_launch(void* const* d_in, const int* in_sizes, int n_in, void* d_out, int out_size, void* d_ws, size_t ws_size, hipStream_t stream) {
    static int grid = 0;
    if (grid == 0) {
        if (n_in != 21 || out_size != T_ * D_ || ws_size < WS_END) { fprintf(stderr, "kernel_launch: unexpected problem (n_in %d, out %d, ws %zu); nothing launched\n", n_in, out_size, ws_size); grid = -1; return; }
        int dev = 0, cus = 0, per_cu = 0;
        if (hipGetDevice(&dev) != hipSuccess || hipDeviceGetAttribute(&cus, hipDeviceAttributeMultiprocessorCount, dev) != hipSuccess) { grid = -1; return; }
        if (hipFuncSetAttribute((const void*)mk_fwd, hipFuncAttributeMaxDynamicSharedMemorySize, LDS_BYTES) != hipSuccess) { fprintf(stderr, "kernel_launch: hipFuncSetAttribute failed\n"); grid = -1; return; }
        if (hipOccupancyMaxActiveBlocksPerMultiprocessor(&per_cu, (const void*)mk_fwd, NWAVES * 64, LDS_BYTES) != hipSuccess || per_cu < 1) { fprintf(stderr, "kernel_launch: occupancy query says %d\n", per_cu); }
        (void)hipGetLastError();
        grid = cus;
    }
    if (grid < 0) return;
    (void)hipMemsetAsync((char*)d_ws + WS_CTL, 0, CTL_ZERO_BYTES, stream);
    Args a{};
    for (int i = 0; i < 21; ++i) a.in[i] = (const float*)d_in[i];
    a.out = (float*)d_out; a.ws = (unsigned char*)d_ws;
    if (MK_N_LAUNCHES == 1) { a.ph_lo = 0; a.ph_hi = NPH; hipLaunchKernelGGL(mk_fwd, dim3(grid), dim3(NWAVES * 64), LDS_BYTES, stream, a); }
    else for (int p = 0; p < NPH; ++p) { a.ph_lo = p; a.ph_hi = p + 1; hipLaunchKernelGGL(mk_fwd, dim3(grid), dim3(NWAVES * 64), LDS_BYTES, stream, a); }
}
```

```cpp
#include <hip/hip_runtime.h>
#include <cstdio>
#include <cstdint>

#ifndef MK_N_LAUNCHES
#define MK_N_LAUNCHES 1
#endif
#ifndef PH_MASK
#define PH_MASK 0xff
#endif
#ifndef REPEAT_MASK
#define REPEAT_MASK 0
#endif
#ifndef GEMM2_FP8
#define GEMM2_FP8 1
#endif
#ifndef PROBE_P0
#define PROBE_P0 0
#endif
#ifndef PROBE_MIX
#define PROBE_MIX 0
#endif
#ifndef PROBE_EXTRA_NN
#define PROBE_EXTRA_NN 0
#endif
#ifndef GEMM_SIMPLE_MASK
#define GEMM_SIMPLE_MASK 0
#endif

#define GAS __attribute__((address_space(1)))
#define LAS __attribute__((address_space(3)))
typedef unsigned short bf16;
typedef unsigned v4u __attribute__((ext_vector_type(4)));
typedef unsigned v2u __attribute__((ext_vector_type(2)));
typedef float f32x4 __attribute__((ext_vector_type(4)));
typedef float f32x2 __attribute__((ext_vector_type(2)));
typedef short bf16x8 __attribute__((ext_vector_type(8)));
#define RLX_AGENT __ATOMIC_RELAXED, __HIP_MEMORY_SCOPE_AGENT
#define LDS_WAIT() asm volatile("s_waitcnt lgkmcnt(0)" ::: "memory")
#define VM_WAIT() asm volatile("s_waitcnt vmcnt(0)" ::: "memory")

constexpr int T_ = 32768, D_ = 1024, SEQ_ = 4096, NL = 2, NE = 32, DE = 512;
constexpr int DIN = 2176, N1 = 2304, NZ = 1408;
constexpr float ALPHA = 1.41421356237f, LN_EPS = 1e-5f;
constexpr int NPH = 1 + 7 * NL;

constexpr size_t MiB = 1u << 20;
constexpr size_t WS_CTL = 0, CTL_ZERO_BYTES = 1 * MiB;
constexpr size_t WS_ROUTE = 1 * MiB;
constexpr size_t WS_WRT = 2 * MiB;
constexpr size_t WS_LISTS = 3 * MiB;
constexpr size_t WS_WIN = 11 * MiB;
constexpr size_t WS_WOUT = 20 * MiB;
constexpr size_t WS_WGU = 24 * MiB;
constexpr size_t WS_H8 = 88 * MiB;
constexpr size_t WS_WD = 152 * MiB;
constexpr size_t WS_HB = 216 * MiB;
constexpr size_t WS_Z = 280 * MiB;
constexpr size_t WS_Y = 368 * MiB;
constexpr size_t WS_U = 280 * MiB;
constexpr size_t WS_HID = 280 * MiB;
constexpr size_t WS_Y2S = 352 * MiB;
constexpr size_t WS_END = 496 * MiB;
constexpr int CW_TMO = 0, CW_BAR = 4096, CW_CNT = 16384;

constexpr int RING_BYTES = 131072, LDSCTL_OFF = RING_BYTES, MISC_OFF = LDSCTL_OFF + 320, TAB_OFF = LDSCTL_OFF + 1024;
constexpr int LDS_BYTES = 147456;

__device__ __forceinline__ unsigned f2bf(float f) { unsigned u = __builtin_bit_cast(unsigned, f); return (u + 0x7fffu + ((u >> 16) & 1u)) >> 16; }
__device__ __forceinline__ unsigned pk2(float lo, float hi) { return f2bf(lo) | (f2bf(hi) << 16); }
__device__ __forceinline__ float bflo(unsigned u) { return __builtin_bit_cast(float, u << 16); }
__device__ __forceinline__ float bfhi(unsigned u) { return __builtin_bit_cast(float, u & 0xffff0000u); }
__device__ __forceinline__ float wave_sum(float v) {
#pragma unroll
    for (int o = 1; o < 64; o <<= 1) v += __shfl_xor(v, o);
    return v;
}
__device__ __forceinline__ unsigned pk4_fp8(float a, float b, float c, float d) {
    int v = 0; v = __builtin_amdgcn_cvt_pk_fp8_f32(a, b, v, false); v = __builtin_amdgcn_cvt_pk_fp8_f32(c, d, v, true); return (unsigned)v; }
__device__ __forceinline__ float sigmoidf_(float x) { return __builtin_amdgcn_rcpf(1.0f + __expf(-x)); }

namespace pg8 {
#define PG8_LAS __attribute__((address_space(3)))
typedef int v8i __attribute__((ext_vector_type(8)));
typedef int v4i __attribute__((ext_vector_type(4)));
constexpr int BM = 256, BK = 64, HALF = 128, HTB = HALF * BK * 2, STAGE_BYTES = 8 * HTB, NXCD = 8, WGM = 8;
__host__ __device__ __forceinline__ int lds_byte(int r, int c) { const int st = (r >> 4) * 2 + (c >> 5), rr = r & 15, cc = c & 31, ob = rr * 64 + cc * 2; return st * 1024 + (ob ^ (((ob >> 9) & 1) << 5)); }
__host__ __device__ __forceinline__ void stage_rc(int b, int& R, int& C) { const int st = b / 1024, sb = b % 1024, swz = sb ^ (((sb >> 9) & 1) << 5); R = (st >> 1) * 16 + swz / 64; C = (st & 1) * 32 + (swz % 64) / 2; }
__host__ __device__ __forceinline__ int perm32(int rho) { const int n = rho >> 4, i = rho & 15; return 8 * (i >> 2) + 4 * n + (i & 3); }

struct Unit { int pm, pn, e, j, rh; };

__device__ __forceinline__ int xcd_remap(int wgid, int nwg) { const int q = nwg / NXCD, r = nwg % NXCD, xcd = wgid % NXCD, off = wgid / NXCD; return (xcd < r ? xcd * (q + 1) : r * (q + 1) + (xcd - r) * q) + off; }

struct DenseOrder {
    static constexpr bool GATHER = false, HAS_HALF = true, HAS_RH = false;
    const char* A; const char* Bt; int K, nM, nN, nwg, G, c, nhalf;
    __device__ void init(const void* A_, const void* Bt_, int M, int N, int K_, int G_, int c_, int half_tile = 0) { A = (const char*)A_; Bt = (const char*)Bt_; K = K_; nM = M / BM; nN = N / BM - half_tile; nwg = nM * nN; G = G_; c = c_; nhalf = half_tile ? nM : 0; }
    __device__ bool next(int i, Unit& u) const {
        const long L = (long)i * G + c; if (L >= nwg + nhalf) return false;
        u.e = 0; u.j = 0; u.rh = -1;
        if (L >= nwg) { u.pm = (int)(L - nwg); u.pn = nN; return true; }
        const int wgid = xcd_remap((int)L, nwg);
        const int nig = WGM * nN, gid = wgid / nig, fm = gid * WGM, gsz = (nM - fm) < WGM ? (nM - fm) : WGM;
        u.pm = fm + ((wgid % nig) % gsz); u.pn = (wgid % nig) / gsz; return true;
    }
    __device__ __forceinline__ bool is_half(const Unit& u) const { return u.pn >= nN; }
    __device__ __forceinline__ int row_half(const Unit&) const { return -1; }
    __device__ __forceinline__ const char* a_tile(const Unit& u) const { return A + (size_t)u.pm * BM * K * 2; }
    __device__ __forceinline__ const char* b_tile(const Unit& u) const { return Bt + (size_t)u.pn * BM * K * 2; }
    __device__ __forceinline__ unsigned a_row_off(const Unit&, int r) const { return (unsigned)(r * K * 2); }
};
struct DenseRowsOrder : DenseOrder {
    static constexpr bool GATHER = true, HAS_HALF = false;
    __device__ __forceinline__ const char* a_tile(const Unit&) const { return A; }
    __device__ __forceinline__ unsigned a_row_off(const Unit& u, int r) const { return (unsigned)(u.pm * BM + r) * (unsigned)(K * 2); }
};
struct MoeOrder {
    static constexpr bool HAS_HALF = false, HAS_RH = true;
    __device__ __forceinline__ bool is_half(const Unit&) const { return false; }
    const char* A; const char* Bt; size_t bexp; int K, nN, nwg, G, c; const PG8_LAS int* tab; const int* lists;
    __device__ bool next(int i, Unit& u) const {
        const int L = i * G + c, nfull = (nwg / G) * G, rem = nwg - nfull;
        int uidx = L; u.rh = -1;
        if (L >= nfull) { if (2 * rem <= G) { if (L >= nfull + 2 * rem) return false; uidx = nfull + ((L - nfull) >> 1); u.rh = (L - nfull) & 1; } else if (L >= nwg) return false; }
        const int wgid = xcd_remap(uidx, nwg);
        const int t = wgid / nN; u.pn = wgid % nN; u.pm = t;
        const int e = tab[80 + t];
        u.e = e; u.j = t - tab[e]; return true;
    }
    __device__ __forceinline__ int row_half(const Unit& u) const { return u.rh; }
    __device__ __forceinline__ const char* b_tile(const Unit& u) const { return Bt + (size_t)u.e * bexp + (size_t)u.pn * BM * K * 2; }
};
struct MoeGatherOrder : MoeOrder {
    static constexpr bool GATHER = true;
    __device__ __forceinline__ const char* a_tile(const Unit&) const { return A; }
    __device__ __forceinline__ unsigned a_row_off(const Unit& u, int r) const {
        const int idx = u.j * BM + r, cnt = tab[40 + u.e];
        const int ii = idx < cnt ? idx : cnt - 1;
        const int tok = lists[(size_t)u.e * 65536 + ii] >> 1;
        return (unsigned)tok * (unsigned)(K * 2);
    }
};
struct MoeRowsOrder : MoeOrder {
    static constexpr bool GATHER = true;
    __device__ __forceinline__ const char* a_tile(const Unit&) const { return A; }
    __device__ __forceinline__ unsigned a_row_off(const Unit& u, int r) const { return (unsigned)(u.pm * BM + r) * (unsigned)(K * 2); }
};
struct MoeDenseOrder : MoeOrder {
    static constexpr bool GATHER = false;
    __device__ __forceinline__ const char* a_tile(const Unit& u) const { return A + (size_t)u.pm * BM * K * 2; }
    __device__ __forceinline__ unsigned a_row_off(const Unit&, int r) const { return (unsigned)(r * K * 2); }
};

__device__ __forceinline__ unsigned cvt_pk_bf16(float lo, float hi) { unsigned r; asm volatile("v_cvt_pk_bf16_f32 %0, %1, %2" : "=v"(r) : "v"(lo), "v"(hi)); return r; }

struct EpiZ {
    static constexpr bool PERM = true;
    bf16* Z;
    __device__ __forceinline__ void operator()(const f32x4 (&acc)[2][2][4][2], const Unit& u, int wr, int wc, int fr, int fq) const {
        const int row0 = u.pm * BM + wr * 64 + fr, cl = wc * 32 + 8 * fq;
        if (u.pn < 6) {
            const bool sg = u.pn >= 3;
            const int zc = (sg ? 768 + (u.pn - 3) * 128 : 384 + u.pn * 128) + cl;
#pragma unroll
            for (int ai = 0; ai < 2; ++ai)
#pragma unroll
                for (int m = 0; m < 4; ++m) {
                    f32x4 a0 = acc[ai][0][m][0], a1 = acc[ai][0][m][1], g0 = acc[ai][1][m][0], g1 = acc[ai][1][m][1];
                    if (sg) {
#pragma unroll
                        for (int q = 0; q < 4; ++q) { g0[q] = sigmoidf_(g0[q]); g1[q] = sigmoidf_(g1[q]); }
                    }
                    a0 = a0 * g0; a1 = a1 * g1;
                    v4u w; w.x = cvt_pk_bf16(a0[0], a0[1]); w.y = cvt_pk_bf16(a0[2], a0[3]); w.z = cvt_pk_bf16(a1[0], a1[1]); w.w = cvt_pk_bf16(a1[2], a1[3]);
                    *(v4u*)(Z + (size_t)(row0 + ai * HALF + m * 16) * NZ + zc) = w;
                }
        } else {
            int zb0, zb1;
            if (u.pn == 6) { zb0 = 0; zb1 = 128; } else if (u.pn == 7) { zb0 = 256; zb1 = 1152; } else { zb0 = 1280; zb1 = -1; }
#pragma unroll
            for (int ai = 0; ai < 2; ++ai)
#pragma unroll
                for (int m = 0; m < 4; ++m) {
                    bf16* rowp = Z + (size_t)(row0 + ai * HALF + m * 16) * NZ + cl;
#pragma unroll
                    for (int bj = 0; bj < 2; ++bj) {
                        const int zb = bj ? zb1 : zb0;
                        if (zb >= 0) { const f32x4 a0 = acc[ai][bj][m][0], a1 = acc[ai][bj][m][1];
                            v4u w; w.x = cvt_pk_bf16(a0[0], a0[1]); w.y = cvt_pk_bf16(a0[2], a0[3]); w.z = cvt_pk_bf16(a1[0], a1[1]); w.w = cvt_pk_bf16(a1[2], a1[3]);
                            *(v4u*)(rowp + zb) = w; }
                    }
                }
        }
    }
};
struct EpiU {
    static constexpr bool PERM = true;
    const bf16* H; bf16* U;
    __device__ __forceinline__ void operator()(const f32x4 (&acc)[2][2][4][2], const Unit& u, int wr, int wc, int fr, int fq) const {
        const int row0 = u.pm * BM + wr * 64 + fr, col0 = u.pn * BM + wc * 32 + 8 * fq;
#pragma unroll
        for (int ai = 0; ai < 2; ++ai)
#pragma unroll
            for (int m = 0; m < 4; ++m) {
                const size_t off = (size_t)(row0 + ai * HALF + m * 16) * D_ + col0;
#pragma unroll
                for (int bj = 0; bj < 2; ++bj) {
                    const v4u h = *(const v4u*)(H + off + bj * HALF);
                    const f32x4 a0 = acc[ai][bj][m][0], a1 = acc[ai][bj][m][1];
                    v4u w;
                    w.x = cvt_pk_bf16(ALPHA * bflo(h.x) + a0[0], ALPHA * bfhi(h.x) + a0[1]); w.y = cvt_pk_bf16(ALPHA * bflo(h.y) + a0[2], ALPHA * bfhi(h.y) + a0[3]);
                    w.z = cvt_pk_bf16(ALPHA * bflo(h.z) + a1[0], ALPHA * bfhi(h.z) + a1[1]); w.w = cvt_pk_bf16(ALPHA * bflo(h.w) + a1[2], ALPHA * bfhi(h.w) + a1[3]);
                    *(v4u*)(U + off + bj * HALF) = w;
                }
                if (m & 1) asm volatile("" ::: "memory");
            }
    }
};
struct EpiHid {
    static constexpr bool PERM = true;
    unsigned char* HID;
    __device__ __forceinline__ void operator()(const f32x4 (&acc)[2][2][4][2], const Unit& u, int wr, int wc, int fr, int fq) const {
        const int row0 = u.pm * BM + wr * 64 + fr, col0 = u.pn * 128 + wc * 32 + 8 * fq;
#pragma unroll
        for (int ai = 0; ai < 2; ++ai) { if (u.rh >= 0 && u.rh != ai) continue;
#pragma unroll
            for (int m = 0; m < 4; ++m) {
                f32x4 g0 = acc[ai][0][m][0], g1 = acc[ai][0][m][1]; const f32x4 u0 = acc[ai][1][m][0], u1 = acc[ai][1][m][1];
#pragma unroll
                for (int q = 0; q < 4; ++q) { g0[q] = g0[q] * sigmoidf_(g0[q]); g1[q] = g1[q] * sigmoidf_(g1[q]); }
                g0 = g0 * u0; g1 = g1 * u1;
                v2u w; w.x = pk4_fp8(g0[0], g0[1], g0[2], g0[3]); w.y = pk4_fp8(g1[0], g1[1], g1[2], g1[3]);
                *(v2u*)(HID + (size_t)(row0 + ai * HALF + m * 16) * DE + col0) = w;
            } }
    }
};
struct EpiPlain8 {
    static constexpr bool PERM = true;
    unsigned char* O; int ldc;
    __device__ __forceinline__ void operator()(const f32x4 (&acc)[2][2][4][2], const Unit& u, int wr, int wc, int fr, int fq) const {
        const int row0 = u.pm * BM + wr * 64 + fr, col0 = u.pn * BM + wc * 32 + 8 * fq;
#pragma unroll
        for (int ai = 0; ai < 2; ++ai) { if (u.rh >= 0 && u.rh != ai) continue;
#pragma unroll
            for (int m = 0; m < 4; ++m) {
                unsigned char* rowp = O + (size_t)(row0 + ai * HALF + m * 16) * ldc + col0;
#pragma unroll
                for (int bj = 0; bj < 2; ++bj) { const f32x4 a0 = acc[ai][bj][m][0], a1 = acc[ai][bj][m][1];
                    v2u w; w.x = pk4_fp8(a0[0], a0[1], a0[2], a0[3]); w.y = pk4_fp8(a1[0], a1[1], a1[2], a1[3]);
                    *(v2u*)(rowp + bj * HALF) = w; }
            } }
    }
};
struct EpiPlain {
    static constexpr bool PERM = true;
    bf16* O; int ldc;
    __device__ __forceinline__ void operator()(const f32x4 (&acc)[2][2][4][2], const Unit& u, int wr, int wc, int fr, int fq) const {
        const int row0 = u.pm * BM + wr * 64 + fr, col0 = u.pn * BM + wc * 32 + 8 * fq;
#pragma unroll
        for (int ai = 0; ai < 2; ++ai)
#pragma unroll
            for (int m = 0; m < 4; ++m) {
                bf16* rowp = O + (size_t)(row0 + ai * HALF + m * 16) * ldc + col0;
#pragma unroll
                for (int bj = 0; bj < 2; ++bj) { const f32x4 a0 = acc[ai][bj][m][0], a1 = acc[ai][bj][m][1];
                    v4u w; w.x = cvt_pk_bf16(a0[0], a0[1]); w.y = cvt_pk_bf16(a0[2], a0[3]); w.z = cvt_pk_bf16(a1[0], a1[1]); w.w = cvt_pk_bf16(a1[2], a1[3]);
                    *(v4u*)(rowp + bj * HALF) = w; }
            }
    }
};

template <class Epi, class Sched>
__device__ __forceinline__ void gemm_phase_simple(const Sched& S, const Epi& E) {
    int tid = threadIdx.x; asm volatile("" : "+v"(tid));
    const int wid = __builtin_amdgcn_readfirstlane(tid >> 6), lane = tid & 63, wr = wid >> 2, wc = wid & 3, fr = lane & 15, fq = lane >> 4;
    const int K = S.K;
    Unit cur;
    for (int ui = 0; S.next(ui, cur); ++ui) {
        f32x4 acc[2][2][4][2];
#pragma unroll
        for (int a = 0; a < 2; ++a)
#pragma unroll
            for (int b = 0; b < 2; ++b)
#pragma unroll
                for (int m = 0; m < 4; ++m)
#pragma unroll
                    for (int n = 0; n < 2; ++n) acc[a][b][m][n] = (f32x4){0.f, 0.f, 0.f, 0.f};
        const char* at = S.a_tile(cur); const char* bt = S.b_tile(cur);
        const char* ap[2][4]; const char* bp[2][2];
#pragma unroll
        for (int ai = 0; ai < 2; ++ai)
#pragma unroll
            for (int m = 0; m < 4; ++m) ap[ai][m] = at + S.a_row_off(cur, ai * HALF + wr * 64 + m * 16 + fr) + fq * 16;
#pragma unroll
        for (int bj = 0; bj < 2; ++bj)
#pragma unroll
            for (int n = 0; n < 2; ++n) { const int rho = n * 16 + fr; bp[bj][n] = bt + (size_t)(bj * HALF + wc * 32 + (Epi::PERM ? perm32(rho) : rho)) * K * 2 + fq * 16; }
        for (int k0 = 0; k0 < K; k0 += 32) {
            bf16x8 a[2][4], b[2][2];
#pragma unroll
            for (int ai = 0; ai < 2; ++ai)
#pragma unroll
                for (int m = 0; m < 4; ++m) a[ai][m] = *(const bf16x8*)(ap[ai][m] + k0 * 2);
#pragma unroll
            for (int bj = 0; bj < 2; ++bj)
#pragma unroll
                for (int n = 0; n < 2; ++n) b[bj][n] = *(const bf16x8*)(bp[bj][n] + k0 * 2);
#pragma unroll
            for (int ai = 0; ai < 2; ++ai)
#pragma unroll
                for (int bj = 0; bj < 2; ++bj)
#pragma unroll
                    for (int m = 0; m < 4; ++m)
#pragma unroll
                        for (int n = 0; n < 2; ++n) acc[ai][bj][m][n] = __builtin_amdgcn_mfma_f32_16x16x32_bf16(b[bj][n], a[ai][m], acc[ai][bj][m][n], 0, 0, 0);
        }
        E(acc, cur, wr, wc, fr, fq);
    }
}

template <int OFF> __device__ __forceinline__ void glds16(const char* base, unsigned voff, unsigned lds_base) {
    asm volatile("s_add_u32 m0, %2, %3\n\ts_nop 0\n\tglobal_load_lds_dwordx4 %0, %1" :: "v"(voff), "s"(base), "s"(lds_base), "n"(OFF) : "memory", "m0", "scc");
}
template <class Epi, class Sched, bool FP8 = false>
__device__ __forceinline__ void gemm_phase(PG8_LAS unsigned char* lds, const Sched& S, const Epi& E) {
    constexpr bool GATHER = Sched::GATHER;
    int tid = threadIdx.x; asm volatile("" : "+v"(tid));
    const int wid = __builtin_amdgcn_readfirstlane(tid >> 6), lane = tid & 63, wr = wid >> 2, wc = wid & 3, fr = lane & 15, fq = lane >> 4;
    const int K = S.K, nt = K / BK;
    unsigned voffB[2], offA[4], nxA[4];
#pragma unroll
    for (int i = 0; i < 2; ++i) { int R, C; stage_rc(tid * 16 + i * 8192, R, C); const int Rb = Epi::PERM ? ((R & ~31) + perm32(R & 31)) : R;
        voffB[i] = (unsigned)(Rb * K + C) * 2u; offA[i] = (unsigned)(R * K + C) * 2u; offA[2 + i] = (unsigned)((R + HALF) * K + C) * 2u; nxA[i] = 0u; nxA[2 + i] = 0u; }
    const size_t kstep = (size_t)(BK * 2);
    const size_t hstep = (size_t)HALF * K * 2;
    const unsigned ldsw = (unsigned)wid * 1024u;
    const unsigned ldsbw = (unsigned)(size_t)lds + ldsw;
    const int aoff = lds_byte(wr * 64 + fr, fq * 8), boff = lds_byte(wc * 32 + fr, fq * 8);
#define PG8_SA(b, h) (((b) * 2 + (h)) * HTB)
#define PG8_SB(b, h) ((4 + (b) * 2 + (h)) * HTB)
#define PG8_STAGE_B(bufoff, gbase) do { glds16<(bufoff)>((const char*)(gbase), voffB[0], ldsbw); glds16<(bufoff) + 8192>((const char*)(gbase), voffB[1], ldsbw); } while (0)
#define PG8_STAGE_A(bufoff, gbase, h) do { glds16<(bufoff)>((const char*)(gbase), offA[(h) * 2], ldsbw); glds16<(bufoff) + 8192>((const char*)(gbase), offA[(h) * 2 + 1], ldsbw); } while (0)
#define PG8_LDA(dst, b, h) do { _Pragma("unroll") for (int m = 0; m < 4; ++m) _Pragma("unroll") for (int k = 0; k < 2; ++k) dst[m][k] = *(const PG8_LAS bf16x8*)(lds + PG8_SA(b, h) + aoff + m * 2048 + k * 1024); } while (0)
#define PG8_LDB(dst, b, h) do { _Pragma("unroll") for (int n = 0; n < 2; ++n) _Pragma("unroll") for (int k = 0; k < 2; ++k) dst[n][k] = *(const PG8_LAS bf16x8*)(lds + PG8_SB(b, h) + boff + n * 2048 + k * 1024); } while (0)
#define PG8_MMA(ai, bj, At, Bt) do { __builtin_amdgcn_s_setprio(1); if constexpr (FP8) { _Pragma("unroll") for (int m = 0; m < 4; ++m) _Pragma("unroll") for (int n = 0; n < 2; ++n) { \
            const v8i _b = __builtin_shufflevector(__builtin_bit_cast(v4i, Bt[n][0]), __builtin_bit_cast(v4i, Bt[n][1]), 0, 1, 2, 3, 4, 5, 6, 7); \
            const v8i _a = __builtin_shufflevector(__builtin_bit_cast(v4i, At[m][0]), __builtin_bit_cast(v4i, At[m][1]), 0, 1, 2, 3, 4, 5, 6, 7); \
            acc[ai][bj][m][n] = __builtin_amdgcn_mfma_scale_f32_16x16x128_f8f6f4(_b, _a, acc[ai][bj][m][n], 0, 0, 0, 0x7A7A7A7A, 0, 0x7F7F7F7F); } } \
        else { _Pragma("unroll") for (int m = 0; m < 4; ++m) _Pragma("unroll") for (int n = 0; n < 2; ++n) _Pragma("unroll") for (int k = 0; k < 2; ++k) \
        acc[ai][bj][m][n] = __builtin_amdgcn_mfma_f32_16x16x32_bf16(Bt[n][k], At[m][k], acc[ai][bj][m][n], 0, 0, 0); } __builtin_amdgcn_s_setprio(0); } while (0)
#define PG8_WAIT_V(n) asm volatile("s_waitcnt vmcnt(" #n ")" ::: "memory")
#define PG8_WAIT_L(n) asm volatile("s_waitcnt lgkmcnt(" #n ")" ::: "memory")
#define PG8_BAR __builtin_amdgcn_s_barrier()
#define PG8_SCHED __builtin_amdgcn_sched_barrier(0)
#define PG8_OFFS(dst, u) do { if constexpr (GATHER) { _Pragma("unroll") for (int _h = 0; _h < 2; ++_h) _Pragma("unroll") for (int _i = 0; _i < 2; ++_i) { \
        int _R, _C; stage_rc(tid * 16 + _i * 8192, _R, _C); dst[_h * 2 + _i] = S.a_row_off(u, _h * HALF + _R) + (unsigned)(_C * 2); } } } while (0)
    Unit cur, nxt; int ui = 0;
    if (!S.next(0, cur)) return;
    f32x4 acc[2][2][4][2];
#pragma unroll
    for (int a = 0; a < 2; ++a)
#pragma unroll
        for (int b = 0; b < 2; ++b)
#pragma unroll
            for (int m = 0; m < 4; ++m)
#pragma unroll
                for (int n = 0; n < 2; ++n) acc[a][b][m][n] = (f32x4){0.f, 0.f, 0.f, 0.f};
    bf16x8 At[4][2], B0[2][2], B1[2][2];
    const char* cA = S.a_tile(cur); const char* cB = S.b_tile(cur);
    PG8_OFFS(offA, cur);
    PG8_STAGE_B(PG8_SB(0, 0), cB); PG8_STAGE_B(PG8_SB(0, 1), cB + hstep); PG8_STAGE_A(PG8_SA(0, 0), cA, 0); PG8_STAGE_A(PG8_SA(0, 1), cA, 1);
    if (wr == 1) PG8_BAR;
    PG8_WAIT_V(2); PG8_BAR;
    PG8_STAGE_B(PG8_SB(1, 0), cB + kstep); PG8_STAGE_A(PG8_SA(1, 0), cA + kstep, 0); PG8_STAGE_B(PG8_SB(1, 1), cB + hstep + kstep);
    PG8_WAIT_V(6); PG8_BAR;
    for (;;) {
        const bool has_next = S.next(ui + 1, nxt);
        const char* nA = has_next ? S.a_tile(nxt) : cA; const char* nB = has_next ? S.b_tile(nxt) : cB;
        if constexpr (GATHER) { if (has_next) { PG8_OFFS(nxA, nxt); } }
#pragma unroll 1
        for (int t = 0; t < nt; t += 2) {
            const bool last = (t == nt - 2);
            const char* a1 = cA + (size_t)(t + 1) * kstep;
            const char* a2 = last ? nA : cA + (size_t)(t + 2) * kstep; const char* b2 = last ? nB : cB + (size_t)(t + 2) * kstep;
            const char* a3 = a2 + kstep; const char* b3 = b2 + kstep;
            PG8_LDB(B0, 0, 0); PG8_LDB(B1, 0, 1); PG8_SCHED; PG8_LDA(At, 0, 0); PG8_STAGE_A(PG8_SA(1, 1), a1, 1);
            if constexpr (GATHER) { if (last && has_next) {
#pragma unroll
                for (int q = 0; q < 4; ++q) offA[q] = nxA[q]; } }
            PG8_WAIT_V(8); PG8_WAIT_L(0); PG8_BAR; if (!(Sched::HAS_RH && cur.rh == 1)) { PG8_MMA(0, 0, At, B0); if (!(Sched::HAS_HALF && S.is_half(cur))) PG8_MMA(0, 1, At, B1); } PG8_BAR; PG8_SCHED;
            PG8_LDA(At, 0, 1); PG8_STAGE_B(PG8_SB(0, 0), b2); PG8_STAGE_B(PG8_SB(0, 1), b2 + hstep); PG8_STAGE_A(PG8_SA(0, 0), a2, 0);
            PG8_WAIT_V(8); PG8_WAIT_L(0); PG8_BAR; if (!(Sched::HAS_RH && cur.rh == 0)) { PG8_MMA(1, 0, At, B0); if (!(Sched::HAS_HALF && S.is_half(cur))) PG8_MMA(1, 1, At, B1); } PG8_BAR; PG8_SCHED;
            PG8_LDB(B0, 1, 0); PG8_LDB(B1, 1, 1); PG8_SCHED; PG8_LDA(At, 1, 0); PG8_STAGE_A(PG8_SA(0, 1), a2, 1);
            PG8_WAIT_V(8); PG8_WAIT_L(0); PG8_BAR; if (!(Sched::HAS_RH && cur.rh == 1)) { PG8_MMA(0, 0, At, B0); if (!(Sched::HAS_HALF && S.is_half(cur))) PG8_MMA(0, 1, At, B1); } PG8_BAR; PG8_SCHED;
            PG8_LDA(At, 1, 1); PG8_STAGE_B(PG8_SB(1, 0), b3); PG8_STAGE_B(PG8_SB(1, 1), b3 + hstep); PG8_STAGE_A(PG8_SA(1, 0), a3, 0);
            PG8_WAIT_V(8); PG8_WAIT_L(0); PG8_BAR; if (!(Sched::HAS_RH && cur.rh == 0)) { PG8_MMA(1, 0, At, B0); if (!(Sched::HAS_HALF && S.is_half(cur))) PG8_MMA(1, 1, At, B1); } PG8_BAR; PG8_SCHED;
        }
        if (wr == 0) PG8_BAR;
        E(acc, cur, wr, wc, fr, fq);
        if (!has_next) break;
#pragma unroll
        for (int a = 0; a < 2; ++a)
#pragma unroll
            for (int b = 0; b < 2; ++b)
#pragma unroll
                for (int m = 0; m < 4; ++m)
#pragma unroll
                    for (int n = 0; n < 2; ++n) acc[a][b][m][n] = (f32x4){0.f, 0.f, 0.f, 0.f};
        cur = nxt; cA = nA; cB = nB; ++ui;
        if (wr == 1) PG8_BAR;
    }
    PG8_WAIT_V(0);
    PG8_BAR;
#undef PG8_SA
#undef PG8_SB
#undef PG8_STAGE_A
#undef PG8_STAGE_B
#undef PG8_LDA
#undef PG8_LDB
#undef PG8_MMA
#undef PG8_WAIT_V
#undef PG8_WAIT_L
#undef PG8_BAR
#undef PG8_SCHED
#undef PG8_OFFS
}
}

#define XB_TMO      128
#define XB_XCNT(j)  (256  + 64 * (j))
#define XB_XSUB(j)  (1280 + 64 * (j))
#define XB_XGEN(j)  (2304 + 64 * (j))
#define XB_TOP      3328
#define XB_TOPGEN   3392
#define XCD_BAR_WORDS 3456
#define XB_SPIN_CAP (1u << 18)
__device__ __forceinline__ unsigned xb_ld(unsigned* p)              { return __hip_atomic_load(p, __ATOMIC_RELAXED, __HIP_MEMORY_SCOPE_AGENT); }
__device__ __forceinline__ unsigned xb_add(unsigned* p, unsigned v) { return __hip_atomic_fetch_add(p, v, __ATOMIC_RELAXED, __HIP_MEMORY_SCOPE_AGENT); }
__device__ __forceinline__ unsigned xb_xcc_id() { return (unsigned)__builtin_amdgcn_s_getreg((3 << 11) | 20) & 0xFu; }
#define XB_SPIN(cond, bar) do { unsigned _sp = 0; while (cond) { __builtin_amdgcn_s_sleep(1); \
    if ((++_sp & 255u) == 0u) { if (xb_ld(&(bar)[XB_TMO])) break; if (_sp > XB_SPIN_CAP) { atomicAdd(&(bar)[XB_TMO], 1u); break; } } } } while (0)
struct XcdBarrier { unsigned* bar; unsigned x; volatile LAS unsigned* st; };
__device__ __forceinline__ XcdBarrier xcd_barrier_post(unsigned* bar, volatile LAS unsigned* st) {
    XcdBarrier b; b.bar = bar; b.x = xb_xcc_id(); b.st = st;
    if (threadIdx.x == 0) (void)xb_add(&bar[XB_XCNT(b.x)], 1u);
    return b;
}
__device__ __forceinline__ void xcd_barrier_complete(unsigned* bar, unsigned x, unsigned& nloc, unsigned& nx) {
    const unsigned G = gridDim.x * gridDim.y * gridDim.z;
    unsigned sum, cnt, mine, sp = 0u;
    for (;;) {
        sum = 0u; cnt = 0u; mine = 0u;
#pragma unroll
        for (unsigned j = 0; j < 16; ++j) { const unsigned c = xb_ld(&bar[XB_XCNT(j)]); sum += c; cnt += (c > 0u) ? 1u : 0u; mine = (j == x) ? c : mine; }
        if (sum == G) break;
        __builtin_amdgcn_s_sleep(1);
        if ((++sp & 255u) == 0u) { if (xb_ld(&bar[XB_TMO])) break; if (sp > XB_SPIN_CAP) { atomicAdd(&bar[XB_TMO], 1u); break; } }
    }
    nloc = mine > 0u ? mine : 1u; nx = cnt > 0u ? cnt : 1u;
}
__device__ __forceinline__ void xcd_barrier(const XcdBarrier& b) {
    asm volatile("s_waitcnt vmcnt(0)" ::: "memory");
    __syncthreads();
    if (threadIdx.x == 0) {
        unsigned* bar = b.bar;
        __builtin_amdgcn_s_waitcnt(0);
        unsigned nloc = b.st[0], nx = b.st[1];
        if (nloc == 0u) { xcd_barrier_complete(bar, b.x, nloc, nx); b.st[0] = nloc; b.st[1] = nx; }
        const unsigned old = xb_add(&bar[XB_XSUB(b.x)], 1u);
        const unsigned gen = old / nloc;
        if (old + 1u == (gen + 1u) * nloc) {
            __builtin_amdgcn_fence(__ATOMIC_RELEASE, "agent");
            asm volatile("s_waitcnt vmcnt(0)" ::: "memory");
            const unsigned og = xb_add(&bar[XB_TOP], 1u);
            const unsigned tg = og / nx;
            if (og + 1u == (tg + 1u) * nx) xb_add(&bar[XB_TOPGEN], 1u);
            else XB_SPIN(xb_ld(&bar[XB_TOPGEN]) == tg, bar);
            __builtin_amdgcn_fence(__ATOMIC_ACQUIRE, "agent");
            xb_add(&bar[XB_XGEN(b.x)], 1u);
            asm volatile("s_waitcnt vmcnt(0)" ::: "memory");
        } else {
            XB_SPIN(xb_ld(&bar[XB_XGEN(b.x)]) == gen, bar);
            __builtin_amdgcn_fence(__ATOMIC_ACQUIRE, "agent");
            asm volatile("s_waitcnt vmcnt(0)" ::: "memory");
        }
    }
    __syncthreads();
}

constexpr int NWAVES = 8;
struct Args { const float* in[21]; float* out; unsigned char* ws; int ph_lo, ph_hi; };
struct Frame {
    LAS unsigned char* lds;
    unsigned* ctl;
    int tid, lane, wave, vcu, G;
    unsigned char* ws;
};
enum { I_X = 0, I_LNIG, I_LNIB, I_RW, I_RB, I_WIN, I_CAW, I_CBW, I_CBB, I_LCG, I_LCB, I_PW, I_PS, I_WOUT, I_LMG, I_LMB, I_WG, I_WU, I_WDN, I_LFG, I_LFB };

__device__ __forceinline__ void tr_item(const float* src, int srcN, int srccol0, bf16* dst, int dstK, int dstrow0, int k0, LAS float* scr, int lane) {
#pragma unroll 8
    for (int i = 0; i < 32; ++i) { const int kk = 2 * i + (lane >> 5); scr[kk * 33 + (lane & 31)] = src[(size_t)(k0 + kk) * srcN + srccol0 + (lane & 31)]; }
    LDS_WAIT(); asm volatile("" ::: "memory");
    const int c = lane & 7;
#pragma unroll
    for (int j = 0; j < 4; ++j) { const int n = (lane >> 3) + 8 * j; const LAS float* s = scr + (8 * c) * 33 + n;
        v4u o; o.x = pk2(s[0 * 33], s[1 * 33]); o.y = pk2(s[2 * 33], s[3 * 33]); o.z = pk2(s[4 * 33], s[5 * 33]); o.w = pk2(s[6 * 33], s[7 * 33]);
        *(GAS v4u*)(dst + (size_t)(dstrow0 + n) * dstK + k0 + 8 * c) = o; }
    LDS_WAIT(); asm volatile("" ::: "memory");
}
__device__ __forceinline__ void tr_item64(const float* src, int srcN, int srccol0, bf16* dst, int dstK, int dstrow0, int k0, LAS unsigned* scr, int lane) {
    const int kr = lane >> 4, c4 = lane & 15;
    const float* sp = src + (size_t)(k0 + 2 * kr) * srcN + srccol0 + 4 * c4;
    f32x4 A[8], B[8];
#pragma unroll
    for (int i = 0; i < 8; ++i) { A[i] = *(const GAS f32x4*)(sp + (size_t)(8 * i) * srcN); B[i] = *(const GAS f32x4*)(sp + (size_t)(8 * i + 1) * srcN); }
#pragma unroll
    for (int i = 0; i < 8; ++i) { LAS unsigned* w = scr + (4 * i + kr) * 65 + 4 * c4;
        w[0] = pk2(A[i].x, B[i].x); w[1] = pk2(A[i].y, B[i].y); w[2] = pk2(A[i].z, B[i].z); w[3] = pk2(A[i].w, B[i].w); }
    LDS_WAIT(); asm volatile("" ::: "memory");
    const int q = lane & 7, nn = lane >> 3;
#pragma unroll
    for (int j = 0; j < 8; ++j) { const int n = nn + 8 * j; const LAS unsigned* r = scr + (4 * q) * 65 + n;
        v4u o; o.x = r[0]; o.y = r[65]; o.z = r[130]; o.w = r[195];
        *(GAS v4u*)(dst + (size_t)(dstrow0 + n) * dstK + k0 + 8 * q) = o; }
    LDS_WAIT(); asm volatile("" ::: "memory");
}
template <int NS>
__device__ __forceinline__ void tr_item64_f8(const float* src, int srcN, int srccol0, unsigned char* dst, int dstKB, int dstrow0, int k0, float scale, LAS unsigned* scr, int lane, bool nostore = false) {
    const int kr = lane >> 4, c4 = lane & 15;
    const float* sp = src + (size_t)(k0 + 4 * kr) * srcN + srccol0 + 4 * c4;
    f32x4 A[NS][4][4];
#pragma unroll
    for (int s = 0; s < NS; ++s)
#pragma unroll
        for (int i = 0; i < 4; ++i)
#pragma unroll
            for (int t = 0; t < 4; ++t) A[s][i][t] = *(const GAS f32x4*)(sp + (size_t)(64 * s + 16 * i + t) * srcN);
    const int q = lane & 3, nn = lane >> 2;
#pragma unroll
    for (int s = 0; s < NS; ++s) {
#pragma unroll
        for (int i = 0; i < 4; ++i) { LAS unsigned* w = scr + (4 * i + kr) * 65 + 4 * c4;
            w[0] = pk4_fp8(A[s][i][0].x * scale, A[s][i][1].x * scale, A[s][i][2].x * scale, A[s][i][3].x * scale); w[1] = pk4_fp8(A[s][i][0].y * scale, A[s][i][1].y * scale, A[s][i][2].y * scale, A[s][i][3].y * scale);
            w[2] = pk4_fp8(A[s][i][0].z * scale, A[s][i][1].z * scale, A[s][i][2].z * scale, A[s][i][3].z * scale); w[3] = pk4_fp8(A[s][i][0].w * scale, A[s][i][1].w * scale, A[s][i][2].w * scale, A[s][i][3].w * scale); }
        LDS_WAIT(); asm volatile("" ::: "memory");
#pragma unroll
        for (int j = 0; j < 4; ++j) { const int n = nn + 16 * j; const LAS unsigned* r = scr + (4 * q) * 65 + n;
            v4u o; o.x = r[0]; o.y = r[65]; o.z = r[130]; o.w = r[195];
            if (nostore) asm volatile("" :: "v"(o)); else *(GAS v4u*)(dst + (size_t)(dstrow0 + n) * dstKB + k0 + 64 * s + 16 * q) = o; }
        LDS_WAIT(); asm volatile("" ::: "memory");
    }
}
__device__ __forceinline__ int win_src(int c0) {
    const int pn = c0 >> 8, j = c0 & 255, half = j >> 7, jj = j & 127;
    if (pn < 3) { const int ch = pn * 128 + jj; return half == 0 ? 384 + ch : 768 + ch; }
    if (pn < 6) { const int ch = (pn - 3) * 128 + jj; return half == 0 ? 1152 + ch : 1536 + ch; }
    if (pn < 8) { const int q = (pn - 6) * 256 + j; return q < 384 ? q : 1920 + (q - 384); }
    return j < 128 ? 1920 + 128 + j : -1;
}
__device__ __forceinline__ void p0_prologue(Frame& F, const Args& A) {
    LAS float* scr = (LAS float*)(F.lds + F.wave * 8448);
    LAS unsigned* scu = (LAS unsigned*)scr;
    const int gw = F.vcu * NWAVES + F.wave, NGW = F.G * NWAVES, lane = F.lane;
    bf16* WIN = (bf16*)(F.ws + WS_WIN); bf16* WOUT = (bf16*)(F.ws + WS_WOUT); unsigned char* WGU = F.ws + WS_WGU; unsigned char* WD = F.ws + WS_WD; bf16* WRT = (bf16*)(F.ws + WS_WRT);
    constexpr int I_A = NL * 16 * 36, I_B = NL * 12 * 16, I_C = NL * NE * 128, I_D = NL * NE * 64, I_E = 16, I_F = NL * 4 * 16 * 2;
    constexpr int NITEMS = I_A + I_B + I_C + I_D + I_E + I_F;
    const int lane0 = lane;
#pragma unroll 1
    for (int prep = 0; prep < ((PROBE_P0 == 1 || PROBE_P0 == 3) ? 2 : 1); ++prep)
    for (int it = gw; it < NITEMS; it += NGW) {
        int lane = lane0; asm volatile("" : "+v"(lane));
        int r = it;
        if (r < I_C) {
            const int le = r >> 7, q = r & 127, kb = q >> 4, nb = q & 15, n0 = nb * 64, pn = n0 >> 8, half = (n0 & 255) >> 7, jj0 = n0 & 127;
            const float* src = (half ? A.in[I_WU] : A.in[I_WG]) + (size_t)le * 1024 * 512;
            tr_item64_f8<2>(src, 512, pn * 128 + jj0, WGU + (size_t)le * 1024 * 1024, 1024, n0, kb * 128, 32.0f, scu, lane, PROBE_P0 == 3 && prep == 1); continue; }
        r -= I_C;
        if (r < I_D) {
            const int le = r >> 6, q = r & 63, kb = q >> 4, nb = q & 15;
            tr_item64_f8<2>(A.in[I_WDN] + (size_t)le * 512 * 1024, 1024, nb * 64, WD + (size_t)le * 1024 * 512, 512, nb * 64, kb * 128, 32.0f, scu, lane, PROBE_P0 == 3 && prep == 1); continue; }
        r -= I_D;
        if (r < I_A) {
            const int l = r / 576, q = r % 576, kb = q / 36, nb = q % 36, c0 = nb * 64, sc = win_src(c0);
            bf16* dst = WIN + (size_t)l * N1 * 1024;
            if (sc >= 0) tr_item64(A.in[I_WIN] + (size_t)l * 1024 * DIN, DIN, sc, dst, 1024, c0, kb * 64, scu, lane);
            else { const int c = lane & 7;
#pragma unroll
                for (int j = 0; j < 8; ++j) { const int n = (lane >> 3) + 8 * j; *(GAS v4u*)(dst + (size_t)(c0 + n) * 1024 + kb * 64 + 8 * c) = (v4u){0u, 0u, 0u, 0u}; } }
            continue; }
        r -= I_A;
        if (r < I_B) {
            const int l = r / 192, q = r % 192, kb = q >> 4, nb = q & 15;
            if (GEMM2_FP8) tr_item64_f8<1>(A.in[I_WOUT] + (size_t)l * 1024 * 1024, 1024, nb * 64, (unsigned char*)WOUT + (size_t)l * 1024 * 1024, 1024, nb * 64, kb * 64, 32.0f, scu, lane);
            else tr_item64(A.in[I_WOUT] + (size_t)l * 1024 * 1024, 1024, nb * 64, WOUT + (size_t)l * 1024 * 1024, 1024, nb * 64, kb * 64, scu, lane);
            continue; }
        r -= I_B;
        if (r < I_E) { tr_item(A.in[I_RW], 32, 0, WRT, 1024, 0, r * 64, scr, lane); continue; }
        r -= I_E;
        {
            const int l = r >> 7, g = (r >> 5) & 3, nb = (r >> 1) & 15, cb = r & 1, n = nb * 64 + lane;
            const float* wo = A.in[I_WOUT] + (size_t)l * 1024 * 1024 + (size_t)(768 + g * 64) * 1024 + n;
            const float* ps = A.in[I_PS] + l * 256 + g * 64;
            const float* pw = A.in[I_PW] + (size_t)(l * 4 + g) * 64 * 64 + cb * 32 * 64;
#pragma unroll
            for (int i = 0; i < 8; ++i) *(LAS f32x4*)(scr + (i * 64 + lane) * 4) = *(const GAS f32x4*)(pw + (i * 64 + lane) * 4);
            float wv[64];
#pragma unroll
            for (int d = 0; d < 64; ++d) wv[d] = wo[(size_t)d * 1024] * ps[d];
            LDS_WAIT(); asm volatile("" ::: "memory");
            bf16* dst = WOUT + (size_t)l * 1024 * 1024 + (size_t)n * 1024 + 768 + g * 64 + cb * 32;
#pragma unroll 1
            for (int c2 = 0; c2 < 16; ++c2) { float o[2];
#pragma unroll
                for (int cc = 0; cc < 2; ++cc) { const LAS f32x4* pr = (const LAS f32x4*)(scr + (c2 * 2 + cc) * 64); float a = 0.f;
#pragma unroll
                    for (int d4 = 0; d4 < 16; ++d4) { const f32x4 p = pr[d4]; a += p.x * wv[4 * d4] + p.y * wv[4 * d4 + 1] + p.z * wv[4 * d4 + 2] + p.w * wv[4 * d4 + 3]; }
                    o[cc] = a; }
                if (GEMM2_FP8) *(GAS unsigned short*)((unsigned char*)WOUT + (size_t)l * 1024 * 1024 + (size_t)n * 1024 + 768 + g * 64 + cb * 32 + c2 * 2) = (unsigned short)pk4_fp8(o[0] * 32.0f, o[1] * 32.0f, 0.f, 0.f);
                else *(GAS unsigned*)(dst + c2 * 2) = pk2(o[0], o[1]); }
            LDS_WAIT(); asm volatile("" ::: "memory");
        }
    }
    bf16* HB = (bf16*)(F.ws + WS_HB);
    const float* g = A.in[I_LNIG]; const float* b = A.in[I_LNIB];
    f32x4 gv[4], bv[4];
#pragma unroll
    for (int j = 0; j < 4; ++j) { gv[j] = *(const f32x4*)(g + 4 * lane + 256 * j); bv[j] = *(const f32x4*)(b + 4 * lane + 256 * j); }
#pragma unroll 1
    for (int prep2 = 0; prep2 < ((PROBE_P0 == 2) ? 2 : 1); ++prep2)
    for (int m0 = gw * 2; m0 < T_; m0 += NGW * 2) {
        f32x4 v[2][4];
#pragma unroll
        for (int u = 0; u < 2; ++u) { const GAS f32x4* xr = (const GAS f32x4*)(A.in[I_X] + (size_t)(m0 + u) * D_) + lane;
#pragma unroll
            for (int j = 0; j < 4; ++j) v[u][j] = xr[64 * j]; }
#pragma unroll
        for (int u = 0; u < 2; ++u) { float s = 0.f;
#pragma unroll
            for (int j = 0; j < 4; ++j) s += (v[u][j].x + v[u][j].y) + (v[u][j].z + v[u][j].w);
            const float mean = wave_sum(s) * (1.f / D_); float s2 = 0.f;
#pragma unroll
            for (int j = 0; j < 4; ++j) { v[u][j] = v[u][j] - mean; s2 += (v[u][j].x * v[u][j].x + v[u][j].y * v[u][j].y) + (v[u][j].z * v[u][j].z + v[u][j].w * v[u][j].w); }
            const float rstd = 1.f / sqrtf(wave_sum(s2) * (1.f / D_) + LN_EPS);
            GAS v2u* o8 = (GAS v2u*)(HB + (size_t)(m0 + u) * D_) + lane;
#pragma unroll
            for (int j = 0; j < 4; ++j) { const f32x4 o = v[u][j] * rstd * gv[j] + bv[j]; v2u w; w.x = pk2(o.x, o.y); w.y = pk2(o.z, o.w); o8[64 * j] = w; } }
    }
}

__device__ __forceinline__ void p2_mixer(Frame& F, const Args& A, int l) {
    LAS unsigned* BV = (LAS unsigned*)F.lds;
    LAS unsigned* PB = (LAS unsigned*)(F.lds + 47616);
    LAS float* V = (LAS float*)(F.lds + 71680);
    const bf16* Z = (const bf16*)(F.ws + WS_Z); bf16* Y = (bf16*)(F.ws + WS_Y);
    const float* wB = A.in[I_CBW] + l * 31 * 384; const float* bB = A.in[I_CBB] + l * 384;
    const float* lg = A.in[I_LCG] + l * 384; const float* lb = A.in[I_LCB] + l * 384; const float* wA = A.in[I_CAW] + l * 3 * 384;
    int tid = F.tid; asm volatile("" : "+v"(tid));
    const int lane = tid & 63, wave = F.wave;
    const bool convt = tid < 384; const int cp = tid % 192, tg = tid / 192;
    f32x2 w[31]; f32x2 bias = (f32x2){0.f, 0.f};
#pragma unroll
    for (int j = 0; j < 31; ++j) w[j] = (f32x2){0.f, 0.f};
    if (convt) {
#pragma unroll
        for (int j = 0; j < 31; ++j) w[j] = *(const f32x2*)(wB + j * 384 + 2 * cp);
        bias = *(const f32x2*)(bB + 2 * cp); }
    v4u pre[9];
#define MIX_PREFETCH(ci_, tid_) do { const int _t0 = (ci_) * 32, _s0 = _t0 & (SEQ_ - 1); \
        _Pragma("unroll") for (int _i = 0; _i < 6; ++_i) { const int _q = (tid_) + 512 * _i; const int _qq = _q < 62 * 48 ? _q : 0; const int _r = _qq / 48, _c = _qq % 48; \
            const int _rr = (_s0 - 30 + _r >= 0) ? _r : 30; pre[_i] = *(const GAS v4u*)(Z + (size_t)(_t0 - 30 + _rr) * NZ + 768 + _c * 8); } \
        _Pragma("unroll") for (int _i = 0; _i < 3; ++_i) { const int _q = (tid_) + 512 * _i; const int _qq = _q < 47 * 32 ? _q : 0; const int _r = _qq >> 5, _c = _qq & 31; \
            const int _rr = (_s0 - 15 + _r >= 0) ? _r : 15; pre[6 + _i] = *(const GAS v4u*)(Z + (size_t)(_t0 - 15 + _rr) * NZ + 1152 + _c * 8); } } while (0)
    if (F.vcu < T_ / 32) MIX_PREFETCH(F.vcu, tid);
    for (int ci = F.vcu; ci < T_ / 32; ci += F.G) {
        const int t0 = ci * 32, s0 = t0 & (SEQ_ - 1);
#pragma unroll
        for (int i = 0; i < 6; ++i) { const int q = tid + 512 * i; if (q < 62 * 48) { const int r = q / 48, c = q % 48;
            *(LAS v4u*)(BV + r * 192 + c * 4) = (s0 - 30 + r >= 0) ? pre[i] : (v4u){0u, 0u, 0u, 0u}; } }
#pragma unroll
        for (int i = 0; i < 3; ++i) { const int q = tid + 512 * i; if (q < 47 * 32) { const int r = q >> 5, c = q & 31;
            *(LAS v4u*)(PB + r * 128 + c * 4) = (s0 - 15 + r >= 0) ? pre[6 + i] : (v4u){0u, 0u, 0u, 0u}; } }
        __syncthreads();
        { int cn = ci + F.G; asm volatile("" : "+s"(cn)); int tidp = tid; asm volatile("" : "+v"(tidp));
          if (cn < T_ / 32) MIX_PREFETCH(cn, tidp); }
#pragma unroll 1
        for (int prep = 0; prep < ((PROBE_MIX == 1) ? 2 : 1); ++prep)
        if (convt) {
#pragma unroll 1
            for (int hh = 0; hh < 2; ++hh) { const int tb = tg * 16 + hh * 8;
                f32x2 x[38];
#pragma unroll
                for (int i = 0; i < 38; ++i) { const unsigned u = BV[(tb + i) * 192 + cp]; x[i] = (f32x2){bflo(u), bfhi(u)}; }
#pragma unroll
                for (int tt = 0; tt < 8; ++tt) { f32x2 a = bias;
#pragma unroll
                    for (int j = 0; j < 31; ++j) a += w[j] * x[tt + j];
                    *(LAS f32x2*)(V + (tb + tt) * 384 + 2 * cp) = a; }
            }
        } else {
            const int p = tid - 384, g = p >> 5, wd = 2 << g;
            f32x2 s = (f32x2){0.f, 0.f};
            for (int i = 1; i < wd; ++i) { const unsigned u = PB[(15 - i) * 128 + p]; s += (f32x2){bflo(u), bfhi(u)}; }
#pragma unroll 1
            for (int blk = 0; blk < 4; ++blk) {
                unsigned xr[23];
#pragma unroll
                for (int i = 0; i < 23; ++i) xr[i] = PB[(8 * blk + i) * 128 + p];
#pragma unroll
                for (int j = 0; j < 8; ++j) { const int tt = 8 * blk + j; const f32x2 xv = (f32x2){bflo(xr[15 + j]), bfhi(xr[15 + j])};
                    s += xv; const int n = (s0 + tt + 1) < wd ? (s0 + tt + 1) : wd; const float inv = __builtin_amdgcn_rcpf((float)n);
                    const f32x2 dd = s * inv - xv;
                    if (GEMM2_FP8) *(GAS unsigned short*)((unsigned char*)Y + (size_t)(t0 + tt) * D_ + 768 + 2 * p) = (unsigned short)pk4_fp8(dd.x, dd.y, 0.f, 0.f);
                    else *(GAS unsigned*)(Y + (size_t)(t0 + tt) * D_ + 768 + 2 * p) = pk2(dd.x, dd.y);
                    const unsigned u2 = xr[15 + j - 1], u4 = xr[15 + j - 3], u8 = xr[15 + j - 7], u16 = xr[j];
                    const unsigned uo = g == 0 ? u2 : (g == 1 ? u4 : (g == 2 ? u8 : u16));
                    s -= (f32x2){bflo(uo), bfhi(uo)}; }
            }
        }
        __syncthreads();
        v4u ya[3][4];
        int t0o = t0; asm volatile("" : "+s"(t0o));
        int tidl = tid; asm volatile("" : "+v"(tidl));
#pragma unroll
        for (int i = 0; i < 3; ++i) { const int q = tidl + 512 * i, tt = q / 48, o8 = q % 48, pos = (t0o & (SEQ_ - 1)) + tt; const size_t row = (size_t)(t0o + tt);
            ya[i][0] = *(const GAS v4u*)(Z + row * NZ + o8 * 8);
            ya[i][1] = *(const GAS v4u*)(Z + row * NZ + 384 + o8 * 8);
            ya[i][2] = *(const GAS v4u*)(Z + (row - (pos >= 1 ? 1 : 0)) * NZ + 384 + o8 * 8);
            ya[i][3] = *(const GAS v4u*)(Z + (row - (pos >= 2 ? 2 : 0)) * NZ + 384 + o8 * 8); }
#pragma unroll 1
        for (int tk = 0; tk < ((PROBE_MIX == 2) ? 8 : 4); ++tk) { const int tt = wave * 4 + (tk & 3);
            f32x2 v[3]; float s = 0.f;
#pragma unroll
            for (int i = 0; i < 3; ++i) { v[i] = *(const LAS f32x2*)(V + tt * 384 + 2 * lane + 128 * i); s += v[i].x + v[i].y; }
            const float mean = wave_sum(s) * (1.f / 384.f); float q = 0.f;
#pragma unroll
            for (int i = 0; i < 3; ++i) { v[i] = v[i] - mean; q += v[i].x * v[i].x + v[i].y * v[i].y; }
            const float rstd = 1.f / sqrtf(wave_sum(q) * (1.f / 384.f) + LN_EPS);
#pragma unroll
            for (int i = 0; i < 3; ++i) { const int c = 2 * lane + 128 * i; const f32x2 gg = *(const f32x2*)(lg + c), bb = *(const f32x2*)(lb + c);
                f32x2 o = v[i] * rstd * gg + bb; o.x = o.x * sigmoidf_(o.x); o.y = o.y * sigmoidf_(o.y);
                if (GEMM2_FP8) *(GAS unsigned short*)((unsigned char*)Y + (size_t)(t0 + tt) * D_ + 384 + c) = (unsigned short)pk4_fp8(o.x, o.y, 0.f, 0.f);
                else *(GAS unsigned*)(Y + (size_t)(t0 + tt) * D_ + 384 + c) = pk2(o.x, o.y); }
        }
#pragma unroll
        for (int i = 0; i < 3; ++i) { const int q = tid + 512 * i, tt = q / 48, o8 = q % 48, pos = s0 + tt; const size_t row = (size_t)(t0 + tt);
            const v4u gb = ya[i][0], x0 = ya[i][1]; v4u x1 = ya[i][2], x2 = ya[i][3];
            if (pos < 1) x1 = (v4u){0u, 0u, 0u, 0u};
            if (pos < 2) x2 = (v4u){0u, 0u, 0u, 0u};
            const f32x4 w2a = *(const f32x4*)(wA + 2 * 384 + o8 * 8), w2b = *(const f32x4*)(wA + 2 * 384 + o8 * 8 + 4);
            const f32x4 w1a = *(const f32x4*)(wA + 1 * 384 + o8 * 8), w1b = *(const f32x4*)(wA + 1 * 384 + o8 * 8 + 4);
            const f32x4 w0a = *(const f32x4*)(wA + o8 * 8), w0b = *(const f32x4*)(wA + o8 * 8 + 4);
            float o[8];
            const unsigned gbw[4] = {gb.x, gb.y, gb.z, gb.w}, x0w[4] = {x0.x, x0.y, x0.z, x0.w}, x1w[4] = {x1.x, x1.y, x1.z, x1.w}, x2w[4] = {x2.x, x2.y, x2.z, x2.w};
            const float w2[8] = {w2a.x, w2a.y, w2a.z, w2a.w, w2b.x, w2b.y, w2b.z, w2b.w}, w1[8] = {w1a.x, w1a.y, w1a.z, w1a.w, w1b.x, w1b.y, w1b.z, w1b.w}, w0[8] = {w0a.x, w0a.y, w0a.z, w0a.w, w0b.x, w0b.y, w0b.z, w0b.w};
#pragma unroll
            for (int e = 0; e < 4; ++e) {
                o[2 * e] = bflo(gbw[e]) * (w2[2 * e] * bflo(x0w[e]) + w1[2 * e] * bflo(x1w[e]) + w0[2 * e] * bflo(x2w[e]));
                o[2 * e + 1] = bfhi(gbw[e]) * (w2[2 * e + 1] * bfhi(x0w[e]) + w1[2 * e + 1] * bfhi(x1w[e]) + w0[2 * e + 1] * bfhi(x2w[e])); }
            if (GEMM2_FP8) { v2u ov; ov.x = pk4_fp8(o[0], o[1], o[2], o[3]); ov.y = pk4_fp8(o[4], o[5], o[6], o[7]); *(GAS v2u*)((unsigned char*)Y + row * D_ + o8 * 8) = ov; }
            else { v4u ov; ov.x = pk2(o[0], o[1]); ov.y = pk2(o[2], o[3]); ov.z = pk2(o[4], o[5]); ov.w = pk2(o[6], o[7]);
            *(GAS v4u*)(Y + row * D_ + o8 * 8) = ov; } }
        __syncthreads();
    }
#undef MIX_PREFETCH
}

__device__ __forceinline__ void top2of4(float q0, float q1, float q2, float q3, float& a1, int& i1, float& a2, int& i2) {
    a1 = q0; i1 = 0; a2 = -1.f; i2 = 1;
#define T2STEP(qv, r) { const bool gt = (qv) > a1; const bool g2 = (qv) > a2; const float na2 = gt ? a1 : (g2 ? (qv) : a2); const int ni2 = gt ? i1 : (g2 ? (r) : i2); \
        a1 = gt ? (qv) : a1; i1 = gt ? (r) : i1; a2 = na2; i2 = ni2; }
    T2STEP(q1, 1) T2STEP(q2, 2) T2STEP(q3, 3)
#undef T2STEP
}
__device__ __forceinline__ void p4_ln_router(Frame& F, const Args& A, int l) {
    LAS unsigned char* lds = F.lds;
    LAS int* cntl = (LAS int*)(lds + 66048); LAS int* basel = cntl + 32; LAS int* sel = cntl + 64; LAS int* lpos = cntl + 64 + 256;
    const bf16* U = (const bf16*)(F.ws + WS_U); bf16* HB = (bf16*)(F.ws + WS_HB); unsigned char* H8 = F.ws + WS_H8; const bf16* WRT = (const bf16*)(F.ws + WS_WRT);
    int* route = (int*)(F.ws + WS_ROUTE); int* lists = (int*)(F.ws + WS_LISTS);
    unsigned* counts = F.ctl + CW_CNT + l * 32 * 64;
    const float* g = A.in[I_LMG] + l * D_; const float* b = A.in[I_LMB] + l * D_; const float* rb = A.in[I_RB];
    int tid = F.tid; asm volatile("" : "+v"(tid));
    const int lane = tid & 63, wave = F.wave, fr = lane & 15, fq = lane >> 4;
    for (int q = tid; q < 32 * 128; q += 512) { const int e = q >> 7, c = q & 127; *(LAS v4u*)(lds + e * 2064 + c * 16) = *(const GAS v4u*)(WRT + e * 1024 + c * 8); }
    if (tid < 32) cntl[tid] = 0;
    f32x4 gv[4], bv[4];
#pragma unroll
    for (int j = 0; j < 4; ++j) { gv[j] = *(const f32x4*)(g + 4 * lane + 256 * j); bv[j] = *(const f32x4*)(b + 4 * lane + 256 * j); }
    __syncthreads();
    for (int blk = F.vcu; blk < T_ / 128; blk += F.G) {
#pragma unroll 1
        for (int i = 0; i < 16; i += 4) { const size_t m = (size_t)(blk * 128 + wave * 16 + i);
            v2u q[4][4];
#pragma unroll
            for (int u = 0; u < 4; ++u) { const GAS v2u* up = (const GAS v2u*)(U + (m + u) * D_) + lane;
#pragma unroll
                for (int j = 0; j < 4; ++j) q[u][j] = up[64 * j]; }
#pragma unroll
            for (int u = 0; u < 4; ++u) { f32x4 v[4]; float s = 0.f;
#pragma unroll
                for (int j = 0; j < 4; ++j) { v[j] = (f32x4){bflo(q[u][j].x), bfhi(q[u][j].x), bflo(q[u][j].y), bfhi(q[u][j].y)}; s += (v[j].x + v[j].y) + (v[j].z + v[j].w); }
                const float mean = wave_sum(s) * (1.f / D_); float s2 = 0.f;
#pragma unroll
                for (int j = 0; j < 4; ++j) { v[j] = v[j] - mean; s2 += (v[j].x * v[j].x + v[j].y * v[j].y) + (v[j].z * v[j].z + v[j].w * v[j].w); }
                const float rstd = 1.f / sqrtf(wave_sum(s2) * (1.f / D_) + LN_EPS);
                GAS v2u* o8 = (GAS v2u*)(HB + (m + u) * D_) + lane; GAS unsigned* o4 = (GAS unsigned*)(H8 + (m + u) * D_) + lane;
#pragma unroll
                for (int j = 0; j < 4; ++j) { const f32x4 o = v[j] * rstd * gv[j] + bv[j]; v2u w; w.x = pk2(o.x, o.y); w.y = pk2(o.z, o.w); o8[64 * j] = w; o4[64 * j] = pk4_fp8(o.x, o.y, o.z, o.w); } }
        }
        VM_WAIT(); asm volatile("" ::: "memory");
        const int token = blk * 128 + wave * 16 + fr;
        f32x4 acc0 = (f32x4){0.f, 0.f, 0.f, 0.f}, acc1 = (f32x4){0.f, 0.f, 0.f, 0.f};
        const bf16* hrow = HB + (size_t)token * D_ + fq * 8;
#pragma unroll 16
        for (int k = 0; k < 32; ++k) { const int kk = k * 32 + fq * 8;
            const bf16x8 hf = *(const GAS bf16x8*)(hrow + k * 32);
            const bf16x8 w0 = *(const LAS bf16x8*)(lds + fr * 2064 + kk * 2), w1 = *(const LAS bf16x8*)(lds + (16 + fr) * 2064 + kk * 2);
            acc0 = __builtin_amdgcn_mfma_f32_16x16x32_bf16(w0, hf, acc0, 0, 0, 0);
            acc1 = __builtin_amdgcn_mfma_f32_16x16x32_bf16(w1, hf, acc1, 0, 0, 0);
        }
        float p0[4], p1[4]; float mx = -3.0e38f;
#pragma unroll
        for (int r = 0; r < 4; ++r) { p0[r] = acc0[r] + rb[4 * fq + r]; p1[r] = acc1[r] + rb[16 + 4 * fq + r]; mx = fmaxf(mx, fmaxf(p0[r], p1[r])); }
        mx = fmaxf(mx, __shfl_xor(mx, 16)); mx = fmaxf(mx, __shfl_xor(mx, 32));
#pragma unroll
        for (int r = 0; r < 4; ++r) { p0[r] = __expf(p0[r] - mx); p1[r] = __expf(p1[r] - mx); }
        float a1, a2, c1, c2; int ia1, ia2, ic1, ic2;
        top2of4(p0[0], p0[1], p0[2], p0[3], a1, ia1, a2, ia2); top2of4(p1[0], p1[1], p1[2], p1[3], c1, ic1, c2, ic2);
        const float sc0 = a1 + a2, sc1 = c1 + c2;
        float bs = sc0; int bg = fq; if (sc1 > sc0) { bs = sc1; bg = 4 + fq; }
#pragma unroll
        for (int off = 16; off <= 32; off <<= 1) { const float os = __shfl_xor(bs, off); const int og = __shfl_xor(bg, off); if (os > bs || (os == bs && og < bg)) { bs = os; bg = og; } }
        if ((bg & 3) == fq) {
            const bool hi = bg >= 4;
            const float pa = hi ? c1 : a1, pb = hi ? c2 : a2; const int ia = hi ? ic1 : ia1, ib = hi ? ic2 : ia2;
            const int ea = bg * 4 + ia, eb = bg * 4 + ib; const float inv = 1.0f / (pa + pb);
            const int tokl = wave * 16 + fr;
            const int la = atomicAdd((int*)&cntl[ea], 1), lb2 = atomicAdd((int*)&cntl[eb], 1);
            sel[tokl * 2] = ea; sel[tokl * 2 + 1] = eb; lpos[tokl * 2] = la; lpos[tokl * 2 + 1] = lb2;
            int* rt = route + (size_t)token * 8; rt[0] = ea; rt[2] = eb; rt[4] = __float_as_int(pa * inv); rt[5] = __float_as_int(pb * inv);
        }
        __syncthreads();
        if (tid < 32) { const int c = cntl[tid]; basel[tid] = c ? (int)__hip_atomic_fetch_add(counts + tid * 64, (unsigned)c, RLX_AGENT) : 0; }
        __syncthreads();
        if (tid < 256) { const int tokl = tid >> 1, k = tid & 1, e = sel[tid], pos = basel[e] + lpos[tid], tok = blk * 128 + tokl;
            lists[(size_t)e * 65536 + pos] = tok * 2 + k; route[(size_t)tok * 8 + 1 + 2 * k] = pos; }
        __syncthreads();
        if (tid < 32) cntl[tid] = 0;
        __syncthreads();
    }
}

__device__ __forceinline__ void moe_table(Frame& F, int l) {
    LAS int* tab = (LAS int*)(F.lds + TAB_OFF);
    __syncthreads();
    if (F.tid < 32) tab[40 + F.tid] = (int)__hip_atomic_load(F.ctl + CW_CNT + (l * 32 + F.tid) * 64, RLX_AGENT);
    __syncthreads();
    if (F.tid == 0) { int s = 0; for (int e = 0; e < 32; ++e) { tab[e] = s; s += (tab[40 + e] + 255) >> 8; } tab[32] = s; }
    __syncthreads();
    for (int t = F.tid; t < tab[32]; t += NWAVES * 64) { int e = 0; while (e < 31 && tab[e + 1] <= t) ++e; tab[80 + t] = e; }
    __syncthreads();
}

__device__ __forceinline__ void p7_combine_ln(Frame& F, const Args& A, int l) {
    const LAS int* tab = (const LAS int*)(F.lds + TAB_OFF);
    bf16* HB = (bf16*)(F.ws + WS_HB); const unsigned char* Y2S = F.ws + WS_Y2S; const int* route = (const int*)(F.ws + WS_ROUTE);
    const float* g = A.in[I_LFG] + l * D_; const float* b = A.in[I_LFB] + l * D_;
    int lane = F.lane; asm volatile("" : "+v"(lane));
    const int gw = F.vcu * NWAVES + F.wave, NGW = F.G * NWAVES;
    f32x4 gv[4], bv[4];
#pragma unroll
    for (int j = 0; j < 4; ++j) { gv[j] = *(const f32x4*)(g + 4 * lane + 256 * j); bv[j] = *(const f32x4*)(b + 4 * lane + 256 * j); }
    const bool last = (l == NL - 1);
    for (int m0 = gw * 2; m0 < T_; m0 += NGW * 2) {
        v2u hq[2][4]; unsigned aq[2][4], cq[2][4]; float g0[2], g1[2];
#pragma unroll
        for (int u = 0; u < 2; ++u) { const int m = m0 + u; const int* rt = route + (size_t)m * 8;
            const int e0 = rt[0], q0 = rt[1], e1 = rt[2], q1 = rt[3]; g0[u] = __int_as_float(rt[4]); g1[u] = __int_as_float(rt[5]);
            const size_t r0 = (size_t)tab[e0] * 256 + q0, r1 = (size_t)tab[e1] * 256 + q1;
            const GAS v2u* hp = (const GAS v2u*)(HB + (size_t)m * D_) + lane; const GAS unsigned* ya = (const GAS unsigned*)(Y2S + r0 * D_) + lane; const GAS unsigned* yb = (const GAS unsigned*)(Y2S + r1 * D_) + lane;
#pragma unroll
            for (int j = 0; j < 4; ++j) { hq[u][j] = hp[64 * j]; aq[u][j] = ya[64 * j]; cq[u][j] = yb[64 * j]; } }
#pragma unroll
        for (int u = 0; u < 2; ++u) { const int m = m0 + u; f32x4 v[4]; float s = 0.f;
#pragma unroll
            for (int j = 0; j < 4; ++j) { const v2u h = hq[u][j]; const unsigned a = aq[u][j], c = cq[u][j];
                const f32x2 a01 = __builtin_amdgcn_cvt_pk_f32_fp8((int)a, false), a23 = __builtin_amdgcn_cvt_pk_f32_fp8((int)a, true), c01 = __builtin_amdgcn_cvt_pk_f32_fp8((int)c, false), c23 = __builtin_amdgcn_cvt_pk_f32_fp8((int)c, true);
                v[j].x = ALPHA * bflo(h.x) + g0[u] * a01.x + g1[u] * c01.x; v[j].y = ALPHA * bfhi(h.x) + g0[u] * a01.y + g1[u] * c01.y;
                v[j].z = ALPHA * bflo(h.y) + g0[u] * a23.x + g1[u] * c23.x; v[j].w = ALPHA * bfhi(h.y) + g0[u] * a23.y + g1[u] * c23.y;
                s += (v[j].x + v[j].y) + (v[j].z + v[j].w); }
            const float mean = wave_sum(s) * (1.f / D_); float s2 = 0.f;
#pragma unroll
            for (int j = 0; j < 4; ++j) { v[j] = v[j] - mean; s2 += (v[j].x * v[j].x + v[j].y * v[j].y) + (v[j].z * v[j].z + v[j].w * v[j].w); }
            const float rstd = 1.f / sqrtf(wave_sum(s2) * (1.f / D_) + LN_EPS);
            if (last) { GAS f32x4* o = (GAS f32x4*)(A.out + (size_t)m * D_) + lane;
#pragma unroll
                for (int j = 0; j < 4; ++j) o[64 * j] = v[j] * rstd * gv[j] + bv[j];
            } else { GAS v2u* o8 = (GAS v2u*)(HB + (size_t)m * D_) + lane;
#pragma unroll
                for (int j = 0; j < 4; ++j) { const f32x4 o = v[j] * rstd * gv[j] + bv[j]; v2u w; w.x = pk2(o.x, o.y); w.y = pk2(o.z, o.w); o8[64 * j] = w; } }
        }
    }
}

#ifndef PH_NOINLINE
#define PH_NOINLINE __forceinline__
#endif
PH_NOINLINE __device__ void run_gemm1(LAS unsigned char* lds, unsigned char* ws, int l, int G, int c) {
    pg8::DenseOrder S; S.init(ws + WS_HB, ws + WS_WIN + (size_t)l * N1 * 1024 * 2, T_, N1, D_, G, c, 1);
    pg8::EpiZ E{(bf16*)(ws + WS_Z)};
    if (GEMM_SIMPLE_MASK & 1) pg8::gemm_phase_simple(S, E); else pg8::gemm_phase(lds, S, E);
}
PH_NOINLINE __device__ void run_gemm_probe(LAS unsigned char* lds, unsigned char* ws, int G, int c) {
    pg8::DenseOrder S; S.init(ws + WS_HB, ws + WS_WIN, T_, 256 * (PROBE_EXTRA_NN ? PROBE_EXTRA_NN : 1), D_, G, c);
    pg8::EpiPlain E{(bf16*)(ws + WS_Y), 2048};
    pg8::gemm_phase(lds, S, E);
}
PH_NOINLINE __device__ void run_gemm2(LAS unsigned char* lds, unsigned char* ws, int l, int G, int c) {
    pg8::EpiU E{(const bf16*)(ws + WS_HB), (bf16*)(ws + WS_U)};
    if (GEMM2_FP8) { pg8::DenseRowsOrder S; int kq = D_ / 2; asm volatile("" : "+s"(kq)); S.init(ws + WS_Y, ws + WS_WOUT + (size_t)l * 1024 * 1024, T_, D_, kq, G, c); pg8::gemm_phase<pg8::EpiU, pg8::DenseRowsOrder, true>(lds, S, E); }
    else { pg8::DenseOrder S; S.init(ws + WS_Y, ws + WS_WOUT + (size_t)l * 1024 * 1024 * 2, T_, D_, D_, G, c); pg8::gemm_phase(lds, S, E); }
}
PH_NOINLINE __device__ void run_gemm5(LAS unsigned char* lds, unsigned char* ws, int l, int G, int c) {
    const LAS int* tab = (const LAS int*)(lds + TAB_OFF);
    pg8::MoeGatherOrder S; S.A = (const char*)(ws + WS_H8); S.Bt = (const char*)(ws + WS_WGU + (size_t)l * NE * 1024 * 1024); S.bexp = (size_t)1024 * 1024;
    int kq = D_ / 2; asm volatile("" : "+s"(kq));
    S.K = kq; S.nN = 4; S.nwg = tab[32] * 4; S.G = G; S.c = c; S.tab = tab; S.lists = (const int*)(ws + WS_LISTS);
    pg8::EpiHid E{ws + WS_HID};
    pg8::gemm_phase<pg8::EpiHid, pg8::MoeGatherOrder, true>(lds, S, E);
}
PH_NOINLINE __device__ void run_gemm6(LAS unsigned char* lds, unsigned char* ws, int l, int G, int c) {
    const LAS int* tab = (const LAS int*)(lds + TAB_OFF);
    pg8::MoeRowsOrder S; S.A = (const char*)(ws + WS_HID); S.Bt = (const char*)(ws + WS_WD + (size_t)l * NE * 1024 * 512); S.bexp = (size_t)1024 * 512;
    int kq = DE / 2; asm volatile("" : "+s"(kq));
    S.K = kq; S.nN = 4; S.nwg = tab[32] * 4; S.G = G; S.c = c; S.tab = tab; S.lists = nullptr;
    pg8::EpiPlain8 E{ws + WS_Y2S, D_};
    pg8::gemm_phase<pg8::EpiPlain8, pg8::MoeRowsOrder, true>(lds, S, E);
}

__global__ void __launch_bounds__(NWAVES * 64, 2) mk_fwd(Args args) {
    extern __shared__ __attribute__((aligned(16))) unsigned char lds_raw[];
    Frame F;
    F.lds = (LAS unsigned char*)lds_raw;
    F.tid = threadIdx.x; F.lane = F.tid & 63; F.wave = __builtin_amdgcn_readfirstlane(F.tid >> 6);
    F.G = gridDim.x; { const int bx = blockIdx.x; F.vcu = (F.G % 8 == 0) ? (bx % 8) * (F.G / 8) + bx / 8 : bx; }
    F.ws = args.ws; F.ctl = (unsigned*)(args.ws + WS_CTL);
    for (int u = F.tid; u < (LDS_BYTES - LDSCTL_OFF) / 4; u += NWAVES * 64) ((LAS unsigned*)(F.lds + LDSCTL_OFF))[u] = 0u;
    __syncthreads();
    volatile LAS unsigned* MISC = (volatile LAS unsigned*)(F.lds + MISC_OFF);
    XcdBarrier bar; bar.bar = F.ctl + CW_BAR; bar.x = 0; bar.st = nullptr;
    if (MK_N_LAUNCHES == 1) bar = xcd_barrier_post(F.ctl + CW_BAR, MISC + 8);
    const int lo = args.ph_lo, hi = args.ph_hi;
#define IN(k) (lo <= (k) && (k) < hi)
#define SEAM(k) do { if (MK_N_LAUNCHES == 1 && (k) + 1 < hi) xcd_barrier(bar); } while (0)
    if (REPEAT_MASK & 256) { for (int rep = 0; rep < 10; ++rep) xcd_barrier(bar); }
    if ((PH_MASK & 1) && IN(0)) { for (int rep = 0; rep < ((REPEAT_MASK & 1) ? 2 : 1); ++rep) { p0_prologue(F, args); SEAM(0); } }
#pragma unroll 1
    for (int l = 0; l < NL; ++l) {
        const int pb = 1 + 7 * l;
        if ((PH_MASK & 2) && IN(pb + 0)) { for (int rep = 0; rep < ((REPEAT_MASK & 2) ? 2 : 1); ++rep) { run_gemm1(F.lds, F.ws, l, F.G, (int)blockIdx.x); SEAM(pb + 0); }
            if (PROBE_EXTRA_NN && l == 0) { run_gemm_probe(F.lds, F.ws, F.G, (int)blockIdx.x); xcd_barrier(bar); } }
        if ((PH_MASK & 4) && IN(pb + 1)) { for (int rep = 0; rep < ((REPEAT_MASK & 4) ? 2 : 1); ++rep) { p2_mixer(F, args, l); SEAM(pb + 1); } }
        if ((PH_MASK & 8) && IN(pb + 2)) { for (int rep = 0; rep < ((REPEAT_MASK & 8) ? 2 : 1); ++rep) { run_gemm2(F.lds, F.ws, l, F.G, (int)blockIdx.x); SEAM(pb + 2); } }
        if ((PH_MASK & 16) && IN(pb + 3)) {
            if (REPEAT_MASK & 16) { p4_ln_router(F, args, l); SEAM(pb + 3);
                if (blockIdx.x == 0 && F.tid < 32) __hip_atomic_store(F.ctl + CW_CNT + (l * 32 + F.tid) * 64, 0u, RLX_AGENT);
                SEAM(pb + 3); }
            p4_ln_router(F, args, l); SEAM(pb + 3); }
        if ((PH_MASK & 32) && IN(pb + 4)) { for (int rep = 0; rep < ((REPEAT_MASK & 32) ? 2 : 1); ++rep) { moe_table(F, l); run_gemm5(F.lds, F.ws, l, F.G, (int)blockIdx.x); SEAM(pb + 4); } }
        if ((PH_MASK & 64) && IN(pb + 5)) { for (int rep = 0; rep < ((REPEAT_MASK & 64) ? 2 : 1); ++rep) { moe_table(F, l); run_gemm6(F.lds, F.ws, l, F.G, (int)blockIdx.x); SEAM(pb + 5); } }
        if ((PH_MASK & 128) && IN(pb + 6)) { for (int rep = 0; rep < (((REPEAT_MASK & 128) && l == NL - 1) ? 2 : 1); ++rep) { moe_table(F, l); p7_combine_ln(F, args, l); if (rep == 0) SEAM(pb + 6); else xcd_barrier(bar); } }
    }
#undef IN
#undef SEAM
}

extern "C" void kernel_launch(void* const* d_in, const int* in_sizes, int n_in, void* d_out, int out_size, void* d_ws, size_t ws_size, hipStream_t stream) {
    static int grid = 0;
    if (grid == 0) {
        if (n_in != 21 || out_size != T_ * D_ || ws_size < WS_END) { fprintf(stderr, "kernel_launch: unexpected problem (n_in %d, out %d, ws %zu); nothing launched\n", n_in, out_size, ws_size); grid = -1; return; }
        int dev = 0, cus = 0, per_cu = 0;
        if (hipGetDevice(&dev) != hipSuccess || hipDeviceGetAttribute(&cus, hipDeviceAttributeMultiprocessorCount, dev) != hipSuccess) { grid = -1; return; }
        if (hipFuncSetAttribute((const void*)mk_fwd, hipFuncAttributeMaxDynamicSharedMemorySize, LDS_BYTES) != hipSuccess) { fprintf(stderr, "kernel_launch: hipFuncSetAttribute failed\n"); grid = -1; return; }
        if (hipOccupancyMaxActiveBlocksPerMultiprocessor(&per_cu, (const void*)mk_fwd, NWAVES * 64, LDS_BYTES) != hipSuccess || per_cu < 1) { fprintf(stderr, "kernel_launch: occupancy query says %d\n", per_cu); }
        (void)hipGetLastError();
        grid = cus;
    }
    if (grid < 0) return;
    (void)hipMemsetAsync((char*)d_ws + WS_CTL, 0, CTL_ZERO_BYTES, stream);
    Args a{};
    for (int i = 0; i < 21; ++i) a.in[i] = (const float*)d_in[i];
    a.out = (float*)d_out; a.ws = (unsigned char*)d_ws;
    if (MK_N_LAUNCHES == 1) { a.ph_lo = 0; a.ph_hi = NPH; hipLaunchKernelGGL(mk_fwd, dim3(grid), dim3(NWAVES * 64), LDS_BYTES, stream, a); }
    else for (int p = 0; p < NPH; ++p) { a.ph_lo = p; a.ph_hi = p + 1; hipLaunchKernelGGL(mk_fwd, dim3(grid), dim3(NWAVES * 64), LDS_BYTES, stream, a); }
}
```

```cpp
#include <hip/hip_runtime.h>
#include <cstdio>
#include <cstdint>

#ifndef MK_N_LAUNCHES
#define MK_N_LAUNCHES 1
#endif
#ifndef PH_MASK
#define PH_MASK 0xff
#endif
#ifndef REPEAT_MASK
#define REPEAT_MASK 0
#endif
#ifndef GEMM2_FP8
#define GEMM2_FP8 1
#endif
#ifndef PROBE_P0
#define PROBE_P0 0
#endif
#ifndef PROBE_MIX
#define PROBE_MIX 0
#endif
#ifndef PROBE_EXTRA_NN
#define PROBE_EXTRA_NN 0
#endif
#ifndef GEMM_SIMPLE_MASK
#define GEMM_SIMPLE_MASK 0
#endif

#define GAS __attribute__((address_space(1)))
#define LAS __attribute__((address_space(3)))
typedef unsigned short bf16;
typedef unsigned v4u __attribute__((ext_vector_type(4)));
typedef unsigned v2u __attribute__((ext_vector_type(2)));
typedef float f32x4 __attribute__((ext_vector_type(4)));
typedef float f32x2 __attribute__((ext_vector_type(2)));
typedef short bf16x8 __attribute__((ext_vector_type(8)));
#define RLX_AGENT __ATOMIC_RELAXED, __HIP_MEMORY_SCOPE_AGENT
#define LDS_WAIT() asm volatile("s_waitcnt lgkmcnt(0)" ::: "memory")
#define VM_WAIT() asm volatile("s_waitcnt vmcnt(0)" ::: "memory")

constexpr int T_ = 32768, D_ = 1024, SEQ_ = 4096, NL = 2, NE = 32, DE = 512;
constexpr int DIN = 2176, N1 = 2304, NZ = 1408;
constexpr float ALPHA = 1.41421356237f, LN_EPS = 1e-5f;
constexpr int NPH = 1 + 7 * NL;

constexpr size_t MiB = 1u << 20;
constexpr size_t WS_CTL = 0, CTL_ZERO_BYTES = 96 * 1024;
constexpr size_t WS_ROUTE = 1 * MiB;
constexpr size_t WS_WRT = 2 * MiB;
constexpr size_t WS_LISTS = 3 * MiB;
constexpr size_t WS_WIN = 11 * MiB;
constexpr size_t WS_WOUT = 20 * MiB;
constexpr size_t WS_WGU = 24 * MiB;
constexpr size_t WS_H8 = 88 * MiB;
constexpr size_t WS_WD = 152 * MiB;
constexpr size_t WS_HB = 216 * MiB;
constexpr size_t WS_Z = 280 * MiB;
constexpr size_t WS_Y = 368 * MiB;
constexpr size_t WS_U = 280 * MiB;
constexpr size_t WS_HID = 280 * MiB;
constexpr size_t WS_Y2S = 352 * MiB;
constexpr size_t WS_END = 496 * MiB;
constexpr int CW_TMO = 0, CW_BAR = 4096, CW_CNT = 16384;

constexpr int RING_BYTES = 131072, LDSCTL_OFF = RING_BYTES, MISC_OFF = LDSCTL_OFF + 320, TAB_OFF = LDSCTL_OFF + 1024;
constexpr int LDS_BYTES = 147456;

__device__ __forceinline__ unsigned f2bf(float f) { unsigned u = __builtin_bit_cast(unsigned, f); return (u + 0x7fffu + ((u >> 16) & 1u)) >> 16; }
__device__ __forceinline__ unsigned pk2(float lo, float hi) { unsigned r; asm("v_cvt_pk_bf16_f32 %0, %1, %2" : "=v"(r) : "v"(lo), "v"(hi)); return r; }
__device__ __forceinline__ float bflo(unsigned u) { return __builtin_bit_cast(float, u << 16); }
__device__ __forceinline__ float bfhi(unsigned u) { return __builtin_bit_cast(float, u & 0xffff0000u); }
template <int CTRL> __device__ __forceinline__ float dpp_mov(float v) { return __builtin_bit_cast(float, __builtin_amdgcn_update_dpp(0, __builtin_bit_cast(int, v), CTRL, 0xf, 0xf, false)); }
__device__ __forceinline__ float wave_sum(float v) {
    v += dpp_mov<0xB1>(v); v += dpp_mov<0x4E>(v); v += dpp_mov<0x141>(v); v += dpp_mov<0x140>(v);
    const int iv = __builtin_bit_cast(int, v);
    return (__builtin_bit_cast(float, __builtin_amdgcn_readlane(iv, 0)) + __builtin_bit_cast(float, __builtin_amdgcn_readlane(iv, 16))) +
           (__builtin_bit_cast(float, __builtin_amdgcn_readlane(iv, 32)) + __builtin_bit_cast(float, __builtin_amdgcn_readlane(iv, 48)));
}
__device__ __forceinline__ unsigned pk4_fp8(float a, float b, float c, float d) {
    int v = 0; v = __builtin_amdgcn_cvt_pk_fp8_f32(a, b, v, false); v = __builtin_amdgcn_cvt_pk_fp8_f32(c, d, v, true); return (unsigned)v; }
__device__ __forceinline__ float sigmoidf_(float x) { return __builtin_amdgcn_rcpf(1.0f + __expf(-x)); }

namespace pg8 {
#define PG8_LAS __attribute__((address_space(3)))
typedef int v8i __attribute__((ext_vector_type(8)));
typedef int v4i __attribute__((ext_vector_type(4)));
constexpr int BM = 256, BK = 64, HALF = 128, HTB = HALF * BK * 2, STAGE_BYTES = 8 * HTB, NXCD = 8, WGM = 8;
__host__ __device__ __forceinline__ int lds_byte(int r, int c) { const int st = (r >> 4) * 2 + (c >> 5), rr = r & 15, cc = c & 31, ob = rr * 64 + cc * 2; return st * 1024 + (ob ^ (((ob >> 9) & 1) << 5)); }
__host__ __device__ __forceinline__ void stage_rc(int b, int& R, int& C) { const int st = b / 1024, sb = b % 1024, swz = sb ^ (((sb >> 9) & 1) << 5); R = (st >> 1) * 16 + swz / 64; C = (st & 1) * 32 + (swz % 64) / 2; }
__host__ __device__ __forceinline__ int perm32(int rho) { const int n = rho >> 4, i = rho & 15; return 8 * (i >> 2) + 4 * n + (i & 3); }

struct Unit { int pm, pn, e, j, rh; };

__device__ __forceinline__ int xcd_remap(int wgid, int nwg) { const int q = nwg / NXCD, r = nwg % NXCD, xcd = wgid % NXCD, off = wgid / NXCD; return (xcd < r ? xcd * (q + 1) : r * (q + 1) + (xcd - r) * q) + off; }

struct DenseOrder {
    static constexpr bool GATHER = false, HAS_HALF = true, HAS_RH = false;
    const char* A; const char* Bt; int K, nM, nN, nwg, G, c, nhalf;
    __device__ void init(const void* A_, const void* Bt_, int M, int N, int K_, int G_, int c_, int half_tile = 0) { A = (const char*)A_; Bt = (const char*)Bt_; K = K_; nM = M / BM; nN = N / BM - half_tile; nwg = nM * nN; G = G_; c = c_; nhalf = half_tile ? nM : 0; }
    __device__ bool next(int i, Unit& u) const {
        const long L = (long)i * G + c; if (L >= nwg + nhalf) return false;
        u.e = 0; u.j = 0; u.rh = -1;
        if (L >= nwg) { u.pm = (int)(L - nwg); u.pn = nN; return true; }
        const int wgid = xcd_remap((int)L, nwg);
        const int nig = WGM * nN, gid = wgid / nig, fm = gid * WGM, gsz = (nM - fm) < WGM ? (nM - fm) : WGM;
        u.pm = fm + ((wgid % nig) % gsz); u.pn = (wgid % nig) / gsz; return true;
    }
    __device__ __forceinline__ bool is_half(const Unit& u) const { return u.pn >= nN; }
    __device__ __forceinline__ int row_half(const Unit&) const { return -1; }
    __device__ __forceinline__ const char* a_tile(const Unit& u) const { return A + (size_t)u.pm * BM * K * 2; }
    __device__ __forceinline__ const char* b_tile(const Unit& u) const { return Bt + (size_t)u.pn * BM * K * 2; }
    __device__ __forceinline__ unsigned a_row_off(const Unit&, int r) const { return (unsigned)(r * K * 2); }
};
struct DenseRowsOrder : DenseOrder {
    static constexpr bool GATHER = true, HAS_HALF = false;
    __device__ __forceinline__ const char* a_tile(const Unit&) const { return A; }
    __device__ __forceinline__ unsigned a_row_off(const Unit& u, int r) const { return (unsigned)(u.pm * BM + r) * (unsigned)(K * 2); }
};
struct MoeOrder {
    static constexpr bool HAS_HALF = false, HAS_RH = true;
    __device__ __forceinline__ bool is_half(const Unit&) const { return false; }
    const char* A; const char* Bt; size_t bexp; int K, nN, nwg, G, c; const PG8_LAS int* tab; const int* lists;
    __device__ bool next(int i, Unit& u) const {
        const int L = i * G + c, nfull = (nwg / G) * G, rem = nwg - nfull;
        int uidx = L; u.rh = -1;
        if (L >= nfull) { if (2 * rem <= G) { if (L >= nfull + 2 * rem) return false; uidx = nfull + ((L - nfull) >> 1); u.rh = (L - nfull) & 1; } else if (L >= nwg) return false; }
        const int wgid = xcd_remap(uidx, nwg);
        const int t = wgid / nN; u.pn = wgid % nN; u.pm = t;
        const int e = tab[80 + t];
        u.e = e; u.j = t - tab[e]; return true;
    }
    __device__ __forceinline__ int row_half(const Unit& u) const { return u.rh; }
    __device__ __forceinline__ const char* b_tile(const Unit& u) const { return Bt + (size_t)u.e * bexp + (size_t)u.pn * BM * K * 2; }
};
struct MoeGatherOrder : MoeOrder {
    static constexpr bool GATHER = true;
    __device__ __forceinline__ const char* a_tile(const Unit&) const { return A; }
    __device__ __forceinline__ unsigned a_row_off(const Unit& u, int r) const {
        const int idx = u.j * BM + r, cnt = tab[40 + u.e];
        const int ii = idx < cnt ? idx : cnt - 1;
        const int tok = lists[(size_t)u.e * 65536 + ii] >> 1;
        return (unsigned)tok * (unsigned)(K * 2);
    }
};
struct MoeRowsOrder : MoeOrder {
    static constexpr bool GATHER = true;
    __device__ __forceinline__ const char* a_tile(const Unit&) const { return A; }
    __device__ __forceinline__ unsigned a_row_off(const Unit& u, int r) const { return (unsigned)(u.pm * BM + r) * (unsigned)(K * 2); }
};
struct MoeDenseOrder : MoeOrder {
    static constexpr bool GATHER = false;
    __device__ __forceinline__ const char* a_tile(const Unit& u) const { return A + (size_t)u.pm * BM * K * 2; }
    __device__ __forceinline__ unsigned a_row_off(const Unit&, int r) const { return (unsigned)(r * K * 2); }
};

__device__ __forceinline__ unsigned cvt_pk_bf16(float lo, float hi) { unsigned r; asm volatile("v_cvt_pk_bf16_f32 %0, %1, %2" : "=v"(r) : "v"(lo), "v"(hi)); return r; }

struct EpiZ {
    static constexpr bool PERM = true;
    bf16* Z;
    __device__ __forceinline__ void operator()(const f32x4 (&acc)[2][2][4][2], const Unit& u, int wr, int wc, int fr, int fq) const {
        const int row0 = u.pm * BM + wr * 64 + fr, cl = wc * 32 + 8 * fq;
        if (u.pn < 6) {
            const bool sg = u.pn >= 3;
            const int zc = (sg ? 768 + (u.pn - 3) * 128 : 384 + u.pn * 128) + cl;
#pragma unroll
            for (int ai = 0; ai < 2; ++ai)
#pragma unroll
                for (int m = 0; m < 4; ++m) {
                    f32x4 a0 = acc[ai][0][m][0], a1 = acc[ai][0][m][1], g0 = acc[ai][1][m][0], g1 = acc[ai][1][m][1];
                    if (sg) {
#pragma unroll
                        for (int q = 0; q < 4; ++q) { g0[q] = sigmoidf_(g0[q]); g1[q] = sigmoidf_(g1[q]); }
                    }
                    a0 = a0 * g0; a1 = a1 * g1;
                    v4u w; w.x = cvt_pk_bf16(a0[0], a0[1]); w.y = cvt_pk_bf16(a0[2], a0[3]); w.z = cvt_pk_bf16(a1[0], a1[1]); w.w = cvt_pk_bf16(a1[2], a1[3]);
                    *(v4u*)(Z + (size_t)(row0 + ai * HALF + m * 16) * NZ + zc) = w;
                }
        } else {
            int zb0, zb1;
            if (u.pn == 6) { zb0 = 0; zb1 = 128; } else if (u.pn == 7) { zb0 = 256; zb1 = 1152; } else { zb0 = 1280; zb1 = -1; }
#pragma unroll
            for (int ai = 0; ai < 2; ++ai)
#pragma unroll
                for (int m = 0; m < 4; ++m) {
                    bf16* rowp = Z + (size_t)(row0 + ai * HALF + m * 16) * NZ + cl;
#pragma unroll
                    for (int bj = 0; bj < 2; ++bj) {
                        const int zb = bj ? zb1 : zb0;
                        if (zb >= 0) { const f32x4 a0 = acc[ai][bj][m][0], a1 = acc[ai][bj][m][1];
                            v4u w; w.x = cvt_pk_bf16(a0[0], a0[1]); w.y = cvt_pk_bf16(a0[2], a0[3]); w.z = cvt_pk_bf16(a1[0], a1[1]); w.w = cvt_pk_bf16(a1[2], a1[3]);
                            *(v4u*)(rowp + zb) = w; }
                    }
                }
        }
    }
};
struct EpiU {
    static constexpr bool PERM = true;
    const bf16* H; bf16* U;
    __device__ __forceinline__ void operator()(const f32x4 (&acc)[2][2][4][2], const Unit& u, int wr, int wc, int fr, int fq) const {
        const int row0 = u.pm * BM + wr * 64 + fr, col0 = u.pn * BM + wc * 32 + 8 * fq;
        v4u hh[2][4][2];
#pragma unroll
        for (int ai = 0; ai < 2; ++ai)
#pragma unroll
            for (int m = 0; m < 4; ++m)
#pragma unroll
                for (int bj = 0; bj < 2; ++bj) hh[ai][m][bj] = *(const v4u*)(H + (size_t)(row0 + ai * HALF + m * 16) * D_ + col0 + bj * HALF);
#pragma unroll
        for (int ai = 0; ai < 2; ++ai)
#pragma unroll
            for (int m = 0; m < 4; ++m) {
                const size_t off = (size_t)(row0 + ai * HALF + m * 16) * D_ + col0;
#pragma unroll
                for (int bj = 0; bj < 2; ++bj) {
                    const v4u h = hh[ai][m][bj];
                    const f32x4 a0 = acc[ai][bj][m][0], a1 = acc[ai][bj][m][1];
                    v4u w;
                    w.x = cvt_pk_bf16(ALPHA * bflo(h.x) + a0[0], ALPHA * bfhi(h.x) + a0[1]); w.y = cvt_pk_bf16(ALPHA * bflo(h.y) + a0[2], ALPHA * bfhi(h.y) + a0[3]);
                    w.z = cvt_pk_bf16(ALPHA * bflo(h.z) + a1[0], ALPHA * bfhi(h.z) + a1[1]); w.w = cvt_pk_bf16(ALPHA * bflo(h.w) + a1[2], ALPHA * bfhi(h.w) + a1[3]);
                    *(v4u*)(U + off + bj * HALF) = w;
                }
            }
    }
};
struct EpiHid {
    static constexpr bool PERM = true;
    unsigned char* HID;
    __device__ __forceinline__ void operator()(const f32x4 (&acc)[2][2][4][2], const Unit& u, int wr, int wc, int fr, int fq) const {
        const int row0 = u.pm * BM + wr * 64 + fr, col0 = u.pn * 128 + wc * 32 + 8 * fq;
#pragma unroll
        for (int ai = 0; ai < 2; ++ai) { if (u.rh >= 0 && u.rh != ai) continue;
#pragma unroll
            for (int m = 0; m < 4; ++m) {
                f32x4 g0 = acc[ai][0][m][0], g1 = acc[ai][0][m][1]; const f32x4 u0 = acc[ai][1][m][0], u1 = acc[ai][1][m][1];
#pragma unroll
                for (int q = 0; q < 4; ++q) { g0[q] = g0[q] * sigmoidf_(g0[q]); g1[q] = g1[q] * sigmoidf_(g1[q]); }
                g0 = g0 * u0; g1 = g1 * u1;
                v2u w; w.x = pk4_fp8(g0[0], g0[1], g0[2], g0[3]); w.y = pk4_fp8(g1[0], g1[1], g1[2], g1[3]);
                *(v2u*)(HID + (size_t)(row0 + ai * HALF + m * 16) * DE + col0) = w;
            } }
    }
};
struct EpiPlain8 {
    static constexpr bool PERM = true;
    unsigned char* O; int ldc;
    __device__ __forceinline__ void operator()(const f32x4 (&acc)[2][2][4][2], const Unit& u, int wr, int wc, int fr, int fq) const {
        const int row0 = u.pm * BM + wr * 64 + fr, col0 = u.pn * BM + wc * 32 + 8 * fq;
#pragma unroll
        for (int ai = 0; ai < 2; ++ai) { if (u.rh >= 0 && u.rh != ai) continue;
#pragma unroll
            for (int m = 0; m < 4; ++m) {
                unsigned char* rowp = O + (size_t)(row0 + ai * HALF + m * 16) * ldc + col0;
#pragma unroll
                for (int bj = 0; bj < 2; ++bj) { const f32x4 a0 = acc[ai][bj][m][0], a1 = acc[ai][bj][m][1];
                    v2u w; w.x = pk4_fp8(a0[0], a0[1], a0[2], a0[3]); w.y = pk4_fp8(a1[0], a1[1], a1[2], a1[3]);
                    *(v2u*)(rowp + bj * HALF) = w; }
            } }
    }
};
struct EpiPlain {
    static constexpr bool PERM = true;
    bf16* O; int ldc;
    __device__ __forceinline__ void operator()(const f32x4 (&acc)[2][2][4][2], const Unit& u, int wr, int wc, int fr, int fq) const {
        const int row0 = u.pm * BM + wr * 64 + fr, col0 = u.pn * BM + wc * 32 + 8 * fq;
#pragma unroll
        for (int ai = 0; ai < 2; ++ai)
#pragma unroll
            for (int m = 0; m < 4; ++m) {
                bf16* rowp = O + (size_t)(row0 + ai * HALF + m * 16) * ldc + col0;
#pragma unroll
                for (int bj = 0; bj < 2; ++bj) { const f32x4 a0 = acc[ai][bj][m][0], a1 = acc[ai][bj][m][1];
                    v4u w; w.x = cvt_pk_bf16(a0[0], a0[1]); w.y = cvt_pk_bf16(a0[2], a0[3]); w.z = cvt_pk_bf16(a1[0], a1[1]); w.w = cvt_pk_bf16(a1[2], a1[3]);
                    *(v4u*)(rowp + bj * HALF) = w; }
            }
    }
};

template <class Epi, class Sched>
__device__ __forceinline__ void gemm_phase_simple(const Sched& S, const Epi& E) {
    int tid = threadIdx.x; asm volatile("" : "+v"(tid));
    const int wid = __builtin_amdgcn_readfirstlane(tid >> 6), lane = tid & 63, wr = wid >> 2, wc = wid & 3, fr = lane & 15, fq = lane >> 4;
    const int K = S.K;
    Unit cur;
    for (int ui = 0; S.next(ui, cur); ++ui) {
        f32x4 acc[2][2][4][2];
#pragma unroll
        for (int a = 0; a < 2; ++a)
#pragma unroll
            for (int b = 0; b < 2; ++b)
#pragma unroll
                for (int m = 0; m < 4; ++m)
#pragma unroll
                    for (int n = 0; n < 2; ++n) acc[a][b][m][n] = (f32x4){0.f, 0.f, 0.f, 0.f};
        const char* at = S.a_tile(cur); const char* bt = S.b_tile(cur);
        const char* ap[2][4]; const char* bp[2][2];
#pragma unroll
        for (int ai = 0; ai < 2; ++ai)
#pragma unroll
            for (int m = 0; m < 4; ++m) ap[ai][m] = at + S.a_row_off(cur, ai * HALF + wr * 64 + m * 16 + fr) + fq * 16;
#pragma unroll
        for (int bj = 0; bj < 2; ++bj)
#pragma unroll
            for (int n = 0; n < 2; ++n) { const int rho = n * 16 + fr; bp[bj][n] = bt + (size_t)(bj * HALF + wc * 32 + (Epi::PERM ? perm32(rho) : rho)) * K * 2 + fq * 16; }
        for (int k0 = 0; k0 < K; k0 += 32) {
            bf16x8 a[2][4], b[2][2];
#pragma unroll
            for (int ai = 0; ai < 2; ++ai)
#pragma unroll
                for (int m = 0; m < 4; ++m) a[ai][m] = *(const bf16x8*)(ap[ai][m] + k0 * 2);
#pragma unroll
            for (int bj = 0; bj < 2; ++bj)
#pragma unroll
                for (int n = 0; n < 2; ++n) b[bj][n] = *(const bf16x8*)(bp[bj][n] + k0 * 2);
#pragma unroll
            for (int ai = 0; ai < 2; ++ai)
#pragma unroll
                for (int bj = 0; bj < 2; ++bj)
#pragma unroll
                    for (int m = 0; m < 4; ++m)
#pragma unroll
                        for (int n = 0; n < 2; ++n) acc[ai][bj][m][n] = __builtin_amdgcn_mfma_f32_16x16x32_bf16(b[bj][n], a[ai][m], acc[ai][bj][m][n], 0, 0, 0);
        }
        E(acc, cur, wr, wc, fr, fq);
    }
}

template <int OFF> __device__ __forceinline__ void glds16(const char* base, unsigned voff, unsigned lds_base) {
    asm volatile("s_add_u32 m0, %2, %3\n\ts_nop 0\n\tglobal_load_lds_dwordx4 %0, %1" :: "v"(voff), "s"(base), "s"(lds_base), "n"(OFF) : "memory", "m0", "scc");
}
template <class Epi, class Sched, bool FP8 = false>
__device__ __forceinline__ void gemm_phase(PG8_LAS unsigned char* lds, const Sched& S, const Epi& E) {
    constexpr bool GATHER = Sched::GATHER;
    int tid = threadIdx.x; asm volatile("" : "+v"(tid));
    const int wid = __builtin_amdgcn_readfirstlane(tid >> 6), lane = tid & 63, wr = wid >> 2, wc = wid & 3, fr = lane & 15, fq = lane >> 4;
    const int K = S.K, nt = K / BK;
    unsigned voffB[2], offA[4], nxA[4];
#pragma unroll
    for (int i = 0; i < 2; ++i) { int R, C; stage_rc(tid * 16 + i * 8192, R, C); const int Rb = Epi::PERM ? ((R & ~31) + perm32(R & 31)) : R;
        voffB[i] = (unsigned)(Rb * K + C) * 2u; offA[i] = (unsigned)(R * K + C) * 2u; offA[2 + i] = (unsigned)((R + HALF) * K + C) * 2u; nxA[i] = 0u; nxA[2 + i] = 0u; }
    const size_t kstep = (size_t)(BK * 2);
    const size_t hstep = (size_t)HALF * K * 2;
    const unsigned ldsw = (unsigned)wid * 1024u;
    const unsigned ldsbw = (unsigned)(size_t)lds + ldsw;
    const int aoff = lds_byte(wr * 64 + fr, fq * 8), boff = lds_byte(wc * 32 + fr, fq * 8);
#define PG8_SA(b, h) (((b) * 2 + (h)) * HTB)
#define PG8_SB(b, h) ((4 + (b) * 2 + (h)) * HTB)
#define PG8_STAGE_B(bufoff, gbase) do { glds16<(bufoff)>((const char*)(gbase), voffB[0], ldsbw); glds16<(bufoff) + 8192>((const char*)(gbase), voffB[1], ldsbw); } while (0)
#define PG8_STAGE_A(bufoff, gbase, h) do { glds16<(bufoff)>((const char*)(gbase), offA[(h) * 2], ldsbw); glds16<(bufoff) + 8192>((const char*)(gbase), offA[(h) * 2 + 1], ldsbw); } while (0)
#define PG8_LDA(dst, b, h) do { _Pragma("unroll") for (int m = 0; m < 4; ++m) _Pragma("unroll") for (int k = 0; k < 2; ++k) dst[m][k] = *(const PG8_LAS bf16x8*)(lds + PG8_SA(b, h) + aoff + m * 2048 + k * 1024); } while (0)
#define PG8_LDB(dst, b, h) do { _Pragma("unroll") for (int n = 0; n < 2; ++n) _Pragma("unroll") for (int k = 0; k < 2; ++k) dst[n][k] = *(const PG8_LAS bf16x8*)(lds + PG8_SB(b, h) + boff + n * 2048 + k * 1024); } while (0)
#define PG8_MMA(ai, bj, At, Bt) do { __builtin_amdgcn_s_setprio(1); if constexpr (FP8) { _Pragma("unroll") for (int m = 0; m < 4; ++m) _Pragma("unroll") for (int n = 0; n < 2; ++n) { \
            const v8i _b = __builtin_shufflevector(__builtin_bit_cast(v4i, Bt[n][0]), __builtin_bit_cast(v4i, Bt[n][1]), 0, 1, 2, 3, 4, 5, 6, 7); \
            const v8i _a = __builtin_shufflevector(__builtin_bit_cast(v4i, At[m][0]), __builtin_bit_cast(v4i, At[m][1]), 0, 1, 2, 3, 4, 5, 6, 7); \
            acc[ai][bj][m][n] = __builtin_amdgcn_mfma_scale_f32_16x16x128_f8f6f4(_b, _a, acc[ai][bj][m][n], 0, 0, 0, 0x7A7A7A7A, 0, 0x7F7F7F7F); } } \
        else { _Pragma("unroll") for (int m = 0; m < 4; ++m) _Pragma("unroll") for (int n = 0; n < 2; ++n) _Pragma("unroll") for (int k = 0; k < 2; ++k) \
        acc[ai][bj][m][n] = __builtin_amdgcn_mfma_f32_16x16x32_bf16(Bt[n][k], At[m][k], acc[ai][bj][m][n], 0, 0, 0); } __builtin_amdgcn_s_setprio(0); } while (0)
#define PG8_WAIT_V(n) asm volatile("s_waitcnt vmcnt(" #n ")" ::: "memory")
#define PG8_WAIT_L(n) asm volatile("s_waitcnt lgkmcnt(" #n ")" ::: "memory")
#define PG8_BAR __builtin_amdgcn_s_barrier()
#define PG8_SCHED __builtin_amdgcn_sched_barrier(0)
#define PG8_OFFS(dst, u) do { if constexpr (GATHER) { _Pragma("unroll") for (int _h = 0; _h < 2; ++_h) _Pragma("unroll") for (int _i = 0; _i < 2; ++_i) { \
        int _R, _C; stage_rc(tid * 16 + _i * 8192, _R, _C); dst[_h * 2 + _i] = S.a_row_off(u, _h * HALF + _R) + (unsigned)(_C * 2); } } } while (0)
    Unit cur, nxt; int ui = 0;
    if (!S.next(0, cur)) return;
    f32x4 acc[2][2][4][2];
#pragma unroll
    for (int a = 0; a < 2; ++a)
#pragma unroll
        for (int b = 0; b < 2; ++b)
#pragma unroll
            for (int m = 0; m < 4; ++m)
#pragma unroll
                for (int n = 0; n < 2; ++n) acc[a][b][m][n] = (f32x4){0.f, 0.f, 0.f, 0.f};
    bf16x8 At[4][2], B0[2][2], B1[2][2];
    const char* cA = S.a_tile(cur); const char* cB = S.b_tile(cur);
    PG8_OFFS(offA, cur);
    PG8_STAGE_B(PG8_SB(0, 0), cB); PG8_STAGE_B(PG8_SB(0, 1), cB + hstep); PG8_STAGE_A(PG8_SA(0, 0), cA, 0); PG8_STAGE_A(PG8_SA(0, 1), cA, 1);
    if (wr == 1) PG8_BAR;
    PG8_WAIT_V(2); PG8_BAR;
    PG8_STAGE_B(PG8_SB(1, 0), cB + kstep); PG8_STAGE_A(PG8_SA(1, 0), cA + kstep, 0); PG8_STAGE_B(PG8_SB(1, 1), cB + hstep + kstep);
    PG8_WAIT_V(6); PG8_BAR;
    for (;;) {
        const bool has_next = S.next(ui + 1, nxt);
        const char* nA = has_next ? S.a_tile(nxt) : cA; const char* nB = has_next ? S.b_tile(nxt) : cB;
        if constexpr (GATHER) { if (has_next) { PG8_OFFS(nxA, nxt); } }
#pragma unroll 1
        for (int t = 0; t < nt; t += 2) {
            const bool last = (t == nt - 2);
            const char* a1 = cA + (size_t)(t + 1) * kstep;
            const char* a2 = last ? nA : cA + (size_t)(t + 2) * kstep; const char* b2 = last ? nB : cB + (size_t)(t + 2) * kstep;
            const char* a3 = a2 + kstep; const char* b3 = b2 + kstep;
            PG8_LDB(B0, 0, 0); PG8_LDB(B1, 0, 1); PG8_SCHED; PG8_LDA(At, 0, 0); PG8_STAGE_A(PG8_SA(1, 1), a1, 1);
            if constexpr (GATHER) { if (last && has_next) {
#pragma unroll
                for (int q = 0; q < 4; ++q) offA[q] = nxA[q]; } }
            PG8_WAIT_V(8); PG8_WAIT_L(0); PG8_BAR; if (!(Sched::HAS_RH && cur.rh == 1)) { PG8_MMA(0, 0, At, B0); if (!(Sched::HAS_HALF && S.is_half(cur))) PG8_MMA(0, 1, At, B1); } PG8_BAR; PG8_SCHED;
            PG8_LDA(At, 0, 1); PG8_STAGE_B(PG8_SB(0, 0), b2); PG8_STAGE_B(PG8_SB(0, 1), b2 + hstep); PG8_STAGE_A(PG8_SA(0, 0), a2, 0);
            PG8_WAIT_V(8); PG8_WAIT_L(0); PG8_BAR; if (!(Sched::HAS_RH && cur.rh == 0)) { PG8_MMA(1, 0, At, B0); if (!(Sched::HAS_HALF && S.is_half(cur))) PG8_MMA(1, 1, At, B1); } PG8_BAR; PG8_SCHED;
            PG8_LDB(B0, 1, 0); PG8_LDB(B1, 1, 1); PG8_SCHED; PG8_LDA(At, 1, 0); PG8_STAGE_A(PG8_SA(0, 1), a2, 1);
            PG8_WAIT_V(8); PG8_WAIT_L(0); PG8_BAR; if (!(Sched::HAS_RH && cur.rh == 1)) { PG8_MMA(0, 0, At, B0); if (!(Sched::HAS_HALF && S.is_half(cur))) PG8_MMA(0, 1, At, B1); } PG8_BAR; PG8_SCHED;
            PG8_LDA(At, 1, 1); PG8_STAGE_B(PG8_SB(1, 0), b3); PG8_STAGE_B(PG8_SB(1, 1), b3 + hstep); PG8_STAGE_A(PG8_SA(1, 0), a3, 0);
            PG8_WAIT_V(8); PG8_WAIT_L(0); PG8_BAR; if (!(Sched::HAS_RH && cur.rh == 0)) { PG8_MMA(1, 0, At, B0); if (!(Sched::HAS_HALF && S.is_half(cur))) PG8_MMA(1, 1, At, B1); } PG8_BAR; PG8_SCHED;
        }
        if (wr == 0) PG8_BAR;
        E(acc, cur, wr, wc, fr, fq);
        if (!has_next) break;
#pragma unroll
        for (int a = 0; a < 2; ++a)
#pragma unroll
            for (int b = 0; b < 2; ++b)
#pragma unroll
                for (int m = 0; m < 4; ++m)
#pragma unroll
                    for (int n = 0; n < 2; ++n) acc[a][b][m][n] = (f32x4){0.f, 0.f, 0.f, 0.f};
        cur = nxt; cA = nA; cB = nB; ++ui;
        if (wr == 1) PG8_BAR;
    }
    PG8_WAIT_V(0);
    PG8_BAR;
#undef PG8_SA
#undef PG8_SB
#undef PG8_STAGE_A
#undef PG8_STAGE_B
#undef PG8_LDA
#undef PG8_LDB
#undef PG8_MMA
#undef PG8_WAIT_V
#undef PG8_WAIT_L
#undef PG8_BAR
#undef PG8_SCHED
#undef PG8_OFFS
}
}

#define XB_TMO      128
#define XB_XCNT(j)  (256  + 64 * (j))
#define XB_XSUB(j)  (1280 + 64 * (j))
#define XB_XGEN(j)  (2304 + 64 * (j))
#define XB_TOP      3328
#define XB_TOPGEN   3392
#define XCD_BAR_WORDS 3456
#define XB_SPIN_CAP (1u << 18)
__device__ __forceinline__ unsigned xb_ld(unsigned* p)              { return __hip_atomic_load(p, __ATOMIC_RELAXED, __HIP_MEMORY_SCOPE_AGENT); }
__device__ __forceinline__ unsigned xb_add(unsigned* p, unsigned v) { return __hip_atomic_fetch_add(p, v, __ATOMIC_RELAXED, __HIP_MEMORY_SCOPE_AGENT); }
__device__ __forceinline__ unsigned xb_xcc_id() { return (unsigned)__builtin_amdgcn_s_getreg((3 << 11) | 20) & 0xFu; }
#define XB_SPIN(cond, bar) do { unsigned _sp = 0; while (cond) { __builtin_amdgcn_s_sleep(1); \
    if ((++_sp & 255u) == 0u) { if (xb_ld(&(bar)[XB_TMO])) break; if (_sp > XB_SPIN_CAP) { atomicAdd(&(bar)[XB_TMO], 1u); break; } } } } while (0)
struct XcdBarrier { unsigned* bar; unsigned x; volatile LAS unsigned* st; };
__device__ __forceinline__ XcdBarrier xcd_barrier_post(unsigned* bar, volatile LAS unsigned* st) {
    XcdBarrier b; b.bar = bar; b.x = xb_xcc_id(); b.st = st;
    if (threadIdx.x == 0) (void)xb_add(&bar[XB_XCNT(b.x)], 1u);
    return b;
}
__device__ __forceinline__ void xcd_barrier_complete(unsigned* bar, unsigned x, unsigned& nloc, unsigned& nx) {
    const unsigned G = gridDim.x * gridDim.y * gridDim.z;
    unsigned sum, cnt, mine, sp = 0u;
    for (;;) {
        sum = 0u; cnt = 0u; mine = 0u;
#pragma unroll
        for (unsigned j = 0; j < 16; ++j) { const unsigned c = xb_ld(&bar[XB_XCNT(j)]); sum += c; cnt += (c > 0u) ? 1u : 0u; mine = (j == x) ? c : mine; }
        if (sum == G) break;
        __builtin_amdgcn_s_sleep(1);
        if ((++sp & 255u) == 0u) { if (xb_ld(&bar[XB_TMO])) break; if (sp > XB_SPIN_CAP) { atomicAdd(&bar[XB_TMO], 1u); break; } }
    }
    nloc = mine > 0u ? mine : 1u; nx = cnt > 0u ? cnt : 1u;
}
__device__ __forceinline__ void xcd_barrier(const XcdBarrier& b) {
    asm volatile("s_waitcnt vmcnt(0)" ::: "memory");
    __syncthreads();
    if (threadIdx.x == 0) {
        unsigned* bar = b.bar;
        __builtin_amdgcn_s_waitcnt(0);
        unsigned nloc = b.st[0], nx = b.st[1];
        if (nloc == 0u) { xcd_barrier_complete(bar, b.x, nloc, nx); b.st[0] = nloc; b.st[1] = nx; }
        const unsigned old = xb_add(&bar[XB_XSUB(b.x)], 1u);
        const unsigned gen = old / nloc;
        if (old + 1u == (gen + 1u) * nloc) {
            __builtin_amdgcn_fence(__ATOMIC_RELEASE, "agent");
            asm volatile("s_waitcnt vmcnt(0)" ::: "memory");
            const unsigned og = xb_add(&bar[XB_TOP], 1u);
            const unsigned tg = og / nx;
            if (og + 1u == (tg + 1u) * nx) xb_add(&bar[XB_TOPGEN], 1u);
            else XB_SPIN(xb_ld(&bar[XB_TOPGEN]) == tg, bar);
            __builtin_amdgcn_fence(__ATOMIC_ACQUIRE, "agent");
            xb_add(&bar[XB_XGEN(b.x)], 1u);
            asm volatile("s_waitcnt vmcnt(0)" ::: "memory");
        } else {
            XB_SPIN(xb_ld(&bar[XB_XGEN(b.x)]) == gen, bar);
            __builtin_amdgcn_fence(__ATOMIC_ACQUIRE, "agent");
            asm volatile("s_waitcnt vmcnt(0)" ::: "memory");
        }
    }
    __syncthreads();
}

constexpr int NWAVES = 8;
struct Args { const float* in[21]; float* out; unsigned char* ws; int ph_lo, ph_hi; };
struct Frame {
    LAS unsigned char* lds;
    unsigned* ctl;
    int tid, lane, wave, vcu, G;
    unsigned char* ws;
};
enum { I_X = 0, I_LNIG, I_LNIB, I_RW, I_RB, I_WIN, I_CAW, I_CBW, I_CBB, I_LCG, I_LCB, I_PW, I_PS, I_WOUT, I_LMG, I_LMB, I_WG, I_WU, I_WDN, I_LFG, I_LFB };

__device__ __forceinline__ void tr_item(const float* src, int srcN, int srccol0, bf16* dst, int dstK, int dstrow0, int k0, LAS float* scr, int lane) {
#pragma unroll 8
    for (int i = 0; i < 32; ++i) { const int kk = 2 * i + (lane >> 5); scr[kk * 33 + (lane & 31)] = src[(size_t)(k0 + kk) * srcN + srccol0 + (lane & 31)]; }
    LDS_WAIT(); asm volatile("" ::: "memory");
    const int c = lane & 7;
#pragma unroll
    for (int j = 0; j < 4; ++j) { const int n = (lane >> 3) + 8 * j; const LAS float* s = scr + (8 * c) * 33 + n;
        v4u o; o.x = pk2(s[0 * 33], s[1 * 33]); o.y = pk2(s[2 * 33], s[3 * 33]); o.z = pk2(s[4 * 33], s[5 * 33]); o.w = pk2(s[6 * 33], s[7 * 33]);
        *(GAS v4u*)(dst + (size_t)(dstrow0 + n) * dstK + k0 + 8 * c) = o; }
    LDS_WAIT(); asm volatile("" ::: "memory");
}
__device__ __forceinline__ void tr_item64(const float* src, int srcN, int srccol0, bf16* dst, int dstK, int dstrow0, int k0, LAS unsigned* scr, int lane) {
    const int kr = lane >> 4, c4 = lane & 15;
    const float* sp = src + (size_t)(k0 + 2 * kr) * srcN + srccol0 + 4 * c4;
    f32x4 A[8], B[8];
#pragma unroll
    for (int i = 0; i < 8; ++i) { A[i] = *(const GAS f32x4*)(sp + (size_t)(8 * i) * srcN); B[i] = *(const GAS f32x4*)(sp + (size_t)(8 * i + 1) * srcN); }
#pragma unroll
    for (int i = 0; i < 8; ++i) { LAS unsigned* w = scr + (4 * i + kr) * 65 + 4 * c4;
        w[0] = pk2(A[i].x, B[i].x); w[1] = pk2(A[i].y, B[i].y); w[2] = pk2(A[i].z, B[i].z); w[3] = pk2(A[i].w, B[i].w); }
    LDS_WAIT(); asm volatile("" ::: "memory");
    const int q = lane & 7, nn = lane >> 3;
#pragma unroll
    for (int j = 0; j < 8; ++j) { const int n = nn + 8 * j; const LAS unsigned* r = scr + (4 * q) * 65 + n;
        v4u o; o.x = r[0]; o.y = r[65]; o.z = r[130]; o.w = r[195];
        *(GAS v4u*)(dst + (size_t)(dstrow0 + n) * dstK + k0 + 8 * q) = o; }
    LDS_WAIT(); asm volatile("" ::: "memory");
}
template <int NS>
__device__ __forceinline__ void tr_item64_f8(const float* src, int srcN, int srccol0, unsigned char* dst, int dstKB, int dstrow0, int k0, float scale, LAS unsigned* scr, int lane, bool nostore = false) {
    const int kr = lane >> 4, c4 = lane & 15;
    const float* sp = src + (size_t)(k0 + 4 * kr) * srcN + srccol0 + 4 * c4;
    f32x4 A[NS][4][4];
#pragma unroll
    for (int s = 0; s < NS; ++s)
#pragma unroll
        for (int i = 0; i < 4; ++i)
#pragma unroll
            for (int t = 0; t < 4; ++t) A[s][i][t] = *(const GAS f32x4*)(sp + (size_t)(64 * s + 16 * i + t) * srcN);
#pragma unroll
    for (int s = 0; s < NS; ++s)
#pragma unroll
        for (int i = 0; i < 4; ++i) { LAS unsigned* w = scr + (16 * s + 4 * i + kr) * 65 + 4 * c4;
            w[0] = pk4_fp8(A[s][i][0].x * scale, A[s][i][1].x * scale, A[s][i][2].x * scale, A[s][i][3].x * scale); w[1] = pk4_fp8(A[s][i][0].y * scale, A[s][i][1].y * scale, A[s][i][2].y * scale, A[s][i][3].y * scale);
            w[2] = pk4_fp8(A[s][i][0].z * scale, A[s][i][1].z * scale, A[s][i][2].z * scale, A[s][i][3].z * scale); w[3] = pk4_fp8(A[s][i][0].w * scale, A[s][i][1].w * scale, A[s][i][2].w * scale, A[s][i][3].w * scale); }
    LDS_WAIT(); asm volatile("" ::: "memory");
    constexpr int QN = 4 * NS, RN = 64 / QN;
    const int q = lane % QN, nn = lane / QN;
#pragma unroll
    for (int j = 0; j < 64 / RN; ++j) { const int n = nn + RN * j; const LAS unsigned* r = scr + (4 * q) * 65 + n;
        v4u o; o.x = r[0]; o.y = r[65]; o.z = r[130]; o.w = r[195];
        if (nostore) asm volatile("" :: "v"(o)); else *(GAS v4u*)(dst + (size_t)(dstrow0 + n) * dstKB + k0 + 16 * q) = o; }
    LDS_WAIT(); asm volatile("" ::: "memory");
}
__device__ __forceinline__ int win_src(int c0) {
    const int pn = c0 >> 8, j = c0 & 255, half = j >> 7, jj = j & 127;
    if (pn < 3) { const int ch = pn * 128 + jj; return half == 0 ? 384 + ch : 768 + ch; }
    if (pn < 6) { const int ch = (pn - 3) * 128 + jj; return half == 0 ? 1152 + ch : 1536 + ch; }
    if (pn < 8) { const int q = (pn - 6) * 256 + j; return q < 384 ? q : 1920 + (q - 384); }
    return j < 128 ? 1920 + 128 + j : -1;
}
__device__ __forceinline__ void p0_prologue(Frame& F, const Args& A) {
    LAS float* scr = (LAS float*)(F.lds + F.wave * 8448);
    LAS unsigned* scu = (LAS unsigned*)scr;
    const int gw = F.vcu * NWAVES + F.wave, NGW = F.G * NWAVES, lane = F.lane;
    bf16* WIN = (bf16*)(F.ws + WS_WIN); bf16* WOUT = (bf16*)(F.ws + WS_WOUT); unsigned char* WGU = F.ws + WS_WGU; unsigned char* WD = F.ws + WS_WD; bf16* WRT = (bf16*)(F.ws + WS_WRT);
    constexpr int I_A = NL * 16 * 36, I_B = NL * 12 * 16, I_C = NL * NE * 128, I_D = NL * NE * 64, I_E = 16, I_F = NL * 4 * 16 * 2;
    constexpr int NITEMS = I_A + I_B + I_C + I_D + I_E + I_F;
    const int lane0 = lane;
#pragma unroll 1
    for (int prep = 0; prep < ((PROBE_P0 == 1 || PROBE_P0 == 3) ? 2 : 1); ++prep)
    for (int it = gw; it < NITEMS; it += NGW) {
        int lane = lane0; asm volatile("" : "+v"(lane));
        int r = it;
        if (r < I_C) {
            const int le = r >> 7, q = r & 127, kb = q >> 4, nb = q & 15, n0 = nb * 64, pn = n0 >> 8, half = (n0 & 255) >> 7, jj0 = n0 & 127;
            const float* src = (half ? A.in[I_WU] : A.in[I_WG]) + (size_t)le * 1024 * 512;
            tr_item64_f8<2>(src, 512, pn * 128 + jj0, WGU + (size_t)le * 1024 * 1024, 1024, n0, kb * 128, 32.0f, scu, lane, PROBE_P0 == 3 && prep == 1); continue; }
        r -= I_C;
        if (r < I_D) {
            const int le = r >> 6, q = r & 63, kb = q >> 4, nb = q & 15;
            tr_item64_f8<2>(A.in[I_WDN] + (size_t)le * 512 * 1024, 1024, nb * 64, WD + (size_t)le * 1024 * 512, 512, nb * 64, kb * 128, 32.0f, scu, lane, PROBE_P0 == 3 && prep == 1); continue; }
        r -= I_D;
        if (r < I_A) {
            const int l = r / 576, q = r % 576, kb = q / 36, nb = q % 36, c0 = nb * 64, sc = win_src(c0);
            bf16* dst = WIN + (size_t)l * N1 * 1024;
            if (sc >= 0) tr_item64(A.in[I_WIN] + (size_t)l * 1024 * DIN, DIN, sc, dst, 1024, c0, kb * 64, scu, lane);
            else { const int c = lane & 7;
#pragma unroll
                for (int j = 0; j < 8; ++j) { const int n = (lane >> 3) + 8 * j; *(GAS v4u*)(dst + (size_t)(c0 + n) * 1024 + kb * 64 + 8 * c) = (v4u){0u, 0u, 0u, 0u}; } }
            continue; }
        r -= I_A;
        if (r < I_B) {
            const int l = r / 192, q = r % 192, kb = q >> 4, nb = q & 15;
            if (GEMM2_FP8) tr_item64_f8<1>(A.in[I_WOUT] + (size_t)l * 1024 * 1024, 1024, nb * 64, (unsigned char*)WOUT + (size_t)l * 1024 * 1024, 1024, nb * 64, kb * 64, 32.0f, scu, lane);
            else tr_item64(A.in[I_WOUT] + (size_t)l * 1024 * 1024, 1024, nb * 64, WOUT + (size_t)l * 1024 * 1024, 1024, nb * 64, kb * 64, scu, lane);
            continue; }
        r -= I_B;
        if (r < I_E) { tr_item(A.in[I_RW], 32, 0, WRT, 1024, 0, r * 64, scr, lane); continue; }
        r -= I_E;
        {
            const int l = r >> 7, g = (r >> 5) & 3, nb = (r >> 1) & 15, cb = r & 1, n = nb * 64 + lane;
            const float* wo = A.in[I_WOUT] + (size_t)l * 1024 * 1024 + (size_t)(768 + g * 64) * 1024 + n;
            const float* ps = A.in[I_PS] + l * 256 + g * 64;
            const float* pw = A.in[I_PW] + (size_t)(l * 4 + g) * 64 * 64 + cb * 32 * 64;
#pragma unroll
            for (int i = 0; i < 8; ++i) *(LAS f32x4*)(scr + (i * 64 + lane) * 4) = *(const GAS f32x4*)(pw + (i * 64 + lane) * 4);
            float wv[64];
#pragma unroll
            for (int d = 0; d < 64; ++d) wv[d] = wo[(size_t)d * 1024] * ps[d];
            LDS_WAIT(); asm volatile("" ::: "memory");
            bf16* dst = WOUT + (size_t)l * 1024 * 1024 + (size_t)n * 1024 + 768 + g * 64 + cb * 32;
#pragma unroll 1
            for (int c2 = 0; c2 < 16; ++c2) { float o[2];
#pragma unroll
                for (int cc = 0; cc < 2; ++cc) { const LAS f32x4* pr = (const LAS f32x4*)(scr + (c2 * 2 + cc) * 64); float a = 0.f;
#pragma unroll
                    for (int d4 = 0; d4 < 16; ++d4) { const f32x4 p = pr[d4]; a += p.x * wv[4 * d4] + p.y * wv[4 * d4 + 1] + p.z * wv[4 * d4 + 2] + p.w * wv[4 * d4 + 3]; }
                    o[cc] = a; }
                if (GEMM2_FP8) *(GAS unsigned short*)((unsigned char*)WOUT + (size_t)l * 1024 * 1024 + (size_t)n * 1024 + 768 + g * 64 + cb * 32 + c2 * 2) = (unsigned short)pk4_fp8(o[0] * 32.0f, o[1] * 32.0f, 0.f, 0.f);
                else *(GAS unsigned*)(dst + c2 * 2) = pk2(o[0], o[1]); }
            LDS_WAIT(); asm volatile("" ::: "memory");
        }
    }
    bf16* HB = (bf16*)(F.ws + WS_HB);
    const float* g = A.in[I_LNIG]; const float* b = A.in[I_LNIB];
    f32x4 gv[4], bv[4];
#pragma unroll
    for (int j = 0; j < 4; ++j) { gv[j] = *(const f32x4*)(g + 4 * lane + 256 * j); bv[j] = *(const f32x4*)(b + 4 * lane + 256 * j); }
#pragma unroll 1
    for (int prep2 = 0; prep2 < ((PROBE_P0 == 2) ? 2 : 1); ++prep2)
    for (int m0 = gw * 2; m0 < T_; m0 += NGW * 2) {
        f32x4 v[2][4];
#pragma unroll
        for (int u = 0; u < 2; ++u) { const GAS f32x4* xr = (const GAS f32x4*)(A.in[I_X] + (size_t)(m0 + u) * D_) + lane;
#pragma unroll
            for (int j = 0; j < 4; ++j) v[u][j] = xr[64 * j]; }
#pragma unroll
        for (int u = 0; u < 2; ++u) { float s = 0.f;
#pragma unroll
            for (int j = 0; j < 4; ++j) s += (v[u][j].x + v[u][j].y) + (v[u][j].z + v[u][j].w);
            const float mean = wave_sum(s) * (1.f / D_); float s2 = 0.f;
#pragma unroll
            for (int j = 0; j < 4; ++j) { v[u][j] = v[u][j] - mean; s2 += (v[u][j].x * v[u][j].x + v[u][j].y * v[u][j].y) + (v[u][j].z * v[u][j].z + v[u][j].w * v[u][j].w); }
            const float rstd = __builtin_amdgcn_rsqf(wave_sum(s2) * (1.f / D_) + LN_EPS);
            GAS v2u* o8 = (GAS v2u*)(HB + (size_t)(m0 + u) * D_) + lane;
#pragma unroll
            for (int j = 0; j < 4; ++j) { const f32x4 o = v[u][j] * rstd * gv[j] + bv[j]; v2u w; w.x = pk2(o.x, o.y); w.y = pk2(o.z, o.w); o8[64 * j] = w; } }
    }
}

__device__ __forceinline__ void p2_mixer(Frame& F, const Args& A, int l) {
    LAS unsigned* BV = (LAS unsigned*)F.lds;
    LAS unsigned* PB = (LAS unsigned*)(F.lds + 47616);
    LAS float* V = (LAS float*)(F.lds + 71680);
    const bf16* Z = (const bf16*)(F.ws + WS_Z); bf16* Y = (bf16*)(F.ws + WS_Y);
    const float* wB = A.in[I_CBW] + l * 31 * 384; const float* bB = A.in[I_CBB] + l * 384;
    const float* lg = A.in[I_LCG] + l * 384; const float* lb = A.in[I_LCB] + l * 384; const float* wA = A.in[I_CAW] + l * 3 * 384;
    int tid = F.tid; asm volatile("" : "+v"(tid));
    const int lane = tid & 63, wave = F.wave;
    const bool convt = tid < 384; const int cp = tid % 192, tg = tid / 192;
    f32x2 w[31]; f32x2 bias = (f32x2){0.f, 0.f};
#pragma unroll
    for (int j = 0; j < 31; ++j) w[j] = (f32x2){0.f, 0.f};
    if (convt) {
#pragma unroll
        for (int j = 0; j < 31; ++j) w[j] = *(const f32x2*)(wB + j * 384 + 2 * cp);
        bias = *(const f32x2*)(bB + 2 * cp); }
    v4u pre[9];
#define MIX_PREFETCH(ci_, tid_) do { const int _t0 = (ci_) * 32, _s0 = _t0 & (SEQ_ - 1); \
        _Pragma("unroll") for (int _i = 0; _i < 6; ++_i) { const int _q = (tid_) + 512 * _i; const int _qq = _q < 62 * 48 ? _q : 0; const int _r = _qq / 48, _c = _qq % 48; \
            const int _rr = (_s0 - 30 + _r >= 0) ? _r : 30; pre[_i] = *(const GAS v4u*)(Z + (size_t)(_t0 - 30 + _rr) * NZ + 768 + _c * 8); } \
        _Pragma("unroll") for (int _i = 0; _i < 3; ++_i) { const int _q = (tid_) + 512 * _i; const int _qq = _q < 47 * 32 ? _q : 0; const int _r = _qq >> 5, _c = _qq & 31; \
            const int _rr = (_s0 - 15 + _r >= 0) ? _r : 15; pre[6 + _i] = *(const GAS v4u*)(Z + (size_t)(_t0 - 15 + _rr) * NZ + 1152 + _c * 8); } } while (0)
    if (F.vcu < T_ / 32) MIX_PREFETCH(F.vcu, tid);
    for (int ci = F.vcu; ci < T_ / 32; ci += F.G) {
        const int t0 = ci * 32, s0 = t0 & (SEQ_ - 1);
#pragma unroll
        for (int i = 0; i < 6; ++i) { const int q = tid + 512 * i; if (q < 62 * 48) { const int r = q / 48, c = q % 48;
            *(LAS v4u*)(BV + r * 192 + c * 4) = (s0 - 30 + r >= 0) ? pre[i] : (v4u){0u, 0u, 0u, 0u}; } }
#pragma unroll
        for (int i = 0; i < 3; ++i) { const int q = tid + 512 * i; if (q < 47 * 32) { const int r = q >> 5, c = q & 31;
            *(LAS v4u*)(PB + r * 128 + c * 4) = (s0 - 15 + r >= 0) ? pre[6 + i] : (v4u){0u, 0u, 0u, 0u}; } }
        __syncthreads();
        { int cn = ci + F.G; asm volatile("" : "+s"(cn)); int tidp = tid; asm volatile("" : "+v"(tidp));
          if (cn < T_ / 32) MIX_PREFETCH(cn, tidp); }
#pragma unroll 1
        for (int prep = 0; prep < ((PROBE_MIX == 1) ? 2 : 1); ++prep)
        if (convt) {
#pragma unroll 1
            for (int hh = 0; hh < 2; ++hh) { const int tb = tg * 16 + hh * 8;
                f32x2 x[38];
#pragma unroll
                for (int i = 0; i < 38; ++i) { const unsigned u = BV[(tb + i) * 192 + cp]; x[i] = (f32x2){bflo(u), bfhi(u)}; }
#pragma unroll
                for (int tt = 0; tt < 8; ++tt) { f32x2 a = bias;
#pragma unroll
                    for (int j = 0; j < 31; ++j) a += w[j] * x[tt + j];
                    *(LAS f32x2*)(V + (tb + tt) * 384 + 2 * cp) = a; }
            }
        } else {
            const int p = tid - 384, g = p >> 5, wd = 2 << g;
            f32x2 s = (f32x2){0.f, 0.f};
            for (int i = 1; i < wd; ++i) { const unsigned u = PB[(15 - i) * 128 + p]; s += (f32x2){bflo(u), bfhi(u)}; }
#pragma unroll 1
            for (int blk = 0; blk < 4; ++blk) {
                unsigned xr[23];
#pragma unroll
                for (int i = 0; i < 23; ++i) xr[i] = PB[(8 * blk + i) * 128 + p];
#pragma unroll
                for (int j = 0; j < 8; ++j) { const int tt = 8 * blk + j; const f32x2 xv = (f32x2){bflo(xr[15 + j]), bfhi(xr[15 + j])};
                    s += xv; const int n = (s0 + tt + 1) < wd ? (s0 + tt + 1) : wd; const float inv = __builtin_amdgcn_rcpf((float)n);
                    const f32x2 dd = s * inv - xv;
                    if (GEMM2_FP8) *(GAS unsigned short*)((unsigned char*)Y + (size_t)(t0 + tt) * D_ + 768 + 2 * p) = (unsigned short)pk4_fp8(dd.x, dd.y, 0.f, 0.f);
                    else *(GAS unsigned*)(Y + (size_t)(t0 + tt) * D_ + 768 + 2 * p) = pk2(dd.x, dd.y);
                    const unsigned u2 = xr[15 + j - 1], u4 = xr[15 + j - 3], u8 = xr[15 + j - 7], u16 = xr[j];
                    const unsigned uo = g == 0 ? u2 : (g == 1 ? u4 : (g == 2 ? u8 : u16));
                    s -= (f32x2){bflo(uo), bfhi(uo)}; }
            }
        }
        __syncthreads();
        v4u ya[3][4];
        int t0o = t0; asm volatile("" : "+s"(t0o));
        int tidl = tid; asm volatile("" : "+v"(tidl));
#pragma unroll
        for (int i = 0; i < 3; ++i) { const int q = tidl + 512 * i, tt = q / 48, o8 = q % 48, pos = (t0o & (SEQ_ - 1)) + tt; const size_t row = (size_t)(t0o + tt);
            ya[i][0] = *(const GAS v4u*)(Z + row * NZ + o8 * 8);
            ya[i][1] = *(const GAS v4u*)(Z + row * NZ + 384 + o8 * 8);
            ya[i][2] = *(const GAS v4u*)(Z + (row - (pos >= 1 ? 1 : 0)) * NZ + 384 + o8 * 8);
            ya[i][3] = *(const GAS v4u*)(Z + (row - (pos >= 2 ? 2 : 0)) * NZ + 384 + o8 * 8); }
#pragma unroll 1
        for (int tk = 0; tk < ((PROBE_MIX == 2) ? 8 : 4); ++tk) { const int tt = wave * 4 + (tk & 3);
            f32x2 v[3]; float s = 0.f;
#pragma unroll
            for (int i = 0; i < 3; ++i) { v[i] = *(const LAS f32x2*)(V + tt * 384 + 2 * lane + 128 * i); s += v[i].x + v[i].y; }
            const float mean = wave_sum(s) * (1.f / 384.f); float q = 0.f;
#pragma unroll
            for (int i = 0; i < 3; ++i) { v[i] = v[i] - mean; q += v[i].x * v[i].x + v[i].y * v[i].y; }
            const float rstd = __builtin_amdgcn_rsqf(wave_sum(q) * (1.f / 384.f) + LN_EPS);
#pragma unroll
            for (int i = 0; i < 3; ++i) { const int c = 2 * lane + 128 * i; const f32x2 gg = *(const f32x2*)(lg + c), bb = *(const f32x2*)(lb + c);
                f32x2 o = v[i] * rstd * gg + bb; o.x = o.x * sigmoidf_(o.x); o.y = o.y * sigmoidf_(o.y);
                if (GEMM2_FP8) *(GAS unsigned short*)((unsigned char*)Y + (size_t)(t0 + tt) * D_ + 384 + c) = (unsigned short)pk4_fp8(o.x, o.y, 0.f, 0.f);
                else *(GAS unsigned*)(Y + (size_t)(t0 + tt) * D_ + 384 + c) = pk2(o.x, o.y); }
        }
#pragma unroll
        for (int i = 0; i < 3; ++i) { const int q = tid + 512 * i, tt = q / 48, o8 = q % 48, pos = s0 + tt; const size_t row = (size_t)(t0 + tt);
            const v4u gb = ya[i][0], x0 = ya[i][1]; v4u x1 = ya[i][2], x2 = ya[i][3];
            if (pos < 1) x1 = (v4u){0u, 0u, 0u, 0u};
            if (pos < 2) x2 = (v4u){0u, 0u, 0u, 0u};
            const f32x4 w2a = *(const f32x4*)(wA + 2 * 384 + o8 * 8), w2b = *(const f32x4*)(wA + 2 * 384 + o8 * 8 + 4);
            const f32x4 w1a = *(const f32x4*)(wA + 1 * 384 + o8 * 8), w1b = *(const f32x4*)(wA + 1 * 384 + o8 * 8 + 4);
            const f32x4 w0a = *(const f32x4*)(wA + o8 * 8), w0b = *(const f32x4*)(wA + o8 * 8 + 4);
            float o[8];
            const unsigned gbw[4] = {gb.x, gb.y, gb.z, gb.w}, x0w[4] = {x0.x, x0.y, x0.z, x0.w}, x1w[4] = {x1.x, x1.y, x1.z, x1.w}, x2w[4] = {x2.x, x2.y, x2.z, x2.w};
            const float w2[8] = {w2a.x, w2a.y, w2a.z, w2a.w, w2b.x, w2b.y, w2b.z, w2b.w}, w1[8] = {w1a.x, w1a.y, w1a.z, w1a.w, w1b.x, w1b.y, w1b.z, w1b.w}, w0[8] = {w0a.x, w0a.y, w0a.z, w0a.w, w0b.x, w0b.y, w0b.z, w0b.w};
#pragma unroll
            for (int e = 0; e < 4; ++e) {
                o[2 * e] = bflo(gbw[e]) * (w2[2 * e] * bflo(x0w[e]) + w1[2 * e] * bflo(x1w[e]) + w0[2 * e] * bflo(x2w[e]));
                o[2 * e + 1] = bfhi(gbw[e]) * (w2[2 * e + 1] * bfhi(x0w[e]) + w1[2 * e + 1] * bfhi(x1w[e]) + w0[2 * e + 1] * bfhi(x2w[e])); }
            if (GEMM2_FP8) { v2u ov; ov.x = pk4_fp8(o[0], o[1], o[2], o[3]); ov.y = pk4_fp8(o[4], o[5], o[6], o[7]); *(GAS v2u*)((unsigned char*)Y + row * D_ + o8 * 8) = ov; }
            else { v4u ov; ov.x = pk2(o[0], o[1]); ov.y = pk2(o[2], o[3]); ov.z = pk2(o[4], o[5]); ov.w = pk2(o[6], o[7]);
            *(GAS v4u*)(Y + row * D_ + o8 * 8) = ov; } }
        __syncthreads();
    }
#undef MIX_PREFETCH
}

__device__ __forceinline__ void top2of4(float q0, float q1, float q2, float q3, float& a1, int& i1, float& a2, int& i2) {
    a1 = q0; i1 = 0; a2 = -1.f; i2 = 1;
#define T2STEP(qv, r) { const bool gt = (qv) > a1; const bool g2 = (qv) > a2; const float na2 = gt ? a1 : (g2 ? (qv) : a2); const int ni2 = gt ? i1 : (g2 ? (r) : i2); \
        a1 = gt ? (qv) : a1; i1 = gt ? (r) : i1; a2 = na2; i2 = ni2; }
    T2STEP(q1, 1) T2STEP(q2, 2) T2STEP(q3, 3)
#undef T2STEP
}
__device__ __forceinline__ void p4_ln_router(Frame& F, const Args& A, int l) {
    LAS unsigned char* lds = F.lds;
    LAS int* cntl = (LAS int*)(lds + 66048); LAS int* basel = cntl + 32; LAS int* sel = cntl + 64; LAS int* lpos = cntl + 64 + 256;
    const bf16* U = (const bf16*)(F.ws + WS_U); bf16* HB = (bf16*)(F.ws + WS_HB); unsigned char* H8 = F.ws + WS_H8; const bf16* WRT = (const bf16*)(F.ws + WS_WRT);
    int* route = (int*)(F.ws + WS_ROUTE); int* lists = (int*)(F.ws + WS_LISTS);
    unsigned* counts = F.ctl + CW_CNT + l * 32 * 64;
    const float* g = A.in[I_LMG] + l * D_; const float* b = A.in[I_LMB] + l * D_; const float* rb = A.in[I_RB];
    int tid = F.tid; asm volatile("" : "+v"(tid));
    const int lane = tid & 63, wave = F.wave, fr = lane & 15, fq = lane >> 4;
    for (int q = tid; q < 32 * 128; q += 512) { const int e = q >> 7, c = q & 127; *(LAS v4u*)(lds + e * 2064 + c * 16) = *(const GAS v4u*)(WRT + e * 1024 + c * 8); }
    if (tid < 32) cntl[tid] = 0;
    f32x4 gv[4], bv[4];
#pragma unroll
    for (int j = 0; j < 4; ++j) { gv[j] = *(const f32x4*)(g + 4 * lane + 256 * j); bv[j] = *(const f32x4*)(b + 4 * lane + 256 * j); }
    __syncthreads();
    for (int blk = F.vcu; blk < T_ / 128; blk += F.G) {
#pragma unroll 1
        for (int i = 0; i < 16; i += 4) { const size_t m = (size_t)(blk * 128 + wave * 16 + i);
            v2u q[4][4];
#pragma unroll
            for (int u = 0; u < 4; ++u) { const GAS v2u* up = (const GAS v2u*)(U + (m + u) * D_) + lane;
#pragma unroll
                for (int j = 0; j < 4; ++j) q[u][j] = up[64 * j]; }
#pragma unroll
            for (int u = 0; u < 4; ++u) { f32x4 v[4]; float s = 0.f;
#pragma unroll
                for (int j = 0; j < 4; ++j) { v[j] = (f32x4){bflo(q[u][j].x), bfhi(q[u][j].x), bflo(q[u][j].y), bfhi(q[u][j].y)}; s += (v[j].x + v[j].y) + (v[j].z + v[j].w); }
                const float mean = wave_sum(s) * (1.f / D_); float s2 = 0.f;
#pragma unroll
                for (int j = 0; j < 4; ++j) { v[j] = v[j] - mean; s2 += (v[j].x * v[j].x + v[j].y * v[j].y) + (v[j].z * v[j].z + v[j].w * v[j].w); }
                const float rstd = __builtin_amdgcn_rsqf(wave_sum(s2) * (1.f / D_) + LN_EPS);
                GAS v2u* o8 = (GAS v2u*)(HB + (m + u) * D_) + lane; GAS unsigned* o4 = (GAS unsigned*)(H8 + (m + u) * D_) + lane;
#pragma unroll
                for (int j = 0; j < 4; ++j) { const f32x4 o = v[j] * rstd * gv[j] + bv[j]; v2u w; w.x = pk2(o.x, o.y); w.y = pk2(o.z, o.w); o8[64 * j] = w; o4[64 * j] = pk4_fp8(o.x, o.y, o.z, o.w); } }
        }
        VM_WAIT(); asm volatile("" ::: "memory");
        const int token = blk * 128 + wave * 16 + fr;
        f32x4 acc0 = (f32x4){0.f, 0.f, 0.f, 0.f}, acc1 = (f32x4){0.f, 0.f, 0.f, 0.f};
        const bf16* hrow = HB + (size_t)token * D_ + fq * 8;
#pragma unroll 16
        for (int k = 0; k < 32; ++k) { const int kk = k * 32 + fq * 8;
            const bf16x8 hf = *(const GAS bf16x8*)(hrow + k * 32);
            const bf16x8 w0 = *(const LAS bf16x8*)(lds + fr * 2064 + kk * 2), w1 = *(const LAS bf16x8*)(lds + (16 + fr) * 2064 + kk * 2);
            acc0 = __builtin_amdgcn_mfma_f32_16x16x32_bf16(w0, hf, acc0, 0, 0, 0);
            acc1 = __builtin_amdgcn_mfma_f32_16x16x32_bf16(w1, hf, acc1, 0, 0, 0);
        }
        float p0[4], p1[4]; float mx = -3.0e38f;
#pragma unroll
        for (int r = 0; r < 4; ++r) { p0[r] = acc0[r] + rb[4 * fq + r]; p1[r] = acc1[r] + rb[16 + 4 * fq + r]; mx = fmaxf(mx, fmaxf(p0[r], p1[r])); }
        mx = fmaxf(mx, __shfl_xor(mx, 16)); mx = fmaxf(mx, __shfl_xor(mx, 32));
#pragma unroll
        for (int r = 0; r < 4; ++r) { p0[r] = __expf(p0[r] - mx); p1[r] = __expf(p1[r] - mx); }
        float a1, a2, c1, c2; int ia1, ia2, ic1, ic2;
        top2of4(p0[0], p0[1], p0[2], p0[3], a1, ia1, a2, ia2); top2of4(p1[0], p1[1], p1[2], p1[3], c1, ic1, c2, ic2);
        const float sc0 = a1 + a2, sc1 = c1 + c2;
        float bs = sc0; int bg = fq; if (sc1 > sc0) { bs = sc1; bg = 4 + fq; }
#pragma unroll
        for (int off = 16; off <= 32; off <<= 1) { const float os = __shfl_xor(bs, off); const int og = __shfl_xor(bg, off); if (os > bs || (os == bs && og < bg)) { bs = os; bg = og; } }
        if ((bg & 3) == fq) {
            const bool hi = bg >= 4;
            const float pa = hi ? c1 : a1, pb = hi ? c2 : a2; const int ia = hi ? ic1 : ia1, ib = hi ? ic2 : ia2;
            const int ea = bg * 4 + ia, eb = bg * 4 + ib; const float inv = 1.0f / (pa + pb);
            const int tokl = wave * 16 + fr;
            const int la = atomicAdd((int*)&cntl[ea], 1), lb2 = atomicAdd((int*)&cntl[eb], 1);
            sel[tokl * 2] = ea; sel[tokl * 2 + 1] = eb; lpos[tokl * 2] = la; lpos[tokl * 2 + 1] = lb2;
            int* rt = route + (size_t)token * 8; rt[0] = ea; rt[2] = eb; rt[4] = __float_as_int(pa * inv); rt[5] = __float_as_int(pb * inv);
        }
        __syncthreads();
        if (tid < 32) { const int c = cntl[tid]; basel[tid] = c ? (int)__hip_atomic_fetch_add(counts + tid * 64, (unsigned)c, RLX_AGENT) : 0; }
        __syncthreads();
        if (tid < 256) { const int tokl = tid >> 1, k = tid & 1, e = sel[tid], pos = basel[e] + lpos[tid], tok = blk * 128 + tokl;
            lists[(size_t)e * 65536 + pos] = tok * 2 + k; route[(size_t)tok * 8 + 1 + 2 * k] = pos; }
        __syncthreads();
        if (tid < 32) cntl[tid] = 0;
        __syncthreads();
    }
}

__device__ __forceinline__ void moe_table(Frame& F, int l) {
    LAS int* tab = (LAS int*)(F.lds + TAB_OFF);
    __syncthreads();
    if (F.tid < 32) tab[40 + F.tid] = (int)__hip_atomic_load(F.ctl + CW_CNT + (l * 32 + F.tid) * 64, RLX_AGENT);
    __syncthreads();
    if (F.tid == 0) { int s = 0; for (int e = 0; e < 32; ++e) { tab[e] = s; s += (tab[40 + e] + 255) >> 8; } tab[32] = s; }
    __syncthreads();
    for (int t = F.tid; t < tab[32]; t += NWAVES * 64) { int e = 0; while (e < 31 && tab[e + 1] <= t) ++e; tab[80 + t] = e; }
    __syncthreads();
}

__device__ __forceinline__ void p7_combine_ln(Frame& F, const Args& A, int l) {
    const LAS int* tab = (const LAS int*)(F.lds + TAB_OFF);
    bf16* HB = (bf16*)(F.ws + WS_HB); const unsigned char* Y2S = F.ws + WS_Y2S; const int* route = (const int*)(F.ws + WS_ROUTE);
    const float* g = A.in[I_LFG] + l * D_; const float* b = A.in[I_LFB] + l * D_;
    int lane = F.lane; asm volatile("" : "+v"(lane));
    const int gw = F.vcu * NWAVES + F.wave, NGW = F.G * NWAVES;
    f32x4 gv[4], bv[4];
#pragma unroll
    for (int j = 0; j < 4; ++j) { gv[j] = *(const f32x4*)(g + 4 * lane + 256 * j); bv[j] = *(const f32x4*)(b + 4 * lane + 256 * j); }
    const bool last = (l == NL - 1);
    const int step = NGW * 2;
    int R[2][6], Rn[2][6];
    v2u hq[2][4], hn[2][4]; unsigned aq[2][4], cq[2][4], an[2][4], cn[2][4];
#define P7_ROUTE(m0_, R_) do { _Pragma("unroll") for (int _u = 0; _u < 2; ++_u) { const int* _rt = route + (size_t)((m0_) + _u) * 8; \
        _Pragma("unroll") for (int _k = 0; _k < 6; ++_k) R_[_u][_k] = _rt[_k]; } } while (0)
#define P7_ROWS(m0_, R_, hq_, aq_, cq_) do { _Pragma("unroll") for (int _u = 0; _u < 2; ++_u) { const int _m = (m0_) + _u; \
        const size_t _r0 = (size_t)tab[R_[_u][0]] * 256 + R_[_u][1], _r1 = (size_t)tab[R_[_u][2]] * 256 + R_[_u][3]; \
        const GAS v2u* _hp = (const GAS v2u*)(HB + (size_t)_m * D_) + lane; const GAS unsigned* _ya = (const GAS unsigned*)(Y2S + _r0 * D_) + lane; const GAS unsigned* _yb = (const GAS unsigned*)(Y2S + _r1 * D_) + lane; \
        _Pragma("unroll") for (int _j = 0; _j < 4; ++_j) { hq_[_u][_j] = _hp[64 * _j]; aq_[_u][_j] = _ya[64 * _j]; cq_[_u][_j] = _yb[64 * _j]; } } } while (0)
    int m0 = gw * 2;
    if (m0 < T_) { P7_ROUTE(m0, R); P7_ROWS(m0, R, hq, aq, cq); if (m0 + step < T_) P7_ROUTE(m0 + step, Rn); }
    for (; m0 < T_; m0 += step) {
        const bool has_n = m0 + step < T_;
        int Rnn[2][6];
        if (has_n) P7_ROWS(m0 + step, Rn, hn, an, cn);
        if (m0 + 2 * step < T_) P7_ROUTE(m0 + 2 * step, Rnn);
#pragma unroll
        for (int u = 0; u < 2; ++u) { const int m = m0 + u; f32x4 v[4]; float s = 0.f; const float g0 = __int_as_float(R[u][4]), g1 = __int_as_float(R[u][5]);
#pragma unroll
            for (int j = 0; j < 4; ++j) { const v2u h = hq[u][j]; const unsigned a = aq[u][j], c = cq[u][j];
                const f32x2 a01 = __builtin_amdgcn_cvt_pk_f32_fp8((int)a, false), a23 = __builtin_amdgcn_cvt_pk_f32_fp8((int)a, true), c01 = __builtin_amdgcn_cvt_pk_f32_fp8((int)c, false), c23 = __builtin_amdgcn_cvt_pk_f32_fp8((int)c, true);
                v[j].x = ALPHA * bflo(h.x) + g0 * a01.x + g1 * c01.x; v[j].y = ALPHA * bfhi(h.x) + g0 * a01.y + g1 * c01.y;
                v[j].z = ALPHA * bflo(h.y) + g0 * a23.x + g1 * c23.x; v[j].w = ALPHA * bfhi(h.y) + g0 * a23.y + g1 * c23.y;
                s += (v[j].x + v[j].y) + (v[j].z + v[j].w); }
            const float mean = wave_sum(s) * (1.f / D_); float s2 = 0.f;
#pragma unroll
            for (int j = 0; j < 4; ++j) { v[j] = v[j] - mean; s2 += (v[j].x * v[j].x + v[j].y * v[j].y) + (v[j].z * v[j].z + v[j].w * v[j].w); }
            const float rstd = __builtin_amdgcn_rsqf(wave_sum(s2) * (1.f / D_) + LN_EPS);
            if (last) { GAS f32x4* o = (GAS f32x4*)(A.out + (size_t)m * D_) + lane;
#pragma unroll
                for (int j = 0; j < 4; ++j) o[64 * j] = v[j] * rstd * gv[j] + bv[j];
            } else { GAS v2u* o8 = (GAS v2u*)(HB + (size_t)m * D_) + lane;
#pragma unroll
                for (int j = 0; j < 4; ++j) { const f32x4 o = v[j] * rstd * gv[j] + bv[j]; v2u w; w.x = pk2(o.x, o.y); w.y = pk2(o.z, o.w); o8[64 * j] = w; } }
        }
#pragma unroll
        for (int u = 0; u < 2; ++u) {
#pragma unroll
            for (int j = 0; j < 4; ++j) { hq[u][j] = hn[u][j]; aq[u][j] = an[u][j]; cq[u][j] = cn[u][j]; }
#pragma unroll
            for (int k = 0; k < 6; ++k) { R[u][k] = Rn[u][k]; Rn[u][k] = Rnn[u][k]; } }
    }
#undef P7_ROUTE
#undef P7_ROWS
}

#ifndef PH_NOINLINE
#define PH_NOINLINE __forceinline__
#endif
PH_NOINLINE __device__ void run_gemm1(LAS unsigned char* lds, unsigned char* ws, int l, int G, int c) {
    pg8::DenseOrder S; S.init(ws + WS_HB, ws + WS_WIN + (size_t)l * N1 * 1024 * 2, T_, N1, D_, G, c, 1);
    pg8::EpiZ E{(bf16*)(ws + WS_Z)};
    if (GEMM_SIMPLE_MASK & 1) pg8::gemm_phase_simple(S, E); else pg8::gemm_phase(lds, S, E);
}
PH_NOINLINE __device__ void run_gemm_probe(LAS unsigned char* lds, unsigned char* ws, int G, int c) {
    pg8::DenseOrder S; S.init(ws + WS_HB, ws + WS_WIN, T_, 256 * (PROBE_EXTRA_NN ? PROBE_EXTRA_NN : 1), D_, G, c);
    pg8::EpiPlain E{(bf16*)(ws + WS_Y), 2048};
    pg8::gemm_phase(lds, S, E);
}
PH_NOINLINE __device__ void run_gemm2(LAS unsigned char* lds, unsigned char* ws, int l, int G, int c) {
    pg8::EpiU E{(const bf16*)(ws + WS_HB), (bf16*)(ws + WS_U)};
    if (GEMM2_FP8) { pg8::DenseRowsOrder S; int kq = D_ / 2; asm volatile("" : "+s"(kq)); S.init(ws + WS_Y, ws + WS_WOUT + (size_t)l * 1024 * 1024, T_, D_, kq, G, c); pg8::gemm_phase<pg8::EpiU, pg8::DenseRowsOrder, true>(lds, S, E); }
    else { pg8::DenseOrder S; S.init(ws + WS_Y, ws + WS_WOUT + (size_t)l * 1024 * 1024 * 2, T_, D_, D_, G, c); pg8::gemm_phase(lds, S, E); }
}
PH_NOINLINE __device__ void run_gemm5(LAS unsigned char* lds, unsigned char* ws, int l, int G, int c) {
    const LAS int* tab = (const LAS int*)(lds + TAB_OFF);
    pg8::MoeGatherOrder S; S.A = (const char*)(ws + WS_H8); S.Bt = (const char*)(ws + WS_WGU + (size_t)l * NE * 1024 * 1024); S.bexp = (size_t)1024 * 1024;
    int kq = D_ / 2; asm volatile("" : "+s"(kq));
    S.K = kq; S.nN = 4; S.nwg = tab[32] * 4; S.G = G; S.c = c; S.tab = tab; S.lists = (const int*)(ws + WS_LISTS);
    pg8::EpiHid E{ws + WS_HID};
    pg8::gemm_phase<pg8::EpiHid, pg8::MoeGatherOrder, true>(lds, S, E);
}
PH_NOINLINE __device__ void run_gemm6(LAS unsigned char* lds, unsigned char* ws, int l, int G, int c) {
    const LAS int* tab = (const LAS int*)(lds + TAB_OFF);
    pg8::MoeRowsOrder S; S.A = (const char*)(ws + WS_HID); S.Bt = (const char*)(ws + WS_WD + (size_t)l * NE * 1024 * 512); S.bexp = (size_t)1024 * 512;
    int kq = DE / 2; asm volatile("" : "+s"(kq));
    S.K = kq; S.nN = 4; S.nwg = tab[32] * 4; S.G = G; S.c = c; S.tab = tab; S.lists = nullptr;
    pg8::EpiPlain8 E{ws + WS_Y2S, D_};
    pg8::gemm_phase<pg8::EpiPlain8, pg8::MoeRowsOrder, true>(lds, S, E);
}

__global__ void __launch_bounds__(NWAVES * 64, 2) mk_fwd(Args args) {
    extern __shared__ __attribute__((aligned(16))) unsigned char lds_raw[];
    Frame F;
    F.lds = (LAS unsigned char*)lds_raw;
    F.tid = threadIdx.x; F.lane = F.tid & 63; F.wave = __builtin_amdgcn_readfirstlane(F.tid >> 6);
    F.G = gridDim.x; { const int bx = blockIdx.x; F.vcu = (F.G % 8 == 0) ? (bx % 8) * (F.G / 8) + bx / 8 : bx; }
    F.ws = args.ws; F.ctl = (unsigned*)(args.ws + WS_CTL);
    for (int u = F.tid; u < (LDS_BYTES - LDSCTL_OFF) / 4; u += NWAVES * 64) ((LAS unsigned*)(F.lds + LDSCTL_OFF))[u] = 0u;
    __syncthreads();
    volatile LAS unsigned* MISC = (volatile LAS unsigned*)(F.lds + MISC_OFF);
    XcdBarrier bar; bar.bar = F.ctl + CW_BAR; bar.x = 0; bar.st = nullptr;
    if (MK_N_LAUNCHES == 1) bar = xcd_barrier_post(F.ctl + CW_BAR, MISC + 8);
    const int lo = args.ph_lo, hi = args.ph_hi;
#define IN(k) (lo <= (k) && (k) < hi)
#define SEAM(k) do { if (MK_N_LAUNCHES == 1 && (k) + 1 < hi) xcd_barrier(bar); } while (0)
    if (REPEAT_MASK & 256) { for (int rep = 0; rep < 10; ++rep) xcd_barrier(bar); }
    if ((PH_MASK & 1) && IN(0)) { for (int rep = 0; rep < ((REPEAT_MASK & 1) ? 2 : 1); ++rep) { p0_prologue(F, args); SEAM(0); } }
#pragma unroll 1
    for (int l = 0; l < NL; ++l) {
        const int pb = 1 + 7 * l;
        if ((PH_MASK & 2) && IN(pb + 0)) { for (int rep = 0; rep < ((REPEAT_MASK & 2) ? 2 : 1); ++rep) { run_gemm1(F.lds, F.ws, l, F.G, (int)blockIdx.x); SEAM(pb + 0); }
            if (PROBE_EXTRA_NN && l == 0) { run_gemm_probe(F.lds, F.ws, F.G, (int)blockIdx.x); xcd_barrier(bar); } }
        if ((PH_MASK & 4) && IN(pb + 1)) { for (int rep = 0; rep < ((REPEAT_MASK & 4) ? 2 : 1); ++rep) { p2_mixer(F, args, l); SEAM(pb + 1); } }
        if ((PH_MASK & 8) && IN(pb + 2)) { for (int rep = 0; rep < ((REPEAT_MASK & 8) ? 2 : 1); ++rep) { run_gemm2(F.lds, F.ws, l, F.G, (int)blockIdx.x); SEAM(pb + 2); } }
        if ((PH_MASK & 16) && IN(pb + 3)) {
            if (REPEAT_MASK & 16) { p4_ln_router(F, args, l); SEAM(pb + 3);
                if (blockIdx.x == 0 && F.tid < 32) __hip_atomic_store(F.ctl + CW_CNT + (l * 32 + F.tid) * 64, 0u, RLX_AGENT);
                SEAM(pb + 3); }
            p4_ln_router(F, args, l); SEAM(pb + 3); }
        if ((PH_MASK & 32) && IN(pb + 4)) { for (int rep = 0; rep < ((REPEAT_MASK & 32) ? 2 : 1); ++rep) { moe_table(F, l); run_gemm5(F.lds, F.ws, l, F.G, (int)blockIdx.x); SEAM(pb + 4); } }
        if ((PH_MASK & 64) && IN(pb + 5)) { for (int rep = 0; rep < ((REPEAT_MASK & 64) ? 2 : 1); ++rep) { if (MK_N_LAUNCHES != 1 || rep) moe_table(F, l); run_gemm6(F.lds, F.ws, l, F.G, (int)blockIdx.x); SEAM(pb + 5); } }
        if ((PH_MASK & 128) && IN(pb + 6)) { for (int rep = 0; rep < (((REPEAT_MASK & 128) && l == NL - 1) ? 2 : 1); ++rep) { if (MK_N_LAUNCHES != 1) moe_table(F, l); p7_combine_ln(F, args, l); if (rep == 0) SEAM(pb + 6); else xcd_barrier(bar); } }
    }
#undef IN
#undef SEAM
}

extern "C" void kernel_launch(void* const* d_in, const int* in_sizes, int n_in, void* d_out, int out_size, void* d_ws, size_t ws_size, hipStream_t stream) {
    static int grid = 0;
    if (grid == 0) {
        if (n_in != 21 || out_size != T_ * D_ || ws_size < WS_END) { fprintf(stderr, "kernel_launch: unexpected problem (n_in %d, out %d, ws %zu); nothing launched\n", n_in, out_size, ws_size); grid = -1; return; }
        int dev = 0, cus = 0, per_cu = 0;
        if (hipGetDevice(&dev) != hipSuccess || hipDeviceGetAttribute(&cus, hipDeviceAttributeMultiprocessorCount, dev) != hipSuccess) { grid = -1; return; }
        if (hipFuncSetAttribute((const void*)mk_fwd, hipFuncAttributeMaxDynamicSharedMemorySize, LDS_BYTES) != hipSuccess) { fprintf(stderr, "kernel_launch: hipFuncSetAttribute failed\n"); grid = -1; return; }
        if (hipOccupancyMaxActiveBlocksPerMultiprocessor(&per_cu, (const void*)mk_fwd, NWAVES * 64, LDS_BYTES) != hipSuccess || per_cu < 1) { fprintf(stderr, "kernel_launch: occupancy query says %d\n", per_cu); }
        (void)hipGetLastError();
        grid = cus;
    }
    if (grid < 0) return;
    (void)hipMemsetAsync((char*)d_ws + WS_CTL, 0, CTL_ZERO_BYTES, stream);
    Args a{};
    for (int i = 0; i < 21; ++i) a.in[i] = (const float*)d_in[i];
    a.out = (float*)d_out; a.ws = (unsigned char*)d_ws;
    if (MK_N_LAUNCHES == 1) { a.ph_lo = 0; a.ph_hi = NPH; hipLaunchKernelGGL(mk_fwd, dim3(grid), dim3(NWAVES * 64), LDS_BYTES, stream, a); }
    else for (int p = 0; p < NPH; ++p) { a.ph_lo = p; a.ph_hi = p + 1; hipLaunchKernelGGL(mk_fwd, dim3(grid), dim3(NWAVES * 64), LDS_BYTES, stream, a); }
}
```

```cpp
#include <hip/hip_runtime.h>
#include <cstdio>
#include <cstdint>

#ifndef MK_N_LAUNCHES
#define MK_N_LAUNCHES 1
#endif
#ifndef PH_MASK
#define PH_MASK 0xff
#endif
#ifndef REPEAT_MASK
#define REPEAT_MASK 0
#endif
#ifndef GEMM1_I8
#define GEMM1_I8 1
#endif
#ifndef GEMM2_FP8
#define GEMM2_FP8 1
#endif
#ifndef PROBE_P0
#define PROBE_P0 0
#endif
#ifndef PROBE_MIX
#define PROBE_MIX 0
#endif
#ifndef PROBE_EXTRA_NN
#define PROBE_EXTRA_NN 0
#endif
#ifndef GEMM_SIMPLE_MASK
#define GEMM_SIMPLE_MASK 0
#endif

#define GAS __attribute__((address_space(1)))
#define LAS __attribute__((address_space(3)))
typedef unsigned short bf16;
typedef unsigned v4u __attribute__((ext_vector_type(4)));
typedef unsigned v2u __attribute__((ext_vector_type(2)));
typedef float f32x4 __attribute__((ext_vector_type(4)));
typedef float f32x2 __attribute__((ext_vector_type(2)));
typedef short bf16x8 __attribute__((ext_vector_type(8)));
#define RLX_AGENT __ATOMIC_RELAXED, __HIP_MEMORY_SCOPE_AGENT
#define LDS_WAIT() asm volatile("s_waitcnt lgkmcnt(0)" ::: "memory")
#define VM_WAIT() asm volatile("s_waitcnt vmcnt(0)" ::: "memory")

constexpr int T_ = 32768, D_ = 1024, SEQ_ = 4096, NL = 2, NE = 32, DE = 512;
constexpr int DIN = 2176, N1 = 2304, NZ = 1408;
constexpr float ALPHA = 1.41421356237f, LN_EPS = 1e-5f;
constexpr int NPH = 1 + 7 * NL;

constexpr size_t MiB = 1u << 20;
constexpr size_t WS_CTL = 0, CTL_ZERO_BYTES = 128 * 1024;
constexpr size_t WS_ROUTE = 1 * MiB;
constexpr size_t WS_WRT = 2 * MiB;
constexpr size_t WS_HS = 2 * MiB + 256 * 1024;
constexpr size_t WS_CS = 2 * MiB + 512 * 1024;
constexpr size_t WS_LISTS = 3 * MiB;
constexpr size_t WS_WIN = 11 * MiB;
constexpr size_t WS_WOUT = 20 * MiB;
constexpr size_t WS_WGU = 24 * MiB;
constexpr size_t WS_H8 = 88 * MiB;
constexpr size_t WS_HQ = 120 * MiB;
constexpr size_t WS_WD = 152 * MiB;
constexpr size_t WS_HB = 216 * MiB;
constexpr size_t WS_Z = 280 * MiB;
constexpr size_t WS_Y = 368 * MiB;
constexpr size_t WS_U = 280 * MiB;
constexpr size_t WS_HID = 280 * MiB;
constexpr size_t WS_Y2S = 352 * MiB;
constexpr size_t WS_END = 496 * MiB;
constexpr int CW_TMO = 0, CW_BAR = 4096, CW_CNT = 16384, CW_CMAX = 20480  , CW_CMAXCNT = 25600;

constexpr int RING_BYTES = 131072, LDSCTL_OFF = RING_BYTES, MISC_OFF = LDSCTL_OFF + 320, TAB_OFF = LDSCTL_OFF + 1024;
constexpr int LDS_BYTES = 147456;

__device__ __forceinline__ unsigned f2bf(float f) { unsigned u = __builtin_bit_cast(unsigned, f); return (u + 0x7fffu + ((u >> 16) & 1u)) >> 16; }
__device__ __forceinline__ unsigned pk2(float lo, float hi) { unsigned r; asm("v_cvt_pk_bf16_f32 %0, %1, %2" : "=v"(r) : "v"(lo), "v"(hi)); return r; }
__device__ __forceinline__ float bflo(unsigned u) { return __builtin_bit_cast(float, u << 16); }
__device__ __forceinline__ float bfhi(unsigned u) { return __builtin_bit_cast(float, u & 0xffff0000u); }
template <int CTRL> __device__ __forceinline__ float dpp_mov(float v) { return __builtin_bit_cast(float, __builtin_amdgcn_update_dpp(0, __builtin_bit_cast(int, v), CTRL, 0xf, 0xf, false)); }
__device__ __forceinline__ float wave_sum(float v) {
    v += dpp_mov<0xB1>(v); v += dpp_mov<0x4E>(v); v += dpp_mov<0x141>(v); v += dpp_mov<0x140>(v);
    const int iv = __builtin_bit_cast(int, v);
    return (__builtin_bit_cast(float, __builtin_amdgcn_readlane(iv, 0)) + __builtin_bit_cast(float, __builtin_amdgcn_readlane(iv, 16))) +
           (__builtin_bit_cast(float, __builtin_amdgcn_readlane(iv, 32)) + __builtin_bit_cast(float, __builtin_amdgcn_readlane(iv, 48)));
}
__device__ __forceinline__ float wave_max(float v) {
    v = fmaxf(v, dpp_mov<0xB1>(v)); v = fmaxf(v, dpp_mov<0x4E>(v)); v = fmaxf(v, dpp_mov<0x141>(v)); v = fmaxf(v, dpp_mov<0x140>(v));
    const int iv = __builtin_bit_cast(int, v);
    return fmaxf(fmaxf(__builtin_bit_cast(float, __builtin_amdgcn_readlane(iv, 0)), __builtin_bit_cast(float, __builtin_amdgcn_readlane(iv, 16))),
                 fmaxf(__builtin_bit_cast(float, __builtin_amdgcn_readlane(iv, 32)), __builtin_bit_cast(float, __builtin_amdgcn_readlane(iv, 48))));
}
__device__ __forceinline__ unsigned pk4_i8(float a, float b, float c, float d) {
    const int ia = (int)__builtin_rintf(a), ib = (int)__builtin_rintf(b), ic = (int)__builtin_rintf(c), id = (int)__builtin_rintf(d);
    return ((unsigned)ia & 0xffu) | (((unsigned)ib & 0xffu) << 8) | (((unsigned)ic & 0xffu) << 16) | ((unsigned)id << 24); }
__device__ __forceinline__ unsigned pk4_fp8(float a, float b, float c, float d) {
    int v = 0; v = __builtin_amdgcn_cvt_pk_fp8_f32(a, b, v, false); v = __builtin_amdgcn_cvt_pk_fp8_f32(c, d, v, true); return (unsigned)v; }
__device__ __forceinline__ float sigmoidf_(float x) { return __builtin_amdgcn_rcpf(1.0f + __expf(-x)); }

namespace pg8 {
#define PG8_LAS __attribute__((address_space(3)))
typedef int v8i __attribute__((ext_vector_type(8)));
typedef int v4i __attribute__((ext_vector_type(4)));
constexpr int BM = 256, BK = 64, HALF = 128, HTB = HALF * BK * 2, STAGE_BYTES = 8 * HTB, NXCD = 8, WGM = 8;
__host__ __device__ __forceinline__ int lds_byte(int r, int c) { const int st = (r >> 4) * 2 + (c >> 5), rr = r & 15, cc = c & 31, ob = rr * 64 + cc * 2; return st * 1024 + (ob ^ (((ob >> 9) & 1) << 5)); }
__host__ __device__ __forceinline__ void stage_rc(int b, int& R, int& C) { const int st = b / 1024, sb = b % 1024, swz = sb ^ (((sb >> 9) & 1) << 5); R = (st >> 1) * 16 + swz / 64; C = (st & 1) * 32 + (swz % 64) / 2; }
__host__ __device__ __forceinline__ int perm32(int rho) { const int n = rho >> 4, i = rho & 15; return 8 * (i >> 2) + 4 * n + (i & 3); }

struct Unit { int pm, pn, e, j, rh; };

__device__ __forceinline__ int xcd_remap(int wgid, int nwg) { const int q = nwg / NXCD, r = nwg % NXCD, xcd = wgid % NXCD, off = wgid / NXCD; return (xcd < r ? xcd * (q + 1) : r * (q + 1) + (xcd - r) * q) + off; }

struct DenseOrder {
    static constexpr bool GATHER = false, HAS_HALF = true, HAS_RH = false;
    const char* A; const char* Bt; int K, nM, nN, nwg, G, c, nhalf;
    __device__ void init(const void* A_, const void* Bt_, int M, int N, int K_, int G_, int c_, int half_tile = 0) { A = (const char*)A_; Bt = (const char*)Bt_; K = K_; nM = M / BM; nN = N / BM - half_tile; nwg = nM * nN; G = G_; c = c_; nhalf = half_tile ? nM : 0; }
    __device__ bool next(int i, Unit& u) const {
        const long L = (long)i * G + c; if (L >= nwg + nhalf) return false;
        u.e = 0; u.j = 0; u.rh = -1;
        if (L >= nwg) { u.pm = (int)(L - nwg); u.pn = nN; return true; }
        const int wgid = xcd_remap((int)L, nwg);
        const int nig = WGM * nN, gid = wgid / nig, fm = gid * WGM, gsz = (nM - fm) < WGM ? (nM - fm) : WGM;
        u.pm = fm + ((wgid % nig) % gsz); u.pn = (wgid % nig) / gsz; return true;
    }
    __device__ __forceinline__ bool is_half(const Unit& u) const { return u.pn >= nN; }
    __device__ __forceinline__ int row_half(const Unit&) const { return -1; }
    __device__ __forceinline__ const char* a_tile(const Unit& u) const { return A + (size_t)u.pm * BM * K * 2; }
    __device__ __forceinline__ const char* b_tile(const Unit& u) const { return Bt + (size_t)u.pn * BM * K * 2; }
    __device__ __forceinline__ unsigned a_row_off(const Unit&, int r) const { return (unsigned)(r * K * 2); }
};
struct DenseRowsOrder : DenseOrder {
    static constexpr bool GATHER = true, HAS_HALF = false;
    __device__ __forceinline__ const char* a_tile(const Unit&) const { return A; }
    __device__ __forceinline__ unsigned a_row_off(const Unit& u, int r) const { return (unsigned)(u.pm * BM + r) * (unsigned)(K * 2); }
};
struct MoeOrder {
    static constexpr bool HAS_HALF = false, HAS_RH = true;
    __device__ __forceinline__ bool is_half(const Unit&) const { return false; }
    const char* A; const char* Bt; size_t bexp; int K, nN, nwg, G, c; const PG8_LAS int* tab; const int* lists;
    __device__ bool next(int i, Unit& u) const {
        const int L = i * G + c, nfull = (nwg / G) * G, rem = nwg - nfull;
        int uidx = L; u.rh = -1;
        if (L >= nfull) { if (2 * rem <= G) { if (L >= nfull + 2 * rem) return false; uidx = nfull + ((L - nfull) >> 1); u.rh = (L - nfull) & 1; } else if (L >= nwg) return false; }
        const int wgid = xcd_remap(uidx, nwg);
        const int t = wgid / nN; u.pn = wgid % nN; u.pm = t;
        const int e = tab[80 + t];
        u.e = e; u.j = t - tab[e]; return true;
    }
    __device__ __forceinline__ int row_half(const Unit& u) const { return u.rh; }
    __device__ __forceinline__ const char* b_tile(const Unit& u) const { return Bt + (size_t)u.e * bexp + (size_t)u.pn * BM * K * 2; }
};
struct MoeGatherOrder : MoeOrder {
    static constexpr bool GATHER = true;
    __device__ __forceinline__ const char* a_tile(const Unit&) const { return A; }
    __device__ __forceinline__ unsigned a_row_off(const Unit& u, int r) const {
        const int idx = u.j * BM + r, cnt = tab[40 + u.e];
        const int ii = idx < cnt ? idx : cnt - 1;
        const int tok = lists[(size_t)u.e * 65536 + ii] >> 1;
        return (unsigned)tok * (unsigned)(K * 2);
    }
};
struct MoeRowsOrder : MoeOrder {
    static constexpr bool GATHER = true;
    __device__ __forceinline__ const char* a_tile(const Unit&) const { return A; }
    __device__ __forceinline__ unsigned a_row_off(const Unit& u, int r) const { return (unsigned)(u.pm * BM + r) * (unsigned)(K * 2); }
};
struct MoeDenseOrder : MoeOrder {
    static constexpr bool GATHER = false;
    __device__ __forceinline__ const char* a_tile(const Unit& u) const { return A + (size_t)u.pm * BM * K * 2; }
    __device__ __forceinline__ unsigned a_row_off(const Unit&, int r) const { return (unsigned)(r * K * 2); }
};

__device__ __forceinline__ unsigned cvt_pk_bf16(float lo, float hi) { unsigned r; asm volatile("v_cvt_pk_bf16_f32 %0, %1, %2" : "=v"(r) : "v"(lo), "v"(hi)); return r; }

struct EpiZ {
    static constexpr bool PERM = true;
    bf16* Z;
    __device__ __forceinline__ void operator()(const f32x4 (&acc)[2][2][4][2], const Unit& u, int wr, int wc, int fr, int fq) const {
        const int row0 = u.pm * BM + wr * 64 + fr, cl = wc * 32 + 8 * fq;
        if (u.pn < 6) {
            const bool sg = u.pn >= 3;
            const int zc = (sg ? 768 + (u.pn - 3) * 128 : 384 + u.pn * 128) + cl;
#pragma unroll
            for (int ai = 0; ai < 2; ++ai)
#pragma unroll
                for (int m = 0; m < 4; ++m) {
                    f32x4 a0 = acc[ai][0][m][0], a1 = acc[ai][0][m][1], g0 = acc[ai][1][m][0], g1 = acc[ai][1][m][1];
                    if (sg) {
#pragma unroll
                        for (int q = 0; q < 4; ++q) { g0[q] = sigmoidf_(g0[q]); g1[q] = sigmoidf_(g1[q]); }
                    }
                    a0 = a0 * g0; a1 = a1 * g1;
                    v4u w; w.x = cvt_pk_bf16(a0[0], a0[1]); w.y = cvt_pk_bf16(a0[2], a0[3]); w.z = cvt_pk_bf16(a1[0], a1[1]); w.w = cvt_pk_bf16(a1[2], a1[3]);
                    *(v4u*)(Z + (size_t)(row0 + ai * HALF + m * 16) * NZ + zc) = w;
                }
        } else {
            int zb0, zb1;
            if (u.pn == 6) { zb0 = 0; zb1 = 128; } else if (u.pn == 7) { zb0 = 256; zb1 = 1152; } else { zb0 = 1280; zb1 = -1; }
#pragma unroll
            for (int ai = 0; ai < 2; ++ai)
#pragma unroll
                for (int m = 0; m < 4; ++m) {
                    bf16* rowp = Z + (size_t)(row0 + ai * HALF + m * 16) * NZ + cl;
#pragma unroll
                    for (int bj = 0; bj < 2; ++bj) {
                        const int zb = bj ? zb1 : zb0;
                        if (zb >= 0) { const f32x4 a0 = acc[ai][bj][m][0], a1 = acc[ai][bj][m][1];
                            v4u w; w.x = cvt_pk_bf16(a0[0], a0[1]); w.y = cvt_pk_bf16(a0[2], a0[3]); w.z = cvt_pk_bf16(a1[0], a1[1]); w.w = cvt_pk_bf16(a1[2], a1[3]);
                            *(v4u*)(rowp + zb) = w; }
                    }
                }
        }
    }
};
struct EpiZq {
    static constexpr bool PERM = true;
    bf16* Z; const float* hs; const float* cs;
    __device__ __forceinline__ void operator()(f32x4 (&acc)[2][2][4][2], const Unit& u, int wr, int wc, int fr, int fq) const {
        const int row0 = u.pm * BM + wr * 64 + fr, cl = wc * 32 + 8 * fq;
        {
            float rs[2][4]; f32x4 cv[2][2];
#pragma unroll
            for (int ai = 0; ai < 2; ++ai)
#pragma unroll
                for (int m = 0; m < 4; ++m) rs[ai][m] = hs[row0 + ai * HALF + m * 16];
#pragma unroll
            for (int bj = 0; bj < 2; ++bj)
#pragma unroll
                for (int n = 0; n < 2; ++n) cv[bj][n] = *(const f32x4*)(cs + u.pn * BM + bj * HALF + cl + 4 * n) * (1.f / 127.f);
#pragma unroll
            for (int ai = 0; ai < 2; ++ai)
#pragma unroll
                for (int bj = 0; bj < 2; ++bj)
#pragma unroll
                    for (int m = 0; m < 4; ++m)
#pragma unroll
                        for (int n = 0; n < 2; ++n) { const v4i q = __builtin_bit_cast(v4i, acc[ai][bj][m][n]);
                            acc[ai][bj][m][n] = (f32x4){(float)q.x, (float)q.y, (float)q.z, (float)q.w} * rs[ai][m] * cv[bj][n]; }
        }
        if (u.pn < 6) {
            const bool sg = u.pn >= 3;
            const int zc = (sg ? 768 + (u.pn - 3) * 128 : 384 + u.pn * 128) + cl;
#pragma unroll
            for (int ai = 0; ai < 2; ++ai)
#pragma unroll
                for (int m = 0; m < 4; ++m) {
                    f32x4 a0 = acc[ai][0][m][0], a1 = acc[ai][0][m][1], g0 = acc[ai][1][m][0], g1 = acc[ai][1][m][1];
                    if (sg) {
#pragma unroll
                        for (int q = 0; q < 4; ++q) { g0[q] = sigmoidf_(g0[q]); g1[q] = sigmoidf_(g1[q]); }
                    }
                    a0 = a0 * g0; a1 = a1 * g1;
                    v4u w; w.x = cvt_pk_bf16(a0[0], a0[1]); w.y = cvt_pk_bf16(a0[2], a0[3]); w.z = cvt_pk_bf16(a1[0], a1[1]); w.w = cvt_pk_bf16(a1[2], a1[3]);
                    *(v4u*)(Z + (size_t)(row0 + ai * HALF + m * 16) * NZ + zc) = w;
                }
        } else {
            int zb0, zb1;
            if (u.pn == 6) { zb0 = 0; zb1 = 128; } else if (u.pn == 7) { zb0 = 256; zb1 = 1152; } else { zb0 = 1280; zb1 = -1; }
#pragma unroll
            for (int ai = 0; ai < 2; ++ai)
#pragma unroll
                for (int m = 0; m < 4; ++m) {
                    bf16* rowp = Z + (size_t)(row0 + ai * HALF + m * 16) * NZ + cl;
#pragma unroll
                    for (int bj = 0; bj < 2; ++bj) {
                        const int zb = bj ? zb1 : zb0;
                        if (zb >= 0) { const f32x4 a0 = acc[ai][bj][m][0], a1 = acc[ai][bj][m][1];
                            v4u w; w.x = cvt_pk_bf16(a0[0], a0[1]); w.y = cvt_pk_bf16(a0[2], a0[3]); w.z = cvt_pk_bf16(a1[0], a1[1]); w.w = cvt_pk_bf16(a1[2], a1[3]);
                            *(v4u*)(rowp + zb) = w; }
                    }
                }
        }
    }
};
struct EpiU {
    static constexpr bool PERM = true;
    const bf16* H; bf16* U;
    __device__ __forceinline__ void operator()(const f32x4 (&acc)[2][2][4][2], const Unit& u, int wr, int wc, int fr, int fq) const {
        const int row0 = u.pm * BM + wr * 64 + fr, col0 = u.pn * BM + wc * 32 + 8 * fq;
        v4u hh[2][4][2];
#pragma unroll
        for (int ai = 0; ai < 2; ++ai)
#pragma unroll
            for (int m = 0; m < 4; ++m)
#pragma unroll
                for (int bj = 0; bj < 2; ++bj) hh[ai][m][bj] = *(const v4u*)(H + (size_t)(row0 + ai * HALF + m * 16) * D_ + col0 + bj * HALF);
#pragma unroll
        for (int ai = 0; ai < 2; ++ai)
#pragma unroll
            for (int m = 0; m < 4; ++m) {
                const size_t off = (size_t)(row0 + ai * HALF + m * 16) * D_ + col0;
#pragma unroll
                for (int bj = 0; bj < 2; ++bj) {
                    const v4u h = hh[ai][m][bj];
                    const f32x4 a0 = acc[ai][bj][m][0], a1 = acc[ai][bj][m][1];
                    v4u w;
                    w.x = cvt_pk_bf16(ALPHA * bflo(h.x) + a0[0], ALPHA * bfhi(h.x) + a0[1]); w.y = cvt_pk_bf16(ALPHA * bflo(h.y) + a0[2], ALPHA * bfhi(h.y) + a0[3]);
                    w.z = cvt_pk_bf16(ALPHA * bflo(h.z) + a1[0], ALPHA * bfhi(h.z) + a1[1]); w.w = cvt_pk_bf16(ALPHA * bflo(h.w) + a1[2], ALPHA * bfhi(h.w) + a1[3]);
                    *(v4u*)(U + off + bj * HALF) = w;
                }
            }
    }
};
struct EpiHid {
    static constexpr bool PERM = true;
    unsigned char* HID;
    __device__ __forceinline__ void operator()(const f32x4 (&acc)[2][2][4][2], const Unit& u, int wr, int wc, int fr, int fq) const {
        const int row0 = u.pm * BM + wr * 64 + fr, col0 = u.pn * 128 + wc * 32 + 8 * fq;
#pragma unroll
        for (int ai = 0; ai < 2; ++ai) { if (u.rh >= 0 && u.rh != ai) continue;
#pragma unroll
            for (int m = 0; m < 4; ++m) {
                f32x4 g0 = acc[ai][0][m][0], g1 = acc[ai][0][m][1]; const f32x4 u0 = acc[ai][1][m][0], u1 = acc[ai][1][m][1];
#pragma unroll
                for (int q = 0; q < 4; ++q) { g0[q] = g0[q] * sigmoidf_(g0[q]); g1[q] = g1[q] * sigmoidf_(g1[q]); }
                g0 = g0 * u0; g1 = g1 * u1;
                v2u w; w.x = pk4_fp8(g0[0], g0[1], g0[2], g0[3]); w.y = pk4_fp8(g1[0], g1[1], g1[2], g1[3]);
                *(v2u*)(HID + (size_t)(row0 + ai * HALF + m * 16) * DE + col0) = w;
            } }
    }
};
struct EpiPlain8 {
    static constexpr bool PERM = true;
    unsigned char* O; int ldc;
    __device__ __forceinline__ void operator()(const f32x4 (&acc)[2][2][4][2], const Unit& u, int wr, int wc, int fr, int fq) const {
        const int row0 = u.pm * BM + wr * 64 + fr, col0 = u.pn * BM + wc * 32 + 8 * fq;
#pragma unroll
        for (int ai = 0; ai < 2; ++ai) { if (u.rh >= 0 && u.rh != ai) continue;
#pragma unroll
            for (int m = 0; m < 4; ++m) {
                unsigned char* rowp = O + (size_t)(row0 + ai * HALF + m * 16) * ldc + col0;
#pragma unroll
                for (int bj = 0; bj < 2; ++bj) { const f32x4 a0 = acc[ai][bj][m][0], a1 = acc[ai][bj][m][1];
                    v2u w; w.x = pk4_fp8(a0[0], a0[1], a0[2], a0[3]); w.y = pk4_fp8(a1[0], a1[1], a1[2], a1[3]);
                    *(v2u*)(rowp + bj * HALF) = w; }
            } }
    }
};
struct EpiPlain {
    static constexpr bool PERM = true;
    bf16* O; int ldc;
    __device__ __forceinline__ void operator()(const f32x4 (&acc)[2][2][4][2], const Unit& u, int wr, int wc, int fr, int fq) const {
        const int row0 = u.pm * BM + wr * 64 + fr, col0 = u.pn * BM + wc * 32 + 8 * fq;
#pragma unroll
        for (int ai = 0; ai < 2; ++ai)
#pragma unroll
            for (int m = 0; m < 4; ++m) {
                bf16* rowp = O + (size_t)(row0 + ai * HALF + m * 16) * ldc + col0;
#pragma unroll
                for (int bj = 0; bj < 2; ++bj) { const f32x4 a0 = acc[ai][bj][m][0], a1 = acc[ai][bj][m][1];
                    v4u w; w.x = cvt_pk_bf16(a0[0], a0[1]); w.y = cvt_pk_bf16(a0[2], a0[3]); w.z = cvt_pk_bf16(a1[0], a1[1]); w.w = cvt_pk_bf16(a1[2], a1[3]);
                    *(v4u*)(rowp + bj * HALF) = w; }
            }
    }
};

template <class Epi, class Sched>
__device__ __forceinline__ void gemm_phase_simple(const Sched& S, const Epi& E) {
    int tid = threadIdx.x; asm volatile("" : "+v"(tid));
    const int wid = __builtin_amdgcn_readfirstlane(tid >> 6), lane = tid & 63, wr = wid >> 2, wc = wid & 3, fr = lane & 15, fq = lane >> 4;
    const int K = S.K;
    Unit cur;
    for (int ui = 0; S.next(ui, cur); ++ui) {
        f32x4 acc[2][2][4][2];
#pragma unroll
        for (int a = 0; a < 2; ++a)
#pragma unroll
            for (int b = 0; b < 2; ++b)
#pragma unroll
                for (int m = 0; m < 4; ++m)
#pragma unroll
                    for (int n = 0; n < 2; ++n) acc[a][b][m][n] = (f32x4){0.f, 0.f, 0.f, 0.f};
        const char* at = S.a_tile(cur); const char* bt = S.b_tile(cur);
        const char* ap[2][4]; const char* bp[2][2];
#pragma unroll
        for (int ai = 0; ai < 2; ++ai)
#pragma unroll
            for (int m = 0; m < 4; ++m) ap[ai][m] = at + S.a_row_off(cur, ai * HALF + wr * 64 + m * 16 + fr) + fq * 16;
#pragma unroll
        for (int bj = 0; bj < 2; ++bj)
#pragma unroll
            for (int n = 0; n < 2; ++n) { const int rho = n * 16 + fr; bp[bj][n] = bt + (size_t)(bj * HALF + wc * 32 + (Epi::PERM ? perm32(rho) : rho)) * K * 2 + fq * 16; }
        for (int k0 = 0; k0 < K; k0 += 32) {
            bf16x8 a[2][4], b[2][2];
#pragma unroll
            for (int ai = 0; ai < 2; ++ai)
#pragma unroll
                for (int m = 0; m < 4; ++m) a[ai][m] = *(const bf16x8*)(ap[ai][m] + k0 * 2);
#pragma unroll
            for (int bj = 0; bj < 2; ++bj)
#pragma unroll
                for (int n = 0; n < 2; ++n) b[bj][n] = *(const bf16x8*)(bp[bj][n] + k0 * 2);
#pragma unroll
            for (int ai = 0; ai < 2; ++ai)
#pragma unroll
                for (int bj = 0; bj < 2; ++bj)
#pragma unroll
                    for (int m = 0; m < 4; ++m)
#pragma unroll
                        for (int n = 0; n < 2; ++n) acc[ai][bj][m][n] = __builtin_amdgcn_mfma_f32_16x16x32_bf16(b[bj][n], a[ai][m], acc[ai][bj][m][n], 0, 0, 0);
        }
        E(acc, cur, wr, wc, fr, fq);
    }
}

template <int OFF> __device__ __forceinline__ void glds16(const char* base, unsigned voff, unsigned lds_base) {
    asm volatile("s_add_u32 m0, %2, %3\n\ts_nop 0\n\tglobal_load_lds_dwordx4 %0, %1" :: "v"(voff), "s"(base), "s"(lds_base), "n"(OFF) : "memory", "m0", "scc");
}
template <class Epi, class Sched, int MODE = 0  >
__device__ __forceinline__ void gemm_phase(PG8_LAS unsigned char* lds, const Sched& S, const Epi& E) {
    constexpr bool GATHER = Sched::GATHER;
    int tid = threadIdx.x; asm volatile("" : "+v"(tid));
    const int wid = __builtin_amdgcn_readfirstlane(tid >> 6), lane = tid & 63, wr = wid >> 2, wc = wid & 3, fr = lane & 15, fq = lane >> 4;
    const int K = S.K, nt = K / BK;
    unsigned voffB[2], offA[4], nxA[4];
#pragma unroll
    for (int i = 0; i < 2; ++i) { int R, C; stage_rc(tid * 16 + i * 8192, R, C); const int Rb = Epi::PERM ? ((R & ~31) + perm32(R & 31)) : R;
        voffB[i] = (unsigned)(Rb * K + C) * 2u; offA[i] = (unsigned)(R * K + C) * 2u; offA[2 + i] = (unsigned)((R + HALF) * K + C) * 2u; nxA[i] = 0u; nxA[2 + i] = 0u; }
    const size_t kstep = (size_t)(BK * 2);
    const size_t hstep = (size_t)HALF * K * 2;
    const unsigned ldsw = (unsigned)wid * 1024u;
    const unsigned ldsbw = (unsigned)(size_t)lds + ldsw;
    const int aoff = lds_byte(wr * 64 + fr, fq * 8), boff = lds_byte(wc * 32 + fr, fq * 8);
#define PG8_SA(b, h) (((b) * 2 + (h)) * HTB)
#define PG8_SB(b, h) ((4 + (b) * 2 + (h)) * HTB)
#define PG8_STAGE_B(bufoff, gbase) do { glds16<(bufoff)>((const char*)(gbase), voffB[0], ldsbw); glds16<(bufoff) + 8192>((const char*)(gbase), voffB[1], ldsbw); } while (0)
#define PG8_STAGE_A(bufoff, gbase, h) do { glds16<(bufoff)>((const char*)(gbase), offA[(h) * 2], ldsbw); glds16<(bufoff) + 8192>((const char*)(gbase), offA[(h) * 2 + 1], ldsbw); } while (0)
#define PG8_LDA(dst, b, h) do { _Pragma("unroll") for (int m = 0; m < 4; ++m) _Pragma("unroll") for (int k = 0; k < 2; ++k) dst[m][k] = *(const PG8_LAS bf16x8*)(lds + PG8_SA(b, h) + aoff + m * 2048 + k * 1024); } while (0)
#define PG8_LDB(dst, b, h) do { _Pragma("unroll") for (int n = 0; n < 2; ++n) _Pragma("unroll") for (int k = 0; k < 2; ++k) dst[n][k] = *(const PG8_LAS bf16x8*)(lds + PG8_SB(b, h) + boff + n * 2048 + k * 1024); } while (0)
#define PG8_MMA(ai, bj, At, Bt) do { __builtin_amdgcn_s_setprio(1); if constexpr (MODE == 1) { _Pragma("unroll") for (int m = 0; m < 4; ++m) _Pragma("unroll") for (int n = 0; n < 2; ++n) { \
            const v8i _b = __builtin_shufflevector(__builtin_bit_cast(v4i, Bt[n][0]), __builtin_bit_cast(v4i, Bt[n][1]), 0, 1, 2, 3, 4, 5, 6, 7); \
            const v8i _a = __builtin_shufflevector(__builtin_bit_cast(v4i, At[m][0]), __builtin_bit_cast(v4i, At[m][1]), 0, 1, 2, 3, 4, 5, 6, 7); \
            acc[ai][bj][m][n] = __builtin_amdgcn_mfma_scale_f32_16x16x128_f8f6f4(_b, _a, acc[ai][bj][m][n], 0, 0, 0, 0x7A7A7A7A, 0, 0x7F7F7F7F); } } \
        else if constexpr (MODE == 2) { _Pragma("unroll") for (int m = 0; m < 4; ++m) _Pragma("unroll") for (int n = 0; n < 2; ++n) _Pragma("unroll") for (int k = 0; k < 2; ++k) \
        acc[ai][bj][m][n] = __builtin_bit_cast(f32x4, __builtin_amdgcn_mfma_i32_16x16x64_i8(__builtin_bit_cast(v4i, Bt[n][k]), __builtin_bit_cast(v4i, At[m][k]), __builtin_bit_cast(v4i, acc[ai][bj][m][n]), 0, 0, 0)); } \
        else { _Pragma("unroll") for (int m = 0; m < 4; ++m) _Pragma("unroll") for (int n = 0; n < 2; ++n) _Pragma("unroll") for (int k = 0; k < 2; ++k) \
        acc[ai][bj][m][n] = __builtin_amdgcn_mfma_f32_16x16x32_bf16(Bt[n][k], At[m][k], acc[ai][bj][m][n], 0, 0, 0); } __builtin_amdgcn_s_setprio(0); } while (0)
#define PG8_WAIT_V(n) asm volatile("s_waitcnt vmcnt(" #n ")" ::: "memory")
#define PG8_WAIT_L(n) asm volatile("s_waitcnt lgkmcnt(" #n ")" ::: "memory")
#define PG8_BAR __builtin_amdgcn_s_barrier()
#define PG8_SCHED __builtin_amdgcn_sched_barrier(0)
#define PG8_OFFS(dst, u) do { if constexpr (GATHER) { _Pragma("unroll") for (int _h = 0; _h < 2; ++_h) _Pragma("unroll") for (int _i = 0; _i < 2; ++_i) { \
        int _R, _C; stage_rc(tid * 16 + _i * 8192, _R, _C); dst[_h * 2 + _i] = S.a_row_off(u, _h * HALF + _R) + (unsigned)(_C * 2); } } } while (0)
    Unit cur, nxt; int ui = 0;
    if (!S.next(0, cur)) return;
    f32x4 acc[2][2][4][2];
#pragma unroll
    for (int a = 0; a < 2; ++a)
#pragma unroll
        for (int b = 0; b < 2; ++b)
#pragma unroll
            for (int m = 0; m < 4; ++m)
#pragma unroll
                for (int n = 0; n < 2; ++n) acc[a][b][m][n] = (f32x4){0.f, 0.f, 0.f, 0.f};
    bf16x8 At[4][2], B0[2][2], B1[2][2];
    const char* cA = S.a_tile(cur); const char* cB = S.b_tile(cur);
    PG8_OFFS(offA, cur);
    PG8_STAGE_B(PG8_SB(0, 0), cB); PG8_STAGE_B(PG8_SB(0, 1), cB + hstep); PG8_STAGE_A(PG8_SA(0, 0), cA, 0); PG8_STAGE_A(PG8_SA(0, 1), cA, 1);
    if (wr == 1) PG8_BAR;
    PG8_WAIT_V(2); PG8_BAR;
    PG8_STAGE_B(PG8_SB(1, 0), cB + kstep); PG8_STAGE_A(PG8_SA(1, 0), cA + kstep, 0); PG8_STAGE_B(PG8_SB(1, 1), cB + hstep + kstep);
    PG8_WAIT_V(6); PG8_BAR;
    for (;;) {
        const bool has_next = S.next(ui + 1, nxt);
        const char* nA = has_next ? S.a_tile(nxt) : cA; const char* nB = has_next ? S.b_tile(nxt) : cB;
        if constexpr (GATHER) { if (has_next) { PG8_OFFS(nxA, nxt); } }
#pragma unroll 1
        for (int t = 0; t < nt; t += 2) {
            const bool last = (t == nt - 2);
            const char* a1 = cA + (size_t)(t + 1) * kstep;
            const char* a2 = last ? nA : cA + (size_t)(t + 2) * kstep; const char* b2 = last ? nB : cB + (size_t)(t + 2) * kstep;
            const char* a3 = a2 + kstep; const char* b3 = b2 + kstep;
            PG8_LDB(B0, 0, 0); PG8_LDB(B1, 0, 1); PG8_SCHED; PG8_LDA(At, 0, 0); PG8_STAGE_A(PG8_SA(1, 1), a1, 1);
            if constexpr (GATHER) { if (last && has_next) {
#pragma unroll
                for (int q = 0; q < 4; ++q) offA[q] = nxA[q]; } }
            PG8_WAIT_V(8); PG8_WAIT_L(0); PG8_BAR; if (!(Sched::HAS_RH && cur.rh == 1)) { PG8_MMA(0, 0, At, B0); if (!(Sched::HAS_HALF && S.is_half(cur))) PG8_MMA(0, 1, At, B1); } PG8_BAR; PG8_SCHED;
            PG8_LDA(At, 0, 1); PG8_STAGE_B(PG8_SB(0, 0), b2); PG8_STAGE_B(PG8_SB(0, 1), b2 + hstep); PG8_STAGE_A(PG8_SA(0, 0), a2, 0);
            PG8_WAIT_V(8); PG8_WAIT_L(0); PG8_BAR; if (!(Sched::HAS_RH && cur.rh == 0)) { PG8_MMA(1, 0, At, B0); if (!(Sched::HAS_HALF && S.is_half(cur))) PG8_MMA(1, 1, At, B1); } PG8_BAR; PG8_SCHED;
            PG8_LDB(B0, 1, 0); PG8_LDB(B1, 1, 1); PG8_SCHED; PG8_LDA(At, 1, 0); PG8_STAGE_A(PG8_SA(0, 1), a2, 1);
            PG8_WAIT_V(8); PG8_WAIT_L(0); PG8_BAR; if (!(Sched::HAS_RH && cur.rh == 1)) { PG8_MMA(0, 0, At, B0); if (!(Sched::HAS_HALF && S.is_half(cur))) PG8_MMA(0, 1, At, B1); } PG8_BAR; PG8_SCHED;
            PG8_LDA(At, 1, 1); PG8_STAGE_B(PG8_SB(1, 0), b3); PG8_STAGE_B(PG8_SB(1, 1), b3 + hstep); PG8_STAGE_A(PG8_SA(1, 0), a3, 0);
            PG8_WAIT_V(8); PG8_WAIT_L(0); PG8_BAR; if (!(Sched::HAS_RH && cur.rh == 0)) { PG8_MMA(1, 0, At, B0); if (!(Sched::HAS_HALF && S.is_half(cur))) PG8_MMA(1, 1, At, B1); } PG8_BAR; PG8_SCHED;
        }
        if (wr == 0) PG8_BAR;
        E(acc, cur, wr, wc, fr, fq);
        if (!has_next) break;
#pragma unroll
        for (int a = 0; a < 2; ++a)
#pragma unroll
            for (int b = 0; b < 2; ++b)
#pragma unroll
                for (int m = 0; m < 4; ++m)
#pragma unroll
                    for (int n = 0; n < 2; ++n) acc[a][b][m][n] = (f32x4){0.f, 0.f, 0.f, 0.f};
        cur = nxt; cA = nA; cB = nB; ++ui;
        if (wr == 1) PG8_BAR;
    }
    PG8_WAIT_V(0);
    PG8_BAR;
#undef PG8_SA
#undef PG8_SB
#undef PG8_STAGE_A
#undef PG8_STAGE_B
#undef PG8_LDA
#undef PG8_LDB
#undef PG8_MMA
#undef PG8_WAIT_V
#undef PG8_WAIT_L
#undef PG8_BAR
#undef PG8_SCHED
#undef PG8_OFFS
}
}

#define XB_TMO      128
#define XB_XCNT(j)  (256  + 64 * (j))
#define XB_XSUB(j)  (1280 + 64 * (j))
#define XB_XGEN(j)  (2304 + 64 * (j))
#define XB_TOP      3328
#define XB_TOPGEN   3392
#define XCD_BAR_WORDS 3456
#define XB_SPIN_CAP (1u << 18)
__device__ __forceinline__ unsigned xb_ld(unsigned* p)              { return __hip_atomic_load(p, __ATOMIC_RELAXED, __HIP_MEMORY_SCOPE_AGENT); }
__device__ __forceinline__ unsigned xb_add(unsigned* p, unsigned v) { return __hip_atomic_fetch_add(p, v, __ATOMIC_RELAXED, __HIP_MEMORY_SCOPE_AGENT); }
__device__ __forceinline__ unsigned xb_xcc_id() { return (unsigned)__builtin_amdgcn_s_getreg((3 << 11) | 20) & 0xFu; }
#define XB_SPIN(cond, bar) do { unsigned _sp = 0; while (cond) { __builtin_amdgcn_s_sleep(1); \
    if ((++_sp & 255u) == 0u) { if (xb_ld(&(bar)[XB_TMO])) break; if (_sp > XB_SPIN_CAP) { atomicAdd(&(bar)[XB_TMO], 1u); break; } } } } while (0)
struct XcdBarrier { unsigned* bar; unsigned x; volatile LAS unsigned* st; };
__device__ __forceinline__ XcdBarrier xcd_barrier_post(unsigned* bar, volatile LAS unsigned* st) {
    XcdBarrier b; b.bar = bar; b.x = xb_xcc_id(); b.st = st;
    if (threadIdx.x == 0) (void)xb_add(&bar[XB_XCNT(b.x)], 1u);
    return b;
}
__device__ __forceinline__ void xcd_barrier_complete(unsigned* bar, unsigned x, unsigned& nloc, unsigned& nx) {
    const unsigned G = gridDim.x * gridDim.y * gridDim.z;
    unsigned sum, cnt, mine, sp = 0u;
    for (;;) {
        sum = 0u; cnt = 0u; mine = 0u;
#pragma unroll
        for (unsigned j = 0; j < 16; ++j) { const unsigned c = xb_ld(&bar[XB_XCNT(j)]); sum += c; cnt += (c > 0u) ? 1u : 0u; mine = (j == x) ? c : mine; }
        if (sum == G) break;
        __builtin_amdgcn_s_sleep(1);
        if ((++sp & 255u) == 0u) { if (xb_ld(&bar[XB_TMO])) break; if (sp > XB_SPIN_CAP) { atomicAdd(&bar[XB_TMO], 1u); break; } }
    }
    nloc = mine > 0u ? mine : 1u; nx = cnt > 0u ? cnt : 1u;
}
__device__ __forceinline__ void xcd_barrier(const XcdBarrier& b) {
    asm volatile("s_waitcnt vmcnt(0)" ::: "memory");
    __syncthreads();
    if (threadIdx.x == 0) {
        unsigned* bar = b.bar;
        __builtin_amdgcn_s_waitcnt(0);
        unsigned nloc = b.st[0], nx = b.st[1];
        if (nloc == 0u) { xcd_barrier_complete(bar, b.x, nloc, nx); b.st[0] = nloc; b.st[1] = nx; }
        const unsigned old = xb_add(&bar[XB_XSUB(b.x)], 1u);
        const unsigned gen = old / nloc;
        if (old + 1u == (gen + 1u) * nloc) {
            __builtin_amdgcn_fence(__ATOMIC_RELEASE, "agent");
            asm volatile("s_waitcnt vmcnt(0)" ::: "memory");
            const unsigned og = xb_add(&bar[XB_TOP], 1u);
            const unsigned tg = og / nx;
            if (og + 1u == (tg + 1u) * nx) xb_add(&bar[XB_TOPGEN], 1u);
            else XB_SPIN(xb_ld(&bar[XB_TOPGEN]) == tg, bar);
            __builtin_amdgcn_fence(__ATOMIC_ACQUIRE, "agent");
            xb_add(&bar[XB_XGEN(b.x)], 1u);
            asm volatile("s_waitcnt vmcnt(0)" ::: "memory");
        } else {
            XB_SPIN(xb_ld(&bar[XB_XGEN(b.x)]) == gen, bar);
            __builtin_amdgcn_fence(__ATOMIC_ACQUIRE, "agent");
            asm volatile("s_waitcnt vmcnt(0)" ::: "memory");
        }
    }
    __syncthreads();
}

constexpr int NWAVES = 8;
struct Args { const float* in[21]; float* out; unsigned char* ws; int ph_lo, ph_hi; };
struct Frame {
    LAS unsigned char* lds;
    unsigned* ctl;
    int tid, lane, wave, vcu, G;
    unsigned char* ws;
};
enum { I_X = 0, I_LNIG, I_LNIB, I_RW, I_RB, I_WIN, I_CAW, I_CBW, I_CBB, I_LCG, I_LCB, I_PW, I_PS, I_WOUT, I_LMG, I_LMB, I_WG, I_WU, I_WDN, I_LFG, I_LFB };

__device__ __forceinline__ void tr_item(const float* src, int srcN, int srccol0, bf16* dst, int dstK, int dstrow0, int k0, LAS float* scr, int lane) {
#pragma unroll 8
    for (int i = 0; i < 32; ++i) { const int kk = 2 * i + (lane >> 5); scr[kk * 33 + (lane & 31)] = src[(size_t)(k0 + kk) * srcN + srccol0 + (lane & 31)]; }
    LDS_WAIT(); asm volatile("" ::: "memory");
    const int c = lane & 7;
#pragma unroll
    for (int j = 0; j < 4; ++j) { const int n = (lane >> 3) + 8 * j; const LAS float* s = scr + (8 * c) * 33 + n;
        v4u o; o.x = pk2(s[0 * 33], s[1 * 33]); o.y = pk2(s[2 * 33], s[3 * 33]); o.z = pk2(s[4 * 33], s[5 * 33]); o.w = pk2(s[6 * 33], s[7 * 33]);
        *(GAS v4u*)(dst + (size_t)(dstrow0 + n) * dstK + k0 + 8 * c) = o; }
    LDS_WAIT(); asm volatile("" ::: "memory");
}
__device__ __forceinline__ void tr_item64(const float* src, int srcN, int srccol0, bf16* dst, int dstK, int dstrow0, int k0, LAS unsigned* scr, int lane) {
    const int kr = lane >> 4, c4 = lane & 15;
    const float* sp = src + (size_t)(k0 + 2 * kr) * srcN + srccol0 + 4 * c4;
    f32x4 A[8], B[8];
#pragma unroll
    for (int i = 0; i < 8; ++i) { A[i] = *(const GAS f32x4*)(sp + (size_t)(8 * i) * srcN); B[i] = *(const GAS f32x4*)(sp + (size_t)(8 * i + 1) * srcN); }
#pragma unroll
    for (int i = 0; i < 8; ++i) { LAS unsigned* w = scr + (4 * i + kr) * 65 + 4 * c4;
        w[0] = pk2(A[i].x, B[i].x); w[1] = pk2(A[i].y, B[i].y); w[2] = pk2(A[i].z, B[i].z); w[3] = pk2(A[i].w, B[i].w); }
    LDS_WAIT(); asm volatile("" ::: "memory");
    const int q = lane & 7, nn = lane >> 3;
#pragma unroll
    for (int j = 0; j < 8; ++j) { const int n = nn + 8 * j; const LAS unsigned* r = scr + (4 * q) * 65 + n;
        v4u o; o.x = r[0]; o.y = r[65]; o.z = r[130]; o.w = r[195];
        *(GAS v4u*)(dst + (size_t)(dstrow0 + n) * dstK + k0 + 8 * q) = o; }
    LDS_WAIT(); asm volatile("" ::: "memory");
}
template <int NS, bool I8 = false>
__device__ __forceinline__ void tr_item64_f8(const float* src, int srcN, int srccol0, unsigned char* dst, int dstKB, int dstrow0, int k0, float scale, LAS unsigned* scr, int lane, bool nostore = false, f32x4 cinv = (f32x4){1.f, 1.f, 1.f, 1.f}) {
    const int kr = lane >> 4, c4 = lane & 15;
    const float* sp = src + (size_t)(k0 + 4 * kr) * srcN + srccol0 + 4 * c4;
    f32x4 A[NS][4][4];
#pragma unroll
    for (int s = 0; s < NS; ++s)
#pragma unroll
        for (int i = 0; i < 4; ++i)
#pragma unroll
            for (int t = 0; t < 4; ++t) A[s][i][t] = *(const GAS f32x4*)(sp + (size_t)(64 * s + 16 * i + t) * srcN);
#pragma unroll
    for (int s = 0; s < NS; ++s)
#pragma unroll
        for (int i = 0; i < 4; ++i) { LAS unsigned* w = scr + (16 * s + 4 * i + kr) * 65 + 4 * c4;
            if constexpr (I8) {
            w[0] = pk4_i8(A[s][i][0].x * cinv.x, A[s][i][1].x * cinv.x, A[s][i][2].x * cinv.x, A[s][i][3].x * cinv.x); w[1] = pk4_i8(A[s][i][0].y * cinv.y, A[s][i][1].y * cinv.y, A[s][i][2].y * cinv.y, A[s][i][3].y * cinv.y);
            w[2] = pk4_i8(A[s][i][0].z * cinv.z, A[s][i][1].z * cinv.z, A[s][i][2].z * cinv.z, A[s][i][3].z * cinv.z); w[3] = pk4_i8(A[s][i][0].w * cinv.w, A[s][i][1].w * cinv.w, A[s][i][2].w * cinv.w, A[s][i][3].w * cinv.w); } else {
            w[0] = pk4_fp8(A[s][i][0].x * scale, A[s][i][1].x * scale, A[s][i][2].x * scale, A[s][i][3].x * scale); w[1] = pk4_fp8(A[s][i][0].y * scale, A[s][i][1].y * scale, A[s][i][2].y * scale, A[s][i][3].y * scale);
            w[2] = pk4_fp8(A[s][i][0].z * scale, A[s][i][1].z * scale, A[s][i][2].z * scale, A[s][i][3].z * scale); w[3] = pk4_fp8(A[s][i][0].w * scale, A[s][i][1].w * scale, A[s][i][2].w * scale, A[s][i][3].w * scale); } }
    LDS_WAIT(); asm volatile("" ::: "memory");
    constexpr int QN = 4 * NS, RN = 64 / QN;
    const int q = lane % QN, nn = lane / QN;
#pragma unroll
    for (int j = 0; j < 64 / RN; ++j) { const int n = nn + RN * j; const LAS unsigned* r = scr + (4 * q) * 65 + n;
        v4u o; o.x = r[0]; o.y = r[65]; o.z = r[130]; o.w = r[195];
        if (nostore) asm volatile("" :: "v"(o)); else *(GAS v4u*)(dst + (size_t)(dstrow0 + n) * dstKB + k0 + 16 * q) = o; }
    LDS_WAIT(); asm volatile("" ::: "memory");
}
__device__ __forceinline__ int win_src(int c0) {
    const int pn = c0 >> 8, j = c0 & 255, half = j >> 7, jj = j & 127;
    if (pn < 3) { const int ch = pn * 128 + jj; return half == 0 ? 384 + ch : 768 + ch; }
    if (pn < 6) { const int ch = (pn - 3) * 128 + jj; return half == 0 ? 1152 + ch : 1536 + ch; }
    if (pn < 8) { const int q = (pn - 6) * 256 + j; return q < 384 ? q : 1920 + (q - 384); }
    return j < 128 ? 1920 + 128 + j : -1;
}
__device__ __forceinline__ void p0_prologue(Frame& F, const Args& A) {
    LAS float* scr = (LAS float*)(F.lds + F.wave * 8448);
    LAS unsigned* scu = (LAS unsigned*)scr;
    const int gw = F.vcu * NWAVES + F.wave, NGW = F.G * NWAVES, lane = F.lane;
    bf16* WIN = (bf16*)(F.ws + WS_WIN); bf16* WOUT = (bf16*)(F.ws + WS_WOUT); unsigned char* WGU = F.ws + WS_WGU; unsigned char* WD = F.ws + WS_WD; bf16* WRT = (bf16*)(F.ws + WS_WRT);
    constexpr int I_M = GEMM1_I8 ? NL * 36 * 8 : 0, I_A = GEMM1_I8 ? NL * 36 * 8 : NL * 16 * 36, I_B = NL * 12 * 16, I_C = NL * NE * 128, I_D = NL * NE * 64, I_E = 16, I_F = NL * 4 * 16 * 2;
    constexpr int NITEMS = I_M + I_A + I_B + I_C + I_D + I_E + I_F;
    const int lane0 = lane;
#pragma unroll 1
    for (int prep = 0; prep < ((PROBE_P0 == 1 || PROBE_P0 == 3) ? 2 : 1); ++prep)
    for (int it = gw; it < NITEMS; it += NGW) {
        int lane = lane0; asm volatile("" : "+v"(lane));
        int r = it;
        if (r < I_M) {
            const int l = r / 288, q = r % 288, cb = q >> 3, kq = q & 7, c0 = cb * 64, sc = win_src(c0), kr = lane >> 4, c4 = lane & 15;
            if (sc >= 0) { const float* sp = A.in[I_WIN] + (size_t)l * 1024 * DIN + (size_t)(kq * 128 + kr) * DIN + sc + 4 * c4;
                f32x4 vv[32];
#pragma unroll
                for (int i = 0; i < 32; ++i) vv[i] = *(const GAS f32x4*)(sp + (size_t)(4 * i) * DIN);
                f32x4 mx = (f32x4){0.f, 0.f, 0.f, 0.f};
#pragma unroll
                for (int i = 0; i < 32; ++i) { mx.x = fmaxf(mx.x, fabsf(vv[i].x)); mx.y = fmaxf(mx.y, fabsf(vv[i].y)); mx.z = fmaxf(mx.z, fabsf(vv[i].z)); mx.w = fmaxf(mx.w, fabsf(vv[i].w)); }
#pragma unroll
                for (int o = 16; o <= 32; o <<= 1) { mx.x = fmaxf(mx.x, __shfl_xor(mx.x, o)); mx.y = fmaxf(mx.y, __shfl_xor(mx.y, o)); mx.z = fmaxf(mx.z, __shfl_xor(mx.z, o)); mx.w = fmaxf(mx.w, __shfl_xor(mx.w, o)); }
                if (kr == 0) { unsigned* cm = F.ctl + CW_CMAX + l * N1 + c0 + 4 * c4;
                    __hip_atomic_fetch_max(cm + 0, __float_as_uint(mx.x), RLX_AGENT); __hip_atomic_fetch_max(cm + 1, __float_as_uint(mx.y), RLX_AGENT);
                    __hip_atomic_fetch_max(cm + 2, __float_as_uint(mx.z), RLX_AGENT); __hip_atomic_fetch_max(cm + 3, __float_as_uint(mx.w), RLX_AGENT); } }
            VM_WAIT();
            if (lane == 0) __hip_atomic_fetch_add(F.ctl + CW_CMAXCNT, 1u, RLX_AGENT);
            continue; }
        r -= I_M;
        if (r < I_C) {
            const int le = r >> 7, q = r & 127, kb = q >> 4, nb = q & 15, n0 = nb * 64, pn = n0 >> 8, half = (n0 & 255) >> 7, jj0 = n0 & 127;
            const float* src = (half ? A.in[I_WU] : A.in[I_WG]) + (size_t)le * 1024 * 512;
            tr_item64_f8<2>(src, 512, pn * 128 + jj0, WGU + (size_t)le * 1024 * 1024, 1024, n0, kb * 128, 32.0f, scu, lane, PROBE_P0 == 3 && prep == 1); continue; }
        r -= I_C;
        if (r < I_D) {
            const int le = r >> 6, q = r & 63, kb = q >> 4, nb = q & 15;
            tr_item64_f8<2>(A.in[I_WDN] + (size_t)le * 512 * 1024, 1024, nb * 64, WD + (size_t)le * 1024 * 512, 512, nb * 64, kb * 128, 32.0f, scu, lane, PROBE_P0 == 3 && prep == 1); continue; }
        r -= I_D;
        if (r < I_A) {
            if (GEMM1_I8) {
                const int l = r / 288, q = r % 288, cb = q >> 3, kb = q & 7, c0 = cb * 64, sc = win_src(c0), c4 = lane & 15;
                unsigned char* dst = F.ws + WS_WIN + (size_t)l * N1 * 1024;
                { unsigned spins = 0;
                  while (__hip_atomic_load(F.ctl + CW_CMAXCNT, RLX_AGENT) < (unsigned)I_M * ((PROBE_P0 == 1 || PROBE_P0 == 3) ? (unsigned)(prep + 1) : 1u)) { __builtin_amdgcn_s_sleep(8); if (++spins > (1u << 22)) break; } }
                if (sc >= 0) { const unsigned* cm = F.ctl + CW_CMAX + l * N1 + c0 + 4 * c4;
                    f32x4 mx; mx.x = __uint_as_float(__hip_atomic_load(cm + 0, RLX_AGENT)); mx.y = __uint_as_float(__hip_atomic_load(cm + 1, RLX_AGENT)); mx.z = __uint_as_float(__hip_atomic_load(cm + 2, RLX_AGENT)); mx.w = __uint_as_float(__hip_atomic_load(cm + 3, RLX_AGENT));
                    f32x4 cinv; cinv.x = mx.x > 0.f ? 127.f / mx.x : 0.f; cinv.y = mx.y > 0.f ? 127.f / mx.y : 0.f; cinv.z = mx.z > 0.f ? 127.f / mx.z : 0.f; cinv.w = mx.w > 0.f ? 127.f / mx.w : 0.f;
                    tr_item64_f8<2, true>(A.in[I_WIN] + (size_t)l * 1024 * DIN, DIN, sc, dst, 1024, c0, kb * 128, 1.f, scu, lane, false, cinv);
                } else { for (int qq = lane; qq < 64 * 8; qq += 64) *(GAS v4u*)(dst + (size_t)(c0 + (qq >> 3)) * 1024 + kb * 128 + (qq & 7) * 16) = (v4u){0u, 0u, 0u, 0u}; }
                continue; }
            const int l = r / 576, q = r % 576, kb = q / 36, nb = q % 36, c0 = nb * 64, sc = win_src(c0);
            bf16* dst = WIN + (size_t)l * N1 * 1024;
            if (sc >= 0) tr_item64(A.in[I_WIN] + (size_t)l * 1024 * DIN, DIN, sc, dst, 1024, c0, kb * 64, scu, lane);
            else { const int c = lane & 7;
#pragma unroll
                for (int j = 0; j < 8; ++j) { const int n = (lane >> 3) + 8 * j; *(GAS v4u*)(dst + (size_t)(c0 + n) * 1024 + kb * 64 + 8 * c) = (v4u){0u, 0u, 0u, 0u}; } }
            continue; }
        r -= I_A;
        if (r < I_B) {
            const int l = r / 192, q = r % 192, kb = q >> 4, nb = q & 15;
            if (GEMM2_FP8) tr_item64_f8<1>(A.in[I_WOUT] + (size_t)l * 1024 * 1024, 1024, nb * 64, (unsigned char*)WOUT + (size_t)l * 1024 * 1024, 1024, nb * 64, kb * 64, 32.0f, scu, lane);
            else tr_item64(A.in[I_WOUT] + (size_t)l * 1024 * 1024, 1024, nb * 64, WOUT + (size_t)l * 1024 * 1024, 1024, nb * 64, kb * 64, scu, lane);
            continue; }
        r -= I_B;
        if (r < I_E) { tr_item(A.in[I_RW], 32, 0, WRT, 1024, 0, r * 64, scr, lane); continue; }
        r -= I_E;
        {
            const int l = r >> 7, g = (r >> 5) & 3, nb = (r >> 1) & 15, cb = r & 1, n = nb * 64 + lane;
            const float* wo = A.in[I_WOUT] + (size_t)l * 1024 * 1024 + (size_t)(768 + g * 64) * 1024 + n;
            const float* ps = A.in[I_PS] + l * 256 + g * 64;
            const float* pw = A.in[I_PW] + (size_t)(l * 4 + g) * 64 * 64 + cb * 32 * 64;
#pragma unroll
            for (int i = 0; i < 8; ++i) *(LAS f32x4*)(scr + (i * 64 + lane) * 4) = *(const GAS f32x4*)(pw + (i * 64 + lane) * 4);
            float wv[64];
#pragma unroll
            for (int d = 0; d < 64; ++d) wv[d] = wo[(size_t)d * 1024] * ps[d];
            LDS_WAIT(); asm volatile("" ::: "memory");
            bf16* dst = WOUT + (size_t)l * 1024 * 1024 + (size_t)n * 1024 + 768 + g * 64 + cb * 32;
#pragma unroll 1
            for (int c2 = 0; c2 < 16; ++c2) { float o[2];
#pragma unroll
                for (int cc = 0; cc < 2; ++cc) { const LAS f32x4* pr = (const LAS f32x4*)(scr + (c2 * 2 + cc) * 64); float a = 0.f;
#pragma unroll
                    for (int d4 = 0; d4 < 16; ++d4) { const f32x4 p = pr[d4]; a += p.x * wv[4 * d4] + p.y * wv[4 * d4 + 1] + p.z * wv[4 * d4 + 2] + p.w * wv[4 * d4 + 3]; }
                    o[cc] = a; }
                if (GEMM2_FP8) *(GAS unsigned short*)((unsigned char*)WOUT + (size_t)l * 1024 * 1024 + (size_t)n * 1024 + 768 + g * 64 + cb * 32 + c2 * 2) = (unsigned short)pk4_fp8(o[0] * 32.0f, o[1] * 32.0f, 0.f, 0.f);
                else *(GAS unsigned*)(dst + c2 * 2) = pk2(o[0], o[1]); }
            LDS_WAIT(); asm volatile("" ::: "memory");
        }
    }
    bf16* HB = (bf16*)(F.ws + WS_HB);
    const float* g = A.in[I_LNIG]; const float* b = A.in[I_LNIB];
    f32x4 gv[4], bv[4];
#pragma unroll
    for (int j = 0; j < 4; ++j) { gv[j] = *(const f32x4*)(g + 4 * lane + 256 * j); bv[j] = *(const f32x4*)(b + 4 * lane + 256 * j); }
#pragma unroll 1
    for (int prep2 = 0; prep2 < ((PROBE_P0 == 2) ? 2 : 1); ++prep2)
    for (int m0 = gw * 2; m0 < T_; m0 += NGW * 2) {
        f32x4 v[2][4];
#pragma unroll
        for (int u = 0; u < 2; ++u) { const GAS f32x4* xr = (const GAS f32x4*)(A.in[I_X] + (size_t)(m0 + u) * D_) + lane;
#pragma unroll
            for (int j = 0; j < 4; ++j) v[u][j] = xr[64 * j]; }
#pragma unroll
        for (int u = 0; u < 2; ++u) { float s = 0.f;
#pragma unroll
            for (int j = 0; j < 4; ++j) s += (v[u][j].x + v[u][j].y) + (v[u][j].z + v[u][j].w);
            const float mean = wave_sum(s) * (1.f / D_); float s2 = 0.f;
#pragma unroll
            for (int j = 0; j < 4; ++j) { v[u][j] = v[u][j] - mean; s2 += (v[u][j].x * v[u][j].x + v[u][j].y * v[u][j].y) + (v[u][j].z * v[u][j].z + v[u][j].w * v[u][j].w); }
            const float rstd = __builtin_amdgcn_rsqf(wave_sum(s2) * (1.f / D_) + LN_EPS);
            GAS v2u* o8 = (GAS v2u*)(HB + (size_t)(m0 + u) * D_) + lane;
            float amax = 0.f;
#pragma unroll
            for (int j = 0; j < 4; ++j) { const f32x4 o = v[u][j] * rstd * gv[j] + bv[j]; v[u][j] = o; v2u w; w.x = pk2(o.x, o.y); w.y = pk2(o.z, o.w); o8[64 * j] = w;
                amax = fmaxf(amax, fmaxf(fmaxf(fabsf(o.x), fabsf(o.y)), fmaxf(fabsf(o.z), fabsf(o.w)))); }
            if (GEMM1_I8) {
                amax = wave_max(amax); const float inv = amax > 0.f ? 127.f / amax : 0.f;
                GAS unsigned* q4 = (GAS unsigned*)(F.ws + WS_HQ + (size_t)(m0 + u) * D_) + lane;
#pragma unroll
                for (int j = 0; j < 4; ++j) q4[64 * j] = pk4_i8(v[u][j].x * inv, v[u][j].y * inv, v[u][j].z * inv, v[u][j].w * inv);
                if (lane == 0) ((float*)(F.ws + WS_HS))[m0 + u] = amax * (1.f / 127.f); } }
    }
}

__device__ __forceinline__ void p2_mixer(Frame& F, const Args& A, int l) {
    LAS unsigned* BV = (LAS unsigned*)F.lds;
    LAS unsigned* PB = (LAS unsigned*)(F.lds + 47616);
    LAS float* V = (LAS float*)(F.lds + 71680);
    const bf16* Z = (const bf16*)(F.ws + WS_Z); bf16* Y = (bf16*)(F.ws + WS_Y);
    const float* wB = A.in[I_CBW] + l * 31 * 384; const float* bB = A.in[I_CBB] + l * 384;
    const float* lg = A.in[I_LCG] + l * 384; const float* lb = A.in[I_LCB] + l * 384; const float* wA = A.in[I_CAW] + l * 3 * 384;
    int tid = F.tid; asm volatile("" : "+v"(tid));
    const int lane = tid & 63, wave = F.wave;
    const bool convt = tid < 384; const int cp = tid % 192, tg = tid / 192;
    f32x2 w[31]; f32x2 bias = (f32x2){0.f, 0.f};
#pragma unroll
    for (int j = 0; j < 31; ++j) w[j] = (f32x2){0.f, 0.f};
    if (convt) {
#pragma unroll
        for (int j = 0; j < 31; ++j) w[j] = *(const f32x2*)(wB + j * 384 + 2 * cp);
        bias = *(const f32x2*)(bB + 2 * cp); }
    v4u pre[9];
#define MIX_PREFETCH(ci_, tid_) do { const int _t0 = (ci_) * 32, _s0 = _t0 & (SEQ_ - 1); \
        _Pragma("unroll") for (int _i = 0; _i < 6; ++_i) { const int _q = (tid_) + 512 * _i; const int _qq = _q < 62 * 48 ? _q : 0; const int _r = _qq / 48, _c = _qq % 48; \
            const int _rr = (_s0 - 30 + _r >= 0) ? _r : 30; pre[_i] = *(const GAS v4u*)(Z + (size_t)(_t0 - 30 + _rr) * NZ + 768 + _c * 8); } \
        _Pragma("unroll") for (int _i = 0; _i < 3; ++_i) { const int _q = (tid_) + 512 * _i; const int _qq = _q < 47 * 32 ? _q : 0; const int _r = _qq >> 5, _c = _qq & 31; \
            const int _rr = (_s0 - 15 + _r >= 0) ? _r : 15; pre[6 + _i] = *(const GAS v4u*)(Z + (size_t)(_t0 - 15 + _rr) * NZ + 1152 + _c * 8); } } while (0)
    if (F.vcu < T_ / 32) MIX_PREFETCH(F.vcu, tid);
    for (int ci = F.vcu; ci < T_ / 32; ci += F.G) {
        const int t0 = ci * 32, s0 = t0 & (SEQ_ - 1);
#pragma unroll
        for (int i = 0; i < 6; ++i) { const int q = tid + 512 * i; if (q < 62 * 48) { const int r = q / 48, c = q % 48;
            *(LAS v4u*)(BV + r * 192 + c * 4) = (s0 - 30 + r >= 0) ? pre[i] : (v4u){0u, 0u, 0u, 0u}; } }
#pragma unroll
        for (int i = 0; i < 3; ++i) { const int q = tid + 512 * i; if (q < 47 * 32) { const int r = q >> 5, c = q & 31;
            *(LAS v4u*)(PB + r * 128 + c * 4) = (s0 - 15 + r >= 0) ? pre[6 + i] : (v4u){0u, 0u, 0u, 0u}; } }
        __syncthreads();
        { int cn = ci + F.G; asm volatile("" : "+s"(cn)); int tidp = tid; asm volatile("" : "+v"(tidp));
          if (cn < T_ / 32) MIX_PREFETCH(cn, tidp); }
#pragma unroll 1
        for (int prep = 0; prep < ((PROBE_MIX == 1) ? 2 : 1); ++prep)
        if (convt) {
#pragma unroll 1
            for (int hh = 0; hh < 2; ++hh) { const int tb = tg * 16 + hh * 8;
                f32x2 x[38];
#pragma unroll
                for (int i = 0; i < 38; ++i) { const unsigned u = BV[(tb + i) * 192 + cp]; x[i] = (f32x2){bflo(u), bfhi(u)}; }
#pragma unroll
                for (int tt = 0; tt < 8; ++tt) { f32x2 a = bias;
#pragma unroll
                    for (int j = 0; j < 31; ++j) a += w[j] * x[tt + j];
                    *(LAS f32x2*)(V + (tb + tt) * 384 + 2 * cp) = a; }
            }
        } else {
            const int p = tid - 384, g = p >> 5, wd = 2 << g;
            f32x2 s = (f32x2){0.f, 0.f};
            for (int i = 1; i < wd; ++i) { const unsigned u = PB[(15 - i) * 128 + p]; s += (f32x2){bflo(u), bfhi(u)}; }
#pragma unroll 1
            for (int blk = 0; blk < 4; ++blk) {
                unsigned xr[23];
#pragma unroll
                for (int i = 0; i < 23; ++i) xr[i] = PB[(8 * blk + i) * 128 + p];
#pragma unroll
                for (int j = 0; j < 8; ++j) { const int tt = 8 * blk + j; const f32x2 xv = (f32x2){bflo(xr[15 + j]), bfhi(xr[15 + j])};
                    s += xv; const int n = (s0 + tt + 1) < wd ? (s0 + tt + 1) : wd; const float inv = __builtin_amdgcn_rcpf((float)n);
                    const f32x2 dd = s * inv - xv;
                    if (GEMM2_FP8) *(GAS unsigned short*)((unsigned char*)Y + (size_t)(t0 + tt) * D_ + 768 + 2 * p) = (unsigned short)pk4_fp8(dd.x, dd.y, 0.f, 0.f);
                    else *(GAS unsigned*)(Y + (size_t)(t0 + tt) * D_ + 768 + 2 * p) = pk2(dd.x, dd.y);
                    const unsigned u2 = xr[15 + j - 1], u4 = xr[15 + j - 3], u8 = xr[15 + j - 7], u16 = xr[j];
                    const unsigned uo = g == 0 ? u2 : (g == 1 ? u4 : (g == 2 ? u8 : u16));
                    s -= (f32x2){bflo(uo), bfhi(uo)}; }
            }
        }
        __syncthreads();
        v4u ya[3][4];
        int t0o = t0; asm volatile("" : "+s"(t0o));
        int tidl = tid; asm volatile("" : "+v"(tidl));
#pragma unroll
        for (int i = 0; i < 3; ++i) { const int q = tidl + 512 * i, tt = q / 48, o8 = q % 48, pos = (t0o & (SEQ_ - 1)) + tt; const size_t row = (size_t)(t0o + tt);
            ya[i][0] = *(const GAS v4u*)(Z + row * NZ + o8 * 8);
            ya[i][1] = *(const GAS v4u*)(Z + row * NZ + 384 + o8 * 8);
            ya[i][2] = *(const GAS v4u*)(Z + (row - (pos >= 1 ? 1 : 0)) * NZ + 384 + o8 * 8);
            ya[i][3] = *(const GAS v4u*)(Z + (row - (pos >= 2 ? 2 : 0)) * NZ + 384 + o8 * 8); }
#pragma unroll 1
        for (int tk = 0; tk < ((PROBE_MIX == 2) ? 8 : 4); ++tk) { const int tt = wave * 4 + (tk & 3);
            f32x2 v[3]; float s = 0.f;
#pragma unroll
            for (int i = 0; i < 3; ++i) { v[i] = *(const LAS f32x2*)(V + tt * 384 + 2 * lane + 128 * i); s += v[i].x + v[i].y; }
            const float mean = wave_sum(s) * (1.f / 384.f); float q = 0.f;
#pragma unroll
            for (int i = 0; i < 3; ++i) { v[i] = v[i] - mean; q += v[i].x * v[i].x + v[i].y * v[i].y; }
            const float rstd = __builtin_amdgcn_rsqf(wave_sum(q) * (1.f / 384.f) + LN_EPS);
#pragma unroll
            for (int i = 0; i < 3; ++i) { const int c = 2 * lane + 128 * i; const f32x2 gg = *(const f32x2*)(lg + c), bb = *(const f32x2*)(lb + c);
                f32x2 o = v[i] * rstd * gg + bb; o.x = o.x * sigmoidf_(o.x); o.y = o.y * sigmoidf_(o.y);
                if (GEMM2_FP8) *(GAS unsigned short*)((unsigned char*)Y + (size_t)(t0 + tt) * D_ + 384 + c) = (unsigned short)pk4_fp8(o.x, o.y, 0.f, 0.f);
                else *(GAS unsigned*)(Y + (size_t)(t0 + tt) * D_ + 384 + c) = pk2(o.x, o.y); }
        }
#pragma unroll
        for (int i = 0; i < 3; ++i) { const int q = tid + 512 * i, tt = q / 48, o8 = q % 48, pos = s0 + tt; const size_t row = (size_t)(t0 + tt);
            const v4u gb = ya[i][0], x0 = ya[i][1]; v4u x1 = ya[i][2], x2 = ya[i][3];
            if (pos < 1) x1 = (v4u){0u, 0u, 0u, 0u};
            if (pos < 2) x2 = (v4u){0u, 0u, 0u, 0u};
            const f32x4 w2a = *(const f32x4*)(wA + 2 * 384 + o8 * 8), w2b = *(const f32x4*)(wA + 2 * 384 + o8 * 8 + 4);
            const f32x4 w1a = *(const f32x4*)(wA + 1 * 384 + o8 * 8), w1b = *(const f32x4*)(wA + 1 * 384 + o8 * 8 + 4);
            const f32x4 w0a = *(const f32x4*)(wA + o8 * 8), w0b = *(const f32x4*)(wA + o8 * 8 + 4);
            float o[8];
            const unsigned gbw[4] = {gb.x, gb.y, gb.z, gb.w}, x0w[4] = {x0.x, x0.y, x0.z, x0.w}, x1w[4] = {x1.x, x1.y, x1.z, x1.w}, x2w[4] = {x2.x, x2.y, x2.z, x2.w};
            const float w2[8] = {w2a.x, w2a.y, w2a.z, w2a.w, w2b.x, w2b.y, w2b.z, w2b.w}, w1[8] = {w1a.x, w1a.y, w1a.z, w1a.w, w1b.x, w1b.y, w1b.z, w1b.w}, w0[8] = {w0a.x, w0a.y, w0a.z, w0a.w, w0b.x, w0b.y, w0b.z, w0b.w};
#pragma unroll
            for (int e = 0; e < 4; ++e) {
                o[2 * e] = bflo(gbw[e]) * (w2[2 * e] * bflo(x0w[e]) + w1[2 * e] * bflo(x1w[e]) + w0[2 * e] * bflo(x2w[e]));
                o[2 * e + 1] = bfhi(gbw[e]) * (w2[2 * e + 1] * bfhi(x0w[e]) + w1[2 * e + 1] * bfhi(x1w[e]) + w0[2 * e + 1] * bfhi(x2w[e])); }
            if (GEMM2_FP8) { v2u ov; ov.x = pk4_fp8(o[0], o[1], o[2], o[3]); ov.y = pk4_fp8(o[4], o[5], o[6], o[7]); *(GAS v2u*)((unsigned char*)Y + row * D_ + o8 * 8) = ov; }
            else { v4u ov; ov.x = pk2(o[0], o[1]); ov.y = pk2(o[2], o[3]); ov.z = pk2(o[4], o[5]); ov.w = pk2(o[6], o[7]);
            *(GAS v4u*)(Y + row * D_ + o8 * 8) = ov; } }
        __syncthreads();
    }
#undef MIX_PREFETCH
}

__device__ __forceinline__ void top2of4(float q0, float q1, float q2, float q3, float& a1, int& i1, float& a2, int& i2) {
    a1 = q0; i1 = 0; a2 = -1.f; i2 = 1;
#define T2STEP(qv, r) { const bool gt = (qv) > a1; const bool g2 = (qv) > a2; const float na2 = gt ? a1 : (g2 ? (qv) : a2); const int ni2 = gt ? i1 : (g2 ? (r) : i2); \
        a1 = gt ? (qv) : a1; i1 = gt ? (r) : i1; a2 = na2; i2 = ni2; }
    T2STEP(q1, 1) T2STEP(q2, 2) T2STEP(q3, 3)
#undef T2STEP
}
__device__ __forceinline__ void p4_ln_router(Frame& F, const Args& A, int l) {
    LAS unsigned char* lds = F.lds;
    LAS int* cntl = (LAS int*)(lds + 66048); LAS int* basel = cntl + 32; LAS int* sel = cntl + 64; LAS int* lpos = cntl + 64 + 256;
    const bf16* U = (const bf16*)(F.ws + WS_U); bf16* HB = (bf16*)(F.ws + WS_HB); unsigned char* H8 = F.ws + WS_H8; const bf16* WRT = (const bf16*)(F.ws + WS_WRT);
    int* route = (int*)(F.ws + WS_ROUTE); int* lists = (int*)(F.ws + WS_LISTS);
    unsigned* counts = F.ctl + CW_CNT + l * 32 * 64;
    const float* g = A.in[I_LMG] + l * D_; const float* b = A.in[I_LMB] + l * D_; const float* rb = A.in[I_RB];
    int tid = F.tid; asm volatile("" : "+v"(tid));
    const int lane = tid & 63, wave = F.wave, fr = lane & 15, fq = lane >> 4;
    for (int q = tid; q < 32 * 128; q += 512) { const int e = q >> 7, c = q & 127; *(LAS v4u*)(lds + e * 2064 + c * 16) = *(const GAS v4u*)(WRT + e * 1024 + c * 8); }
    if (tid < 32) cntl[tid] = 0;
    f32x4 gv[4], bv[4];
#pragma unroll
    for (int j = 0; j < 4; ++j) { gv[j] = *(const f32x4*)(g + 4 * lane + 256 * j); bv[j] = *(const f32x4*)(b + 4 * lane + 256 * j); }
    __syncthreads();
    for (int blk = F.vcu; blk < T_ / 128; blk += F.G) {
#pragma unroll 1
        for (int i = 0; i < 16; i += 4) { const size_t m = (size_t)(blk * 128 + wave * 16 + i);
            v2u q[4][4];
#pragma unroll
            for (int u = 0; u < 4; ++u) { const GAS v2u* up = (const GAS v2u*)(U + (m + u) * D_) + lane;
#pragma unroll
                for (int j = 0; j < 4; ++j) q[u][j] = up[64 * j]; }
#pragma unroll
            for (int u = 0; u < 4; ++u) { f32x4 v[4]; float s = 0.f;
#pragma unroll
                for (int j = 0; j < 4; ++j) { v[j] = (f32x4){bflo(q[u][j].x), bfhi(q[u][j].x), bflo(q[u][j].y), bfhi(q[u][j].y)}; s += (v[j].x + v[j].y) + (v[j].z + v[j].w); }
                const float mean = wave_sum(s) * (1.f / D_); float s2 = 0.f;
#pragma unroll
                for (int j = 0; j < 4; ++j) { v[j] = v[j] - mean; s2 += (v[j].x * v[j].x + v[j].y * v[j].y) + (v[j].z * v[j].z + v[j].w * v[j].w); }
                const float rstd = __builtin_amdgcn_rsqf(wave_sum(s2) * (1.f / D_) + LN_EPS);
                GAS v2u* o8 = (GAS v2u*)(HB + (m + u) * D_) + lane; GAS unsigned* o4 = (GAS unsigned*)(H8 + (m + u) * D_) + lane;
#pragma unroll
                for (int j = 0; j < 4; ++j) { const f32x4 o = v[j] * rstd * gv[j] + bv[j]; v2u w; w.x = pk2(o.x, o.y); w.y = pk2(o.z, o.w); o8[64 * j] = w; o4[64 * j] = pk4_fp8(o.x, o.y, o.z, o.w); } }
        }
        VM_WAIT(); asm volatile("" ::: "memory");
        const int token = blk * 128 + wave * 16 + fr;
        f32x4 acc0 = (f32x4){0.f, 0.f, 0.f, 0.f}, acc1 = (f32x4){0.f, 0.f, 0.f, 0.f};
        const bf16* hrow = HB + (size_t)token * D_ + fq * 8;
#pragma unroll 16
        for (int k = 0; k < 32; ++k) { const int kk = k * 32 + fq * 8;
            const bf16x8 hf = *(const GAS bf16x8*)(hrow + k * 32);
            const bf16x8 w0 = *(const LAS bf16x8*)(lds + fr * 2064 + kk * 2), w1 = *(const LAS bf16x8*)(lds + (16 + fr) * 2064 + kk * 2);
            acc0 = __builtin_amdgcn_mfma_f32_16x16x32_bf16(w0, hf, acc0, 0, 0, 0);
            acc1 = __builtin_amdgcn_mfma_f32_16x16x32_bf16(w1, hf, acc1, 0, 0, 0);
        }
        float p0[4], p1[4]; float mx = -3.0e38f;
#pragma unroll
        for (int r = 0; r < 4; ++r) { p0[r] = acc0[r] + rb[4 * fq + r]; p1[r] = acc1[r] + rb[16 + 4 * fq + r]; mx = fmaxf(mx, fmaxf(p0[r], p1[r])); }
        mx = fmaxf(mx, __shfl_xor(mx, 16)); mx = fmaxf(mx, __shfl_xor(mx, 32));
#pragma unroll
        for (int r = 0; r < 4; ++r) { p0[r] = __expf(p0[r] - mx); p1[r] = __expf(p1[r] - mx); }
        float a1, a2, c1, c2; int ia1, ia2, ic1, ic2;
        top2of4(p0[0], p0[1], p0[2], p0[3], a1, ia1, a2, ia2); top2of4(p1[0], p1[1], p1[2], p1[3], c1, ic1, c2, ic2);
        const float sc0 = a1 + a2, sc1 = c1 + c2;
        float bs = sc0; int bg = fq; if (sc1 > sc0) { bs = sc1; bg = 4 + fq; }
#pragma unroll
        for (int off = 16; off <= 32; off <<= 1) { const float os = __shfl_xor(bs, off); const int og = __shfl_xor(bg, off); if (os > bs || (os == bs && og < bg)) { bs = os; bg = og; } }
        if ((bg & 3) == fq) {
            const bool hi = bg >= 4;
            const float pa = hi ? c1 : a1, pb = hi ? c2 : a2; const int ia = hi ? ic1 : ia1, ib = hi ? ic2 : ia2;
            const int ea = bg * 4 + ia, eb = bg * 4 + ib; const float inv = 1.0f / (pa + pb);
            const int tokl = wave * 16 + fr;
            const int la = atomicAdd((int*)&cntl[ea], 1), lb2 = atomicAdd((int*)&cntl[eb], 1);
            sel[tokl * 2] = ea; sel[tokl * 2 + 1] = eb; lpos[tokl * 2] = la; lpos[tokl * 2 + 1] = lb2;
            int* rt = route + (size_t)token * 8; rt[0] = ea; rt[2] = eb; rt[4] = __float_as_int(pa * inv); rt[5] = __float_as_int(pb * inv);
        }
        __syncthreads();
        if (tid < 32) { const int c = cntl[tid]; basel[tid] = c ? (int)__hip_atomic_fetch_add(counts + tid * 64, (unsigned)c, RLX_AGENT) : 0; }
        __syncthreads();
        if (tid < 256) { const int tokl = tid >> 1, k = tid & 1, e = sel[tid], pos = basel[e] + lpos[tid], tok = blk * 128 + tokl;
            lists[(size_t)e * 65536 + pos] = tok * 2 + k; route[(size_t)tok * 8 + 1 + 2 * k] = pos; }
        __syncthreads();
        if (tid < 32) cntl[tid] = 0;
        __syncthreads();
    }
}

__device__ __forceinline__ void moe_table(Frame& F, int l) {
    LAS int* tab = (LAS int*)(F.lds + TAB_OFF);
    __syncthreads();
    if (F.tid < 32) tab[40 + F.tid] = (int)__hip_atomic_load(F.ctl + CW_CNT + (l * 32 + F.tid) * 64, RLX_AGENT);
    __syncthreads();
    if (F.tid == 0) { int s = 0; for (int e = 0; e < 32; ++e) { tab[e] = s; s += (tab[40 + e] + 255) >> 8; } tab[32] = s; }
    __syncthreads();
    for (int t = F.tid; t < tab[32]; t += NWAVES * 64) { int e = 0; while (e < 31 && tab[e + 1] <= t) ++e; tab[80 + t] = e; }
    __syncthreads();
}

__device__ __forceinline__ void p7_combine_ln(Frame& F, const Args& A, int l) {
    const LAS int* tab = (const LAS int*)(F.lds + TAB_OFF);
    bf16* HB = (bf16*)(F.ws + WS_HB); const unsigned char* Y2S = F.ws + WS_Y2S; const int* route = (const int*)(F.ws + WS_ROUTE);
    const float* g = A.in[I_LFG] + l * D_; const float* b = A.in[I_LFB] + l * D_;
    int lane = F.lane; asm volatile("" : "+v"(lane));
    const int gw = F.vcu * NWAVES + F.wave, NGW = F.G * NWAVES;
    f32x4 gv[4], bv[4];
#pragma unroll
    for (int j = 0; j < 4; ++j) { gv[j] = *(const f32x4*)(g + 4 * lane + 256 * j); bv[j] = *(const f32x4*)(b + 4 * lane + 256 * j); }
    const bool last = (l == NL - 1);
    const int step = NGW * 2;
    int R[2][6], Rn[2][6];
    v2u hq[2][4], hn[2][4]; unsigned aq[2][4], cq[2][4], an[2][4], cn[2][4];
#define P7_ROUTE(m0_, R_) do { _Pragma("unroll") for (int _u = 0; _u < 2; ++_u) { const int* _rt = route + (size_t)((m0_) + _u) * 8; \
        _Pragma("unroll") for (int _k = 0; _k < 6; ++_k) R_[_u][_k] = _rt[_k]; } } while (0)
#define P7_ROWS(m0_, R_, hq_, aq_, cq_) do { _Pragma("unroll") for (int _u = 0; _u < 2; ++_u) { const int _m = (m0_) + _u; \
        const size_t _r0 = (size_t)tab[R_[_u][0]] * 256 + R_[_u][1], _r1 = (size_t)tab[R_[_u][2]] * 256 + R_[_u][3]; \
        const GAS v2u* _hp = (const GAS v2u*)(HB + (size_t)_m * D_) + lane; const GAS unsigned* _ya = (const GAS unsigned*)(Y2S + _r0 * D_) + lane; const GAS unsigned* _yb = (const GAS unsigned*)(Y2S + _r1 * D_) + lane; \
        _Pragma("unroll") for (int _j = 0; _j < 4; ++_j) { hq_[_u][_j] = _hp[64 * _j]; aq_[_u][_j] = _ya[64 * _j]; cq_[_u][_j] = _yb[64 * _j]; } } } while (0)
    int m0 = gw * 2;
    if (m0 < T_) { P7_ROUTE(m0, R); P7_ROWS(m0, R, hq, aq, cq); if (m0 + step < T_) P7_ROUTE(m0 + step, Rn); }
    for (; m0 < T_; m0 += step) {
        const bool has_n = m0 + step < T_;
        int Rnn[2][6];
        if (has_n) P7_ROWS(m0 + step, Rn, hn, an, cn);
        if (m0 + 2 * step < T_) P7_ROUTE(m0 + 2 * step, Rnn);
#pragma unroll
        for (int u = 0; u < 2; ++u) { const int m = m0 + u; f32x4 v[4]; float s = 0.f; const float g0 = __int_as_float(R[u][4]), g1 = __int_as_float(R[u][5]);
#pragma unroll
            for (int j = 0; j < 4; ++j) { const v2u h = hq[u][j]; const unsigned a = aq[u][j], c = cq[u][j];
                const f32x2 a01 = __builtin_amdgcn_cvt_pk_f32_fp8((int)a, false), a23 = __builtin_amdgcn_cvt_pk_f32_fp8((int)a, true), c01 = __builtin_amdgcn_cvt_pk_f32_fp8((int)c, false), c23 = __builtin_amdgcn_cvt_pk_f32_fp8((int)c, true);
                v[j].x = ALPHA * bflo(h.x) + g0 * a01.x + g1 * c01.x; v[j].y = ALPHA * bfhi(h.x) + g0 * a01.y + g1 * c01.y;
                v[j].z = ALPHA * bflo(h.y) + g0 * a23.x + g1 * c23.x; v[j].w = ALPHA * bfhi(h.y) + g0 * a23.y + g1 * c23.y;
                s += (v[j].x + v[j].y) + (v[j].z + v[j].w); }
            const float mean = wave_sum(s) * (1.f / D_); float s2 = 0.f;
#pragma unroll
            for (int j = 0; j < 4; ++j) { v[j] = v[j] - mean; s2 += (v[j].x * v[j].x + v[j].y * v[j].y) + (v[j].z * v[j].z + v[j].w * v[j].w); }
            const float rstd = __builtin_amdgcn_rsqf(wave_sum(s2) * (1.f / D_) + LN_EPS);
            if (last) { GAS f32x4* o = (GAS f32x4*)(A.out + (size_t)m * D_) + lane;
#pragma unroll
                for (int j = 0; j < 4; ++j) o[64 * j] = v[j] * rstd * gv[j] + bv[j];
            } else { GAS v2u* o8 = (GAS v2u*)(HB + (size_t)m * D_) + lane; float amax = 0.f;
#pragma unroll
                for (int j = 0; j < 4; ++j) { const f32x4 o = v[j] * rstd * gv[j] + bv[j]; v[j] = o; v2u w; w.x = pk2(o.x, o.y); w.y = pk2(o.z, o.w); o8[64 * j] = w;
                    amax = fmaxf(amax, fmaxf(fmaxf(fabsf(o.x), fabsf(o.y)), fmaxf(fabsf(o.z), fabsf(o.w)))); }
                if (GEMM1_I8) { amax = wave_max(amax); const float inv = amax > 0.f ? 127.f / amax : 0.f;
                    GAS unsigned* q4 = (GAS unsigned*)(F.ws + WS_HQ + (size_t)m * D_) + lane;
#pragma unroll
                    for (int j = 0; j < 4; ++j) q4[64 * j] = pk4_i8(v[j].x * inv, v[j].y * inv, v[j].z * inv, v[j].w * inv);
                    if (lane == 0) ((float*)(F.ws + WS_HS))[m] = amax * (1.f / 127.f); } }
        }
#pragma unroll
        for (int u = 0; u < 2; ++u) {
#pragma unroll
            for (int j = 0; j < 4; ++j) { hq[u][j] = hn[u][j]; aq[u][j] = an[u][j]; cq[u][j] = cn[u][j]; }
#pragma unroll
            for (int k = 0; k < 6; ++k) { R[u][k] = Rn[u][k]; Rn[u][k] = Rnn[u][k]; } }
    }
#undef P7_ROUTE
#undef P7_ROWS
}

#ifndef PH_NOINLINE
#define PH_NOINLINE __forceinline__
#endif
PH_NOINLINE __device__ void run_gemm1(LAS unsigned char* lds, unsigned char* ws, int l, int G, int c) {
    pg8::DenseOrder S;
    if (GEMM1_I8) { S.init(ws + WS_HQ, ws + WS_WIN + (size_t)l * N1 * 1024, T_, N1, D_ / 2, G, c, 1);
        pg8::EpiZq E{(bf16*)(ws + WS_Z), (const float*)(ws + WS_HS), (const float*)((unsigned*)(ws + WS_CTL) + CW_CMAX) + l * N1}; pg8::gemm_phase<pg8::EpiZq, pg8::DenseOrder, 2>(lds, S, E); }
    else { S.init(ws + WS_HB, ws + WS_WIN + (size_t)l * N1 * 1024 * 2, T_, N1, D_, G, c, 1); pg8::EpiZ E{(bf16*)(ws + WS_Z)}; pg8::gemm_phase(lds, S, E); }
}
PH_NOINLINE __device__ void run_gemm_probe(LAS unsigned char* lds, unsigned char* ws, int G, int c) {
    pg8::DenseOrder S; S.init(ws + WS_HB, ws + WS_WIN, T_, 256 * (PROBE_EXTRA_NN ? PROBE_EXTRA_NN : 1), D_, G, c);
    pg8::EpiPlain E{(bf16*)(ws + WS_Y), 2048};
    pg8::gemm_phase(lds, S, E);
}
PH_NOINLINE __device__ void run_gemm2(LAS unsigned char* lds, unsigned char* ws, int l, int G, int c) {
    pg8::EpiU E{(const bf16*)(ws + WS_HB), (bf16*)(ws + WS_U)};
    if (GEMM2_FP8) { pg8::DenseRowsOrder S; int kq = D_ / 2; asm volatile("" : "+s"(kq)); S.init(ws + WS_Y, ws + WS_WOUT + (size_t)l * 1024 * 1024, T_, D_, kq, G, c); pg8::gemm_phase<pg8::EpiU, pg8::DenseRowsOrder, true>(lds, S, E); }
    else { pg8::DenseOrder S; S.init(ws + WS_Y, ws + WS_WOUT + (size_t)l * 1024 * 1024 * 2, T_, D_, D_, G, c); pg8::gemm_phase(lds, S, E); }
}
PH_NOINLINE __device__ void run_gemm5(LAS unsigned char* lds, unsigned char* ws, int l, int G, int c) {
    const LAS int* tab = (const LAS int*)(lds + TAB_OFF);
    pg8::MoeGatherOrder S; S.A = (const char*)(ws + WS_H8); S.Bt = (const char*)(ws + WS_WGU + (size_t)l * NE * 1024 * 1024); S.bexp = (size_t)1024 * 1024;
    int kq = D_ / 2; asm volatile("" : "+s"(kq));
    S.K = kq; S.nN = 4; S.nwg = tab[32] * 4; S.G = G; S.c = c; S.tab = tab; S.lists = (const int*)(ws + WS_LISTS);
    pg8::EpiHid E{ws + WS_HID};
    pg8::gemm_phase<pg8::EpiHid, pg8::MoeGatherOrder, true>(lds, S, E);
}
PH_NOINLINE __device__ void run_gemm6(LAS unsigned char* lds, unsigned char* ws, int l, int G, int c) {
    const LAS int* tab = (const LAS int*)(lds + TAB_OFF);
    pg8::MoeRowsOrder S; S.A = (const char*)(ws + WS_HID); S.Bt = (const char*)(ws + WS_WD + (size_t)l * NE * 1024 * 512); S.bexp = (size_t)1024 * 512;
    int kq = DE / 2; asm volatile("" : "+s"(kq));
    S.K = kq; S.nN = 4; S.nwg = tab[32] * 4; S.G = G; S.c = c; S.tab = tab; S.lists = nullptr;
    pg8::EpiPlain8 E{ws + WS_Y2S, D_};
    pg8::gemm_phase<pg8::EpiPlain8, pg8::MoeRowsOrder, true>(lds, S, E);
}

__global__ void __launch_bounds__(NWAVES * 64, 2) mk_fwd(Args args) {
    extern __shared__ __attribute__((aligned(16))) unsigned char lds_raw[];
    Frame F;
    F.lds = (LAS unsigned char*)lds_raw;
    F.tid = threadIdx.x; F.lane = F.tid & 63; F.wave = __builtin_amdgcn_readfirstlane(F.tid >> 6);
    F.G = gridDim.x; { const int bx = blockIdx.x; F.vcu = (F.G % 8 == 0) ? (bx % 8) * (F.G / 8) + bx / 8 : bx; }
    F.ws = args.ws; F.ctl = (unsigned*)(args.ws + WS_CTL);
    for (int u = F.tid; u < (LDS_BYTES - LDSCTL_OFF) / 4; u += NWAVES * 64) ((LAS unsigned*)(F.lds + LDSCTL_OFF))[u] = 0u;
    __syncthreads();
    volatile LAS unsigned* MISC = (volatile LAS unsigned*)(F.lds + MISC_OFF);
    XcdBarrier bar; bar.bar = F.ctl + CW_BAR; bar.x = 0; bar.st = nullptr;
    if (MK_N_LAUNCHES == 1) bar = xcd_barrier_post(F.ctl + CW_BAR, MISC + 8);
    const int lo = args.ph_lo, hi = args.ph_hi;
#define IN(k) (lo <= (k) && (k) < hi)
#define SEAM(k) do { if (MK_N_LAUNCHES == 1 && (k) + 1 < hi) xcd_barrier(bar); } while (0)
    if (REPEAT_MASK & 256) { for (int rep = 0; rep < 10; ++rep) xcd_barrier(bar); }
    if ((PH_MASK & 1) && IN(0)) { for (int rep = 0; rep < ((REPEAT_MASK & 1) ? 2 : 1); ++rep) { p0_prologue(F, args); SEAM(0); } }
#pragma unroll 1
    for (int l = 0; l < NL; ++l) {
        const int pb = 1 + 7 * l;
        if ((PH_MASK & 2) && IN(pb + 0)) { for (int rep = 0; rep < ((REPEAT_MASK & 2) ? 2 : 1); ++rep) { run_gemm1(F.lds, F.ws, l, F.G, (int)blockIdx.x); SEAM(pb + 0); }
            if (PROBE_EXTRA_NN && l == 0) { run_gemm_probe(F.lds, F.ws, F.G, (int)blockIdx.x); xcd_barrier(bar); } }
        if ((PH_MASK & 4) && IN(pb + 1)) { for (int rep = 0; rep < ((REPEAT_MASK & 4) ? 2 : 1); ++rep) { p2_mixer(F, args, l); SEAM(pb + 1); } }
        if ((PH_MASK & 8) && IN(pb + 2)) { for (int rep = 0; rep < ((REPEAT_MASK & 8) ? 2 : 1); ++rep) { run_gemm2(F.lds, F.ws, l, F.G, (int)blockIdx.x); SEAM(pb + 2); } }
        if ((PH_MASK & 16) && IN(pb + 3)) {
            if (REPEAT_MASK & 16) { p4_ln_router(F, args, l); SEAM(pb + 3);
                if (blockIdx.x == 0 && F.tid < 32) __hip_atomic_store(F.ctl + CW_CNT + (l * 32 + F.tid) * 64, 0u, RLX_AGENT);
                SEAM(pb + 3); }
            p4_ln_router(F, args, l); SEAM(pb + 3); }
        if ((PH_MASK & 32) && IN(pb + 4)) { for (int rep = 0; rep < ((REPEAT_MASK & 32) ? 2 : 1); ++rep) { moe_table(F, l); run_gemm5(F.lds, F.ws, l, F.G, (int)blockIdx.x); SEAM(pb + 4); } }
        if ((PH_MASK & 64) && IN(pb + 5)) { for (int rep = 0; rep < ((REPEAT_MASK & 64) ? 2 : 1); ++rep) { if (MK_N_LAUNCHES != 1 || rep) moe_table(F, l); run_gemm6(F.lds, F.ws, l, F.G, (int)blockIdx.x); SEAM(pb + 5); } }
        if ((PH_MASK & 128) && IN(pb + 6)) { for (int rep = 0; rep < (((REPEAT_MASK & 128) && l == NL - 1) ? 2 : 1); ++rep) { if (MK_N_LAUNCHES != 1) moe_table(F, l); p7_combine_ln(F, args, l); if (rep == 0) SEAM(pb + 6); else xcd_barrier(bar); } }
    }
#undef IN
#undef SEAM
}

extern "C" void kernel_launch(void* const* d_in, const int* in_sizes, int n_in, void* d_out, int out_size, void* d_ws, size_t ws_size, hipStream_t stream) {
    static int grid = 0;
    if (grid == 0) {
        if (n_in != 21 || out_size != T_ * D_ || ws_size < WS_END) { fprintf(stderr, "kernel_launch: unexpected problem (n_in %d, out %d, ws %zu); nothing launched\n", n_in, out_size, ws_size); grid = -1; return; }
        int dev = 0, cus = 0, per_cu = 0;
        if (hipGetDevice(&dev) != hipSuccess || hipDeviceGetAttribute(&cus, hipDeviceAttributeMultiprocessorCount, dev) != hipSuccess) { grid = -1; return; }
        if (hipFuncSetAttribute((const void*)mk_fwd, hipFuncAttributeMaxDynamicSharedMemorySize, LDS_BYTES) != hipSuccess) { fprintf(stderr, "kernel_launch: hipFuncSetAttribute failed\n"); grid = -1; return; }
        if (hipOccupancyMaxActiveBlocksPerMultiprocessor(&per_cu, (const void*)mk_fwd, NWAVES * 64, LDS_BYTES) != hipSuccess || per_cu < 1) { fprintf(stderr, "kernel_launch: occupancy query says %d\n", per_cu); }
        (void)hipGetLastError();
        grid = cus;
    }
    if (grid < 0) return;
    (void)hipMemsetAsync((char*)d_ws + WS_CTL, 0, CTL_ZERO_BYTES, stream);
    Args a{};
    for (int i = 0; i < 21; ++i) a.in[i] = (const float*)d_in[i];
    a.out = (float*)d_out; a.ws = (unsigned char*)d_ws;
    if (MK_N_LAUNCHES == 1) { a.ph_lo = 0; a.ph_hi = NPH; hipLaunchKernelGGL(mk_fwd, dim3(grid), dim3(NWAVES * 64), LDS_BYTES, stream, a); }
    else for (int p = 0; p < NPH; ++p) { a.ph_lo = p; a.ph_hi = p + 1; hipLaunchKernelGGL(mk_fwd, dim3(grid), dim3(NWAVES * 64), LDS_BYTES, stream, a); }
}
```

```cpp
#include <hip/hip_runtime.h>
#include <cstdio>
#include <cstdint>

#ifndef MK_N_LAUNCHES
#define MK_N_LAUNCHES 1
#endif
#ifndef PH_MASK
#define PH_MASK 0xff
#endif
#ifndef REPEAT_MASK
#define REPEAT_MASK 0
#endif
#ifndef GEMM1_I8
#define GEMM1_I8 1
#endif
#ifndef GEMM2_FP8
#define GEMM2_FP8 1
#endif
#ifndef PROBE_P0
#define PROBE_P0 0
#endif
#ifndef PROBE_MIX
#define PROBE_MIX 0
#endif
#ifndef PROBE_EXTRA_NN
#define PROBE_EXTRA_NN 0
#endif
#ifndef GEMM_SIMPLE_MASK
#define GEMM_SIMPLE_MASK 0
#endif

#define GAS __attribute__((address_space(1)))
#define LAS __attribute__((address_space(3)))
typedef unsigned short bf16;
typedef unsigned v4u __attribute__((ext_vector_type(4)));
typedef unsigned v2u __attribute__((ext_vector_type(2)));
typedef float f32x4 __attribute__((ext_vector_type(4)));
typedef float f32x2 __attribute__((ext_vector_type(2)));
typedef short bf16x8 __attribute__((ext_vector_type(8)));
#define RLX_AGENT __ATOMIC_RELAXED, __HIP_MEMORY_SCOPE_AGENT
#define LDS_WAIT() asm volatile("s_waitcnt lgkmcnt(0)" ::: "memory")
#define VM_WAIT() asm volatile("s_waitcnt vmcnt(0)" ::: "memory")

constexpr int T_ = 32768, D_ = 1024, SEQ_ = 4096, NL = 2, NE = 32, DE = 512;
constexpr int DIN = 2176, N1 = 2304, NZ = 1408;
constexpr float ALPHA = 1.41421356237f, LN_EPS = 1e-5f;
constexpr int NPH = 1 + 7 * NL;

constexpr size_t MiB = 1u << 20;
constexpr size_t WS_CTL = 0, CTL_ZERO_BYTES = 128 * 1024;
constexpr size_t WS_ROUTE = 1 * MiB;
constexpr size_t WS_WRT = 2 * MiB;
constexpr size_t WS_HS = 2 * MiB + 256 * 1024;
constexpr size_t WS_CS = 2 * MiB + 512 * 1024;
constexpr size_t WS_LISTS = 3 * MiB;
constexpr size_t WS_WIN = 11 * MiB;
constexpr size_t WS_WOUT = 20 * MiB;
constexpr size_t WS_WGU = 24 * MiB;
constexpr size_t WS_H8 = 88 * MiB;
constexpr size_t WS_HQ = 120 * MiB;
constexpr size_t WS_WD = 152 * MiB;
constexpr size_t WS_HB = 216 * MiB;
constexpr size_t WS_Z = 280 * MiB;
constexpr size_t WS_Y = 368 * MiB;
constexpr size_t WS_U = 280 * MiB;
constexpr size_t WS_HID = 280 * MiB;
constexpr size_t WS_Y2S = 352 * MiB;
constexpr size_t WS_END = 496 * MiB;
constexpr int CW_TMO = 0, CW_BAR = 4096, CW_CNT = 16384, CW_CMAX = 20480  , CW_CMAXCNT = 25600;

constexpr int RING_BYTES = 131072, LDSCTL_OFF = RING_BYTES, MISC_OFF = LDSCTL_OFF + 320, TAB_OFF = LDSCTL_OFF + 1024;
constexpr int LDS_BYTES = 147456;

__device__ __forceinline__ unsigned f2bf(float f) { unsigned u = __builtin_bit_cast(unsigned, f); return (u + 0x7fffu + ((u >> 16) & 1u)) >> 16; }
__device__ __forceinline__ unsigned pk2(float lo, float hi) { unsigned r; asm("v_cvt_pk_bf16_f32 %0, %1, %2" : "=v"(r) : "v"(lo), "v"(hi)); return r; }
__device__ __forceinline__ float bflo(unsigned u) { return __builtin_bit_cast(float, u << 16); }
__device__ __forceinline__ float bfhi(unsigned u) { return __builtin_bit_cast(float, u & 0xffff0000u); }
template <int CTRL> __device__ __forceinline__ float dpp_mov(float v) { return __builtin_bit_cast(float, __builtin_amdgcn_update_dpp(0, __builtin_bit_cast(int, v), CTRL, 0xf, 0xf, false)); }
__device__ __forceinline__ float wave_sum(float v) {
    v += dpp_mov<0xB1>(v); v += dpp_mov<0x4E>(v); v += dpp_mov<0x141>(v); v += dpp_mov<0x140>(v);
    const int iv = __builtin_bit_cast(int, v);
    return (__builtin_bit_cast(float, __builtin_amdgcn_readlane(iv, 0)) + __builtin_bit_cast(float, __builtin_amdgcn_readlane(iv, 16))) +
           (__builtin_bit_cast(float, __builtin_amdgcn_readlane(iv, 32)) + __builtin_bit_cast(float, __builtin_amdgcn_readlane(iv, 48)));
}
__device__ __forceinline__ float wave_max(float v) {
    v = fmaxf(v, dpp_mov<0xB1>(v)); v = fmaxf(v, dpp_mov<0x4E>(v)); v = fmaxf(v, dpp_mov<0x141>(v)); v = fmaxf(v, dpp_mov<0x140>(v));
    const int iv = __builtin_bit_cast(int, v);
    return fmaxf(fmaxf(__builtin_bit_cast(float, __builtin_amdgcn_readlane(iv, 0)), __builtin_bit_cast(float, __builtin_amdgcn_readlane(iv, 16))),
                 fmaxf(__builtin_bit_cast(float, __builtin_amdgcn_readlane(iv, 32)), __builtin_bit_cast(float, __builtin_amdgcn_readlane(iv, 48))));
}
__device__ __forceinline__ unsigned pk4_i8(float a, float b, float c, float d) {
    const int ia = (int)__builtin_rintf(a), ib = (int)__builtin_rintf(b), ic = (int)__builtin_rintf(c), id = (int)__builtin_rintf(d);
    return ((unsigned)ia & 0xffu) | (((unsigned)ib & 0xffu) << 8) | (((unsigned)ic & 0xffu) << 16) | ((unsigned)id << 24); }
__device__ __forceinline__ unsigned pk4_fp8(float a, float b, float c, float d) {
    int v = 0; v = __builtin_amdgcn_cvt_pk_fp8_f32(a, b, v, false); v = __builtin_amdgcn_cvt_pk_fp8_f32(c, d, v, true); return (unsigned)v; }
__device__ __forceinline__ float sigmoidf_(float x) { return __builtin_amdgcn_rcpf(1.0f + __expf(-x)); }

namespace pg8 {
#define PG8_LAS __attribute__((address_space(3)))
typedef int v8i __attribute__((ext_vector_type(8)));
typedef int v4i __attribute__((ext_vector_type(4)));
constexpr int BM = 256, BK = 64, HALF = 128, HTB = HALF * BK * 2, STAGE_BYTES = 8 * HTB, NXCD = 8, WGM = 8;
__host__ __device__ __forceinline__ int lds_byte(int r, int c) { const int st = (r >> 4) * 2 + (c >> 5), rr = r & 15, cc = c & 31, ob = rr * 64 + cc * 2; return st * 1024 + (ob ^ (((ob >> 9) & 1) << 5)); }
__host__ __device__ __forceinline__ void stage_rc(int b, int& R, int& C) { const int st = b / 1024, sb = b % 1024, swz = sb ^ (((sb >> 9) & 1) << 5); R = (st >> 1) * 16 + swz / 64; C = (st & 1) * 32 + (swz % 64) / 2; }
__host__ __device__ __forceinline__ int perm32(int rho) { const int n = rho >> 4, i = rho & 15; return 8 * (i >> 2) + 4 * n + (i & 3); }

struct Unit { int pm, pn, e, j, rh; };

__device__ __forceinline__ int xcd_remap(int wgid, int nwg) { const int q = nwg / NXCD, r = nwg % NXCD, xcd = wgid % NXCD, off = wgid / NXCD; return (xcd < r ? xcd * (q + 1) : r * (q + 1) + (xcd - r) * q) + off; }

struct DenseOrder {
    static constexpr bool GATHER = false, HAS_HALF = true, HAS_RH = false;
    const char* A; const char* Bt; int K, nM, nN, nwg, G, c, nhalf;
    __device__ void init(const void* A_, const void* Bt_, int M, int N, int K_, int G_, int c_, int half_tile = 0) { A = (const char*)A_; Bt = (const char*)Bt_; K = K_; nM = M / BM; nN = N / BM - half_tile; nwg = nM * nN; G = G_; c = c_; nhalf = half_tile ? nM : 0; }
    __device__ bool next(int i, Unit& u) const {
        const long L = (long)i * G + c; if (L >= nwg + nhalf) return false;
        u.e = 0; u.j = 0; u.rh = -1;
        if (L >= nwg) { u.pm = (int)(L - nwg); u.pn = nN; return true; }
        const int wgid = xcd_remap((int)L, nwg);
        const int nig = WGM * nN, gid = wgid / nig, fm = gid * WGM, gsz = (nM - fm) < WGM ? (nM - fm) : WGM;
        u.pm = fm + ((wgid % nig) % gsz); u.pn = (wgid % nig) / gsz; return true;
    }
    __device__ __forceinline__ bool is_half(const Unit& u) const { return u.pn >= nN; }
    __device__ __forceinline__ int row_half(const Unit&) const { return -1; }
    __device__ __forceinline__ const char* a_tile(const Unit& u) const { return A + (size_t)u.pm * BM * K * 2; }
    __device__ __forceinline__ const char* b_tile(const Unit& u) const { return Bt + (size_t)u.pn * BM * K * 2; }
    __device__ __forceinline__ unsigned a_row_off(const Unit&, int r) const { return (unsigned)(r * K * 2); }
};
struct DenseRowsOrder : DenseOrder {
    static constexpr bool GATHER = true, HAS_HALF = false;
    __device__ __forceinline__ const char* a_tile(const Unit&) const { return A; }
    __device__ __forceinline__ unsigned a_row_off(const Unit& u, int r) const { return (unsigned)(u.pm * BM + r) * (unsigned)(K * 2); }
};
struct MoeOrder {
    static constexpr bool HAS_HALF = false, HAS_RH = true;
    __device__ __forceinline__ bool is_half(const Unit&) const { return false; }
    const char* A; const char* Bt; size_t bexp; int K, nN, nwg, G, c; const PG8_LAS int* tab; const int* lists;
    __device__ bool next(int i, Unit& u) const {
        const int L = i * G + c, nfull = (nwg / G) * G, rem = nwg - nfull;
        int uidx = L; u.rh = -1;
        if (L >= nfull) { if (2 * rem <= G) { if (L >= nfull + 2 * rem) return false; uidx = nfull + ((L - nfull) >> 1); u.rh = (L - nfull) & 1; } else if (L >= nwg) return false; }
        const int wgid = xcd_remap(uidx, nwg);
        const int t = wgid / nN; u.pn = wgid % nN; u.pm = t;
        const int e = tab[80 + t];
        u.e = e; u.j = t - tab[e]; return true;
    }
    __device__ __forceinline__ int row_half(const Unit& u) const { return u.rh; }
    __device__ __forceinline__ const char* b_tile(const Unit& u) const { return Bt + (size_t)u.e * bexp + (size_t)u.pn * BM * K * 2; }
};
struct MoeGatherOrder : MoeOrder {
    static constexpr bool GATHER = true;
    __device__ __forceinline__ const char* a_tile(const Unit&) const { return A; }
    __device__ __forceinline__ unsigned a_row_off(const Unit& u, int r) const {
        const int idx = u.j * BM + r, cnt = tab[40 + u.e];
        const int ii = idx < cnt ? idx : cnt - 1;
        const int tok = lists[(size_t)u.e * 65536 + ii] >> 1;
        return (unsigned)tok * (unsigned)(K * 2);
    }
};
struct MoeRowsOrder : MoeOrder {
    static constexpr bool GATHER = true;
    __device__ __forceinline__ const char* a_tile(const Unit&) const { return A; }
    __device__ __forceinline__ unsigned a_row_off(const Unit& u, int r) const { return (unsigned)(u.pm * BM + r) * (unsigned)(K * 2); }
};
struct MoeDenseOrder : MoeOrder {
    static constexpr bool GATHER = false;
    __device__ __forceinline__ const char* a_tile(const Unit& u) const { return A + (size_t)u.pm * BM * K * 2; }
    __device__ __forceinline__ unsigned a_row_off(const Unit&, int r) const { return (unsigned)(r * K * 2); }
};

__device__ __forceinline__ unsigned cvt_pk_bf16(float lo, float hi) { unsigned r; asm volatile("v_cvt_pk_bf16_f32 %0, %1, %2" : "=v"(r) : "v"(lo), "v"(hi)); return r; }

struct EpiZ {
    static constexpr bool PERM = true;
    bf16* Z;
    __device__ __forceinline__ void operator()(const f32x4 (&acc)[2][2][4][2], const Unit& u, int wr, int wc, int fr, int fq) const {
        const int row0 = u.pm * BM + wr * 64 + fr, cl = wc * 32 + 8 * fq;
        if (u.pn < 6) {
            const bool sg = u.pn >= 3;
            const int zc = (sg ? 768 + (u.pn - 3) * 128 : 384 + u.pn * 128) + cl;
#pragma unroll
            for (int ai = 0; ai < 2; ++ai)
#pragma unroll
                for (int m = 0; m < 4; ++m) {
                    f32x4 a0 = acc[ai][0][m][0], a1 = acc[ai][0][m][1], g0 = acc[ai][1][m][0], g1 = acc[ai][1][m][1];
                    if (sg) {
#pragma unroll
                        for (int q = 0; q < 4; ++q) { g0[q] = sigmoidf_(g0[q]); g1[q] = sigmoidf_(g1[q]); }
                    }
                    a0 = a0 * g0; a1 = a1 * g1;
                    v4u w; w.x = cvt_pk_bf16(a0[0], a0[1]); w.y = cvt_pk_bf16(a0[2], a0[3]); w.z = cvt_pk_bf16(a1[0], a1[1]); w.w = cvt_pk_bf16(a1[2], a1[3]);
                    *(v4u*)(Z + (size_t)(row0 + ai * HALF + m * 16) * NZ + zc) = w;
                }
        } else {
            int zb0, zb1;
            if (u.pn == 6) { zb0 = 0; zb1 = 128; } else if (u.pn == 7) { zb0 = 256; zb1 = 1152; } else { zb0 = 1280; zb1 = -1; }
#pragma unroll
            for (int ai = 0; ai < 2; ++ai)
#pragma unroll
                for (int m = 0; m < 4; ++m) {
                    bf16* rowp = Z + (size_t)(row0 + ai * HALF + m * 16) * NZ + cl;
#pragma unroll
                    for (int bj = 0; bj < 2; ++bj) {
                        const int zb = bj ? zb1 : zb0;
                        if (zb >= 0) { const f32x4 a0 = acc[ai][bj][m][0], a1 = acc[ai][bj][m][1];
                            v4u w; w.x = cvt_pk_bf16(a0[0], a0[1]); w.y = cvt_pk_bf16(a0[2], a0[3]); w.z = cvt_pk_bf16(a1[0], a1[1]); w.w = cvt_pk_bf16(a1[2], a1[3]);
                            *(v4u*)(rowp + zb) = w; }
                    }
                }
        }
    }
};
struct EpiZq {
    static constexpr bool PERM = true;
    bf16* Z; const float* hs; const float* cs;
    __device__ __forceinline__ void operator()(f32x4 (&acc)[2][2][4][2], const Unit& u, int wr, int wc, int fr, int fq) const {
        const int row0 = u.pm * BM + wr * 64 + fr, cl = wc * 32 + 8 * fq;
        {
            float rs[2][4]; f32x4 cv[2][2];
#pragma unroll
            for (int ai = 0; ai < 2; ++ai)
#pragma unroll
                for (int m = 0; m < 4; ++m) rs[ai][m] = hs[row0 + ai * HALF + m * 16];
#pragma unroll
            for (int bj = 0; bj < 2; ++bj)
#pragma unroll
                for (int n = 0; n < 2; ++n) cv[bj][n] = *(const f32x4*)(cs + u.pn * BM + bj * HALF + cl + 4 * n) * (1.f / 127.f);
#pragma unroll
            for (int ai = 0; ai < 2; ++ai)
#pragma unroll
                for (int bj = 0; bj < 2; ++bj)
#pragma unroll
                    for (int m = 0; m < 4; ++m)
#pragma unroll
                        for (int n = 0; n < 2; ++n) { const v4i q = __builtin_bit_cast(v4i, acc[ai][bj][m][n]);
                            acc[ai][bj][m][n] = (f32x4){(float)q.x, (float)q.y, (float)q.z, (float)q.w} * rs[ai][m] * cv[bj][n]; }
        }
        if (u.pn < 6) {
            const bool sg = u.pn >= 3;
            const int zc = (sg ? 768 + (u.pn - 3) * 128 : 384 + u.pn * 128) + cl;
#pragma unroll
            for (int ai = 0; ai < 2; ++ai)
#pragma unroll
                for (int m = 0; m < 4; ++m) {
                    f32x4 a0 = acc[ai][0][m][0], a1 = acc[ai][0][m][1], g0 = acc[ai][1][m][0], g1 = acc[ai][1][m][1];
                    if (sg) {
#pragma unroll
                        for (int q = 0; q < 4; ++q) { g0[q] = sigmoidf_(g0[q]); g1[q] = sigmoidf_(g1[q]); }
                    }
                    a0 = a0 * g0; a1 = a1 * g1;
                    v4u w; w.x = cvt_pk_bf16(a0[0], a0[1]); w.y = cvt_pk_bf16(a0[2], a0[3]); w.z = cvt_pk_bf16(a1[0], a1[1]); w.w = cvt_pk_bf16(a1[2], a1[3]);
                    *(v4u*)(Z + (size_t)(row0 + ai * HALF + m * 16) * NZ + zc) = w;
                }
        } else {
            int zb0, zb1;
            if (u.pn == 6) { zb0 = 0; zb1 = 128; } else if (u.pn == 7) { zb0 = 256; zb1 = 1152; } else { zb0 = 1280; zb1 = -1; }
#pragma unroll
            for (int ai = 0; ai < 2; ++ai)
#pragma unroll
                for (int m = 0; m < 4; ++m) {
                    bf16* rowp = Z + (size_t)(row0 + ai * HALF + m * 16) * NZ + cl;
#pragma unroll
                    for (int bj = 0; bj < 2; ++bj) {
                        const int zb = bj ? zb1 : zb0;
                        if (zb >= 0) { const f32x4 a0 = acc[ai][bj][m][0], a1 = acc[ai][bj][m][1];
                            v4u w; w.x = cvt_pk_bf16(a0[0], a0[1]); w.y = cvt_pk_bf16(a0[2], a0[3]); w.z = cvt_pk_bf16(a1[0], a1[1]); w.w = cvt_pk_bf16(a1[2], a1[3]);
                            *(v4u*)(rowp + zb) = w; }
                    }
                }
        }
    }
};
struct EpiU {
    static constexpr bool PERM = true;
    const bf16* H; bf16* U;
    __device__ __forceinline__ void operator()(const f32x4 (&acc)[2][2][4][2], const Unit& u, int wr, int wc, int fr, int fq) const {
        const int row0 = u.pm * BM + wr * 64 + fr, col0 = u.pn * BM + wc * 32 + 8 * fq;
        v4u hh[2][4][2];
#pragma unroll
        for (int ai = 0; ai < 2; ++ai)
#pragma unroll
            for (int m = 0; m < 4; ++m)
#pragma unroll
                for (int bj = 0; bj < 2; ++bj) hh[ai][m][bj] = *(const v4u*)(H + (size_t)(row0 + ai * HALF + m * 16) * D_ + col0 + bj * HALF);
#pragma unroll
        for (int ai = 0; ai < 2; ++ai)
#pragma unroll
            for (int m = 0; m < 4; ++m) {
                const size_t off = (size_t)(row0 + ai * HALF + m * 16) * D_ + col0;
#pragma unroll
                for (int bj = 0; bj < 2; ++bj) {
                    const v4u h = hh[ai][m][bj];
                    const f32x4 a0 = acc[ai][bj][m][0], a1 = acc[ai][bj][m][1];
                    v4u w;
                    w.x = cvt_pk_bf16(ALPHA * bflo(h.x) + a0[0], ALPHA * bfhi(h.x) + a0[1]); w.y = cvt_pk_bf16(ALPHA * bflo(h.y) + a0[2], ALPHA * bfhi(h.y) + a0[3]);
                    w.z = cvt_pk_bf16(ALPHA * bflo(h.z) + a1[0], ALPHA * bfhi(h.z) + a1[1]); w.w = cvt_pk_bf16(ALPHA * bflo(h.w) + a1[2], ALPHA * bfhi(h.w) + a1[3]);
                    *(v4u*)(U + off + bj * HALF) = w;
                }
            }
    }
};
struct EpiHid {
    static constexpr bool PERM = true;
    unsigned char* HID;
    __device__ __forceinline__ void operator()(const f32x4 (&acc)[2][2][4][2], const Unit& u, int wr, int wc, int fr, int fq) const {
        const int row0 = u.pm * BM + wr * 64 + fr, col0 = u.pn * 128 + wc * 32 + 8 * fq;
#pragma unroll
        for (int ai = 0; ai < 2; ++ai) { if (u.rh >= 0 && u.rh != ai) continue;
#pragma unroll
            for (int m = 0; m < 4; ++m) {
                f32x4 g0 = acc[ai][0][m][0], g1 = acc[ai][0][m][1]; const f32x4 u0 = acc[ai][1][m][0], u1 = acc[ai][1][m][1];
#pragma unroll
                for (int q = 0; q < 4; ++q) { g0[q] = g0[q] * sigmoidf_(g0[q]); g1[q] = g1[q] * sigmoidf_(g1[q]); }
                g0 = g0 * u0; g1 = g1 * u1;
                v2u w; w.x = pk4_fp8(g0[0], g0[1], g0[2], g0[3]); w.y = pk4_fp8(g1[0], g1[1], g1[2], g1[3]);
                *(v2u*)(HID + (size_t)(row0 + ai * HALF + m * 16) * DE + col0) = w;
            } }
    }
};
struct EpiPlain8 {
    static constexpr bool PERM = true;
    unsigned char* O; int ldc;
    __device__ __forceinline__ void operator()(const f32x4 (&acc)[2][2][4][2], const Unit& u, int wr, int wc, int fr, int fq) const {
        const int row0 = u.pm * BM + wr * 64 + fr, col0 = u.pn * BM + wc * 32 + 8 * fq;
#pragma unroll
        for (int ai = 0; ai < 2; ++ai) { if (u.rh >= 0 && u.rh != ai) continue;
#pragma unroll
            for (int m = 0; m < 4; ++m) {
                unsigned char* rowp = O + (size_t)(row0 + ai * HALF + m * 16) * ldc + col0;
#pragma unroll
                for (int bj = 0; bj < 2; ++bj) { const f32x4 a0 = acc[ai][bj][m][0], a1 = acc[ai][bj][m][1];
                    v2u w; w.x = pk4_fp8(a0[0], a0[1], a0[2], a0[3]); w.y = pk4_fp8(a1[0], a1[1], a1[2], a1[3]);
                    *(v2u*)(rowp + bj * HALF) = w; }
            } }
    }
};
struct EpiPlain {
    static constexpr bool PERM = true;
    bf16* O; int ldc;
    __device__ __forceinline__ void operator()(const f32x4 (&acc)[2][2][4][2], const Unit& u, int wr, int wc, int fr, int fq) const {
        const int row0 = u.pm * BM + wr * 64 + fr, col0 = u.pn * BM + wc * 32 + 8 * fq;
#pragma unroll
        for (int ai = 0; ai < 2; ++ai)
#pragma unroll
            for (int m = 0; m < 4; ++m) {
                bf16* rowp = O + (size_t)(row0 + ai * HALF + m * 16) * ldc + col0;
#pragma unroll
                for (int bj = 0; bj < 2; ++bj) { const f32x4 a0 = acc[ai][bj][m][0], a1 = acc[ai][bj][m][1];
                    v4u w; w.x = cvt_pk_bf16(a0[0], a0[1]); w.y = cvt_pk_bf16(a0[2], a0[3]); w.z = cvt_pk_bf16(a1[0], a1[1]); w.w = cvt_pk_bf16(a1[2], a1[3]);
                    *(v4u*)(rowp + bj * HALF) = w; }
            }
    }
};

template <class Epi, class Sched>
__device__ __forceinline__ void gemm_phase_simple(const Sched& S, const Epi& E) {
    int tid = threadIdx.x; asm volatile("" : "+v"(tid));
    const int wid = __builtin_amdgcn_readfirstlane(tid >> 6), lane = tid & 63, wr = wid >> 2, wc = wid & 3, fr = lane & 15, fq = lane >> 4;
    const int K = S.K;
    Unit cur;
    for (int ui = 0; S.next(ui, cur); ++ui) {
        f32x4 acc[2][2][4][2];
#pragma unroll
        for (int a = 0; a < 2; ++a)
#pragma unroll
            for (int b = 0; b < 2; ++b)
#pragma unroll
                for (int m = 0; m < 4; ++m)
#pragma unroll
                    for (int n = 0; n < 2; ++n) acc[a][b][m][n] = (f32x4){0.f, 0.f, 0.f, 0.f};
        const char* at = S.a_tile(cur); const char* bt = S.b_tile(cur);
        const char* ap[2][4]; const char* bp[2][2];
#pragma unroll
        for (int ai = 0; ai < 2; ++ai)
#pragma unroll
            for (int m = 0; m < 4; ++m) ap[ai][m] = at + S.a_row_off(cur, ai * HALF + wr * 64 + m * 16 + fr) + fq * 16;
#pragma unroll
        for (int bj = 0; bj < 2; ++bj)
#pragma unroll
            for (int n = 0; n < 2; ++n) { const int rho = n * 16 + fr; bp[bj][n] = bt + (size_t)(bj * HALF + wc * 32 + (Epi::PERM ? perm32(rho) : rho)) * K * 2 + fq * 16; }
        for (int k0 = 0; k0 < K; k0 += 32) {
            bf16x8 a[2][4], b[2][2];
#pragma unroll
            for (int ai = 0; ai < 2; ++ai)
#pragma unroll
                for (int m = 0; m < 4; ++m) a[ai][m] = *(const bf16x8*)(ap[ai][m] + k0 * 2);
#pragma unroll
            for (int bj = 0; bj < 2; ++bj)
#pragma unroll
                for (int n = 0; n < 2; ++n) b[bj][n] = *(const bf16x8*)(bp[bj][n] + k0 * 2);
#pragma unroll
            for (int ai = 0; ai < 2; ++ai)
#pragma unroll
                for (int bj = 0; bj < 2; ++bj)
#pragma unroll
                    for (int m = 0; m < 4; ++m)
#pragma unroll
                        for (int n = 0; n < 2; ++n) acc[ai][bj][m][n] = __builtin_amdgcn_mfma_f32_16x16x32_bf16(b[bj][n], a[ai][m], acc[ai][bj][m][n], 0, 0, 0);
        }
        E(acc, cur, wr, wc, fr, fq);
    }
}

template <int OFF> __device__ __forceinline__ void glds16(const char* base, unsigned voff, unsigned lds_base) {
    asm volatile("s_add_u32 m0, %2, %3\n\ts_nop 0\n\tglobal_load_lds_dwordx4 %0, %1" :: "v"(voff), "s"(base), "s"(lds_base), "n"(OFF) : "memory", "m0", "scc");
}
template <class Epi, class Sched, int MODE = 0  >
__device__ __forceinline__ void gemm_phase(PG8_LAS unsigned char* lds, const Sched& S, const Epi& E) {
    constexpr bool GATHER = Sched::GATHER;
    int tid = threadIdx.x; asm volatile("" : "+v"(tid));
    const int wid = __builtin_amdgcn_readfirstlane(tid >> 6), lane = tid & 63, wr = wid >> 2, wc = wid & 3, fr = lane & 15, fq = lane >> 4;
    const int K = S.K, nt = K / BK;
    unsigned voffB[2], offA[4], nxA[4];
#pragma unroll
    for (int i = 0; i < 2; ++i) { int R, C; stage_rc(tid * 16 + i * 8192, R, C); const int Rb = Epi::PERM ? ((R & ~31) + perm32(R & 31)) : R;
        voffB[i] = (unsigned)(Rb * K + C) * 2u; offA[i] = (unsigned)(R * K + C) * 2u; offA[2 + i] = (unsigned)((R + HALF) * K + C) * 2u; nxA[i] = 0u; nxA[2 + i] = 0u; }
    const size_t kstep = (size_t)(BK * 2);
    const size_t hstep = (size_t)HALF * K * 2;
    const unsigned ldsw = (unsigned)wid * 1024u;
    const unsigned ldsbw = (unsigned)(size_t)lds + ldsw;
    const int aoff = lds_byte(wr * 64 + fr, fq * 8), boff = lds_byte(wc * 32 + fr, fq * 8);
#define PG8_SA(b, h) (((b) * 2 + (h)) * HTB)
#define PG8_SB(b, h) ((4 + (b) * 2 + (h)) * HTB)
#define PG8_STAGE_B(bufoff, gbase) do { glds16<(bufoff)>((const char*)(gbase), voffB[0], ldsbw); glds16<(bufoff) + 8192>((const char*)(gbase), voffB[1], ldsbw); } while (0)
#define PG8_STAGE_A(bufoff, gbase, h) do { glds16<(bufoff)>((const char*)(gbase), offA[(h) * 2], ldsbw); glds16<(bufoff) + 8192>((const char*)(gbase), offA[(h) * 2 + 1], ldsbw); } while (0)
#define PG8_LDA(dst, b, h) do { _Pragma("unroll") for (int m = 0; m < 4; ++m) _Pragma("unroll") for (int k = 0; k < 2; ++k) dst[m][k] = *(const PG8_LAS bf16x8*)(lds + PG8_SA(b, h) + aoff + m * 2048 + k * 1024); } while (0)
#define PG8_LDB(dst, b, h) do { _Pragma("unroll") for (int n = 0; n < 2; ++n) _Pragma("unroll") for (int k = 0; k < 2; ++k) dst[n][k] = *(const PG8_LAS bf16x8*)(lds + PG8_SB(b, h) + boff + n * 2048 + k * 1024); } while (0)
#define PG8_MMA(ai, bj, At, Bt) do { __builtin_amdgcn_s_setprio(1); if constexpr (MODE == 1) { _Pragma("unroll") for (int m = 0; m < 4; ++m) _Pragma("unroll") for (int n = 0; n < 2; ++n) { \
            const v8i _b = __builtin_shufflevector(__builtin_bit_cast(v4i, Bt[n][0]), __builtin_bit_cast(v4i, Bt[n][1]), 0, 1, 2, 3, 4, 5, 6, 7); \
            const v8i _a = __builtin_shufflevector(__builtin_bit_cast(v4i, At[m][0]), __builtin_bit_cast(v4i, At[m][1]), 0, 1, 2, 3, 4, 5, 6, 7); \
            acc[ai][bj][m][n] = __builtin_amdgcn_mfma_scale_f32_16x16x128_f8f6f4(_b, _a, acc[ai][bj][m][n], 0, 0, 0, 0x7A7A7A7A, 0, 0x7F7F7F7F); } } \
        else if constexpr (MODE == 2) { _Pragma("unroll") for (int m = 0; m < 4; ++m) _Pragma("unroll") for (int n = 0; n < 2; ++n) _Pragma("unroll") for (int k = 0; k < 2; ++k) \
        acc[ai][bj][m][n] = __builtin_bit_cast(f32x4, __builtin_amdgcn_mfma_i32_16x16x64_i8(__builtin_bit_cast(v4i, Bt[n][k]), __builtin_bit_cast(v4i, At[m][k]), __builtin_bit_cast(v4i, acc[ai][bj][m][n]), 0, 0, 0)); } \
        else { _Pragma("unroll") for (int m = 0; m < 4; ++m) _Pragma("unroll") for (int n = 0; n < 2; ++n) _Pragma("unroll") for (int k = 0; k < 2; ++k) \
        acc[ai][bj][m][n] = __builtin_amdgcn_mfma_f32_16x16x32_bf16(Bt[n][k], At[m][k], acc[ai][bj][m][n], 0, 0, 0); } __builtin_amdgcn_s_setprio(0); } while (0)
#define PG8_WAIT_V(n) asm volatile("s_waitcnt vmcnt(" #n ")" ::: "memory")
#define PG8_WAIT_L(n) asm volatile("s_waitcnt lgkmcnt(" #n ")" ::: "memory")
#define PG8_BAR __builtin_amdgcn_s_barrier()
#define PG8_SCHED __builtin_amdgcn_sched_barrier(0)
#define PG8_OFFS(dst, u) do { if constexpr (GATHER) { _Pragma("unroll") for (int _h = 0; _h < 2; ++_h) _Pragma("unroll") for (int _i = 0; _i < 2; ++_i) { \
        int _R, _C; stage_rc(tid * 16 + _i * 8192, _R, _C); dst[_h * 2 + _i] = S.a_row_off(u, _h * HALF + _R) + (unsigned)(_C * 2); } } } while (0)
    Unit cur, nxt; int ui = 0;
    if (!S.next(0, cur)) return;
    f32x4 acc[2][2][4][2];
#pragma unroll
    for (int a = 0; a < 2; ++a)
#pragma unroll
        for (int b = 0; b < 2; ++b)
#pragma unroll
            for (int m = 0; m < 4; ++m)
#pragma unroll
                for (int n = 0; n < 2; ++n) acc[a][b][m][n] = (f32x4){0.f, 0.f, 0.f, 0.f};
    bf16x8 At[4][2], B0[2][2], B1[2][2];
    const char* cA = S.a_tile(cur); const char* cB = S.b_tile(cur);
    PG8_OFFS(offA, cur);
    PG8_STAGE_B(PG8_SB(0, 0), cB); PG8_STAGE_B(PG8_SB(0, 1), cB + hstep); PG8_STAGE_A(PG8_SA(0, 0), cA, 0); PG8_STAGE_A(PG8_SA(0, 1), cA, 1);
    if (wr == 1) PG8_BAR;
    PG8_WAIT_V(2); PG8_BAR;
    PG8_STAGE_B(PG8_SB(1, 0), cB + kstep); PG8_STAGE_A(PG8_SA(1, 0), cA + kstep, 0); PG8_STAGE_B(PG8_SB(1, 1), cB + hstep + kstep);
    PG8_WAIT_V(6); PG8_BAR;
    for (;;) {
        const bool has_next = S.next(ui + 1, nxt);
        const char* nA = has_next ? S.a_tile(nxt) : cA; const char* nB = has_next ? S.b_tile(nxt) : cB;
        if constexpr (GATHER) { if (has_next) { PG8_OFFS(nxA, nxt); } }
#pragma unroll 1
        for (int t = 0; t < nt; t += 2) {
            const bool last = (t == nt - 2);
            const char* a1 = cA + (size_t)(t + 1) * kstep;
            const char* a2 = last ? nA : cA + (size_t)(t + 2) * kstep; const char* b2 = last ? nB : cB + (size_t)(t + 2) * kstep;
            const char* a3 = a2 + kstep; const char* b3 = b2 + kstep;
            PG8_LDB(B0, 0, 0); PG8_LDB(B1, 0, 1); PG8_SCHED; PG8_LDA(At, 0, 0); PG8_STAGE_A(PG8_SA(1, 1), a1, 1);
            if constexpr (GATHER) { if (last && has_next) {
#pragma unroll
                for (int q = 0; q < 4; ++q) offA[q] = nxA[q]; } }
            PG8_WAIT_V(8); PG8_WAIT_L(0); PG8_BAR; if (!(Sched::HAS_RH && cur.rh == 1)) { PG8_MMA(0, 0, At, B0); if (!(Sched::HAS_HALF && S.is_half(cur))) PG8_MMA(0, 1, At, B1); } PG8_BAR; PG8_SCHED;
            PG8_LDA(At, 0, 1); PG8_STAGE_B(PG8_SB(0, 0), b2); PG8_STAGE_B(PG8_SB(0, 1), b2 + hstep); PG8_STAGE_A(PG8_SA(0, 0), a2, 0);
            PG8_WAIT_V(8); PG8_WAIT_L(0); PG8_BAR; if (!(Sched::HAS_RH && cur.rh == 0)) { PG8_MMA(1, 0, At, B0); if (!(Sched::HAS_HALF && S.is_half(cur))) PG8_MMA(1, 1, At, B1); } PG8_BAR; PG8_SCHED;
            PG8_LDB(B0, 1, 0); PG8_LDB(B1, 1, 1); PG8_SCHED; PG8_LDA(At, 1, 0); PG8_STAGE_A(PG8_SA(0, 1), a2, 1);
            PG8_WAIT_V(8); PG8_WAIT_L(0); PG8_BAR; if (!(Sched::HAS_RH && cur.rh == 1)) { PG8_MMA(0, 0, At, B0); if (!(Sched::HAS_HALF && S.is_half(cur))) PG8_MMA(0, 1, At, B1); } PG8_BAR; PG8_SCHED;
            PG8_LDA(At, 1, 1); PG8_STAGE_B(PG8_SB(1, 0), b3); PG8_STAGE_B(PG8_SB(1, 1), b3 + hstep); PG8_STAGE_A(PG8_SA(1, 0), a3, 0);
            PG8_WAIT_V(8); PG8_WAIT_L(0); PG8_BAR; if (!(Sched::HAS_RH && cur.rh == 0)) { PG8_MMA(1, 0, At, B0); if (!(Sched::HAS_HALF && S.is_half(cur))) PG8_MMA(1, 1, At, B1); } PG8_BAR; PG8_SCHED;
        }
        if (wr == 0) PG8_BAR;
        E(acc, cur, wr, wc, fr, fq);
        if (!has_next) break;
#pragma unroll
        for (int a = 0; a < 2; ++a)
#pragma unroll
            for (int b = 0; b < 2; ++b)
#pragma unroll
                for (int m = 0; m < 4; ++m)
#pragma unroll
                    for (int n = 0; n < 2; ++n) acc[a][b][m][n] = (f32x4){0.f, 0.f, 0.f, 0.f};
        cur = nxt; cA = nA; cB = nB; ++ui;
        if (wr == 1) PG8_BAR;
    }
    PG8_WAIT_V(0);
    PG8_BAR;
#undef PG8_SA
#undef PG8_SB
#undef PG8_STAGE_A
#undef PG8_STAGE_B
#undef PG8_LDA
#undef PG8_LDB
#undef PG8_MMA
#undef PG8_WAIT_V
#undef PG8_WAIT_L
#undef PG8_BAR
#undef PG8_SCHED
#undef PG8_OFFS
}
}

#define XB_TMO      128
#define XB_XCNT(j)  (256  + 64 * (j))
#define XB_XSUB(j)  (1280 + 64 * (j))
#define XB_XGEN(j)  (2304 + 64 * (j))
#define XB_TOP      3328
#define XB_TOPGEN   3392
#define XCD_BAR_WORDS 3456
#define XB_SPIN_CAP (1u << 18)
__device__ __forceinline__ unsigned xb_ld(unsigned* p)              { return __hip_atomic_load(p, __ATOMIC_RELAXED, __HIP_MEMORY_SCOPE_AGENT); }
__device__ __forceinline__ unsigned xb_add(unsigned* p, unsigned v) { return __hip_atomic_fetch_add(p, v, __ATOMIC_RELAXED, __HIP_MEMORY_SCOPE_AGENT); }
__device__ __forceinline__ unsigned xb_xcc_id() { return (unsigned)__builtin_amdgcn_s_getreg((3 << 11) | 20) & 0xFu; }
#define XB_SPIN(cond, bar) do { unsigned _sp = 0; while (cond) { __builtin_amdgcn_s_sleep(1); \
    if ((++_sp & 255u) == 0u) { if (xb_ld(&(bar)[XB_TMO])) break; if (_sp > XB_SPIN_CAP) { atomicAdd(&(bar)[XB_TMO], 1u); break; } } } } while (0)
struct XcdBarrier { unsigned* bar; unsigned x; volatile LAS unsigned* st; };
__device__ __forceinline__ XcdBarrier xcd_barrier_post(unsigned* bar, volatile LAS unsigned* st) {
    XcdBarrier b; b.bar = bar; b.x = xb_xcc_id(); b.st = st;
    if (threadIdx.x == 0) (void)xb_add(&bar[XB_XCNT(b.x)], 1u);
    return b;
}
__device__ __forceinline__ void xcd_barrier_complete(unsigned* bar, unsigned x, unsigned& nloc, unsigned& nx) {
    const unsigned G = gridDim.x * gridDim.y * gridDim.z;
    unsigned sum, cnt, mine, sp = 0u;
    for (;;) {
        sum = 0u; cnt = 0u; mine = 0u;
#pragma unroll
        for (unsigned j = 0; j < 16; ++j) { const unsigned c = xb_ld(&bar[XB_XCNT(j)]); sum += c; cnt += (c > 0u) ? 1u : 0u; mine = (j == x) ? c : mine; }
        if (sum == G) break;
        __builtin_amdgcn_s_sleep(1);
        if ((++sp & 255u) == 0u) { if (xb_ld(&bar[XB_TMO])) break; if (sp > XB_SPIN_CAP) { atomicAdd(&bar[XB_TMO], 1u); break; } }
    }
    nloc = mine > 0u ? mine : 1u; nx = cnt > 0u ? cnt : 1u;
}
__device__ __forceinline__ void xcd_barrier(const XcdBarrier& b) {
    asm volatile("s_waitcnt vmcnt(0)" ::: "memory");
    __syncthreads();
    if (threadIdx.x == 0) {
        unsigned* bar = b.bar;
        __builtin_amdgcn_s_waitcnt(0);
        unsigned nloc = b.st[0], nx = b.st[1];
        if (nloc == 0u) { xcd_barrier_complete(bar, b.x, nloc, nx); b.st[0] = nloc; b.st[1] = nx; }
        const unsigned old = xb_add(&bar[XB_XSUB(b.x)], 1u);
        const unsigned gen = old / nloc;
        if (old + 1u == (gen + 1u) * nloc) {
            __builtin_amdgcn_fence(__ATOMIC_RELEASE, "agent");
            asm volatile("s_waitcnt vmcnt(0)" ::: "memory");
            const unsigned og = xb_add(&bar[XB_TOP], 1u);
            const unsigned tg = og / nx;
            if (og + 1u == (tg + 1u) * nx) xb_add(&bar[XB_TOPGEN], 1u);
            else XB_SPIN(xb_ld(&bar[XB_TOPGEN]) == tg, bar);
            __builtin_amdgcn_fence(__ATOMIC_ACQUIRE, "agent");
            xb_add(&bar[XB_XGEN(b.x)], 1u);
            asm volatile("s_waitcnt vmcnt(0)" ::: "memory");
        } else {
            XB_SPIN(xb_ld(&bar[XB_XGEN(b.x)]) == gen, bar);
            __builtin_amdgcn_fence(__ATOMIC_ACQUIRE, "agent");
            asm volatile("s_waitcnt vmcnt(0)" ::: "memory");
        }
    }
    __syncthreads();
}

constexpr int NWAVES = 8;
struct Args { const float* in[21]; float* out; unsigned char* ws; int ph_lo, ph_hi; };
struct Frame {
    LAS unsigned char* lds;
    unsigned* ctl;
    int tid, lane, wave, vcu, G;
    unsigned char* ws;
};
enum { I_X = 0, I_LNIG, I_LNIB, I_RW, I_RB, I_WIN, I_CAW, I_CBW, I_CBB, I_LCG, I_LCB, I_PW, I_PS, I_WOUT, I_LMG, I_LMB, I_WG, I_WU, I_WDN, I_LFG, I_LFB };

__device__ __forceinline__ void tr_item(const float* src, int srcN, int srccol0, bf16* dst, int dstK, int dstrow0, int k0, LAS float* scr, int lane) {
#pragma unroll 8
    for (int i = 0; i < 32; ++i) { const int kk = 2 * i + (lane >> 5); scr[kk * 33 + (lane & 31)] = src[(size_t)(k0 + kk) * srcN + srccol0 + (lane & 31)]; }
    LDS_WAIT(); asm volatile("" ::: "memory");
    const int c = lane & 7;
#pragma unroll
    for (int j = 0; j < 4; ++j) { const int n = (lane >> 3) + 8 * j; const LAS float* s = scr + (8 * c) * 33 + n;
        v4u o; o.x = pk2(s[0 * 33], s[1 * 33]); o.y = pk2(s[2 * 33], s[3 * 33]); o.z = pk2(s[4 * 33], s[5 * 33]); o.w = pk2(s[6 * 33], s[7 * 33]);
        *(GAS v4u*)(dst + (size_t)(dstrow0 + n) * dstK + k0 + 8 * c) = o; }
    LDS_WAIT(); asm volatile("" ::: "memory");
}
__device__ __forceinline__ void tr_item64(const float* src, int srcN, int srccol0, bf16* dst, int dstK, int dstrow0, int k0, LAS unsigned* scr, int lane) {
    const int kr = lane >> 4, c4 = lane & 15;
    const float* sp = src + (size_t)(k0 + 2 * kr) * srcN + srccol0 + 4 * c4;
    f32x4 A[8], B[8];
#pragma unroll
    for (int i = 0; i < 8; ++i) { A[i] = *(const GAS f32x4*)(sp + (size_t)(8 * i) * srcN); B[i] = *(const GAS f32x4*)(sp + (size_t)(8 * i + 1) * srcN); }
#pragma unroll
    for (int i = 0; i < 8; ++i) { LAS unsigned* w = scr + (4 * i + kr) * 65 + 4 * c4;
        w[0] = pk2(A[i].x, B[i].x); w[1] = pk2(A[i].y, B[i].y); w[2] = pk2(A[i].z, B[i].z); w[3] = pk2(A[i].w, B[i].w); }
    LDS_WAIT(); asm volatile("" ::: "memory");
    const int q = lane & 7, nn = lane >> 3;
#pragma unroll
    for (int j = 0; j < 8; ++j) { const int n = nn + 8 * j; const LAS unsigned* r = scr + (4 * q) * 65 + n;
        v4u o; o.x = r[0]; o.y = r[65]; o.z = r[130]; o.w = r[195];
        *(GAS v4u*)(dst + (size_t)(dstrow0 + n) * dstK + k0 + 8 * q) = o; }
    LDS_WAIT(); asm volatile("" ::: "memory");
}
template <int NS, bool I8 = false>
__device__ __forceinline__ void tr_item64_f8(const float* src, int srcN, int srccol0, unsigned char* dst, int dstKB, int dstrow0, int k0, float scale, LAS unsigned* scr, int lane, bool nostore = false, f32x4 cinv = (f32x4){1.f, 1.f, 1.f, 1.f}) {
    const int kr = lane >> 4, c4 = lane & 15;
    const float* sp = src + (size_t)(k0 + 4 * kr) * srcN + srccol0 + 4 * c4;
    f32x4 A[NS][4][4];
#pragma unroll
    for (int s = 0; s < NS; ++s)
#pragma unroll
        for (int i = 0; i < 4; ++i)
#pragma unroll
            for (int t = 0; t < 4; ++t) A[s][i][t] = *(const GAS f32x4*)(sp + (size_t)(64 * s + 16 * i + t) * srcN);
#pragma unroll
    for (int s = 0; s < NS; ++s)
#pragma unroll
        for (int i = 0; i < 4; ++i) { LAS unsigned* w = scr + (16 * s + 4 * i + kr) * 65 + 4 * c4;
            if constexpr (I8) {
            w[0] = pk4_i8(A[s][i][0].x * cinv.x, A[s][i][1].x * cinv.x, A[s][i][2].x * cinv.x, A[s][i][3].x * cinv.x); w[1] = pk4_i8(A[s][i][0].y * cinv.y, A[s][i][1].y * cinv.y, A[s][i][2].y * cinv.y, A[s][i][3].y * cinv.y);
            w[2] = pk4_i8(A[s][i][0].z * cinv.z, A[s][i][1].z * cinv.z, A[s][i][2].z * cinv.z, A[s][i][3].z * cinv.z); w[3] = pk4_i8(A[s][i][0].w * cinv.w, A[s][i][1].w * cinv.w, A[s][i][2].w * cinv.w, A[s][i][3].w * cinv.w); } else {
            w[0] = pk4_fp8(A[s][i][0].x * scale, A[s][i][1].x * scale, A[s][i][2].x * scale, A[s][i][3].x * scale); w[1] = pk4_fp8(A[s][i][0].y * scale, A[s][i][1].y * scale, A[s][i][2].y * scale, A[s][i][3].y * scale);
            w[2] = pk4_fp8(A[s][i][0].z * scale, A[s][i][1].z * scale, A[s][i][2].z * scale, A[s][i][3].z * scale); w[3] = pk4_fp8(A[s][i][0].w * scale, A[s][i][1].w * scale, A[s][i][2].w * scale, A[s][i][3].w * scale); } }
    LDS_WAIT(); asm volatile("" ::: "memory");
    constexpr int QN = 4 * NS, RN = 64 / QN;
    const int q = lane % QN, nn = lane / QN;
#pragma unroll
    for (int j = 0; j < 64 / RN; ++j) { const int n = nn + RN * j; const LAS unsigned* r = scr + (4 * q) * 65 + n;
        v4u o; o.x = r[0]; o.y = r[65]; o.z = r[130]; o.w = r[195];
        if (nostore) asm volatile("" :: "v"(o)); else *(GAS v4u*)(dst + (size_t)(dstrow0 + n) * dstKB + k0 + 16 * q) = o; }
    LDS_WAIT(); asm volatile("" ::: "memory");
}
__device__ __forceinline__ int win_src(int c0) {
    const int pn = c0 >> 8, j = c0 & 255, half = j >> 7, jj = j & 127;
    if (pn < 3) { const int ch = pn * 128 + jj; return half == 0 ? 384 + ch : 768 + ch; }
    if (pn < 6) { const int ch = (pn - 3) * 128 + jj; return half == 0 ? 1152 + ch : 1536 + ch; }
    if (pn < 8) { const int q = (pn - 6) * 256 + j; return q < 384 ? q : 1920 + (q - 384); }
    return j < 128 ? 1920 + 128 + j : -1;
}
__device__ __forceinline__ void p0_prologue(Frame& F, const Args& A) {
    LAS float* scr = (LAS float*)(F.lds + F.wave * 8448);
    LAS unsigned* scu = (LAS unsigned*)scr;
    const int gw = F.vcu * NWAVES + F.wave, NGW = F.G * NWAVES, lane = F.lane;
    bf16* WIN = (bf16*)(F.ws + WS_WIN); bf16* WOUT = (bf16*)(F.ws + WS_WOUT); unsigned char* WGU = F.ws + WS_WGU; unsigned char* WD = F.ws + WS_WD; bf16* WRT = (bf16*)(F.ws + WS_WRT);
    constexpr int I_M = GEMM1_I8 ? NL * 36 * 8 : 0, I_A = GEMM1_I8 ? NL * 36 * 8 : NL * 16 * 36, I_B = NL * 12 * 16, I_C = NL * NE * 128, I_D = NL * NE * 64, I_E = 16, I_F = NL * 4 * 16 * 2;
    constexpr int NITEMS = I_M + I_A + I_B + I_C + I_D + I_E + I_F;
    const int lane0 = lane;
#pragma unroll 1
    for (int prep = 0; prep < ((PROBE_P0 == 1 || PROBE_P0 == 3) ? 2 : 1); ++prep)
    for (int it = gw; it < NITEMS; it += NGW) {
        int lane = lane0; asm volatile("" : "+v"(lane));
        int r = it;
        if (r < I_M) {
            const int l = r / 288, q = r % 288, cb = q >> 3, kq = q & 7, c0 = cb * 64, sc = win_src(c0), kr = lane >> 4, c4 = lane & 15;
            if (sc >= 0) { const float* sp = A.in[I_WIN] + (size_t)l * 1024 * DIN + (size_t)(kq * 128 + kr) * DIN + sc + 4 * c4;
                f32x4 vv[32];
#pragma unroll
                for (int i = 0; i < 32; ++i) vv[i] = *(const GAS f32x4*)(sp + (size_t)(4 * i) * DIN);
                f32x4 mx = (f32x4){0.f, 0.f, 0.f, 0.f};
#pragma unroll
                for (int i = 0; i < 32; ++i) { mx.x = fmaxf(mx.x, fabsf(vv[i].x)); mx.y = fmaxf(mx.y, fabsf(vv[i].y)); mx.z = fmaxf(mx.z, fabsf(vv[i].z)); mx.w = fmaxf(mx.w, fabsf(vv[i].w)); }
#pragma unroll
                for (int o = 16; o <= 32; o <<= 1) { mx.x = fmaxf(mx.x, __shfl_xor(mx.x, o)); mx.y = fmaxf(mx.y, __shfl_xor(mx.y, o)); mx.z = fmaxf(mx.z, __shfl_xor(mx.z, o)); mx.w = fmaxf(mx.w, __shfl_xor(mx.w, o)); }
                if (kr == 0) { unsigned* cm = F.ctl + CW_CMAX + l * N1 + c0 + 4 * c4;
                    __hip_atomic_fetch_max(cm + 0, __float_as_uint(mx.x), RLX_AGENT); __hip_atomic_fetch_max(cm + 1, __float_as_uint(mx.y), RLX_AGENT);
                    __hip_atomic_fetch_max(cm + 2, __float_as_uint(mx.z), RLX_AGENT); __hip_atomic_fetch_max(cm + 3, __float_as_uint(mx.w), RLX_AGENT); } }
            VM_WAIT();
            if (lane == 0) __hip_atomic_fetch_add(F.ctl + CW_CMAXCNT, 1u, RLX_AGENT);
            continue; }
        r -= I_M;
        if (r < I_C) {
            const int le = r >> 7, q = r & 127, kb = q >> 4, nb = q & 15, n0 = nb * 64, pn = n0 >> 8, half = (n0 & 255) >> 7, jj0 = n0 & 127;
            const float* src = (half ? A.in[I_WU] : A.in[I_WG]) + (size_t)le * 1024 * 512;
            tr_item64_f8<2>(src, 512, pn * 128 + jj0, WGU + (size_t)le * 1024 * 1024, 1024, n0, kb * 128, 32.0f, scu, lane, PROBE_P0 == 3 && prep == 1); continue; }
        r -= I_C;
        if (r < I_D) {
            const int le = r >> 6, q = r & 63, kb = q >> 4, nb = q & 15;
            tr_item64_f8<2>(A.in[I_WDN] + (size_t)le * 512 * 1024, 1024, nb * 64, WD + (size_t)le * 1024 * 512, 512, nb * 64, kb * 128, 32.0f, scu, lane, PROBE_P0 == 3 && prep == 1); continue; }
        r -= I_D;
        if (r < I_A) {
            if (GEMM1_I8) {
                const int l = r / 288, q = r % 288, cb = q >> 3, kb = q & 7, c0 = cb * 64, sc = win_src(c0), c4 = lane & 15;
                unsigned char* dst = F.ws + WS_WIN + (size_t)l * N1 * 1024;
                { unsigned spins = 0;
                  while (__hip_atomic_load(F.ctl + CW_CMAXCNT, RLX_AGENT) < (unsigned)I_M * ((PROBE_P0 == 1 || PROBE_P0 == 3) ? (unsigned)(prep + 1) : 1u)) { __builtin_amdgcn_s_sleep(8); if (++spins > (1u << 22)) break; } }
                if (sc >= 0) { const unsigned* cm = F.ctl + CW_CMAX + l * N1 + c0 + 4 * c4;
                    f32x4 mx; mx.x = __uint_as_float(__hip_atomic_load(cm + 0, RLX_AGENT)); mx.y = __uint_as_float(__hip_atomic_load(cm + 1, RLX_AGENT)); mx.z = __uint_as_float(__hip_atomic_load(cm + 2, RLX_AGENT)); mx.w = __uint_as_float(__hip_atomic_load(cm + 3, RLX_AGENT));
                    f32x4 cinv; cinv.x = mx.x > 0.f ? 127.f / mx.x : 0.f; cinv.y = mx.y > 0.f ? 127.f / mx.y : 0.f; cinv.z = mx.z > 0.f ? 127.f / mx.z : 0.f; cinv.w = mx.w > 0.f ? 127.f / mx.w : 0.f;
                    tr_item64_f8<2, true>(A.in[I_WIN] + (size_t)l * 1024 * DIN, DIN, sc, dst, 1024, c0, kb * 128, 1.f, scu, lane, false, cinv);
                } else { for (int qq = lane; qq < 64 * 8; qq += 64) *(GAS v4u*)(dst + (size_t)(c0 + (qq >> 3)) * 1024 + kb * 128 + (qq & 7) * 16) = (v4u){0u, 0u, 0u, 0u}; }
                continue; }
            const int l = r / 576, q = r % 576, kb = q / 36, nb = q % 36, c0 = nb * 64, sc = win_src(c0);
            bf16* dst = WIN + (size_t)l * N1 * 1024;
            if (sc >= 0) tr_item64(A.in[I_WIN] + (size_t)l * 1024 * DIN, DIN, sc, dst, 1024, c0, kb * 64, scu, lane);
            else { const int c = lane & 7;
#pragma unroll
                for (int j = 0; j < 8; ++j) { const int n = (lane >> 3) + 8 * j; *(GAS v4u*)(dst + (size_t)(c0 + n) * 1024 + kb * 64 + 8 * c) = (v4u){0u, 0u, 0u, 0u}; } }
            continue; }
        r -= I_A;
        if (r < I_B) {
            const int l = r / 192, q = r % 192, kb = q >> 4, nb = q & 15;
            if (GEMM2_FP8) tr_item64_f8<1>(A.in[I_WOUT] + (size_t)l * 1024 * 1024, 1024, nb * 64, (unsigned char*)WOUT + (size_t)l * 1024 * 1024, 1024, nb * 64, kb * 64, 32.0f, scu, lane);
            else tr_item64(A.in[I_WOUT] + (size_t)l * 1024 * 1024, 1024, nb * 64, WOUT + (size_t)l * 1024 * 1024, 1024, nb * 64, kb * 64, scu, lane);
            continue; }
        r -= I_B;
        if (r < I_E) { tr_item(A.in[I_RW], 32, 0, WRT, 1024, 0, r * 64, scr, lane); continue; }
        r -= I_E;
        {
            const int l = r >> 7, g = (r >> 5) & 3, nb = (r >> 1) & 15, cb = r & 1, n = nb * 64 + lane;
            const float* wo = A.in[I_WOUT] + (size_t)l * 1024 * 1024 + (size_t)(768 + g * 64) * 1024 + n;
            const float* ps = A.in[I_PS] + l * 256 + g * 64;
            const float* pw = A.in[I_PW] + (size_t)(l * 4 + g) * 64 * 64 + cb * 32 * 64;
#pragma unroll
            for (int i = 0; i < 8; ++i) *(LAS f32x4*)(scr + (i * 64 + lane) * 4) = *(const GAS f32x4*)(pw + (i * 64 + lane) * 4);
            float wv[64];
#pragma unroll
            for (int d = 0; d < 64; ++d) wv[d] = wo[(size_t)d * 1024] * ps[d];
            LDS_WAIT(); asm volatile("" ::: "memory");
            bf16* dst = WOUT + (size_t)l * 1024 * 1024 + (size_t)n * 1024 + 768 + g * 64 + cb * 32;
#pragma unroll 1
            for (int c2 = 0; c2 < 16; ++c2) { float o[2];
#pragma unroll
                for (int cc = 0; cc < 2; ++cc) { const LAS f32x4* pr = (const LAS f32x4*)(scr + (c2 * 2 + cc) * 64); float a = 0.f;
#pragma unroll
                    for (int d4 = 0; d4 < 16; ++d4) { const f32x4 p = pr[d4]; a += p.x * wv[4 * d4] + p.y * wv[4 * d4 + 1] + p.z * wv[4 * d4 + 2] + p.w * wv[4 * d4 + 3]; }
                    o[cc] = a; }
                if (GEMM2_FP8) *(GAS unsigned short*)((unsigned char*)WOUT + (size_t)l * 1024 * 1024 + (size_t)n * 1024 + 768 + g * 64 + cb * 32 + c2 * 2) = (unsigned short)pk4_fp8(o[0] * 32.0f, o[1] * 32.0f, 0.f, 0.f);
                else *(GAS unsigned*)(dst + c2 * 2) = pk2(o[0], o[1]); }
            LDS_WAIT(); asm volatile("" ::: "memory");
        }
    }
    bf16* HB = (bf16*)(F.ws + WS_HB);
    const float* g = A.in[I_LNIG]; const float* b = A.in[I_LNIB];
    f32x4 gv[4], bv[4];
#pragma unroll
    for (int j = 0; j < 4; ++j) { gv[j] = *(const f32x4*)(g + 4 * lane + 256 * j); bv[j] = *(const f32x4*)(b + 4 * lane + 256 * j); }
#pragma unroll 1
    for (int prep2 = 0; prep2 < ((PROBE_P0 == 2) ? 2 : 1); ++prep2)
    for (int m0 = gw * 2; m0 < T_; m0 += NGW * 2) {
        f32x4 v[2][4];
#pragma unroll
        for (int u = 0; u < 2; ++u) { const GAS f32x4* xr = (const GAS f32x4*)(A.in[I_X] + (size_t)(m0 + u) * D_) + lane;
#pragma unroll
            for (int j = 0; j < 4; ++j) v[u][j] = xr[64 * j]; }
#pragma unroll
        for (int u = 0; u < 2; ++u) { float s = 0.f;
#pragma unroll
            for (int j = 0; j < 4; ++j) s += (v[u][j].x + v[u][j].y) + (v[u][j].z + v[u][j].w);
            const float mean = wave_sum(s) * (1.f / D_); float s2 = 0.f;
#pragma unroll
            for (int j = 0; j < 4; ++j) { v[u][j] = v[u][j] - mean; s2 += (v[u][j].x * v[u][j].x + v[u][j].y * v[u][j].y) + (v[u][j].z * v[u][j].z + v[u][j].w * v[u][j].w); }
            const float rstd = __builtin_amdgcn_rsqf(wave_sum(s2) * (1.f / D_) + LN_EPS);
            GAS v2u* o8 = (GAS v2u*)(HB + (size_t)(m0 + u) * D_) + lane;
            float amax = 0.f;
#pragma unroll
            for (int j = 0; j < 4; ++j) { const f32x4 o = v[u][j] * rstd * gv[j] + bv[j]; v[u][j] = o; v2u w; w.x = pk2(o.x, o.y); w.y = pk2(o.z, o.w); o8[64 * j] = w;
                amax = fmaxf(amax, fmaxf(fmaxf(fabsf(o.x), fabsf(o.y)), fmaxf(fabsf(o.z), fabsf(o.w)))); }
            if (GEMM1_I8) {
                amax = wave_max(amax); const float inv = amax > 0.f ? 127.f / amax : 0.f;
                GAS unsigned* q4 = (GAS unsigned*)(F.ws + WS_HQ + (size_t)(m0 + u) * D_) + lane;
#pragma unroll
                for (int j = 0; j < 4; ++j) q4[64 * j] = pk4_i8(v[u][j].x * inv, v[u][j].y * inv, v[u][j].z * inv, v[u][j].w * inv);
                if (lane == 0) ((float*)(F.ws + WS_HS))[m0 + u] = amax * (1.f / 127.f); } }
    }
}

__device__ __forceinline__ void p2_mixer(Frame& F, const Args& A, int l) {
    LAS unsigned* BV = (LAS unsigned*)F.lds;
    LAS unsigned* PB = (LAS unsigned*)(F.lds + 47616);
    LAS float* V = (LAS float*)(F.lds + 71680);
    const bf16* Z = (const bf16*)(F.ws + WS_Z); bf16* Y = (bf16*)(F.ws + WS_Y);
    const float* wB = A.in[I_CBW] + l * 31 * 384; const float* bB = A.in[I_CBB] + l * 384;
    const float* lg = A.in[I_LCG] + l * 384; const float* lb = A.in[I_LCB] + l * 384; const float* wA = A.in[I_CAW] + l * 3 * 384;
    int tid = F.tid; asm volatile("" : "+v"(tid));
    const int lane = tid & 63, wave = F.wave;
    const bool convt = tid < 384; const int cp = tid % 192, tg = tid / 192;
    f32x2 w[31]; f32x2 bias = (f32x2){0.f, 0.f};
#pragma unroll
    for (int j = 0; j < 31; ++j) w[j] = (f32x2){0.f, 0.f};
    if (convt) {
#pragma unroll
        for (int j = 0; j < 31; ++j) w[j] = *(const f32x2*)(wB + j * 384 + 2 * cp);
        bias = *(const f32x2*)(bB + 2 * cp); }
    v4u pre[9];
#define MIX_PREFETCH(ci_, tid_) do { const int _t0 = (ci_) * 32, _s0 = _t0 & (SEQ_ - 1); \
        _Pragma("unroll") for (int _i = 0; _i < 6; ++_i) { const int _q = (tid_) + 512 * _i; const int _qq = _q < 62 * 48 ? _q : 0; const int _r = _qq / 48, _c = _qq % 48; \
            const int _rr = (_s0 - 30 + _r >= 0) ? _r : 30; pre[_i] = *(const GAS v4u*)(Z + (size_t)(_t0 - 30 + _rr) * NZ + 768 + _c * 8); } \
        _Pragma("unroll") for (int _i = 0; _i < 3; ++_i) { const int _q = (tid_) + 512 * _i; const int _qq = _q < 47 * 32 ? _q : 0; const int _r = _qq >> 5, _c = _qq & 31; \
            const int _rr = (_s0 - 15 + _r >= 0) ? _r : 15; pre[6 + _i] = *(const GAS v4u*)(Z + (size_t)(_t0 - 15 + _rr) * NZ + 1152 + _c * 8); } } while (0)
    if (F.vcu < T_ / 32) MIX_PREFETCH(F.vcu, tid);
    for (int ci = F.vcu; ci < T_ / 32; ci += F.G) {
        const int t0 = ci * 32, s0 = t0 & (SEQ_ - 1);
#pragma unroll
        for (int i = 0; i < 6; ++i) { const int q = tid + 512 * i; if (q < 62 * 48) { const int r = q / 48, c = q % 48;
            *(LAS v4u*)(BV + r * 192 + c * 4) = (s0 - 30 + r >= 0) ? pre[i] : (v4u){0u, 0u, 0u, 0u}; } }
#pragma unroll
        for (int i = 0; i < 3; ++i) { const int q = tid + 512 * i; if (q < 47 * 32) { const int r = q >> 5, c = q & 31;
            *(LAS v4u*)(PB + r * 128 + c * 4) = (s0 - 15 + r >= 0) ? pre[6 + i] : (v4u){0u, 0u, 0u, 0u}; } }
        __syncthreads();
        { int cn = ci + F.G; asm volatile("" : "+s"(cn)); int tidp = tid; asm volatile("" : "+v"(tidp));
          if (cn < T_ / 32) MIX_PREFETCH(cn, tidp); }
        if (PROBE_MIX == 3) { int cn = ci + F.G; asm volatile("" : "+s"(cn)); int tidp = tid; asm volatile("" : "+v"(tidp));
          if (cn < T_ / 32) { v4u sink[9]; const int _t0 = cn * 32;
#pragma unroll
              for (int i = 0; i < 6; ++i) { const int q = tidp + 512 * i, qq = q < 62 * 48 ? q : 0, r = qq / 48, c = qq % 48; sink[i] = *(const GAS v4u*)(Z + (size_t)(_t0 + r) * NZ + 768 + c * 8 + 8); }
#pragma unroll
              for (int i = 0; i < 3; ++i) { const int q = tidp + 512 * i, qq = q < 47 * 32 ? q : 0, r = qq >> 5, c = qq & 31; sink[6 + i] = *(const GAS v4u*)(Z + (size_t)(_t0 + r) * NZ + 1152 + c * 8); }
#pragma unroll
              for (int i = 0; i < 9; ++i) asm volatile("" :: "v"(sink[i])); } }
#pragma unroll 1
        for (int prep = 0; prep < ((PROBE_MIX == 1) ? 2 : 1); ++prep)
        if (convt) {
#pragma unroll 1
            for (int hh = 0; hh < 2; ++hh) { const int tb = tg * 16 + hh * 8;
                f32x2 x[38];
#pragma unroll
                for (int i = 0; i < 38; ++i) { const unsigned u = BV[(tb + i) * 192 + cp]; x[i] = (f32x2){bflo(u), bfhi(u)}; }
#pragma unroll
                for (int tt = 0; tt < 8; ++tt) { f32x2 a = bias;
#pragma unroll
                    for (int j = 0; j < 31; ++j) a += w[j] * x[tt + j];
                    *(LAS f32x2*)(V + (tb + tt) * 384 + 2 * cp) = a; }
            }
        } else {
            const int p = tid - 384, g = p >> 5, wd = 2 << g;
            f32x2 s = (f32x2){0.f, 0.f};
            for (int i = 1; i < wd; ++i) { const unsigned u = PB[(15 - i) * 128 + p]; s += (f32x2){bflo(u), bfhi(u)}; }
#pragma unroll 1
            for (int blk = 0; blk < 4; ++blk) {
                unsigned xr[23];
#pragma unroll
                for (int i = 0; i < 23; ++i) xr[i] = PB[(8 * blk + i) * 128 + p];
#pragma unroll
                for (int j = 0; j < 8; ++j) { const int tt = 8 * blk + j; const f32x2 xv = (f32x2){bflo(xr[15 + j]), bfhi(xr[15 + j])};
                    s += xv; const int n = (s0 + tt + 1) < wd ? (s0 + tt + 1) : wd; const float inv = __builtin_amdgcn_rcpf((float)n);
                    const f32x2 dd = s * inv - xv;
                    if (GEMM2_FP8) *(GAS unsigned short*)((unsigned char*)Y + (size_t)(t0 + tt) * D_ + 768 + 2 * p) = (unsigned short)pk4_fp8(dd.x, dd.y, 0.f, 0.f);
                    else *(GAS unsigned*)(Y + (size_t)(t0 + tt) * D_ + 768 + 2 * p) = pk2(dd.x, dd.y);
                    const unsigned u2 = xr[15 + j - 1], u4 = xr[15 + j - 3], u8 = xr[15 + j - 7], u16 = xr[j];
                    const unsigned uo = g == 0 ? u2 : (g == 1 ? u4 : (g == 2 ? u8 : u16));
                    s -= (f32x2){bflo(uo), bfhi(uo)}; }
            }
        }
        __syncthreads();
        v4u ya[3][4];
        int t0o = t0; asm volatile("" : "+s"(t0o));
        int tidl = tid; asm volatile("" : "+v"(tidl));
#pragma unroll
        for (int i = 0; i < 3; ++i) { const int q = tidl + 512 * i, tt = q / 48, o8 = q % 48, pos = (t0o & (SEQ_ - 1)) + tt; const size_t row = (size_t)(t0o + tt);
            ya[i][0] = *(const GAS v4u*)(Z + row * NZ + o8 * 8);
            ya[i][1] = *(const GAS v4u*)(Z + row * NZ + 384 + o8 * 8);
            ya[i][2] = *(const GAS v4u*)(Z + (row - (pos >= 1 ? 1 : 0)) * NZ + 384 + o8 * 8);
            ya[i][3] = *(const GAS v4u*)(Z + (row - (pos >= 2 ? 2 : 0)) * NZ + 384 + o8 * 8); }
#pragma unroll 1
        for (int tk = 0; tk < ((PROBE_MIX == 2) ? 8 : 4); ++tk) { const int tt = wave * 4 + (tk & 3);
            f32x2 v[3]; float s = 0.f;
#pragma unroll
            for (int i = 0; i < 3; ++i) { v[i] = *(const LAS f32x2*)(V + tt * 384 + 2 * lane + 128 * i); s += v[i].x + v[i].y; }
            const float mean = wave_sum(s) * (1.f / 384.f); float q = 0.f;
#pragma unroll
            for (int i = 0; i < 3; ++i) { v[i] = v[i] - mean; q += v[i].x * v[i].x + v[i].y * v[i].y; }
            const float rstd = __builtin_amdgcn_rsqf(wave_sum(q) * (1.f / 384.f) + LN_EPS);
#pragma unroll
            for (int i = 0; i < 3; ++i) { const int c = 2 * lane + 128 * i; const f32x2 gg = *(const f32x2*)(lg + c), bb = *(const f32x2*)(lb + c);
                f32x2 o = v[i] * rstd * gg + bb; o.x = o.x * sigmoidf_(o.x); o.y = o.y * sigmoidf_(o.y);
                if (GEMM2_FP8) *(GAS unsigned short*)((unsigned char*)Y + (size_t)(t0 + tt) * D_ + 384 + c) = (unsigned short)pk4_fp8(o.x, o.y, 0.f, 0.f);
                else *(GAS unsigned*)(Y + (size_t)(t0 + tt) * D_ + 384 + c) = pk2(o.x, o.y); }
        }
#pragma unroll
        for (int i = 0; i < 3; ++i) { const int q = tid + 512 * i, tt = q / 48, o8 = q % 48, pos = s0 + tt; const size_t row = (size_t)(t0 + tt);
            const v4u gb = ya[i][0], x0 = ya[i][1]; v4u x1 = ya[i][2], x2 = ya[i][3];
            if (pos < 1) x1 = (v4u){0u, 0u, 0u, 0u};
            if (pos < 2) x2 = (v4u){0u, 0u, 0u, 0u};
            const f32x4 w2a = *(const f32x4*)(wA + 2 * 384 + o8 * 8), w2b = *(const f32x4*)(wA + 2 * 384 + o8 * 8 + 4);
            const f32x4 w1a = *(const f32x4*)(wA + 1 * 384 + o8 * 8), w1b = *(const f32x4*)(wA + 1 * 384 + o8 * 8 + 4);
            const f32x4 w0a = *(const f32x4*)(wA + o8 * 8), w0b = *(const f32x4*)(wA + o8 * 8 + 4);
            float o[8];
            const unsigned gbw[4] = {gb.x, gb.y, gb.z, gb.w}, x0w[4] = {x0.x, x0.y, x0.z, x0.w}, x1w[4] = {x1.x, x1.y, x1.z, x1.w}, x2w[4] = {x2.x, x2.y, x2.z, x2.w};
            const float w2[8] = {w2a.x, w2a.y, w2a.z, w2a.w, w2b.x, w2b.y, w2b.z, w2b.w}, w1[8] = {w1a.x, w1a.y, w1a.z, w1a.w, w1b.x, w1b.y, w1b.z, w1b.w}, w0[8] = {w0a.x, w0a.y, w0a.z, w0a.w, w0b.x, w0b.y, w0b.z, w0b.w};
#pragma unroll
            for (int e = 0; e < 4; ++e) {
                o[2 * e] = bflo(gbw[e]) * (w2[2 * e] * bflo(x0w[e]) + w1[2 * e] * bflo(x1w[e]) + w0[2 * e] * bflo(x2w[e]));
                o[2 * e + 1] = bfhi(gbw[e]) * (w2[2 * e + 1] * bfhi(x0w[e]) + w1[2 * e + 1] * bfhi(x1w[e]) + w0[2 * e + 1] * bfhi(x2w[e])); }
            if (GEMM2_FP8) { v2u ov; ov.x = pk4_fp8(o[0], o[1], o[2], o[3]); ov.y = pk4_fp8(o[4], o[5], o[6], o[7]); *(GAS v2u*)((unsigned char*)Y + row * D_ + o8 * 8) = ov; }
            else { v4u ov; ov.x = pk2(o[0], o[1]); ov.y = pk2(o[2], o[3]); ov.z = pk2(o[4], o[5]); ov.w = pk2(o[6], o[7]);
            *(GAS v4u*)(Y + row * D_ + o8 * 8) = ov; } }
        __syncthreads();
    }
#undef MIX_PREFETCH
}

__device__ __forceinline__ void top2of4(float q0, float q1, float q2, float q3, float& a1, int& i1, float& a2, int& i2) {
    a1 = q0; i1 = 0; a2 = -1.f; i2 = 1;
#define T2STEP(qv, r) { const bool gt = (qv) > a1; const bool g2 = (qv) > a2; const float na2 = gt ? a1 : (g2 ? (qv) : a2); const int ni2 = gt ? i1 : (g2 ? (r) : i2); \
        a1 = gt ? (qv) : a1; i1 = gt ? (r) : i1; a2 = na2; i2 = ni2; }
    T2STEP(q1, 1) T2STEP(q2, 2) T2STEP(q3, 3)
#undef T2STEP
}
__device__ __forceinline__ void p4_ln_router(Frame& F, const Args& A, int l) {
    LAS unsigned char* lds = F.lds;
    LAS int* cntl = (LAS int*)(lds + 66048); LAS int* basel = cntl + 32; LAS int* sel = cntl + 64; LAS int* lpos = cntl + 64 + 256;
    const bf16* U = (const bf16*)(F.ws + WS_U); bf16* HB = (bf16*)(F.ws + WS_HB); unsigned char* H8 = F.ws + WS_H8; const bf16* WRT = (const bf16*)(F.ws + WS_WRT);
    int* route = (int*)(F.ws + WS_ROUTE); int* lists = (int*)(F.ws + WS_LISTS);
    unsigned* counts = F.ctl + CW_CNT + l * 32 * 64;
    const float* g = A.in[I_LMG] + l * D_; const float* b = A.in[I_LMB] + l * D_; const float* rb = A.in[I_RB];
    int tid = F.tid; asm volatile("" : "+v"(tid));
    const int lane = tid & 63, wave = F.wave, fr = lane & 15, fq = lane >> 4;
    for (int q = tid; q < 32 * 128; q += 512) { const int e = q >> 7, c = q & 127; *(LAS v4u*)(lds + e * 2064 + c * 16) = *(const GAS v4u*)(WRT + e * 1024 + c * 8); }
    if (tid < 32) cntl[tid] = 0;
    f32x4 gv[4], bv[4];
#pragma unroll
    for (int j = 0; j < 4; ++j) { gv[j] = *(const f32x4*)(g + 4 * lane + 256 * j); bv[j] = *(const f32x4*)(b + 4 * lane + 256 * j); }
    __syncthreads();
    for (int blk = F.vcu; blk < T_ / 128; blk += F.G) {
#pragma unroll 1
        for (int i = 0; i < 16; i += 4) { const size_t m = (size_t)(blk * 128 + wave * 16 + i);
            v2u q[4][4];
#pragma unroll
            for (int u = 0; u < 4; ++u) { const GAS v2u* up = (const GAS v2u*)(U + (m + u) * D_) + lane;
#pragma unroll
                for (int j = 0; j < 4; ++j) q[u][j] = up[64 * j]; }
#pragma unroll
            for (int u = 0; u < 4; ++u) { f32x4 v[4]; float s = 0.f;
#pragma unroll
                for (int j = 0; j < 4; ++j) { v[j] = (f32x4){bflo(q[u][j].x), bfhi(q[u][j].x), bflo(q[u][j].y), bfhi(q[u][j].y)}; s += (v[j].x + v[j].y) + (v[j].z + v[j].w); }
                const float mean = wave_sum(s) * (1.f / D_); float s2 = 0.f;
#pragma unroll
                for (int j = 0; j < 4; ++j) { v[j] = v[j] - mean; s2 += (v[j].x * v[j].x + v[j].y * v[j].y) + (v[j].z * v[j].z + v[j].w * v[j].w); }
                const float rstd = __builtin_amdgcn_rsqf(wave_sum(s2) * (1.f / D_) + LN_EPS);
                GAS v2u* o8 = (GAS v2u*)(HB + (m + u) * D_) + lane; GAS unsigned* o4 = (GAS unsigned*)(H8 + (m + u) * D_) + lane;
#pragma unroll
                for (int j = 0; j < 4; ++j) { const f32x4 o = v[j] * rstd * gv[j] + bv[j]; v2u w; w.x = pk2(o.x, o.y); w.y = pk2(o.z, o.w); o8[64 * j] = w; o4[64 * j] = pk4_fp8(o.x, o.y, o.z, o.w); } }
        }
        VM_WAIT(); asm volatile("" ::: "memory");
        const int token = blk * 128 + wave * 16 + fr;
        f32x4 acc0 = (f32x4){0.f, 0.f, 0.f, 0.f}, acc1 = (f32x4){0.f, 0.f, 0.f, 0.f};
        const bf16* hrow = HB + (size_t)token * D_ + fq * 8;
#pragma unroll 16
        for (int k = 0; k < 32; ++k) { const int kk = k * 32 + fq * 8;
            const bf16x8 hf = *(const GAS bf16x8*)(hrow + k * 32);
            const bf16x8 w0 = *(const LAS bf16x8*)(lds + fr * 2064 + kk * 2), w1 = *(const LAS bf16x8*)(lds + (16 + fr) * 2064 + kk * 2);
            acc0 = __builtin_amdgcn_mfma_f32_16x16x32_bf16(w0, hf, acc0, 0, 0, 0);
            acc1 = __builtin_amdgcn_mfma_f32_16x16x32_bf16(w1, hf, acc1, 0, 0, 0);
        }
        float p0[4], p1[4]; float mx = -3.0e38f;
#pragma unroll
        for (int r = 0; r < 4; ++r) { p0[r] = acc0[r] + rb[4 * fq + r]; p1[r] = acc1[r] + rb[16 + 4 * fq + r]; mx = fmaxf(mx, fmaxf(p0[r], p1[r])); }
        mx = fmaxf(mx, __shfl_xor(mx, 16)); mx = fmaxf(mx, __shfl_xor(mx, 32));
#pragma unroll
        for (int r = 0; r < 4; ++r) { p0[r] = __expf(p0[r] - mx); p1[r] = __expf(p1[r] - mx); }
        float a1, a2, c1, c2; int ia1, ia2, ic1, ic2;
        top2of4(p0[0], p0[1], p0[2], p0[3], a1, ia1, a2, ia2); top2of4(p1[0], p1[1], p1[2], p1[3], c1, ic1, c2, ic2);
        const float sc0 = a1 + a2, sc1 = c1 + c2;
        float bs = sc0; int bg = fq; if (sc1 > sc0) { bs = sc1; bg = 4 + fq; }
#pragma unroll
        for (int off = 16; off <= 32; off <<= 1) { const float os = __shfl_xor(bs, off); const int og = __shfl_xor(bg, off); if (os > bs || (os == bs && og < bg)) { bs = os; bg = og; } }
        if ((bg & 3) == fq) {
            const bool hi = bg >= 4;
            const float pa = hi ? c1 : a1, pb = hi ? c2 : a2; const int ia = hi ? ic1 : ia1, ib = hi ? ic2 : ia2;
            const int ea = bg * 4 + ia, eb = bg * 4 + ib; const float inv = 1.0f / (pa + pb);
            const int tokl = wave * 16 + fr;
            const int la = atomicAdd((int*)&cntl[ea], 1), lb2 = atomicAdd((int*)&cntl[eb], 1);
            sel[tokl * 2] = ea; sel[tokl * 2 + 1] = eb; lpos[tokl * 2] = la; lpos[tokl * 2 + 1] = lb2;
            int* rt = route + (size_t)token * 8; rt[0] = ea; rt[2] = eb; rt[4] = __float_as_int(pa * inv); rt[5] = __float_as_int(pb * inv);
        }
        __syncthreads();
        if (tid < 32) { const int c = cntl[tid]; basel[tid] = c ? (int)__hip_atomic_fetch_add(counts + tid * 64, (unsigned)c, RLX_AGENT) : 0; }
        __syncthreads();
        if (tid < 256) { const int tokl = tid >> 1, k = tid & 1, e = sel[tid], pos = basel[e] + lpos[tid], tok = blk * 128 + tokl;
            lists[(size_t)e * 65536 + pos] = tok * 2 + k; route[(size_t)tok * 8 + 1 + 2 * k] = pos; }
        __syncthreads();
        if (tid < 32) cntl[tid] = 0;
        __syncthreads();
    }
}

__device__ __forceinline__ void moe_table(Frame& F, int l) {
    LAS int* tab = (LAS int*)(F.lds + TAB_OFF);
    __syncthreads();
    if (F.tid < 32) tab[40 + F.tid] = (int)__hip_atomic_load(F.ctl + CW_CNT + (l * 32 + F.tid) * 64, RLX_AGENT);
    __syncthreads();
    if (F.tid == 0) { int s = 0; for (int e = 0; e < 32; ++e) { tab[e] = s; s += (tab[40 + e] + 255) >> 8; } tab[32] = s; }
    __syncthreads();
    for (int t = F.tid; t < tab[32]; t += NWAVES * 64) { int e = 0; while (e < 31 && tab[e + 1] <= t) ++e; tab[80 + t] = e; }
    __syncthreads();
}

__device__ __forceinline__ void p7_combine_ln(Frame& F, const Args& A, int l) {
    const LAS int* tab = (const LAS int*)(F.lds + TAB_OFF);
    bf16* HB = (bf16*)(F.ws + WS_HB); const unsigned char* Y2S = F.ws + WS_Y2S; const int* route = (const int*)(F.ws + WS_ROUTE);
    const float* g = A.in[I_LFG] + l * D_; const float* b = A.in[I_LFB] + l * D_;
    int lane = F.lane; asm volatile("" : "+v"(lane));
    const int gw = F.vcu * NWAVES + F.wave, NGW = F.G * NWAVES;
    f32x4 gv[4], bv[4];
#pragma unroll
    for (int j = 0; j < 4; ++j) { gv[j] = *(const f32x4*)(g + 4 * lane + 256 * j); bv[j] = *(const f32x4*)(b + 4 * lane + 256 * j); }
    const bool last = (l == NL - 1);
    const int step = NGW * 2;
    int R[2][6], Rn[2][6];
    v2u hq[2][4], hn[2][4]; unsigned aq[2][4], cq[2][4], an[2][4], cn[2][4];
#define P7_ROUTE(m0_, R_) do { _Pragma("unroll") for (int _u = 0; _u < 2; ++_u) { const int* _rt = route + (size_t)((m0_) + _u) * 8; \
        _Pragma("unroll") for (int _k = 0; _k < 6; ++_k) R_[_u][_k] = _rt[_k]; } } while (0)
#define P7_ROWS(m0_, R_, hq_, aq_, cq_) do { _Pragma("unroll") for (int _u = 0; _u < 2; ++_u) { const int _m = (m0_) + _u; \
        const size_t _r0 = (size_t)tab[R_[_u][0]] * 256 + R_[_u][1], _r1 = (size_t)tab[R_[_u][2]] * 256 + R_[_u][3]; \
        const GAS v2u* _hp = (const GAS v2u*)(HB + (size_t)_m * D_) + lane; const GAS unsigned* _ya = (const GAS unsigned*)(Y2S + _r0 * D_) + lane; const GAS unsigned* _yb = (const GAS unsigned*)(Y2S + _r1 * D_) + lane; \
        _Pragma("unroll") for (int _j = 0; _j < 4; ++_j) { hq_[_u][_j] = _hp[64 * _j]; aq_[_u][_j] = _ya[64 * _j]; cq_[_u][_j] = _yb[64 * _j]; } } } while (0)
    int m0 = gw * 2;
    if (m0 < T_) { P7_ROUTE(m0, R); P7_ROWS(m0, R, hq, aq, cq); if (m0 + step < T_) P7_ROUTE(m0 + step, Rn); }
    for (; m0 < T_; m0 += step) {
        const bool has_n = m0 + step < T_;
        int Rnn[2][6];
        if (has_n) P7_ROWS(m0 + step, Rn, hn, an, cn);
        if (m0 + 2 * step < T_) P7_ROUTE(m0 + 2 * step, Rnn);
#pragma unroll
        for (int u = 0; u < 2; ++u) { const int m = m0 + u; f32x4 v[4]; float s = 0.f; const float g0 = __int_as_float(R[u][4]), g1 = __int_as_float(R[u][5]);
#pragma unroll
            for (int j = 0; j < 4; ++j) { const v2u h = hq[u][j]; const unsigned a = aq[u][j], c = cq[u][j];
                const f32x2 a01 = __builtin_amdgcn_cvt_pk_f32_fp8((int)a, false), a23 = __builtin_amdgcn_cvt_pk_f32_fp8((int)a, true), c01 = __builtin_amdgcn_cvt_pk_f32_fp8((int)c, false), c23 = __builtin_amdgcn_cvt_pk_f32_fp8((int)c, true);
                v[j].x = ALPHA * bflo(h.x) + g0 * a01.x + g1 * c01.x; v[j].y = ALPHA * bfhi(h.x) + g0 * a01.y + g1 * c01.y;
                v[j].z = ALPHA * bflo(h.y) + g0 * a23.x + g1 * c23.x; v[j].w = ALPHA * bfhi(h.y) + g0 * a23.y + g1 * c23.y;
                s += (v[j].x + v[j].y) + (v[j].z + v[j].w); }
            const float mean = wave_sum(s) * (1.f / D_); float s2 = 0.f;
#pragma unroll
            for (int j = 0; j < 4; ++j) { v[j] = v[j] - mean; s2 += (v[j].x * v[j].x + v[j].y * v[j].y) + (v[j].z * v[j].z + v[j].w * v[j].w); }
            const float rstd = __builtin_amdgcn_rsqf(wave_sum(s2) * (1.f / D_) + LN_EPS);
            if (last) { GAS f32x4* o = (GAS f32x4*)(A.out + (size_t)m * D_) + lane;
#pragma unroll
                for (int j = 0; j < 4; ++j) o[64 * j] = v[j] * rstd * gv[j] + bv[j];
            } else { GAS v2u* o8 = (GAS v2u*)(HB + (size_t)m * D_) + lane; float amax = 0.f;
#pragma unroll
                for (int j = 0; j < 4; ++j) { const f32x4 o = v[j] * rstd * gv[j] + bv[j]; v[j] = o; v2u w; w.x = pk2(o.x, o.y); w.y = pk2(o.z, o.w); o8[64 * j] = w;
                    amax = fmaxf(amax, fmaxf(fmaxf(fabsf(o.x), fabsf(o.y)), fmaxf(fabsf(o.z), fabsf(o.w)))); }
                if (GEMM1_I8) { amax = wave_max(amax); const float inv = amax > 0.f ? 127.f / amax : 0.f;
                    GAS unsigned* q4 = (GAS unsigned*)(F.ws + WS_HQ + (size_t)m * D_) + lane;
#pragma unroll
                    for (int j = 0; j < 4; ++j) q4[64 * j] = pk4_i8(v[j].x * inv, v[j].y * inv, v[j].z * inv, v[j].w * inv);
                    if (lane == 0) ((float*)(F.ws + WS_HS))[m] = amax * (1.f / 127.f); } }
        }
#pragma unroll
        for (int u = 0; u < 2; ++u) {
#pragma unroll
            for (int j = 0; j < 4; ++j) { hq[u][j] = hn[u][j]; aq[u][j] = an[u][j]; cq[u][j] = cn[u][j]; }
#pragma unroll
            for (int k = 0; k < 6; ++k) { R[u][k] = Rn[u][k]; Rn[u][k] = Rnn[u][k]; } }
    }
#undef P7_ROUTE
#undef P7_ROWS
}

#ifndef PH_NOINLINE
#define PH_NOINLINE __forceinline__
#endif
PH_NOINLINE __device__ void run_gemm1(LAS unsigned char* lds, unsigned char* ws, int l, int G, int c) {
    pg8::DenseOrder S;
    if (GEMM1_I8) { S.init(ws + WS_HQ, ws + WS_WIN + (size_t)l * N1 * 1024, T_, N1, D_ / 2, G, c, 1);
        pg8::EpiZq E{(bf16*)(ws + WS_Z), (const float*)(ws + WS_HS), (const float*)((unsigned*)(ws + WS_CTL) + CW_CMAX) + l * N1}; pg8::gemm_phase<pg8::EpiZq, pg8::DenseOrder, 2>(lds, S, E); }
    else { S.init(ws + WS_HB, ws + WS_WIN + (size_t)l * N1 * 1024 * 2, T_, N1, D_, G, c, 1); pg8::EpiZ E{(bf16*)(ws + WS_Z)}; pg8::gemm_phase(lds, S, E); }
}
PH_NOINLINE __device__ void run_gemm_probe(LAS unsigned char* lds, unsigned char* ws, int G, int c) {
    pg8::DenseOrder S; S.init(ws + WS_HB, ws + WS_WIN, T_, 256 * (PROBE_EXTRA_NN ? PROBE_EXTRA_NN : 1), D_, G, c);
    pg8::EpiPlain E{(bf16*)(ws + WS_Y), 2048};
    pg8::gemm_phase(lds, S, E);
}
PH_NOINLINE __device__ void run_gemm2(LAS unsigned char* lds, unsigned char* ws, int l, int G, int c) {
    pg8::EpiU E{(const bf16*)(ws + WS_HB), (bf16*)(ws + WS_U)};
    if (GEMM2_FP8) { pg8::DenseRowsOrder S; int kq = D_ / 2; asm volatile("" : "+s"(kq)); S.init(ws + WS_Y, ws + WS_WOUT + (size_t)l * 1024 * 1024, T_, D_, kq, G, c); pg8::gemm_phase<pg8::EpiU, pg8::DenseRowsOrder, true>(lds, S, E); }
    else { pg8::DenseOrder S; S.init(ws + WS_Y, ws + WS_WOUT + (size_t)l * 1024 * 1024 * 2, T_, D_, D_, G, c); pg8::gemm_phase(lds, S, E); }
}
PH_NOINLINE __device__ void run_gemm5(LAS unsigned char* lds, unsigned char* ws, int l, int G, int c) {
    const LAS int* tab = (const LAS int*)(lds + TAB_OFF);
    pg8::MoeGatherOrder S; S.A = (const char*)(ws + WS_H8); S.Bt = (const char*)(ws + WS_WGU + (size_t)l * NE * 1024 * 1024); S.bexp = (size_t)1024 * 1024;
    int kq = D_ / 2; asm volatile("" : "+s"(kq));
    S.K = kq; S.nN = 4; S.nwg = tab[32] * 4; S.G = G; S.c = c; S.tab = tab; S.lists = (const int*)(ws + WS_LISTS);
    pg8::EpiHid E{ws + WS_HID};
    pg8::gemm_phase<pg8::EpiHid, pg8::MoeGatherOrder, true>(lds, S, E);
}
PH_NOINLINE __device__ void run_gemm6(LAS unsigned char* lds, unsigned char* ws, int l, int G, int c) {
    const LAS int* tab = (const LAS int*)(lds + TAB_OFF);
    pg8::MoeRowsOrder S; S.A = (const char*)(ws + WS_HID); S.Bt = (const char*)(ws + WS_WD + (size_t)l * NE * 1024 * 512); S.bexp = (size_t)1024 * 512;
    int kq = DE / 2; asm volatile("" : "+s"(kq));
    S.K = kq; S.nN = 4; S.nwg = tab[32] * 4; S.G = G; S.c = c; S.tab = tab; S.lists = nullptr;
    pg8::EpiPlain8 E{ws + WS_Y2S, D_};
    pg8::gemm_phase<pg8::EpiPlain8, pg8::MoeRowsOrder, true>(lds, S, E);
}

__global__ void __launch_bounds__(NWAVES * 64, 2) mk_fwd(Args args) {
    extern __shared__ __attribute__((aligned(16))) unsigned char lds_raw[];
    Frame F;
    F.lds = (LAS unsigned char*)lds_raw;
    F.tid = threadIdx.x; F.lane = F.tid & 63; F.wave = __builtin_amdgcn_readfirstlane(F.tid >> 6);
    F.G = gridDim.x; { const int bx = blockIdx.x; F.vcu = (F.G % 8 == 0) ? (bx % 8) * (F.G / 8) + bx / 8 : bx; }
    F.ws = args.ws; F.ctl = (unsigned*)(args.ws + WS_CTL);
    for (int u = F.tid; u < (LDS_BYTES - LDSCTL_OFF) / 4; u += NWAVES * 64) ((LAS unsigned*)(F.lds + LDSCTL_OFF))[u] = 0u;
    __syncthreads();
    volatile LAS unsigned* MISC = (volatile LAS unsigned*)(F.lds + MISC_OFF);
    XcdBarrier bar; bar.bar = F.ctl + CW_BAR; bar.x = 0; bar.st = nullptr;
    if (MK_N_LAUNCHES == 1) bar = xcd_barrier_post(F.ctl + CW_BAR, MISC + 8);
    const int lo = args.ph_lo, hi = args.ph_hi;
#define IN(k) (lo <= (k) && (k) < hi)
#define SEAM(k) do { if (MK_N_LAUNCHES == 1 && (k) + 1 < hi) xcd_barrier(bar); } while (0)
    if (REPEAT_MASK & 256) { for (int rep = 0; rep < 10; ++rep) xcd_barrier(bar); }
    if ((PH_MASK & 1) && IN(0)) { for (int rep = 0; rep < ((REPEAT_MASK & 1) ? 2 : 1); ++rep) { p0_prologue(F, args); SEAM(0); } }
#pragma unroll 1
    for (int l = 0; l < NL; ++l) {
        const int pb = 1 + 7 * l;
        if ((PH_MASK & 2) && IN(pb + 0)) { for (int rep = 0; rep < ((REPEAT_MASK & 2) ? 2 : 1); ++rep) { run_gemm1(F.lds, F.ws, l, F.G, (int)blockIdx.x); SEAM(pb + 0); }
            if (PROBE_EXTRA_NN && l == 0) { run_gemm_probe(F.lds, F.ws, F.G, (int)blockIdx.x); xcd_barrier(bar); } }
        if ((PH_MASK & 4) && IN(pb + 1)) { for (int rep = 0; rep < ((REPEAT_MASK & 4) ? 2 : 1); ++rep) { p2_mixer(F, args, l); SEAM(pb + 1); } }
        if ((PH_MASK & 8) && IN(pb + 2)) { for (int rep = 0; rep < ((REPEAT_MASK & 8) ? 2 : 1); ++rep) { run_gemm2(F.lds, F.ws, l, F.G, (int)blockIdx.x); SEAM(pb + 2); } }
        if ((PH_MASK & 16) && IN(pb + 3)) {
            if (REPEAT_MASK & 16) { p4_ln_router(F, args, l); SEAM(pb + 3);
                if (blockIdx.x == 0 && F.tid < 32) __hip_atomic_store(F.ctl + CW_CNT + (l * 32 + F.tid) * 64, 0u, RLX_AGENT);
                SEAM(pb + 3); }
            p4_ln_router(F, args, l); SEAM(pb + 3); }
        if ((PH_MASK & 32) && IN(pb + 4)) { for (int rep = 0; rep < ((REPEAT_MASK & 32) ? 2 : 1); ++rep) { moe_table(F, l); run_gemm5(F.lds, F.ws, l, F.G, (int)blockIdx.x); SEAM(pb + 4); } }
        if ((PH_MASK & 64) && IN(pb + 5)) { for (int rep = 0; rep < ((REPEAT_MASK & 64) ? 2 : 1); ++rep) { if (MK_N_LAUNCHES != 1 || rep) moe_table(F, l); run_gemm6(F.lds, F.ws, l, F.G, (int)blockIdx.x); SEAM(pb + 5); } }
        if ((PH_MASK & 128) && IN(pb + 6)) { for (int rep = 0; rep < (((REPEAT_MASK & 128) && l == NL - 1) ? 2 : 1); ++rep) { if (MK_N_LAUNCHES != 1) moe_table(F, l); p7_combine_ln(F, args, l); if (rep == 0) SEAM(pb + 6); else xcd_barrier(bar); } }
    }
#undef IN
#undef SEAM
}

extern "C" void kernel_launch(void* const* d_in, const int* in_sizes, int n_in, void* d_out, int out_size, void* d_ws, size_t ws_size, hipStream_t stream) {
    static int grid = 0;
    if (grid == 0) {
        if (n_in != 21 || out_size != T_ * D_ || ws_size < WS_END) { fprintf(stderr, "kernel_launch: unexpected problem (n_in %d, out %d, ws %zu); nothing launched\n", n_in, out_size, ws_size); grid = -1; return; }
        int dev = 0, cus = 0, per_cu = 0;
        if (hipGetDevice(&dev) != hipSuccess || hipDeviceGetAttribute(&cus, hipDeviceAttributeMultiprocessorCount, dev) != hipSuccess) { grid = -1; return; }
        if (hipFuncSetAttribute((const void*)mk_fwd, hipFuncAttributeMaxDynamicSharedMemorySize, LDS_BYTES) != hipSuccess) { fprintf(stderr, "kernel_launch: hipFuncSetAttribute failed\n"); grid = -1; return; }
        if (hipOccupancyMaxActiveBlocksPerMultiprocessor(&per_cu, (const void*)mk_fwd, NWAVES * 64, LDS_BYTES) != hipSuccess || per_cu < 1) { fprintf(stderr, "kernel_launch: occupancy query says %d\n", per_cu); }
        (void)hipGetLastError();
        grid = cus;
    }
    if (grid < 0) return;
    (void)hipMemsetAsync((char*)d_ws + WS_CTL, 0, CTL_ZERO_BYTES, stream);
    Args a{};
    for (int i = 0; i < 21; ++i) a.in[i] = (const float*)d_in[i];
    a.out = (float*)d_out; a.ws = (unsigned char*)d_ws;
    if (MK_N_LAUNCHES == 1) { a.ph_lo = 0; a.ph_hi = NPH; hipLaunchKernelGGL(mk_fwd, dim3(grid), dim3(NWAVES * 64), LDS_BYTES, stream, a); }
    else for (int p = 0; p < NPH; ++p) { a.ph_lo = p; a.ph_hi = p + 1; hipLaunchKernelGGL(mk_fwd, dim3(grid), dim3(NWAVES * 64), LDS_BYTES, stream, a); }
}
```

```cpp
#include <hip/hip_runtime.h>
#include <cstdio>
#include <cstdint>

#ifndef MK_N_LAUNCHES
#define MK_N_LAUNCHES 1
#endif
#ifndef PH_MASK
#define PH_MASK 0xff
#endif
#ifndef REPEAT_MASK
#define REPEAT_MASK 0
#endif
#ifndef GEMM1_I8
#define GEMM1_I8 1
#endif
#ifndef GEMM2_FP8
#define GEMM2_FP8 1
#endif
#ifndef PROBE_P0
#define PROBE_P0 0
#endif
#ifndef PROBE_MIX
#define PROBE_MIX 0
#endif
#ifndef PROBE_EXTRA_NN
#define PROBE_EXTRA_NN 0
#endif
#ifndef GEMM_SIMPLE_MASK
#define GEMM_SIMPLE_MASK 0
#endif

#define GAS __attribute__((address_space(1)))
#define LAS __attribute__((address_space(3)))
typedef unsigned short bf16;
typedef unsigned v4u __attribute__((ext_vector_type(4)));
typedef unsigned v2u __attribute__((ext_vector_type(2)));
typedef float f32x4 __attribute__((ext_vector_type(4)));
typedef float f32x2 __attribute__((ext_vector_type(2)));
typedef short bf16x8 __attribute__((ext_vector_type(8)));
#define RLX_AGENT __ATOMIC_RELAXED, __HIP_MEMORY_SCOPE_AGENT
#define LDS_WAIT() asm volatile("s_waitcnt lgkmcnt(0)" ::: "memory")
#define VM_WAIT() asm volatile("s_waitcnt vmcnt(0)" ::: "memory")

constexpr int T_ = 32768, D_ = 1024, SEQ_ = 4096, NL = 2, NE = 32, DE = 512;
constexpr int DIN = 2176, N1 = 2304, NZ = 1408;
constexpr float ALPHA = 1.41421356237f, LN_EPS = 1e-5f;
constexpr int NPH = 1 + 7 * NL;

constexpr size_t MiB = 1u << 20;
constexpr size_t WS_CTL = 0, CTL_ZERO_BYTES = 128 * 1024;
constexpr size_t WS_ROUTE = 1 * MiB;
constexpr size_t WS_WRT = 2 * MiB;
constexpr size_t WS_HS = 2 * MiB + 256 * 1024;
constexpr size_t WS_CS = 2 * MiB + 512 * 1024;
constexpr size_t WS_LISTS = 3 * MiB;
constexpr size_t WS_WIN = 11 * MiB;
constexpr size_t WS_WOUT = 20 * MiB;
constexpr size_t WS_WGU = 24 * MiB;
constexpr size_t WS_H8 = 88 * MiB;
constexpr size_t WS_HQ = 120 * MiB;
constexpr size_t WS_WD = 152 * MiB;
constexpr size_t WS_HB = 216 * MiB;
constexpr size_t WS_Z = 280 * MiB;
constexpr size_t WS_Y = 368 * MiB;
constexpr size_t WS_U = 280 * MiB;
constexpr size_t WS_HID = 280 * MiB;
constexpr size_t WS_Y2S = 352 * MiB;
constexpr size_t WS_END = 496 * MiB;
constexpr int CW_TMO = 0, CW_BAR = 4096, CW_CNT = 16384, CW_CMAX = 20480  , CW_CMAXCNT = 25600;

constexpr int RING_BYTES = 131072, LDSCTL_OFF = RING_BYTES, MISC_OFF = LDSCTL_OFF + 320, TAB_OFF = LDSCTL_OFF + 1024;
constexpr int LDS_BYTES = 147456;

__device__ __forceinline__ unsigned f2bf(float f) { unsigned u = __builtin_bit_cast(unsigned, f); return (u + 0x7fffu + ((u >> 16) & 1u)) >> 16; }
__device__ __forceinline__ unsigned pk2(float lo, float hi) { unsigned r; asm("v_cvt_pk_bf16_f32 %0, %1, %2" : "=v"(r) : "v"(lo), "v"(hi)); return r; }
__device__ __forceinline__ float bflo(unsigned u) { return __builtin_bit_cast(float, u << 16); }
__device__ __forceinline__ float bfhi(unsigned u) { return __builtin_bit_cast(float, u & 0xffff0000u); }
template <int CTRL> __device__ __forceinline__ float dpp_mov(float v) { return __builtin_bit_cast(float, __builtin_amdgcn_update_dpp(0, __builtin_bit_cast(int, v), CTRL, 0xf, 0xf, false)); }
__device__ __forceinline__ float wave_sum(float v) {
    v += dpp_mov<0xB1>(v); v += dpp_mov<0x4E>(v); v += dpp_mov<0x141>(v); v += dpp_mov<0x140>(v);
    const int iv = __builtin_bit_cast(int, v);
    return (__builtin_bit_cast(float, __builtin_amdgcn_readlane(iv, 0)) + __builtin_bit_cast(float, __builtin_amdgcn_readlane(iv, 16))) +
           (__builtin_bit_cast(float, __builtin_amdgcn_readlane(iv, 32)) + __builtin_bit_cast(float, __builtin_amdgcn_readlane(iv, 48)));
}
__device__ __forceinline__ float wave_max(float v) {
    v = fmaxf(v, dpp_mov<0xB1>(v)); v = fmaxf(v, dpp_mov<0x4E>(v)); v = fmaxf(v, dpp_mov<0x141>(v)); v = fmaxf(v, dpp_mov<0x140>(v));
    const int iv = __builtin_bit_cast(int, v);
    return fmaxf(fmaxf(__builtin_bit_cast(float, __builtin_amdgcn_readlane(iv, 0)), __builtin_bit_cast(float, __builtin_amdgcn_readlane(iv, 16))),
                 fmaxf(__builtin_bit_cast(float, __builtin_amdgcn_readlane(iv, 32)), __builtin_bit_cast(float, __builtin_amdgcn_readlane(iv, 48))));
}
__device__ __forceinline__ unsigned pk4_i8(float a, float b, float c, float d) {
    const int ia = (int)__builtin_rintf(a), ib = (int)__builtin_rintf(b), ic = (int)__builtin_rintf(c), id = (int)__builtin_rintf(d);
    return ((unsigned)ia & 0xffu) | (((unsigned)ib & 0xffu) << 8) | (((unsigned)ic & 0xffu) << 16) | ((unsigned)id << 24); }
__device__ __forceinline__ unsigned pk4_fp8(float a, float b, float c, float d) {
    int v = 0; v = __builtin_amdgcn_cvt_pk_fp8_f32(a, b, v, false); v = __builtin_amdgcn_cvt_pk_fp8_f32(c, d, v, true); return (unsigned)v; }
__device__ __forceinline__ float sigmoidf_(float x) { return __builtin_amdgcn_rcpf(1.0f + __expf(-x)); }

namespace pg8 {
#define PG8_LAS __attribute__((address_space(3)))
typedef int v8i __attribute__((ext_vector_type(8)));
typedef int v4i __attribute__((ext_vector_type(4)));
constexpr int BM = 256, BK = 64, HALF = 128, HTB = HALF * BK * 2, STAGE_BYTES = 8 * HTB, NXCD = 8, WGM = 8;
__host__ __device__ __forceinline__ int lds_byte(int r, int c) { const int st = (r >> 4) * 2 + (c >> 5), rr = r & 15, cc = c & 31, ob = rr * 64 + cc * 2; return st * 1024 + (ob ^ (((ob >> 9) & 1) << 5)); }
__host__ __device__ __forceinline__ void stage_rc(int b, int& R, int& C) { const int st = b / 1024, sb = b % 1024, swz = sb ^ (((sb >> 9) & 1) << 5); R = (st >> 1) * 16 + swz / 64; C = (st & 1) * 32 + (swz % 64) / 2; }
__host__ __device__ __forceinline__ int perm32(int rho) { const int n = rho >> 4, i = rho & 15; return 8 * (i >> 2) + 4 * n + (i & 3); }

struct Unit { int pm, pn, e, j, rh; };

__device__ __forceinline__ int xcd_remap(int wgid, int nwg) { const int q = nwg / NXCD, r = nwg % NXCD, xcd = wgid % NXCD, off = wgid / NXCD; return (xcd < r ? xcd * (q + 1) : r * (q + 1) + (xcd - r) * q) + off; }

struct DenseOrder {
    static constexpr bool GATHER = false, HAS_HALF = true, HAS_RH = false;
    const char* A; const char* Bt; int K, nM, nN, nwg, G, c, nhalf;
    __device__ void init(const void* A_, const void* Bt_, int M, int N, int K_, int G_, int c_, int half_tile = 0) { A = (const char*)A_; Bt = (const char*)Bt_; K = K_; nM = M / BM; nN = N / BM - half_tile; nwg = nM * nN; G = G_; c = c_; nhalf = half_tile ? nM : 0; }
    __device__ bool next(int i, Unit& u) const {
        const long L = (long)i * G + c; if (L >= nwg + nhalf) return false;
        u.e = 0; u.j = 0; u.rh = -1;
        if (L >= nwg) { u.pm = (int)(L - nwg); u.pn = nN; return true; }
        const int wgid = xcd_remap((int)L, nwg);
        const int nig = WGM * nN, gid = wgid / nig, fm = gid * WGM, gsz = (nM - fm) < WGM ? (nM - fm) : WGM;
        u.pm = fm + ((wgid % nig) % gsz); u.pn = (wgid % nig) / gsz; return true;
    }
    __device__ __forceinline__ bool is_half(const Unit& u) const { return u.pn >= nN; }
    __device__ __forceinline__ int row_half(const Unit&) const { return -1; }
    __device__ __forceinline__ const char* a_tile(const Unit& u) const { return A + (size_t)u.pm * BM * K * 2; }
    __device__ __forceinline__ const char* b_tile(const Unit& u) const { return Bt + (size_t)u.pn * BM * K * 2; }
    __device__ __forceinline__ unsigned a_row_off(const Unit&, int r) const { return (unsigned)(r * K * 2); }
};
struct DenseRowsOrder : DenseOrder {
    static constexpr bool GATHER = true, HAS_HALF = false;
    __device__ __forceinline__ const char* a_tile(const Unit&) const { return A; }
    __device__ __forceinline__ unsigned a_row_off(const Unit& u, int r) const { return (unsigned)(u.pm * BM + r) * (unsigned)(K * 2); }
};
struct MoeOrder {
    static constexpr bool HAS_HALF = false, HAS_RH = true;
    __device__ __forceinline__ bool is_half(const Unit&) const { return false; }
    const char* A; const char* Bt; size_t bexp; int K, nN, nwg, G, c; const PG8_LAS int* tab; const int* lists;
    __device__ bool next(int i, Unit& u) const {
        const int L = i * G + c, nfull = (nwg / G) * G, rem = nwg - nfull;
        int uidx = L; u.rh = -1;
        if (L >= nfull) { if (2 * rem <= G) { if (L >= nfull + 2 * rem) return false; uidx = nfull + ((L - nfull) >> 1); u.rh = (L - nfull) & 1; } else if (L >= nwg) return false; }
        const int wgid = xcd_remap(uidx, nwg);
        const int t = wgid / nN; u.pn = wgid % nN; u.pm = t;
        const int e = tab[80 + t];
        u.e = e; u.j = t - tab[e]; return true;
    }
    __device__ __forceinline__ int row_half(const Unit& u) const { return u.rh; }
    __device__ __forceinline__ const char* b_tile(const Unit& u) const { return Bt + (size_t)u.e * bexp + (size_t)u.pn * BM * K * 2; }
};
struct MoeGatherOrder : MoeOrder {
    static constexpr bool GATHER = true;
    __device__ __forceinline__ const char* a_tile(const Unit&) const { return A; }
    __device__ __forceinline__ unsigned a_row_off(const Unit& u, int r) const {
        const int idx = u.j * BM + r, cnt = tab[40 + u.e];
        const int ii = idx < cnt ? idx : cnt - 1;
        const int tok = lists[(size_t)u.e * 65536 + ii] >> 1;
        return (unsigned)tok * (unsigned)(K * 2);
    }
};
struct MoeRowsOrder : MoeOrder {
    static constexpr bool GATHER = true;
    __device__ __forceinline__ const char* a_tile(const Unit&) const { return A; }
    __device__ __forceinline__ unsigned a_row_off(const Unit& u, int r) const { return (unsigned)(u.pm * BM + r) * (unsigned)(K * 2); }
};
struct MoeDenseOrder : MoeOrder {
    static constexpr bool GATHER = false;
    __device__ __forceinline__ const char* a_tile(const Unit& u) const { return A + (size_t)u.pm * BM * K * 2; }
    __device__ __forceinline__ unsigned a_row_off(const Unit&, int r) const { return (unsigned)(r * K * 2); }
};

__device__ __forceinline__ unsigned cvt_pk_bf16(float lo, float hi) { unsigned r; asm volatile("v_cvt_pk_bf16_f32 %0, %1, %2" : "=v"(r) : "v"(lo), "v"(hi)); return r; }

struct EpiZ {
    static constexpr bool PERM = true;
    bf16* Z;
    __device__ __forceinline__ void operator()(const f32x4 (&acc)[2][2][4][2], const Unit& u, int wr, int wc, int fr, int fq) const {
        const int row0 = u.pm * BM + wr * 64 + fr, cl = wc * 32 + 8 * fq;
        if (u.pn < 6) {
            const bool sg = u.pn >= 3;
            const int zc = (sg ? 768 + (u.pn - 3) * 128 : 384 + u.pn * 128) + cl;
#pragma unroll
            for (int ai = 0; ai < 2; ++ai)
#pragma unroll
                for (int m = 0; m < 4; ++m) {
                    f32x4 a0 = acc[ai][0][m][0], a1 = acc[ai][0][m][1], g0 = acc[ai][1][m][0], g1 = acc[ai][1][m][1];
                    if (sg) {
#pragma unroll
                        for (int q = 0; q < 4; ++q) { g0[q] = sigmoidf_(g0[q]); g1[q] = sigmoidf_(g1[q]); }
                    }
                    a0 = a0 * g0; a1 = a1 * g1;
                    v4u w; w.x = cvt_pk_bf16(a0[0], a0[1]); w.y = cvt_pk_bf16(a0[2], a0[3]); w.z = cvt_pk_bf16(a1[0], a1[1]); w.w = cvt_pk_bf16(a1[2], a1[3]);
                    *(v4u*)(Z + (size_t)(row0 + ai * HALF + m * 16) * NZ + zc) = w;
                }
        } else {
            int zb0, zb1;
            if (u.pn == 6) { zb0 = 0; zb1 = 128; } else if (u.pn == 7) { zb0 = 256; zb1 = 1152; } else { zb0 = 1280; zb1 = -1; }
#pragma unroll
            for (int ai = 0; ai < 2; ++ai)
#pragma unroll
                for (int m = 0; m < 4; ++m) {
                    bf16* rowp = Z + (size_t)(row0 + ai * HALF + m * 16) * NZ + cl;
#pragma unroll
                    for (int bj = 0; bj < 2; ++bj) {
                        const int zb = bj ? zb1 : zb0;
                        if (zb >= 0) { const f32x4 a0 = acc[ai][bj][m][0], a1 = acc[ai][bj][m][1];
                            v4u w; w.x = cvt_pk_bf16(a0[0], a0[1]); w.y = cvt_pk_bf16(a0[2], a0[3]); w.z = cvt_pk_bf16(a1[0], a1[1]); w.w = cvt_pk_bf16(a1[2], a1[3]);
                            *(v4u*)(rowp + zb) = w; }
                    }
                }
        }
    }
};
struct EpiZq {
    static constexpr bool PERM = true;
    bf16* Z; const float* hs; const float* cs;
    __device__ __forceinline__ void operator()(f32x4 (&acc)[2][2][4][2], const Unit& u, int wr, int wc, int fr, int fq) const {
        const int row0 = u.pm * BM + wr * 64 + fr, cl = wc * 32 + 8 * fq;
        {
            float rs[2][4]; f32x4 cv[2][2];
#pragma unroll
            for (int ai = 0; ai < 2; ++ai)
#pragma unroll
                for (int m = 0; m < 4; ++m) rs[ai][m] = hs[row0 + ai * HALF + m * 16];
#pragma unroll
            for (int bj = 0; bj < 2; ++bj)
#pragma unroll
                for (int n = 0; n < 2; ++n) cv[bj][n] = *(const f32x4*)(cs + u.pn * BM + bj * HALF + cl + 4 * n) * (1.f / 127.f);
#pragma unroll
            for (int ai = 0; ai < 2; ++ai)
#pragma unroll
                for (int bj = 0; bj < 2; ++bj)
#pragma unroll
                    for (int m = 0; m < 4; ++m)
#pragma unroll
                        for (int n = 0; n < 2; ++n) { const v4i q = __builtin_bit_cast(v4i, acc[ai][bj][m][n]);
                            acc[ai][bj][m][n] = (f32x4){(float)q.x, (float)q.y, (float)q.z, (float)q.w} * rs[ai][m] * cv[bj][n]; }
        }
        if (u.pn < 6) {
            const bool sg = u.pn >= 3;
            const int zc = (sg ? 768 + (u.pn - 3) * 128 : 384 + u.pn * 128) + cl;
#pragma unroll
            for (int ai = 0; ai < 2; ++ai)
#pragma unroll
                for (int m = 0; m < 4; ++m) {
                    f32x4 a0 = acc[ai][0][m][0], a1 = acc[ai][0][m][1], g0 = acc[ai][1][m][0], g1 = acc[ai][1][m][1];
                    if (sg) {
#pragma unroll
                        for (int q = 0; q < 4; ++q) { g0[q] = sigmoidf_(g0[q]); g1[q] = sigmoidf_(g1[q]); }
                    }
                    a0 = a0 * g0; a1 = a1 * g1;
                    v4u w; w.x = cvt_pk_bf16(a0[0], a0[1]); w.y = cvt_pk_bf16(a0[2], a0[3]); w.z = cvt_pk_bf16(a1[0], a1[1]); w.w = cvt_pk_bf16(a1[2], a1[3]);
                    *(v4u*)(Z + (size_t)(row0 + ai * HALF + m * 16) * NZ + zc) = w;
                }
        } else {
            int zb0, zb1;
            if (u.pn == 6) { zb0 = 0; zb1 = 128; } else if (u.pn == 7) { zb0 = 256; zb1 = 1152; } else { zb0 = 1280; zb1 = -1; }
#pragma unroll
            for (int ai = 0; ai < 2; ++ai)
#pragma unroll
                for (int m = 0; m < 4; ++m) {
                    bf16* rowp = Z + (size_t)(row0 + ai * HALF + m * 16) * NZ + cl;
#pragma unroll
                    for (int bj = 0; bj < 2; ++bj) {
                        const int zb = bj ? zb1 : zb0;
                        if (zb >= 0) { const f32x4 a0 = acc[ai][bj][m][0], a1 = acc[ai][bj][m][1];
                            v4u w; w.x = cvt_pk_bf16(a0[0], a0[1]); w.y = cvt_pk_bf16(a0[2], a0[3]); w.z = cvt_pk_bf16(a1[0], a1[1]); w.w = cvt_pk_bf16(a1[2], a1[3]);
                            *(v4u*)(rowp + zb) = w; }
                    }
                }
        }
    }
};
struct EpiU {
    static constexpr bool PERM = true;
    const bf16* H; bf16* U;
    __device__ __forceinline__ void operator()(const f32x4 (&acc)[2][2][4][2], const Unit& u, int wr, int wc, int fr, int fq) const {
        const int row0 = u.pm * BM + wr * 64 + fr, col0 = u.pn * BM + wc * 32 + 8 * fq;
        v4u hh[2][4][2];
#pragma unroll
        for (int ai = 0; ai < 2; ++ai)
#pragma unroll
            for (int m = 0; m < 4; ++m)
#pragma unroll
                for (int bj = 0; bj < 2; ++bj) hh[ai][m][bj] = *(const v4u*)(H + (size_t)(row0 + ai * HALF + m * 16) * D_ + col0 + bj * HALF);
#pragma unroll
        for (int ai = 0; ai < 2; ++ai)
#pragma unroll
            for (int m = 0; m < 4; ++m) {
                const size_t off = (size_t)(row0 + ai * HALF + m * 16) * D_ + col0;
#pragma unroll
                for (int bj = 0; bj < 2; ++bj) {
                    const v4u h = hh[ai][m][bj];
                    const f32x4 a0 = acc[ai][bj][m][0], a1 = acc[ai][bj][m][1];
                    v4u w;
                    w.x = cvt_pk_bf16(ALPHA * bflo(h.x) + a0[0], ALPHA * bfhi(h.x) + a0[1]); w.y = cvt_pk_bf16(ALPHA * bflo(h.y) + a0[2], ALPHA * bfhi(h.y) + a0[3]);
                    w.z = cvt_pk_bf16(ALPHA * bflo(h.z) + a1[0], ALPHA * bfhi(h.z) + a1[1]); w.w = cvt_pk_bf16(ALPHA * bflo(h.w) + a1[2], ALPHA * bfhi(h.w) + a1[3]);
                    *(v4u*)(U + off + bj * HALF) = w;
                }
            }
    }
};
struct EpiHid {
    static constexpr bool PERM = true;
    unsigned char* HID;
    __device__ __forceinline__ void operator()(const f32x4 (&acc)[2][2][4][2], const Unit& u, int wr, int wc, int fr, int fq) const {
        const int row0 = u.pm * BM + wr * 64 + fr, col0 = u.pn * 128 + wc * 32 + 8 * fq;
#pragma unroll
        for (int ai = 0; ai < 2; ++ai) { if (u.rh >= 0 && u.rh != ai) continue;
#pragma unroll
            for (int m = 0; m < 4; ++m) {
                f32x4 g0 = acc[ai][0][m][0], g1 = acc[ai][0][m][1]; const f32x4 u0 = acc[ai][1][m][0], u1 = acc[ai][1][m][1];
#pragma unroll
                for (int q = 0; q < 4; ++q) { g0[q] = g0[q] * sigmoidf_(g0[q]); g1[q] = g1[q] * sigmoidf_(g1[q]); }
                g0 = g0 * u0; g1 = g1 * u1;
                v2u w; w.x = pk4_fp8(g0[0], g0[1], g0[2], g0[3]); w.y = pk4_fp8(g1[0], g1[1], g1[2], g1[3]);
                *(v2u*)(HID + (size_t)(row0 + ai * HALF + m * 16) * DE + col0) = w;
            } }
    }
};
struct EpiPlain8 {
    static constexpr bool PERM = true;
    unsigned char* O; int ldc;
    __device__ __forceinline__ void operator()(const f32x4 (&acc)[2][2][4][2], const Unit& u, int wr, int wc, int fr, int fq) const {
        const int row0 = u.pm * BM + wr * 64 + fr, col0 = u.pn * BM + wc * 32 + 8 * fq;
#pragma unroll
        for (int ai = 0; ai < 2; ++ai) { if (u.rh >= 0 && u.rh != ai) continue;
#pragma unroll
            for (int m = 0; m < 4; ++m) {
                unsigned char* rowp = O + (size_t)(row0 + ai * HALF + m * 16) * ldc + col0;
#pragma unroll
                for (int bj = 0; bj < 2; ++bj) { const f32x4 a0 = acc[ai][bj][m][0], a1 = acc[ai][bj][m][1];
                    v2u w; w.x = pk4_fp8(a0[0], a0[1], a0[2], a0[3]); w.y = pk4_fp8(a1[0], a1[1], a1[2], a1[3]);
                    *(v2u*)(rowp + bj * HALF) = w; }
            } }
    }
};
struct EpiPlain {
    static constexpr bool PERM = true;
    bf16* O; int ldc;
    __device__ __forceinline__ void operator()(const f32x4 (&acc)[2][2][4][2], const Unit& u, int wr, int wc, int fr, int fq) const {
        const int row0 = u.pm * BM + wr * 64 + fr, col0 = u.pn * BM + wc * 32 + 8 * fq;
#pragma unroll
        for (int ai = 0; ai < 2; ++ai)
#pragma unroll
            for (int m = 0; m < 4; ++m) {
                bf16* rowp = O + (size_t)(row0 + ai * HALF + m * 16) * ldc + col0;
#pragma unroll
                for (int bj = 0; bj < 2; ++bj) { const f32x4 a0 = acc[ai][bj][m][0], a1 = acc[ai][bj][m][1];
                    v4u w; w.x = cvt_pk_bf16(a0[0], a0[1]); w.y = cvt_pk_bf16(a0[2], a0[3]); w.z = cvt_pk_bf16(a1[0], a1[1]); w.w = cvt_pk_bf16(a1[2], a1[3]);
                    *(v4u*)(rowp + bj * HALF) = w; }
            }
    }
};

template <class Epi, class Sched>
__device__ __forceinline__ void gemm_phase_simple(const Sched& S, const Epi& E) {
    int tid = threadIdx.x; asm volatile("" : "+v"(tid));
    const int wid = __builtin_amdgcn_readfirstlane(tid >> 6), lane = tid & 63, wr = wid >> 2, wc = wid & 3, fr = lane & 15, fq = lane >> 4;
    const int K = S.K;
    Unit cur;
    for (int ui = 0; S.next(ui, cur); ++ui) {
        f32x4 acc[2][2][4][2];
#pragma unroll
        for (int a = 0; a < 2; ++a)
#pragma unroll
            for (int b = 0; b < 2; ++b)
#pragma unroll
                for (int m = 0; m < 4; ++m)
#pragma unroll
                    for (int n = 0; n < 2; ++n) acc[a][b][m][n] = (f32x4){0.f, 0.f, 0.f, 0.f};
        const char* at = S.a_tile(cur); const char* bt = S.b_tile(cur);
        const char* ap[2][4]; const char* bp[2][2];
#pragma unroll
        for (int ai = 0; ai < 2; ++ai)
#pragma unroll
            for (int m = 0; m < 4; ++m) ap[ai][m] = at + S.a_row_off(cur, ai * HALF + wr * 64 + m * 16 + fr) + fq * 16;
#pragma unroll
        for (int bj = 0; bj < 2; ++bj)
#pragma unroll
            for (int n = 0; n < 2; ++n) { const int rho = n * 16 + fr; bp[bj][n] = bt + (size_t)(bj * HALF + wc * 32 + (Epi::PERM ? perm32(rho) : rho)) * K * 2 + fq * 16; }
        for (int k0 = 0; k0 < K; k0 += 32) {
            bf16x8 a[2][4], b[2][2];
#pragma unroll
            for (int ai = 0; ai < 2; ++ai)
#pragma unroll
                for (int m = 0; m < 4; ++m) a[ai][m] = *(const bf16x8*)(ap[ai][m] + k0 * 2);
#pragma unroll
            for (int bj = 0; bj < 2; ++bj)
#pragma unroll
                for (int n = 0; n < 2; ++n) b[bj][n] = *(const bf16x8*)(bp[bj][n] + k0 * 2);
#pragma unroll
            for (int ai = 0; ai < 2; ++ai)
#pragma unroll
                for (int bj = 0; bj < 2; ++bj)
#pragma unroll
                    for (int m = 0; m < 4; ++m)
#pragma unroll
                        for (int n = 0; n < 2; ++n) acc[ai][bj][m][n] = __builtin_amdgcn_mfma_f32_16x16x32_bf16(b[bj][n], a[ai][m], acc[ai][bj][m][n], 0, 0, 0);
        }
        E(acc, cur, wr, wc, fr, fq);
    }
}

template <int OFF> __device__ __forceinline__ void glds16(const char* base, unsigned voff, unsigned lds_base) {
    asm volatile("s_add_u32 m0, %2, %3\n\ts_nop 0\n\tglobal_load_lds_dwordx4 %0, %1" :: "v"(voff), "s"(base), "s"(lds_base), "n"(OFF) : "memory", "m0", "scc");
}
template <class Epi, class Sched, int MODE = 0  >
__device__ __forceinline__ void gemm_phase(PG8_LAS unsigned char* lds, const Sched& S, const Epi& E) {
    constexpr bool GATHER = Sched::GATHER;
    int tid = threadIdx.x; asm volatile("" : "+v"(tid));
    const int wid = __builtin_amdgcn_readfirstlane(tid >> 6), lane = tid & 63, wr = wid >> 2, wc = wid & 3, fr = lane & 15, fq = lane >> 4;
    const int K = S.K, nt = K / BK;
    unsigned voffB[2], offA[4], nxA[4];
#pragma unroll
    for (int i = 0; i < 2; ++i) { int R, C; stage_rc(tid * 16 + i * 8192, R, C); const int Rb = Epi::PERM ? ((R & ~31) + perm32(R & 31)) : R;
        voffB[i] = (unsigned)(Rb * K + C) * 2u; offA[i] = (unsigned)(R * K + C) * 2u; offA[2 + i] = (unsigned)((R + HALF) * K + C) * 2u; nxA[i] = 0u; nxA[2 + i] = 0u; }
    const size_t kstep = (size_t)(BK * 2);
    const size_t hstep = (size_t)HALF * K * 2;
    const unsigned ldsw = (unsigned)wid * 1024u;
    const unsigned ldsbw = (unsigned)(size_t)lds + ldsw;
    const int aoff = lds_byte(wr * 64 + fr, fq * 8), boff = lds_byte(wc * 32 + fr, fq * 8);
#define PG8_SA(b, h) (((b) * 2 + (h)) * HTB)
#define PG8_SB(b, h) ((4 + (b) * 2 + (h)) * HTB)
#define PG8_STAGE_B(bufoff, gbase) do { glds16<(bufoff)>((const char*)(gbase), voffB[0], ldsbw); glds16<(bufoff) + 8192>((const char*)(gbase), voffB[1], ldsbw); } while (0)
#define PG8_STAGE_A(bufoff, gbase, h) do { glds16<(bufoff)>((const char*)(gbase), offA[(h) * 2], ldsbw); glds16<(bufoff) + 8192>((const char*)(gbase), offA[(h) * 2 + 1], ldsbw); } while (0)
#define PG8_LDA(dst, b, h) do { _Pragma("unroll") for (int m = 0; m < 4; ++m) _Pragma("unroll") for (int k = 0; k < 2; ++k) dst[m][k] = *(const PG8_LAS bf16x8*)(lds + PG8_SA(b, h) + aoff + m * 2048 + k * 1024); } while (0)
#define PG8_LDB(dst, b, h) do { _Pragma("unroll") for (int n = 0; n < 2; ++n) _Pragma("unroll") for (int k = 0; k < 2; ++k) dst[n][k] = *(const PG8_LAS bf16x8*)(lds + PG8_SB(b, h) + boff + n * 2048 + k * 1024); } while (0)
#define PG8_MMA(ai, bj, At, Bt) do { __builtin_amdgcn_s_setprio(1); if constexpr (MODE == 1) { _Pragma("unroll") for (int m = 0; m < 4; ++m) _Pragma("unroll") for (int n = 0; n < 2; ++n) { \
            const v8i _b = __builtin_shufflevector(__builtin_bit_cast(v4i, Bt[n][0]), __builtin_bit_cast(v4i, Bt[n][1]), 0, 1, 2, 3, 4, 5, 6, 7); \
            const v8i _a = __builtin_shufflevector(__builtin_bit_cast(v4i, At[m][0]), __builtin_bit_cast(v4i, At[m][1]), 0, 1, 2, 3, 4, 5, 6, 7); \
            acc[ai][bj][m][n] = __builtin_amdgcn_mfma_scale_f32_16x16x128_f8f6f4(_b, _a, acc[ai][bj][m][n], 0, 0, 0, 0x7A7A7A7A, 0, 0x7F7F7F7F); } } \
        else if constexpr (MODE == 2) { _Pragma("unroll") for (int m = 0; m < 4; ++m) _Pragma("unroll") for (int n = 0; n < 2; ++n) _Pragma("unroll") for (int k = 0; k < 2; ++k) \
        acc[ai][bj][m][n] = __builtin_bit_cast(f32x4, __builtin_amdgcn_mfma_i32_16x16x64_i8(__builtin_bit_cast(v4i, Bt[n][k]), __builtin_bit_cast(v4i, At[m][k]), __builtin_bit_cast(v4i, acc[ai][bj][m][n]), 0, 0, 0)); } \
        else { _Pragma("unroll") for (int m = 0; m < 4; ++m) _Pragma("unroll") for (int n = 0; n < 2; ++n) _Pragma("unroll") for (int k = 0; k < 2; ++k) \
        acc[ai][bj][m][n] = __builtin_amdgcn_mfma_f32_16x16x32_bf16(Bt[n][k], At[m][k], acc[ai][bj][m][n], 0, 0, 0); } __builtin_amdgcn_s_setprio(0); } while (0)
#define PG8_WAIT_V(n) asm volatile("s_waitcnt vmcnt(" #n ")" ::: "memory")
#define PG8_WAIT_L(n) asm volatile("s_waitcnt lgkmcnt(" #n ")" ::: "memory")
#define PG8_BAR __builtin_amdgcn_s_barrier()
#define PG8_SCHED __builtin_amdgcn_sched_barrier(0)
#define PG8_OFFS(dst, u) do { if constexpr (GATHER) { _Pragma("unroll") for (int _h = 0; _h < 2; ++_h) _Pragma("unroll") for (int _i = 0; _i < 2; ++_i) { \
        int _R, _C; stage_rc(tid * 16 + _i * 8192, _R, _C); dst[_h * 2 + _i] = S.a_row_off(u, _h * HALF + _R) + (unsigned)(_C * 2); } } } while (0)
    Unit cur, nxt; int ui = 0;
    if (!S.next(0, cur)) return;
    f32x4 acc[2][2][4][2];
#pragma unroll
    for (int a = 0; a < 2; ++a)
#pragma unroll
        for (int b = 0; b < 2; ++b)
#pragma unroll
            for (int m = 0; m < 4; ++m)
#pragma unroll
                for (int n = 0; n < 2; ++n) acc[a][b][m][n] = (f32x4){0.f, 0.f, 0.f, 0.f};
    bf16x8 At[4][2], B0[2][2], B1[2][2];
    const char* cA = S.a_tile(cur); const char* cB = S.b_tile(cur);
    PG8_OFFS(offA, cur);
    PG8_STAGE_B(PG8_SB(0, 0), cB); PG8_STAGE_B(PG8_SB(0, 1), cB + hstep); PG8_STAGE_A(PG8_SA(0, 0), cA, 0); PG8_STAGE_A(PG8_SA(0, 1), cA, 1);
    if (wr == 1) PG8_BAR;
    PG8_WAIT_V(2); PG8_BAR;
    PG8_STAGE_B(PG8_SB(1, 0), cB + kstep); PG8_STAGE_A(PG8_SA(1, 0), cA + kstep, 0); PG8_STAGE_B(PG8_SB(1, 1), cB + hstep + kstep);
    PG8_WAIT_V(6); PG8_BAR;
    for (;;) {
        const bool has_next = S.next(ui + 1, nxt);
        const char* nA = has_next ? S.a_tile(nxt) : cA; const char* nB = has_next ? S.b_tile(nxt) : cB;
        if constexpr (GATHER) { if (has_next) { PG8_OFFS(nxA, nxt); } }
#pragma unroll 1
        for (int t = 0; t < nt; t += 2) {
            const bool last = (t == nt - 2);
            const char* a1 = cA + (size_t)(t + 1) * kstep;
            const char* a2 = last ? nA : cA + (size_t)(t + 2) * kstep; const char* b2 = last ? nB : cB + (size_t)(t + 2) * kstep;
            const char* a3 = a2 + kstep; const char* b3 = b2 + kstep;
            PG8_LDB(B0, 0, 0); PG8_LDB(B1, 0, 1); PG8_SCHED; PG8_LDA(At, 0, 0); PG8_STAGE_A(PG8_SA(1, 1), a1, 1);
            if constexpr (GATHER) { if (last && has_next) {
#pragma unroll
                for (int q = 0; q < 4; ++q) offA[q] = nxA[q]; } }
            PG8_WAIT_V(8); PG8_WAIT_L(0); PG8_BAR; if (!(Sched::HAS_RH && cur.rh == 1)) { PG8_MMA(0, 0, At, B0); if (!(Sched::HAS_HALF && S.is_half(cur))) PG8_MMA(0, 1, At, B1); } PG8_BAR; PG8_SCHED;
            PG8_LDA(At, 0, 1); PG8_STAGE_B(PG8_SB(0, 0), b2); PG8_STAGE_B(PG8_SB(0, 1), b2 + hstep); PG8_STAGE_A(PG8_SA(0, 0), a2, 0);
            PG8_WAIT_V(8); PG8_WAIT_L(0); PG8_BAR; if (!(Sched::HAS_RH && cur.rh == 0)) { PG8_MMA(1, 0, At, B0); if (!(Sched::HAS_HALF && S.is_half(cur))) PG8_MMA(1, 1, At, B1); } PG8_BAR; PG8_SCHED;
            PG8_LDB(B0, 1, 0); PG8_LDB(B1, 1, 1); PG8_SCHED; PG8_LDA(At, 1, 0); PG8_STAGE_A(PG8_SA(0, 1), a2, 1);
            PG8_WAIT_V(8); PG8_WAIT_L(0); PG8_BAR; if (!(Sched::HAS_RH && cur.rh == 1)) { PG8_MMA(0, 0, At, B0); if (!(Sched::HAS_HALF && S.is_half(cur))) PG8_MMA(0, 1, At, B1); } PG8_BAR; PG8_SCHED;
            PG8_LDA(At, 1, 1); PG8_STAGE_B(PG8_SB(1, 0), b3); PG8_STAGE_B(PG8_SB(1, 1), b3 + hstep); PG8_STAGE_A(PG8_SA(1, 0), a3, 0);
            PG8_WAIT_V(8); PG8_WAIT_L(0); PG8_BAR; if (!(Sched::HAS_RH && cur.rh == 0)) { PG8_MMA(1, 0, At, B0); if (!(Sched::HAS_HALF && S.is_half(cur))) PG8_MMA(1, 1, At, B1); } PG8_BAR; PG8_SCHED;
        }
        if (wr == 0) PG8_BAR;
        E(acc, cur, wr, wc, fr, fq);
        if (!has_next) break;
#pragma unroll
        for (int a = 0; a < 2; ++a)
#pragma unroll
            for (int b = 0; b < 2; ++b)
#pragma unroll
                for (int m = 0; m < 4; ++m)
#pragma unroll
                    for (int n = 0; n < 2; ++n) acc[a][b][m][n] = (f32x4){0.f, 0.f, 0.f, 0.f};
        cur = nxt; cA = nA; cB = nB; ++ui;
        if (wr == 1) PG8_BAR;
    }
    PG8_WAIT_V(0);
    PG8_BAR;
#undef PG8_SA
#undef PG8_SB
#undef PG8_STAGE_A
#undef PG8_STAGE_B
#undef PG8_LDA
#undef PG8_LDB
#undef PG8_MMA
#undef PG8_WAIT_V
#undef PG8_WAIT_L
#undef PG8_BAR
#undef PG8_SCHED
#undef PG8_OFFS
}
}

#define XB_TMO      128
#define XB_XCNT(j)  (256  + 64 * (j))
#define XB_XSUB(j)  (1280 + 64 * (j))
#define XB_XGEN(j)  (2304 + 64 * (j))
#define XB_TOP      3328
#define XB_TOPGEN   3392
#define XCD_BAR_WORDS 3456
#define XB_SPIN_CAP (1u << 18)
__device__ __forceinline__ unsigned xb_ld(unsigned* p)              { return __hip_atomic_load(p, __ATOMIC_RELAXED, __HIP_MEMORY_SCOPE_AGENT); }
__device__ __forceinline__ unsigned xb_add(unsigned* p, unsigned v) { return __hip_atomic_fetch_add(p, v, __ATOMIC_RELAXED, __HIP_MEMORY_SCOPE_AGENT); }
__device__ __forceinline__ unsigned xb_xcc_id() { return (unsigned)__builtin_amdgcn_s_getreg((3 << 11) | 20) & 0xFu; }
#define XB_SPIN(cond, bar) do { unsigned _sp = 0; while (cond) { __builtin_amdgcn_s_sleep(1); \
    if ((++_sp & 255u) == 0u) { if (xb_ld(&(bar)[XB_TMO])) break; if (_sp > XB_SPIN_CAP) { atomicAdd(&(bar)[XB_TMO], 1u); break; } } } } while (0)
struct XcdBarrier { unsigned* bar; unsigned x; volatile LAS unsigned* st; };
__device__ __forceinline__ XcdBarrier xcd_barrier_post(unsigned* bar, volatile LAS unsigned* st) {
    XcdBarrier b; b.bar = bar; b.x = xb_xcc_id(); b.st = st;
    if (threadIdx.x == 0) (void)xb_add(&bar[XB_XCNT(b.x)], 1u);
    return b;
}
__device__ __forceinline__ void xcd_barrier_complete(unsigned* bar, unsigned x, unsigned& nloc, unsigned& nx) {
    const unsigned G = gridDim.x * gridDim.y * gridDim.z;
    unsigned sum, cnt, mine, sp = 0u;
    for (;;) {
        sum = 0u; cnt = 0u; mine = 0u;
#pragma unroll
        for (unsigned j = 0; j < 16; ++j) { const unsigned c = xb_ld(&bar[XB_XCNT(j)]); sum += c; cnt += (c > 0u) ? 1u : 0u; mine = (j == x) ? c : mine; }
        if (sum == G) break;
        __builtin_amdgcn_s_sleep(1);
        if ((++sp & 255u) == 0u) { if (xb_ld(&bar[XB_TMO])) break; if (sp > XB_SPIN_CAP) { atomicAdd(&bar[XB_TMO], 1u); break; } }
    }
    nloc = mine > 0u ? mine : 1u; nx = cnt > 0u ? cnt : 1u;
}
__device__ __forceinline__ void xcd_barrier(const XcdBarrier& b) {
    asm volatile("s_waitcnt vmcnt(0)" ::: "memory");
    __syncthreads();
    if (threadIdx.x == 0) {
        unsigned* bar = b.bar;
        __builtin_amdgcn_s_waitcnt(0);
        unsigned nloc = b.st[0], nx = b.st[1];
        if (nloc == 0u) { xcd_barrier_complete(bar, b.x, nloc, nx); b.st[0] = nloc; b.st[1] = nx; }
        const unsigned old = xb_add(&bar[XB_XSUB(b.x)], 1u);
        const unsigned gen = old / nloc;
        if (old + 1u == (gen + 1u) * nloc) {
            __builtin_amdgcn_fence(__ATOMIC_RELEASE, "agent");
            asm volatile("s_waitcnt vmcnt(0)" ::: "memory");
            const unsigned og = xb_add(&bar[XB_TOP], 1u);
            const unsigned tg = og / nx;
            if (og + 1u == (tg + 1u) * nx) xb_add(&bar[XB_TOPGEN], 1u);
            else XB_SPIN(xb_ld(&bar[XB_TOPGEN]) == tg, bar);
            __builtin_amdgcn_fence(__ATOMIC_ACQUIRE, "agent");
            xb_add(&bar[XB_XGEN(b.x)], 1u);
            asm volatile("s_waitcnt vmcnt(0)" ::: "memory");
        } else {
            XB_SPIN(xb_ld(&bar[XB_XGEN(b.x)]) == gen, bar);
            __builtin_amdgcn_fence(__ATOMIC_ACQUIRE, "agent");
            asm volatile("s_waitcnt vmcnt(0)" ::: "memory");
        }
    }
    __syncthreads();
}

constexpr int NWAVES = 8;
struct Args { const float* in[21]; float* out; unsigned char* ws; int ph_lo, ph_hi; };
struct Frame {
    LAS unsigned char* lds;
    unsigned* ctl;
    int tid, lane, wave, vcu, G;
    unsigned char* ws;
};
enum { I_X = 0, I_LNIG, I_LNIB, I_RW, I_RB, I_WIN, I_CAW, I_CBW, I_CBB, I_LCG, I_LCB, I_PW, I_PS, I_WOUT, I_LMG, I_LMB, I_WG, I_WU, I_WDN, I_LFG, I_LFB };

__device__ __forceinline__ void tr_item(const float* src, int srcN, int srccol0, bf16* dst, int dstK, int dstrow0, int k0, LAS float* scr, int lane) {
#pragma unroll 8
    for (int i = 0; i < 32; ++i) { const int kk = 2 * i + (lane >> 5); scr[kk * 33 + (lane & 31)] = src[(size_t)(k0 + kk) * srcN + srccol0 + (lane & 31)]; }
    LDS_WAIT(); asm volatile("" ::: "memory");
    const int c = lane & 7;
#pragma unroll
    for (int j = 0; j < 4; ++j) { const int n = (lane >> 3) + 8 * j; const LAS float* s = scr + (8 * c) * 33 + n;
        v4u o; o.x = pk2(s[0 * 33], s[1 * 33]); o.y = pk2(s[2 * 33], s[3 * 33]); o.z = pk2(s[4 * 33], s[5 * 33]); o.w = pk2(s[6 * 33], s[7 * 33]);
        *(GAS v4u*)(dst + (size_t)(dstrow0 + n) * dstK + k0 + 8 * c) = o; }
    LDS_WAIT(); asm volatile("" ::: "memory");
}
__device__ __forceinline__ void tr_item64(const float* src, int srcN, int srccol0, bf16* dst, int dstK, int dstrow0, int k0, LAS unsigned* scr, int lane) {
    const int kr = lane >> 4, c4 = lane & 15;
    const float* sp = src + (size_t)(k0 + 2 * kr) * srcN + srccol0 + 4 * c4;
    f32x4 A[8], B[8];
#pragma unroll
    for (int i = 0; i < 8; ++i) { A[i] = *(const GAS f32x4*)(sp + (size_t)(8 * i) * srcN); B[i] = *(const GAS f32x4*)(sp + (size_t)(8 * i + 1) * srcN); }
#pragma unroll
    for (int i = 0; i < 8; ++i) { LAS unsigned* w = scr + (4 * i + kr) * 65 + 4 * c4;
        w[0] = pk2(A[i].x, B[i].x); w[1] = pk2(A[i].y, B[i].y); w[2] = pk2(A[i].z, B[i].z); w[3] = pk2(A[i].w, B[i].w); }
    LDS_WAIT(); asm volatile("" ::: "memory");
    const int q = lane & 7, nn = lane >> 3;
#pragma unroll
    for (int j = 0; j < 8; ++j) { const int n = nn + 8 * j; const LAS unsigned* r = scr + (4 * q) * 65 + n;
        v4u o; o.x = r[0]; o.y = r[65]; o.z = r[130]; o.w = r[195];
        *(GAS v4u*)(dst + (size_t)(dstrow0 + n) * dstK + k0 + 8 * q) = o; }
    LDS_WAIT(); asm volatile("" ::: "memory");
}
template <int NS, bool I8 = false>
__device__ __forceinline__ void tr_item64_f8(const float* src, int srcN, int srccol0, unsigned char* dst, int dstKB, int dstrow0, int k0, float scale, LAS unsigned* scr, int lane, bool nostore = false, f32x4 cinv = (f32x4){1.f, 1.f, 1.f, 1.f}) {
    const int kr = lane >> 4, c4 = lane & 15;
    const float* sp = src + (size_t)(k0 + 4 * kr) * srcN + srccol0 + 4 * c4;
    f32x4 A[NS][4][4];
#pragma unroll
    for (int s = 0; s < NS; ++s)
#pragma unroll
        for (int i = 0; i < 4; ++i)
#pragma unroll
            for (int t = 0; t < 4; ++t) A[s][i][t] = __builtin_nontemporal_load((const GAS f32x4*)(sp + (size_t)(64 * s + 16 * i + t) * srcN));
#pragma unroll
    for (int s = 0; s < NS; ++s)
#pragma unroll
        for (int i = 0; i < 4; ++i) { LAS unsigned* w = scr + (16 * s + 4 * i + kr) * 65 + 4 * c4;
            if constexpr (I8) {
            w[0] = pk4_i8(A[s][i][0].x * cinv.x, A[s][i][1].x * cinv.x, A[s][i][2].x * cinv.x, A[s][i][3].x * cinv.x); w[1] = pk4_i8(A[s][i][0].y * cinv.y, A[s][i][1].y * cinv.y, A[s][i][2].y * cinv.y, A[s][i][3].y * cinv.y);
            w[2] = pk4_i8(A[s][i][0].z * cinv.z, A[s][i][1].z * cinv.z, A[s][i][2].z * cinv.z, A[s][i][3].z * cinv.z); w[3] = pk4_i8(A[s][i][0].w * cinv.w, A[s][i][1].w * cinv.w, A[s][i][2].w * cinv.w, A[s][i][3].w * cinv.w); } else {
            w[0] = pk4_fp8(A[s][i][0].x * scale, A[s][i][1].x * scale, A[s][i][2].x * scale, A[s][i][3].x * scale); w[1] = pk4_fp8(A[s][i][0].y * scale, A[s][i][1].y * scale, A[s][i][2].y * scale, A[s][i][3].y * scale);
            w[2] = pk4_fp8(A[s][i][0].z * scale, A[s][i][1].z * scale, A[s][i][2].z * scale, A[s][i][3].z * scale); w[3] = pk4_fp8(A[s][i][0].w * scale, A[s][i][1].w * scale, A[s][i][2].w * scale, A[s][i][3].w * scale); } }
    LDS_WAIT(); asm volatile("" ::: "memory");
    constexpr int QN = 4 * NS, RN = 64 / QN;
    const int q = lane % QN, nn = lane / QN;
#pragma unroll
    for (int j = 0; j < 64 / RN; ++j) { const int n = nn + RN * j; const LAS unsigned* r = scr + (4 * q) * 65 + n;
        v4u o; o.x = r[0]; o.y = r[65]; o.z = r[130]; o.w = r[195];
        if (nostore) asm volatile("" :: "v"(o)); else *(GAS v4u*)(dst + (size_t)(dstrow0 + n) * dstKB + k0 + 16 * q) = o; }
    LDS_WAIT(); asm volatile("" ::: "memory");
}
__device__ __forceinline__ int win_src(int c0) {
    const int pn = c0 >> 8, j = c0 & 255, half = j >> 7, jj = j & 127;
    if (pn < 3) { const int ch = pn * 128 + jj; return half == 0 ? 384 + ch : 768 + ch; }
    if (pn < 6) { const int ch = (pn - 3) * 128 + jj; return half == 0 ? 1152 + ch : 1536 + ch; }
    if (pn < 8) { const int q = (pn - 6) * 256 + j; return q < 384 ? q : 1920 + (q - 384); }
    return j < 128 ? 1920 + 128 + j : -1;
}
__device__ __forceinline__ void p0_prologue(Frame& F, const Args& A) {
    LAS float* scr = (LAS float*)(F.lds + F.wave * 8448);
    LAS unsigned* scu = (LAS unsigned*)scr;
    const int gw = F.vcu * NWAVES + F.wave, NGW = F.G * NWAVES, lane = F.lane;
    bf16* WIN = (bf16*)(F.ws + WS_WIN); bf16* WOUT = (bf16*)(F.ws + WS_WOUT); unsigned char* WGU = F.ws + WS_WGU; unsigned char* WD = F.ws + WS_WD; bf16* WRT = (bf16*)(F.ws + WS_WRT);
    constexpr int I_M = GEMM1_I8 ? NL * 36 * 8 : 0, I_A = GEMM1_I8 ? NL * 36 * 8 : NL * 16 * 36, I_B = NL * 12 * 16, I_C = NL * NE * 128, I_D = NL * NE * 64, I_E = 16, I_F = NL * 4 * 16 * 2;
    constexpr int NITEMS = I_M + I_A + I_B + I_C + I_D + I_E + I_F;
    const int lane0 = lane;
#pragma unroll 1
    for (int prep = 0; prep < ((PROBE_P0 == 1 || PROBE_P0 == 3) ? 2 : 1); ++prep)
    for (int it = gw; it < NITEMS; it += NGW) {
        int lane = lane0; asm volatile("" : "+v"(lane));
        int r = it;
        if (r < I_M) {
            const int l = r / 288, q = r % 288, cb = q >> 3, kq = q & 7, c0 = cb * 64, sc = win_src(c0), kr = lane >> 4, c4 = lane & 15;
            if (sc >= 0) { const float* sp = A.in[I_WIN] + (size_t)l * 1024 * DIN + (size_t)(kq * 128 + kr) * DIN + sc + 4 * c4;
                f32x4 vv[32];
#pragma unroll
                for (int i = 0; i < 32; ++i) vv[i] = *(const GAS f32x4*)(sp + (size_t)(4 * i) * DIN);
                f32x4 mx = (f32x4){0.f, 0.f, 0.f, 0.f};
#pragma unroll
                for (int i = 0; i < 32; ++i) { mx.x = fmaxf(mx.x, fabsf(vv[i].x)); mx.y = fmaxf(mx.y, fabsf(vv[i].y)); mx.z = fmaxf(mx.z, fabsf(vv[i].z)); mx.w = fmaxf(mx.w, fabsf(vv[i].w)); }
#pragma unroll
                for (int o = 16; o <= 32; o <<= 1) { mx.x = fmaxf(mx.x, __shfl_xor(mx.x, o)); mx.y = fmaxf(mx.y, __shfl_xor(mx.y, o)); mx.z = fmaxf(mx.z, __shfl_xor(mx.z, o)); mx.w = fmaxf(mx.w, __shfl_xor(mx.w, o)); }
                if (kr == 0) { unsigned* cm = F.ctl + CW_CMAX + l * N1 + c0 + 4 * c4;
                    __hip_atomic_fetch_max(cm + 0, __float_as_uint(mx.x), RLX_AGENT); __hip_atomic_fetch_max(cm + 1, __float_as_uint(mx.y), RLX_AGENT);
                    __hip_atomic_fetch_max(cm + 2, __float_as_uint(mx.z), RLX_AGENT); __hip_atomic_fetch_max(cm + 3, __float_as_uint(mx.w), RLX_AGENT); } }
            VM_WAIT();
            if (lane == 0) __hip_atomic_fetch_add(F.ctl + CW_CMAXCNT, 1u, RLX_AGENT);
            continue; }
        r -= I_M;
        if (r < I_C) {
            const int le = r >> 7, q = r & 127, kb = q >> 4, nb = q & 15, n0 = nb * 64, pn = n0 >> 8, half = (n0 & 255) >> 7, jj0 = n0 & 127;
            const float* src = (half ? A.in[I_WU] : A.in[I_WG]) + (size_t)le * 1024 * 512;
            tr_item64_f8<2>(src, 512, pn * 128 + jj0, WGU + (size_t)le * 1024 * 1024, 1024, n0, kb * 128, 32.0f, scu, lane, PROBE_P0 == 3 && prep == 1); continue; }
        r -= I_C;
        if (r < I_D) {
            const int le = r >> 6, q = r & 63, kb = q >> 4, nb = q & 15;
            tr_item64_f8<2>(A.in[I_WDN] + (size_t)le * 512 * 1024, 1024, nb * 64, WD + (size_t)le * 1024 * 512, 512, nb * 64, kb * 128, 32.0f, scu, lane, PROBE_P0 == 3 && prep == 1); continue; }
        r -= I_D;
        if (r < I_A) {
            if (GEMM1_I8) {
                const int l = r / 288, q = r % 288, cb = q >> 3, kb = q & 7, c0 = cb * 64, sc = win_src(c0), c4 = lane & 15;
                unsigned char* dst = F.ws + WS_WIN + (size_t)l * N1 * 1024;
                { unsigned spins = 0;
                  while (__hip_atomic_load(F.ctl + CW_CMAXCNT, RLX_AGENT) < (unsigned)I_M * ((PROBE_P0 == 1 || PROBE_P0 == 3) ? (unsigned)(prep + 1) : 1u)) { __builtin_amdgcn_s_sleep(8); if (++spins > (1u << 22)) break; } }
                if (sc >= 0) { const unsigned* cm = F.ctl + CW_CMAX + l * N1 + c0 + 4 * c4;
                    f32x4 mx; mx.x = __uint_as_float(__hip_atomic_load(cm + 0, RLX_AGENT)); mx.y = __uint_as_float(__hip_atomic_load(cm + 1, RLX_AGENT)); mx.z = __uint_as_float(__hip_atomic_load(cm + 2, RLX_AGENT)); mx.w = __uint_as_float(__hip_atomic_load(cm + 3, RLX_AGENT));
                    f32x4 cinv; cinv.x = mx.x > 0.f ? 127.f / mx.x : 0.f; cinv.y = mx.y > 0.f ? 127.f / mx.y : 0.f; cinv.z = mx.z > 0.f ? 127.f / mx.z : 0.f; cinv.w = mx.w > 0.f ? 127.f / mx.w : 0.f;
                    tr_item64_f8<2, true>(A.in[I_WIN] + (size_t)l * 1024 * DIN, DIN, sc, dst, 1024, c0, kb * 128, 1.f, scu, lane, false, cinv);
                } else { for (int qq = lane; qq < 64 * 8; qq += 64) *(GAS v4u*)(dst + (size_t)(c0 + (qq >> 3)) * 1024 + kb * 128 + (qq & 7) * 16) = (v4u){0u, 0u, 0u, 0u}; }
                continue; }
            const int l = r / 576, q = r % 576, kb = q / 36, nb = q % 36, c0 = nb * 64, sc = win_src(c0);
            bf16* dst = WIN + (size_t)l * N1 * 1024;
            if (sc >= 0) tr_item64(A.in[I_WIN] + (size_t)l * 1024 * DIN, DIN, sc, dst, 1024, c0, kb * 64, scu, lane);
            else { const int c = lane & 7;
#pragma unroll
                for (int j = 0; j < 8; ++j) { const int n = (lane >> 3) + 8 * j; *(GAS v4u*)(dst + (size_t)(c0 + n) * 1024 + kb * 64 + 8 * c) = (v4u){0u, 0u, 0u, 0u}; } }
            continue; }
        r -= I_A;
        if (r < I_B) {
            const int l = r / 192, q = r % 192, kb = q >> 4, nb = q & 15;
            if (GEMM2_FP8) tr_item64_f8<1>(A.in[I_WOUT] + (size_t)l * 1024 * 1024, 1024, nb * 64, (unsigned char*)WOUT + (size_t)l * 1024 * 1024, 1024, nb * 64, kb * 64, 32.0f, scu, lane);
            else tr_item64(A.in[I_WOUT] + (size_t)l * 1024 * 1024, 1024, nb * 64, WOUT + (size_t)l * 1024 * 1024, 1024, nb * 64, kb * 64, scu, lane);
            continue; }
        r -= I_B;
        if (r < I_E) { tr_item(A.in[I_RW], 32, 0, WRT, 1024, 0, r * 64, scr, lane); continue; }
        r -= I_E;
        {
            const int l = r >> 7, g = (r >> 5) & 3, nb = (r >> 1) & 15, cb = r & 1, n = nb * 64 + lane;
            const float* wo = A.in[I_WOUT] + (size_t)l * 1024 * 1024 + (size_t)(768 + g * 64) * 1024 + n;
            const float* ps = A.in[I_PS] + l * 256 + g * 64;
            const float* pw = A.in[I_PW] + (size_t)(l * 4 + g) * 64 * 64 + cb * 32 * 64;
#pragma unroll
            for (int i = 0; i < 8; ++i) *(LAS f32x4*)(scr + (i * 64 + lane) * 4) = *(const GAS f32x4*)(pw + (i * 64 + lane) * 4);
            float wv[64];
#pragma unroll
            for (int d = 0; d < 64; ++d) wv[d] = wo[(size_t)d * 1024] * ps[d];
            LDS_WAIT(); asm volatile("" ::: "memory");
            bf16* dst = WOUT + (size_t)l * 1024 * 1024 + (size_t)n * 1024 + 768 + g * 64 + cb * 32;
#pragma unroll 1
            for (int c2 = 0; c2 < 16; ++c2) { float o[2];
#pragma unroll
                for (int cc = 0; cc < 2; ++cc) { const LAS f32x4* pr = (const LAS f32x4*)(scr + (c2 * 2 + cc) * 64); float a = 0.f;
#pragma unroll
                    for (int d4 = 0; d4 < 16; ++d4) { const f32x4 p = pr[d4]; a += p.x * wv[4 * d4] + p.y * wv[4 * d4 + 1] + p.z * wv[4 * d4 + 2] + p.w * wv[4 * d4 + 3]; }
                    o[cc] = a; }
                if (GEMM2_FP8) *(GAS unsigned short*)((unsigned char*)WOUT + (size_t)l * 1024 * 1024 + (size_t)n * 1024 + 768 + g * 64 + cb * 32 + c2 * 2) = (unsigned short)pk4_fp8(o[0] * 32.0f, o[1] * 32.0f, 0.f, 0.f);
                else *(GAS unsigned*)(dst + c2 * 2) = pk2(o[0], o[1]); }
            LDS_WAIT(); asm volatile("" ::: "memory");
        }
    }
    bf16* HB = (bf16*)(F.ws + WS_HB);
    const float* g = A.in[I_LNIG]; const float* b = A.in[I_LNIB];
    f32x4 gv[4], bv[4];
#pragma unroll
    for (int j = 0; j < 4; ++j) { gv[j] = *(const f32x4*)(g + 4 * lane + 256 * j); bv[j] = *(const f32x4*)(b + 4 * lane + 256 * j); }
#pragma unroll 1
    for (int prep2 = 0; prep2 < ((PROBE_P0 == 2) ? 2 : 1); ++prep2)
    for (int m0 = gw * 2; m0 < T_; m0 += NGW * 2) {
        f32x4 v[2][4];
#pragma unroll
        for (int u = 0; u < 2; ++u) { const GAS f32x4* xr = (const GAS f32x4*)(A.in[I_X] + (size_t)(m0 + u) * D_) + lane;
#pragma unroll
            for (int j = 0; j < 4; ++j) v[u][j] = __builtin_nontemporal_load(xr + 64 * j); }
#pragma unroll
        for (int u = 0; u < 2; ++u) { float s = 0.f;
#pragma unroll
            for (int j = 0; j < 4; ++j) s += (v[u][j].x + v[u][j].y) + (v[u][j].z + v[u][j].w);
            const float mean = wave_sum(s) * (1.f / D_); float s2 = 0.f;
#pragma unroll
            for (int j = 0; j < 4; ++j) { v[u][j] = v[u][j] - mean; s2 += (v[u][j].x * v[u][j].x + v[u][j].y * v[u][j].y) + (v[u][j].z * v[u][j].z + v[u][j].w * v[u][j].w); }
            const float rstd = __builtin_amdgcn_rsqf(wave_sum(s2) * (1.f / D_) + LN_EPS);
            GAS v2u* o8 = (GAS v2u*)(HB + (size_t)(m0 + u) * D_) + lane;
            float amax = 0.f;
#pragma unroll
            for (int j = 0; j < 4; ++j) { const f32x4 o = v[u][j] * rstd * gv[j] + bv[j]; v[u][j] = o; v2u w; w.x = pk2(o.x, o.y); w.y = pk2(o.z, o.w); o8[64 * j] = w;
                amax = fmaxf(amax, fmaxf(fmaxf(fabsf(o.x), fabsf(o.y)), fmaxf(fabsf(o.z), fabsf(o.w)))); }
            if (GEMM1_I8) {
                amax = wave_max(amax); const float inv = amax > 0.f ? 127.f / amax : 0.f;
                GAS unsigned* q4 = (GAS unsigned*)(F.ws + WS_HQ + (size_t)(m0 + u) * D_) + lane;
#pragma unroll
                for (int j = 0; j < 4; ++j) q4[64 * j] = pk4_i8(v[u][j].x * inv, v[u][j].y * inv, v[u][j].z * inv, v[u][j].w * inv);
                if (lane == 0) ((float*)(F.ws + WS_HS))[m0 + u] = amax * (1.f / 127.f); } }
    }
}

__device__ __forceinline__ void p2_mixer(Frame& F, const Args& A, int l) {
    LAS unsigned* BV = (LAS unsigned*)F.lds;
    LAS unsigned* PB = (LAS unsigned*)(F.lds + 47616);
    LAS float* V = (LAS float*)(F.lds + 71680);
    const bf16* Z = (const bf16*)(F.ws + WS_Z); bf16* Y = (bf16*)(F.ws + WS_Y);
    const float* wB = A.in[I_CBW] + l * 31 * 384; const float* bB = A.in[I_CBB] + l * 384;
    const float* lg = A.in[I_LCG] + l * 384; const float* lb = A.in[I_LCB] + l * 384; const float* wA = A.in[I_CAW] + l * 3 * 384;
    int tid = F.tid; asm volatile("" : "+v"(tid));
    const int lane = tid & 63, wave = F.wave;
    const bool convt = tid < 384; const int cp = tid % 192, tg = tid / 192;
    f32x2 w[31]; f32x2 bias = (f32x2){0.f, 0.f};
#pragma unroll
    for (int j = 0; j < 31; ++j) w[j] = (f32x2){0.f, 0.f};
    if (convt) {
#pragma unroll
        for (int j = 0; j < 31; ++j) w[j] = *(const f32x2*)(wB + j * 384 + 2 * cp);
        bias = *(const f32x2*)(bB + 2 * cp); }
    v4u pre[9];
#define MIX_PREFETCH(ci_, tid_) do { const int _t0 = (ci_) * 32, _s0 = _t0 & (SEQ_ - 1); \
        _Pragma("unroll") for (int _i = 0; _i < 6; ++_i) { const int _q = (tid_) + 512 * _i; const int _qq = _q < 62 * 48 ? _q : 0; const int _r = _qq / 48, _c = _qq % 48; \
            const int _rr = (_s0 - 30 + _r >= 0) ? _r : 30; pre[_i] = *(const GAS v4u*)(Z + (size_t)(_t0 - 30 + _rr) * NZ + 768 + _c * 8); } \
        _Pragma("unroll") for (int _i = 0; _i < 3; ++_i) { const int _q = (tid_) + 512 * _i; const int _qq = _q < 47 * 32 ? _q : 0; const int _r = _qq >> 5, _c = _qq & 31; \
            const int _rr = (_s0 - 15 + _r >= 0) ? _r : 15; pre[6 + _i] = *(const GAS v4u*)(Z + (size_t)(_t0 - 15 + _rr) * NZ + 1152 + _c * 8); } } while (0)
    if (F.vcu < T_ / 32) MIX_PREFETCH(F.vcu, tid);
    for (int ci = F.vcu; ci < T_ / 32; ci += F.G) {
        const int t0 = ci * 32, s0 = t0 & (SEQ_ - 1);
#pragma unroll
        for (int i = 0; i < 6; ++i) { const int q = tid + 512 * i; if (q < 62 * 48) { const int r = q / 48, c = q % 48;
            *(LAS v4u*)(BV + r * 192 + c * 4) = (s0 - 30 + r >= 0) ? pre[i] : (v4u){0u, 0u, 0u, 0u}; } }
#pragma unroll
        for (int i = 0; i < 3; ++i) { const int q = tid + 512 * i; if (q < 47 * 32) { const int r = q >> 5, c = q & 31;
            *(LAS v4u*)(PB + r * 128 + c * 4) = (s0 - 15 + r >= 0) ? pre[6 + i] : (v4u){0u, 0u, 0u, 0u}; } }
        __syncthreads();
        { int cn = ci + F.G; asm volatile("" : "+s"(cn)); int tidp = tid; asm volatile("" : "+v"(tidp));
          if (cn < T_ / 32) MIX_PREFETCH(cn, tidp); }
        if (PROBE_MIX == 3) { int cn = ci + F.G; asm volatile("" : "+s"(cn)); int tidp = tid; asm volatile("" : "+v"(tidp));
          if (cn < T_ / 32) { v4u sink[9]; const int _t0 = cn * 32;
#pragma unroll
              for (int i = 0; i < 6; ++i) { const int q = tidp + 512 * i, qq = q < 62 * 48 ? q : 0, r = qq / 48, c = qq % 48; sink[i] = *(const GAS v4u*)(Z + (size_t)(_t0 + r) * NZ + 768 + c * 8 + 8); }
#pragma unroll
              for (int i = 0; i < 3; ++i) { const int q = tidp + 512 * i, qq = q < 47 * 32 ? q : 0, r = qq >> 5, c = qq & 31; sink[6 + i] = *(const GAS v4u*)(Z + (size_t)(_t0 + r) * NZ + 1152 + c * 8); }
#pragma unroll
              for (int i = 0; i < 9; ++i) asm volatile("" :: "v"(sink[i])); } }
#pragma unroll 1
        for (int prep = 0; prep < ((PROBE_MIX == 1) ? 2 : 1); ++prep)
        if (convt) {
#pragma unroll 1
            for (int hh = 0; hh < 2; ++hh) { const int tb = tg * 16 + hh * 8;
                f32x2 x[38];
#pragma unroll
                for (int i = 0; i < 38; ++i) { const unsigned u = BV[(tb + i) * 192 + cp]; x[i] = (f32x2){bflo(u), bfhi(u)}; }
#pragma unroll
                for (int tt = 0; tt < 8; ++tt) { f32x2 a = bias;
#pragma unroll
                    for (int j = 0; j < 31; ++j) a += w[j] * x[tt + j];
                    *(LAS f32x2*)(V + (tb + tt) * 384 + 2 * cp) = a; }
            }
        } else {
            const int p = tid - 384, g = p >> 5, wd = 2 << g;
            f32x2 s = (f32x2){0.f, 0.f};
            for (int i = 1; i < wd; ++i) { const unsigned u = PB[(15 - i) * 128 + p]; s += (f32x2){bflo(u), bfhi(u)}; }
#pragma unroll 1
            for (int blk = 0; blk < 4; ++blk) {
                unsigned xr[23];
#pragma unroll
                for (int i = 0; i < 23; ++i) xr[i] = PB[(8 * blk + i) * 128 + p];
#pragma unroll
                for (int j = 0; j < 8; ++j) { const int tt = 8 * blk + j; const f32x2 xv = (f32x2){bflo(xr[15 + j]), bfhi(xr[15 + j])};
                    s += xv; const int n = (s0 + tt + 1) < wd ? (s0 + tt + 1) : wd; const float inv = __builtin_amdgcn_rcpf((float)n);
                    const f32x2 dd = s * inv - xv;
                    if (GEMM2_FP8) *(GAS unsigned short*)((unsigned char*)Y + (size_t)(t0 + tt) * D_ + 768 + 2 * p) = (unsigned short)pk4_fp8(dd.x, dd.y, 0.f, 0.f);
                    else *(GAS unsigned*)(Y + (size_t)(t0 + tt) * D_ + 768 + 2 * p) = pk2(dd.x, dd.y);
                    const unsigned u2 = xr[15 + j - 1], u4 = xr[15 + j - 3], u8 = xr[15 + j - 7], u16 = xr[j];
                    const unsigned uo = g == 0 ? u2 : (g == 1 ? u4 : (g == 2 ? u8 : u16));
                    s -= (f32x2){bflo(uo), bfhi(uo)}; }
            }
        }
        __syncthreads();
        v4u ya[3][4];
        int t0o = t0; asm volatile("" : "+s"(t0o));
        int tidl = tid; asm volatile("" : "+v"(tidl));
#pragma unroll
        for (int i = 0; i < 3; ++i) { const int q = tidl + 512 * i, tt = q / 48, o8 = q % 48, pos = (t0o & (SEQ_ - 1)) + tt; const size_t row = (size_t)(t0o + tt);
            ya[i][0] = *(const GAS v4u*)(Z + row * NZ + o8 * 8);
            ya[i][1] = *(const GAS v4u*)(Z + row * NZ + 384 + o8 * 8);
            ya[i][2] = *(const GAS v4u*)(Z + (row - (pos >= 1 ? 1 : 0)) * NZ + 384 + o8 * 8);
            ya[i][3] = *(const GAS v4u*)(Z + (row - (pos >= 2 ? 2 : 0)) * NZ + 384 + o8 * 8); }
#pragma unroll 1
        for (int tk = 0; tk < ((PROBE_MIX == 2) ? 8 : 4); ++tk) { const int tt = wave * 4 + (tk & 3);
            f32x2 v[3]; float s = 0.f;
#pragma unroll
            for (int i = 0; i < 3; ++i) { v[i] = *(const LAS f32x2*)(V + tt * 384 + 2 * lane + 128 * i); s += v[i].x + v[i].y; }
            const float mean = wave_sum(s) * (1.f / 384.f); float q = 0.f;
#pragma unroll
            for (int i = 0; i < 3; ++i) { v[i] = v[i] - mean; q += v[i].x * v[i].x + v[i].y * v[i].y; }
            const float rstd = __builtin_amdgcn_rsqf(wave_sum(q) * (1.f / 384.f) + LN_EPS);
#pragma unroll
            for (int i = 0; i < 3; ++i) { const int c = 2 * lane + 128 * i; const f32x2 gg = *(const f32x2*)(lg + c), bb = *(const f32x2*)(lb + c);
                f32x2 o = v[i] * rstd * gg + bb; o.x = o.x * sigmoidf_(o.x); o.y = o.y * sigmoidf_(o.y);
                if (GEMM2_FP8) *(GAS unsigned short*)((unsigned char*)Y + (size_t)(t0 + tt) * D_ + 384 + c) = (unsigned short)pk4_fp8(o.x, o.y, 0.f, 0.f);
                else *(GAS unsigned*)(Y + (size_t)(t0 + tt) * D_ + 384 + c) = pk2(o.x, o.y); }
        }
#pragma unroll
        for (int i = 0; i < 3; ++i) { const int q = tid + 512 * i, tt = q / 48, o8 = q % 48, pos = s0 + tt; const size_t row = (size_t)(t0 + tt);
            const v4u gb = ya[i][0], x0 = ya[i][1]; v4u x1 = ya[i][2], x2 = ya[i][3];
            if (pos < 1) x1 = (v4u){0u, 0u, 0u, 0u};
            if (pos < 2) x2 = (v4u){0u, 0u, 0u, 0u};
            const f32x4 w2a = *(const f32x4*)(wA + 2 * 384 + o8 * 8), w2b = *(const f32x4*)(wA + 2 * 384 + o8 * 8 + 4);
            const f32x4 w1a = *(const f32x4*)(wA + 1 * 384 + o8 * 8), w1b = *(const f32x4*)(wA + 1 * 384 + o8 * 8 + 4);
            const f32x4 w0a = *(const f32x4*)(wA + o8 * 8), w0b = *(const f32x4*)(wA + o8 * 8 + 4);
            float o[8];
            const unsigned gbw[4] = {gb.x, gb.y, gb.z, gb.w}, x0w[4] = {x0.x, x0.y, x0.z, x0.w}, x1w[4] = {x1.x, x1.y, x1.z, x1.w}, x2w[4] = {x2.x, x2.y, x2.z, x2.w};
            const float w2[8] = {w2a.x, w2a.y, w2a.z, w2a.w, w2b.x, w2b.y, w2b.z, w2b.w}, w1[8] = {w1a.x, w1a.y, w1a.z, w1a.w, w1b.x, w1b.y, w1b.z, w1b.w}, w0[8] = {w0a.x, w0a.y, w0a.z, w0a.w, w0b.x, w0b.y, w0b.z, w0b.w};
#pragma unroll
            for (int e = 0; e < 4; ++e) {
                o[2 * e] = bflo(gbw[e]) * (w2[2 * e] * bflo(x0w[e]) + w1[2 * e] * bflo(x1w[e]) + w0[2 * e] * bflo(x2w[e]));
                o[2 * e + 1] = bfhi(gbw[e]) * (w2[2 * e + 1] * bfhi(x0w[e]) + w1[2 * e + 1] * bfhi(x1w[e]) + w0[2 * e + 1] * bfhi(x2w[e])); }
            if (GEMM2_FP8) { v2u ov; ov.x = pk4_fp8(o[0], o[1], o[2], o[3]); ov.y = pk4_fp8(o[4], o[5], o[6], o[7]); *(GAS v2u*)((unsigned char*)Y + row * D_ + o8 * 8) = ov; }
            else { v4u ov; ov.x = pk2(o[0], o[1]); ov.y = pk2(o[2], o[3]); ov.z = pk2(o[4], o[5]); ov.w = pk2(o[6], o[7]);
            *(GAS v4u*)(Y + row * D_ + o8 * 8) = ov; } }
        __syncthreads();
    }
#undef MIX_PREFETCH
}

__device__ __forceinline__ void top2of4(float q0, float q1, float q2, float q3, float& a1, int& i1, float& a2, int& i2) {
    a1 = q0; i1 = 0; a2 = -1.f; i2 = 1;
#define T2STEP(qv, r) { const bool gt = (qv) > a1; const bool g2 = (qv) > a2; const float na2 = gt ? a1 : (g2 ? (qv) : a2); const int ni2 = gt ? i1 : (g2 ? (r) : i2); \
        a1 = gt ? (qv) : a1; i1 = gt ? (r) : i1; a2 = na2; i2 = ni2; }
    T2STEP(q1, 1) T2STEP(q2, 2) T2STEP(q3, 3)
#undef T2STEP
}
__device__ __forceinline__ void p4_ln_router(Frame& F, const Args& A, int l) {
    LAS unsigned char* lds = F.lds;
    LAS int* cntl = (LAS int*)(lds + 66048); LAS int* basel = cntl + 32; LAS int* sel = cntl + 64; LAS int* lpos = cntl + 64 + 256;
    const bf16* U = (const bf16*)(F.ws + WS_U); bf16* HB = (bf16*)(F.ws + WS_HB); unsigned char* H8 = F.ws + WS_H8; const bf16* WRT = (const bf16*)(F.ws + WS_WRT);
    int* route = (int*)(F.ws + WS_ROUTE); int* lists = (int*)(F.ws + WS_LISTS);
    unsigned* counts = F.ctl + CW_CNT + l * 32 * 64;
    const float* g = A.in[I_LMG] + l * D_; const float* b = A.in[I_LMB] + l * D_; const float* rb = A.in[I_RB];
    int tid = F.tid; asm volatile("" : "+v"(tid));
    const int lane = tid & 63, wave = F.wave, fr = lane & 15, fq = lane >> 4;
    for (int q = tid; q < 32 * 128; q += 512) { const int e = q >> 7, c = q & 127; *(LAS v4u*)(lds + e * 2064 + c * 16) = *(const GAS v4u*)(WRT + e * 1024 + c * 8); }
    if (tid < 32) cntl[tid] = 0;
    f32x4 gv[4], bv[4];
#pragma unroll
    for (int j = 0; j < 4; ++j) { gv[j] = *(const f32x4*)(g + 4 * lane + 256 * j); bv[j] = *(const f32x4*)(b + 4 * lane + 256 * j); }
    __syncthreads();
    for (int blk = F.vcu; blk < T_ / 128; blk += F.G) {
#pragma unroll 1
        for (int i = 0; i < 16; i += 4) { const size_t m = (size_t)(blk * 128 + wave * 16 + i);
            v2u q[4][4];
#pragma unroll
            for (int u = 0; u < 4; ++u) { const GAS v2u* up = (const GAS v2u*)(U + (m + u) * D_) + lane;
#pragma unroll
                for (int j = 0; j < 4; ++j) q[u][j] = up[64 * j]; }
#pragma unroll
            for (int u = 0; u < 4; ++u) { f32x4 v[4]; float s = 0.f;
#pragma unroll
                for (int j = 0; j < 4; ++j) { v[j] = (f32x4){bflo(q[u][j].x), bfhi(q[u][j].x), bflo(q[u][j].y), bfhi(q[u][j].y)}; s += (v[j].x + v[j].y) + (v[j].z + v[j].w); }
                const float mean = wave_sum(s) * (1.f / D_); float s2 = 0.f;
#pragma unroll
                for (int j = 0; j < 4; ++j) { v[j] = v[j] - mean; s2 += (v[j].x * v[j].x + v[j].y * v[j].y) + (v[j].z * v[j].z + v[j].w * v[j].w); }
                const float rstd = __builtin_amdgcn_rsqf(wave_sum(s2) * (1.f / D_) + LN_EPS);
                GAS v2u* o8 = (GAS v2u*)(HB + (m + u) * D_) + lane; GAS unsigned* o4 = (GAS unsigned*)(H8 + (m + u) * D_) + lane;
#pragma unroll
                for (int j = 0; j < 4; ++j) { const f32x4 o = v[j] * rstd * gv[j] + bv[j]; v2u w; w.x = pk2(o.x, o.y); w.y = pk2(o.z, o.w); o8[64 * j] = w; o4[64 * j] = pk4_fp8(o.x, o.y, o.z, o.w); } }
        }
        VM_WAIT(); asm volatile("" ::: "memory");
        const int token = blk * 128 + wave * 16 + fr;
        f32x4 acc0 = (f32x4){0.f, 0.f, 0.f, 0.f}, acc1 = (f32x4){0.f, 0.f, 0.f, 0.f};
        const bf16* hrow = HB + (size_t)token * D_ + fq * 8;
#pragma unroll 16
        for (int k = 0; k < 32; ++k) { const int kk = k * 32 + fq * 8;
            const bf16x8 hf = *(const GAS bf16x8*)(hrow + k * 32);
            const bf16x8 w0 = *(const LAS bf16x8*)(lds + fr * 2064 + kk * 2), w1 = *(const LAS bf16x8*)(lds + (16 + fr) * 2064 + kk * 2);
            acc0 = __builtin_amdgcn_mfma_f32_16x16x32_bf16(w0, hf, acc0, 0, 0, 0);
            acc1 = __builtin_amdgcn_mfma_f32_16x16x32_bf16(w1, hf, acc1, 0, 0, 0);
        }
        float p0[4], p1[4]; float mx = -3.0e38f;
#pragma unroll
        for (int r = 0; r < 4; ++r) { p0[r] = acc0[r] + rb[4 * fq + r]; p1[r] = acc1[r] + rb[16 + 4 * fq + r]; mx = fmaxf(mx, fmaxf(p0[r], p1[r])); }
        mx = fmaxf(mx, __shfl_xor(mx, 16)); mx = fmaxf(mx, __shfl_xor(mx, 32));
#pragma unroll
        for (int r = 0; r < 4; ++r) { p0[r] = __expf(p0[r] - mx); p1[r] = __expf(p1[r] - mx); }
        float a1, a2, c1, c2; int ia1, ia2, ic1, ic2;
        top2of4(p0[0], p0[1], p0[2], p0[3], a1, ia1, a2, ia2); top2of4(p1[0], p1[1], p1[2], p1[3], c1, ic1, c2, ic2);
        const float sc0 = a1 + a2, sc1 = c1 + c2;
        float bs = sc0; int bg = fq; if (sc1 > sc0) { bs = sc1; bg = 4 + fq; }
#pragma unroll
        for (int off = 16; off <= 32; off <<= 1) { const float os = __shfl_xor(bs, off); const int og = __shfl_xor(bg, off); if (os > bs || (os == bs && og < bg)) { bs = os; bg = og; } }
        if ((bg & 3) == fq) {
            const bool hi = bg >= 4;
            const float pa = hi ? c1 : a1, pb = hi ? c2 : a2; const int ia = hi ? ic1 : ia1, ib = hi ? ic2 : ia2;
            const int ea = bg * 4 + ia, eb = bg * 4 + ib; const float inv = 1.0f / (pa + pb);
            const int tokl = wave * 16 + fr;
            const int la = atomicAdd((int*)&cntl[ea], 1), lb2 = atomicAdd((int*)&cntl[eb], 1);
            sel[tokl * 2] = ea; sel[tokl * 2 + 1] = eb; lpos[tokl * 2] = la; lpos[tokl * 2 + 1] = lb2;
            int* rt = route + (size_t)token * 8; rt[0] = ea; rt[2] = eb; rt[4] = __float_as_int(pa * inv); rt[5] = __float_as_int(pb * inv);
        }
        __syncthreads();
        if (tid < 32) { const int c = cntl[tid]; basel[tid] = c ? (int)__hip_atomic_fetch_add(counts + tid * 64, (unsigned)c, RLX_AGENT) : 0; }
        __syncthreads();
        if (tid < 256) { const int tokl = tid >> 1, k = tid & 1, e = sel[tid], pos = basel[e] + lpos[tid], tok = blk * 128 + tokl;
            lists[(size_t)e * 65536 + pos] = tok * 2 + k; route[(size_t)tok * 8 + 1 + 2 * k] = pos; }
        __syncthreads();
        if (tid < 32) cntl[tid] = 0;
        __syncthreads();
    }
}

__device__ __forceinline__ void moe_table(Frame& F, int l) {
    LAS int* tab = (LAS int*)(F.lds + TAB_OFF);
    __syncthreads();
    if (F.tid < 32) tab[40 + F.tid] = (int)__hip_atomic_load(F.ctl + CW_CNT + (l * 32 + F.tid) * 64, RLX_AGENT);
    __syncthreads();
    if (F.tid == 0) { int s = 0; for (int e = 0; e < 32; ++e) { tab[e] = s; s += (tab[40 + e] + 255) >> 8; } tab[32] = s; }
    __syncthreads();
    for (int t = F.tid; t < tab[32]; t += NWAVES * 64) { int e = 0; while (e < 31 && tab[e + 1] <= t) ++e; tab[80 + t] = e; }
    __syncthreads();
}

__device__ __forceinline__ void p7_combine_ln(Frame& F, const Args& A, int l) {
    const LAS int* tab = (const LAS int*)(F.lds + TAB_OFF);
    bf16* HB = (bf16*)(F.ws + WS_HB); const unsigned char* Y2S = F.ws + WS_Y2S; const int* route = (const int*)(F.ws + WS_ROUTE);
    const float* g = A.in[I_LFG] + l * D_; const float* b = A.in[I_LFB] + l * D_;
    int lane = F.lane; asm volatile("" : "+v"(lane));
    const int gw = F.vcu * NWAVES + F.wave, NGW = F.G * NWAVES;
    f32x4 gv[4], bv[4];
#pragma unroll
    for (int j = 0; j < 4; ++j) { gv[j] = *(const f32x4*)(g + 4 * lane + 256 * j); bv[j] = *(const f32x4*)(b + 4 * lane + 256 * j); }
    const bool last = (l == NL - 1);
    const int step = NGW * 2;
    int R[2][6], Rn[2][6];
    v2u hq[2][4], hn[2][4]; unsigned aq[2][4], cq[2][4], an[2][4], cn[2][4];
#define P7_ROUTE(m0_, R_) do { _Pragma("unroll") for (int _u = 0; _u < 2; ++_u) { const int* _rt = route + (size_t)((m0_) + _u) * 8; \
        _Pragma("unroll") for (int _k = 0; _k < 6; ++_k) R_[_u][_k] = _rt[_k]; } } while (0)
#define P7_ROWS(m0_, R_, hq_, aq_, cq_) do { _Pragma("unroll") for (int _u = 0; _u < 2; ++_u) { const int _m = (m0_) + _u; \
        const size_t _r0 = (size_t)tab[R_[_u][0]] * 256 + R_[_u][1], _r1 = (size_t)tab[R_[_u][2]] * 256 + R_[_u][3]; \
        const GAS v2u* _hp = (const GAS v2u*)(HB + (size_t)_m * D_) + lane; const GAS unsigned* _ya = (const GAS unsigned*)(Y2S + _r0 * D_) + lane; const GAS unsigned* _yb = (const GAS unsigned*)(Y2S + _r1 * D_) + lane; \
        _Pragma("unroll") for (int _j = 0; _j < 4; ++_j) { hq_[_u][_j] = _hp[64 * _j]; aq_[_u][_j] = _ya[64 * _j]; cq_[_u][_j] = _yb[64 * _j]; } } } while (0)
    int m0 = gw * 2;
    if (m0 < T_) { P7_ROUTE(m0, R); P7_ROWS(m0, R, hq, aq, cq); if (m0 + step < T_) P7_ROUTE(m0 + step, Rn); }
    for (; m0 < T_; m0 += step) {
        const bool has_n = m0 + step < T_;
        int Rnn[2][6];
        if (has_n) P7_ROWS(m0 + step, Rn, hn, an, cn);
        if (m0 + 2 * step < T_) P7_ROUTE(m0 + 2 * step, Rnn);
#pragma unroll
        for (int u = 0; u < 2; ++u) { const int m = m0 + u; f32x4 v[4]; float s = 0.f; const float g0 = __int_as_float(R[u][4]), g1 = __int_as_float(R[u][5]);
#pragma unroll
            for (int j = 0; j < 4; ++j) { const v2u h = hq[u][j]; const unsigned a = aq[u][j], c = cq[u][j];
                const f32x2 a01 = __builtin_amdgcn_cvt_pk_f32_fp8((int)a, false), a23 = __builtin_amdgcn_cvt_pk_f32_fp8((int)a, true), c01 = __builtin_amdgcn_cvt_pk_f32_fp8((int)c, false), c23 = __builtin_amdgcn_cvt_pk_f32_fp8((int)c, true);
                v[j].x = ALPHA * bflo(h.x) + g0 * a01.x + g1 * c01.x; v[j].y = ALPHA * bfhi(h.x) + g0 * a01.y + g1 * c01.y;
                v[j].z = ALPHA * bflo(h.y) + g0 * a23.x + g1 * c23.x; v[j].w = ALPHA * bfhi(h.y) + g0 * a23.y + g1 * c23.y;
                s += (v[j].x + v[j].y) + (v[j].z + v[j].w); }
            const float mean = wave_sum(s) * (1.f / D_); float s2 = 0.f;
#pragma unroll
            for (int j = 0; j < 4; ++j) { v[j] = v[j] - mean; s2 += (v[j].x * v[j].x + v[j].y * v[j].y) + (v[j].z * v[j].z + v[j].w * v[j].w); }
            const float rstd = __builtin_amdgcn_rsqf(wave_sum(s2) * (1.f / D_) + LN_EPS);
            if (last) { GAS f32x4* o = (GAS f32x4*)(A.out + (size_t)m * D_) + lane;
#pragma unroll
                for (int j = 0; j < 4; ++j) o[64 * j] = v[j] * rstd * gv[j] + bv[j];
            } else { GAS v2u* o8 = (GAS v2u*)(HB + (size_t)m * D_) + lane; float amax = 0.f;
#pragma unroll
                for (int j = 0; j < 4; ++j) { const f32x4 o = v[j] * rstd * gv[j] + bv[j]; v[j] = o; v2u w; w.x = pk2(o.x, o.y); w.y = pk2(o.z, o.w); o8[64 * j] = w;
                    amax = fmaxf(amax, fmaxf(fmaxf(fabsf(o.x), fabsf(o.y)), fmaxf(fabsf(o.z), fabsf(o.w)))); }
                if (GEMM1_I8) { amax = wave_max(amax); const float inv = amax > 0.f ? 127.f / amax : 0.f;
                    GAS unsigned* q4 = (GAS unsigned*)(F.ws + WS_HQ + (size_t)m * D_) + lane;
#pragma unroll
                    for (int j = 0; j < 4; ++j) q4[64 * j] = pk4_i8(v[j].x * inv, v[j].y * inv, v[j].z * inv, v[j].w * inv);
                    if (lane == 0) ((float*)(F.ws + WS_HS))[m] = amax * (1.f / 127.f); } }
        }
#pragma unroll
        for (int u = 0; u < 2; ++u) {
#pragma unroll
            for (int j = 0; j < 4; ++j) { hq[u][j] = hn[u][j]; aq[u][j] = an[u][j]; cq[u][j] = cn[u][j]; }
#pragma unroll
            for (int k = 0; k < 6; ++k) { R[u][k] = Rn[u][k]; Rn[u][k] = Rnn[u][k]; } }
    }
#undef P7_ROUTE
#undef P7_ROWS
}

#ifndef PH_NOINLINE
#define PH_NOINLINE __forceinline__
#endif
PH_NOINLINE __device__ void run_gemm1(LAS unsigned char* lds, unsigned char* ws, int l, int G, int c) {
    pg8::DenseOrder S;
    if (GEMM1_I8) { S.init(ws + WS_HQ, ws + WS_WIN + (size_t)l * N1 * 1024, T_, N1, D_ / 2, G, c, 1);
        pg8::EpiZq E{(bf16*)(ws + WS_Z), (const float*)(ws + WS_HS), (const float*)((unsigned*)(ws + WS_CTL) + CW_CMAX) + l * N1}; pg8::gemm_phase<pg8::EpiZq, pg8::DenseOrder, 2>(lds, S, E); }
    else { S.init(ws + WS_HB, ws + WS_WIN + (size_t)l * N1 * 1024 * 2, T_, N1, D_, G, c, 1); pg8::EpiZ E{(bf16*)(ws + WS_Z)}; pg8::gemm_phase(lds, S, E); }
}
PH_NOINLINE __device__ void run_gemm_probe(LAS unsigned char* lds, unsigned char* ws, int G, int c) {
    pg8::DenseOrder S; S.init(ws + WS_HB, ws + WS_WIN, T_, 256 * (PROBE_EXTRA_NN ? PROBE_EXTRA_NN : 1), D_, G, c);
    pg8::EpiPlain E{(bf16*)(ws + WS_Y), 2048};
    pg8::gemm_phase(lds, S, E);
}
PH_NOINLINE __device__ void run_gemm2(LAS unsigned char* lds, unsigned char* ws, int l, int G, int c) {
    pg8::EpiU E{(const bf16*)(ws + WS_HB), (bf16*)(ws + WS_U)};
    if (GEMM2_FP8) { pg8::DenseRowsOrder S; int kq = D_ / 2; asm volatile("" : "+s"(kq)); S.init(ws + WS_Y, ws + WS_WOUT + (size_t)l * 1024 * 1024, T_, D_, kq, G, c); pg8::gemm_phase<pg8::EpiU, pg8::DenseRowsOrder, true>(lds, S, E); }
    else { pg8::DenseOrder S; S.init(ws + WS_Y, ws + WS_WOUT + (size_t)l * 1024 * 1024 * 2, T_, D_, D_, G, c); pg8::gemm_phase(lds, S, E); }
}
PH_NOINLINE __device__ void run_gemm5(LAS unsigned char* lds, unsigned char* ws, int l, int G, int c) {
    const LAS int* tab = (const LAS int*)(lds + TAB_OFF);
    pg8::MoeGatherOrder S; S.A = (const char*)(ws + WS_H8); S.Bt = (const char*)(ws + WS_WGU + (size_t)l * NE * 1024 * 1024); S.bexp = (size_t)1024 * 1024;
    int kq = D_ / 2; asm volatile("" : "+s"(kq));
    S.K = kq; S.nN = 4; S.nwg = tab[32] * 4; S.G = G; S.c = c; S.tab = tab; S.lists = (const int*)(ws + WS_LISTS);
    pg8::EpiHid E{ws + WS_HID};
    pg8::gemm_phase<pg8::EpiHid, pg8::MoeGatherOrder, true>(lds, S, E);
}
PH_NOINLINE __device__ void run_gemm6(LAS unsigned char* lds, unsigned char* ws, int l, int G, int c) {
    const LAS int* tab = (const LAS int*)(lds + TAB_OFF);
    pg8::MoeRowsOrder S; S.A = (const char*)(ws + WS_HID); S.Bt = (const char*)(ws + WS_WD + (size_t)l * NE * 1024 * 512); S.bexp = (size_t)1024 * 512;
    int kq = DE / 2; asm volatile("" : "+s"(kq));
    S.K = kq; S.nN = 4; S.nwg = tab[32] * 4; S.G = G; S.c = c; S.tab = tab; S.lists = nullptr;
    pg8::EpiPlain8 E{ws + WS_Y2S, D_};
    pg8::gemm_phase<pg8::EpiPlain8, pg8::MoeRowsOrder, true>(lds, S, E);
}

__global__ void __launch_bounds__(NWAVES * 64, 2) mk_fwd(Args args) {
    extern __shared__ __attribute__((aligned(16))) unsigned char lds_raw[];
    Frame F;
    F.lds = (LAS unsigned char*)lds_raw;
    F.tid = threadIdx.x; F.lane = F.tid & 63; F.wave = __builtin_amdgcn_readfirstlane(F.tid >> 6);
    F.G = gridDim.x; { const int bx = blockIdx.x; F.vcu = (F.G % 8 == 0) ? (bx % 8) * (F.G / 8) + bx / 8 : bx; }
    F.ws = args.ws; F.ctl = (unsigned*)(args.ws + WS_CTL);
    for (int u = F.tid; u < (LDS_BYTES - LDSCTL_OFF) / 4; u += NWAVES * 64) ((LAS unsigned*)(F.lds + LDSCTL_OFF))[u] = 0u;
    __syncthreads();
    volatile LAS unsigned* MISC = (volatile LAS unsigned*)(F.lds + MISC_OFF);
    XcdBarrier bar; bar.bar = F.ctl + CW_BAR; bar.x = 0; bar.st = nullptr;
    if (MK_N_LAUNCHES == 1) bar = xcd_barrier_post(F.ctl + CW_BAR, MISC + 8);
    const int lo = args.ph_lo, hi = args.ph_hi;
#define IN(k) (lo <= (k) && (k) < hi)
#define SEAM(k) do { if (MK_N_LAUNCHES == 1 && (k) + 1 < hi) xcd_barrier(bar); } while (0)
    if (REPEAT_MASK & 256) { for (int rep = 0; rep < 10; ++rep) xcd_barrier(bar); }
    if ((PH_MASK & 1) && IN(0)) { for (int rep = 0; rep < ((REPEAT_MASK & 1) ? 2 : 1); ++rep) { p0_prologue(F, args); SEAM(0); } }
#pragma unroll 1
    for (int l = 0; l < NL; ++l) {
        const int pb = 1 + 7 * l;
        if ((PH_MASK & 2) && IN(pb + 0)) { for (int rep = 0; rep < ((REPEAT_MASK & 2) ? 2 : 1); ++rep) { run_gemm1(F.lds, F.ws, l, F.G, (int)blockIdx.x); SEAM(pb + 0); }
            if (PROBE_EXTRA_NN && l == 0) { run_gemm_probe(F.lds, F.ws, F.G, (int)blockIdx.x); xcd_barrier(bar); } }
        if ((PH_MASK & 4) && IN(pb + 1)) { for (int rep = 0; rep < ((REPEAT_MASK & 4) ? 2 : 1); ++rep) { p2_mixer(F, args, l); SEAM(pb + 1); } }
        if ((PH_MASK & 8) && IN(pb + 2)) { for (int rep = 0; rep < ((REPEAT_MASK & 8) ? 2 : 1); ++rep) { run_gemm2(F.lds, F.ws, l, F.G, (int)blockIdx.x); SEAM(pb + 2); } }
        if ((PH_MASK & 16) && IN(pb + 3)) {
            if (REPEAT_MASK & 16) { p4_ln_router(F, args, l); SEAM(pb + 3);
                if (blockIdx.x == 0 && F.tid < 32) __hip_atomic_store(F.ctl + CW_CNT + (l * 32 + F.tid) * 64, 0u, RLX_AGENT);
                SEAM(pb + 3); }
            p4_ln_router(F, args, l); SEAM(pb + 3); }
        if ((PH_MASK & 32) && IN(pb + 4)) { for (int rep = 0; rep < ((REPEAT_MASK & 32) ? 2 : 1); ++rep) { moe_table(F, l); run_gemm5(F.lds, F.ws, l, F.G, (int)blockIdx.x); SEAM(pb + 4); } }
        if ((PH_MASK & 64) && IN(pb + 5)) { for (int rep = 0; rep < ((REPEAT_MASK & 64) ? 2 : 1); ++rep) { if (MK_N_LAUNCHES != 1 || rep) moe_table(F, l); run_gemm6(F.lds, F.ws, l, F.G, (int)blockIdx.x); SEAM(pb + 5); } }
        if ((PH_MASK & 128) && IN(pb + 6)) { for (int rep = 0; rep < (((REPEAT_MASK & 128) && l == NL - 1) ? 2 : 1); ++rep) { if (MK_N_LAUNCHES != 1) moe_table(F, l); p7_combine_ln(F, args, l); if (rep == 0) SEAM(pb + 6); else xcd_barrier(bar); } }
    }
#undef IN
#undef SEAM
}

extern "C" void kernel_launch(void* const* d_in, const int* in_sizes, int n_in, void* d_out, int out_size, void* d_ws, size_t ws_size, hipStream_t stream) {
    static int grid = 0;
    if (grid == 0) {
        if (n_in != 21 || out_size != T_ * D_ || ws_size < WS_END) { fprintf(stderr, "kernel_launch: unexpected problem (n_in %d, out %d, ws %zu); nothing launched\n", n_in, out_size, ws_size); grid = -1; return; }
        int dev = 0, cus = 0, per_cu = 0;
        if (hipGetDevice(&dev) != hipSuccess || hipDeviceGetAttribute(&cus, hipDeviceAttributeMultiprocessorCount, dev) != hipSuccess) { grid = -1; return; }
        if (hipFuncSetAttribute((const void*)mk_fwd, hipFuncAttributeMaxDynamicSharedMemorySize, LDS_BYTES) != hipSuccess) { fprintf(stderr, "kernel_launch: hipFuncSetAttribute failed\n"); grid = -1; return; }
        if (hipOccupancyMaxActiveBlocksPerMultiprocessor(&per_cu, (const void*)mk_fwd, NWAVES * 64, LDS_BYTES) != hipSuccess || per_cu < 1) { fprintf(stderr, "kernel_launch: occupancy query says %d\n", per_cu); }
        (void)hipGetLastError();
        grid = cus;
    }
    if (grid < 0) return;
    (void)hipMemsetAsync((char*)d_ws + WS_CTL, 0, CTL_ZERO_BYTES, stream);
    Args a{};
    for (int i = 0; i < 21; ++i) a.in[i] = (const float*)d_in[i];
    a.out = (float*)d_out; a.ws = (unsigned char*)d_ws;
    if (MK_N_LAUNCHES == 1) { a.ph_lo = 0; a.ph_hi = NPH; hipLaunchKernelGGL(mk_fwd, dim3(grid), dim3(NWAVES * 64), LDS_BYTES, stream, a); }
    else for (int p = 0; p < NPH; ++p) { a.ph_lo = p; a.ph_hi = p + 1; hipLaunchKernelGGL(mk_fwd, dim3(grid), dim3(NWAVES * 64), LDS_BYTES, stream, a); }
}
```

```cpp
#include <hip/hip_runtime.h>
#include <cstdio>
#include <cstdint>

#ifndef MK_N_LAUNCHES
#define MK_N_LAUNCHES 1
#endif
#ifndef PH_MASK
#define PH_MASK 0xff
#endif
#ifndef REPEAT_MASK
#define REPEAT_MASK 0
#endif
#ifndef GEMM1_I8
#define GEMM1_I8 1
#endif
#ifndef GEMM2_FP8
#define GEMM2_FP8 1
#endif
#ifndef PROBE_P0
#define PROBE_P0 0
#endif
#ifndef PROBE_MIX
#define PROBE_MIX 0
#endif
#ifndef PROBE_EXTRA_NN
#define PROBE_EXTRA_NN 0
#endif
#ifndef GEMM_SIMPLE_MASK
#define GEMM_SIMPLE_MASK 0
#endif

#define GAS __attribute__((address_space(1)))
#define LAS __attribute__((address_space(3)))
typedef unsigned short bf16;
typedef unsigned v4u __attribute__((ext_vector_type(4)));
typedef unsigned v2u __attribute__((ext_vector_type(2)));
typedef float f32x4 __attribute__((ext_vector_type(4)));
typedef float f32x2 __attribute__((ext_vector_type(2)));
typedef short bf16x8 __attribute__((ext_vector_type(8)));
#define RLX_AGENT __ATOMIC_RELAXED, __HIP_MEMORY_SCOPE_AGENT
#define LDS_WAIT() asm volatile("s_waitcnt lgkmcnt(0)" ::: "memory")
#define VM_WAIT() asm volatile("s_waitcnt vmcnt(0)" ::: "memory")

constexpr int T_ = 32768, D_ = 1024, SEQ_ = 4096, NL = 2, NE = 32, DE = 512;
constexpr int DIN = 2176, N1 = 2304, NZ = 1408;
constexpr float ALPHA = 1.41421356237f, LN_EPS = 1e-5f;
constexpr int NPH = 1 + 7 * NL;

constexpr size_t MiB = 1u << 20;
constexpr size_t WS_CTL = 0, CTL_ZERO_BYTES = 128 * 1024;
constexpr size_t WS_ROUTE = 1 * MiB;
constexpr size_t WS_WRT = 2 * MiB;
constexpr size_t WS_HS = 2 * MiB + 256 * 1024;
constexpr size_t WS_CS = 2 * MiB + 512 * 1024;
constexpr size_t WS_LISTS = 3 * MiB;
constexpr size_t WS_WIN = 11 * MiB;
constexpr size_t WS_WOUT = 20 * MiB;
constexpr size_t WS_WGU = 24 * MiB;
constexpr size_t WS_H8 = 88 * MiB;
constexpr size_t WS_HQ = 120 * MiB;
constexpr size_t WS_WD = 152 * MiB;
constexpr size_t WS_HB = 216 * MiB;
constexpr size_t WS_Z = 280 * MiB;
constexpr size_t WS_Y = 368 * MiB;
constexpr size_t WS_U = 280 * MiB;
constexpr size_t WS_HID = 280 * MiB;
constexpr size_t WS_Y2S = 352 * MiB;
constexpr size_t WS_END = 496 * MiB;
constexpr int CW_TMO = 0, CW_BAR = 4096, CW_CNT = 16384, CW_CMAX = 20480  , CW_CMAXCNT = 25600;

constexpr int RING_BYTES = 131072, LDSCTL_OFF = RING_BYTES, MISC_OFF = LDSCTL_OFF + 320, TAB_OFF = LDSCTL_OFF + 1024;
constexpr int LDS_BYTES = 147456;

__device__ __forceinline__ unsigned f2bf(float f) { unsigned u = __builtin_bit_cast(unsigned, f); return (u + 0x7fffu + ((u >> 16) & 1u)) >> 16; }
__device__ __forceinline__ unsigned pk2(float lo, float hi) { unsigned r; asm("v_cvt_pk_bf16_f32 %0, %1, %2" : "=v"(r) : "v"(lo), "v"(hi)); return r; }
__device__ __forceinline__ float bflo(unsigned u) { return __builtin_bit_cast(float, u << 16); }
__device__ __forceinline__ float bfhi(unsigned u) { return __builtin_bit_cast(float, u & 0xffff0000u); }
template <int CTRL> __device__ __forceinline__ float dpp_mov(float v) { return __builtin_bit_cast(float, __builtin_amdgcn_update_dpp(0, __builtin_bit_cast(int, v), CTRL, 0xf, 0xf, false)); }
__device__ __forceinline__ float wave_sum(float v) {
    v += dpp_mov<0xB1>(v); v += dpp_mov<0x4E>(v); v += dpp_mov<0x141>(v); v += dpp_mov<0x140>(v);
    const int iv = __builtin_bit_cast(int, v);
    return (__builtin_bit_cast(float, __builtin_amdgcn_readlane(iv, 0)) + __builtin_bit_cast(float, __builtin_amdgcn_readlane(iv, 16))) +
           (__builtin_bit_cast(float, __builtin_amdgcn_readlane(iv, 32)) + __builtin_bit_cast(float, __builtin_amdgcn_readlane(iv, 48)));
}
__device__ __forceinline__ float wave_max(float v) {
    v = fmaxf(v, dpp_mov<0xB1>(v)); v = fmaxf(v, dpp_mov<0x4E>(v)); v = fmaxf(v, dpp_mov<0x141>(v)); v = fmaxf(v, dpp_mov<0x140>(v));
    const int iv = __builtin_bit_cast(int, v);
    return fmaxf(fmaxf(__builtin_bit_cast(float, __builtin_amdgcn_readlane(iv, 0)), __builtin_bit_cast(float, __builtin_amdgcn_readlane(iv, 16))),
                 fmaxf(__builtin_bit_cast(float, __builtin_amdgcn_readlane(iv, 32)), __builtin_bit_cast(float, __builtin_amdgcn_readlane(iv, 48))));
}
__device__ __forceinline__ unsigned pk4_i8(float a, float b, float c, float d) {
    const int ia = (int)__builtin_rintf(a), ib = (int)__builtin_rintf(b), ic = (int)__builtin_rintf(c), id = (int)__builtin_rintf(d);
    return ((unsigned)ia & 0xffu) | (((unsigned)ib & 0xffu) << 8) | (((unsigned)ic & 0xffu) << 16) | ((unsigned)id << 24); }
__device__ __forceinline__ unsigned pk4_fp8(float a, float b, float c, float d) {
    int v = 0; v = __builtin_amdgcn_cvt_pk_fp8_f32(a, b, v, false); v = __builtin_amdgcn_cvt_pk_fp8_f32(c, d, v, true); return (unsigned)v; }
__device__ __forceinline__ float sigmoidf_(float x) { return __builtin_amdgcn_rcpf(1.0f + __expf(-x)); }

namespace pg8 {
#define PG8_LAS __attribute__((address_space(3)))
typedef int v8i __attribute__((ext_vector_type(8)));
typedef int v4i __attribute__((ext_vector_type(4)));
constexpr int BM = 256, BK = 64, HALF = 128, HTB = HALF * BK * 2, STAGE_BYTES = 8 * HTB, NXCD = 8, WGM = 8;
__host__ __device__ __forceinline__ int lds_byte(int r, int c) { const int st = (r >> 4) * 2 + (c >> 5), rr = r & 15, cc = c & 31, ob = rr * 64 + cc * 2; return st * 1024 + (ob ^ (((ob >> 9) & 1) << 5)); }
__host__ __device__ __forceinline__ void stage_rc(int b, int& R, int& C) { const int st = b / 1024, sb = b % 1024, swz = sb ^ (((sb >> 9) & 1) << 5); R = (st >> 1) * 16 + swz / 64; C = (st & 1) * 32 + (swz % 64) / 2; }
__host__ __device__ __forceinline__ int perm32(int rho) { const int n = rho >> 4, i = rho & 15; return 8 * (i >> 2) + 4 * n + (i & 3); }

struct Unit { int pm, pn, e, j, rh; };

__device__ __forceinline__ int xcd_remap(int wgid, int nwg) { const int q = nwg / NXCD, r = nwg % NXCD, xcd = wgid % NXCD, off = wgid / NXCD; return (xcd < r ? xcd * (q + 1) : r * (q + 1) + (xcd - r) * q) + off; }

struct DenseOrder {
    static constexpr bool GATHER = false, HAS_HALF = true, HAS_RH = false;
    const char* A; const char* Bt; int K, nM, nN, nwg, G, c, nhalf;
    __device__ void init(const void* A_, const void* Bt_, int M, int N, int K_, int G_, int c_, int half_tile = 0) { A = (const char*)A_; Bt = (const char*)Bt_; K = K_; nM = M / BM; nN = N / BM - half_tile; nwg = nM * nN; G = G_; c = c_; nhalf = half_tile ? nM : 0; }
    __device__ bool next(int i, Unit& u) const {
        const long L = (long)i * G + c; if (L >= nwg + nhalf) return false;
        u.e = 0; u.j = 0; u.rh = -1;
        if (L >= nwg) { u.pm = (int)(L - nwg); u.pn = nN; return true; }
        const int wgid = xcd_remap((int)L, nwg);
        const int nig = WGM * nN, gid = wgid / nig, fm = gid * WGM, gsz = (nM - fm) < WGM ? (nM - fm) : WGM;
        u.pm = fm + ((wgid % nig) % gsz); u.pn = (wgid % nig) / gsz; return true;
    }
    __device__ __forceinline__ bool is_half(const Unit& u) const { return u.pn >= nN; }
    __device__ __forceinline__ int row_half(const Unit&) const { return -1; }
    __device__ __forceinline__ const char* a_tile(const Unit& u) const { return A + (size_t)u.pm * BM * K * 2; }
    __device__ __forceinline__ const char* b_tile(const Unit& u) const { return Bt + (size_t)u.pn * BM * K * 2; }
    __device__ __forceinline__ unsigned a_row_off(const Unit&, int r) const { return (unsigned)(r * K * 2); }
};
struct DenseRowsOrder : DenseOrder {
    static constexpr bool GATHER = true, HAS_HALF = false;
    __device__ __forceinline__ const char* a_tile(const Unit&) const { return A; }
    __device__ __forceinline__ unsigned a_row_off(const Unit& u, int r) const { return (unsigned)(u.pm * BM + r) * (unsigned)(K * 2); }
};
struct MoeOrder {
    static constexpr bool HAS_HALF = false, HAS_RH = true;
    __device__ __forceinline__ bool is_half(const Unit&) const { return false; }
    const char* A; const char* Bt; size_t bexp; int K, nN, nwg, G, c; const PG8_LAS int* tab; const int* lists;
    __device__ bool next(int i, Unit& u) const {
        const int L = i * G + c, nfull = (nwg / G) * G, rem = nwg - nfull;
        int uidx = L; u.rh = -1;
        if (L >= nfull) { if (2 * rem <= G) { if (L >= nfull + 2 * rem) return false; uidx = nfull + ((L - nfull) >> 1); u.rh = (L - nfull) & 1; } else if (L >= nwg) return false; }
        const int wgid = xcd_remap(uidx, nwg);
        const int t = wgid / nN; u.pn = wgid % nN; u.pm = t;
        const int e = tab[80 + t];
        u.e = e; u.j = t - tab[e]; return true;
    }
    __device__ __forceinline__ int row_half(const Unit& u) const { return u.rh; }
    __device__ __forceinline__ const char* b_tile(const Unit& u) const { return Bt + (size_t)u.e * bexp + (size_t)u.pn * BM * K * 2; }
};
struct MoeGatherOrder : MoeOrder {
    static constexpr bool GATHER = true;
    __device__ __forceinline__ const char* a_tile(const Unit&) const { return A; }
    __device__ __forceinline__ unsigned a_row_off(const Unit& u, int r) const {
        const int idx = u.j * BM + r, cnt = tab[40 + u.e];
        const int ii = idx < cnt ? idx : cnt - 1;
        const int tok = lists[(size_t)u.e * 65536 + ii] >> 1;
        return (unsigned)tok * (unsigned)(K * 2);
    }
};
struct MoeRowsOrder : MoeOrder {
    static constexpr bool GATHER = true;
    __device__ __forceinline__ const char* a_tile(const Unit&) const { return A; }
    __device__ __forceinline__ unsigned a_row_off(const Unit& u, int r) const { return (unsigned)(u.pm * BM + r) * (unsigned)(K * 2); }
};
struct MoeDenseOrder : MoeOrder {
    static constexpr bool GATHER = false;
    __device__ __forceinline__ const char* a_tile(const Unit& u) const { return A + (size_t)u.pm * BM * K * 2; }
    __device__ __forceinline__ unsigned a_row_off(const Unit&, int r) const { return (unsigned)(r * K * 2); }
};

__device__ __forceinline__ unsigned cvt_pk_bf16(float lo, float hi) { unsigned r; asm volatile("v_cvt_pk_bf16_f32 %0, %1, %2" : "=v"(r) : "v"(lo), "v"(hi)); return r; }

struct EpiZ {
    static constexpr bool PERM = true;
    bf16* Z;
    __device__ __forceinline__ void operator()(const f32x4 (&acc)[2][2][4][2], const Unit& u, int wr, int wc, int fr, int fq) const {
        const int row0 = u.pm * BM + wr * 64 + fr, cl = wc * 32 + 8 * fq;
        if (u.pn < 6) {
            const bool sg = u.pn >= 3;
            const int zc = (sg ? 768 + (u.pn - 3) * 128 : 384 + u.pn * 128) + cl;
#pragma unroll
            for (int ai = 0; ai < 2; ++ai)
#pragma unroll
                for (int m = 0; m < 4; ++m) {
                    f32x4 a0 = acc[ai][0][m][0], a1 = acc[ai][0][m][1], g0 = acc[ai][1][m][0], g1 = acc[ai][1][m][1];
                    if (sg) {
#pragma unroll
                        for (int q = 0; q < 4; ++q) { g0[q] = sigmoidf_(g0[q]); g1[q] = sigmoidf_(g1[q]); }
                    }
                    a0 = a0 * g0; a1 = a1 * g1;
                    v4u w; w.x = cvt_pk_bf16(a0[0], a0[1]); w.y = cvt_pk_bf16(a0[2], a0[3]); w.z = cvt_pk_bf16(a1[0], a1[1]); w.w = cvt_pk_bf16(a1[2], a1[3]);
                    *(v4u*)(Z + (size_t)(row0 + ai * HALF + m * 16) * NZ + zc) = w;
                }
        } else {
            int zb0, zb1;
            if (u.pn == 6) { zb0 = 0; zb1 = 128; } else if (u.pn == 7) { zb0 = 256; zb1 = 1152; } else { zb0 = 1280; zb1 = -1; }
#pragma unroll
            for (int ai = 0; ai < 2; ++ai)
#pragma unroll
                for (int m = 0; m < 4; ++m) {
                    bf16* rowp = Z + (size_t)(row0 + ai * HALF + m * 16) * NZ + cl;
#pragma unroll
                    for (int bj = 0; bj < 2; ++bj) {
                        const int zb = bj ? zb1 : zb0;
                        if (zb >= 0) { const f32x4 a0 = acc[ai][bj][m][0], a1 = acc[ai][bj][m][1];
                            v4u w; w.x = cvt_pk_bf16(a0[0], a0[1]); w.y = cvt_pk_bf16(a0[2], a0[3]); w.z = cvt_pk_bf16(a1[0], a1[1]); w.w = cvt_pk_bf16(a1[2], a1[3]);
                            *(v4u*)(rowp + zb) = w; }
                    }
                }
        }
    }
};
struct EpiZq {
    static constexpr bool PERM = true;
    bf16* Z; const float* hs; const float* cs;
    __device__ __forceinline__ void operator()(f32x4 (&acc)[2][2][4][2], const Unit& u, int wr, int wc, int fr, int fq) const {
        const int row0 = u.pm * BM + wr * 64 + fr, cl = wc * 32 + 8 * fq;
        {
            float rs[2][4]; f32x4 cv[2][2];
#pragma unroll
            for (int ai = 0; ai < 2; ++ai)
#pragma unroll
                for (int m = 0; m < 4; ++m) rs[ai][m] = hs[row0 + ai * HALF + m * 16];
#pragma unroll
            for (int bj = 0; bj < 2; ++bj)
#pragma unroll
                for (int n = 0; n < 2; ++n) cv[bj][n] = *(const f32x4*)(cs + u.pn * BM + bj * HALF + cl + 4 * n) * (1.f / 127.f);
#pragma unroll
            for (int ai = 0; ai < 2; ++ai)
#pragma unroll
                for (int bj = 0; bj < 2; ++bj)
#pragma unroll
                    for (int m = 0; m < 4; ++m)
#pragma unroll
                        for (int n = 0; n < 2; ++n) { const v4i q = __builtin_bit_cast(v4i, acc[ai][bj][m][n]);
                            acc[ai][bj][m][n] = (f32x4){(float)q.x, (float)q.y, (float)q.z, (float)q.w} * rs[ai][m] * cv[bj][n]; }
        }
        if (u.pn < 6) {
            const bool sg = u.pn >= 3;
            const int zc = (sg ? 768 + (u.pn - 3) * 128 : 384 + u.pn * 128) + cl;
#pragma unroll
            for (int ai = 0; ai < 2; ++ai)
#pragma unroll
                for (int m = 0; m < 4; ++m) {
                    f32x4 a0 = acc[ai][0][m][0], a1 = acc[ai][0][m][1], g0 = acc[ai][1][m][0], g1 = acc[ai][1][m][1];
                    if (sg) {
#pragma unroll
                        for (int q = 0; q < 4; ++q) { g0[q] = sigmoidf_(g0[q]); g1[q] = sigmoidf_(g1[q]); }
                    }
                    a0 = a0 * g0; a1 = a1 * g1;
                    v4u w; w.x = cvt_pk_bf16(a0[0], a0[1]); w.y = cvt_pk_bf16(a0[2], a0[3]); w.z = cvt_pk_bf16(a1[0], a1[1]); w.w = cvt_pk_bf16(a1[2], a1[3]);
                    *(v4u*)(Z + (size_t)(row0 + ai * HALF + m * 16) * NZ + zc) = w;
                }
        } else {
            int zb0, zb1;
            if (u.pn == 6) { zb0 = 0; zb1 = 128; } else if (u.pn == 7) { zb0 = 256; zb1 = 1152; } else { zb0 = 1280; zb1 = -1; }
#pragma unroll
            for (int ai = 0; ai < 2; ++ai)
#pragma unroll
                for (int m = 0; m < 4; ++m) {
                    bf16* rowp = Z + (size_t)(row0 + ai * HALF + m * 16) * NZ + cl;
#pragma unroll
                    for (int bj = 0; bj < 2; ++bj) {
                        const int zb = bj ? zb1 : zb0;
                        if (zb >= 0) { const f32x4 a0 = acc[ai][bj][m][0], a1 = acc[ai][bj][m][1];
                            v4u w; w.x = cvt_pk_bf16(a0[0], a0[1]); w.y = cvt_pk_bf16(a0[2], a0[3]); w.z = cvt_pk_bf16(a1[0], a1[1]); w.w = cvt_pk_bf16(a1[2], a1[3]);
                            *(v4u*)(rowp + zb) = w; }
                    }
                }
        }
    }
};
struct EpiU {
    static constexpr bool PERM = true;
    const bf16* H; bf16* U;
    __device__ __forceinline__ void operator()(const f32x4 (&acc)[2][2][4][2], const Unit& u, int wr, int wc, int fr, int fq) const {
        const int row0 = u.pm * BM + wr * 64 + fr, col0 = u.pn * BM + wc * 32 + 8 * fq;
        v4u hh[2][4][2];
#pragma unroll
        for (int ai = 0; ai < 2; ++ai)
#pragma unroll
            for (int m = 0; m < 4; ++m)
#pragma unroll
                for (int bj = 0; bj < 2; ++bj) hh[ai][m][bj] = *(const v4u*)(H + (size_t)(row0 + ai * HALF + m * 16) * D_ + col0 + bj * HALF);
#pragma unroll
        for (int ai = 0; ai < 2; ++ai)
#pragma unroll
            for (int m = 0; m < 4; ++m) {
                const size_t off = (size_t)(row0 + ai * HALF + m * 16) * D_ + col0;
#pragma unroll
                for (int bj = 0; bj < 2; ++bj) {
                    const v4u h = hh[ai][m][bj];
                    const f32x4 a0 = acc[ai][bj][m][0], a1 = acc[ai][bj][m][1];
                    v4u w;
                    w.x = cvt_pk_bf16(ALPHA * bflo(h.x) + a0[0], ALPHA * bfhi(h.x) + a0[1]); w.y = cvt_pk_bf16(ALPHA * bflo(h.y) + a0[2], ALPHA * bfhi(h.y) + a0[3]);
                    w.z = cvt_pk_bf16(ALPHA * bflo(h.z) + a1[0], ALPHA * bfhi(h.z) + a1[1]); w.w = cvt_pk_bf16(ALPHA * bflo(h.w) + a1[2], ALPHA * bfhi(h.w) + a1[3]);
                    *(v4u*)(U + off + bj * HALF) = w;
                }
            }
    }
};
struct EpiHid {
    static constexpr bool PERM = true;
    unsigned char* HID;
    __device__ __forceinline__ void operator()(const f32x4 (&acc)[2][2][4][2], const Unit& u, int wr, int wc, int fr, int fq) const {
        const int row0 = u.pm * BM + wr * 64 + fr, col0 = u.pn * 128 + wc * 32 + 8 * fq;
#pragma unroll
        for (int ai = 0; ai < 2; ++ai) { if (u.rh >= 0 && u.rh != ai) continue;
#pragma unroll
            for (int m = 0; m < 4; ++m) {
                f32x4 g0 = acc[ai][0][m][0], g1 = acc[ai][0][m][1]; const f32x4 u0 = acc[ai][1][m][0], u1 = acc[ai][1][m][1];
#pragma unroll
                for (int q = 0; q < 4; ++q) { g0[q] = g0[q] * sigmoidf_(g0[q]); g1[q] = g1[q] * sigmoidf_(g1[q]); }
                g0 = g0 * u0; g1 = g1 * u1;
                v2u w; w.x = pk4_fp8(g0[0], g0[1], g0[2], g0[3]); w.y = pk4_fp8(g1[0], g1[1], g1[2], g1[3]);
                *(v2u*)(HID + (size_t)(row0 + ai * HALF + m * 16) * DE + col0) = w;
            } }
    }
};
struct EpiPlain8 {
    static constexpr bool PERM = true;
    unsigned char* O; int ldc;
    __device__ __forceinline__ void operator()(const f32x4 (&acc)[2][2][4][2], const Unit& u, int wr, int wc, int fr, int fq) const {
        const int row0 = u.pm * BM + wr * 64 + fr, col0 = u.pn * BM + wc * 32 + 8 * fq;
#pragma unroll
        for (int ai = 0; ai < 2; ++ai) { if (u.rh >= 0 && u.rh != ai) continue;
#pragma unroll
            for (int m = 0; m < 4; ++m) {
                unsigned char* rowp = O + (size_t)(row0 + ai * HALF + m * 16) * ldc + col0;
#pragma unroll
                for (int bj = 0; bj < 2; ++bj) { const f32x4 a0 = acc[ai][bj][m][0], a1 = acc[ai][bj][m][1];
                    v2u w; w.x = pk4_fp8(a0[0], a0[1], a0[2], a0[3]); w.y = pk4_fp8(a1[0], a1[1], a1[2], a1[3]);
                    *(v2u*)(rowp + bj * HALF) = w; }
            } }
    }
};
struct EpiPlain {
    static constexpr bool PERM = true;
    bf16* O; int ldc;
    __device__ __forceinline__ void operator()(const f32x4 (&acc)[2][2][4][2], const Unit& u, int wr, int wc, int fr, int fq) const {
        const int row0 = u.pm * BM + wr * 64 + fr, col0 = u.pn * BM + wc * 32 + 8 * fq;
#pragma unroll
        for (int ai = 0; ai < 2; ++ai)
#pragma unroll
            for (int m = 0; m < 4; ++m) {
                bf16* rowp = O + (size_t)(row0 + ai * HALF + m * 16) * ldc + col0;
#pragma unroll
                for (int bj = 0; bj < 2; ++bj) { const f32x4 a0 = acc[ai][bj][m][0], a1 = acc[ai][bj][m][1];
                    v4u w; w.x = cvt_pk_bf16(a0[0], a0[1]); w.y = cvt_pk_bf16(a0[2], a0[3]); w.z = cvt_pk_bf16(a1[0], a1[1]); w.w = cvt_pk_bf16(a1[2], a1[3]);
                    *(v4u*)(rowp + bj * HALF) = w; }
            }
    }
};

template <class Epi, class Sched>
__device__ __forceinline__ void gemm_phase_simple(const Sched& S, const Epi& E) {
    int tid = threadIdx.x; asm volatile("" : "+v"(tid));
    const int wid = __builtin_amdgcn_readfirstlane(tid >> 6), lane = tid & 63, wr = wid >> 2, wc = wid & 3, fr = lane & 15, fq = lane >> 4;
    const int K = S.K;
    Unit cur;
    for (int ui = 0; S.next(ui, cur); ++ui) {
        f32x4 acc[2][2][4][2];
#pragma unroll
        for (int a = 0; a < 2; ++a)
#pragma unroll
            for (int b = 0; b < 2; ++b)
#pragma unroll
                for (int m = 0; m < 4; ++m)
#pragma unroll
                    for (int n = 0; n < 2; ++n) acc[a][b][m][n] = (f32x4){0.f, 0.f, 0.f, 0.f};
        const char* at = S.a_tile(cur); const char* bt = S.b_tile(cur);
        const char* ap[2][4]; const char* bp[2][2];
#pragma unroll
        for (int ai = 0; ai < 2; ++ai)
#pragma unroll
            for (int m = 0; m < 4; ++m) ap[ai][m] = at + S.a_row_off(cur, ai * HALF + wr * 64 + m * 16 + fr) + fq * 16;
#pragma unroll
        for (int bj = 0; bj < 2; ++bj)
#pragma unroll
            for (int n = 0; n < 2; ++n) { const int rho = n * 16 + fr; bp[bj][n] = bt + (size_t)(bj * HALF + wc * 32 + (Epi::PERM ? perm32(rho) : rho)) * K * 2 + fq * 16; }
        for (int k0 = 0; k0 < K; k0 += 32) {
            bf16x8 a[2][4], b[2][2];
#pragma unroll
            for (int ai = 0; ai < 2; ++ai)
#pragma unroll
                for (int m = 0; m < 4; ++m) a[ai][m] = *(const bf16x8*)(ap[ai][m] + k0 * 2);
#pragma unroll
            for (int bj = 0; bj < 2; ++bj)
#pragma unroll
                for (int n = 0; n < 2; ++n) b[bj][n] = *(const bf16x8*)(bp[bj][n] + k0 * 2);
#pragma unroll
            for (int ai = 0; ai < 2; ++ai)
#pragma unroll
                for (int bj = 0; bj < 2; ++bj)
#pragma unroll
                    for (int m = 0; m < 4; ++m)
#pragma unroll
                        for (int n = 0; n < 2; ++n) acc[ai][bj][m][n] = __builtin_amdgcn_mfma_f32_16x16x32_bf16(b[bj][n], a[ai][m], acc[ai][bj][m][n], 0, 0, 0);
        }
        E(acc, cur, wr, wc, fr, fq);
    }
}

template <int OFF> __device__ __forceinline__ void glds16(const char* base, unsigned voff, unsigned lds_base) {
    asm volatile("s_add_u32 m0, %2, %3\n\ts_nop 0\n\tglobal_load_lds_dwordx4 %0, %1" :: "v"(voff), "s"(base), "s"(lds_base), "n"(OFF) : "memory", "m0", "scc");
}
template <class Epi, class Sched, int MODE = 0  >
__device__ __forceinline__ void gemm_phase(PG8_LAS unsigned char* lds, const Sched& S, const Epi& E) {
    constexpr bool GATHER = Sched::GATHER;
    int tid = threadIdx.x; asm volatile("" : "+v"(tid));
    const int wid = __builtin_amdgcn_readfirstlane(tid >> 6), lane = tid & 63, wr = wid >> 2, wc = wid & 3, fr = lane & 15, fq = lane >> 4;
    const int K = S.K, nt = K / BK;
    unsigned voffB[2], offA[4], nxA[4];
#pragma unroll
    for (int i = 0; i < 2; ++i) { int R, C; stage_rc(tid * 16 + i * 8192, R, C); const int Rb = Epi::PERM ? ((R & ~31) + perm32(R & 31)) : R;
        voffB[i] = (unsigned)(Rb * K + C) * 2u; offA[i] = (unsigned)(R * K + C) * 2u; offA[2 + i] = (unsigned)((R + HALF) * K + C) * 2u; nxA[i] = 0u; nxA[2 + i] = 0u; }
    const size_t kstep = (size_t)(BK * 2);
    const size_t hstep = (size_t)HALF * K * 2;
    const unsigned ldsw = (unsigned)wid * 1024u;
    const unsigned ldsbw = (unsigned)(size_t)lds + ldsw;
    const int aoff = lds_byte(wr * 64 + fr, fq * 8), boff = lds_byte(wc * 32 + fr, fq * 8);
#define PG8_SA(b, h) (((b) * 2 + (h)) * HTB)
#define PG8_SB(b, h) ((4 + (b) * 2 + (h)) * HTB)
#define PG8_STAGE_B(bufoff, gbase) do { glds16<(bufoff)>((const char*)(gbase), voffB[0], ldsbw); glds16<(bufoff) + 8192>((const char*)(gbase), voffB[1], ldsbw); } while (0)
#define PG8_STAGE_A(bufoff, gbase, h) do { glds16<(bufoff)>((const char*)(gbase), offA[(h) * 2], ldsbw); glds16<(bufoff) + 8192>((const char*)(gbase), offA[(h) * 2 + 1], ldsbw); } while (0)
#define PG8_LDA(dst, b, h) do { _Pragma("unroll") for (int m = 0; m < 4; ++m) _Pragma("unroll") for (int k = 0; k < 2; ++k) dst[m][k] = *(const PG8_LAS bf16x8*)(lds + PG8_SA(b, h) + aoff + m * 2048 + k * 1024); } while (0)
#define PG8_LDB(dst, b, h) do { _Pragma("unroll") for (int n = 0; n < 2; ++n) _Pragma("unroll") for (int k = 0; k < 2; ++k) dst[n][k] = *(const PG8_LAS bf16x8*)(lds + PG8_SB(b, h) + boff + n * 2048 + k * 1024); } while (0)
#define PG8_MMA(ai, bj, At, Bt) do { __builtin_amdgcn_s_setprio(1); if constexpr (MODE == 1) { _Pragma("unroll") for (int m = 0; m < 4; ++m) _Pragma("unroll") for (int n = 0; n < 2; ++n) { \
            const v8i _b = __builtin_shufflevector(__builtin_bit_cast(v4i, Bt[n][0]), __builtin_bit_cast(v4i, Bt[n][1]), 0, 1, 2, 3, 4, 5, 6, 7); \
            const v8i _a = __builtin_shufflevector(__builtin_bit_cast(v4i, At[m][0]), __builtin_bit_cast(v4i, At[m][1]), 0, 1, 2, 3, 4, 5, 6, 7); \
            acc[ai][bj][m][n] = __builtin_amdgcn_mfma_scale_f32_16x16x128_f8f6f4(_b, _a, acc[ai][bj][m][n], 0, 0, 0, 0x7A7A7A7A, 0, 0x7F7F7F7F); } } \
        else if constexpr (MODE == 2) { _Pragma("unroll") for (int m = 0; m < 4; ++m) _Pragma("unroll") for (int n = 0; n < 2; ++n) _Pragma("unroll") for (int k = 0; k < 2; ++k) \
        acc[ai][bj][m][n] = __builtin_bit_cast(f32x4, __builtin_amdgcn_mfma_i32_16x16x64_i8(__builtin_bit_cast(v4i, Bt[n][k]), __builtin_bit_cast(v4i, At[m][k]), __builtin_bit_cast(v4i, acc[ai][bj][m][n]), 0, 0, 0)); } \
        else { _Pragma("unroll") for (int m = 0; m < 4; ++m) _Pragma("unroll") for (int n = 0; n < 2; ++n) _Pragma("unroll") for (int k = 0; k < 2; ++k) \
        acc[ai][bj][m][n] = __builtin_amdgcn_mfma_f32_16x16x32_bf16(Bt[n][k], At[m][k], acc[ai][bj][m][n], 0, 0, 0); } __builtin_amdgcn_s_setprio(0); } while (0)
#define PG8_WAIT_V(n) asm volatile("s_waitcnt vmcnt(" #n ")" ::: "memory")
#define PG8_WAIT_L(n) asm volatile("s_waitcnt lgkmcnt(" #n ")" ::: "memory")
#define PG8_BAR __builtin_amdgcn_s_barrier()
#define PG8_SCHED __builtin_amdgcn_sched_barrier(0)
#define PG8_OFFS(dst, u) do { if constexpr (GATHER) { _Pragma("unroll") for (int _h = 0; _h < 2; ++_h) _Pragma("unroll") for (int _i = 0; _i < 2; ++_i) { \
        int _R, _C; stage_rc(tid * 16 + _i * 8192, _R, _C); dst[_h * 2 + _i] = S.a_row_off(u, _h * HALF + _R) + (unsigned)(_C * 2); } } } while (0)
    Unit cur, nxt; int ui = 0;
    if (!S.next(0, cur)) return;
    f32x4 acc[2][2][4][2];
#pragma unroll
    for (int a = 0; a < 2; ++a)
#pragma unroll
        for (int b = 0; b < 2; ++b)
#pragma unroll
            for (int m = 0; m < 4; ++m)
#pragma unroll
                for (int n = 0; n < 2; ++n) acc[a][b][m][n] = (f32x4){0.f, 0.f, 0.f, 0.f};
    bf16x8 At[4][2], B0[2][2], B1[2][2];
    const char* cA = S.a_tile(cur); const char* cB = S.b_tile(cur);
    PG8_OFFS(offA, cur);
    PG8_STAGE_B(PG8_SB(0, 0), cB); PG8_STAGE_B(PG8_SB(0, 1), cB + hstep); PG8_STAGE_A(PG8_SA(0, 0), cA, 0); PG8_STAGE_A(PG8_SA(0, 1), cA, 1);
    if (wr == 1) PG8_BAR;
    PG8_WAIT_V(2); PG8_BAR;
    PG8_STAGE_B(PG8_SB(1, 0), cB + kstep); PG8_STAGE_A(PG8_SA(1, 0), cA + kstep, 0); PG8_STAGE_B(PG8_SB(1, 1), cB + hstep + kstep);
    PG8_WAIT_V(6); PG8_BAR;
    for (;;) {
        const bool has_next = S.next(ui + 1, nxt);
        const char* nA = has_next ? S.a_tile(nxt) : cA; const char* nB = has_next ? S.b_tile(nxt) : cB;
        if constexpr (GATHER) { if (has_next) { PG8_OFFS(nxA, nxt); } }
#pragma unroll 1
        for (int t = 0; t < nt; t += 2) {
            const bool last = (t == nt - 2);
            const char* a1 = cA + (size_t)(t + 1) * kstep;
            const char* a2 = last ? nA : cA + (size_t)(t + 2) * kstep; const char* b2 = last ? nB : cB + (size_t)(t + 2) * kstep;
            const char* a3 = a2 + kstep; const char* b3 = b2 + kstep;
            PG8_LDB(B0, 0, 0); PG8_LDB(B1, 0, 1); PG8_SCHED; PG8_LDA(At, 0, 0); PG8_STAGE_A(PG8_SA(1, 1), a1, 1);
            if constexpr (GATHER) { if (last && has_next) {
#pragma unroll
                for (int q = 0; q < 4; ++q) offA[q] = nxA[q]; } }
            PG8_WAIT_V(8); PG8_WAIT_L(0); PG8_BAR; if (!(Sched::HAS_RH && cur.rh == 1)) { PG8_MMA(0, 0, At, B0); if (!(Sched::HAS_HALF && S.is_half(cur))) PG8_MMA(0, 1, At, B1); } PG8_BAR; PG8_SCHED;
            PG8_LDA(At, 0, 1); PG8_STAGE_B(PG8_SB(0, 0), b2); PG8_STAGE_B(PG8_SB(0, 1), b2 + hstep); PG8_STAGE_A(PG8_SA(0, 0), a2, 0);
            PG8_WAIT_V(8); PG8_WAIT_L(0); PG8_BAR; if (!(Sched::HAS_RH && cur.rh == 0)) { PG8_MMA(1, 0, At, B0); if (!(Sched::HAS_HALF && S.is_half(cur))) PG8_MMA(1, 1, At, B1); } PG8_BAR; PG8_SCHED;
            PG8_LDB(B0, 1, 0); PG8_LDB(B1, 1, 1); PG8_SCHED; PG8_LDA(At, 1, 0); PG8_STAGE_A(PG8_SA(0, 1), a2, 1);
            PG8_WAIT_V(8); PG8_WAIT_L(0); PG8_BAR; if (!(Sched::HAS_RH && cur.rh == 1)) { PG8_MMA(0, 0, At, B0); if (!(Sched::HAS_HALF && S.is_half(cur))) PG8_MMA(0, 1, At, B1); } PG8_BAR; PG8_SCHED;
            PG8_LDA(At, 1, 1); PG8_STAGE_B(PG8_SB(1, 0), b3); PG8_STAGE_B(PG8_SB(1, 1), b3 + hstep); PG8_STAGE_A(PG8_SA(1, 0), a3, 0);
            PG8_WAIT_V(8); PG8_WAIT_L(0); PG8_BAR; if (!(Sched::HAS_RH && cur.rh == 0)) { PG8_MMA(1, 0, At, B0); if (!(Sched::HAS_HALF && S.is_half(cur))) PG8_MMA(1, 1, At, B1); } PG8_BAR; PG8_SCHED;
        }
        if (wr == 0) PG8_BAR;
        E(acc, cur, wr, wc, fr, fq);
        if (!has_next) break;
#pragma unroll
        for (int a = 0; a < 2; ++a)
#pragma unroll
            for (int b = 0; b < 2; ++b)
#pragma unroll
                for (int m = 0; m < 4; ++m)
#pragma unroll
                    for (int n = 0; n < 2; ++n) acc[a][b][m][n] = (f32x4){0.f, 0.f, 0.f, 0.f};
        cur = nxt; cA = nA; cB = nB; ++ui;
        if (wr == 1) PG8_BAR;
    }
    PG8_WAIT_V(0);
    PG8_BAR;
#undef PG8_SA
#undef PG8_SB
#undef PG8_STAGE_A
#undef PG8_STAGE_B
#undef PG8_LDA
#undef PG8_LDB
#undef PG8_MMA
#undef PG8_WAIT_V
#undef PG8_WAIT_L
#undef PG8_BAR
#undef PG8_SCHED
#undef PG8_OFFS
}
}

#define XB_TMO      128
#define XB_XCNT(j)  (256  + 64 * (j))
#define XB_XSUB(j)  (1280 + 64 * (j))
#define XB_XGEN(j)  (2304 + 64 * (j))
#define XB_TOP      3328
#define XB_TOPGEN   3392
#define XCD_BAR_WORDS 3456
#define XB_SPIN_CAP (1u << 18)
__device__ __forceinline__ unsigned xb_ld(unsigned* p)              { return __hip_atomic_load(p, __ATOMIC_RELAXED, __HIP_MEMORY_SCOPE_AGENT); }
__device__ __forceinline__ unsigned xb_add(unsigned* p, unsigned v) { return __hip_atomic_fetch_add(p, v, __ATOMIC_RELAXED, __HIP_MEMORY_SCOPE_AGENT); }
__device__ __forceinline__ unsigned xb_xcc_id() { return (unsigned)__builtin_amdgcn_s_getreg((3 << 11) | 20) & 0xFu; }
#define XB_SPIN(cond, bar) do { unsigned _sp = 0; while (cond) { __builtin_amdgcn_s_sleep(1); \
    if ((++_sp & 255u) == 0u) { if (xb_ld(&(bar)[XB_TMO])) break; if (_sp > XB_SPIN_CAP) { atomicAdd(&(bar)[XB_TMO], 1u); break; } } } } while (0)
struct XcdBarrier { unsigned* bar; unsigned x; volatile LAS unsigned* st; };
__device__ __forceinline__ XcdBarrier xcd_barrier_post(unsigned* bar, volatile LAS unsigned* st) {
    XcdBarrier b; b.bar = bar; b.x = xb_xcc_id(); b.st = st;
    if (threadIdx.x == 0) (void)xb_add(&bar[XB_XCNT(b.x)], 1u);
    return b;
}
__device__ __forceinline__ void xcd_barrier_complete(unsigned* bar, unsigned x, unsigned& nloc, unsigned& nx) {
    const unsigned G = gridDim.x * gridDim.y * gridDim.z;
    unsigned sum, cnt, mine, sp = 0u;
    for (;;) {
        sum = 0u; cnt = 0u; mine = 0u;
#pragma unroll
        for (unsigned j = 0; j < 16; ++j) { const unsigned c = xb_ld(&bar[XB_XCNT(j)]); sum += c; cnt += (c > 0u) ? 1u : 0u; mine = (j == x) ? c : mine; }
        if (sum == G) break;
        __builtin_amdgcn_s_sleep(1);
        if ((++sp & 255u) == 0u) { if (xb_ld(&bar[XB_TMO])) break; if (sp > XB_SPIN_CAP) { atomicAdd(&bar[XB_TMO], 1u); break; } }
    }
    nloc = mine > 0u ? mine : 1u; nx = cnt > 0u ? cnt : 1u;
}
__device__ __forceinline__ void xcd_barrier(const XcdBarrier& b) {
    asm volatile("s_waitcnt vmcnt(0)" ::: "memory");
    __syncthreads();
    if (threadIdx.x == 0) {
        unsigned* bar = b.bar;
        __builtin_amdgcn_s_waitcnt(0);
        unsigned nloc = b.st[0], nx = b.st[1];
        if (nloc == 0u) { xcd_barrier_complete(bar, b.x, nloc, nx); b.st[0] = nloc; b.st[1] = nx; }
        const unsigned old = xb_add(&bar[XB_XSUB(b.x)], 1u);
        const unsigned gen = old / nloc;
        if (old + 1u == (gen + 1u) * nloc) {
            __builtin_amdgcn_fence(__ATOMIC_RELEASE, "agent");
            asm volatile("s_waitcnt vmcnt(0)" ::: "memory");
            const unsigned og = xb_add(&bar[XB_TOP], 1u);
            const unsigned tg = og / nx;
            if (og + 1u == (tg + 1u) * nx) xb_add(&bar[XB_TOPGEN], 1u);
            else XB_SPIN(xb_ld(&bar[XB_TOPGEN]) == tg, bar);
            __builtin_amdgcn_fence(__ATOMIC_ACQUIRE, "agent");
            xb_add(&bar[XB_XGEN(b.x)], 1u);
            asm volatile("s_waitcnt vmcnt(0)" ::: "memory");
        } else {
            XB_SPIN(xb_ld(&bar[XB_XGEN(b.x)]) == gen, bar);
            __builtin_amdgcn_fence(__ATOMIC_ACQUIRE, "agent");
            asm volatile("s_waitcnt vmcnt(0)" ::: "memory");
        }
    }
    __syncthreads();
}

constexpr int NWAVES = 8;
struct Args { const float* in[21]; float* out; unsigned char* ws; int ph_lo, ph_hi; };
struct Frame {
    LAS unsigned char* lds;
    unsigned* ctl;
    int tid, lane, wave, vcu, G;
    unsigned char* ws;
};
enum { I_X = 0, I_LNIG, I_LNIB, I_RW, I_RB, I_WIN, I_CAW, I_CBW, I_CBB, I_LCG, I_LCB, I_PW, I_PS, I_WOUT, I_LMG, I_LMB, I_WG, I_WU, I_WDN, I_LFG, I_LFB };

__device__ __forceinline__ void tr_item(const float* src, int srcN, int srccol0, bf16* dst, int dstK, int dstrow0, int k0, LAS float* scr, int lane) {
#pragma unroll 8
    for (int i = 0; i < 32; ++i) { const int kk = 2 * i + (lane >> 5); scr[kk * 33 + (lane & 31)] = src[(size_t)(k0 + kk) * srcN + srccol0 + (lane & 31)]; }
    LDS_WAIT(); asm volatile("" ::: "memory");
    const int c = lane & 7;
#pragma unroll
    for (int j = 0; j < 4; ++j) { const int n = (lane >> 3) + 8 * j; const LAS float* s = scr + (8 * c) * 33 + n;
        v4u o; o.x = pk2(s[0 * 33], s[1 * 33]); o.y = pk2(s[2 * 33], s[3 * 33]); o.z = pk2(s[4 * 33], s[5 * 33]); o.w = pk2(s[6 * 33], s[7 * 33]);
        *(GAS v4u*)(dst + (size_t)(dstrow0 + n) * dstK + k0 + 8 * c) = o; }
    LDS_WAIT(); asm volatile("" ::: "memory");
}
__device__ __forceinline__ void tr_item64(const float* src, int srcN, int srccol0, bf16* dst, int dstK, int dstrow0, int k0, LAS unsigned* scr, int lane) {
    const int kr = lane >> 4, c4 = lane & 15;
    const float* sp = src + (size_t)(k0 + 2 * kr) * srcN + srccol0 + 4 * c4;
    f32x4 A[8], B[8];
#pragma unroll
    for (int i = 0; i < 8; ++i) { A[i] = *(const GAS f32x4*)(sp + (size_t)(8 * i) * srcN); B[i] = *(const GAS f32x4*)(sp + (size_t)(8 * i + 1) * srcN); }
#pragma unroll
    for (int i = 0; i < 8; ++i) { LAS unsigned* w = scr + (4 * i + kr) * 65 + 4 * c4;
        w[0] = pk2(A[i].x, B[i].x); w[1] = pk2(A[i].y, B[i].y); w[2] = pk2(A[i].z, B[i].z); w[3] = pk2(A[i].w, B[i].w); }
    LDS_WAIT(); asm volatile("" ::: "memory");
    const int q = lane & 7, nn = lane >> 3;
#pragma unroll
    for (int j = 0; j < 8; ++j) { const int n = nn + 8 * j; const LAS unsigned* r = scr + (4 * q) * 65 + n;
        v4u o; o.x = r[0]; o.y = r[65]; o.z = r[130]; o.w = r[195];
        *(GAS v4u*)(dst + (size_t)(dstrow0 + n) * dstK + k0 + 8 * q) = o; }
    LDS_WAIT(); asm volatile("" ::: "memory");
}
template <int NS, bool I8 = false>
__device__ __forceinline__ void tr_item64_f8(const float* src, int srcN, int srccol0, unsigned char* dst, int dstKB, int dstrow0, int k0, float scale, LAS unsigned* scr, int lane, bool nostore = false, f32x4 cinv = (f32x4){1.f, 1.f, 1.f, 1.f}) {
    const int kr = lane >> 4, c4 = lane & 15;
    const float* sp = src + (size_t)(k0 + 4 * kr) * srcN + srccol0 + 4 * c4;
    f32x4 A[NS][4][4];
#pragma unroll
    for (int s = 0; s < NS; ++s)
#pragma unroll
        for (int i = 0; i < 4; ++i)
#pragma unroll
            for (int t = 0; t < 4; ++t) A[s][i][t] = __builtin_nontemporal_load((const GAS f32x4*)(sp + (size_t)(64 * s + 16 * i + t) * srcN));
#pragma unroll
    for (int s = 0; s < NS; ++s)
#pragma unroll
        for (int i = 0; i < 4; ++i) { LAS unsigned* w = scr + (16 * s + 4 * i + kr) * 65 + 4 * c4;
            if constexpr (I8) {
            w[0] = pk4_i8(A[s][i][0].x * cinv.x, A[s][i][1].x * cinv.x, A[s][i][2].x * cinv.x, A[s][i][3].x * cinv.x); w[1] = pk4_i8(A[s][i][0].y * cinv.y, A[s][i][1].y * cinv.y, A[s][i][2].y * cinv.y, A[s][i][3].y * cinv.y);
            w[2] = pk4_i8(A[s][i][0].z * cinv.z, A[s][i][1].z * cinv.z, A[s][i][2].z * cinv.z, A[s][i][3].z * cinv.z); w[3] = pk4_i8(A[s][i][0].w * cinv.w, A[s][i][1].w * cinv.w, A[s][i][2].w * cinv.w, A[s][i][3].w * cinv.w); } else {
            w[0] = pk4_fp8(A[s][i][0].x * scale, A[s][i][1].x * scale, A[s][i][2].x * scale, A[s][i][3].x * scale); w[1] = pk4_fp8(A[s][i][0].y * scale, A[s][i][1].y * scale, A[s][i][2].y * scale, A[s][i][3].y * scale);
            w[2] = pk4_fp8(A[s][i][0].z * scale, A[s][i][1].z * scale, A[s][i][2].z * scale, A[s][i][3].z * scale); w[3] = pk4_fp8(A[s][i][0].w * scale, A[s][i][1].w * scale, A[s][i][2].w * scale, A[s][i][3].w * scale); } }
    LDS_WAIT(); asm volatile("" ::: "memory");
    constexpr int QN = 4 * NS, RN = 64 / QN;
    const int q = lane % QN, nn = lane / QN;
#pragma unroll
    for (int j = 0; j < 64 / RN; ++j) { const int n = nn + RN * j; const LAS unsigned* r = scr + (4 * q) * 65 + n;
        v4u o; o.x = r[0]; o.y = r[65]; o.z = r[130]; o.w = r[195];
        if (nostore) asm volatile("" :: "v"(o)); else *(GAS v4u*)(dst + (size_t)(dstrow0 + n) * dstKB + k0 + 16 * q) = o; }
    LDS_WAIT(); asm volatile("" ::: "memory");
}
__device__ __forceinline__ int win_src(int c0) {
    const int pn = c0 >> 8, j = c0 & 255, half = j >> 7, jj = j & 127;
    if (pn < 3) { const int ch = pn * 128 + jj; return half == 0 ? 384 + ch : 768 + ch; }
    if (pn < 6) { const int ch = (pn - 3) * 128 + jj; return half == 0 ? 1152 + ch : 1536 + ch; }
    if (pn < 8) { const int q = (pn - 6) * 256 + j; return q < 384 ? q : 1920 + (q - 384); }
    return j < 128 ? 1920 + 128 + j : -1;
}
__device__ __forceinline__ void p0_prologue(Frame& F, const Args& A) {
    LAS float* scr = (LAS float*)(F.lds + F.wave * 8448);
    LAS unsigned* scu = (LAS unsigned*)scr;
    const int gw = F.vcu * NWAVES + F.wave, NGW = F.G * NWAVES, lane = F.lane;
    bf16* WIN = (bf16*)(F.ws + WS_WIN); bf16* WOUT = (bf16*)(F.ws + WS_WOUT); unsigned char* WGU = F.ws + WS_WGU; unsigned char* WD = F.ws + WS_WD; bf16* WRT = (bf16*)(F.ws + WS_WRT);
    constexpr int I_M = GEMM1_I8 ? NL * 36 * 8 : 0, I_A = GEMM1_I8 ? NL * 36 * 8 : NL * 16 * 36, I_B = NL * 12 * 16, I_C = NL * NE * 128, I_D = NL * NE * 64, I_E = 16, I_F = NL * 4 * 16 * 2;
    constexpr int NITEMS = I_M + I_A + I_B + I_C + I_D + I_E + I_F;
    const int lane0 = lane;
#pragma unroll 1
    for (int prep = 0; prep < ((PROBE_P0 == 1 || PROBE_P0 == 3) ? 2 : 1); ++prep)
    for (int it = gw; it < NITEMS; it += NGW) {
        int lane = lane0; asm volatile("" : "+v"(lane));
        int r = it;
        if (r < I_M) {
            const int l = r / 288, q = r % 288, cb = q >> 3, kq = q & 7, c0 = cb * 64, sc = win_src(c0), kr = lane >> 4, c4 = lane & 15;
            if (sc >= 0) { const float* sp = A.in[I_WIN] + (size_t)l * 1024 * DIN + (size_t)(kq * 128 + kr) * DIN + sc + 4 * c4;
                f32x4 vv[32];
#pragma unroll
                for (int i = 0; i < 32; ++i) vv[i] = *(const GAS f32x4*)(sp + (size_t)(4 * i) * DIN);
                f32x4 mx = (f32x4){0.f, 0.f, 0.f, 0.f};
#pragma unroll
                for (int i = 0; i < 32; ++i) { mx.x = fmaxf(mx.x, fabsf(vv[i].x)); mx.y = fmaxf(mx.y, fabsf(vv[i].y)); mx.z = fmaxf(mx.z, fabsf(vv[i].z)); mx.w = fmaxf(mx.w, fabsf(vv[i].w)); }
#pragma unroll
                for (int o = 16; o <= 32; o <<= 1) { mx.x = fmaxf(mx.x, __shfl_xor(mx.x, o)); mx.y = fmaxf(mx.y, __shfl_xor(mx.y, o)); mx.z = fmaxf(mx.z, __shfl_xor(mx.z, o)); mx.w = fmaxf(mx.w, __shfl_xor(mx.w, o)); }
                if (kr == 0) { unsigned* cm = F.ctl + CW_CMAX + l * N1 + c0 + 4 * c4;
                    __hip_atomic_fetch_max(cm + 0, __float_as_uint(mx.x), RLX_AGENT); __hip_atomic_fetch_max(cm + 1, __float_as_uint(mx.y), RLX_AGENT);
                    __hip_atomic_fetch_max(cm + 2, __float_as_uint(mx.z), RLX_AGENT); __hip_atomic_fetch_max(cm + 3, __float_as_uint(mx.w), RLX_AGENT); } }
            VM_WAIT();
            if (lane == 0) __hip_atomic_fetch_add(F.ctl + CW_CMAXCNT, 1u, RLX_AGENT);
            continue; }
        r -= I_M;
        if (r < I_C) {
            const int le = r >> 7, q = r & 127, kb = q >> 4, nb = q & 15, n0 = nb * 64, pn = n0 >> 8, half = (n0 & 255) >> 7, jj0 = n0 & 127;
            const float* src = (half ? A.in[I_WU] : A.in[I_WG]) + (size_t)le * 1024 * 512;
            tr_item64_f8<2>(src, 512, pn * 128 + jj0, WGU + (size_t)le * 1024 * 1024, 1024, n0, kb * 128, 32.0f, scu, lane, PROBE_P0 == 3 && prep == 1); continue; }
        r -= I_C;
        if (r < I_D) {
            const int le = r >> 6, q = r & 63, kb = q >> 4, nb = q & 15;
            tr_item64_f8<2>(A.in[I_WDN] + (size_t)le * 512 * 1024, 1024, nb * 64, WD + (size_t)le * 1024 * 512, 512, nb * 64, kb * 128, 32.0f, scu, lane, PROBE_P0 == 3 && prep == 1); continue; }
        r -= I_D;
        if (r < I_A) {
            if (GEMM1_I8) {
                const int l = r / 288, q = r % 288, cb = q >> 3, kb = q & 7, c0 = cb * 64, sc = win_src(c0), c4 = lane & 15;
                unsigned char* dst = F.ws + WS_WIN + (size_t)l * N1 * 1024;
                { unsigned spins = 0;
                  while (__hip_atomic_load(F.ctl + CW_CMAXCNT, RLX_AGENT) < (unsigned)I_M * ((PROBE_P0 == 1 || PROBE_P0 == 3) ? (unsigned)(prep + 1) : 1u)) { __builtin_amdgcn_s_sleep(8); if (++spins > (1u << 22)) break; } }
                if (sc >= 0) { const unsigned* cm = F.ctl + CW_CMAX + l * N1 + c0 + 4 * c4;
                    f32x4 mx; mx.x = __uint_as_float(__hip_atomic_load(cm + 0, RLX_AGENT)); mx.y = __uint_as_float(__hip_atomic_load(cm + 1, RLX_AGENT)); mx.z = __uint_as_float(__hip_atomic_load(cm + 2, RLX_AGENT)); mx.w = __uint_as_float(__hip_atomic_load(cm + 3, RLX_AGENT));
                    f32x4 cinv; cinv.x = mx.x > 0.f ? 127.f / mx.x : 0.f; cinv.y = mx.y > 0.f ? 127.f / mx.y : 0.f; cinv.z = mx.z > 0.f ? 127.f / mx.z : 0.f; cinv.w = mx.w > 0.f ? 127.f / mx.w : 0.f;
                    tr_item64_f8<2, true>(A.in[I_WIN] + (size_t)l * 1024 * DIN, DIN, sc, dst, 1024, c0, kb * 128, 1.f, scu, lane, false, cinv);
                } else { for (int qq = lane; qq < 64 * 8; qq += 64) *(GAS v4u*)(dst + (size_t)(c0 + (qq >> 3)) * 1024 + kb * 128 + (qq & 7) * 16) = (v4u){0u, 0u, 0u, 0u}; }
                continue; }
            const int l = r / 576, q = r % 576, kb = q / 36, nb = q % 36, c0 = nb * 64, sc = win_src(c0);
            bf16* dst = WIN + (size_t)l * N1 * 1024;
            if (sc >= 0) tr_item64(A.in[I_WIN] + (size_t)l * 1024 * DIN, DIN, sc, dst, 1024, c0, kb * 64, scu, lane);
            else { const int c = lane & 7;
#pragma unroll
                for (int j = 0; j < 8; ++j) { const int n = (lane >> 3) + 8 * j; *(GAS v4u*)(dst + (size_t)(c0 + n) * 1024 + kb * 64 + 8 * c) = (v4u){0u, 0u, 0u, 0u}; } }
            continue; }
        r -= I_A;
        if (r < I_B) {
            const int l = r / 192, q = r % 192, kb = q >> 4, nb = q & 15;
            if (GEMM2_FP8) tr_item64_f8<1>(A.in[I_WOUT] + (size_t)l * 1024 * 1024, 1024, nb * 64, (unsigned char*)WOUT + (size_t)l * 1024 * 1024, 1024, nb * 64, kb * 64, 32.0f, scu, lane);
            else tr_item64(A.in[I_WOUT] + (size_t)l * 1024 * 1024, 1024, nb * 64, WOUT + (size_t)l * 1024 * 1024, 1024, nb * 64, kb * 64, scu, lane);
            continue; }
        r -= I_B;
        if (r < I_E) { tr_item(A.in[I_RW], 32, 0, WRT, 1024, 0, r * 64, scr, lane); continue; }
        r -= I_E;
        {
            const int l = r >> 7, g = (r >> 5) & 3, nb = (r >> 1) & 15, cb = r & 1, n = nb * 64 + lane;
            const float* wo = A.in[I_WOUT] + (size_t)l * 1024 * 1024 + (size_t)(768 + g * 64) * 1024 + n;
            const float* ps = A.in[I_PS] + l * 256 + g * 64;
            const float* pw = A.in[I_PW] + (size_t)(l * 4 + g) * 64 * 64 + cb * 32 * 64;
#pragma unroll
            for (int i = 0; i < 8; ++i) *(LAS f32x4*)(scr + (i * 64 + lane) * 4) = *(const GAS f32x4*)(pw + (i * 64 + lane) * 4);
            float wv[64];
#pragma unroll
            for (int d = 0; d < 64; ++d) wv[d] = wo[(size_t)d * 1024] * ps[d];
            LDS_WAIT(); asm volatile("" ::: "memory");
            bf16* dst = WOUT + (size_t)l * 1024 * 1024 + (size_t)n * 1024 + 768 + g * 64 + cb * 32;
#pragma unroll 1
            for (int c2 = 0; c2 < 16; ++c2) { float o[2];
#pragma unroll
                for (int cc = 0; cc < 2; ++cc) { const LAS f32x4* pr = (const LAS f32x4*)(scr + (c2 * 2 + cc) * 64); float a = 0.f;
#pragma unroll
                    for (int d4 = 0; d4 < 16; ++d4) { const f32x4 p = pr[d4]; a += p.x * wv[4 * d4] + p.y * wv[4 * d4 + 1] + p.z * wv[4 * d4 + 2] + p.w * wv[4 * d4 + 3]; }
                    o[cc] = a; }
                if (GEMM2_FP8) *(GAS unsigned short*)((unsigned char*)WOUT + (size_t)l * 1024 * 1024 + (size_t)n * 1024 + 768 + g * 64 + cb * 32 + c2 * 2) = (unsigned short)pk4_fp8(o[0] * 32.0f, o[1] * 32.0f, 0.f, 0.f);
                else *(GAS unsigned*)(dst + c2 * 2) = pk2(o[0], o[1]); }
            LDS_WAIT(); asm volatile("" ::: "memory");
        }
    }
    bf16* HB = (bf16*)(F.ws + WS_HB);
    const float* g = A.in[I_LNIG]; const float* b = A.in[I_LNIB];
    f32x4 gv[4], bv[4];
#pragma unroll
    for (int j = 0; j < 4; ++j) { gv[j] = *(const f32x4*)(g + 4 * lane + 256 * j); bv[j] = *(const f32x4*)(b + 4 * lane + 256 * j); }
#pragma unroll 1
    for (int prep2 = 0; prep2 < ((PROBE_P0 == 2) ? 2 : 1); ++prep2)
    for (int m0 = gw * 2; m0 < T_; m0 += NGW * 2) {
        f32x4 v[2][4];
#pragma unroll
        for (int u = 0; u < 2; ++u) { const GAS f32x4* xr = (const GAS f32x4*)(A.in[I_X] + (size_t)(m0 + u) * D_) + lane;
#pragma unroll
            for (int j = 0; j < 4; ++j) v[u][j] = __builtin_nontemporal_load(xr + 64 * j); }
#pragma unroll
        for (int u = 0; u < 2; ++u) { float s = 0.f;
#pragma unroll
            for (int j = 0; j < 4; ++j) s += (v[u][j].x + v[u][j].y) + (v[u][j].z + v[u][j].w);
            const float mean = wave_sum(s) * (1.f / D_); float s2 = 0.f;
#pragma unroll
            for (int j = 0; j < 4; ++j) { v[u][j] = v[u][j] - mean; s2 += (v[u][j].x * v[u][j].x + v[u][j].y * v[u][j].y) + (v[u][j].z * v[u][j].z + v[u][j].w * v[u][j].w); }
            const float rstd = __builtin_amdgcn_rsqf(wave_sum(s2) * (1.f / D_) + LN_EPS);
            GAS v2u* o8 = (GAS v2u*)(HB + (size_t)(m0 + u) * D_) + lane;
            float amax = 0.f;
#pragma unroll
            for (int j = 0; j < 4; ++j) { const f32x4 o = v[u][j] * rstd * gv[j] + bv[j]; v[u][j] = o; v2u w; w.x = pk2(o.x, o.y); w.y = pk2(o.z, o.w); o8[64 * j] = w;
                amax = fmaxf(amax, fmaxf(fmaxf(fabsf(o.x), fabsf(o.y)), fmaxf(fabsf(o.z), fabsf(o.w)))); }
            if (GEMM1_I8) {
                amax = wave_max(amax); const float inv = amax > 0.f ? 127.f / amax : 0.f;
                GAS unsigned* q4 = (GAS unsigned*)(F.ws + WS_HQ + (size_t)(m0 + u) * D_) + lane;
#pragma unroll
                for (int j = 0; j < 4; ++j) q4[64 * j] = pk4_i8(v[u][j].x * inv, v[u][j].y * inv, v[u][j].z * inv, v[u][j].w * inv);
                if (lane == 0) ((float*)(F.ws + WS_HS))[m0 + u] = amax * (1.f / 127.f); } }
    }
}

__device__ __forceinline__ void p2_mixer(Frame& F, const Args& A, int l) {
    LAS unsigned* BV = (LAS unsigned*)F.lds;
    LAS unsigned* PB = (LAS unsigned*)(F.lds + 47616);
    LAS float* V = (LAS float*)(F.lds + 71680);
    LAS float* LGB = (LAS float*)(F.lds + 120832);
    LAS float* WA = (LAS float*)(F.lds + 123904);
    const bf16* Z = (const bf16*)(F.ws + WS_Z); bf16* Y = (bf16*)(F.ws + WS_Y);
    const float* wB = A.in[I_CBW] + l * 31 * 384; const float* bB = A.in[I_CBB] + l * 384;
    const float* lg = A.in[I_LCG] + l * 384; const float* lb = A.in[I_LCB] + l * 384; const float* wA = A.in[I_CAW] + l * 3 * 384;
    int tid = F.tid; asm volatile("" : "+v"(tid));
    const int lane = tid & 63, wave = F.wave;
    const bool convt = tid < 384; const int cp = tid % 192, tg = tid / 192;
    f32x2 w[31]; f32x2 bias = (f32x2){0.f, 0.f};
#pragma unroll
    for (int j = 0; j < 31; ++j) w[j] = (f32x2){0.f, 0.f};
    if (convt) {
#pragma unroll
        for (int j = 0; j < 31; ++j) w[j] = *(const f32x2*)(wB + j * 384 + 2 * cp);
        bias = *(const f32x2*)(bB + 2 * cp); }
    for (int q = tid; q < 384; q += 512) { LGB[q] = lg[q]; LGB[384 + q] = lb[q]; }
    for (int q = tid; q < 3 * 384; q += 512) WA[q] = wA[q];
    v4u pre[9];
#define MIX_PREFETCH(ci_, tid_) do { const int _t0 = (ci_) * 32, _s0 = _t0 & (SEQ_ - 1); \
        _Pragma("unroll") for (int _i = 0; _i < 6; ++_i) { const int _q = (tid_) + 512 * _i; const int _qq = _q < 62 * 48 ? _q : 0; const int _r = _qq / 48, _c = _qq % 48; \
            const int _rr = (_s0 - 30 + _r >= 0) ? _r : 30; pre[_i] = __builtin_nontemporal_load((const GAS v4u*)(Z + (size_t)(_t0 - 30 + _rr) * NZ + 768 + _c * 8)); } \
        _Pragma("unroll") for (int _i = 0; _i < 3; ++_i) { const int _q = (tid_) + 512 * _i; const int _qq = _q < 47 * 32 ? _q : 0; const int _r = _qq >> 5, _c = _qq & 31; \
            const int _rr = (_s0 - 15 + _r >= 0) ? _r : 15; pre[6 + _i] = __builtin_nontemporal_load((const GAS v4u*)(Z + (size_t)(_t0 - 15 + _rr) * NZ + 1152 + _c * 8)); } } while (0)
    if (F.vcu < T_ / 32) MIX_PREFETCH(F.vcu, tid);
    for (int ci = F.vcu; ci < T_ / 32; ci += F.G) {
        const int t0 = ci * 32, s0 = t0 & (SEQ_ - 1);
#pragma unroll
        for (int i = 0; i < 6; ++i) { const int q = tid + 512 * i; if (q < 62 * 48) { const int r = q / 48, c = q % 48;
            *(LAS v4u*)(BV + r * 192 + c * 4) = (s0 - 30 + r >= 0) ? pre[i] : (v4u){0u, 0u, 0u, 0u}; } }
#pragma unroll
        for (int i = 0; i < 3; ++i) { const int q = tid + 512 * i; if (q < 47 * 32) { const int r = q >> 5, c = q & 31;
            *(LAS v4u*)(PB + r * 128 + c * 4) = (s0 - 15 + r >= 0) ? pre[6 + i] : (v4u){0u, 0u, 0u, 0u}; } }
        __syncthreads();
        { int cn = ci + F.G; asm volatile("" : "+s"(cn)); int tidp = tid; asm volatile("" : "+v"(tidp));
          if (cn < T_ / 32) MIX_PREFETCH(cn, tidp); }
        if (PROBE_MIX == 3) { int cn = ci + F.G; asm volatile("" : "+s"(cn)); int tidp = tid; asm volatile("" : "+v"(tidp));
          if (cn < T_ / 32) { v4u sink[9]; const int _t0 = cn * 32;
#pragma unroll
              for (int i = 0; i < 6; ++i) { const int q = tidp + 512 * i, qq = q < 62 * 48 ? q : 0, r = qq / 48, c = qq % 48; sink[i] = *(const GAS v4u*)(Z + (size_t)(_t0 + r) * NZ + 768 + c * 8 + 8); }
#pragma unroll
              for (int i = 0; i < 3; ++i) { const int q = tidp + 512 * i, qq = q < 47 * 32 ? q : 0, r = qq >> 5, c = qq & 31; sink[6 + i] = *(const GAS v4u*)(Z + (size_t)(_t0 + r) * NZ + 1152 + c * 8); }
#pragma unroll
              for (int i = 0; i < 9; ++i) asm volatile("" :: "v"(sink[i])); } }
#pragma unroll 1
        for (int prep = 0; prep < ((PROBE_MIX == 1) ? 2 : 1); ++prep)
        if (convt) {
#pragma unroll 1
            for (int hh = 0; hh < 2; ++hh) { const int tb = tg * 16 + hh * 8;
                f32x2 x[38];
#pragma unroll
                for (int i = 0; i < 38; ++i) { const unsigned u = BV[(tb + i) * 192 + cp]; x[i] = (f32x2){bflo(u), bfhi(u)}; }
#pragma unroll
                for (int tt = 0; tt < 8; ++tt) { f32x2 a = bias;
#pragma unroll
                    for (int j = 0; j < 31; ++j) a += w[j] * x[tt + j];
                    *(LAS f32x2*)(V + (tb + tt) * 384 + 2 * cp) = a; }
            }
        } else {
            const int p = tid - 384, g = p >> 5, wd = 2 << g;
            f32x2 s = (f32x2){0.f, 0.f};
            for (int i = 1; i < wd; ++i) { const unsigned u = PB[(15 - i) * 128 + p]; s += (f32x2){bflo(u), bfhi(u)}; }
#pragma unroll 1
            for (int blk = 0; blk < 4; ++blk) {
                unsigned xr[23];
#pragma unroll
                for (int i = 0; i < 23; ++i) xr[i] = PB[(8 * blk + i) * 128 + p];
#pragma unroll
                for (int j = 0; j < 8; ++j) { const int tt = 8 * blk + j; const f32x2 xv = (f32x2){bflo(xr[15 + j]), bfhi(xr[15 + j])};
                    s += xv; const int n = (s0 + tt + 1) < wd ? (s0 + tt + 1) : wd; const float inv = __builtin_amdgcn_rcpf((float)n);
                    const f32x2 dd = s * inv - xv;
                    if (GEMM2_FP8) *(GAS unsigned short*)((unsigned char*)Y + (size_t)(t0 + tt) * D_ + 768 + 2 * p) = (unsigned short)pk4_fp8(dd.x, dd.y, 0.f, 0.f);
                    else *(GAS unsigned*)(Y + (size_t)(t0 + tt) * D_ + 768 + 2 * p) = pk2(dd.x, dd.y);
                    const unsigned u2 = xr[15 + j - 1], u4 = xr[15 + j - 3], u8 = xr[15 + j - 7], u16 = xr[j];
                    const unsigned uo = g == 0 ? u2 : (g == 1 ? u4 : (g == 2 ? u8 : u16));
                    s -= (f32x2){bflo(uo), bfhi(uo)}; }
            }
        }
        __syncthreads();
        v4u ya[3][4];
        int t0o = t0; asm volatile("" : "+s"(t0o));
        int tidl = tid; asm volatile("" : "+v"(tidl));
#pragma unroll
        for (int i = 0; i < 3; ++i) { const int q = tidl + 512 * i, tt = q / 48, o8 = q % 48, pos = (t0o & (SEQ_ - 1)) + tt; const size_t row = (size_t)(t0o + tt);
            ya[i][0] = __builtin_nontemporal_load((const GAS v4u*)(Z + row * NZ + o8 * 8));
            ya[i][1] = *(const GAS v4u*)(Z + row * NZ + 384 + o8 * 8);
            ya[i][2] = *(const GAS v4u*)(Z + (row - (pos >= 1 ? 1 : 0)) * NZ + 384 + o8 * 8);
            ya[i][3] = *(const GAS v4u*)(Z + (row - (pos >= 2 ? 2 : 0)) * NZ + 384 + o8 * 8); }
#pragma unroll
        for (int tk = 0; tk < 4; ++tk) { const int tt = wave * 4 + tk;
            f32x2 v[3]; float s = 0.f;
#pragma unroll
            for (int i = 0; i < 3; ++i) { v[i] = *(const LAS f32x2*)(V + tt * 384 + 2 * lane + 128 * i); s += v[i].x + v[i].y; }
            const float mean = wave_sum(s) * (1.f / 384.f); float q = 0.f;
#pragma unroll
            for (int i = 0; i < 3; ++i) { v[i] = v[i] - mean; q += v[i].x * v[i].x + v[i].y * v[i].y; }
            const float rstd = __builtin_amdgcn_rsqf(wave_sum(q) * (1.f / 384.f) + LN_EPS);
#pragma unroll
            for (int i = 0; i < 3; ++i) { const int c = 2 * lane + 128 * i; const f32x2 gg = *(const LAS f32x2*)(LGB + c), bb = *(const LAS f32x2*)(LGB + 384 + c);
                f32x2 o = v[i] * rstd * gg + bb; o.x = o.x * sigmoidf_(o.x); o.y = o.y * sigmoidf_(o.y);
                if (GEMM2_FP8) *(GAS unsigned short*)((unsigned char*)Y + (size_t)(t0 + tt) * D_ + 384 + c) = (unsigned short)pk4_fp8(o.x, o.y, 0.f, 0.f);
                else *(GAS unsigned*)(Y + (size_t)(t0 + tt) * D_ + 384 + c) = pk2(o.x, o.y); }
        }
#pragma unroll
        for (int i = 0; i < 3; ++i) { const int q = tid + 512 * i, tt = q / 48, o8 = q % 48, pos = s0 + tt; const size_t row = (size_t)(t0 + tt);
            const v4u gb = ya[i][0], x0 = ya[i][1]; v4u x1 = ya[i][2], x2 = ya[i][3];
            if (pos < 1) x1 = (v4u){0u, 0u, 0u, 0u};
            if (pos < 2) x2 = (v4u){0u, 0u, 0u, 0u};
            const LAS f32x4* wp = (const LAS f32x4*)(WA + o8 * 8);
            const f32x4 w0a = wp[0], w0b = wp[1], w1a = wp[96], w1b = wp[97], w2a = wp[192], w2b = wp[193];
            float o[8];
            const unsigned gbw[4] = {gb.x, gb.y, gb.z, gb.w}, x0w[4] = {x0.x, x0.y, x0.z, x0.w}, x1w[4] = {x1.x, x1.y, x1.z, x1.w}, x2w[4] = {x2.x, x2.y, x2.z, x2.w};
            const float w2[8] = {w2a.x, w2a.y, w2a.z, w2a.w, w2b.x, w2b.y, w2b.z, w2b.w}, w1[8] = {w1a.x, w1a.y, w1a.z, w1a.w, w1b.x, w1b.y, w1b.z, w1b.w}, w0[8] = {w0a.x, w0a.y, w0a.z, w0a.w, w0b.x, w0b.y, w0b.z, w0b.w};
#pragma unroll
            for (int e = 0; e < 4; ++e) {
                o[2 * e] = bflo(gbw[e]) * (w2[2 * e] * bflo(x0w[e]) + w1[2 * e] * bflo(x1w[e]) + w0[2 * e] * bflo(x2w[e]));
                o[2 * e + 1] = bfhi(gbw[e]) * (w2[2 * e + 1] * bfhi(x0w[e]) + w1[2 * e + 1] * bfhi(x1w[e]) + w0[2 * e + 1] * bfhi(x2w[e])); }
            if (GEMM2_FP8) { v2u ov; ov.x = pk4_fp8(o[0], o[1], o[2], o[3]); ov.y = pk4_fp8(o[4], o[5], o[6], o[7]); *(GAS v2u*)((unsigned char*)Y + row * D_ + o8 * 8) = ov; }
            else { v4u ov; ov.x = pk2(o[0], o[1]); ov.y = pk2(o[2], o[3]); ov.z = pk2(o[4], o[5]); ov.w = pk2(o[6], o[7]);
            *(GAS v4u*)(Y + row * D_ + o8 * 8) = ov; } }
        __syncthreads();
    }
#undef MIX_PREFETCH
}

__device__ __forceinline__ void top2of4(float q0, float q1, float q2, float q3, float& a1, int& i1, float& a2, int& i2) {
    a1 = q0; i1 = 0; a2 = -1.f; i2 = 1;
#define T2STEP(qv, r) { const bool gt = (qv) > a1; const bool g2 = (qv) > a2; const float na2 = gt ? a1 : (g2 ? (qv) : a2); const int ni2 = gt ? i1 : (g2 ? (r) : i2); \
        a1 = gt ? (qv) : a1; i1 = gt ? (r) : i1; a2 = na2; i2 = ni2; }
    T2STEP(q1, 1) T2STEP(q2, 2) T2STEP(q3, 3)
#undef T2STEP
}
__device__ __forceinline__ void p4_ln_router(Frame& F, const Args& A, int l) {
    LAS unsigned char* lds = F.lds;
    LAS int* cntl = (LAS int*)(lds + 66048); LAS int* basel = cntl + 32; LAS int* sel = cntl + 64; LAS int* lpos = cntl + 64 + 256;
    const bf16* U = (const bf16*)(F.ws + WS_U); bf16* HB = (bf16*)(F.ws + WS_HB); unsigned char* H8 = F.ws + WS_H8; const bf16* WRT = (const bf16*)(F.ws + WS_WRT);
    int* route = (int*)(F.ws + WS_ROUTE); int* lists = (int*)(F.ws + WS_LISTS);
    unsigned* counts = F.ctl + CW_CNT + l * 32 * 64;
    const float* g = A.in[I_LMG] + l * D_; const float* b = A.in[I_LMB] + l * D_; const float* rb = A.in[I_RB];
    int tid = F.tid; asm volatile("" : "+v"(tid));
    const int lane = tid & 63, wave = F.wave, fr = lane & 15, fq = lane >> 4;
    for (int q = tid; q < 32 * 128; q += 512) { const int e = q >> 7, c = q & 127; *(LAS v4u*)(lds + e * 2064 + c * 16) = *(const GAS v4u*)(WRT + e * 1024 + c * 8); }
    if (tid < 32) cntl[tid] = 0;
    f32x4 gv[4], bv[4];
#pragma unroll
    for (int j = 0; j < 4; ++j) { gv[j] = *(const f32x4*)(g + 4 * lane + 256 * j); bv[j] = *(const f32x4*)(b + 4 * lane + 256 * j); }
    __syncthreads();
    for (int blk = F.vcu; blk < T_ / 128; blk += F.G) {
#pragma unroll 1
        for (int i = 0; i < 16; i += 4) { const size_t m = (size_t)(blk * 128 + wave * 16 + i);
            v2u q[4][4];
#pragma unroll
            for (int u = 0; u < 4; ++u) { const GAS v2u* up = (const GAS v2u*)(U + (m + u) * D_) + lane;
#pragma unroll
                for (int j = 0; j < 4; ++j) q[u][j] = up[64 * j]; }
#pragma unroll
            for (int u = 0; u < 4; ++u) { f32x4 v[4]; float s = 0.f;
#pragma unroll
                for (int j = 0; j < 4; ++j) { v[j] = (f32x4){bflo(q[u][j].x), bfhi(q[u][j].x), bflo(q[u][j].y), bfhi(q[u][j].y)}; s += (v[j].x + v[j].y) + (v[j].z + v[j].w); }
                const float mean = wave_sum(s) * (1.f / D_); float s2 = 0.f;
#pragma unroll
                for (int j = 0; j < 4; ++j) { v[j] = v[j] - mean; s2 += (v[j].x * v[j].x + v[j].y * v[j].y) + (v[j].z * v[j].z + v[j].w * v[j].w); }
                const float rstd = __builtin_amdgcn_rsqf(wave_sum(s2) * (1.f / D_) + LN_EPS);
                GAS v2u* o8 = (GAS v2u*)(HB + (m + u) * D_) + lane; GAS unsigned* o4 = (GAS unsigned*)(H8 + (m + u) * D_) + lane;
#pragma unroll
                for (int j = 0; j < 4; ++j) { const f32x4 o = v[j] * rstd * gv[j] + bv[j]; v2u w; w.x = pk2(o.x, o.y); w.y = pk2(o.z, o.w); o8[64 * j] = w; o4[64 * j] = pk4_fp8(o.x, o.y, o.z, o.w); } }
        }
        VM_WAIT(); asm volatile("" ::: "memory");
        const int token = blk * 128 + wave * 16 + fr;
        f32x4 acc0 = (f32x4){0.f, 0.f, 0.f, 0.f}, acc1 = (f32x4){0.f, 0.f, 0.f, 0.f};
        const bf16* hrow = HB + (size_t)token * D_ + fq * 8;
#pragma unroll 16
        for (int k = 0; k < 32; ++k) { const int kk = k * 32 + fq * 8;
            const bf16x8 hf = *(const GAS bf16x8*)(hrow + k * 32);
            const bf16x8 w0 = *(const LAS bf16x8*)(lds + fr * 2064 + kk * 2), w1 = *(const LAS bf16x8*)(lds + (16 + fr) * 2064 + kk * 2);
            acc0 = __builtin_amdgcn_mfma_f32_16x16x32_bf16(w0, hf, acc0, 0, 0, 0);
            acc1 = __builtin_amdgcn_mfma_f32_16x16x32_bf16(w1, hf, acc1, 0, 0, 0);
        }
        float p0[4], p1[4]; float mx = -3.0e38f;
#pragma unroll
        for (int r = 0; r < 4; ++r) { p0[r] = acc0[r] + rb[4 * fq + r]; p1[r] = acc1[r] + rb[16 + 4 * fq + r]; mx = fmaxf(mx, fmaxf(p0[r], p1[r])); }
        mx = fmaxf(mx, __shfl_xor(mx, 16)); mx = fmaxf(mx, __shfl_xor(mx, 32));
#pragma unroll
        for (int r = 0; r < 4; ++r) { p0[r] = __expf(p0[r] - mx); p1[r] = __expf(p1[r] - mx); }
        float a1, a2, c1, c2; int ia1, ia2, ic1, ic2;
        top2of4(p0[0], p0[1], p0[2], p0[3], a1, ia1, a2, ia2); top2of4(p1[0], p1[1], p1[2], p1[3], c1, ic1, c2, ic2);
        const float sc0 = a1 + a2, sc1 = c1 + c2;
        float bs = sc0; int bg = fq; if (sc1 > sc0) { bs = sc1; bg = 4 + fq; }
#pragma unroll
        for (int off = 16; off <= 32; off <<= 1) { const float os = __shfl_xor(bs, off); const int og = __shfl_xor(bg, off); if (os > bs || (os == bs && og < bg)) { bs = os; bg = og; } }
        if ((bg & 3) == fq) {
            const bool hi = bg >= 4;
            const float pa = hi ? c1 : a1, pb = hi ? c2 : a2; const int ia = hi ? ic1 : ia1, ib = hi ? ic2 : ia2;
            const int ea = bg * 4 + ia, eb = bg * 4 + ib; const float inv = 1.0f / (pa + pb);
            const int tokl = wave * 16 + fr;
            const int la = atomicAdd((int*)&cntl[ea], 1), lb2 = atomicAdd((int*)&cntl[eb], 1);
            sel[tokl * 2] = ea; sel[tokl * 2 + 1] = eb; lpos[tokl * 2] = la; lpos[tokl * 2 + 1] = lb2;
            int* rt = route + (size_t)token * 8; rt[0] = ea; rt[2] = eb; rt[4] = __float_as_int(pa * inv); rt[5] = __float_as_int(pb * inv);
        }
        __syncthreads();
        if (tid < 32) { const int c = cntl[tid]; basel[tid] = c ? (int)__hip_atomic_fetch_add(counts + tid * 64, (unsigned)c, RLX_AGENT) : 0; }
        __syncthreads();
        if (tid < 256) { const int tokl = tid >> 1, k = tid & 1, e = sel[tid], pos = basel[e] + lpos[tid], tok = blk * 128 + tokl;
            lists[(size_t)e * 65536 + pos] = tok * 2 + k; route[(size_t)tok * 8 + 1 + 2 * k] = pos; }
        __syncthreads();
        if (tid < 32) cntl[tid] = 0;
        __syncthreads();
    }
}

__device__ __forceinline__ void moe_table(Frame& F, int l) {
    LAS int* tab = (LAS int*)(F.lds + TAB_OFF);
    __syncthreads();
    if (F.tid < 32) tab[40 + F.tid] = (int)__hip_atomic_load(F.ctl + CW_CNT + (l * 32 + F.tid) * 64, RLX_AGENT);
    __syncthreads();
    if (F.tid == 0) { int s = 0; for (int e = 0; e < 32; ++e) { tab[e] = s; s += (tab[40 + e] + 255) >> 8; } tab[32] = s; }
    __syncthreads();
    for (int t = F.tid; t < tab[32]; t += NWAVES * 64) { int e = 0; while (e < 31 && tab[e + 1] <= t) ++e; tab[80 + t] = e; }
    __syncthreads();
}

__device__ __forceinline__ void p7_combine_ln(Frame& F, const Args& A, int l) {
    const LAS int* tab = (const LAS int*)(F.lds + TAB_OFF);
    bf16* HB = (bf16*)(F.ws + WS_HB); const unsigned char* Y2S = F.ws + WS_Y2S; const int* route = (const int*)(F.ws + WS_ROUTE);
    const float* g = A.in[I_LFG] + l * D_; const float* b = A.in[I_LFB] + l * D_;
    int lane = F.lane; asm volatile("" : "+v"(lane));
    const int gw = F.vcu * NWAVES + F.wave, NGW = F.G * NWAVES;
    f32x4 gv[4], bv[4];
#pragma unroll
    for (int j = 0; j < 4; ++j) { gv[j] = *(const f32x4*)(g + 4 * lane + 256 * j); bv[j] = *(const f32x4*)(b + 4 * lane + 256 * j); }
    const bool last = (l == NL - 1);
    const int step = NGW * 2;
    int R[2][6], Rn[2][6];
    v2u hq[2][4], hn[2][4]; unsigned aq[2][4], cq[2][4], an[2][4], cn[2][4];
#define P7_ROUTE(m0_, R_) do { _Pragma("unroll") for (int _u = 0; _u < 2; ++_u) { const int* _rt = route + (size_t)((m0_) + _u) * 8; \
        _Pragma("unroll") for (int _k = 0; _k < 6; ++_k) R_[_u][_k] = _rt[_k]; } } while (0)
#define P7_ROWS(m0_, R_, hq_, aq_, cq_) do { _Pragma("unroll") for (int _u = 0; _u < 2; ++_u) { const int _m = (m0_) + _u; \
        const size_t _r0 = (size_t)tab[R_[_u][0]] * 256 + R_[_u][1], _r1 = (size_t)tab[R_[_u][2]] * 256 + R_[_u][3]; \
        const GAS v2u* _hp = (const GAS v2u*)(HB + (size_t)_m * D_) + lane; const GAS unsigned* _ya = (const GAS unsigned*)(Y2S + _r0 * D_) + lane; const GAS unsigned* _yb = (const GAS unsigned*)(Y2S + _r1 * D_) + lane; \
        _Pragma("unroll") for (int _j = 0; _j < 4; ++_j) { hq_[_u][_j] = _hp[64 * _j]; aq_[_u][_j] = _ya[64 * _j]; cq_[_u][_j] = _yb[64 * _j]; } } } while (0)
    int m0 = gw * 2;
    if (m0 < T_) { P7_ROUTE(m0, R); P7_ROWS(m0, R, hq, aq, cq); if (m0 + step < T_) P7_ROUTE(m0 + step, Rn); }
    for (; m0 < T_; m0 += step) {
        const bool has_n = m0 + step < T_;
        int Rnn[2][6];
        if (has_n) P7_ROWS(m0 + step, Rn, hn, an, cn);
        if (m0 + 2 * step < T_) P7_ROUTE(m0 + 2 * step, Rnn);
#pragma unroll
        for (int u = 0; u < 2; ++u) { const int m = m0 + u; f32x4 v[4]; float s = 0.f; const float g0 = __int_as_float(R[u][4]), g1 = __int_as_float(R[u][5]);
#pragma unroll
            for (int j = 0; j < 4; ++j) { const v2u h = hq[u][j]; const unsigned a = aq[u][j], c = cq[u][j];
                const f32x2 a01 = __builtin_amdgcn_cvt_pk_f32_fp8((int)a, false), a23 = __builtin_amdgcn_cvt_pk_f32_fp8((int)a, true), c01 = __builtin_amdgcn_cvt_pk_f32_fp8((int)c, false), c23 = __builtin_amdgcn_cvt_pk_f32_fp8((int)c, true);
                v[j].x = ALPHA * bflo(h.x) + g0 * a01.x + g1 * c01.x; v[j].y = ALPHA * bfhi(h.x) + g0 * a01.y + g1 * c01.y;
                v[j].z = ALPHA * bflo(h.y) + g0 * a23.x + g1 * c23.x; v[j].w = ALPHA * bfhi(h.y) + g0 * a23.y + g1 * c23.y;
                s += (v[j].x + v[j].y) + (v[j].z + v[j].w); }
            const float mean = wave_sum(s) * (1.f / D_); float s2 = 0.f;
#pragma unroll
            for (int j = 0; j < 4; ++j) { v[j] = v[j] - mean; s2 += (v[j].x * v[j].x + v[j].y * v[j].y) + (v[j].z * v[j].z + v[j].w * v[j].w); }
            const float rstd = __builtin_amdgcn_rsqf(wave_sum(s2) * (1.f / D_) + LN_EPS);
            if (last) { GAS f32x4* o = (GAS f32x4*)(A.out + (size_t)m * D_) + lane;
#pragma unroll
                for (int j = 0; j < 4; ++j) o[64 * j] = v[j] * rstd * gv[j] + bv[j];
            } else { GAS v2u* o8 = (GAS v2u*)(HB + (size_t)m * D_) + lane; float amax = 0.f;
#pragma unroll
                for (int j = 0; j < 4; ++j) { const f32x4 o = v[j] * rstd * gv[j] + bv[j]; v[j] = o; v2u w; w.x = pk2(o.x, o.y); w.y = pk2(o.z, o.w); o8[64 * j] = w;
                    amax = fmaxf(amax, fmaxf(fmaxf(fabsf(o.x), fabsf(o.y)), fmaxf(fabsf(o.z), fabsf(o.w)))); }
                if (GEMM1_I8) { amax = wave_max(amax); const float inv = amax > 0.f ? 127.f / amax : 0.f;
                    GAS unsigned* q4 = (GAS unsigned*)(F.ws + WS_HQ + (size_t)m * D_) + lane;
#pragma unroll
                    for (int j = 0; j < 4; ++j) q4[64 * j] = pk4_i8(v[j].x * inv, v[j].y * inv, v[j].z * inv, v[j].w * inv);
                    if (lane == 0) ((float*)(F.ws + WS_HS))[m] = amax * (1.f / 127.f); } }
        }
#pragma unroll
        for (int u = 0; u < 2; ++u) {
#pragma unroll
            for (int j = 0; j < 4; ++j) { hq[u][j] = hn[u][j]; aq[u][j] = an[u][j]; cq[u][j] = cn[u][j]; }
#pragma unroll
            for (int k = 0; k < 6; ++k) { R[u][k] = Rn[u][k]; Rn[u][k] = Rnn[u][k]; } }
    }
#undef P7_ROUTE
#undef P7_ROWS
}

#ifndef PH_NOINLINE
#define PH_NOINLINE __forceinline__
#endif
PH_NOINLINE __device__ void run_gemm1(LAS unsigned char* lds, unsigned char* ws, int l, int G, int c) {
    pg8::DenseOrder S;
    if (GEMM1_I8) { S.init(ws + WS_HQ, ws + WS_WIN + (size_t)l * N1 * 1024, T_, N1, D_ / 2, G, c, 1);
        pg8::EpiZq E{(bf16*)(ws + WS_Z), (const float*)(ws + WS_HS), (const float*)((unsigned*)(ws + WS_CTL) + CW_CMAX) + l * N1}; pg8::gemm_phase<pg8::EpiZq, pg8::DenseOrder, 2>(lds, S, E); }
    else { S.init(ws + WS_HB, ws + WS_WIN + (size_t)l * N1 * 1024 * 2, T_, N1, D_, G, c, 1); pg8::EpiZ E{(bf16*)(ws + WS_Z)}; pg8::gemm_phase(lds, S, E); }
}
PH_NOINLINE __device__ void run_gemm_probe(LAS unsigned char* lds, unsigned char* ws, int G, int c) {
    pg8::DenseOrder S; S.init(ws + WS_HB, ws + WS_WIN, T_, 256 * (PROBE_EXTRA_NN ? PROBE_EXTRA_NN : 1), D_, G, c);
    pg8::EpiPlain E{(bf16*)(ws + WS_Y), 2048};
    pg8::gemm_phase(lds, S, E);
}
PH_NOINLINE __device__ void run_gemm2(LAS unsigned char* lds, unsigned char* ws, int l, int G, int c) {
    pg8::EpiU E{(const bf16*)(ws + WS_HB), (bf16*)(ws + WS_U)};
    if (GEMM2_FP8) { pg8::DenseRowsOrder S; int kq = D_ / 2; asm volatile("" : "+s"(kq)); S.init(ws + WS_Y, ws + WS_WOUT + (size_t)l * 1024 * 1024, T_, D_, kq, G, c); pg8::gemm_phase<pg8::EpiU, pg8::DenseRowsOrder, true>(lds, S, E); }
    else { pg8::DenseOrder S; S.init(ws + WS_Y, ws + WS_WOUT + (size_t)l * 1024 * 1024 * 2, T_, D_, D_, G, c); pg8::gemm_phase(lds, S, E); }
}
PH_NOINLINE __device__ void run_gemm5(LAS unsigned char* lds, unsigned char* ws, int l, int G, int c) {
    const LAS int* tab = (const LAS int*)(lds + TAB_OFF);
    pg8::MoeGatherOrder S; S.A = (const char*)(ws + WS_H8); S.Bt = (const char*)(ws + WS_WGU + (size_t)l * NE * 1024 * 1024); S.bexp = (size_t)1024 * 1024;
    int kq = D_ / 2; asm volatile("" : "+s"(kq));
    S.K = kq; S.nN = 4; S.nwg = tab[32] * 4; S.G = G; S.c = c; S.tab = tab; S.lists = (const int*)(ws + WS_LISTS);
    pg8::EpiHid E{ws + WS_HID};
    pg8::gemm_phase<pg8::EpiHid, pg8::MoeGatherOrder, true>(lds, S, E);
}
PH_NOINLINE __device__ void run_gemm6(LAS unsigned char* lds, unsigned char* ws, int l, int G, int c) {
    const LAS int* tab = (const LAS int*)(lds + TAB_OFF);
    pg8::MoeRowsOrder S; S.A = (const char*)(ws + WS_HID); S.Bt = (const char*)(ws + WS_WD + (size_t)l * NE * 1024 * 512); S.bexp = (size_t)1024 * 512;
    int kq = DE / 2; asm volatile("" : "+s"(kq));
    S.K = kq; S.nN = 4; S.nwg = tab[32] * 4; S.G = G; S.c = c; S.tab = tab; S.lists = nullptr;
    pg8::EpiPlain8 E{ws + WS_Y2S, D_};
    pg8::gemm_phase<pg8::EpiPlain8, pg8::MoeRowsOrder, true>(lds, S, E);
}

__global__ void __launch_bounds__(NWAVES * 64, 2) mk_fwd(Args args) {
    extern __shared__ __attribute__((aligned(16))) unsigned char lds_raw[];
    Frame F;
    F.lds = (LAS unsigned char*)lds_raw;
    F.tid = threadIdx.x; F.lane = F.tid & 63; F.wave = __builtin_amdgcn_readfirstlane(F.tid >> 6);
    F.G = gridDim.x; { const int bx = blockIdx.x; F.vcu = (F.G % 8 == 0) ? (bx % 8) * (F.G / 8) + bx / 8 : bx; }
    F.ws = args.ws; F.ctl = (unsigned*)(args.ws + WS_CTL);
    for (int u = F.tid; u < (LDS_BYTES - LDSCTL_OFF) / 4; u += NWAVES * 64) ((LAS unsigned*)(F.lds + LDSCTL_OFF))[u] = 0u;
    __syncthreads();
    volatile LAS unsigned* MISC = (volatile LAS unsigned*)(F.lds + MISC_OFF);
    XcdBarrier bar; bar.bar = F.ctl + CW_BAR; bar.x = 0; bar.st = nullptr;
    if (MK_N_LAUNCHES == 1) bar = xcd_barrier_post(F.ctl + CW_BAR, MISC + 8);
    const int lo = args.ph_lo, hi = args.ph_hi;
#define IN(k) (lo <= (k) && (k) < hi)
#define SEAM(k) do { if (MK_N_LAUNCHES == 1 && (k) + 1 < hi) xcd_barrier(bar); } while (0)
    if (REPEAT_MASK & 256) { for (int rep = 0; rep < 10; ++rep) xcd_barrier(bar); }
    if ((PH_MASK & 1) && IN(0)) { for (int rep = 0; rep < ((REPEAT_MASK & 1) ? 2 : 1); ++rep) { p0_prologue(F, args); SEAM(0); } }
#pragma unroll 1
    for (int l = 0; l < NL; ++l) {
        const int pb = 1 + 7 * l;
        if ((PH_MASK & 2) && IN(pb + 0)) { for (int rep = 0; rep < ((REPEAT_MASK & 2) ? 2 : 1); ++rep) { run_gemm1(F.lds, F.ws, l, F.G, (int)blockIdx.x); SEAM(pb + 0); }
            if (PROBE_EXTRA_NN && l == 0) { run_gemm_probe(F.lds, F.ws, F.G, (int)blockIdx.x); xcd_barrier(bar); } }
        if ((PH_MASK & 4) && IN(pb + 1)) { for (int rep = 0; rep < ((REPEAT_MASK & 4) ? 2 : 1); ++rep) { p2_mixer(F, args, l); SEAM(pb + 1); } }
        if ((PH_MASK & 8) && IN(pb + 2)) { for (int rep = 0; rep < ((REPEAT_MASK & 8) ? 2 : 1); ++rep) { run_gemm2(F.lds, F.ws, l, F.G, (int)blockIdx.x); SEAM(pb + 2); } }
        if ((PH_MASK & 16) && IN(pb + 3)) {
            if (REPEAT_MASK & 16) { p4_ln_router(F, args, l); SEAM(pb + 3);
                if (blockIdx.x == 0 && F.tid < 32) __hip_atomic_store(F.ctl + CW_CNT + (l * 32 + F.tid) * 64, 0u, RLX_AGENT);
                SEAM(pb + 3); }
            p4_ln_router(F, args, l); SEAM(pb + 3); }
        if ((PH_MASK & 32) && IN(pb + 4)) { for (int rep = 0; rep < ((REPEAT_MASK & 32) ? 2 : 1); ++rep) { moe_table(F, l); run_gemm5(F.lds, F.ws, l, F.G, (int)blockIdx.x); SEAM(pb + 4); } }
        if ((PH_MASK & 64) && IN(pb + 5)) { for (int rep = 0; rep < ((REPEAT_MASK & 64) ? 2 : 1); ++rep) { if (MK_N_LAUNCHES != 1 || rep) moe_table(F, l); run_gemm6(F.lds, F.ws, l, F.G, (int)blockIdx.x); SEAM(pb + 5); } }
        if ((PH_MASK & 128) && IN(pb + 6)) { for (int rep = 0; rep < (((REPEAT_MASK & 128) && l == NL - 1) ? 2 : 1); ++rep) { if (MK_N_LAUNCHES != 1) moe_table(F, l); p7_combine_ln(F, args, l); if (rep == 0) SEAM(pb + 6); else xcd_barrier(bar); } }
    }
#undef IN
#undef SEAM
}

extern "C" void kernel_launch(void* const* d_in, const int* in_sizes, int n_in, void* d_out, int out_size, void* d_ws, size_t ws_size, hipStream_t stream) {
    static int grid = 0;
    if (grid == 0) {
        if (n_in != 21 || out_size != T_ * D_ || ws_size < WS_END) { fprintf(stderr, "kernel_launch: unexpected problem (n_in %d, out %d, ws %zu); nothing launched\n", n_in, out_size, ws_size); grid = -1; return; }
        int dev = 0, cus = 0, per_cu = 0;
        if (hipGetDevice(&dev) != hipSuccess || hipDeviceGetAttribute(&cus, hipDeviceAttributeMultiprocessorCount, dev) != hipSuccess) { grid = -1; return; }
        if (hipFuncSetAttribute((const void*)mk_fwd, hipFuncAttributeMaxDynamicSharedMemorySize, LDS_BYTES) != hipSuccess) { fprintf(stderr, "kernel_launch: hipFuncSetAttribute failed\n"); grid = -1; return; }
        if (hipOccupancyMaxActiveBlocksPerMultiprocessor(&per_cu, (const void*)mk_fwd, NWAVES * 64, LDS_BYTES) != hipSuccess || per_cu < 1) { fprintf(stderr, "kernel_launch: occupancy query says %d\n", per_cu); }
        (void)hipGetLastError();
        grid = cus;
    }
    if (grid < 0) return;
    (void)hipMemsetAsync((char*)d_ws + WS_CTL, 0, CTL_ZERO_BYTES, stream);
    Args a{};
    for (int i = 0; i < 21; ++i) a.in[i] = (const float*)d_in[i];
    a.out = (float*)d_out; a.ws = (unsigned char*)d_ws;
    if (MK_N_LAUNCHES == 1) { a.ph_lo = 0; a.ph_hi = NPH; hipLaunchKernelGGL(mk_fwd, dim3(grid), dim3(NWAVES * 64), LDS_BYTES, stream, a); }
    else for (int p = 0; p < NPH; ++p) { a.ph_lo = p; a.ph_hi = p + 1; hipLaunchKernelGGL(mk_fwd, dim3(grid), dim3(NWAVES * 64), LDS_BYTES, stream, a); }
}
```

```cpp
#include <hip/hip_runtime.h>
#include <cstdio>
#include <cstdint>

#ifndef MK_N_LAUNCHES
#define MK_N_LAUNCHES 1
#endif
#ifndef PH_MASK
#define PH_MASK 0xff
#endif
#ifndef REPEAT_MASK
#define REPEAT_MASK 0
#endif
#ifndef GEMM1_I8
#define GEMM1_I8 1
#endif
#ifndef GEMM2_FP8
#define GEMM2_FP8 1
#endif
#ifndef PROBE_P0
#define PROBE_P0 0
#endif
#ifndef PROBE_MIX
#define PROBE_MIX 0
#endif
#ifndef PROBE_EXTRA_NN
#define PROBE_EXTRA_NN 0
#endif
#ifndef GEMM_SIMPLE_MASK
#define GEMM_SIMPLE_MASK 0
#endif

#define GAS __attribute__((address_space(1)))
#define LAS __attribute__((address_space(3)))
typedef unsigned short bf16;
typedef unsigned v4u __attribute__((ext_vector_type(4)));
typedef unsigned v2u __attribute__((ext_vector_type(2)));
typedef float f32x4 __attribute__((ext_vector_type(4)));
typedef float f32x2 __attribute__((ext_vector_type(2)));
typedef short bf16x8 __attribute__((ext_vector_type(8)));
#define RLX_AGENT __ATOMIC_RELAXED, __HIP_MEMORY_SCOPE_AGENT
#define LDS_WAIT() asm volatile("s_waitcnt lgkmcnt(0)" ::: "memory")
#define VM_WAIT() asm volatile("s_waitcnt vmcnt(0)" ::: "memory")

constexpr int T_ = 32768, D_ = 1024, SEQ_ = 4096, NL = 2, NE = 32, DE = 512;
constexpr int DIN = 2176, N1 = 2304, NZ = 1408;
constexpr float ALPHA = 1.41421356237f, LN_EPS = 1e-5f;
constexpr int NPH = 1 + 7 * NL;

constexpr size_t MiB = 1u << 20;
constexpr size_t WS_CTL = 0, CTL_ZERO_BYTES = 128 * 1024;
constexpr size_t WS_ROUTE = 1 * MiB;
constexpr size_t WS_WRT = 2 * MiB;
constexpr size_t WS_HS = 2 * MiB + 256 * 1024;
constexpr size_t WS_CS = 2 * MiB + 512 * 1024;
constexpr size_t WS_LISTS = 3 * MiB;
constexpr size_t WS_WIN = 11 * MiB;
constexpr size_t WS_WOUT = 20 * MiB;
constexpr size_t WS_WGU = 24 * MiB;
constexpr size_t WS_H8 = 88 * MiB;
constexpr size_t WS_HQ = 120 * MiB;
constexpr size_t WS_WD = 152 * MiB;
constexpr size_t WS_HB = 216 * MiB;
constexpr size_t WS_Z = 280 * MiB;
constexpr size_t WS_Y = 368 * MiB;
constexpr size_t WS_U = 280 * MiB;
constexpr size_t WS_HID = 280 * MiB;
constexpr size_t WS_Y2S = 352 * MiB;
constexpr size_t WS_END = 496 * MiB;
constexpr int CW_TMO = 0, CW_BAR = 4096, CW_CNT = 16384, CW_CMAX = 20480  , CW_CMAXCNT = 25600;

constexpr int RING_BYTES = 131072, LDSCTL_OFF = RING_BYTES, MISC_OFF = LDSCTL_OFF + 320, TAB_OFF = LDSCTL_OFF + 1024;
constexpr int LDS_BYTES = 147456;

__device__ __forceinline__ unsigned f2bf(float f) { unsigned u = __builtin_bit_cast(unsigned, f); return (u + 0x7fffu + ((u >> 16) & 1u)) >> 16; }
__device__ __forceinline__ unsigned pk2(float lo, float hi) { unsigned r; asm("v_cvt_pk_bf16_f32 %0, %1, %2" : "=v"(r) : "v"(lo), "v"(hi)); return r; }
__device__ __forceinline__ float bflo(unsigned u) { return __builtin_bit_cast(float, u << 16); }
__device__ __forceinline__ float bfhi(unsigned u) { return __builtin_bit_cast(float, u & 0xffff0000u); }
template <int CTRL> __device__ __forceinline__ float dpp_mov(float v) { return __builtin_bit_cast(float, __builtin_amdgcn_update_dpp(0, __builtin_bit_cast(int, v), CTRL, 0xf, 0xf, false)); }
__device__ __forceinline__ float wave_sum(float v) {
    v += dpp_mov<0xB1>(v); v += dpp_mov<0x4E>(v); v += dpp_mov<0x141>(v); v += dpp_mov<0x140>(v);
    const int iv = __builtin_bit_cast(int, v);
    return (__builtin_bit_cast(float, __builtin_amdgcn_readlane(iv, 0)) + __builtin_bit_cast(float, __builtin_amdgcn_readlane(iv, 16))) +
           (__builtin_bit_cast(float, __builtin_amdgcn_readlane(iv, 32)) + __builtin_bit_cast(float, __builtin_amdgcn_readlane(iv, 48)));
}
__device__ __forceinline__ float wave_max(float v) {
    v = fmaxf(v, dpp_mov<0xB1>(v)); v = fmaxf(v, dpp_mov<0x4E>(v)); v = fmaxf(v, dpp_mov<0x141>(v)); v = fmaxf(v, dpp_mov<0x140>(v));
    const int iv = __builtin_bit_cast(int, v);
    return fmaxf(fmaxf(__builtin_bit_cast(float, __builtin_amdgcn_readlane(iv, 0)), __builtin_bit_cast(float, __builtin_amdgcn_readlane(iv, 16))),
                 fmaxf(__builtin_bit_cast(float, __builtin_amdgcn_readlane(iv, 32)), __builtin_bit_cast(float, __builtin_amdgcn_readlane(iv, 48))));
}
__device__ __forceinline__ unsigned pk4_i8(float a, float b, float c, float d) {
    const int ia = (int)__builtin_rintf(a), ib = (int)__builtin_rintf(b), ic = (int)__builtin_rintf(c), id = (int)__builtin_rintf(d);
    return ((unsigned)ia & 0xffu) | (((unsigned)ib & 0xffu) << 8) | (((unsigned)ic & 0xffu) << 16) | ((unsigned)id << 24); }
__device__ __forceinline__ unsigned pk4_fp8(float a, float b, float c, float d) {
    int v = 0; v = __builtin_amdgcn_cvt_pk_fp8_f32(a, b, v, false); v = __builtin_amdgcn_cvt_pk_fp8_f32(c, d, v, true); return (unsigned)v; }
__device__ __forceinline__ float sigmoidf_(float x) { return __builtin_amdgcn_rcpf(1.0f + __expf(-x)); }

namespace pg8 {
#define PG8_LAS __attribute__((address_space(3)))
typedef int v8i __attribute__((ext_vector_type(8)));
typedef int v4i __attribute__((ext_vector_type(4)));
constexpr int BM = 256, BK = 64, HALF = 128, HTB = HALF * BK * 2, STAGE_BYTES = 8 * HTB, NXCD = 8, WGM = 8;
__host__ __device__ __forceinline__ int lds_byte(int r, int c) { const int st = (r >> 4) * 2 + (c >> 5), rr = r & 15, cc = c & 31, ob = rr * 64 + cc * 2; return st * 1024 + (ob ^ (((ob >> 9) & 1) << 5)); }
__host__ __device__ __forceinline__ void stage_rc(int b, int& R, int& C) { const int st = b / 1024, sb = b % 1024, swz = sb ^ (((sb >> 9) & 1) << 5); R = (st >> 1) * 16 + swz / 64; C = (st & 1) * 32 + (swz % 64) / 2; }
__host__ __device__ __forceinline__ int perm32(int rho) { const int n = rho >> 4, i = rho & 15; return 8 * (i >> 2) + 4 * n + (i & 3); }

struct Unit { int pm, pn, e, j, rh; };

__device__ __forceinline__ int xcd_remap(int wgid, int nwg) { const int q = nwg / NXCD, r = nwg % NXCD, xcd = wgid % NXCD, off = wgid / NXCD; return (xcd < r ? xcd * (q + 1) : r * (q + 1) + (xcd - r) * q) + off; }

struct DenseOrder {
    static constexpr bool GATHER = false, HAS_HALF = true, HAS_RH = false;
    const char* A; const char* Bt; int K, nM, nN, nwg, G, c, nhalf;
    __device__ void init(const void* A_, const void* Bt_, int M, int N, int K_, int G_, int c_, int half_tile = 0) { A = (const char*)A_; Bt = (const char*)Bt_; K = K_; nM = M / BM; nN = N / BM - half_tile; nwg = nM * nN; G = G_; c = c_; nhalf = half_tile ? nM : 0; }
    __device__ bool next(int i, Unit& u) const {
        const long L = (long)i * G + c; if (L >= nwg + nhalf) return false;
        u.e = 0; u.j = 0; u.rh = -1;
        if (L >= nwg) { u.pm = (int)(L - nwg); u.pn = nN; return true; }
        const int wgid = xcd_remap((int)L, nwg);
        const int nig = WGM * nN, gid = wgid / nig, fm = gid * WGM, gsz = (nM - fm) < WGM ? (nM - fm) : WGM;
        u.pm = fm + ((wgid % nig) % gsz); u.pn = (wgid % nig) / gsz; return true;
    }
    __device__ __forceinline__ bool is_half(const Unit& u) const { return u.pn >= nN; }
    __device__ __forceinline__ int row_half(const Unit&) const { return -1; }
    __device__ __forceinline__ const char* a_tile(const Unit& u) const { return A + (size_t)u.pm * BM * K * 2; }
    __device__ __forceinline__ const char* b_tile(const Unit& u) const { return Bt + (size_t)u.pn * BM * K * 2; }
    __device__ __forceinline__ unsigned a_row_off(const Unit&, int r) const { return (unsigned)(r * K * 2); }
};
struct DenseRowsOrder : DenseOrder {
    static constexpr bool GATHER = true, HAS_HALF = false;
    __device__ __forceinline__ const char* a_tile(const Unit&) const { return A; }
    __device__ __forceinline__ unsigned a_row_off(const Unit& u, int r) const { return (unsigned)(u.pm * BM + r) * (unsigned)(K * 2); }
};
struct MoeOrder {
    static constexpr bool HAS_HALF = false, HAS_RH = true;
    __device__ __forceinline__ bool is_half(const Unit&) const { return false; }
    const char* A; const char* Bt; size_t bexp; int K, nN, nwg, G, c; const PG8_LAS int* tab; const int* lists;
    __device__ bool next(int i, Unit& u) const {
        const int L = i * G + c, nfull = (nwg / G) * G, rem = nwg - nfull;
        int uidx = L; u.rh = -1;
        if (L >= nfull) { if (2 * rem <= G) { if (L >= nfull + 2 * rem) return false; uidx = nfull + ((L - nfull) >> 1); u.rh = (L - nfull) & 1; } else if (L >= nwg) return false; }
        const int wgid = xcd_remap(uidx, nwg);
        const int t = wgid / nN; u.pn = wgid % nN; u.pm = t;
        const int e = tab[80 + t];
        u.e = e; u.j = t - tab[e]; return true;
    }
    __device__ __forceinline__ int row_half(const Unit& u) const { return u.rh; }
    __device__ __forceinline__ const char* b_tile(const Unit& u) const { return Bt + (size_t)u.e * bexp + (size_t)u.pn * BM * K * 2; }
};
struct MoeGatherOrder : MoeOrder {
    static constexpr bool GATHER = true;
    __device__ __forceinline__ const char* a_tile(const Unit&) const { return A; }
    __device__ __forceinline__ unsigned a_row_off(const Unit& u, int r) const {
        const int idx = u.j * BM + r, cnt = tab[40 + u.e];
        const int ii = idx < cnt ? idx : cnt - 1;
        const int tok = lists[(size_t)u.e * 65536 + ii] >> 1;
        return (unsigned)tok * (unsigned)(K * 2);
    }
};
struct MoeRowsOrder : MoeOrder {
    static constexpr bool GATHER = true;
    __device__ __forceinline__ const char* a_tile(const Unit&) const { return A; }
    __device__ __forceinline__ unsigned a_row_off(const Unit& u, int r) const { return (unsigned)(u.pm * BM + r) * (unsigned)(K * 2); }
};
struct MoeDenseOrder : MoeOrder {
    static constexpr bool GATHER = false;
    __device__ __forceinline__ const char* a_tile(const Unit& u) const { return A + (size_t)u.pm * BM * K * 2; }
    __device__ __forceinline__ unsigned a_row_off(const Unit&, int r) const { return (unsigned)(r * K * 2); }
};

__device__ __forceinline__ unsigned cvt_pk_bf16(float lo, float hi) { unsigned r; asm volatile("v_cvt_pk_bf16_f32 %0, %1, %2" : "=v"(r) : "v"(lo), "v"(hi)); return r; }

struct EpiZ {
    static constexpr bool PERM = true;
    bf16* Z;
    __device__ __forceinline__ void operator()(const f32x4 (&acc)[2][2][4][2], const Unit& u, int wr, int wc, int fr, int fq) const {
        const int row0 = u.pm * BM + wr * 64 + fr, cl = wc * 32 + 8 * fq;
        if (u.pn < 6) {
            const bool sg = u.pn >= 3;
            const int zc = (sg ? 768 + (u.pn - 3) * 128 : 384 + u.pn * 128) + cl;
#pragma unroll
            for (int ai = 0; ai < 2; ++ai)
#pragma unroll
                for (int m = 0; m < 4; ++m) {
                    f32x4 a0 = acc[ai][0][m][0], a1 = acc[ai][0][m][1], g0 = acc[ai][1][m][0], g1 = acc[ai][1][m][1];
                    if (sg) {
#pragma unroll
                        for (int q = 0; q < 4; ++q) { g0[q] = sigmoidf_(g0[q]); g1[q] = sigmoidf_(g1[q]); }
                    }
                    a0 = a0 * g0; a1 = a1 * g1;
                    v4u w; w.x = cvt_pk_bf16(a0[0], a0[1]); w.y = cvt_pk_bf16(a0[2], a0[3]); w.z = cvt_pk_bf16(a1[0], a1[1]); w.w = cvt_pk_bf16(a1[2], a1[3]);
                    *(v4u*)(Z + (size_t)(row0 + ai * HALF + m * 16) * NZ + zc) = w;
                }
        } else {
            int zb0, zb1;
            if (u.pn == 6) { zb0 = 0; zb1 = 128; } else if (u.pn == 7) { zb0 = 256; zb1 = 1152; } else { zb0 = 1280; zb1 = -1; }
#pragma unroll
            for (int ai = 0; ai < 2; ++ai)
#pragma unroll
                for (int m = 0; m < 4; ++m) {
                    bf16* rowp = Z + (size_t)(row0 + ai * HALF + m * 16) * NZ + cl;
#pragma unroll
                    for (int bj = 0; bj < 2; ++bj) {
                        const int zb = bj ? zb1 : zb0;
                        if (zb >= 0) { const f32x4 a0 = acc[ai][bj][m][0], a1 = acc[ai][bj][m][1];
                            v4u w; w.x = cvt_pk_bf16(a0[0], a0[1]); w.y = cvt_pk_bf16(a0[2], a0[3]); w.z = cvt_pk_bf16(a1[0], a1[1]); w.w = cvt_pk_bf16(a1[2], a1[3]);
                            *(v4u*)(rowp + zb) = w; }
                    }
                }
        }
    }
};
struct EpiZq {
    static constexpr bool PERM = true;
    bf16* Z; const float* hs; const float* cs;
    __device__ __forceinline__ void operator()(f32x4 (&acc)[2][2][4][2], const Unit& u, int wr, int wc, int fr, int fq) const {
        const int row0 = u.pm * BM + wr * 64 + fr, cl = wc * 32 + 8 * fq;
        {
            float rs[2][4]; f32x4 cv[2][2];
#pragma unroll
            for (int ai = 0; ai < 2; ++ai)
#pragma unroll
                for (int m = 0; m < 4; ++m) rs[ai][m] = hs[row0 + ai * HALF + m * 16];
#pragma unroll
            for (int bj = 0; bj < 2; ++bj)
#pragma unroll
                for (int n = 0; n < 2; ++n) cv[bj][n] = *(const f32x4*)(cs + u.pn * BM + bj * HALF + cl + 4 * n) * (1.f / 127.f);
#pragma unroll
            for (int ai = 0; ai < 2; ++ai)
#pragma unroll
                for (int bj = 0; bj < 2; ++bj)
#pragma unroll
                    for (int m = 0; m < 4; ++m)
#pragma unroll
                        for (int n = 0; n < 2; ++n) { const v4i q = __builtin_bit_cast(v4i, acc[ai][bj][m][n]);
                            acc[ai][bj][m][n] = (f32x4){(float)q.x, (float)q.y, (float)q.z, (float)q.w} * rs[ai][m] * cv[bj][n]; }
        }
        if (u.pn < 6) {
            const bool sg = u.pn >= 3;
            const int zc = (sg ? 768 + (u.pn - 3) * 128 : 384 + u.pn * 128) + cl;
#pragma unroll
            for (int ai = 0; ai < 2; ++ai)
#pragma unroll
                for (int m = 0; m < 4; ++m) {
                    f32x4 a0 = acc[ai][0][m][0], a1 = acc[ai][0][m][1], g0 = acc[ai][1][m][0], g1 = acc[ai][1][m][1];
                    if (sg) {
#pragma unroll
                        for (int q = 0; q < 4; ++q) { g0[q] = sigmoidf_(g0[q]); g1[q] = sigmoidf_(g1[q]); }
                    }
                    a0 = a0 * g0; a1 = a1 * g1;
                    v4u w; w.x = cvt_pk_bf16(a0[0], a0[1]); w.y = cvt_pk_bf16(a0[2], a0[3]); w.z = cvt_pk_bf16(a1[0], a1[1]); w.w = cvt_pk_bf16(a1[2], a1[3]);
                    *(v4u*)(Z + (size_t)(row0 + ai * HALF + m * 16) * NZ + zc) = w;
                }
        } else {
            int zb0, zb1;
            if (u.pn == 6) { zb0 = 0; zb1 = 128; } else if (u.pn == 7) { zb0 = 256; zb1 = 1152; } else { zb0 = 1280; zb1 = -1; }
#pragma unroll
            for (int ai = 0; ai < 2; ++ai)
#pragma unroll
                for (int m = 0; m < 4; ++m) {
                    bf16* rowp = Z + (size_t)(row0 + ai * HALF + m * 16) * NZ + cl;
#pragma unroll
                    for (int bj = 0; bj < 2; ++bj) {
                        const int zb = bj ? zb1 : zb0;
                        if (zb >= 0) { const f32x4 a0 = acc[ai][bj][m][0], a1 = acc[ai][bj][m][1];
                            v4u w; w.x = cvt_pk_bf16(a0[0], a0[1]); w.y = cvt_pk_bf16(a0[2], a0[3]); w.z = cvt_pk_bf16(a1[0], a1[1]); w.w = cvt_pk_bf16(a1[2], a1[3]);
                            *(v4u*)(rowp + zb) = w; }
                    }
                }
        }
    }
};
struct EpiU {
    static constexpr bool PERM = true;
    const bf16* H; bf16* U;
    __device__ __forceinline__ void operator()(const f32x4 (&acc)[2][2][4][2], const Unit& u, int wr, int wc, int fr, int fq) const {
        const int row0 = u.pm * BM + wr * 64 + fr, col0 = u.pn * BM + wc * 32 + 8 * fq;
        v4u hh[2][4][2];
#pragma unroll
        for (int ai = 0; ai < 2; ++ai)
#pragma unroll
            for (int m = 0; m < 4; ++m)
#pragma unroll
                for (int bj = 0; bj < 2; ++bj) hh[ai][m][bj] = *(const v4u*)(H + (size_t)(row0 + ai * HALF + m * 16) * D_ + col0 + bj * HALF);
#pragma unroll
        for (int ai = 0; ai < 2; ++ai)
#pragma unroll
            for (int m = 0; m < 4; ++m) {
                const size_t off = (size_t)(row0 + ai * HALF + m * 16) * D_ + col0;
#pragma unroll
                for (int bj = 0; bj < 2; ++bj) {
                    const v4u h = hh[ai][m][bj];
                    const f32x4 a0 = acc[ai][bj][m][0], a1 = acc[ai][bj][m][1];
                    v4u w;
                    w.x = cvt_pk_bf16(ALPHA * bflo(h.x) + a0[0], ALPHA * bfhi(h.x) + a0[1]); w.y = cvt_pk_bf16(ALPHA * bflo(h.y) + a0[2], ALPHA * bfhi(h.y) + a0[3]);
                    w.z = cvt_pk_bf16(ALPHA * bflo(h.z) + a1[0], ALPHA * bfhi(h.z) + a1[1]); w.w = cvt_pk_bf16(ALPHA * bflo(h.w) + a1[2], ALPHA * bfhi(h.w) + a1[3]);
                    *(v4u*)(U + off + bj * HALF) = w;
                }
            }
    }
};
struct EpiHid {
    static constexpr bool PERM = true;
    unsigned char* HID;
    __device__ __forceinline__ void operator()(const f32x4 (&acc)[2][2][4][2], const Unit& u, int wr, int wc, int fr, int fq) const {
        const int row0 = u.pm * BM + wr * 64 + fr, col0 = u.pn * 128 + wc * 32 + 8 * fq;
#pragma unroll
        for (int ai = 0; ai < 2; ++ai) { if (u.rh >= 0 && u.rh != ai) continue;
#pragma unroll
            for (int m = 0; m < 4; ++m) {
                f32x4 g0 = acc[ai][0][m][0], g1 = acc[ai][0][m][1]; const f32x4 u0 = acc[ai][1][m][0], u1 = acc[ai][1][m][1];
#pragma unroll
                for (int q = 0; q < 4; ++q) { g0[q] = g0[q] * sigmoidf_(g0[q]); g1[q] = g1[q] * sigmoidf_(g1[q]); }
                g0 = g0 * u0; g1 = g1 * u1;
                v2u w; w.x = pk4_fp8(g0[0], g0[1], g0[2], g0[3]); w.y = pk4_fp8(g1[0], g1[1], g1[2], g1[3]);
                *(v2u*)(HID + (size_t)(row0 + ai * HALF + m * 16) * DE + col0) = w;
            } }
    }
};
struct EpiPlain8 {
    static constexpr bool PERM = true;
    unsigned char* O; int ldc;
    __device__ __forceinline__ void operator()(const f32x4 (&acc)[2][2][4][2], const Unit& u, int wr, int wc, int fr, int fq) const {
        const int row0 = u.pm * BM + wr * 64 + fr, col0 = u.pn * BM + wc * 32 + 8 * fq;
#pragma unroll
        for (int ai = 0; ai < 2; ++ai) { if (u.rh >= 0 && u.rh != ai) continue;
#pragma unroll
            for (int m = 0; m < 4; ++m) {
                unsigned char* rowp = O + (size_t)(row0 + ai * HALF + m * 16) * ldc + col0;
#pragma unroll
                for (int bj = 0; bj < 2; ++bj) { const f32x4 a0 = acc[ai][bj][m][0], a1 = acc[ai][bj][m][1];
                    v2u w; w.x = pk4_fp8(a0[0], a0[1], a0[2], a0[3]); w.y = pk4_fp8(a1[0], a1[1], a1[2], a1[3]);
                    *(v2u*)(rowp + bj * HALF) = w; }
            } }
    }
};
struct EpiPlain {
    static constexpr bool PERM = true;
    bf16* O; int ldc;
    __device__ __forceinline__ void operator()(const f32x4 (&acc)[2][2][4][2], const Unit& u, int wr, int wc, int fr, int fq) const {
        const int row0 = u.pm * BM + wr * 64 + fr, col0 = u.pn * BM + wc * 32 + 8 * fq;
#pragma unroll
        for (int ai = 0; ai < 2; ++ai)
#pragma unroll
            for (int m = 0; m < 4; ++m) {
                bf16* rowp = O + (size_t)(row0 + ai * HALF + m * 16) * ldc + col0;
#pragma unroll
                for (int bj = 0; bj < 2; ++bj) { const f32x4 a0 = acc[ai][bj][m][0], a1 = acc[ai][bj][m][1];
                    v4u w; w.x = cvt_pk_bf16(a0[0], a0[1]); w.y = cvt_pk_bf16(a0[2], a0[3]); w.z = cvt_pk_bf16(a1[0], a1[1]); w.w = cvt_pk_bf16(a1[2], a1[3]);
                    *(v4u*)(rowp + bj * HALF) = w; }
            }
    }
};

template <class Epi, class Sched>
__device__ __forceinline__ void gemm_phase_simple(const Sched& S, const Epi& E) {
    int tid = threadIdx.x; asm volatile("" : "+v"(tid));
    const int wid = __builtin_amdgcn_readfirstlane(tid >> 6), lane = tid & 63, wr = wid >> 2, wc = wid & 3, fr = lane & 15, fq = lane >> 4;
    const int K = S.K;
    Unit cur;
    for (int ui = 0; S.next(ui, cur); ++ui) {
        f32x4 acc[2][2][4][2];
#pragma unroll
        for (int a = 0; a < 2; ++a)
#pragma unroll
            for (int b = 0; b < 2; ++b)
#pragma unroll
                for (int m = 0; m < 4; ++m)
#pragma unroll
                    for (int n = 0; n < 2; ++n) acc[a][b][m][n] = (f32x4){0.f, 0.f, 0.f, 0.f};
        const char* at = S.a_tile(cur); const char* bt = S.b_tile(cur);
        const char* ap[2][4]; const char* bp[2][2];
#pragma unroll
        for (int ai = 0; ai < 2; ++ai)
#pragma unroll
            for (int m = 0; m < 4; ++m) ap[ai][m] = at + S.a_row_off(cur, ai * HALF + wr * 64 + m * 16 + fr) + fq * 16;
#pragma unroll
        for (int bj = 0; bj < 2; ++bj)
#pragma unroll
            for (int n = 0; n < 2; ++n) { const int rho = n * 16 + fr; bp[bj][n] = bt + (size_t)(bj * HALF + wc * 32 + (Epi::PERM ? perm32(rho) : rho)) * K * 2 + fq * 16; }
        for (int k0 = 0; k0 < K; k0 += 32) {
            bf16x8 a[2][4], b[2][2];
#pragma unroll
            for (int ai = 0; ai < 2; ++ai)
#pragma unroll
                for (int m = 0; m < 4; ++m) a[ai][m] = *(const bf16x8*)(ap[ai][m] + k0 * 2);
#pragma unroll
            for (int bj = 0; bj < 2; ++bj)
#pragma unroll
                for (int n = 0; n < 2; ++n) b[bj][n] = *(const bf16x8*)(bp[bj][n] + k0 * 2);
#pragma unroll
            for (int ai = 0; ai < 2; ++ai)
#pragma unroll
                for (int bj = 0; bj < 2; ++bj)
#pragma unroll
                    for (int m = 0; m < 4; ++m)
#pragma unroll
                        for (int n = 0; n < 2; ++n) acc[ai][bj][m][n] = __builtin_amdgcn_mfma_f32_16x16x32_bf16(b[bj][n], a[ai][m], acc[ai][bj][m][n], 0, 0, 0);
        }
        E(acc, cur, wr, wc, fr, fq);
    }
}

template <int OFF> __device__ __forceinline__ void glds16(const char* base, unsigned voff, unsigned lds_base) {
    asm volatile("s_add_u32 m0, %2, %3\n\ts_nop 0\n\tglobal_load_lds_dwordx4 %0, %1" :: "v"(voff), "s"(base), "s"(lds_base), "n"(OFF) : "memory", "m0", "scc");
}
template <class Epi, class Sched, int MODE = 0  >
__device__ __forceinline__ void gemm_phase(PG8_LAS unsigned char* lds, const Sched& S, const Epi& E) {
    constexpr bool GATHER = Sched::GATHER;
    int tid = threadIdx.x; asm volatile("" : "+v"(tid));
    const int wid = __builtin_amdgcn_readfirstlane(tid >> 6), lane = tid & 63, wr = wid >> 2, wc = wid & 3, fr = lane & 15, fq = lane >> 4;
    const int K = S.K, nt = K / BK;
    unsigned voffB[2], offA[4], nxA[4];
#pragma unroll
    for (int i = 0; i < 2; ++i) { int R, C; stage_rc(tid * 16 + i * 8192, R, C); const int Rb = Epi::PERM ? ((R & ~31) + perm32(R & 31)) : R;
        voffB[i] = (unsigned)(Rb * K + C) * 2u; offA[i] = (unsigned)(R * K + C) * 2u; offA[2 + i] = (unsigned)((R + HALF) * K + C) * 2u; nxA[i] = 0u; nxA[2 + i] = 0u; }
    const size_t kstep = (size_t)(BK * 2);
    const size_t hstep = (size_t)HALF * K * 2;
    const unsigned ldsw = (unsigned)wid * 1024u;
    const unsigned ldsbw = (unsigned)(size_t)lds + ldsw;
    const int aoff = lds_byte(wr * 64 + fr, fq * 8), boff = lds_byte(wc * 32 + fr, fq * 8);
#define PG8_SA(b, h) (((b) * 2 + (h)) * HTB)
#define PG8_SB(b, h) ((4 + (b) * 2 + (h)) * HTB)
#define PG8_STAGE_B(bufoff, gbase) do { glds16<(bufoff)>((const char*)(gbase), voffB[0], ldsbw); glds16<(bufoff) + 8192>((const char*)(gbase), voffB[1], ldsbw); } while (0)
#define PG8_STAGE_A(bufoff, gbase, h) do { glds16<(bufoff)>((const char*)(gbase), offA[(h) * 2], ldsbw); glds16<(bufoff) + 8192>((const char*)(gbase), offA[(h) * 2 + 1], ldsbw); } while (0)
#define PG8_LDA(dst, b, h) do { _Pragma("unroll") for (int m = 0; m < 4; ++m) _Pragma("unroll") for (int k = 0; k < 2; ++k) dst[m][k] = *(const PG8_LAS bf16x8*)(lds + PG8_SA(b, h) + aoff + m * 2048 + k * 1024); } while (0)
#define PG8_LDB(dst, b, h) do { _Pragma("unroll") for (int n = 0; n < 2; ++n) _Pragma("unroll") for (int k = 0; k < 2; ++k) dst[n][k] = *(const PG8_LAS bf16x8*)(lds + PG8_SB(b, h) + boff + n * 2048 + k * 1024); } while (0)
#define PG8_MMA(ai, bj, At, Bt) do { __builtin_amdgcn_s_setprio(1); if constexpr (MODE == 1) { _Pragma("unroll") for (int m = 0; m < 4; ++m) _Pragma("unroll") for (int n = 0; n < 2; ++n) { \
            const v8i _b = __builtin_shufflevector(__builtin_bit_cast(v4i, Bt[n][0]), __builtin_bit_cast(v4i, Bt[n][1]), 0, 1, 2, 3, 4, 5, 6, 7); \
            const v8i _a = __builtin_shufflevector(__builtin_bit_cast(v4i, At[m][0]), __builtin_bit_cast(v4i, At[m][1]), 0, 1, 2, 3, 4, 5, 6, 7); \
            acc[ai][bj][m][n] = __builtin_amdgcn_mfma_scale_f32_16x16x128_f8f6f4(_b, _a, acc[ai][bj][m][n], 0, 0, 0, 0x7A7A7A7A, 0, 0x7F7F7F7F); } } \
        else if constexpr (MODE == 2) { _Pragma("unroll") for (int m = 0; m < 4; ++m) _Pragma("unroll") for (int n = 0; n < 2; ++n) _Pragma("unroll") for (int k = 0; k < 2; ++k) \
        acc[ai][bj][m][n] = __builtin_bit_cast(f32x4, __builtin_amdgcn_mfma_i32_16x16x64_i8(__builtin_bit_cast(v4i, Bt[n][k]), __builtin_bit_cast(v4i, At[m][k]), __builtin_bit_cast(v4i, acc[ai][bj][m][n]), 0, 0, 0)); } \
        else { _Pragma("unroll") for (int m = 0; m < 4; ++m) _Pragma("unroll") for (int n = 0; n < 2; ++n) _Pragma("unroll") for (int k = 0; k < 2; ++k) \
        acc[ai][bj][m][n] = __builtin_amdgcn_mfma_f32_16x16x32_bf16(Bt[n][k], At[m][k], acc[ai][bj][m][n], 0, 0, 0); } __builtin_amdgcn_s_setprio(0); } while (0)
#define PG8_WAIT_V(n) asm volatile("s_waitcnt vmcnt(" #n ")" ::: "memory")
#define PG8_WAIT_L(n) asm volatile("s_waitcnt lgkmcnt(" #n ")" ::: "memory")
#define PG8_BAR __builtin_amdgcn_s_barrier()
#define PG8_SCHED __builtin_amdgcn_sched_barrier(0)
#define PG8_OFFS(dst, u) do { if constexpr (GATHER) { _Pragma("unroll") for (int _h = 0; _h < 2; ++_h) _Pragma("unroll") for (int _i = 0; _i < 2; ++_i) { \
        int _R, _C; stage_rc(tid * 16 + _i * 8192, _R, _C); dst[_h * 2 + _i] = S.a_row_off(u, _h * HALF + _R) + (unsigned)(_C * 2); } } } while (0)
    Unit cur, nxt; int ui = 0;
    if (!S.next(0, cur)) return;
    f32x4 acc[2][2][4][2];
#pragma unroll
    for (int a = 0; a < 2; ++a)
#pragma unroll
        for (int b = 0; b < 2; ++b)
#pragma unroll
            for (int m = 0; m < 4; ++m)
#pragma unroll
                for (int n = 0; n < 2; ++n) acc[a][b][m][n] = (f32x4){0.f, 0.f, 0.f, 0.f};
    bf16x8 At[4][2], B0[2][2], B1[2][2];
    const char* cA = S.a_tile(cur); const char* cB = S.b_tile(cur);
    PG8_OFFS(offA, cur);
    PG8_STAGE_B(PG8_SB(0, 0), cB); PG8_STAGE_B(PG8_SB(0, 1), cB + hstep); PG8_STAGE_A(PG8_SA(0, 0), cA, 0); PG8_STAGE_A(PG8_SA(0, 1), cA, 1);
    if (wr == 1) PG8_BAR;
    PG8_WAIT_V(2); PG8_BAR;
    PG8_STAGE_B(PG8_SB(1, 0), cB + kstep); PG8_STAGE_A(PG8_SA(1, 0), cA + kstep, 0); PG8_STAGE_B(PG8_SB(1, 1), cB + hstep + kstep);
    PG8_WAIT_V(6); PG8_BAR;
    for (;;) {
        const bool has_next = S.next(ui + 1, nxt);
        const char* nA = has_next ? S.a_tile(nxt) : cA; const char* nB = has_next ? S.b_tile(nxt) : cB;
        if constexpr (GATHER) { if (has_next) { PG8_OFFS(nxA, nxt); } }
#pragma unroll 1
        for (int t = 0; t < nt; t += 2) {
            const bool last = (t == nt - 2);
            const char* a1 = cA + (size_t)(t + 1) * kstep;
            const char* a2 = last ? nA : cA + (size_t)(t + 2) * kstep; const char* b2 = last ? nB : cB + (size_t)(t + 2) * kstep;
            const char* a3 = a2 + kstep; const char* b3 = b2 + kstep;
            PG8_LDB(B0, 0, 0); PG8_LDB(B1, 0, 1); PG8_SCHED; PG8_LDA(At, 0, 0); PG8_STAGE_A(PG8_SA(1, 1), a1, 1);
            if constexpr (GATHER) { if (last && has_next) {
#pragma unroll
                for (int q = 0; q < 4; ++q) offA[q] = nxA[q]; } }
            PG8_WAIT_V(8); PG8_WAIT_L(0); PG8_BAR; if (!(Sched::HAS_RH && cur.rh == 1)) { PG8_MMA(0, 0, At, B0); if (!(Sched::HAS_HALF && S.is_half(cur))) PG8_MMA(0, 1, At, B1); } PG8_BAR; PG8_SCHED;
            PG8_LDA(At, 0, 1); PG8_STAGE_B(PG8_SB(0, 0), b2); PG8_STAGE_B(PG8_SB(0, 1), b2 + hstep); PG8_STAGE_A(PG8_SA(0, 0), a2, 0);
            PG8_WAIT_V(8); PG8_WAIT_L(0); PG8_BAR; if (!(Sched::HAS_RH && cur.rh == 0)) { PG8_MMA(1, 0, At, B0); if (!(Sched::HAS_HALF && S.is_half(cur))) PG8_MMA(1, 1, At, B1); } PG8_BAR; PG8_SCHED;
            PG8_LDB(B0, 1, 0); PG8_LDB(B1, 1, 1); PG8_SCHED; PG8_LDA(At, 1, 0); PG8_STAGE_A(PG8_SA(0, 1), a2, 1);
            PG8_WAIT_V(8); PG8_WAIT_L(0); PG8_BAR; if (!(Sched::HAS_RH && cur.rh == 1)) { PG8_MMA(0, 0, At, B0); if (!(Sched::HAS_HALF && S.is_half(cur))) PG8_MMA(0, 1, At, B1); } PG8_BAR; PG8_SCHED;
            PG8_LDA(At, 1, 1); PG8_STAGE_B(PG8_SB(1, 0), b3); PG8_STAGE_B(PG8_SB(1, 1), b3 + hstep); PG8_STAGE_A(PG8_SA(1, 0), a3, 0);
            PG8_WAIT_V(8); PG8_WAIT_L(0); PG8_BAR; if (!(Sched::HAS_RH && cur.rh == 0)) { PG8_MMA(1, 0, At, B0); if (!(Sched::HAS_HALF && S.is_half(cur))) PG8_MMA(1, 1, At, B1); } PG8_BAR; PG8_SCHED;
        }
        if (wr == 0) PG8_BAR;
        E(acc, cur, wr, wc, fr, fq);
        if (!has_next) break;
#pragma unroll
        for (int a = 0; a < 2; ++a)
#pragma unroll
            for (int b = 0; b < 2; ++b)
#pragma unroll
                for (int m = 0; m < 4; ++m)
#pragma unroll
                    for (int n = 0; n < 2; ++n) acc[a][b][m][n] = (f32x4){0.f, 0.f, 0.f, 0.f};
        cur = nxt; cA = nA; cB = nB; ++ui;
        if (wr == 1) PG8_BAR;
    }
    PG8_WAIT_V(0);
    PG8_BAR;
#undef PG8_SA
#undef PG8_SB
#undef PG8_STAGE_A
#undef PG8_STAGE_B
#undef PG8_LDA
#undef PG8_LDB
#undef PG8_MMA
#undef PG8_WAIT_V
#undef PG8_WAIT_L
#undef PG8_BAR
#undef PG8_SCHED
#undef PG8_OFFS
}
}

#define XB_TMO      128
#define XB_XCNT(j)  (256  + 64 * (j))
#define XB_XSUB(j)  (1280 + 64 * (j))
#define XB_XGEN(j)  (2304 + 64 * (j))
#define XB_TOP      3328
#define XB_TOPGEN   3392
#define XCD_BAR_WORDS 3456
#define XB_SPIN_CAP (1u << 18)
__device__ __forceinline__ unsigned xb_ld(unsigned* p)              { return __hip_atomic_load(p, __ATOMIC_RELAXED, __HIP_MEMORY_SCOPE_AGENT); }
__device__ __forceinline__ unsigned xb_add(unsigned* p, unsigned v) { return __hip_atomic_fetch_add(p, v, __ATOMIC_RELAXED, __HIP_MEMORY_SCOPE_AGENT); }
__device__ __forceinline__ unsigned xb_xcc_id() { return (unsigned)__builtin_amdgcn_s_getreg((3 << 11) | 20) & 0xFu; }
#define XB_SPIN(cond, bar) do { unsigned _sp = 0; while (cond) { __builtin_amdgcn_s_sleep(1); \
    if ((++_sp & 255u) == 0u) { if (xb_ld(&(bar)[XB_TMO])) break; if (_sp > XB_SPIN_CAP) { atomicAdd(&(bar)[XB_TMO], 1u); break; } } } } while (0)
struct XcdBarrier { unsigned* bar; unsigned x; volatile LAS unsigned* st; };
__device__ __forceinline__ XcdBarrier xcd_barrier_post(unsigned* bar, volatile LAS unsigned* st) {
    XcdBarrier b; b.bar = bar; b.x = xb_xcc_id(); b.st = st;
    if (threadIdx.x == 0) (void)xb_add(&bar[XB_XCNT(b.x)], 1u);
    return b;
}
__device__ __forceinline__ void xcd_barrier_complete(unsigned* bar, unsigned x, unsigned& nloc, unsigned& nx) {
    const unsigned G = gridDim.x * gridDim.y * gridDim.z;
    unsigned sum, cnt, mine, sp = 0u;
    for (;;) {
        sum = 0u; cnt = 0u; mine = 0u;
#pragma unroll
        for (unsigned j = 0; j < 16; ++j) { const unsigned c = xb_ld(&bar[XB_XCNT(j)]); sum += c; cnt += (c > 0u) ? 1u : 0u; mine = (j == x) ? c : mine; }
        if (sum == G) break;
        __builtin_amdgcn_s_sleep(1);
        if ((++sp & 255u) == 0u) { if (xb_ld(&bar[XB_TMO])) break; if (sp > XB_SPIN_CAP) { atomicAdd(&bar[XB_TMO], 1u); break; } }
    }
    nloc = mine > 0u ? mine : 1u; nx = cnt > 0u ? cnt : 1u;
}
__device__ __forceinline__ void xcd_barrier(const XcdBarrier& b) {
    asm volatile("s_waitcnt vmcnt(0)" ::: "memory");
    __syncthreads();
    if (threadIdx.x == 0) {
        unsigned* bar = b.bar;
        __builtin_amdgcn_s_waitcnt(0);
        unsigned nloc = b.st[0], nx = b.st[1];
        if (nloc == 0u) { xcd_barrier_complete(bar, b.x, nloc, nx); b.st[0] = nloc; b.st[1] = nx; }
        const unsigned old = xb_add(&bar[XB_XSUB(b.x)], 1u);
        const unsigned gen = old / nloc;
        if (old + 1u == (gen + 1u) * nloc) {
            __builtin_amdgcn_fence(__ATOMIC_RELEASE, "agent");
            asm volatile("s_waitcnt vmcnt(0)" ::: "memory");
            const unsigned og = xb_add(&bar[XB_TOP], 1u);
            const unsigned tg = og / nx;
            if (og + 1u == (tg + 1u) * nx) xb_add(&bar[XB_TOPGEN], 1u);
            else XB_SPIN(xb_ld(&bar[XB_TOPGEN]) == tg, bar);
            __builtin_amdgcn_fence(__ATOMIC_ACQUIRE, "agent");
            xb_add(&bar[XB_XGEN(b.x)], 1u);
            asm volatile("s_waitcnt vmcnt(0)" ::: "memory");
        } else {
            XB_SPIN(xb_ld(&bar[XB_XGEN(b.x)]) == gen, bar);
            __builtin_amdgcn_fence(__ATOMIC_ACQUIRE, "agent");
            asm volatile("s_waitcnt vmcnt(0)" ::: "memory");
        }
    }
    __syncthreads();
}

constexpr int NWAVES = 8;
struct Args { const float* in[21]; float* out; unsigned char* ws; int ph_lo, ph_hi; };
struct Frame {
    LAS unsigned char* lds;
    unsigned* ctl;
    int tid, lane, wave, vcu, G;
    unsigned char* ws;
};
enum { I_X = 0, I_LNIG, I_LNIB, I_RW, I_RB, I_WIN, I_CAW, I_CBW, I_CBB, I_LCG, I_LCB, I_PW, I_PS, I_WOUT, I_LMG, I_LMB, I_WG, I_WU, I_WDN, I_LFG, I_LFB };

__device__ __forceinline__ void tr_item(const float* src, int srcN, int srccol0, bf16* dst, int dstK, int dstrow0, int k0, LAS float* scr, int lane) {
#pragma unroll 8
    for (int i = 0; i < 32; ++i) { const int kk = 2 * i + (lane >> 5); scr[kk * 33 + (lane & 31)] = src[(size_t)(k0 + kk) * srcN + srccol0 + (lane & 31)]; }
    LDS_WAIT(); asm volatile("" ::: "memory");
    const int c = lane & 7;
#pragma unroll
    for (int j = 0; j < 4; ++j) { const int n = (lane >> 3) + 8 * j; const LAS float* s = scr + (8 * c) * 33 + n;
        v4u o; o.x = pk2(s[0 * 33], s[1 * 33]); o.y = pk2(s[2 * 33], s[3 * 33]); o.z = pk2(s[4 * 33], s[5 * 33]); o.w = pk2(s[6 * 33], s[7 * 33]);
        *(GAS v4u*)(dst + (size_t)(dstrow0 + n) * dstK + k0 + 8 * c) = o; }
    LDS_WAIT(); asm volatile("" ::: "memory");
}
__device__ __forceinline__ void tr_item64(const float* src, int srcN, int srccol0, bf16* dst, int dstK, int dstrow0, int k0, LAS unsigned* scr, int lane) {
    const int kr = lane >> 4, c4 = lane & 15;
    const float* sp = src + (size_t)(k0 + 2 * kr) * srcN + srccol0 + 4 * c4;
    f32x4 A[8], B[8];
#pragma unroll
    for (int i = 0; i < 8; ++i) { A[i] = *(const GAS f32x4*)(sp + (size_t)(8 * i) * srcN); B[i] = *(const GAS f32x4*)(sp + (size_t)(8 * i + 1) * srcN); }
#pragma unroll
    for (int i = 0; i < 8; ++i) { LAS unsigned* w = scr + (4 * i + kr) * 65 + 4 * c4;
        w[0] = pk2(A[i].x, B[i].x); w[1] = pk2(A[i].y, B[i].y); w[2] = pk2(A[i].z, B[i].z); w[3] = pk2(A[i].w, B[i].w); }
    LDS_WAIT(); asm volatile("" ::: "memory");
    const int q = lane & 7, nn = lane >> 3;
#pragma unroll
    for (int j = 0; j < 8; ++j) { const int n = nn + 8 * j; const LAS unsigned* r = scr + (4 * q) * 65 + n;
        v4u o; o.x = r[0]; o.y = r[65]; o.z = r[130]; o.w = r[195];
        *(GAS v4u*)(dst + (size_t)(dstrow0 + n) * dstK + k0 + 8 * q) = o; }
    LDS_WAIT(); asm volatile("" ::: "memory");
}
template <int NS, bool I8 = false>
__device__ __forceinline__ void tr_item64_f8(const float* src, int srcN, int srccol0, unsigned char* dst, int dstKB, int dstrow0, int k0, float scale, LAS unsigned* scr, int lane, bool nostore = false, f32x4 cinv = (f32x4){1.f, 1.f, 1.f, 1.f}) {
    const int kr = lane >> 4, c4 = lane & 15;
    const float* sp = src + (size_t)(k0 + 4 * kr) * srcN + srccol0 + 4 * c4;
    f32x4 A[NS][4][4];
#pragma unroll
    for (int s = 0; s < NS; ++s)
#pragma unroll
        for (int i = 0; i < 4; ++i)
#pragma unroll
            for (int t = 0; t < 4; ++t) A[s][i][t] = __builtin_nontemporal_load((const GAS f32x4*)(sp + (size_t)(64 * s + 16 * i + t) * srcN));
#pragma unroll
    for (int s = 0; s < NS; ++s)
#pragma unroll
        for (int i = 0; i < 4; ++i) { LAS unsigned* w = scr + (16 * s + 4 * i + kr) * 65 + 4 * c4;
            if constexpr (I8) {
            w[0] = pk4_i8(A[s][i][0].x * cinv.x, A[s][i][1].x * cinv.x, A[s][i][2].x * cinv.x, A[s][i][3].x * cinv.x); w[1] = pk4_i8(A[s][i][0].y * cinv.y, A[s][i][1].y * cinv.y, A[s][i][2].y * cinv.y, A[s][i][3].y * cinv.y);
            w[2] = pk4_i8(A[s][i][0].z * cinv.z, A[s][i][1].z * cinv.z, A[s][i][2].z * cinv.z, A[s][i][3].z * cinv.z); w[3] = pk4_i8(A[s][i][0].w * cinv.w, A[s][i][1].w * cinv.w, A[s][i][2].w * cinv.w, A[s][i][3].w * cinv.w); } else {
            w[0] = pk4_fp8(A[s][i][0].x * scale, A[s][i][1].x * scale, A[s][i][2].x * scale, A[s][i][3].x * scale); w[1] = pk4_fp8(A[s][i][0].y * scale, A[s][i][1].y * scale, A[s][i][2].y * scale, A[s][i][3].y * scale);
            w[2] = pk4_fp8(A[s][i][0].z * scale, A[s][i][1].z * scale, A[s][i][2].z * scale, A[s][i][3].z * scale); w[3] = pk4_fp8(A[s][i][0].w * scale, A[s][i][1].w * scale, A[s][i][2].w * scale, A[s][i][3].w * scale); } }
    LDS_WAIT(); asm volatile("" ::: "memory");
    constexpr int QN = 4 * NS, RN = 64 / QN;
    const int q = lane % QN, nn = lane / QN;
#pragma unroll
    for (int j = 0; j < 64 / RN; ++j) { const int n = nn + RN * j; const LAS unsigned* r = scr + (4 * q) * 65 + n;
        v4u o; o.x = r[0]; o.y = r[65]; o.z = r[130]; o.w = r[195];
        if (nostore) asm volatile("" :: "v"(o)); else *(GAS v4u*)(dst + (size_t)(dstrow0 + n) * dstKB + k0 + 16 * q) = o; }
    LDS_WAIT(); asm volatile("" ::: "memory");
}
__device__ __forceinline__ int win_src(int c0) {
    const int pn = c0 >> 8, j = c0 & 255, half = j >> 7, jj = j & 127;
    if (pn < 3) { const int ch = pn * 128 + jj; return half == 0 ? 384 + ch : 768 + ch; }
    if (pn < 6) { const int ch = (pn - 3) * 128 + jj; return half == 0 ? 1152 + ch : 1536 + ch; }
    if (pn < 8) { const int q = (pn - 6) * 256 + j; return q < 384 ? q : 1920 + (q - 384); }
    return j < 128 ? 1920 + 128 + j : -1;
}
__device__ __forceinline__ void p0_prologue(Frame& F, const Args& A) {
    LAS float* scr = (LAS float*)(F.lds + F.wave * 8448);
    LAS unsigned* scu = (LAS unsigned*)scr;
    const int gw = F.vcu * NWAVES + F.wave, NGW = F.G * NWAVES, lane = F.lane;
    bf16* WIN = (bf16*)(F.ws + WS_WIN); bf16* WOUT = (bf16*)(F.ws + WS_WOUT); unsigned char* WGU = F.ws + WS_WGU; unsigned char* WD = F.ws + WS_WD; bf16* WRT = (bf16*)(F.ws + WS_WRT);
    constexpr int I_M = GEMM1_I8 ? NL * 36 * 8 : 0, I_A = GEMM1_I8 ? NL * 36 * 8 : NL * 16 * 36, I_B = NL * 12 * 16, I_C = NL * NE * 128, I_D = NL * NE * 64, I_E = 16, I_F = NL * 4 * 16 * 2;
    constexpr int NITEMS = I_M + I_A + I_B + I_C + I_D + I_E + I_F;
    const int lane0 = lane;
#pragma unroll 1
    for (int prep = 0; prep < ((PROBE_P0 == 1 || PROBE_P0 == 3) ? 2 : 1); ++prep)
    for (int it = gw; it < NITEMS; it += NGW) {
        int lane = lane0; asm volatile("" : "+v"(lane));
        int r = it;
        if (r < I_M) {
            const int l = r / 288, q = r % 288, cb = q >> 3, kq = q & 7, c0 = cb * 64, sc = win_src(c0), kr = lane >> 4, c4 = lane & 15;
            if (sc >= 0) { const float* sp = A.in[I_WIN] + (size_t)l * 1024 * DIN + (size_t)(kq * 128 + kr) * DIN + sc + 4 * c4;
                f32x4 vv[32];
#pragma unroll
                for (int i = 0; i < 32; ++i) vv[i] = *(const GAS f32x4*)(sp + (size_t)(4 * i) * DIN);
                f32x4 mx = (f32x4){0.f, 0.f, 0.f, 0.f};
#pragma unroll
                for (int i = 0; i < 32; ++i) { mx.x = fmaxf(mx.x, fabsf(vv[i].x)); mx.y = fmaxf(mx.y, fabsf(vv[i].y)); mx.z = fmaxf(mx.z, fabsf(vv[i].z)); mx.w = fmaxf(mx.w, fabsf(vv[i].w)); }
#pragma unroll
                for (int o = 16; o <= 32; o <<= 1) { mx.x = fmaxf(mx.x, __shfl_xor(mx.x, o)); mx.y = fmaxf(mx.y, __shfl_xor(mx.y, o)); mx.z = fmaxf(mx.z, __shfl_xor(mx.z, o)); mx.w = fmaxf(mx.w, __shfl_xor(mx.w, o)); }
                if (kr == 0) { unsigned* cm = F.ctl + CW_CMAX + l * N1 + c0 + 4 * c4;
                    __hip_atomic_fetch_max(cm + 0, __float_as_uint(mx.x), RLX_AGENT); __hip_atomic_fetch_max(cm + 1, __float_as_uint(mx.y), RLX_AGENT);
                    __hip_atomic_fetch_max(cm + 2, __float_as_uint(mx.z), RLX_AGENT); __hip_atomic_fetch_max(cm + 3, __float_as_uint(mx.w), RLX_AGENT); } }
            VM_WAIT();
            if (lane == 0) __hip_atomic_fetch_add(F.ctl + CW_CMAXCNT, 1u, RLX_AGENT);
            continue; }
        r -= I_M;
        if (r < I_C) {
            const int le = r >> 7, q = r & 127, kb = q >> 4, nb = q & 15, n0 = nb * 64, pn = n0 >> 8, half = (n0 & 255) >> 7, jj0 = n0 & 127;
            const float* src = (half ? A.in[I_WU] : A.in[I_WG]) + (size_t)le * 1024 * 512;
            tr_item64_f8<2>(src, 512, pn * 128 + jj0, WGU + (size_t)le * 1024 * 1024, 1024, n0, kb * 128, 32.0f, scu, lane, PROBE_P0 == 3 && prep == 1); continue; }
        r -= I_C;
        if (r < I_D) {
            const int le = r >> 6, q = r & 63, kb = q >> 4, nb = q & 15;
            tr_item64_f8<2>(A.in[I_WDN] + (size_t)le * 512 * 1024, 1024, nb * 64, WD + (size_t)le * 1024 * 512, 512, nb * 64, kb * 128, 32.0f, scu, lane, PROBE_P0 == 3 && prep == 1); continue; }
        r -= I_D;
        if (r < I_A) {
            if (GEMM1_I8) {
                const int l = r / 288, q = r % 288, cb = q >> 3, kb = q & 7, c0 = cb * 64, sc = win_src(c0), c4 = lane & 15;
                unsigned char* dst = F.ws + WS_WIN + (size_t)l * N1 * 1024;
                { unsigned spins = 0;
                  while (__hip_atomic_load(F.ctl + CW_CMAXCNT, RLX_AGENT) < (unsigned)I_M * ((PROBE_P0 == 1 || PROBE_P0 == 3) ? (unsigned)(prep + 1) : 1u)) { __builtin_amdgcn_s_sleep(8); if (++spins > (1u << 22)) break; } }
                if (sc >= 0) { const unsigned* cm = F.ctl + CW_CMAX + l * N1 + c0 + 4 * c4;
                    f32x4 mx; mx.x = __uint_as_float(__hip_atomic_load(cm + 0, RLX_AGENT)); mx.y = __uint_as_float(__hip_atomic_load(cm + 1, RLX_AGENT)); mx.z = __uint_as_float(__hip_atomic_load(cm + 2, RLX_AGENT)); mx.w = __uint_as_float(__hip_atomic_load(cm + 3, RLX_AGENT));
                    f32x4 cinv; cinv.x = mx.x > 0.f ? 127.f / mx.x : 0.f; cinv.y = mx.y > 0.f ? 127.f / mx.y : 0.f; cinv.z = mx.z > 0.f ? 127.f / mx.z : 0.f; cinv.w = mx.w > 0.f ? 127.f / mx.w : 0.f;
                    tr_item64_f8<2, true>(A.in[I_WIN] + (size_t)l * 1024 * DIN, DIN, sc, dst, 1024, c0, kb * 128, 1.f, scu, lane, false, cinv);
                } else { for (int qq = lane; qq < 64 * 8; qq += 64) *(GAS v4u*)(dst + (size_t)(c0 + (qq >> 3)) * 1024 + kb * 128 + (qq & 7) * 16) = (v4u){0u, 0u, 0u, 0u}; }
                continue; }
            const int l = r / 576, q = r % 576, kb = q / 36, nb = q % 36, c0 = nb * 64, sc = win_src(c0);
            bf16* dst = WIN + (size_t)l * N1 * 1024;
            if (sc >= 0) tr_item64(A.in[I_WIN] + (size_t)l * 1024 * DIN, DIN, sc, dst, 1024, c0, kb * 64, scu, lane);
            else { const int c = lane & 7;
#pragma unroll
                for (int j = 0; j < 8; ++j) { const int n = (lane >> 3) + 8 * j; *(GAS v4u*)(dst + (size_t)(c0 + n) * 1024 + kb * 64 + 8 * c) = (v4u){0u, 0u, 0u, 0u}; } }
            continue; }
        r -= I_A;
        if (r < I_B) {
            const int l = r / 192, q = r % 192, kb = q >> 4, nb = q & 15;
            if (GEMM2_FP8) tr_item64_f8<1>(A.in[I_WOUT] + (size_t)l * 1024 * 1024, 1024, nb * 64, (unsigned char*)WOUT + (size_t)l * 1024 * 1024, 1024, nb * 64, kb * 64, 32.0f, scu, lane);
            else tr_item64(A.in[I_WOUT] + (size_t)l * 1024 * 1024, 1024, nb * 64, WOUT + (size_t)l * 1024 * 1024, 1024, nb * 64, kb * 64, scu, lane);
            continue; }
        r -= I_B;
        if (r < I_E) { tr_item(A.in[I_RW], 32, 0, WRT, 1024, 0, r * 64, scr, lane); continue; }
        r -= I_E;
        {
            const int l = r >> 7, g = (r >> 5) & 3, nb = (r >> 1) & 15, cb = r & 1, n = nb * 64 + lane;
            const float* wo = A.in[I_WOUT] + (size_t)l * 1024 * 1024 + (size_t)(768 + g * 64) * 1024 + n;
            const float* ps = A.in[I_PS] + l * 256 + g * 64;
            const float* pw = A.in[I_PW] + (size_t)(l * 4 + g) * 64 * 64 + cb * 32 * 64;
#pragma unroll
            for (int i = 0; i < 8; ++i) *(LAS f32x4*)(scr + (i * 64 + lane) * 4) = *(const GAS f32x4*)(pw + (i * 64 + lane) * 4);
            float wv[64];
#pragma unroll
            for (int d = 0; d < 64; ++d) wv[d] = wo[(size_t)d * 1024] * ps[d];
            LDS_WAIT(); asm volatile("" ::: "memory");
            bf16* dst = WOUT + (size_t)l * 1024 * 1024 + (size_t)n * 1024 + 768 + g * 64 + cb * 32;
#pragma unroll 1
            for (int c2 = 0; c2 < 16; ++c2) { float o[2];
#pragma unroll
                for (int cc = 0; cc < 2; ++cc) { const LAS f32x4* pr = (const LAS f32x4*)(scr + (c2 * 2 + cc) * 64); float a = 0.f;
#pragma unroll
                    for (int d4 = 0; d4 < 16; ++d4) { const f32x4 p = pr[d4]; a += p.x * wv[4 * d4] + p.y * wv[4 * d4 + 1] + p.z * wv[4 * d4 + 2] + p.w * wv[4 * d4 + 3]; }
                    o[cc] = a; }
                if (GEMM2_FP8) *(GAS unsigned short*)((unsigned char*)WOUT + (size_t)l * 1024 * 1024 + (size_t)n * 1024 + 768 + g * 64 + cb * 32 + c2 * 2) = (unsigned short)pk4_fp8(o[0] * 32.0f, o[1] * 32.0f, 0.f, 0.f);
                else *(GAS unsigned*)(dst + c2 * 2) = pk2(o[0], o[1]); }
            LDS_WAIT(); asm volatile("" ::: "memory");
        }
    }
    bf16* HB = (bf16*)(F.ws + WS_HB);
    const float* g = A.in[I_LNIG]; const float* b = A.in[I_LNIB];
    f32x4 gv[4], bv[4];
#pragma unroll
    for (int j = 0; j < 4; ++j) { gv[j] = *(const f32x4*)(g + 4 * lane + 256 * j); bv[j] = *(const f32x4*)(b + 4 * lane + 256 * j); }
#pragma unroll 1
    for (int prep2 = 0; prep2 < ((PROBE_P0 == 2) ? 2 : 1); ++prep2)
    for (int m0 = gw * 2; m0 < T_; m0 += NGW * 2) {
        f32x4 v[2][4];
#pragma unroll
        for (int u = 0; u < 2; ++u) { const GAS f32x4* xr = (const GAS f32x4*)(A.in[I_X] + (size_t)(m0 + u) * D_) + lane;
#pragma unroll
            for (int j = 0; j < 4; ++j) v[u][j] = __builtin_nontemporal_load(xr + 64 * j); }
#pragma unroll
        for (int u = 0; u < 2; ++u) { float s = 0.f;
#pragma unroll
            for (int j = 0; j < 4; ++j) s += (v[u][j].x + v[u][j].y) + (v[u][j].z + v[u][j].w);
            const float mean = wave_sum(s) * (1.f / D_); float s2 = 0.f;
#pragma unroll
            for (int j = 0; j < 4; ++j) { v[u][j] = v[u][j] - mean; s2 += (v[u][j].x * v[u][j].x + v[u][j].y * v[u][j].y) + (v[u][j].z * v[u][j].z + v[u][j].w * v[u][j].w); }
            const float rstd = __builtin_amdgcn_rsqf(wave_sum(s2) * (1.f / D_) + LN_EPS);
            GAS v2u* o8 = (GAS v2u*)(HB + (size_t)(m0 + u) * D_) + lane;
            float amax = 0.f;
#pragma unroll
            for (int j = 0; j < 4; ++j) { const f32x4 o = v[u][j] * rstd * gv[j] + bv[j]; v[u][j] = o; v2u w; w.x = pk2(o.x, o.y); w.y = pk2(o.z, o.w); o8[64 * j] = w;
                amax = fmaxf(amax, fmaxf(fmaxf(fabsf(o.x), fabsf(o.y)), fmaxf(fabsf(o.z), fabsf(o.w)))); }
            if (GEMM1_I8) {
                amax = wave_max(amax); const float inv = amax > 0.f ? 127.f / amax : 0.f;
                GAS unsigned* q4 = (GAS unsigned*)(F.ws + WS_HQ + (size_t)(m0 + u) * D_) + lane;
#pragma unroll
                for (int j = 0; j < 4; ++j) q4[64 * j] = pk4_i8(v[u][j].x * inv, v[u][j].y * inv, v[u][j].z * inv, v[u][j].w * inv);
                if (lane == 0) ((float*)(F.ws + WS_HS))[m0 + u] = amax * (1.f / 127.f); } }
    }
}

__device__ __forceinline__ void p2_mixer(Frame& F, const Args& A, int l) {
    LAS unsigned* BV = (LAS unsigned*)F.lds;
    LAS unsigned* PB = (LAS unsigned*)(F.lds + 47616);
    LAS float* V = (LAS float*)(F.lds + 71680);
    LAS float* LGB = (LAS float*)(F.lds + 120832);
    LAS float* WA = (LAS float*)(F.lds + 123904);
    const bf16* Z = (const bf16*)(F.ws + WS_Z); bf16* Y = (bf16*)(F.ws + WS_Y);
    const float* wB = A.in[I_CBW] + l * 31 * 384; const float* bB = A.in[I_CBB] + l * 384;
    const float* lg = A.in[I_LCG] + l * 384; const float* lb = A.in[I_LCB] + l * 384; const float* wA = A.in[I_CAW] + l * 3 * 384;
    int tid = F.tid; asm volatile("" : "+v"(tid));
    const int lane = tid & 63, wave = F.wave;
    const bool convt = tid < 384; const int cp = tid % 192, tg = tid / 192;
    f32x2 w[31]; f32x2 bias = (f32x2){0.f, 0.f};
#pragma unroll
    for (int j = 0; j < 31; ++j) w[j] = (f32x2){0.f, 0.f};
    if (convt) {
#pragma unroll
        for (int j = 0; j < 31; ++j) w[j] = *(const f32x2*)(wB + j * 384 + 2 * cp);
        bias = *(const f32x2*)(bB + 2 * cp); }
    for (int q = tid; q < 384; q += 512) { LGB[q] = lg[q]; LGB[384 + q] = lb[q]; }
    for (int q = tid; q < 3 * 384; q += 512) WA[q] = wA[q];
    v4u pre[9];
#define MIX_PREFETCH(ci_, tid_) do { const int _t0 = (ci_) * 32, _s0 = _t0 & (SEQ_ - 1); \
        _Pragma("unroll") for (int _i = 0; _i < 6; ++_i) { const int _q = (tid_) + 512 * _i; const int _qq = _q < 62 * 48 ? _q : 0; const int _r = _qq / 48, _c = _qq % 48; \
            const int _rr = (_s0 - 30 + _r >= 0) ? _r : 30; pre[_i] = __builtin_nontemporal_load((const GAS v4u*)(Z + (size_t)(_t0 - 30 + _rr) * NZ + 768 + _c * 8)); } \
        _Pragma("unroll") for (int _i = 0; _i < 3; ++_i) { const int _q = (tid_) + 512 * _i; const int _qq = _q < 47 * 32 ? _q : 0; const int _r = _qq >> 5, _c = _qq & 31; \
            const int _rr = (_s0 - 15 + _r >= 0) ? _r : 15; pre[6 + _i] = __builtin_nontemporal_load((const GAS v4u*)(Z + (size_t)(_t0 - 15 + _rr) * NZ + 1152 + _c * 8)); } } while (0)
    if (F.vcu < T_ / 32) MIX_PREFETCH(F.vcu, tid);
    for (int ci = F.vcu; ci < T_ / 32; ci += F.G) {
        const int t0 = ci * 32, s0 = t0 & (SEQ_ - 1);
#pragma unroll
        for (int i = 0; i < 6; ++i) { const int q = tid + 512 * i; if (q < 62 * 48) { const int r = q / 48, c = q % 48;
            *(LAS v4u*)(BV + r * 192 + c * 4) = (s0 - 30 + r >= 0) ? pre[i] : (v4u){0u, 0u, 0u, 0u}; } }
#pragma unroll
        for (int i = 0; i < 3; ++i) { const int q = tid + 512 * i; if (q < 47 * 32) { const int r = q >> 5, c = q & 31;
            *(LAS v4u*)(PB + r * 128 + c * 4) = (s0 - 15 + r >= 0) ? pre[6 + i] : (v4u){0u, 0u, 0u, 0u}; } }
        __syncthreads();
        { int cn = ci + F.G; asm volatile("" : "+s"(cn)); int tidp = tid; asm volatile("" : "+v"(tidp));
          if (cn < T_ / 32) MIX_PREFETCH(cn, tidp); }
        if (PROBE_MIX == 3) { int cn = ci + F.G; asm volatile("" : "+s"(cn)); int tidp = tid; asm volatile("" : "+v"(tidp));
          if (cn < T_ / 32) { v4u sink[9]; const int _t0 = cn * 32;
#pragma unroll
              for (int i = 0; i < 6; ++i) { const int q = tidp + 512 * i, qq = q < 62 * 48 ? q : 0, r = qq / 48, c = qq % 48; sink[i] = *(const GAS v4u*)(Z + (size_t)(_t0 + r) * NZ + 768 + c * 8 + 8); }
#pragma unroll
              for (int i = 0; i < 3; ++i) { const int q = tidp + 512 * i, qq = q < 47 * 32 ? q : 0, r = qq >> 5, c = qq & 31; sink[6 + i] = *(const GAS v4u*)(Z + (size_t)(_t0 + r) * NZ + 1152 + c * 8); }
#pragma unroll
              for (int i = 0; i < 9; ++i) asm volatile("" :: "v"(sink[i])); } }
#pragma unroll 1
        for (int prep = 0; prep < ((PROBE_MIX == 1) ? 2 : 1); ++prep)
        if (convt) {
#pragma unroll 1
            for (int hh = 0; hh < 2; ++hh) { const int tb = tg * 16 + hh * 8;
                f32x2 x[38];
#pragma unroll
                for (int i = 0; i < 38; ++i) { const unsigned u = BV[(tb + i) * 192 + cp]; x[i] = (f32x2){bflo(u), bfhi(u)}; }
#pragma unroll
                for (int tt = 0; tt < 8; ++tt) { f32x2 a = bias;
#pragma unroll
                    for (int j = 0; j < 31; ++j) a += w[j] * x[tt + j];
                    *(LAS f32x2*)(V + (tb + tt) * 384 + 2 * cp) = a; }
            }
        } else {
            const int p = tid - 384, g = p >> 5, wd = 2 << g;
            f32x2 s = (f32x2){0.f, 0.f};
            for (int i = 1; i < wd; ++i) { const unsigned u = PB[(15 - i) * 128 + p]; s += (f32x2){bflo(u), bfhi(u)}; }
#pragma unroll 1
            for (int blk = 0; blk < 4; ++blk) {
                unsigned xr[23];
#pragma unroll
                for (int i = 0; i < 23; ++i) xr[i] = PB[(8 * blk + i) * 128 + p];
#pragma unroll
                for (int j = 0; j < 8; ++j) { const int tt = 8 * blk + j; const f32x2 xv = (f32x2){bflo(xr[15 + j]), bfhi(xr[15 + j])};
                    s += xv; const int n = (s0 + tt + 1) < wd ? (s0 + tt + 1) : wd; const float inv = __builtin_amdgcn_rcpf((float)n);
                    const f32x2 dd = s * inv - xv;
                    if (GEMM2_FP8) *(GAS unsigned short*)((unsigned char*)Y + (size_t)(t0 + tt) * D_ + 768 + 2 * p) = (unsigned short)pk4_fp8(dd.x, dd.y, 0.f, 0.f);
                    else *(GAS unsigned*)(Y + (size_t)(t0 + tt) * D_ + 768 + 2 * p) = pk2(dd.x, dd.y);
                    const unsigned u2 = xr[15 + j - 1], u4 = xr[15 + j - 3], u8 = xr[15 + j - 7], u16 = xr[j];
                    const unsigned uo = g == 0 ? u2 : (g == 1 ? u4 : (g == 2 ? u8 : u16));
                    s -= (f32x2){bflo(uo), bfhi(uo)}; }
            }
        }
        __syncthreads();
        v4u ya[3][4];
        int t0o = t0; asm volatile("" : "+s"(t0o));
        int tidl = tid; asm volatile("" : "+v"(tidl));
#pragma unroll
        for (int i = 0; i < 3; ++i) { const int q = tidl + 512 * i, tt = q / 48, o8 = q % 48, pos = (t0o & (SEQ_ - 1)) + tt; const size_t row = (size_t)(t0o + tt);
            ya[i][0] = __builtin_nontemporal_load((const GAS v4u*)(Z + row * NZ + o8 * 8));
            ya[i][1] = *(const GAS v4u*)(Z + row * NZ + 384 + o8 * 8);
            ya[i][2] = *(const GAS v4u*)(Z + (row - (pos >= 1 ? 1 : 0)) * NZ + 384 + o8 * 8);
            ya[i][3] = *(const GAS v4u*)(Z + (row - (pos >= 2 ? 2 : 0)) * NZ + 384 + o8 * 8); }
#pragma unroll
        for (int tk = 0; tk < 4; ++tk) { const int tt = wave * 4 + tk;
            f32x2 v[3]; float s = 0.f;
#pragma unroll
            for (int i = 0; i < 3; ++i) { v[i] = *(const LAS f32x2*)(V + tt * 384 + 2 * lane + 128 * i); s += v[i].x + v[i].y; }
            const float mean = wave_sum(s) * (1.f / 384.f); float q = 0.f;
#pragma unroll
            for (int i = 0; i < 3; ++i) { v[i] = v[i] - mean; q += v[i].x * v[i].x + v[i].y * v[i].y; }
            const float rstd = __builtin_amdgcn_rsqf(wave_sum(q) * (1.f / 384.f) + LN_EPS);
#pragma unroll
            for (int i = 0; i < 3; ++i) { const int c = 2 * lane + 128 * i; const f32x2 gg = *(const LAS f32x2*)(LGB + c), bb = *(const LAS f32x2*)(LGB + 384 + c);
                f32x2 o = v[i] * rstd * gg + bb; o.x = o.x * sigmoidf_(o.x); o.y = o.y * sigmoidf_(o.y);
                if (GEMM2_FP8) *(GAS unsigned short*)((unsigned char*)Y + (size_t)(t0 + tt) * D_ + 384 + c) = (unsigned short)pk4_fp8(o.x, o.y, 0.f, 0.f);
                else *(GAS unsigned*)(Y + (size_t)(t0 + tt) * D_ + 384 + c) = pk2(o.x, o.y); }
        }
#pragma unroll
        for (int i = 0; i < 3; ++i) { const int q = tid + 512 * i, tt = q / 48, o8 = q % 48, pos = s0 + tt; const size_t row = (size_t)(t0 + tt);
            const v4u gb = ya[i][0], x0 = ya[i][1]; v4u x1 = ya[i][2], x2 = ya[i][3];
            if (pos < 1) x1 = (v4u){0u, 0u, 0u, 0u};
            if (pos < 2) x2 = (v4u){0u, 0u, 0u, 0u};
            const LAS f32x4* wp = (const LAS f32x4*)(WA + o8 * 8);
            const f32x4 w0a = wp[0], w0b = wp[1], w1a = wp[96], w1b = wp[97], w2a = wp[192], w2b = wp[193];
            float o[8];
            const unsigned gbw[4] = {gb.x, gb.y, gb.z, gb.w}, x0w[4] = {x0.x, x0.y, x0.z, x0.w}, x1w[4] = {x1.x, x1.y, x1.z, x1.w}, x2w[4] = {x2.x, x2.y, x2.z, x2.w};
            const float w2[8] = {w2a.x, w2a.y, w2a.z, w2a.w, w2b.x, w2b.y, w2b.z, w2b.w}, w1[8] = {w1a.x, w1a.y, w1a.z, w1a.w, w1b.x, w1b.y, w1b.z, w1b.w}, w0[8] = {w0a.x, w0a.y, w0a.z, w0a.w, w0b.x, w0b.y, w0b.z, w0b.w};
#pragma unroll
            for (int e = 0; e < 4; ++e) {
                o[2 * e] = bflo(gbw[e]) * (w2[2 * e] * bflo(x0w[e]) + w1[2 * e] * bflo(x1w[e]) + w0[2 * e] * bflo(x2w[e]));
                o[2 * e + 1] = bfhi(gbw[e]) * (w2[2 * e + 1] * bfhi(x0w[e]) + w1[2 * e + 1] * bfhi(x1w[e]) + w0[2 * e + 1] * bfhi(x2w[e])); }
            if (GEMM2_FP8) { v2u ov; ov.x = pk4_fp8(o[0], o[1], o[2], o[3]); ov.y = pk4_fp8(o[4], o[5], o[6], o[7]); *(GAS v2u*)((unsigned char*)Y + row * D_ + o8 * 8) = ov; }
            else { v4u ov; ov.x = pk2(o[0], o[1]); ov.y = pk2(o[2], o[3]); ov.z = pk2(o[4], o[5]); ov.w = pk2(o[6], o[7]);
            *(GAS v4u*)(Y + row * D_ + o8 * 8) = ov; } }
        __syncthreads();
    }
#undef MIX_PREFETCH
}

__device__ __forceinline__ void top2of4(float q0, float q1, float q2, float q3, float& a1, int& i1, float& a2, int& i2) {
    a1 = q0; i1 = 0; a2 = -1.f; i2 = 1;
#define T2STEP(qv, r) { const bool gt = (qv) > a1; const bool g2 = (qv) > a2; const float na2 = gt ? a1 : (g2 ? (qv) : a2); const int ni2 = gt ? i1 : (g2 ? (r) : i2); \
        a1 = gt ? (qv) : a1; i1 = gt ? (r) : i1; a2 = na2; i2 = ni2; }
    T2STEP(q1, 1) T2STEP(q2, 2) T2STEP(q3, 3)
#undef T2STEP
}
__device__ __forceinline__ void p4_ln_router(Frame& F, const Args& A, int l) {
    LAS unsigned char* lds = F.lds;
    LAS int* cntl = (LAS int*)(lds + 66048); LAS int* basel = cntl + 32; LAS int* sel = cntl + 64; LAS int* lpos = cntl + 64 + 256;
    const bf16* U = (const bf16*)(F.ws + WS_U); bf16* HB = (bf16*)(F.ws + WS_HB); unsigned char* H8 = F.ws + WS_H8; const bf16* WRT = (const bf16*)(F.ws + WS_WRT);
    int* route = (int*)(F.ws + WS_ROUTE); int* lists = (int*)(F.ws + WS_LISTS);
    unsigned* counts = F.ctl + CW_CNT + l * 32 * 64;
    const float* g = A.in[I_LMG] + l * D_; const float* b = A.in[I_LMB] + l * D_; const float* rb = A.in[I_RB];
    int tid = F.tid; asm volatile("" : "+v"(tid));
    const int lane = tid & 63, wave = F.wave, fr = lane & 15, fq = lane >> 4;
    for (int q = tid; q < 32 * 128; q += 512) { const int e = q >> 7, c = q & 127; *(LAS v4u*)(lds + e * 2064 + c * 16) = *(const GAS v4u*)(WRT + e * 1024 + c * 8); }
    if (tid < 32) cntl[tid] = 0;
    f32x4 gv[4], bv[4];
#pragma unroll
    for (int j = 0; j < 4; ++j) { gv[j] = *(const f32x4*)(g + 4 * lane + 256 * j); bv[j] = *(const f32x4*)(b + 4 * lane + 256 * j); }
    __syncthreads();
    for (int blk = F.vcu; blk < T_ / 128; blk += F.G) {
        v2u q[2][4][4];
        { const size_t m = (size_t)(blk * 128 + wave * 16);
#pragma unroll
          for (int u = 0; u < 4; ++u) { const GAS v2u* up = (const GAS v2u*)(U + (m + u) * D_) + lane;
#pragma unroll
              for (int j = 0; j < 4; ++j) q[0][u][j] = up[64 * j]; } }
#pragma unroll
        for (int b = 0; b < 4; ++b) { const size_t m = (size_t)(blk * 128 + wave * 16 + b * 4);
            if (b < 3) {
#pragma unroll
                for (int u = 0; u < 4; ++u) { const GAS v2u* up = (const GAS v2u*)(U + (m + 4 + u) * D_) + lane;
#pragma unroll
                    for (int j = 0; j < 4; ++j) q[(b + 1) & 1][u][j] = up[64 * j]; }
                asm volatile("" ::: "memory"); }
#pragma unroll
            for (int u = 0; u < 4; ++u) { f32x4 v[4]; float s = 0.f;
#pragma unroll
                for (int j = 0; j < 4; ++j) { const v2u qq = q[b & 1][u][j]; v[j] = (f32x4){bflo(qq.x), bfhi(qq.x), bflo(qq.y), bfhi(qq.y)}; s += (v[j].x + v[j].y) + (v[j].z + v[j].w); }
                const float mean = wave_sum(s) * (1.f / D_); float s2 = 0.f;
#pragma unroll
                for (int j = 0; j < 4; ++j) { v[j] = v[j] - mean; s2 += (v[j].x * v[j].x + v[j].y * v[j].y) + (v[j].z * v[j].z + v[j].w * v[j].w); }
                const float rstd = __builtin_amdgcn_rsqf(wave_sum(s2) * (1.f / D_) + LN_EPS);
                GAS v2u* o8 = (GAS v2u*)(HB + (m + u) * D_) + lane; GAS unsigned* o4 = (GAS unsigned*)(H8 + (m + u) * D_) + lane;
#pragma unroll
                for (int j = 0; j < 4; ++j) { const f32x4 o = v[j] * rstd * gv[j] + bv[j]; v2u w; w.x = pk2(o.x, o.y); w.y = pk2(o.z, o.w); o8[64 * j] = w; o4[64 * j] = pk4_fp8(o.x, o.y, o.z, o.w); } }
        }
        VM_WAIT(); asm volatile("" ::: "memory");
        const int token = blk * 128 + wave * 16 + fr;
        f32x4 acc0 = (f32x4){0.f, 0.f, 0.f, 0.f}, acc1 = (f32x4){0.f, 0.f, 0.f, 0.f};
        const bf16* hrow = HB + (size_t)token * D_ + fq * 8;
#pragma unroll 16
        for (int k = 0; k < 32; ++k) { const int kk = k * 32 + fq * 8;
            const bf16x8 hf = *(const GAS bf16x8*)(hrow + k * 32);
            const bf16x8 w0 = *(const LAS bf16x8*)(lds + fr * 2064 + kk * 2), w1 = *(const LAS bf16x8*)(lds + (16 + fr) * 2064 + kk * 2);
            acc0 = __builtin_amdgcn_mfma_f32_16x16x32_bf16(w0, hf, acc0, 0, 0, 0);
            acc1 = __builtin_amdgcn_mfma_f32_16x16x32_bf16(w1, hf, acc1, 0, 0, 0);
        }
        float p0[4], p1[4]; float mx = -3.0e38f;
#pragma unroll
        for (int r = 0; r < 4; ++r) { p0[r] = acc0[r] + rb[4 * fq + r]; p1[r] = acc1[r] + rb[16 + 4 * fq + r]; mx = fmaxf(mx, fmaxf(p0[r], p1[r])); }
        mx = fmaxf(mx, __shfl_xor(mx, 16)); mx = fmaxf(mx, __shfl_xor(mx, 32));
#pragma unroll
        for (int r = 0; r < 4; ++r) { p0[r] = __expf(p0[r] - mx); p1[r] = __expf(p1[r] - mx); }
        float a1, a2, c1, c2; int ia1, ia2, ic1, ic2;
        top2of4(p0[0], p0[1], p0[2], p0[3], a1, ia1, a2, ia2); top2of4(p1[0], p1[1], p1[2], p1[3], c1, ic1, c2, ic2);
        const float sc0 = a1 + a2, sc1 = c1 + c2;
        float bs = sc0; int bg = fq; if (sc1 > sc0) { bs = sc1; bg = 4 + fq; }
#pragma unroll
        for (int off = 16; off <= 32; off <<= 1) { const float os = __shfl_xor(bs, off); const int og = __shfl_xor(bg, off); if (os > bs || (os == bs && og < bg)) { bs = os; bg = og; } }
        if ((bg & 3) == fq) {
            const bool hi = bg >= 4;
            const float pa = hi ? c1 : a1, pb = hi ? c2 : a2; const int ia = hi ? ic1 : ia1, ib = hi ? ic2 : ia2;
            const int ea = bg * 4 + ia, eb = bg * 4 + ib; const float inv = 1.0f / (pa + pb);
            const int tokl = wave * 16 + fr;
            const int la = atomicAdd((int*)&cntl[ea], 1), lb2 = atomicAdd((int*)&cntl[eb], 1);
            sel[tokl * 2] = ea; sel[tokl * 2 + 1] = eb; lpos[tokl * 2] = la; lpos[tokl * 2 + 1] = lb2;
            int* rt = route + (size_t)token * 8; rt[0] = ea; rt[2] = eb; rt[4] = __float_as_int(pa * inv); rt[5] = __float_as_int(pb * inv);
        }
        __syncthreads();
        if (tid < 32) { const int c = cntl[tid]; basel[tid] = c ? (int)__hip_atomic_fetch_add(counts + tid * 64, (unsigned)c, RLX_AGENT) : 0; }
        __syncthreads();
        if (tid < 256) { const int tokl = tid >> 1, k = tid & 1, e = sel[tid], pos = basel[e] + lpos[tid], tok = blk * 128 + tokl;
            lists[(size_t)e * 65536 + pos] = tok * 2 + k; route[(size_t)tok * 8 + 1 + 2 * k] = pos; }
        __syncthreads();
        if (tid < 32) cntl[tid] = 0;
        __syncthreads();
    }
}

__device__ __forceinline__ void moe_table(Frame& F, int l) {
    LAS int* tab = (LAS int*)(F.lds + TAB_OFF);
    __syncthreads();
    if (F.tid < 32) tab[40 + F.tid] = (int)__hip_atomic_load(F.ctl + CW_CNT + (l * 32 + F.tid) * 64, RLX_AGENT);
    __syncthreads();
    if (F.tid == 0) { int s = 0; for (int e = 0; e < 32; ++e) { tab[e] = s; s += (tab[40 + e] + 255) >> 8; } tab[32] = s; }
    __syncthreads();
    for (int t = F.tid; t < tab[32]; t += NWAVES * 64) { int e = 0; while (e < 31 && tab[e + 1] <= t) ++e; tab[80 + t] = e; }
    __syncthreads();
}

__device__ __forceinline__ void p7_combine_ln(Frame& F, const Args& A, int l) {
    const LAS int* tab = (const LAS int*)(F.lds + TAB_OFF);
    bf16* HB = (bf16*)(F.ws + WS_HB); const unsigned char* Y2S = F.ws + WS_Y2S; const int* route = (const int*)(F.ws + WS_ROUTE);
    const float* g = A.in[I_LFG] + l * D_; const float* b = A.in[I_LFB] + l * D_;
    int lane = F.lane; asm volatile("" : "+v"(lane));
    const int gw = F.vcu * NWAVES + F.wave, NGW = F.G * NWAVES;
    f32x4 gv[4], bv[4];
#pragma unroll
    for (int j = 0; j < 4; ++j) { gv[j] = *(const f32x4*)(g + 4 * lane + 256 * j); bv[j] = *(const f32x4*)(b + 4 * lane + 256 * j); }
    const bool last = (l == NL - 1);
    const int step = NGW * 2;
    int R[2][6], Rn[2][6];
    v2u hq[2][4], hn[2][4]; unsigned aq[2][4], cq[2][4], an[2][4], cn[2][4];
#define P7_ROUTE(m0_, R_) do { _Pragma("unroll") for (int _u = 0; _u < 2; ++_u) { const int* _rt = route + (size_t)((m0_) + _u) * 8; \
        _Pragma("unroll") for (int _k = 0; _k < 6; ++_k) R_[_u][_k] = _rt[_k]; } } while (0)
#define P7_ROWS(m0_, R_, hq_, aq_, cq_) do { _Pragma("unroll") for (int _u = 0; _u < 2; ++_u) { const int _m = (m0_) + _u; \
        const size_t _r0 = (size_t)tab[R_[_u][0]] * 256 + R_[_u][1], _r1 = (size_t)tab[R_[_u][2]] * 256 + R_[_u][3]; \
        const GAS v2u* _hp = (const GAS v2u*)(HB + (size_t)_m * D_) + lane; const GAS unsigned* _ya = (const GAS unsigned*)(Y2S + _r0 * D_) + lane; const GAS unsigned* _yb = (const GAS unsigned*)(Y2S + _r1 * D_) + lane; \
        _Pragma("unroll") for (int _j = 0; _j < 4; ++_j) { hq_[_u][_j] = _hp[64 * _j]; aq_[_u][_j] = _ya[64 * _j]; cq_[_u][_j] = _yb[64 * _j]; } } } while (0)
    int m0 = gw * 2;
    if (m0 < T_) { P7_ROUTE(m0, R); P7_ROWS(m0, R, hq, aq, cq); if (m0 + step < T_) P7_ROUTE(m0 + step, Rn); }
    for (; m0 < T_; m0 += step) {
        const bool has_n = m0 + step < T_;
        int Rnn[2][6];
        if (has_n) P7_ROWS(m0 + step, Rn, hn, an, cn);
        if (m0 + 2 * step < T_) P7_ROUTE(m0 + 2 * step, Rnn);
#pragma unroll
        for (int u = 0; u < 2; ++u) { const int m = m0 + u; f32x4 v[4]; float s = 0.f; const float g0 = __int_as_float(R[u][4]), g1 = __int_as_float(R[u][5]);
#pragma unroll
            for (int j = 0; j < 4; ++j) { const v2u h = hq[u][j]; const unsigned a = aq[u][j], c = cq[u][j];
                const f32x2 a01 = __builtin_amdgcn_cvt_pk_f32_fp8((int)a, false), a23 = __builtin_amdgcn_cvt_pk_f32_fp8((int)a, true), c01 = __builtin_amdgcn_cvt_pk_f32_fp8((int)c, false), c23 = __builtin_amdgcn_cvt_pk_f32_fp8((int)c, true);
                v[j].x = ALPHA * bflo(h.x) + g0 * a01.x + g1 * c01.x; v[j].y = ALPHA * bfhi(h.x) + g0 * a01.y + g1 * c01.y;
                v[j].z = ALPHA * bflo(h.y) + g0 * a23.x + g1 * c23.x; v[j].w = ALPHA * bfhi(h.y) + g0 * a23.y + g1 * c23.y;
                s += (v[j].x + v[j].y) + (v[j].z + v[j].w); }
            const float mean = wave_sum(s) * (1.f / D_); float s2 = 0.f;
#pragma unroll
            for (int j = 0; j < 4; ++j) { v[j] = v[j] - mean; s2 += (v[j].x * v[j].x + v[j].y * v[j].y) + (v[j].z * v[j].z + v[j].w * v[j].w); }
            const float rstd = __builtin_amdgcn_rsqf(wave_sum(s2) * (1.f / D_) + LN_EPS);
            if (last) { GAS f32x4* o = (GAS f32x4*)(A.out + (size_t)m * D_) + lane;
#pragma unroll
                for (int j = 0; j < 4; ++j) o[64 * j] = v[j] * rstd * gv[j] + bv[j];
            } else { GAS v2u* o8 = (GAS v2u*)(HB + (size_t)m * D_) + lane; float amax = 0.f;
#pragma unroll
                for (int j = 0; j < 4; ++j) { const f32x4 o = v[j] * rstd * gv[j] + bv[j]; v[j] = o; v2u w; w.x = pk2(o.x, o.y); w.y = pk2(o.z, o.w); o8[64 * j] = w;
                    amax = fmaxf(amax, fmaxf(fmaxf(fabsf(o.x), fabsf(o.y)), fmaxf(fabsf(o.z), fabsf(o.w)))); }
                if (GEMM1_I8) { amax = wave_max(amax); const float inv = amax > 0.f ? 127.f / amax : 0.f;
                    GAS unsigned* q4 = (GAS unsigned*)(F.ws + WS_HQ + (size_t)m * D_) + lane;
#pragma unroll
                    for (int j = 0; j < 4; ++j) q4[64 * j] = pk4_i8(v[j].x * inv, v[j].y * inv, v[j].z * inv, v[j].w * inv);
                    if (lane == 0) ((float*)(F.ws + WS_HS))[m] = amax * (1.f / 127.f); } }
        }
#pragma unroll
        for (int u = 0; u < 2; ++u) {
#pragma unroll
            for (int j = 0; j < 4; ++j) { hq[u][j] = hn[u][j]; aq[u][j] = an[u][j]; cq[u][j] = cn[u][j]; }
#pragma unroll
            for (int k = 0; k < 6; ++k) { R[u][k] = Rn[u][k]; Rn[u][k] = Rnn[u][k]; } }
    }
#undef P7_ROUTE
#undef P7_ROWS
}

#ifndef PH_NOINLINE
#define PH_NOINLINE __forceinline__
#endif
PH_NOINLINE __device__ void run_gemm1(LAS unsigned char* lds, unsigned char* ws, int l, int G, int c) {
    pg8::DenseOrder S;
    if (GEMM1_I8) { S.init(ws + WS_HQ, ws + WS_WIN + (size_t)l * N1 * 1024, T_, N1, D_ / 2, G, c, 1);
        pg8::EpiZq E{(bf16*)(ws + WS_Z), (const float*)(ws + WS_HS), (const float*)((unsigned*)(ws + WS_CTL) + CW_CMAX) + l * N1}; pg8::gemm_phase<pg8::EpiZq, pg8::DenseOrder, 2>(lds, S, E); }
    else { S.init(ws + WS_HB, ws + WS_WIN + (size_t)l * N1 * 1024 * 2, T_, N1, D_, G, c, 1); pg8::EpiZ E{(bf16*)(ws + WS_Z)}; pg8::gemm_phase(lds, S, E); }
}
PH_NOINLINE __device__ void run_gemm_probe(LAS unsigned char* lds, unsigned char* ws, int G, int c) {
    pg8::DenseOrder S; S.init(ws + WS_HB, ws + WS_WIN, T_, 256 * (PROBE_EXTRA_NN ? PROBE_EXTRA_NN : 1), D_, G, c);
    pg8::EpiPlain E{(bf16*)(ws + WS_Y), 2048};
    pg8::gemm_phase(lds, S, E);
}
PH_NOINLINE __device__ void run_gemm2(LAS unsigned char* lds, unsigned char* ws, int l, int G, int c) {
    pg8::EpiU E{(const bf16*)(ws + WS_HB), (bf16*)(ws + WS_U)};
    if (GEMM2_FP8) { pg8::DenseRowsOrder S; int kq = D_ / 2; asm volatile("" : "+s"(kq)); S.init(ws + WS_Y, ws + WS_WOUT + (size_t)l * 1024 * 1024, T_, D_, kq, G, c); pg8::gemm_phase<pg8::EpiU, pg8::DenseRowsOrder, true>(lds, S, E); }
    else { pg8::DenseOrder S; S.init(ws + WS_Y, ws + WS_WOUT + (size_t)l * 1024 * 1024 * 2, T_, D_, D_, G, c); pg8::gemm_phase(lds, S, E); }
}
PH_NOINLINE __device__ void run_gemm5(LAS unsigned char* lds, unsigned char* ws, int l, int G, int c) {
    const LAS int* tab = (const LAS int*)(lds + TAB_OFF);
    pg8::MoeGatherOrder S; S.A = (const char*)(ws + WS_H8); S.Bt = (const char*)(ws + WS_WGU + (size_t)l * NE * 1024 * 1024); S.bexp = (size_t)1024 * 1024;
    int kq = D_ / 2; asm volatile("" : "+s"(kq));
    S.K = kq; S.nN = 4; S.nwg = tab[32] * 4; S.G = G; S.c = c; S.tab = tab; S.lists = (const int*)(ws + WS_LISTS);
    pg8::EpiHid E{ws + WS_HID};
    pg8::gemm_phase<pg8::EpiHid, pg8::MoeGatherOrder, true>(lds, S, E);
}
PH_NOINLINE __device__ void run_gemm6(LAS unsigned char* lds, unsigned char* ws, int l, int G, int c) {
    const LAS int* tab = (const LAS int*)(lds + TAB_OFF);
    pg8::MoeRowsOrder S; S.A = (const char*)(ws + WS_HID); S.Bt = (const char*)(ws + WS_WD + (size_t)l * NE * 1024 * 512); S.bexp = (size_t)1024 * 512;
    int kq = DE / 2; asm volatile("" : "+s"(kq));
    S.K = kq; S.nN = 4; S.nwg = tab[32] * 4; S.G = G; S.c = c; S.tab = tab; S.lists = nullptr;
    pg8::EpiPlain8 E{ws + WS_Y2S, D_};
    pg8::gemm_phase<pg8::EpiPlain8, pg8::MoeRowsOrder, true>(lds, S, E);
}

__global__ void __launch_bounds__(NWAVES * 64, 2) mk_fwd(Args args) {
    extern __shared__ __attribute__((aligned(16))) unsigned char lds_raw[];
    Frame F;
    F.lds = (LAS unsigned char*)lds_raw;
    F.tid = threadIdx.x; F.lane = F.tid & 63; F.wave = __builtin_amdgcn_readfirstlane(F.tid >> 6);
    F.G = gridDim.x; { const int bx = blockIdx.x; F.vcu = (F.G % 8 == 0) ? (bx % 8) * (F.G / 8) + bx / 8 : bx; }
    F.ws = args.ws; F.ctl = (unsigned*)(args.ws + WS_CTL);
    for (int u = F.tid; u < (LDS_BYTES - LDSCTL_OFF) / 4; u += NWAVES * 64) ((LAS unsigned*)(F.lds + LDSCTL_OFF))[u] = 0u;
    __syncthreads();
    volatile LAS unsigned* MISC = (volatile LAS unsigned*)(F.lds + MISC_OFF);
    XcdBarrier bar; bar.bar = F.ctl + CW_BAR; bar.x = 0; bar.st = nullptr;
    if (MK_N_LAUNCHES == 1) bar = xcd_barrier_post(F.ctl + CW_BAR, MISC + 8);
    const int lo = args.ph_lo, hi = args.ph_hi;
#define IN(k) (lo <= (k) && (k) < hi)
#define SEAM(k) do { if (MK_N_LAUNCHES == 1 && (k) + 1 < hi) xcd_barrier(bar); } while (0)
    if (REPEAT_MASK & 256) { for (int rep = 0; rep < 10; ++rep) xcd_barrier(bar); }
    if ((PH_MASK & 1) && IN(0)) { for (int rep = 0; rep < ((REPEAT_MASK & 1) ? 2 : 1); ++rep) { p0_prologue(F, args); SEAM(0); } }
#pragma unroll 1
    for (int l = 0; l < NL; ++l) {
        const int pb = 1 + 7 * l;
        if ((PH_MASK & 2) && IN(pb + 0)) { for (int rep = 0; rep < ((REPEAT_MASK & 2) ? 2 : 1); ++rep) { run_gemm1(F.lds, F.ws, l, F.G, (int)blockIdx.x); SEAM(pb + 0); }
            if (PROBE_EXTRA_NN && l == 0) { run_gemm_probe(F.lds, F.ws, F.G, (int)blockIdx.x); xcd_barrier(bar); } }
        if ((PH_MASK & 4) && IN(pb + 1)) { for (int rep = 0; rep < ((REPEAT_MASK & 4) ? 2 : 1); ++rep) { p2_mixer(F, args, l); SEAM(pb + 1); } }
        if ((PH_MASK & 8) && IN(pb + 2)) { for (int rep = 0; rep < ((REPEAT_MASK & 8) ? 2 : 1); ++rep) { run_gemm2(F.lds, F.ws, l, F.G, (int)blockIdx.x); SEAM(pb + 2); } }
        if ((PH_MASK & 16) && IN(pb + 3)) {
            if (REPEAT_MASK & 16) { p4_ln_router(F, args, l); SEAM(pb + 3);
                if (blockIdx.x == 0 && F.tid < 32) __hip_atomic_store(F.ctl + CW_CNT + (l * 32 + F.tid) * 64, 0u, RLX_AGENT);
                SEAM(pb + 3); }
            p4_ln_router(F, args, l); SEAM(pb + 3); }
        if ((PH_MASK & 32) && IN(pb + 4)) { for (int rep = 0; rep < ((REPEAT_MASK & 32) ? 2 : 1); ++rep) { moe_table(F, l); run_gemm5(F.lds, F.ws, l, F.G, (int)blockIdx.x); SEAM(pb + 4); } }
        if ((PH_MASK & 64) && IN(pb + 5)) { for (int rep = 0; rep < ((REPEAT_MASK & 64) ? 2 : 1); ++rep) { if (MK_N_LAUNCHES != 1 || rep) moe_table(F, l); run_gemm6(F.lds, F.ws, l, F.G, (int)blockIdx.x); SEAM(pb + 5); } }
        if ((PH_MASK & 128) && IN(pb + 6)) { for (int rep = 0; rep < (((REPEAT_MASK & 128) && l == NL - 1) ? 2 : 1); ++rep) { if (MK_N_LAUNCHES != 1) moe_table(F, l); p7_combine_ln(F, args, l); if (rep == 0) SEAM(pb + 6); else xcd_barrier(bar); } }
    }
#undef IN
#undef SEAM
}

extern "C" void kernel_launch(void* const* d_in, const int* in_sizes, int n_in, void* d_out, int out_size, void* d_ws, size_t ws_size, hipStream_t stream) {
    static int grid = 0;
    if (grid == 0) {
        if (n_in != 21 || out_size != T_ * D_ || ws_size < WS_END) { fprintf(stderr, "kernel_launch: unexpected problem (n_in %d, out %d, ws %zu); nothing launched\n", n_in, out_size, ws_size); grid = -1; return; }
        int dev = 0, cus = 0, per_cu = 0;
        if (hipGetDevice(&dev) != hipSuccess || hipDeviceGetAttribute(&cus, hipDeviceAttributeMultiprocessorCount, dev) != hipSuccess) { grid = -1; return; }
        if (hipFuncSetAttribute((const void*)mk_fwd, hipFuncAttributeMaxDynamicSharedMemorySize, LDS_BYTES) != hipSuccess) { fprintf(stderr, "kernel_launch: hipFuncSetAttribute failed\n"); grid = -1; return; }
        if (hipOccupancyMaxActiveBlocksPerMultiprocessor(&per_cu, (const void*)mk_fwd, NWAVES * 64, LDS_BYTES) != hipSuccess || per_cu < 1) { fprintf(stderr, "kernel_launch: occupancy query says %d\n", per_cu); }
        (void)hipGetLastError();
        grid = cus;
    }
    if (grid < 0) return;
    (void)hipMemsetAsync((char*)d_ws + WS_CTL, 0, CTL_ZERO_BYTES, stream);
    Args a{};
    for (int i = 0; i < 21; ++i) a.in[i] = (const float*)d_in[i];
    a.out = (float*)d_out; a.ws = (unsigned char*)d_ws;
    if (MK_N_LAUNCHES == 1) { a.ph_lo = 0; a.ph_hi = NPH; hipLaunchKernelGGL(mk_fwd, dim3(grid), dim3(NWAVES * 64), LDS_BYTES, stream, a); }
    else for (int p = 0; p < NPH; ++p) { a.ph_lo = p; a.ph_hi = p + 1; hipLaunchKernelGGL(mk_fwd, dim3(grid), dim3(NWAVES * 64), LDS_BYTES, stream, a); }
}
```

```cpp
#include <hip/hip_runtime.h>
#include <cstdio>
#include <cstdint>

#ifndef MK_N_LAUNCHES
#define MK_N_LAUNCHES 1
#endif
#ifndef PH_MASK
#define PH_MASK 0xff
#endif
#ifndef REPEAT_MASK
#define REPEAT_MASK 0
#endif
#ifndef GEMM1_I8
#define GEMM1_I8 1
#endif
#ifndef GEMM2_FP8
#define GEMM2_FP8 1
#endif
#ifndef PROBE_P0
#define PROBE_P0 0
#endif
#ifndef PROBE_MIX
#define PROBE_MIX 0
#endif
#ifndef PROBE_EXTRA_NN
#define PROBE_EXTRA_NN 0
#endif
#ifndef GEMM_SIMPLE_MASK
#define GEMM_SIMPLE_MASK 0
#endif

#define GAS __attribute__((address_space(1)))
#define LAS __attribute__((address_space(3)))
typedef unsigned short bf16;
typedef unsigned v4u __attribute__((ext_vector_type(4)));
typedef unsigned v2u __attribute__((ext_vector_type(2)));
typedef float f32x4 __attribute__((ext_vector_type(4)));
typedef float f32x2 __attribute__((ext_vector_type(2)));
typedef short bf16x8 __attribute__((ext_vector_type(8)));
#define RLX_AGENT __ATOMIC_RELAXED, __HIP_MEMORY_SCOPE_AGENT
#define LDS_WAIT() asm volatile("s_waitcnt lgkmcnt(0)" ::: "memory")
#define VM_WAIT() asm volatile("s_waitcnt vmcnt(0)" ::: "memory")

constexpr int T_ = 32768, D_ = 1024, SEQ_ = 4096, NL = 2, NE = 32, DE = 512;
constexpr int DIN = 2176, N1 = 2304, NZ = 1408;
constexpr float ALPHA = 1.41421356237f, LN_EPS = 1e-5f;
constexpr int NPH = 1 + 7 * NL;

constexpr size_t MiB = 1u << 20;
constexpr size_t WS_CTL = 0, CTL_ZERO_BYTES = 128 * 1024;
constexpr size_t WS_ROUTE = 1 * MiB;
constexpr size_t WS_WRT = 2 * MiB;
constexpr size_t WS_HS = 2 * MiB + 256 * 1024;
constexpr size_t WS_CS = 2 * MiB + 512 * 1024;
constexpr size_t WS_LISTS = 3 * MiB;
constexpr size_t WS_WIN = 11 * MiB;
constexpr size_t WS_WOUT = 20 * MiB;
constexpr size_t WS_WGU = 24 * MiB;
constexpr size_t WS_H8 = 88 * MiB;
constexpr size_t WS_HQ = 120 * MiB;
constexpr size_t WS_WD = 152 * MiB;
constexpr size_t WS_HB = 216 * MiB;
constexpr size_t WS_Z = 280 * MiB;
constexpr size_t WS_Y = 368 * MiB;
constexpr size_t WS_U = 280 * MiB;
constexpr size_t WS_HID = 280 * MiB;
constexpr size_t WS_Y2S = 352 * MiB;
constexpr size_t WS_END = 496 * MiB;
constexpr int CW_TMO = 0, CW_BAR = 4096, CW_CNT = 16384, CW_CMAX = 20480  , CW_CMAXCNT = 25600;

constexpr int RING_BYTES = 131072, LDSCTL_OFF = RING_BYTES, MISC_OFF = LDSCTL_OFF + 320, TAB_OFF = LDSCTL_OFF + 1024;
constexpr int LDS_BYTES = 147456;
constexpr int LISTROW_OFF = 139264;

__device__ __forceinline__ unsigned f2bf(float f) { unsigned u = __builtin_bit_cast(unsigned, f); return (u + 0x7fffu + ((u >> 16) & 1u)) >> 16; }
__device__ __forceinline__ unsigned pk2(float lo, float hi) { unsigned r; asm("v_cvt_pk_bf16_f32 %0, %1, %2" : "=v"(r) : "v"(lo), "v"(hi)); return r; }
__device__ __forceinline__ float bflo(unsigned u) { return __builtin_bit_cast(float, u << 16); }
__device__ __forceinline__ float bfhi(unsigned u) { return __builtin_bit_cast(float, u & 0xffff0000u); }
template <int CTRL> __device__ __forceinline__ float dpp_mov(float v) { return __builtin_bit_cast(float, __builtin_amdgcn_update_dpp(0, __builtin_bit_cast(int, v), CTRL, 0xf, 0xf, false)); }
__device__ __forceinline__ float wave_sum(float v) {
    v += dpp_mov<0xB1>(v); v += dpp_mov<0x4E>(v); v += dpp_mov<0x141>(v); v += dpp_mov<0x140>(v);
    const int iv = __builtin_bit_cast(int, v);
    return (__builtin_bit_cast(float, __builtin_amdgcn_readlane(iv, 0)) + __builtin_bit_cast(float, __builtin_amdgcn_readlane(iv, 16))) +
           (__builtin_bit_cast(float, __builtin_amdgcn_readlane(iv, 32)) + __builtin_bit_cast(float, __builtin_amdgcn_readlane(iv, 48)));
}
__device__ __forceinline__ float wave_max(float v) {
    v = fmaxf(v, dpp_mov<0xB1>(v)); v = fmaxf(v, dpp_mov<0x4E>(v)); v = fmaxf(v, dpp_mov<0x141>(v)); v = fmaxf(v, dpp_mov<0x140>(v));
    const int iv = __builtin_bit_cast(int, v);
    return fmaxf(fmaxf(__builtin_bit_cast(float, __builtin_amdgcn_readlane(iv, 0)), __builtin_bit_cast(float, __builtin_amdgcn_readlane(iv, 16))),
                 fmaxf(__builtin_bit_cast(float, __builtin_amdgcn_readlane(iv, 32)), __builtin_bit_cast(float, __builtin_amdgcn_readlane(iv, 48))));
}
__device__ __forceinline__ unsigned pk4_i8(float a, float b, float c, float d) {
    const int ia = (int)__builtin_rintf(a), ib = (int)__builtin_rintf(b), ic = (int)__builtin_rintf(c), id = (int)__builtin_rintf(d);
    return ((unsigned)ia & 0xffu) | (((unsigned)ib & 0xffu) << 8) | (((unsigned)ic & 0xffu) << 16) | ((unsigned)id << 24); }
__device__ __forceinline__ unsigned pk4_fp8(float a, float b, float c, float d) {
    int v = 0; v = __builtin_amdgcn_cvt_pk_fp8_f32(a, b, v, false); v = __builtin_amdgcn_cvt_pk_fp8_f32(c, d, v, true); return (unsigned)v; }
__device__ __forceinline__ float sigmoidf_(float x) { return __builtin_amdgcn_rcpf(1.0f + __expf(-x)); }

namespace pg8 {
#define PG8_LAS __attribute__((address_space(3)))
typedef int v8i __attribute__((ext_vector_type(8)));
typedef int v4i __attribute__((ext_vector_type(4)));
constexpr int BM = 256, BK = 64, HALF = 128, HTB = HALF * BK * 2, STAGE_BYTES = 8 * HTB, NXCD = 8, WGM = 8;
__host__ __device__ __forceinline__ int lds_byte(int r, int c) { const int st = (r >> 4) * 2 + (c >> 5), rr = r & 15, cc = c & 31, ob = rr * 64 + cc * 2; return st * 1024 + (ob ^ (((ob >> 9) & 1) << 5)); }
__host__ __device__ __forceinline__ void stage_rc(int b, int& R, int& C) { const int st = b / 1024, sb = b % 1024, swz = sb ^ (((sb >> 9) & 1) << 5); R = (st >> 1) * 16 + swz / 64; C = (st & 1) * 32 + (swz % 64) / 2; }
__host__ __device__ __forceinline__ int perm32(int rho) { const int n = rho >> 4, i = rho & 15; return 8 * (i >> 2) + 4 * n + (i & 3); }

struct Unit { int pm, pn, e, j, rh; };

__device__ __forceinline__ int xcd_remap(int wgid, int nwg) { const int q = nwg / NXCD, r = nwg % NXCD, xcd = wgid % NXCD, off = wgid / NXCD; return (xcd < r ? xcd * (q + 1) : r * (q + 1) + (xcd - r) * q) + off; }

struct DenseOrder {
    static constexpr bool GATHER = false, HAS_HALF = true, HAS_RH = false, LISTS = false;
    const char* A; const char* Bt; int K, nM, nN, nwg, G, c, nhalf;
    __device__ void init(const void* A_, const void* Bt_, int M, int N, int K_, int G_, int c_, int half_tile = 0) { A = (const char*)A_; Bt = (const char*)Bt_; K = K_; nM = M / BM; nN = N / BM - half_tile; nwg = nM * nN; G = G_; c = c_; nhalf = half_tile ? nM : 0; }
    __device__ bool next(int i, Unit& u) const {
        const long L = (long)i * G + c; if (L >= nwg + nhalf) return false;
        u.e = 0; u.j = 0; u.rh = -1;
        if (L >= nwg) { u.pm = (int)(L - nwg); u.pn = nN; return true; }
        const int wgid = xcd_remap((int)L, nwg);
        const int nig = WGM * nN, gid = wgid / nig, fm = gid * WGM, gsz = (nM - fm) < WGM ? (nM - fm) : WGM;
        u.pm = fm + ((wgid % nig) % gsz); u.pn = (wgid % nig) / gsz; return true;
    }
    __device__ __forceinline__ bool is_half(const Unit& u) const { return u.pn >= nN; }
    __device__ __forceinline__ int row_half(const Unit&) const { return -1; }
    __device__ __forceinline__ const char* a_tile(const Unit& u) const { return A + (size_t)u.pm * BM * K * 2; }
    __device__ __forceinline__ const char* b_tile(const Unit& u) const { return Bt + (size_t)u.pn * BM * K * 2; }
    __device__ __forceinline__ unsigned a_row_off(const Unit&, int r) const { return (unsigned)(r * K * 2); }
};
struct DenseRowsOrder : DenseOrder {
    static constexpr bool GATHER = true, HAS_HALF = false;
    __device__ __forceinline__ const char* a_tile(const Unit&) const { return A; }
    __device__ __forceinline__ unsigned a_row_off(const Unit& u, int r) const { return (unsigned)(u.pm * BM + r) * (unsigned)(K * 2); }
};
struct MoeOrder {
    static constexpr bool HAS_HALF = false, HAS_RH = true, LISTS = false;
    __device__ __forceinline__ bool is_half(const Unit&) const { return false; }
    const char* A; const char* Bt; size_t bexp; int K, nN, nwg, G, c; const PG8_LAS int* tab; const int* lists;
    __device__ bool next(int i, Unit& u) const {
        const int L = i * G + c, nfull = (nwg / G) * G, rem = nwg - nfull;
        int uidx = L; u.rh = -1;
        if (L >= nfull) { if (2 * rem <= G) { if (L >= nfull + 2 * rem) return false; uidx = nfull + ((L - nfull) >> 1); u.rh = (L - nfull) & 1; } else if (L >= nwg) return false; }
        const int wgid = xcd_remap(uidx, nwg);
        const int t = wgid / nN; u.pn = wgid % nN; u.pm = t;
        const int e = tab[80 + t];
        u.e = e; u.j = t - tab[e]; return true;
    }
    __device__ __forceinline__ int row_half(const Unit& u) const { return u.rh; }
    __device__ __forceinline__ const char* b_tile(const Unit& u) const { return Bt + (size_t)u.e * bexp + (size_t)u.pn * BM * K * 2; }
};
struct MoeGatherOrder : MoeOrder {
    static constexpr bool GATHER = true, LISTS = true;
    __device__ __forceinline__ unsigned list_off(const Unit& u, int r) const {
        const int idx = u.j * BM + r, cnt = tab[40 + u.e];
        return (unsigned)(u.e * 65536 + (idx < cnt ? idx : cnt - 1)) * 4u; }
    __device__ __forceinline__ const char* a_tile(const Unit&) const { return A; }
    __device__ __forceinline__ unsigned a_row_off(const Unit& u, int r) const {
        const int idx = u.j * BM + r, cnt = tab[40 + u.e];
        const int ii = idx < cnt ? idx : cnt - 1;
        const int tok = lists[(size_t)u.e * 65536 + ii] >> 1;
        return (unsigned)tok * (unsigned)(K * 2);
    }
};
struct MoeRowsOrder : MoeOrder {
    static constexpr bool GATHER = true;
    __device__ __forceinline__ const char* a_tile(const Unit&) const { return A; }
    __device__ __forceinline__ unsigned a_row_off(const Unit& u, int r) const { return (unsigned)(u.pm * BM + r) * (unsigned)(K * 2); }
};
struct MoeDenseOrder : MoeOrder {
    static constexpr bool GATHER = false;
    __device__ __forceinline__ const char* a_tile(const Unit& u) const { return A + (size_t)u.pm * BM * K * 2; }
    __device__ __forceinline__ unsigned a_row_off(const Unit&, int r) const { return (unsigned)(r * K * 2); }
};

__device__ __forceinline__ unsigned cvt_pk_bf16(float lo, float hi) { unsigned r; asm volatile("v_cvt_pk_bf16_f32 %0, %1, %2" : "=v"(r) : "v"(lo), "v"(hi)); return r; }

struct EpiZ {
    static constexpr bool PERM = true;
    bf16* Z;
    __device__ __forceinline__ void operator()(const f32x4 (&acc)[2][2][4][2], const Unit& u, int wr, int wc, int fr, int fq) const {
        const int row0 = u.pm * BM + wr * 64 + fr, cl = wc * 32 + 8 * fq;
        if (u.pn < 6) {
            const bool sg = u.pn >= 3;
            const int zc = (sg ? 768 + (u.pn - 3) * 128 : 384 + u.pn * 128) + cl;
#pragma unroll
            for (int ai = 0; ai < 2; ++ai)
#pragma unroll
                for (int m = 0; m < 4; ++m) {
                    f32x4 a0 = acc[ai][0][m][0], a1 = acc[ai][0][m][1], g0 = acc[ai][1][m][0], g1 = acc[ai][1][m][1];
                    if (sg) {
#pragma unroll
                        for (int q = 0; q < 4; ++q) { g0[q] = sigmoidf_(g0[q]); g1[q] = sigmoidf_(g1[q]); }
                    }
                    a0 = a0 * g0; a1 = a1 * g1;
                    v4u w; w.x = cvt_pk_bf16(a0[0], a0[1]); w.y = cvt_pk_bf16(a0[2], a0[3]); w.z = cvt_pk_bf16(a1[0], a1[1]); w.w = cvt_pk_bf16(a1[2], a1[3]);
                    *(v4u*)(Z + (size_t)(row0 + ai * HALF + m * 16) * NZ + zc) = w;
                }
        } else {
            int zb0, zb1;
            if (u.pn == 6) { zb0 = 0; zb1 = 128; } else if (u.pn == 7) { zb0 = 256; zb1 = 1152; } else { zb0 = 1280; zb1 = -1; }
#pragma unroll
            for (int ai = 0; ai < 2; ++ai)
#pragma unroll
                for (int m = 0; m < 4; ++m) {
                    bf16* rowp = Z + (size_t)(row0 + ai * HALF + m * 16) * NZ + cl;
#pragma unroll
                    for (int bj = 0; bj < 2; ++bj) {
                        const int zb = bj ? zb1 : zb0;
                        if (zb >= 0) { const f32x4 a0 = acc[ai][bj][m][0], a1 = acc[ai][bj][m][1];
                            v4u w; w.x = cvt_pk_bf16(a0[0], a0[1]); w.y = cvt_pk_bf16(a0[2], a0[3]); w.z = cvt_pk_bf16(a1[0], a1[1]); w.w = cvt_pk_bf16(a1[2], a1[3]);
                            *(v4u*)(rowp + zb) = w; }
                    }
                }
        }
    }
};
struct EpiZq {
    static constexpr bool PERM = true;
    bf16* Z; const float* hs; const float* cs;
    __device__ __forceinline__ void operator()(f32x4 (&acc)[2][2][4][2], const Unit& u, int wr, int wc, int fr, int fq) const {
        const int row0 = u.pm * BM + wr * 64 + fr, cl = wc * 32 + 8 * fq;
        {
            float rs[2][4]; f32x4 cv[2][2];
#pragma unroll
            for (int ai = 0; ai < 2; ++ai)
#pragma unroll
                for (int m = 0; m < 4; ++m) rs[ai][m] = hs[row0 + ai * HALF + m * 16];
#pragma unroll
            for (int bj = 0; bj < 2; ++bj)
#pragma unroll
                for (int n = 0; n < 2; ++n) cv[bj][n] = *(const f32x4*)(cs + u.pn * BM + bj * HALF + cl + 4 * n) * (1.f / 127.f);
#pragma unroll
            for (int ai = 0; ai < 2; ++ai)
#pragma unroll
                for (int bj = 0; bj < 2; ++bj)
#pragma unroll
                    for (int m = 0; m < 4; ++m)
#pragma unroll
                        for (int n = 0; n < 2; ++n) { const v4i q = __builtin_bit_cast(v4i, acc[ai][bj][m][n]);
                            acc[ai][bj][m][n] = (f32x4){(float)q.x, (float)q.y, (float)q.z, (float)q.w} * rs[ai][m] * cv[bj][n]; }
        }
        if (u.pn < 6) {
            const bool sg = u.pn >= 3;
            const int zc = (sg ? 768 + (u.pn - 3) * 128 : 384 + u.pn * 128) + cl;
#pragma unroll
            for (int ai = 0; ai < 2; ++ai)
#pragma unroll
                for (int m = 0; m < 4; ++m) {
                    f32x4 a0 = acc[ai][0][m][0], a1 = acc[ai][0][m][1], g0 = acc[ai][1][m][0], g1 = acc[ai][1][m][1];
                    if (sg) {
#pragma unroll
                        for (int q = 0; q < 4; ++q) { g0[q] = sigmoidf_(g0[q]); g1[q] = sigmoidf_(g1[q]); }
                    }
                    a0 = a0 * g0; a1 = a1 * g1;
                    v4u w; w.x = cvt_pk_bf16(a0[0], a0[1]); w.y = cvt_pk_bf16(a0[2], a0[3]); w.z = cvt_pk_bf16(a1[0], a1[1]); w.w = cvt_pk_bf16(a1[2], a1[3]);
                    *(v4u*)(Z + (size_t)(row0 + ai * HALF + m * 16) * NZ + zc) = w;
                }
        } else {
            int zb0, zb1;
            if (u.pn == 6) { zb0 = 0; zb1 = 128; } else if (u.pn == 7) { zb0 = 256; zb1 = 1152; } else { zb0 = 1280; zb1 = -1; }
#pragma unroll
            for (int ai = 0; ai < 2; ++ai)
#pragma unroll
                for (int m = 0; m < 4; ++m) {
                    bf16* rowp = Z + (size_t)(row0 + ai * HALF + m * 16) * NZ + cl;
#pragma unroll
                    for (int bj = 0; bj < 2; ++bj) {
                        const int zb = bj ? zb1 : zb0;
                        if (zb >= 0) { const f32x4 a0 = acc[ai][bj][m][0], a1 = acc[ai][bj][m][1];
                            v4u w; w.x = cvt_pk_bf16(a0[0], a0[1]); w.y = cvt_pk_bf16(a0[2], a0[3]); w.z = cvt_pk_bf16(a1[0], a1[1]); w.w = cvt_pk_bf16(a1[2], a1[3]);
                            *(v4u*)(rowp + zb) = w; }
                    }
                }
        }
    }
};
struct EpiU {
    static constexpr bool PERM = true;
    const bf16* H; bf16* U;
    __device__ __forceinline__ void operator()(const f32x4 (&acc)[2][2][4][2], const Unit& u, int wr, int wc, int fr, int fq) const {
        const int row0 = u.pm * BM + wr * 64 + fr, col0 = u.pn * BM + wc * 32 + 8 * fq;
        v4u hh[2][4][2];
#pragma unroll
        for (int ai = 0; ai < 2; ++ai)
#pragma unroll
            for (int m = 0; m < 4; ++m)
#pragma unroll
                for (int bj = 0; bj < 2; ++bj) hh[ai][m][bj] = *(const v4u*)(H + (size_t)(row0 + ai * HALF + m * 16) * D_ + col0 + bj * HALF);
#pragma unroll
        for (int ai = 0; ai < 2; ++ai)
#pragma unroll
            for (int m = 0; m < 4; ++m) {
                const size_t off = (size_t)(row0 + ai * HALF + m * 16) * D_ + col0;
#pragma unroll
                for (int bj = 0; bj < 2; ++bj) {
                    const v4u h = hh[ai][m][bj];
                    const f32x4 a0 = acc[ai][bj][m][0], a1 = acc[ai][bj][m][1];
                    v4u w;
                    w.x = cvt_pk_bf16(ALPHA * bflo(h.x) + a0[0], ALPHA * bfhi(h.x) + a0[1]); w.y = cvt_pk_bf16(ALPHA * bflo(h.y) + a0[2], ALPHA * bfhi(h.y) + a0[3]);
                    w.z = cvt_pk_bf16(ALPHA * bflo(h.z) + a1[0], ALPHA * bfhi(h.z) + a1[1]); w.w = cvt_pk_bf16(ALPHA * bflo(h.w) + a1[2], ALPHA * bfhi(h.w) + a1[3]);
                    *(v4u*)(U + off + bj * HALF) = w;
                }
            }
    }
};
struct EpiHid {
    static constexpr bool PERM = true;
    unsigned char* HID;
    __device__ __forceinline__ void operator()(const f32x4 (&acc)[2][2][4][2], const Unit& u, int wr, int wc, int fr, int fq) const {
        const int row0 = u.pm * BM + wr * 64 + fr, col0 = u.pn * 128 + wc * 32 + 8 * fq;
#pragma unroll
        for (int ai = 0; ai < 2; ++ai) { if (u.rh >= 0 && u.rh != ai) continue;
#pragma unroll
            for (int m = 0; m < 4; ++m) {
                f32x4 g0 = acc[ai][0][m][0], g1 = acc[ai][0][m][1]; const f32x4 u0 = acc[ai][1][m][0], u1 = acc[ai][1][m][1];
#pragma unroll
                for (int q = 0; q < 4; ++q) { g0[q] = g0[q] * sigmoidf_(g0[q]); g1[q] = g1[q] * sigmoidf_(g1[q]); }
                g0 = g0 * u0; g1 = g1 * u1;
                v2u w; w.x = pk4_fp8(g0[0], g0[1], g0[2], g0[3]); w.y = pk4_fp8(g1[0], g1[1], g1[2], g1[3]);
                *(v2u*)(HID + (size_t)(row0 + ai * HALF + m * 16) * DE + col0) = w;
            } }
    }
};
struct EpiPlain8 {
    static constexpr bool PERM = true;
    unsigned char* O; int ldc;
    __device__ __forceinline__ void operator()(const f32x4 (&acc)[2][2][4][2], const Unit& u, int wr, int wc, int fr, int fq) const {
        const int row0 = u.pm * BM + wr * 64 + fr, col0 = u.pn * BM + wc * 32 + 8 * fq;
#pragma unroll
        for (int ai = 0; ai < 2; ++ai) { if (u.rh >= 0 && u.rh != ai) continue;
#pragma unroll
            for (int m = 0; m < 4; ++m) {
                unsigned char* rowp = O + (size_t)(row0 + ai * HALF + m * 16) * ldc + col0;
#pragma unroll
                for (int bj = 0; bj < 2; ++bj) { const f32x4 a0 = acc[ai][bj][m][0], a1 = acc[ai][bj][m][1];
                    v2u w; w.x = pk4_fp8(a0[0], a0[1], a0[2], a0[3]); w.y = pk4_fp8(a1[0], a1[1], a1[2], a1[3]);
                    *(v2u*)(rowp + bj * HALF) = w; }
            } }
    }
};
struct EpiPlain {
    static constexpr bool PERM = true;
    bf16* O; int ldc;
    __device__ __forceinline__ void operator()(const f32x4 (&acc)[2][2][4][2], const Unit& u, int wr, int wc, int fr, int fq) const {
        const int row0 = u.pm * BM + wr * 64 + fr, col0 = u.pn * BM + wc * 32 + 8 * fq;
#pragma unroll
        for (int ai = 0; ai < 2; ++ai)
#pragma unroll
            for (int m = 0; m < 4; ++m) {
                bf16* rowp = O + (size_t)(row0 + ai * HALF + m * 16) * ldc + col0;
#pragma unroll
                for (int bj = 0; bj < 2; ++bj) { const f32x4 a0 = acc[ai][bj][m][0], a1 = acc[ai][bj][m][1];
                    v4u w; w.x = cvt_pk_bf16(a0[0], a0[1]); w.y = cvt_pk_bf16(a0[2], a0[3]); w.z = cvt_pk_bf16(a1[0], a1[1]); w.w = cvt_pk_bf16(a1[2], a1[3]);
                    *(v4u*)(rowp + bj * HALF) = w; }
            }
    }
};

template <class Epi, class Sched>
__device__ __forceinline__ void gemm_phase_simple(const Sched& S, const Epi& E) {
    int tid = threadIdx.x; asm volatile("" : "+v"(tid));
    const int wid = __builtin_amdgcn_readfirstlane(tid >> 6), lane = tid & 63, wr = wid >> 2, wc = wid & 3, fr = lane & 15, fq = lane >> 4;
    const int K = S.K;
    Unit cur;
    for (int ui = 0; S.next(ui, cur); ++ui) {
        f32x4 acc[2][2][4][2];
#pragma unroll
        for (int a = 0; a < 2; ++a)
#pragma unroll
            for (int b = 0; b < 2; ++b)
#pragma unroll
                for (int m = 0; m < 4; ++m)
#pragma unroll
                    for (int n = 0; n < 2; ++n) acc[a][b][m][n] = (f32x4){0.f, 0.f, 0.f, 0.f};
        const char* at = S.a_tile(cur); const char* bt = S.b_tile(cur);
        const char* ap[2][4]; const char* bp[2][2];
#pragma unroll
        for (int ai = 0; ai < 2; ++ai)
#pragma unroll
            for (int m = 0; m < 4; ++m) ap[ai][m] = at + S.a_row_off(cur, ai * HALF + wr * 64 + m * 16 + fr) + fq * 16;
#pragma unroll
        for (int bj = 0; bj < 2; ++bj)
#pragma unroll
            for (int n = 0; n < 2; ++n) { const int rho = n * 16 + fr; bp[bj][n] = bt + (size_t)(bj * HALF + wc * 32 + (Epi::PERM ? perm32(rho) : rho)) * K * 2 + fq * 16; }
        for (int k0 = 0; k0 < K; k0 += 32) {
            bf16x8 a[2][4], b[2][2];
#pragma unroll
            for (int ai = 0; ai < 2; ++ai)
#pragma unroll
                for (int m = 0; m < 4; ++m) a[ai][m] = *(const bf16x8*)(ap[ai][m] + k0 * 2);
#pragma unroll
            for (int bj = 0; bj < 2; ++bj)
#pragma unroll
                for (int n = 0; n < 2; ++n) b[bj][n] = *(const bf16x8*)(bp[bj][n] + k0 * 2);
#pragma unroll
            for (int ai = 0; ai < 2; ++ai)
#pragma unroll
                for (int bj = 0; bj < 2; ++bj)
#pragma unroll
                    for (int m = 0; m < 4; ++m)
#pragma unroll
                        for (int n = 0; n < 2; ++n) acc[ai][bj][m][n] = __builtin_amdgcn_mfma_f32_16x16x32_bf16(b[bj][n], a[ai][m], acc[ai][bj][m][n], 0, 0, 0);
        }
        E(acc, cur, wr, wc, fr, fq);
    }
}

template <int OFF> __device__ __forceinline__ void glds16(const char* base, unsigned voff, unsigned lds_base) {
    asm volatile("s_add_u32 m0, %2, %3\n\ts_nop 0\n\tglobal_load_lds_dwordx4 %0, %1" :: "v"(voff), "s"(base), "s"(lds_base), "n"(OFF) : "memory", "m0", "scc");
}
template <int OFF> __device__ __forceinline__ void glds4(const char* base, unsigned voff, unsigned lds_base) {
    asm volatile("s_add_u32 m0, %2, %3\n\ts_nop 0\n\tglobal_load_lds_dword %0, %1" :: "v"(voff), "s"(base), "s"(lds_base), "n"(OFF) : "memory", "m0", "scc");
}
template <class Epi, class Sched, int MODE = 0  >
__device__ __forceinline__ void gemm_phase(PG8_LAS unsigned char* lds, const Sched& S, const Epi& E) {
    constexpr bool GATHER = Sched::GATHER;
    int tid = threadIdx.x; asm volatile("" : "+v"(tid));
    const int wid = __builtin_amdgcn_readfirstlane(tid >> 6), lane = tid & 63, wr = wid >> 2, wc = wid & 3, fr = lane & 15, fq = lane >> 4;
    const int K = S.K, nt = K / BK;
    unsigned voffB[2], offA[4], nxA[4];
#pragma unroll
    for (int i = 0; i < 2; ++i) { int R, C; stage_rc(tid * 16 + i * 8192, R, C); const int Rb = Epi::PERM ? ((R & ~31) + perm32(R & 31)) : R;
        voffB[i] = (unsigned)(Rb * K + C) * 2u; offA[i] = (unsigned)(R * K + C) * 2u; offA[2 + i] = (unsigned)((R + HALF) * K + C) * 2u; nxA[i] = 0u; nxA[2 + i] = 0u; }
    const size_t kstep = (size_t)(BK * 2);
    const size_t hstep = (size_t)HALF * K * 2;
    const unsigned ldsw = (unsigned)wid * 1024u;
    const unsigned ldsbw = (unsigned)(size_t)lds + ldsw;
    const int aoff = lds_byte(wr * 64 + fr, fq * 8), boff = lds_byte(wc * 32 + fr, fq * 8);
#define PG8_SA(b, h) (((b) * 2 + (h)) * HTB)
#define PG8_SB(b, h) ((4 + (b) * 2 + (h)) * HTB)
#define PG8_STAGE_B(bufoff, gbase) do { glds16<(bufoff)>((const char*)(gbase), voffB[0], ldsbw); glds16<(bufoff) + 8192>((const char*)(gbase), voffB[1], ldsbw); } while (0)
#define PG8_STAGE_A(bufoff, gbase, h) do { glds16<(bufoff)>((const char*)(gbase), offA[(h) * 2], ldsbw); glds16<(bufoff) + 8192>((const char*)(gbase), offA[(h) * 2 + 1], ldsbw); } while (0)
#define PG8_LDA(dst, b, h) do { _Pragma("unroll") for (int m = 0; m < 4; ++m) _Pragma("unroll") for (int k = 0; k < 2; ++k) dst[m][k] = *(const PG8_LAS bf16x8*)(lds + PG8_SA(b, h) + aoff + m * 2048 + k * 1024); } while (0)
#define PG8_LDB(dst, b, h) do { _Pragma("unroll") for (int n = 0; n < 2; ++n) _Pragma("unroll") for (int k = 0; k < 2; ++k) dst[n][k] = *(const PG8_LAS bf16x8*)(lds + PG8_SB(b, h) + boff + n * 2048 + k * 1024); } while (0)
#define PG8_MMA(ai, bj, At, Bt) do { __builtin_amdgcn_s_setprio(1); if constexpr (MODE == 1) { _Pragma("unroll") for (int m = 0; m < 4; ++m) _Pragma("unroll") for (int n = 0; n < 2; ++n) { \
            const v8i _b = __builtin_shufflevector(__builtin_bit_cast(v4i, Bt[n][0]), __builtin_bit_cast(v4i, Bt[n][1]), 0, 1, 2, 3, 4, 5, 6, 7); \
            const v8i _a = __builtin_shufflevector(__builtin_bit_cast(v4i, At[m][0]), __builtin_bit_cast(v4i, At[m][1]), 0, 1, 2, 3, 4, 5, 6, 7); \
            acc[ai][bj][m][n] = __builtin_amdgcn_mfma_scale_f32_16x16x128_f8f6f4(_b, _a, acc[ai][bj][m][n], 0, 0, 0, 0x7A7A7A7A, 0, 0x7F7F7F7F); } } \
        else if constexpr (MODE == 2) { _Pragma("unroll") for (int m = 0; m < 4; ++m) _Pragma("unroll") for (int n = 0; n < 2; ++n) _Pragma("unroll") for (int k = 0; k < 2; ++k) \
        acc[ai][bj][m][n] = __builtin_bit_cast(f32x4, __builtin_amdgcn_mfma_i32_16x16x64_i8(__builtin_bit_cast(v4i, Bt[n][k]), __builtin_bit_cast(v4i, At[m][k]), __builtin_bit_cast(v4i, acc[ai][bj][m][n]), 0, 0, 0)); } \
        else { _Pragma("unroll") for (int m = 0; m < 4; ++m) _Pragma("unroll") for (int n = 0; n < 2; ++n) _Pragma("unroll") for (int k = 0; k < 2; ++k) \
        acc[ai][bj][m][n] = __builtin_amdgcn_mfma_f32_16x16x32_bf16(Bt[n][k], At[m][k], acc[ai][bj][m][n], 0, 0, 0); } __builtin_amdgcn_s_setprio(0); } while (0)
#define PG8_WAIT_V(n) asm volatile("s_waitcnt vmcnt(" #n ")" ::: "memory")
#define PG8_WAIT_L(n) asm volatile("s_waitcnt lgkmcnt(" #n ")" ::: "memory")
#define PG8_BAR __builtin_amdgcn_s_barrier()
#define PG8_SCHED __builtin_amdgcn_sched_barrier(0)
#define PG8_OFFS(dst, u) do { if constexpr (GATHER) { _Pragma("unroll") for (int _h = 0; _h < 2; ++_h) _Pragma("unroll") for (int _i = 0; _i < 2; ++_i) { \
        int _R, _C; stage_rc(tid * 16 + _i * 8192, _R, _C); dst[_h * 2 + _i] = S.a_row_off(u, _h * HALF + _R) + (unsigned)(_C * 2); } } } while (0)
#define PG8_LIST_STAGE(u) do { if constexpr (Sched::LISTS) { glds4<LISTROW_OFF>((const char*)S.lists, S.list_off(u, (wid & 3) * 64 + lane), (unsigned)(size_t)lds + (unsigned)(wid & 3) * 256u); } } while (0)
#define PG8_LIST_READ(dst) do { if constexpr (Sched::LISTS) { _Pragma("unroll") for (int _h = 0; _h < 2; ++_h) _Pragma("unroll") for (int _i = 0; _i < 2; ++_i) { \
        int _R, _C; stage_rc(tid * 16 + _i * 8192, _R, _C); const int _v = *(const PG8_LAS int*)(lds + LISTROW_OFF + (_h * HALF + _R) * 4); \
        dst[_h * 2 + _i] = (unsigned)(_v >> 1) * (unsigned)(K * 2) + (unsigned)(_C * 2); } } } while (0)
    Unit cur, nxt; int ui = 0;
    if (!S.next(0, cur)) return;
    f32x4 acc[2][2][4][2];
#pragma unroll
    for (int a = 0; a < 2; ++a)
#pragma unroll
        for (int b = 0; b < 2; ++b)
#pragma unroll
            for (int m = 0; m < 4; ++m)
#pragma unroll
                for (int n = 0; n < 2; ++n) acc[a][b][m][n] = (f32x4){0.f, 0.f, 0.f, 0.f};
    bf16x8 At[4][2], B0[2][2], B1[2][2];
    const char* cA = S.a_tile(cur); const char* cB = S.b_tile(cur);
    if constexpr (Sched::LISTS) { PG8_LIST_STAGE(cur); PG8_WAIT_V(0); PG8_BAR; PG8_LIST_READ(offA); }
    else PG8_OFFS(offA, cur);
    PG8_STAGE_B(PG8_SB(0, 0), cB); PG8_STAGE_B(PG8_SB(0, 1), cB + hstep); PG8_STAGE_A(PG8_SA(0, 0), cA, 0); PG8_STAGE_A(PG8_SA(0, 1), cA, 1);
    if (wr == 1) PG8_BAR;
    PG8_WAIT_V(2); PG8_BAR;
    PG8_STAGE_B(PG8_SB(1, 0), cB + kstep); PG8_STAGE_A(PG8_SA(1, 0), cA + kstep, 0); PG8_STAGE_B(PG8_SB(1, 1), cB + hstep + kstep);
    PG8_WAIT_V(6); PG8_BAR;
    for (;;) {
        const bool has_next = S.next(ui + 1, nxt);
        const char* nA = has_next ? S.a_tile(nxt) : cA; const char* nB = has_next ? S.b_tile(nxt) : cB;
        if constexpr (Sched::LISTS) { if (has_next) PG8_LIST_STAGE(nxt); }
        else if constexpr (GATHER) { if (has_next) { PG8_OFFS(nxA, nxt); } }
#pragma unroll 1
        for (int t = 0; t < nt; t += 2) {
            const bool last = (t == nt - 2);
            const char* a1 = cA + (size_t)(t + 1) * kstep;
            const char* a2 = last ? nA : cA + (size_t)(t + 2) * kstep; const char* b2 = last ? nB : cB + (size_t)(t + 2) * kstep;
            const char* a3 = a2 + kstep; const char* b3 = b2 + kstep;
            PG8_LDB(B0, 0, 0); PG8_LDB(B1, 0, 1); PG8_SCHED; PG8_LDA(At, 0, 0); PG8_STAGE_A(PG8_SA(1, 1), a1, 1);
            if constexpr (Sched::LISTS) { if (last && has_next) PG8_LIST_READ(offA); }
            else if constexpr (GATHER) { if (last && has_next) {
#pragma unroll
                for (int q = 0; q < 4; ++q) offA[q] = nxA[q]; } }
            PG8_WAIT_V(8); PG8_WAIT_L(0); PG8_BAR; if (!(Sched::HAS_RH && cur.rh == 1)) { PG8_MMA(0, 0, At, B0); if (!(Sched::HAS_HALF && S.is_half(cur))) PG8_MMA(0, 1, At, B1); } PG8_BAR; PG8_SCHED;
            PG8_LDA(At, 0, 1); PG8_STAGE_B(PG8_SB(0, 0), b2); PG8_STAGE_B(PG8_SB(0, 1), b2 + hstep); PG8_STAGE_A(PG8_SA(0, 0), a2, 0);
            PG8_WAIT_V(8); PG8_WAIT_L(0); PG8_BAR; if (!(Sched::HAS_RH && cur.rh == 0)) { PG8_MMA(1, 0, At, B0); if (!(Sched::HAS_HALF && S.is_half(cur))) PG8_MMA(1, 1, At, B1); } PG8_BAR; PG8_SCHED;
            PG8_LDB(B0, 1, 0); PG8_LDB(B1, 1, 1); PG8_SCHED; PG8_LDA(At, 1, 0); PG8_STAGE_A(PG8_SA(0, 1), a2, 1);
            PG8_WAIT_V(8); PG8_WAIT_L(0); PG8_BAR; if (!(Sched::HAS_RH && cur.rh == 1)) { PG8_MMA(0, 0, At, B0); if (!(Sched::HAS_HALF && S.is_half(cur))) PG8_MMA(0, 1, At, B1); } PG8_BAR; PG8_SCHED;
            PG8_LDA(At, 1, 1); PG8_STAGE_B(PG8_SB(1, 0), b3); PG8_STAGE_B(PG8_SB(1, 1), b3 + hstep); PG8_STAGE_A(PG8_SA(1, 0), a3, 0);
            PG8_WAIT_V(8); PG8_WAIT_L(0); PG8_BAR; if (!(Sched::HAS_RH && cur.rh == 0)) { PG8_MMA(1, 0, At, B0); if (!(Sched::HAS_HALF && S.is_half(cur))) PG8_MMA(1, 1, At, B1); } PG8_BAR; PG8_SCHED;
        }
        if (wr == 0) PG8_BAR;
        E(acc, cur, wr, wc, fr, fq);
        if (!has_next) break;
#pragma unroll
        for (int a = 0; a < 2; ++a)
#pragma unroll
            for (int b = 0; b < 2; ++b)
#pragma unroll
                for (int m = 0; m < 4; ++m)
#pragma unroll
                    for (int n = 0; n < 2; ++n) acc[a][b][m][n] = (f32x4){0.f, 0.f, 0.f, 0.f};
        cur = nxt; cA = nA; cB = nB; ++ui;
        if (wr == 1) PG8_BAR;
    }
    PG8_WAIT_V(0);
    PG8_BAR;
#undef PG8_SA
#undef PG8_SB
#undef PG8_STAGE_A
#undef PG8_STAGE_B
#undef PG8_LDA
#undef PG8_LDB
#undef PG8_MMA
#undef PG8_WAIT_V
#undef PG8_WAIT_L
#undef PG8_BAR
#undef PG8_SCHED
#undef PG8_LIST_STAGE
#undef PG8_LIST_READ
#undef PG8_OFFS
}
}

#define XB_TMO      128
#define XB_XCNT(j)  (256  + 64 * (j))
#define XB_XSUB(j)  (1280 + 64 * (j))
#define XB_XGEN(j)  (2304 + 64 * (j))
#define XB_TOP      3328
#define XB_TOPGEN   3392
#define XCD_BAR_WORDS 3456
#define XB_SPIN_CAP (1u << 18)
__device__ __forceinline__ unsigned xb_ld(unsigned* p)              { return __hip_atomic_load(p, __ATOMIC_RELAXED, __HIP_MEMORY_SCOPE_AGENT); }
__device__ __forceinline__ unsigned xb_add(unsigned* p, unsigned v) { return __hip_atomic_fetch_add(p, v, __ATOMIC_RELAXED, __HIP_MEMORY_SCOPE_AGENT); }
__device__ __forceinline__ unsigned xb_xcc_id() { return (unsigned)__builtin_amdgcn_s_getreg((3 << 11) | 20) & 0xFu; }
#define XB_SPIN(cond, bar) do { unsigned _sp = 0; while (cond) { __builtin_amdgcn_s_sleep(1); \
    if ((++_sp & 255u) == 0u) { if (xb_ld(&(bar)[XB_TMO])) break; if (_sp > XB_SPIN_CAP) { atomicAdd(&(bar)[XB_TMO], 1u); break; } } } } while (0)
struct XcdBarrier { unsigned* bar; unsigned x; volatile LAS unsigned* st; };
__device__ __forceinline__ XcdBarrier xcd_barrier_post(unsigned* bar, volatile LAS unsigned* st) {
    XcdBarrier b; b.bar = bar; b.x = xb_xcc_id(); b.st = st;
    if (threadIdx.x == 0) (void)xb_add(&bar[XB_XCNT(b.x)], 1u);
    return b;
}
__device__ __forceinline__ void xcd_barrier_complete(unsigned* bar, unsigned x, unsigned& nloc, unsigned& nx) {
    const unsigned G = gridDim.x * gridDim.y * gridDim.z;
    unsigned sum, cnt, mine, sp = 0u;
    for (;;) {
        sum = 0u; cnt = 0u; mine = 0u;
#pragma unroll
        for (unsigned j = 0; j < 16; ++j) { const unsigned c = xb_ld(&bar[XB_XCNT(j)]); sum += c; cnt += (c > 0u) ? 1u : 0u; mine = (j == x) ? c : mine; }
        if (sum == G) break;
        __builtin_amdgcn_s_sleep(1);
        if ((++sp & 255u) == 0u) { if (xb_ld(&bar[XB_TMO])) break; if (sp > XB_SPIN_CAP) { atomicAdd(&bar[XB_TMO], 1u); break; } }
    }
    nloc = mine > 0u ? mine : 1u; nx = cnt > 0u ? cnt : 1u;
}
__device__ __forceinline__ void xcd_barrier(const XcdBarrier& b) {
    asm volatile("s_waitcnt vmcnt(0)" ::: "memory");
    __syncthreads();
    if (threadIdx.x == 0) {
        unsigned* bar = b.bar;
        __builtin_amdgcn_s_waitcnt(0);
        unsigned nloc = b.st[0], nx = b.st[1];
        if (nloc == 0u) { xcd_barrier_complete(bar, b.x, nloc, nx); b.st[0] = nloc; b.st[1] = nx; }
        const unsigned old = xb_add(&bar[XB_XSUB(b.x)], 1u);
        const unsigned gen = old / nloc;
        if (old + 1u == (gen + 1u) * nloc) {
            __builtin_amdgcn_fence(__ATOMIC_RELEASE, "agent");
            asm volatile("s_waitcnt vmcnt(0)" ::: "memory");
            const unsigned og = xb_add(&bar[XB_TOP], 1u);
            const unsigned tg = og / nx;
            if (og + 1u == (tg + 1u) * nx) xb_add(&bar[XB_TOPGEN], 1u);
            else XB_SPIN(xb_ld(&bar[XB_TOPGEN]) == tg, bar);
            __builtin_amdgcn_fence(__ATOMIC_ACQUIRE, "agent");
            xb_add(&bar[XB_XGEN(b.x)], 1u);
            asm volatile("s_waitcnt vmcnt(0)" ::: "memory");
        } else {
            XB_SPIN(xb_ld(&bar[XB_XGEN(b.x)]) == gen, bar);
            __builtin_amdgcn_fence(__ATOMIC_ACQUIRE, "agent");
            asm volatile("s_waitcnt vmcnt(0)" ::: "memory");
        }
    }
    __syncthreads();
}

constexpr int NWAVES = 8;
struct Args { const float* in[21]; float* out; unsigned char* ws; int ph_lo, ph_hi; };
struct Frame {
    LAS unsigned char* lds;
    unsigned* ctl;
    int tid, lane, wave, vcu, G;
    unsigned char* ws;
};
enum { I_X = 0, I_LNIG, I_LNIB, I_RW, I_RB, I_WIN, I_CAW, I_CBW, I_CBB, I_LCG, I_LCB, I_PW, I_PS, I_WOUT, I_LMG, I_LMB, I_WG, I_WU, I_WDN, I_LFG, I_LFB };

__device__ __forceinline__ void tr_item(const float* src, int srcN, int srccol0, bf16* dst, int dstK, int dstrow0, int k0, LAS float* scr, int lane) {
#pragma unroll 8
    for (int i = 0; i < 32; ++i) { const int kk = 2 * i + (lane >> 5); scr[kk * 33 + (lane & 31)] = src[(size_t)(k0 + kk) * srcN + srccol0 + (lane & 31)]; }
    LDS_WAIT(); asm volatile("" ::: "memory");
    const int c = lane & 7;
#pragma unroll
    for (int j = 0; j < 4; ++j) { const int n = (lane >> 3) + 8 * j; const LAS float* s = scr + (8 * c) * 33 + n;
        v4u o; o.x = pk2(s[0 * 33], s[1 * 33]); o.y = pk2(s[2 * 33], s[3 * 33]); o.z = pk2(s[4 * 33], s[5 * 33]); o.w = pk2(s[6 * 33], s[7 * 33]);
        *(GAS v4u*)(dst + (size_t)(dstrow0 + n) * dstK + k0 + 8 * c) = o; }
    LDS_WAIT(); asm volatile("" ::: "memory");
}
__device__ __forceinline__ void tr_item64(const float* src, int srcN, int srccol0, bf16* dst, int dstK, int dstrow0, int k0, LAS unsigned* scr, int lane) {
    const int kr = lane >> 4, c4 = lane & 15;
    const float* sp = src + (size_t)(k0 + 2 * kr) * srcN + srccol0 + 4 * c4;
    f32x4 A[8], B[8];
#pragma unroll
    for (int i = 0; i < 8; ++i) { A[i] = *(const GAS f32x4*)(sp + (size_t)(8 * i) * srcN); B[i] = *(const GAS f32x4*)(sp + (size_t)(8 * i + 1) * srcN); }
#pragma unroll
    for (int i = 0; i < 8; ++i) { LAS unsigned* w = scr + (4 * i + kr) * 65 + 4 * c4;
        w[0] = pk2(A[i].x, B[i].x); w[1] = pk2(A[i].y, B[i].y); w[2] = pk2(A[i].z, B[i].z); w[3] = pk2(A[i].w, B[i].w); }
    LDS_WAIT(); asm volatile("" ::: "memory");
    const int q = lane & 7, nn = lane >> 3;
#pragma unroll
    for (int j = 0; j < 8; ++j) { const int n = nn + 8 * j; const LAS unsigned* r = scr + (4 * q) * 65 + n;
        v4u o; o.x = r[0]; o.y = r[65]; o.z = r[130]; o.w = r[195];
        *(GAS v4u*)(dst + (size_t)(dstrow0 + n) * dstK + k0 + 8 * q) = o; }
    LDS_WAIT(); asm volatile("" ::: "memory");
}
template <int NS, bool I8 = false>
__device__ __forceinline__ void tr_item64_f8(const float* src, int srcN, int srccol0, unsigned char* dst, int dstKB, int dstrow0, int k0, float scale, LAS unsigned* scr, int lane, bool nostore = false, f32x4 cinv = (f32x4){1.f, 1.f, 1.f, 1.f}) {
    const int kr = lane >> 4, c4 = lane & 15;
    const float* sp = src + (size_t)(k0 + 4 * kr) * srcN + srccol0 + 4 * c4;
    f32x4 A[NS][4][4];
#pragma unroll
    for (int s = 0; s < NS; ++s)
#pragma unroll
        for (int i = 0; i < 4; ++i)
#pragma unroll
            for (int t = 0; t < 4; ++t) A[s][i][t] = __builtin_nontemporal_load((const GAS f32x4*)(sp + (size_t)(64 * s + 16 * i + t) * srcN));
#pragma unroll
    for (int s = 0; s < NS; ++s)
#pragma unroll
        for (int i = 0; i < 4; ++i) { LAS unsigned* w = scr + (16 * s + 4 * i + kr) * 65 + 4 * c4;
            if constexpr (I8) {
            w[0] = pk4_i8(A[s][i][0].x * cinv.x, A[s][i][1].x * cinv.x, A[s][i][2].x * cinv.x, A[s][i][3].x * cinv.x); w[1] = pk4_i8(A[s][i][0].y * cinv.y, A[s][i][1].y * cinv.y, A[s][i][2].y * cinv.y, A[s][i][3].y * cinv.y);
            w[2] = pk4_i8(A[s][i][0].z * cinv.z, A[s][i][1].z * cinv.z, A[s][i][2].z * cinv.z, A[s][i][3].z * cinv.z); w[3] = pk4_i8(A[s][i][0].w * cinv.w, A[s][i][1].w * cinv.w, A[s][i][2].w * cinv.w, A[s][i][3].w * cinv.w); } else {
            w[0] = pk4_fp8(A[s][i][0].x * scale, A[s][i][1].x * scale, A[s][i][2].x * scale, A[s][i][3].x * scale); w[1] = pk4_fp8(A[s][i][0].y * scale, A[s][i][1].y * scale, A[s][i][2].y * scale, A[s][i][3].y * scale);
            w[2] = pk4_fp8(A[s][i][0].z * scale, A[s][i][1].z * scale, A[s][i][2].z * scale, A[s][i][3].z * scale); w[3] = pk4_fp8(A[s][i][0].w * scale, A[s][i][1].w * scale, A[s][i][2].w * scale, A[s][i][3].w * scale); } }
    LDS_WAIT(); asm volatile("" ::: "memory");
    constexpr int QN = 4 * NS, RN = 64 / QN;
    const int q = lane % QN, nn = lane / QN;
#pragma unroll
    for (int j = 0; j < 64 / RN; ++j) { const int n = nn + RN * j; const LAS unsigned* r = scr + (4 * q) * 65 + n;
        v4u o; o.x = r[0]; o.y = r[65]; o.z = r[130]; o.w = r[195];
        if (nostore) asm volatile("" :: "v"(o)); else *(GAS v4u*)(dst + (size_t)(dstrow0 + n) * dstKB + k0 + 16 * q) = o; }
    LDS_WAIT(); asm volatile("" ::: "memory");
}
__device__ __forceinline__ int win_src(int c0) {
    const int pn = c0 >> 8, j = c0 & 255, half = j >> 7, jj = j & 127;
    if (pn < 3) { const int ch = pn * 128 + jj; return half == 0 ? 384 + ch : 768 + ch; }
    if (pn < 6) { const int ch = (pn - 3) * 128 + jj; return half == 0 ? 1152 + ch : 1536 + ch; }
    if (pn < 8) { const int q = (pn - 6) * 256 + j; return q < 384 ? q : 1920 + (q - 384); }
    return j < 128 ? 1920 + 128 + j : -1;
}
__device__ __forceinline__ void p0_prologue(Frame& F, const Args& A) {
    LAS float* scr = (LAS float*)(F.lds + F.wave * 8448);
    LAS unsigned* scu = (LAS unsigned*)scr;
    const int gw = F.vcu * NWAVES + F.wave, NGW = F.G * NWAVES, lane = F.lane;
    bf16* WIN = (bf16*)(F.ws + WS_WIN); bf16* WOUT = (bf16*)(F.ws + WS_WOUT); unsigned char* WGU = F.ws + WS_WGU; unsigned char* WD = F.ws + WS_WD; bf16* WRT = (bf16*)(F.ws + WS_WRT);
    constexpr int I_M = GEMM1_I8 ? NL * 36 * 8 : 0, I_A = GEMM1_I8 ? NL * 36 * 8 : NL * 16 * 36, I_B = NL * 12 * 16, I_C = NL * NE * 128, I_D = NL * NE * 64, I_E = 16, I_F = NL * 4 * 16 * 2;
    constexpr int NITEMS = I_M + I_A + I_B + I_C + I_D + I_E + I_F;
    const int lane0 = lane;
#pragma unroll 1
    for (int prep = 0; prep < ((PROBE_P0 == 1 || PROBE_P0 == 3) ? 2 : 1); ++prep)
    for (int it = gw; it < NITEMS; it += NGW) {
        int lane = lane0; asm volatile("" : "+v"(lane));
        int r = it;
        if (r < I_M) {
            const int l = r / 288, q = r % 288, cb = q >> 3, kq = q & 7, c0 = cb * 64, sc = win_src(c0), kr = lane >> 4, c4 = lane & 15;
            if (sc >= 0) { const float* sp = A.in[I_WIN] + (size_t)l * 1024 * DIN + (size_t)(kq * 128 + kr) * DIN + sc + 4 * c4;
                f32x4 vv[32];
#pragma unroll
                for (int i = 0; i < 32; ++i) vv[i] = *(const GAS f32x4*)(sp + (size_t)(4 * i) * DIN);
                f32x4 mx = (f32x4){0.f, 0.f, 0.f, 0.f};
#pragma unroll
                for (int i = 0; i < 32; ++i) { mx.x = fmaxf(mx.x, fabsf(vv[i].x)); mx.y = fmaxf(mx.y, fabsf(vv[i].y)); mx.z = fmaxf(mx.z, fabsf(vv[i].z)); mx.w = fmaxf(mx.w, fabsf(vv[i].w)); }
#pragma unroll
                for (int o = 16; o <= 32; o <<= 1) { mx.x = fmaxf(mx.x, __shfl_xor(mx.x, o)); mx.y = fmaxf(mx.y, __shfl_xor(mx.y, o)); mx.z = fmaxf(mx.z, __shfl_xor(mx.z, o)); mx.w = fmaxf(mx.w, __shfl_xor(mx.w, o)); }
                if (kr == 0) { unsigned* cm = F.ctl + CW_CMAX + l * N1 + c0 + 4 * c4;
                    __hip_atomic_fetch_max(cm + 0, __float_as_uint(mx.x), RLX_AGENT); __hip_atomic_fetch_max(cm + 1, __float_as_uint(mx.y), RLX_AGENT);
                    __hip_atomic_fetch_max(cm + 2, __float_as_uint(mx.z), RLX_AGENT); __hip_atomic_fetch_max(cm + 3, __float_as_uint(mx.w), RLX_AGENT); } }
            VM_WAIT();
            if (lane == 0) __hip_atomic_fetch_add(F.ctl + CW_CMAXCNT, 1u, RLX_AGENT);
            continue; }
        r -= I_M;
        if (r < I_C) {
            const int le = r >> 7, q = r & 127, kb = q >> 4, nb = q & 15, n0 = nb * 64, pn = n0 >> 8, half = (n0 & 255) >> 7, jj0 = n0 & 127;
            const float* src = (half ? A.in[I_WU] : A.in[I_WG]) + (size_t)le * 1024 * 512;
            tr_item64_f8<2>(src, 512, pn * 128 + jj0, WGU + (size_t)le * 1024 * 1024, 1024, n0, kb * 128, 32.0f, scu, lane, PROBE_P0 == 3 && prep == 1); continue; }
        r -= I_C;
        if (r < I_D) {
            const int le = r >> 6, q = r & 63, kb = q >> 4, nb = q & 15;
            tr_item64_f8<2>(A.in[I_WDN] + (size_t)le * 512 * 1024, 1024, nb * 64, WD + (size_t)le * 1024 * 512, 512, nb * 64, kb * 128, 32.0f, scu, lane, PROBE_P0 == 3 && prep == 1); continue; }
        r -= I_D;
        if (r < I_A) {
            if (GEMM1_I8) {
                const int l = r / 288, q = r % 288, cb = q >> 3, kb = q & 7, c0 = cb * 64, sc = win_src(c0), c4 = lane & 15;
                unsigned char* dst = F.ws + WS_WIN + (size_t)l * N1 * 1024;
                { unsigned spins = 0;
                  while (__hip_atomic_load(F.ctl + CW_CMAXCNT, RLX_AGENT) < (unsigned)I_M * ((PROBE_P0 == 1 || PROBE_P0 == 3) ? (unsigned)(prep + 1) : 1u)) { __builtin_amdgcn_s_sleep(8); if (++spins > (1u << 22)) break; } }
                if (sc >= 0) { const unsigned* cm = F.ctl + CW_CMAX + l * N1 + c0 + 4 * c4;
                    f32x4 mx; mx.x = __uint_as_float(__hip_atomic_load(cm + 0, RLX_AGENT)); mx.y = __uint_as_float(__hip_atomic_load(cm + 1, RLX_AGENT)); mx.z = __uint_as_float(__hip_atomic_load(cm + 2, RLX_AGENT)); mx.w = __uint_as_float(__hip_atomic_load(cm + 3, RLX_AGENT));
                    f32x4 cinv; cinv.x = mx.x > 0.f ? 127.f / mx.x : 0.f; cinv.y = mx.y > 0.f ? 127.f / mx.y : 0.f; cinv.z = mx.z > 0.f ? 127.f / mx.z : 0.f; cinv.w = mx.w > 0.f ? 127.f / mx.w : 0.f;
                    tr_item64_f8<2, true>(A.in[I_WIN] + (size_t)l * 1024 * DIN, DIN, sc, dst, 1024, c0, kb * 128, 1.f, scu, lane, false, cinv);
                } else { for (int qq = lane; qq < 64 * 8; qq += 64) *(GAS v4u*)(dst + (size_t)(c0 + (qq >> 3)) * 1024 + kb * 128 + (qq & 7) * 16) = (v4u){0u, 0u, 0u, 0u}; }
                continue; }
            const int l = r / 576, q = r % 576, kb = q / 36, nb = q % 36, c0 = nb * 64, sc = win_src(c0);
            bf16* dst = WIN + (size_t)l * N1 * 1024;
            if (sc >= 0) tr_item64(A.in[I_WIN] + (size_t)l * 1024 * DIN, DIN, sc, dst, 1024, c0, kb * 64, scu, lane);
            else { const int c = lane & 7;
#pragma unroll
                for (int j = 0; j < 8; ++j) { const int n = (lane >> 3) + 8 * j; *(GAS v4u*)(dst + (size_t)(c0 + n) * 1024 + kb * 64 + 8 * c) = (v4u){0u, 0u, 0u, 0u}; } }
            continue; }
        r -= I_A;
        if (r < I_B) {
            const int l = r / 192, q = r % 192, kb = q >> 4, nb = q & 15;
            if (GEMM2_FP8) tr_item64_f8<1>(A.in[I_WOUT] + (size_t)l * 1024 * 1024, 1024, nb * 64, (unsigned char*)WOUT + (size_t)l * 1024 * 1024, 1024, nb * 64, kb * 64, 32.0f, scu, lane);
            else tr_item64(A.in[I_WOUT] + (size_t)l * 1024 * 1024, 1024, nb * 64, WOUT + (size_t)l * 1024 * 1024, 1024, nb * 64, kb * 64, scu, lane);
            continue; }
        r -= I_B;
        if (r < I_E) { tr_item(A.in[I_RW], 32, 0, WRT, 1024, 0, r * 64, scr, lane); continue; }
        r -= I_E;
        {
            const int l = r >> 7, g = (r >> 5) & 3, nb = (r >> 1) & 15, cb = r & 1, n = nb * 64 + lane;
            const float* wo = A.in[I_WOUT] + (size_t)l * 1024 * 1024 + (size_t)(768 + g * 64) * 1024 + n;
            const float* ps = A.in[I_PS] + l * 256 + g * 64;
            const float* pw = A.in[I_PW] + (size_t)(l * 4 + g) * 64 * 64 + cb * 32 * 64;
#pragma unroll
            for (int i = 0; i < 8; ++i) *(LAS f32x4*)(scr + (i * 64 + lane) * 4) = *(const GAS f32x4*)(pw + (i * 64 + lane) * 4);
            float wv[64];
#pragma unroll
            for (int d = 0; d < 64; ++d) wv[d] = wo[(size_t)d * 1024] * ps[d];
            LDS_WAIT(); asm volatile("" ::: "memory");
            bf16* dst = WOUT + (size_t)l * 1024 * 1024 + (size_t)n * 1024 + 768 + g * 64 + cb * 32;
#pragma unroll 1
            for (int c2 = 0; c2 < 16; ++c2) { float o[2];
#pragma unroll
                for (int cc = 0; cc < 2; ++cc) { const LAS f32x4* pr = (const LAS f32x4*)(scr + (c2 * 2 + cc) * 64); float a = 0.f;
#pragma unroll
                    for (int d4 = 0; d4 < 16; ++d4) { const f32x4 p = pr[d4]; a += p.x * wv[4 * d4] + p.y * wv[4 * d4 + 1] + p.z * wv[4 * d4 + 2] + p.w * wv[4 * d4 + 3]; }
                    o[cc] = a; }
                if (GEMM2_FP8) *(GAS unsigned short*)((unsigned char*)WOUT + (size_t)l * 1024 * 1024 + (size_t)n * 1024 + 768 + g * 64 + cb * 32 + c2 * 2) = (unsigned short)pk4_fp8(o[0] * 32.0f, o[1] * 32.0f, 0.f, 0.f);
                else *(GAS unsigned*)(dst + c2 * 2) = pk2(o[0], o[1]); }
            LDS_WAIT(); asm volatile("" ::: "memory");
        }
    }
    bf16* HB = (bf16*)(F.ws + WS_HB);
    const float* g = A.in[I_LNIG]; const float* b = A.in[I_LNIB];
    f32x4 gv[4], bv[4];
#pragma unroll
    for (int j = 0; j < 4; ++j) { gv[j] = *(const f32x4*)(g + 4 * lane + 256 * j); bv[j] = *(const f32x4*)(b + 4 * lane + 256 * j); }
#pragma unroll 1
    for (int prep2 = 0; prep2 < ((PROBE_P0 == 2) ? 2 : 1); ++prep2)
    for (int m0 = gw * 2; m0 < T_; m0 += NGW * 2) {
        f32x4 v[2][4];
#pragma unroll
        for (int u = 0; u < 2; ++u) { const GAS f32x4* xr = (const GAS f32x4*)(A.in[I_X] + (size_t)(m0 + u) * D_) + lane;
#pragma unroll
            for (int j = 0; j < 4; ++j) v[u][j] = __builtin_nontemporal_load(xr + 64 * j); }
#pragma unroll
        for (int u = 0; u < 2; ++u) { float s = 0.f;
#pragma unroll
            for (int j = 0; j < 4; ++j) s += (v[u][j].x + v[u][j].y) + (v[u][j].z + v[u][j].w);
            const float mean = wave_sum(s) * (1.f / D_); float s2 = 0.f;
#pragma unroll
            for (int j = 0; j < 4; ++j) { v[u][j] = v[u][j] - mean; s2 += (v[u][j].x * v[u][j].x + v[u][j].y * v[u][j].y) + (v[u][j].z * v[u][j].z + v[u][j].w * v[u][j].w); }
            const float rstd = __builtin_amdgcn_rsqf(wave_sum(s2) * (1.f / D_) + LN_EPS);
            GAS v2u* o8 = (GAS v2u*)(HB + (size_t)(m0 + u) * D_) + lane;
            float amax = 0.f;
#pragma unroll
            for (int j = 0; j < 4; ++j) { const f32x4 o = v[u][j] * rstd * gv[j] + bv[j]; v[u][j] = o; v2u w; w.x = pk2(o.x, o.y); w.y = pk2(o.z, o.w); o8[64 * j] = w;
                amax = fmaxf(amax, fmaxf(fmaxf(fabsf(o.x), fabsf(o.y)), fmaxf(fabsf(o.z), fabsf(o.w)))); }
            if (GEMM1_I8) {
                amax = wave_max(amax); const float inv = amax > 0.f ? 127.f / amax : 0.f;
                GAS unsigned* q4 = (GAS unsigned*)(F.ws + WS_HQ + (size_t)(m0 + u) * D_) + lane;
#pragma unroll
                for (int j = 0; j < 4; ++j) q4[64 * j] = pk4_i8(v[u][j].x * inv, v[u][j].y * inv, v[u][j].z * inv, v[u][j].w * inv);
                if (lane == 0) ((float*)(F.ws + WS_HS))[m0 + u] = amax * (1.f / 127.f); } }
    }
}

__device__ __forceinline__ void p2_mixer(Frame& F, const Args& A, int l) {
    LAS unsigned* BV = (LAS unsigned*)F.lds;
    LAS unsigned* PB = (LAS unsigned*)(F.lds + 47616);
    LAS float* V = (LAS float*)(F.lds + 71680);
    LAS float* LGB = (LAS float*)(F.lds + 120832);
    LAS float* WA = (LAS float*)(F.lds + 123904);
    const bf16* Z = (const bf16*)(F.ws + WS_Z); bf16* Y = (bf16*)(F.ws + WS_Y);
    const float* wB = A.in[I_CBW] + l * 31 * 384; const float* bB = A.in[I_CBB] + l * 384;
    const float* lg = A.in[I_LCG] + l * 384; const float* lb = A.in[I_LCB] + l * 384; const float* wA = A.in[I_CAW] + l * 3 * 384;
    int tid = F.tid; asm volatile("" : "+v"(tid));
    const int lane = tid & 63, wave = F.wave;
    const bool convt = tid < 384; const int cp = tid % 192, tg = tid / 192;
    f32x2 w[31]; f32x2 bias = (f32x2){0.f, 0.f};
#pragma unroll
    for (int j = 0; j < 31; ++j) w[j] = (f32x2){0.f, 0.f};
    if (convt) {
#pragma unroll
        for (int j = 0; j < 31; ++j) w[j] = *(const f32x2*)(wB + j * 384 + 2 * cp);
        bias = *(const f32x2*)(bB + 2 * cp); }
    for (int q = tid; q < 384; q += 512) { LGB[q] = lg[q]; LGB[384 + q] = lb[q]; }
    for (int q = tid; q < 3 * 384; q += 512) WA[q] = wA[q];
    v4u pre[9];
#define MIX_PREFETCH(ci_, tid_) do { const int _t0 = (ci_) * 32, _s0 = _t0 & (SEQ_ - 1); \
        _Pragma("unroll") for (int _i = 0; _i < 6; ++_i) { const int _q = (tid_) + 512 * _i; const int _qq = _q < 62 * 48 ? _q : 0; const int _r = _qq / 48, _c = _qq % 48; \
            const int _rr = (_s0 - 30 + _r >= 0) ? _r : 30; pre[_i] = __builtin_nontemporal_load((const GAS v4u*)(Z + (size_t)(_t0 - 30 + _rr) * NZ + 768 + _c * 8)); } \
        _Pragma("unroll") for (int _i = 0; _i < 3; ++_i) { const int _q = (tid_) + 512 * _i; const int _qq = _q < 47 * 32 ? _q : 0; const int _r = _qq >> 5, _c = _qq & 31; \
            const int _rr = (_s0 - 15 + _r >= 0) ? _r : 15; pre[6 + _i] = __builtin_nontemporal_load((const GAS v4u*)(Z + (size_t)(_t0 - 15 + _rr) * NZ + 1152 + _c * 8)); } } while (0)
    if (F.vcu < T_ / 32) MIX_PREFETCH(F.vcu, tid);
    for (int ci = F.vcu; ci < T_ / 32; ci += F.G) {
        const int t0 = ci * 32, s0 = t0 & (SEQ_ - 1);
#pragma unroll
        for (int i = 0; i < 6; ++i) { const int q = tid + 512 * i; if (q < 62 * 48) { const int r = q / 48, c = q % 48;
            *(LAS v4u*)(BV + r * 192 + c * 4) = (s0 - 30 + r >= 0) ? pre[i] : (v4u){0u, 0u, 0u, 0u}; } }
#pragma unroll
        for (int i = 0; i < 3; ++i) { const int q = tid + 512 * i; if (q < 47 * 32) { const int r = q >> 5, c = q & 31;
            *(LAS v4u*)(PB + r * 128 + c * 4) = (s0 - 15 + r >= 0) ? pre[6 + i] : (v4u){0u, 0u, 0u, 0u}; } }
        __syncthreads();
        { int cn = ci + F.G; asm volatile("" : "+s"(cn)); int tidp = tid; asm volatile("" : "+v"(tidp));
          if (cn < T_ / 32) MIX_PREFETCH(cn, tidp); }
        if (PROBE_MIX == 3) { int cn = ci + F.G; asm volatile("" : "+s"(cn)); int tidp = tid; asm volatile("" : "+v"(tidp));
          if (cn < T_ / 32) { v4u sink[9]; const int _t0 = cn * 32;
#pragma unroll
              for (int i = 0; i < 6; ++i) { const int q = tidp + 512 * i, qq = q < 62 * 48 ? q : 0, r = qq / 48, c = qq % 48; sink[i] = *(const GAS v4u*)(Z + (size_t)(_t0 + r) * NZ + 768 + c * 8 + 8); }
#pragma unroll
              for (int i = 0; i < 3; ++i) { const int q = tidp + 512 * i, qq = q < 47 * 32 ? q : 0, r = qq >> 5, c = qq & 31; sink[6 + i] = *(const GAS v4u*)(Z + (size_t)(_t0 + r) * NZ + 1152 + c * 8); }
#pragma unroll
              for (int i = 0; i < 9; ++i) asm volatile("" :: "v"(sink[i])); } }
#pragma unroll 1
        for (int prep = 0; prep < ((PROBE_MIX == 1) ? 2 : 1); ++prep)
        if (convt) {
#pragma unroll 1
            for (int hh = 0; hh < 2; ++hh) { const int tb = tg * 16 + hh * 8;
                f32x2 x[38];
#pragma unroll
                for (int i = 0; i < 38; ++i) { const unsigned u = BV[(tb + i) * 192 + cp]; x[i] = (f32x2){bflo(u), bfhi(u)}; }
#pragma unroll
                for (int tt = 0; tt < 8; ++tt) { f32x2 a = bias;
#pragma unroll
                    for (int j = 0; j < 31; ++j) a += w[j] * x[tt + j];
                    *(LAS f32x2*)(V + (tb + tt) * 384 + 2 * cp) = a; }
            }
        } else {
            const int p = tid - 384, g = p >> 5, wd = 2 << g;
            f32x2 s = (f32x2){0.f, 0.f};
            for (int i = 1; i < wd; ++i) { const unsigned u = PB[(15 - i) * 128 + p]; s += (f32x2){bflo(u), bfhi(u)}; }
#pragma unroll 1
            for (int blk = 0; blk < 4; ++blk) {
                unsigned xr[23];
#pragma unroll
                for (int i = 0; i < 23; ++i) xr[i] = PB[(8 * blk + i) * 128 + p];
#pragma unroll
                for (int j = 0; j < 8; ++j) { const int tt = 8 * blk + j; const f32x2 xv = (f32x2){bflo(xr[15 + j]), bfhi(xr[15 + j])};
                    s += xv; const int n = (s0 + tt + 1) < wd ? (s0 + tt + 1) : wd; const float inv = __builtin_amdgcn_rcpf((float)n);
                    const f32x2 dd = s * inv - xv;
                    if (GEMM2_FP8) *(GAS unsigned short*)((unsigned char*)Y + (size_t)(t0 + tt) * D_ + 768 + 2 * p) = (unsigned short)pk4_fp8(dd.x, dd.y, 0.f, 0.f);
                    else *(GAS unsigned*)(Y + (size_t)(t0 + tt) * D_ + 768 + 2 * p) = pk2(dd.x, dd.y);
                    const unsigned u2 = xr[15 + j - 1], u4 = xr[15 + j - 3], u8 = xr[15 + j - 7], u16 = xr[j];
                    const unsigned uo = g == 0 ? u2 : (g == 1 ? u4 : (g == 2 ? u8 : u16));
                    s -= (f32x2){bflo(uo), bfhi(uo)}; }
            }
        }
        __syncthreads();
        v4u ya[3][4];
        int t0o = t0; asm volatile("" : "+s"(t0o));
        int tidl = tid; asm volatile("" : "+v"(tidl));
#pragma unroll
        for (int i = 0; i < 3; ++i) { const int q = tidl + 512 * i, tt = q / 48, o8 = q % 48, pos = (t0o & (SEQ_ - 1)) + tt; const size_t row = (size_t)(t0o + tt);
            ya[i][0] = __builtin_nontemporal_load((const GAS v4u*)(Z + row * NZ + o8 * 8));
            ya[i][1] = *(const GAS v4u*)(Z + row * NZ + 384 + o8 * 8);
            ya[i][2] = *(const GAS v4u*)(Z + (row - (pos >= 1 ? 1 : 0)) * NZ + 384 + o8 * 8);
            ya[i][3] = *(const GAS v4u*)(Z + (row - (pos >= 2 ? 2 : 0)) * NZ + 384 + o8 * 8); }
#pragma unroll
        for (int tk = 0; tk < 4; ++tk) { const int tt = wave * 4 + tk;
            f32x2 v[3]; float s = 0.f;
#pragma unroll
            for (int i = 0; i < 3; ++i) { v[i] = *(const LAS f32x2*)(V + tt * 384 + 2 * lane + 128 * i); s += v[i].x + v[i].y; }
            const float mean = wave_sum(s) * (1.f / 384.f); float q = 0.f;
#pragma unroll
            for (int i = 0; i < 3; ++i) { v[i] = v[i] - mean; q += v[i].x * v[i].x + v[i].y * v[i].y; }
            const float rstd = __builtin_amdgcn_rsqf(wave_sum(q) * (1.f / 384.f) + LN_EPS);
#pragma unroll
            for (int i = 0; i < 3; ++i) { const int c = 2 * lane + 128 * i; const f32x2 gg = *(const LAS f32x2*)(LGB + c), bb = *(const LAS f32x2*)(LGB + 384 + c);
                f32x2 o = v[i] * rstd * gg + bb; o.x = o.x * sigmoidf_(o.x); o.y = o.y * sigmoidf_(o.y);
                if (GEMM2_FP8) *(GAS unsigned short*)((unsigned char*)Y + (size_t)(t0 + tt) * D_ + 384 + c) = (unsigned short)pk4_fp8(o.x, o.y, 0.f, 0.f);
                else *(GAS unsigned*)(Y + (size_t)(t0 + tt) * D_ + 384 + c) = pk2(o.x, o.y); }
        }
#pragma unroll
        for (int i = 0; i < 3; ++i) { const int q = tid + 512 * i, tt = q / 48, o8 = q % 48, pos = s0 + tt; const size_t row = (size_t)(t0 + tt);
            const v4u gb = ya[i][0], x0 = ya[i][1]; v4u x1 = ya[i][2], x2 = ya[i][3];
            if (pos < 1) x1 = (v4u){0u, 0u, 0u, 0u};
            if (pos < 2) x2 = (v4u){0u, 0u, 0u, 0u};
            const LAS f32x4* wp = (const LAS f32x4*)(WA + o8 * 8);
            const f32x4 w0a = wp[0], w0b = wp[1], w1a = wp[96], w1b = wp[97], w2a = wp[192], w2b = wp[193];
            float o[8];
            const unsigned gbw[4] = {gb.x, gb.y, gb.z, gb.w}, x0w[4] = {x0.x, x0.y, x0.z, x0.w}, x1w[4] = {x1.x, x1.y, x1.z, x1.w}, x2w[4] = {x2.x, x2.y, x2.z, x2.w};
            const float w2[8] = {w2a.x, w2a.y, w2a.z, w2a.w, w2b.x, w2b.y, w2b.z, w2b.w}, w1[8] = {w1a.x, w1a.y, w1a.z, w1a.w, w1b.x, w1b.y, w1b.z, w1b.w}, w0[8] = {w0a.x, w0a.y, w0a.z, w0a.w, w0b.x, w0b.y, w0b.z, w0b.w};
#pragma unroll
            for (int e = 0; e < 4; ++e) {
                o[2 * e] = bflo(gbw[e]) * (w2[2 * e] * bflo(x0w[e]) + w1[2 * e] * bflo(x1w[e]) + w0[2 * e] * bflo(x2w[e]));
                o[2 * e + 1] = bfhi(gbw[e]) * (w2[2 * e + 1] * bfhi(x0w[e]) + w1[2 * e + 1] * bfhi(x1w[e]) + w0[2 * e + 1] * bfhi(x2w[e])); }
            if (GEMM2_FP8) { v2u ov; ov.x = pk4_fp8(o[0], o[1], o[2], o[3]); ov.y = pk4_fp8(o[4], o[5], o[6], o[7]); *(GAS v2u*)((unsigned char*)Y + row * D_ + o8 * 8) = ov; }
            else { v4u ov; ov.x = pk2(o[0], o[1]); ov.y = pk2(o[2], o[3]); ov.z = pk2(o[4], o[5]); ov.w = pk2(o[6], o[7]);
            *(GAS v4u*)(Y + row * D_ + o8 * 8) = ov; } }
        __syncthreads();
    }
#undef MIX_PREFETCH
}

__device__ __forceinline__ void top2of4(float q0, float q1, float q2, float q3, float& a1, int& i1, float& a2, int& i2) {
    a1 = q0; i1 = 0; a2 = -1.f; i2 = 1;
#define T2STEP(qv, r) { const bool gt = (qv) > a1; const bool g2 = (qv) > a2; const float na2 = gt ? a1 : (g2 ? (qv) : a2); const int ni2 = gt ? i1 : (g2 ? (r) : i2); \
        a1 = gt ? (qv) : a1; i1 = gt ? (r) : i1; a2 = na2; i2 = ni2; }
    T2STEP(q1, 1) T2STEP(q2, 2) T2STEP(q3, 3)
#undef T2STEP
}
__device__ __forceinline__ void p4_ln_router(Frame& F, const Args& A, int l) {
    LAS unsigned char* lds = F.lds;
    LAS int* cntl = (LAS int*)(lds + 66048); LAS int* basel = cntl + 32; LAS int* sel = cntl + 64; LAS int* lpos = cntl + 64 + 256;
    const bf16* U = (const bf16*)(F.ws + WS_U); bf16* HB = (bf16*)(F.ws + WS_HB); unsigned char* H8 = F.ws + WS_H8; const bf16* WRT = (const bf16*)(F.ws + WS_WRT);
    int* route = (int*)(F.ws + WS_ROUTE); int* lists = (int*)(F.ws + WS_LISTS);
    unsigned* counts = F.ctl + CW_CNT + l * 32 * 64;
    const float* g = A.in[I_LMG] + l * D_; const float* b = A.in[I_LMB] + l * D_; const float* rb = A.in[I_RB];
    int tid = F.tid; asm volatile("" : "+v"(tid));
    const int lane = tid & 63, wave = F.wave, fr = lane & 15, fq = lane >> 4;
    for (int q = tid; q < 32 * 128; q += 512) { const int e = q >> 7, c = q & 127; *(LAS v4u*)(lds + e * 2064 + c * 16) = *(const GAS v4u*)(WRT + e * 1024 + c * 8); }
    if (tid < 32) cntl[tid] = 0;
    f32x4 gv[4], bv[4];
#pragma unroll
    for (int j = 0; j < 4; ++j) { gv[j] = *(const f32x4*)(g + 4 * lane + 256 * j); bv[j] = *(const f32x4*)(b + 4 * lane + 256 * j); }
    __syncthreads();
    for (int blk = F.vcu; blk < T_ / 128; blk += F.G) {
        v2u q[2][4][4];
        { const size_t m = (size_t)(blk * 128 + wave * 16);
#pragma unroll
          for (int u = 0; u < 4; ++u) { const GAS v2u* up = (const GAS v2u*)(U + (m + u) * D_) + lane;
#pragma unroll
              for (int j = 0; j < 4; ++j) q[0][u][j] = up[64 * j]; } }
#pragma unroll
        for (int b = 0; b < 4; ++b) { const size_t m = (size_t)(blk * 128 + wave * 16 + b * 4);
            if (b < 3) {
#pragma unroll
                for (int u = 0; u < 4; ++u) { const GAS v2u* up = (const GAS v2u*)(U + (m + 4 + u) * D_) + lane;
#pragma unroll
                    for (int j = 0; j < 4; ++j) q[(b + 1) & 1][u][j] = up[64 * j]; }
                asm volatile("" ::: "memory"); }
#pragma unroll
            for (int u = 0; u < 4; ++u) { f32x4 v[4]; float s = 0.f;
#pragma unroll
                for (int j = 0; j < 4; ++j) { const v2u qq = q[b & 1][u][j]; v[j] = (f32x4){bflo(qq.x), bfhi(qq.x), bflo(qq.y), bfhi(qq.y)}; s += (v[j].x + v[j].y) + (v[j].z + v[j].w); }
                const float mean = wave_sum(s) * (1.f / D_); float s2 = 0.f;
#pragma unroll
                for (int j = 0; j < 4; ++j) { v[j] = v[j] - mean; s2 += (v[j].x * v[j].x + v[j].y * v[j].y) + (v[j].z * v[j].z + v[j].w * v[j].w); }
                const float rstd = __builtin_amdgcn_rsqf(wave_sum(s2) * (1.f / D_) + LN_EPS);
                GAS v2u* o8 = (GAS v2u*)(HB + (m + u) * D_) + lane; GAS unsigned* o4 = (GAS unsigned*)(H8 + (m + u) * D_) + lane;
#pragma unroll
                for (int j = 0; j < 4; ++j) { const f32x4 o = v[j] * rstd * gv[j] + bv[j]; v2u w; w.x = pk2(o.x, o.y); w.y = pk2(o.z, o.w); o8[64 * j] = w; o4[64 * j] = pk4_fp8(o.x, o.y, o.z, o.w); } }
        }
        VM_WAIT(); asm volatile("" ::: "memory");
        const int token = blk * 128 + wave * 16 + fr;
        f32x4 acc0 = (f32x4){0.f, 0.f, 0.f, 0.f}, acc1 = (f32x4){0.f, 0.f, 0.f, 0.f};
        const bf16* hrow = HB + (size_t)token * D_ + fq * 8;
#pragma unroll 16
        for (int k = 0; k < 32; ++k) { const int kk = k * 32 + fq * 8;
            const bf16x8 hf = *(const GAS bf16x8*)(hrow + k * 32);
            const bf16x8 w0 = *(const LAS bf16x8*)(lds + fr * 2064 + kk * 2), w1 = *(const LAS bf16x8*)(lds + (16 + fr) * 2064 + kk * 2);
            acc0 = __builtin_amdgcn_mfma_f32_16x16x32_bf16(w0, hf, acc0, 0, 0, 0);
            acc1 = __builtin_amdgcn_mfma_f32_16x16x32_bf16(w1, hf, acc1, 0, 0, 0);
        }
        float p0[4], p1[4]; float mx = -3.0e38f;
#pragma unroll
        for (int r = 0; r < 4; ++r) { p0[r] = acc0[r] + rb[4 * fq + r]; p1[r] = acc1[r] + rb[16 + 4 * fq + r]; mx = fmaxf(mx, fmaxf(p0[r], p1[r])); }
        mx = fmaxf(mx, __shfl_xor(mx, 16)); mx = fmaxf(mx, __shfl_xor(mx, 32));
#pragma unroll
        for (int r = 0; r < 4; ++r) { p0[r] = __expf(p0[r] - mx); p1[r] = __expf(p1[r] - mx); }
        float a1, a2, c1, c2; int ia1, ia2, ic1, ic2;
        top2of4(p0[0], p0[1], p0[2], p0[3], a1, ia1, a2, ia2); top2of4(p1[0], p1[1], p1[2], p1[3], c1, ic1, c2, ic2);
        const float sc0 = a1 + a2, sc1 = c1 + c2;
        float bs = sc0; int bg = fq; if (sc1 > sc0) { bs = sc1; bg = 4 + fq; }
#pragma unroll
        for (int off = 16; off <= 32; off <<= 1) { const float os = __shfl_xor(bs, off); const int og = __shfl_xor(bg, off); if (os > bs || (os == bs && og < bg)) { bs = os; bg = og; } }
        if ((bg & 3) == fq) {
            const bool hi = bg >= 4;
            const float pa = hi ? c1 : a1, pb = hi ? c2 : a2; const int ia = hi ? ic1 : ia1, ib = hi ? ic2 : ia2;
            const int ea = bg * 4 + ia, eb = bg * 4 + ib; const float inv = 1.0f / (pa + pb);
            const int tokl = wave * 16 + fr;
            const int la = atomicAdd((int*)&cntl[ea], 1), lb2 = atomicAdd((int*)&cntl[eb], 1);
            sel[tokl * 2] = ea; sel[tokl * 2 + 1] = eb; lpos[tokl * 2] = la; lpos[tokl * 2 + 1] = lb2;
            int* rt = route + (size_t)token * 8; rt[0] = ea; rt[2] = eb; rt[4] = __float_as_int(pa * inv); rt[5] = __float_as_int(pb * inv);
        }
        __syncthreads();
        if (tid < 32) { const int c = cntl[tid]; basel[tid] = c ? (int)__hip_atomic_fetch_add(counts + tid * 64, (unsigned)c, RLX_AGENT) : 0; }
        __syncthreads();
        if (tid < 256) { const int tokl = tid >> 1, k = tid & 1, e = sel[tid], pos = basel[e] + lpos[tid], tok = blk * 128 + tokl;
            lists[(size_t)e * 65536 + pos] = tok * 2 + k; route[(size_t)tok * 8 + 1 + 2 * k] = pos; }
        __syncthreads();
        if (tid < 32) cntl[tid] = 0;
        __syncthreads();
    }
}

__device__ __forceinline__ void moe_table(Frame& F, int l) {
    LAS int* tab = (LAS int*)(F.lds + TAB_OFF);
    __syncthreads();
    if (F.tid < 32) tab[40 + F.tid] = (int)__hip_atomic_load(F.ctl + CW_CNT + (l * 32 + F.tid) * 64, RLX_AGENT);
    __syncthreads();
    if (F.tid == 0) { int s = 0; for (int e = 0; e < 32; ++e) { tab[e] = s; s += (tab[40 + e] + 255) >> 8; } tab[32] = s; }
    __syncthreads();
    for (int t = F.tid; t < tab[32]; t += NWAVES * 64) { int e = 0; while (e < 31 && tab[e + 1] <= t) ++e; tab[80 + t] = e; }
    __syncthreads();
}

__device__ __forceinline__ void p7_combine_ln(Frame& F, const Args& A, int l) {
    const LAS int* tab = (const LAS int*)(F.lds + TAB_OFF);
    bf16* HB = (bf16*)(F.ws + WS_HB); const unsigned char* Y2S = F.ws + WS_Y2S; const int* route = (const int*)(F.ws + WS_ROUTE);
    const float* g = A.in[I_LFG] + l * D_; const float* b = A.in[I_LFB] + l * D_;
    int lane = F.lane; asm volatile("" : "+v"(lane));
    const int gw = F.vcu * NWAVES + F.wave, NGW = F.G * NWAVES;
    f32x4 gv[4], bv[4];
#pragma unroll
    for (int j = 0; j < 4; ++j) { gv[j] = *(const f32x4*)(g + 4 * lane + 256 * j); bv[j] = *(const f32x4*)(b + 4 * lane + 256 * j); }
    const bool last = (l == NL - 1);
    const int step = NGW * 2;
    int R[2][6], Rn[2][6];
    v2u hq[2][4], hn[2][4]; unsigned aq[2][4], cq[2][4], an[2][4], cn[2][4];
#define P7_ROUTE(m0_, R_) do { _Pragma("unroll") for (int _u = 0; _u < 2; ++_u) { const int* _rt = route + (size_t)((m0_) + _u) * 8; \
        _Pragma("unroll") for (int _k = 0; _k < 6; ++_k) R_[_u][_k] = _rt[_k]; } } while (0)
#define P7_ROWS(m0_, R_, hq_, aq_, cq_) do { _Pragma("unroll") for (int _u = 0; _u < 2; ++_u) { const int _m = (m0_) + _u; \
        const size_t _r0 = (size_t)tab[R_[_u][0]] * 256 + R_[_u][1], _r1 = (size_t)tab[R_[_u][2]] * 256 + R_[_u][3]; \
        const GAS v2u* _hp = (const GAS v2u*)(HB + (size_t)_m * D_) + lane; const GAS unsigned* _ya = (const GAS unsigned*)(Y2S + _r0 * D_) + lane; const GAS unsigned* _yb = (const GAS unsigned*)(Y2S + _r1 * D_) + lane; \
        _Pragma("unroll") for (int _j = 0; _j < 4; ++_j) { hq_[_u][_j] = _hp[64 * _j]; aq_[_u][_j] = _ya[64 * _j]; cq_[_u][_j] = _yb[64 * _j]; } } } while (0)
    int m0 = gw * 2;
    if (m0 < T_) { P7_ROUTE(m0, R); P7_ROWS(m0, R, hq, aq, cq); if (m0 + step < T_) P7_ROUTE(m0 + step, Rn); }
    for (; m0 < T_; m0 += step) {
        const bool has_n = m0 + step < T_;
        int Rnn[2][6];
        if (has_n) P7_ROWS(m0 + step, Rn, hn, an, cn);
        if (m0 + 2 * step < T_) P7_ROUTE(m0 + 2 * step, Rnn);
#pragma unroll
        for (int u = 0; u < 2; ++u) { const int m = m0 + u; f32x4 v[4]; float s = 0.f; const float g0 = __int_as_float(R[u][4]), g1 = __int_as_float(R[u][5]);
#pragma unroll
            for (int j = 0; j < 4; ++j) { const v2u h = hq[u][j]; const unsigned a = aq[u][j], c = cq[u][j];
                const f32x2 a01 = __builtin_amdgcn_cvt_pk_f32_fp8((int)a, false), a23 = __builtin_amdgcn_cvt_pk_f32_fp8((int)a, true), c01 = __builtin_amdgcn_cvt_pk_f32_fp8((int)c, false), c23 = __builtin_amdgcn_cvt_pk_f32_fp8((int)c, true);
                v[j].x = ALPHA * bflo(h.x) + g0 * a01.x + g1 * c01.x; v[j].y = ALPHA * bfhi(h.x) + g0 * a01.y + g1 * c01.y;
                v[j].z = ALPHA * bflo(h.y) + g0 * a23.x + g1 * c23.x; v[j].w = ALPHA * bfhi(h.y) + g0 * a23.y + g1 * c23.y;
                s += (v[j].x + v[j].y) + (v[j].z + v[j].w); }
            const float mean = wave_sum(s) * (1.f / D_); float s2 = 0.f;
#pragma unroll
            for (int j = 0; j < 4; ++j) { v[j] = v[j] - mean; s2 += (v[j].x * v[j].x + v[j].y * v[j].y) + (v[j].z * v[j].z + v[j].w * v[j].w); }
            const float rstd = __builtin_amdgcn_rsqf(wave_sum(s2) * (1.f / D_) + LN_EPS);
            if (last) { GAS f32x4* o = (GAS f32x4*)(A.out + (size_t)m * D_) + lane;
#pragma unroll
                for (int j = 0; j < 4; ++j) o[64 * j] = v[j] * rstd * gv[j] + bv[j];
            } else { GAS v2u* o8 = (GAS v2u*)(HB + (size_t)m * D_) + lane; float amax = 0.f;
#pragma unroll
                for (int j = 0; j < 4; ++j) { const f32x4 o = v[j] * rstd * gv[j] + bv[j]; v[j] = o; v2u w; w.x = pk2(o.x, o.y); w.y = pk2(o.z, o.w); o8[64 * j] = w;
                    amax = fmaxf(amax, fmaxf(fmaxf(fabsf(o.x), fabsf(o.y)), fmaxf(fabsf(o.z), fabsf(o.w)))); }
                if (GEMM1_I8) { amax = wave_max(amax); const float inv = amax > 0.f ? 127.f / amax : 0.f;
                    GAS unsigned* q4 = (GAS unsigned*)(F.ws + WS_HQ + (size_t)m * D_) + lane;
#pragma unroll
                    for (int j = 0; j < 4; ++j) q4[64 * j] = pk4_i8(v[j].x * inv, v[j].y * inv, v[j].z * inv, v[j].w * inv);
                    if (lane == 0) ((float*)(F.ws + WS_HS))[m] = amax * (1.f / 127.f); } }
        }
#pragma unroll
        for (int u = 0; u < 2; ++u) {
#pragma unroll
            for (int j = 0; j < 4; ++j) { hq[u][j] = hn[u][j]; aq[u][j] = an[u][j]; cq[u][j] = cn[u][j]; }
#pragma unroll
            for (int k = 0; k < 6; ++k) { R[u][k] = Rn[u][k]; Rn[u][k] = Rnn[u][k]; } }
    }
#undef P7_ROUTE
#undef P7_ROWS
}

#ifndef PH_NOINLINE
#define PH_NOINLINE __forceinline__
#endif
PH_NOINLINE __device__ void run_gemm1(LAS unsigned char* lds, unsigned char* ws, int l, int G, int c) {
    pg8::DenseOrder S;
    if (GEMM1_I8) { S.init(ws + WS_HQ, ws + WS_WIN + (size_t)l * N1 * 1024, T_, N1, D_ / 2, G, c, 1);
        pg8::EpiZq E{(bf16*)(ws + WS_Z), (const float*)(ws + WS_HS), (const float*)((unsigned*)(ws + WS_CTL) + CW_CMAX) + l * N1}; pg8::gemm_phase<pg8::EpiZq, pg8::DenseOrder, 2>(lds, S, E); }
    else { S.init(ws + WS_HB, ws + WS_WIN + (size_t)l * N1 * 1024 * 2, T_, N1, D_, G, c, 1); pg8::EpiZ E{(bf16*)(ws + WS_Z)}; pg8::gemm_phase(lds, S, E); }
}
PH_NOINLINE __device__ void run_gemm_probe(LAS unsigned char* lds, unsigned char* ws, int G, int c) {
    pg8::DenseOrder S; S.init(ws + WS_HB, ws + WS_WIN, T_, 256 * (PROBE_EXTRA_NN ? PROBE_EXTRA_NN : 1), D_, G, c);
    pg8::EpiPlain E{(bf16*)(ws + WS_Y), 2048};
    pg8::gemm_phase(lds, S, E);
}
PH_NOINLINE __device__ void run_gemm2(LAS unsigned char* lds, unsigned char* ws, int l, int G, int c) {
    pg8::EpiU E{(const bf16*)(ws + WS_HB), (bf16*)(ws + WS_U)};
    if (GEMM2_FP8) { pg8::DenseRowsOrder S; int kq = D_ / 2; asm volatile("" : "+s"(kq)); S.init(ws + WS_Y, ws + WS_WOUT + (size_t)l * 1024 * 1024, T_, D_, kq, G, c); pg8::gemm_phase<pg8::EpiU, pg8::DenseRowsOrder, true>(lds, S, E); }
    else { pg8::DenseOrder S; S.init(ws + WS_Y, ws + WS_WOUT + (size_t)l * 1024 * 1024 * 2, T_, D_, D_, G, c); pg8::gemm_phase(lds, S, E); }
}
PH_NOINLINE __device__ void run_gemm5(LAS unsigned char* lds, unsigned char* ws, int l, int G, int c) {
    const LAS int* tab = (const LAS int*)(lds + TAB_OFF);
    pg8::MoeGatherOrder S; S.A = (const char*)(ws + WS_H8); S.Bt = (const char*)(ws + WS_WGU + (size_t)l * NE * 1024 * 1024); S.bexp = (size_t)1024 * 1024;
    int kq = D_ / 2; asm volatile("" : "+s"(kq));
    S.K = kq; S.nN = 4; S.nwg = tab[32] * 4; S.G = G; S.c = c; S.tab = tab; S.lists = (const int*)(ws + WS_LISTS);
    pg8::EpiHid E{ws + WS_HID};
    pg8::gemm_phase<pg8::EpiHid, pg8::MoeGatherOrder, true>(lds, S, E);
}
PH_NOINLINE __device__ void run_gemm6(LAS unsigned char* lds, unsigned char* ws, int l, int G, int c) {
    const LAS int* tab = (const LAS int*)(lds + TAB_OFF);
    pg8::MoeRowsOrder S; S.A = (const char*)(ws + WS_HID); S.Bt = (const char*)(ws + WS_WD + (size_t)l * NE * 1024 * 512); S.bexp = (size_t)1024 * 512;
    int kq = DE / 2; asm volatile("" : "+s"(kq));
    S.K = kq; S.nN = 4; S.nwg = tab[32] * 4; S.G = G; S.c = c; S.tab = tab; S.lists = nullptr;
    pg8::EpiPlain8 E{ws + WS_Y2S, D_};
    pg8::gemm_phase<pg8::EpiPlain8, pg8::MoeRowsOrder, true>(lds, S, E);
}

__global__ void __launch_bounds__(NWAVES * 64, 2) mk_fwd(Args args) {
    extern __shared__ __attribute__((aligned(16))) unsigned char lds_raw[];
    Frame F;
    F.lds = (LAS unsigned char*)lds_raw;
    F.tid = threadIdx.x; F.lane = F.tid & 63; F.wave = __builtin_amdgcn_readfirstlane(F.tid >> 6);
    F.G = gridDim.x; { const int bx = blockIdx.x; F.vcu = (F.G % 8 == 0) ? (bx % 8) * (F.G / 8) + bx / 8 : bx; }
    F.ws = args.ws; F.ctl = (unsigned*)(args.ws + WS_CTL);
    for (int u = F.tid; u < (LDS_BYTES - LDSCTL_OFF) / 4; u += NWAVES * 64) ((LAS unsigned*)(F.lds + LDSCTL_OFF))[u] = 0u;
    __syncthreads();
    volatile LAS unsigned* MISC = (volatile LAS unsigned*)(F.lds + MISC_OFF);
    XcdBarrier bar; bar.bar = F.ctl + CW_BAR; bar.x = 0; bar.st = nullptr;
    if (MK_N_LAUNCHES == 1) bar = xcd_barrier_post(F.ctl + CW_BAR, MISC + 8);
    const int lo = args.ph_lo, hi = args.ph_hi;
#define IN(k) (lo <= (k) && (k) < hi)
#define SEAM(k) do { if (MK_N_LAUNCHES == 1 && (k) + 1 < hi) xcd_barrier(bar); } while (0)
    if (REPEAT_MASK & 256) { for (int rep = 0; rep < 10; ++rep) xcd_barrier(bar); }
    if ((PH_MASK & 1) && IN(0)) { for (int rep = 0; rep < ((REPEAT_MASK & 1) ? 2 : 1); ++rep) { p0_prologue(F, args); SEAM(0); } }
#pragma unroll 1
    for (int l = 0; l < NL; ++l) {
        const int pb = 1 + 7 * l;
        if ((PH_MASK & 2) && IN(pb + 0)) { for (int rep = 0; rep < ((REPEAT_MASK & 2) ? 2 : 1); ++rep) { run_gemm1(F.lds, F.ws, l, F.G, (int)blockIdx.x); SEAM(pb + 0); }
            if (PROBE_EXTRA_NN && l == 0) { run_gemm_probe(F.lds, F.ws, F.G, (int)blockIdx.x); xcd_barrier(bar); } }
        if ((PH_MASK & 4) && IN(pb + 1)) { for (int rep = 0; rep < ((REPEAT_MASK & 4) ? 2 : 1); ++rep) { p2_mixer(F, args, l); SEAM(pb + 1); } }
        if ((PH_MASK & 8) && IN(pb + 2)) { for (int rep = 0; rep < ((REPEAT_MASK & 8) ? 2 : 1); ++rep) { run_gemm2(F.lds, F.ws, l, F.G, (int)blockIdx.x); SEAM(pb + 2); } }
        if ((PH_MASK & 16) && IN(pb + 3)) {
            if (REPEAT_MASK & 16) { p4_ln_router(F, args, l); SEAM(pb + 3);
                if (blockIdx.x == 0 && F.tid < 32) __hip_atomic_store(F.ctl + CW_CNT + (l * 32 + F.tid) * 64, 0u, RLX_AGENT);
                SEAM(pb + 3); }
            p4_ln_router(F, args, l); SEAM(pb + 3); }
        if ((PH_MASK & 32) && IN(pb + 4)) { for (int rep = 0; rep < ((REPEAT_MASK & 32) ? 2 : 1); ++rep) { moe_table(F, l); run_gemm5(F.lds, F.ws, l, F.G, (int)blockIdx.x); SEAM(pb + 4); } }
        if ((PH_MASK & 64) && IN(pb + 5)) { for (int rep = 0; rep < ((REPEAT_MASK & 64) ? 2 : 1); ++rep) { if (MK_N_LAUNCHES != 1 || rep) moe_table(F, l); run_gemm6(F.lds, F.ws, l, F.G, (int)blockIdx.x); SEAM(pb + 5); } }
        if ((PH_MASK & 128) && IN(pb + 6)) { for (int rep = 0; rep < (((REPEAT_MASK & 128) && l == NL - 1) ? 2 : 1); ++rep) { if (MK_N_LAUNCHES != 1) moe_table(F, l); p7_combine_ln(F, args, l); if (rep == 0) SEAM(pb + 6); else xcd_barrier(bar); } }
    }
#undef IN
#undef SEAM
}

extern "C" void kernel_launch(void* const* d_in, const int* in_sizes, int n_in, void* d_out, int out_size, void* d_ws, size_t ws_size, hipStream_t stream) {
    static int grid = 0;
    if (grid == 0) {
        if (n_in != 21 || out_size != T_ * D_ || ws_size < WS_END) { fprintf(stderr, "kernel_launch: unexpected problem (n_in %d, out %d, ws %zu); nothing launched\n", n_in, out_size, ws_size); grid = -1; return; }
        int dev = 0, cus = 0, per_cu = 0;
        if (hipGetDevice(&dev) != hipSuccess || hipDeviceGetAttribute(&cus, hipDeviceAttributeMultiprocessorCount, dev) != hipSuccess) { grid = -1; return; }
        if (hipFuncSetAttribute((const void*)mk_fwd, hipFuncAttributeMaxDynamicSharedMemorySize, LDS_BYTES) != hipSuccess) { fprintf(stderr, "kernel_launch: hipFuncSetAttribute failed\n"); grid = -1; return; }
        if (hipOccupancyMaxActiveBlocksPerMultiprocessor(&per_cu, (const void*)mk_fwd, NWAVES * 64, LDS_BYTES) != hipSuccess || per_cu < 1) { fprintf(stderr, "kernel_launch: occupancy query says %d\n", per_cu); }
        (void)hipGetLastError();
        grid = cus;
    }
    if (grid < 0) return;
    (void)hipMemsetAsync((char*)d_ws + WS_CTL, 0, CTL_ZERO_BYTES, stream);
    Args a{};
    for (int i = 0; i < 21; ++i) a.in[i] = (const float*)d_in[i];
    a.out = (float*)d_out; a.ws = (unsigned char*)d_ws;
    if (MK_N_LAUNCHES == 1) { a.ph_lo = 0; a.ph_hi = NPH; hipLaunchKernelGGL(mk_fwd, dim3(grid), dim3(NWAVES * 64), LDS_BYTES, stream, a); }
    else for (int p = 0; p < NPH; ++p) { a.ph_lo = p; a.ph_hi = p + 1; hipLaunchKernelGGL(mk_fwd, dim3(grid), dim3(NWAVES * 64), LDS_BYTES, stream, a); }
}
```

```cpp
#include <hip/hip_runtime.h>
#include <cstdio>
#include <cstdint>

#ifndef MK_N_LAUNCHES
#define MK_N_LAUNCHES 1
#endif
#ifndef PH_MASK
#define PH_MASK 0xff
#endif
#ifndef REPEAT_MASK
#define REPEAT_MASK 0
#endif
#ifndef GEMM1_I8
#define GEMM1_I8 1
#endif
#ifndef GEMM2_FP8
#define GEMM2_FP8 1
#endif
#ifndef PROBE_P0
#define PROBE_P0 0
#endif
#ifndef PROBE_MIX
#define PROBE_MIX 0
#endif
#ifndef RESID_I8
#define RESID_I8 1
#endif
#ifndef U_I8
#define U_I8 1
#endif
#ifndef NO_HB1
#define NO_HB1 1
#endif
#ifndef PROBE_EXTRA_NN
#define PROBE_EXTRA_NN 0
#endif
#ifndef GEMM_SIMPLE_MASK
#define GEMM_SIMPLE_MASK 0
#endif

#define GAS __attribute__((address_space(1)))
#define LAS __attribute__((address_space(3)))
typedef unsigned short bf16;
typedef unsigned v4u __attribute__((ext_vector_type(4)));
typedef unsigned v2u __attribute__((ext_vector_type(2)));
typedef float f32x4 __attribute__((ext_vector_type(4)));
typedef float f32x2 __attribute__((ext_vector_type(2)));
typedef short bf16x8 __attribute__((ext_vector_type(8)));
#define RLX_AGENT __ATOMIC_RELAXED, __HIP_MEMORY_SCOPE_AGENT
#define LDS_WAIT() asm volatile("s_waitcnt lgkmcnt(0)" ::: "memory")
#define VM_WAIT() asm volatile("s_waitcnt vmcnt(0)" ::: "memory")

constexpr int T_ = 32768, D_ = 1024, SEQ_ = 4096, NL = 2, NE = 32, DE = 512;
constexpr int DIN = 2176, N1 = 2304, NZ = 1408;
constexpr float ALPHA = 1.41421356237f, LN_EPS = 1e-5f;
constexpr int NPH = 1 + 7 * NL;

constexpr size_t MiB = 1u << 20;
constexpr size_t WS_CTL = 0, CTL_ZERO_BYTES = 128 * 1024;
constexpr size_t WS_ROUTE = 1 * MiB;
constexpr size_t WS_WRT = 2 * MiB;
constexpr size_t WS_HS = 2 * MiB + 256 * 1024;
constexpr size_t WS_CS = 2 * MiB + 512 * 1024;
constexpr size_t WS_LISTS = 3 * MiB;
constexpr size_t WS_WIN = 11 * MiB;
constexpr size_t WS_WOUT = 20 * MiB;
constexpr size_t WS_WGU = 24 * MiB;
constexpr size_t WS_H8 = 88 * MiB;
constexpr size_t WS_HQ = 120 * MiB;
constexpr size_t WS_WD = 152 * MiB;
constexpr size_t WS_HB = 216 * MiB;
constexpr size_t WS_Z = 280 * MiB;
constexpr size_t WS_Y = 368 * MiB;
constexpr size_t WS_U = 280 * MiB;
constexpr size_t WS_U8 = (NO_HB1 && U_I8 && RESID_I8 && GEMM1_I8 && GEMM2_FP8) ? WS_HB : WS_U;
constexpr size_t WS_HID = 280 * MiB;
constexpr size_t WS_Y2S = 352 * MiB;
constexpr size_t WS_END = 496 * MiB;
constexpr int CW_TMO = 0, CW_BAR = 4096, CW_CNT = 16384, CW_CMAX = 20480  , CW_CMAXCNT = 25600;

constexpr int RING_BYTES = 131072, LDSCTL_OFF = RING_BYTES, MISC_OFF = LDSCTL_OFF + 320, TAB_OFF = LDSCTL_OFF + 1024;
constexpr int LDS_BYTES = 163840;
constexpr int LISTROW_OFF = 139264;

__device__ __forceinline__ unsigned f2bf(float f) { unsigned u = __builtin_bit_cast(unsigned, f); return (u + 0x7fffu + ((u >> 16) & 1u)) >> 16; }
__device__ __forceinline__ unsigned pk2(float lo, float hi) { unsigned r; asm("v_cvt_pk_bf16_f32 %0, %1, %2" : "=v"(r) : "v"(lo), "v"(hi)); return r; }
__device__ __forceinline__ float bflo(unsigned u) { return __builtin_bit_cast(float, u << 16); }
__device__ __forceinline__ float bfhi(unsigned u) { return __builtin_bit_cast(float, u & 0xffff0000u); }
template <int CTRL> __device__ __forceinline__ float dpp_mov(float v) { return __builtin_bit_cast(float, __builtin_amdgcn_update_dpp(0, __builtin_bit_cast(int, v), CTRL, 0xf, 0xf, false)); }
__device__ __forceinline__ void wave_sum4(float& a, float& b, float& c, float& d) {
    a += dpp_mov<0xB1>(a); b += dpp_mov<0xB1>(b); c += dpp_mov<0xB1>(c); d += dpp_mov<0xB1>(d);
    a += dpp_mov<0x4E>(a); b += dpp_mov<0x4E>(b); c += dpp_mov<0x4E>(c); d += dpp_mov<0x4E>(d);
    a += dpp_mov<0x141>(a); b += dpp_mov<0x141>(b); c += dpp_mov<0x141>(c); d += dpp_mov<0x141>(d);
    a += dpp_mov<0x140>(a); b += dpp_mov<0x140>(b); c += dpp_mov<0x140>(c); d += dpp_mov<0x140>(d);
#define WS4_FIN(x) do { const int iv_ = __builtin_bit_cast(int, x); x = (__builtin_bit_cast(float, __builtin_amdgcn_readlane(iv_, 0)) + __builtin_bit_cast(float, __builtin_amdgcn_readlane(iv_, 16))) + \
        (__builtin_bit_cast(float, __builtin_amdgcn_readlane(iv_, 32)) + __builtin_bit_cast(float, __builtin_amdgcn_readlane(iv_, 48))); } while (0)
    WS4_FIN(a); WS4_FIN(b); WS4_FIN(c); WS4_FIN(d);
#undef WS4_FIN
}
__device__ __forceinline__ float wave_sum(float v) {
    v += dpp_mov<0xB1>(v); v += dpp_mov<0x4E>(v); v += dpp_mov<0x141>(v); v += dpp_mov<0x140>(v);
    const int iv = __builtin_bit_cast(int, v);
    return (__builtin_bit_cast(float, __builtin_amdgcn_readlane(iv, 0)) + __builtin_bit_cast(float, __builtin_amdgcn_readlane(iv, 16))) +
           (__builtin_bit_cast(float, __builtin_amdgcn_readlane(iv, 32)) + __builtin_bit_cast(float, __builtin_amdgcn_readlane(iv, 48)));
}
__device__ __forceinline__ float wave_max(float v) {
    v = fmaxf(v, dpp_mov<0xB1>(v)); v = fmaxf(v, dpp_mov<0x4E>(v)); v = fmaxf(v, dpp_mov<0x141>(v)); v = fmaxf(v, dpp_mov<0x140>(v));
    const int iv = __builtin_bit_cast(int, v);
    return fmaxf(fmaxf(__builtin_bit_cast(float, __builtin_amdgcn_readlane(iv, 0)), __builtin_bit_cast(float, __builtin_amdgcn_readlane(iv, 16))),
                 fmaxf(__builtin_bit_cast(float, __builtin_amdgcn_readlane(iv, 32)), __builtin_bit_cast(float, __builtin_amdgcn_readlane(iv, 48))));
}
__device__ __forceinline__ void wave_sum2(float& a, float& b) {
    a += dpp_mov<0xB1>(a); b += dpp_mov<0xB1>(b); a += dpp_mov<0x4E>(a); b += dpp_mov<0x4E>(b); a += dpp_mov<0x141>(a); b += dpp_mov<0x141>(b); a += dpp_mov<0x140>(a); b += dpp_mov<0x140>(b);
    const int ia = __builtin_bit_cast(int, a), ib = __builtin_bit_cast(int, b);
    a = (__builtin_bit_cast(float, __builtin_amdgcn_readlane(ia, 0)) + __builtin_bit_cast(float, __builtin_amdgcn_readlane(ia, 16))) + (__builtin_bit_cast(float, __builtin_amdgcn_readlane(ia, 32)) + __builtin_bit_cast(float, __builtin_amdgcn_readlane(ia, 48)));
    b = (__builtin_bit_cast(float, __builtin_amdgcn_readlane(ib, 0)) + __builtin_bit_cast(float, __builtin_amdgcn_readlane(ib, 16))) + (__builtin_bit_cast(float, __builtin_amdgcn_readlane(ib, 32)) + __builtin_bit_cast(float, __builtin_amdgcn_readlane(ib, 48)));
}
__device__ __forceinline__ void wave_max2(float& a, float& b) {
    a = fmaxf(a, dpp_mov<0xB1>(a)); b = fmaxf(b, dpp_mov<0xB1>(b)); a = fmaxf(a, dpp_mov<0x4E>(a)); b = fmaxf(b, dpp_mov<0x4E>(b));
    a = fmaxf(a, dpp_mov<0x141>(a)); b = fmaxf(b, dpp_mov<0x141>(b)); a = fmaxf(a, dpp_mov<0x140>(a)); b = fmaxf(b, dpp_mov<0x140>(b));
    const int ia = __builtin_bit_cast(int, a), ib = __builtin_bit_cast(int, b);
    a = fmaxf(fmaxf(__builtin_bit_cast(float, __builtin_amdgcn_readlane(ia, 0)), __builtin_bit_cast(float, __builtin_amdgcn_readlane(ia, 16))), fmaxf(__builtin_bit_cast(float, __builtin_amdgcn_readlane(ia, 32)), __builtin_bit_cast(float, __builtin_amdgcn_readlane(ia, 48))));
    b = fmaxf(fmaxf(__builtin_bit_cast(float, __builtin_amdgcn_readlane(ib, 0)), __builtin_bit_cast(float, __builtin_amdgcn_readlane(ib, 16))), fmaxf(__builtin_bit_cast(float, __builtin_amdgcn_readlane(ib, 32)), __builtin_bit_cast(float, __builtin_amdgcn_readlane(ib, 48))));
}
__device__ __forceinline__ unsigned pk4_i8(float a, float b, float c, float d) {
    const float M = 12582912.f;
    const unsigned ua = __builtin_bit_cast(unsigned, a + M), ub = __builtin_bit_cast(unsigned, b + M), uc = __builtin_bit_cast(unsigned, c + M), ud = __builtin_bit_cast(unsigned, d + M);
    return __builtin_amdgcn_perm(ub, ua, 0x0c0c0400u) | __builtin_amdgcn_perm(ud, uc, 0x04000c0cu); }
__device__ __forceinline__ unsigned pk4_fp8(float a, float b, float c, float d) {
    int v = 0; v = __builtin_amdgcn_cvt_pk_fp8_f32(a, b, v, false); v = __builtin_amdgcn_cvt_pk_fp8_f32(c, d, v, true); return (unsigned)v; }
__device__ __forceinline__ float sigmoidf_(float x) { return __builtin_amdgcn_rcpf(1.0f + __expf(-x)); }

namespace pg8 {
#define PG8_LAS __attribute__((address_space(3)))
typedef int v8i __attribute__((ext_vector_type(8)));
typedef int v4i __attribute__((ext_vector_type(4)));
constexpr int BM = 256, BK = 64, HALF = 128, HTB = HALF * BK * 2, STAGE_BYTES = 8 * HTB, NXCD = 8, WGM = 8;
__host__ __device__ __forceinline__ int lds_byte(int r, int c) { const int st = (r >> 4) * 2 + (c >> 5), rr = r & 15, cc = c & 31, ob = rr * 64 + cc * 2; return st * 1024 + (ob ^ (((ob >> 9) & 1) << 5)); }
__host__ __device__ __forceinline__ void stage_rc(int b, int& R, int& C) { const int st = b / 1024, sb = b % 1024, swz = sb ^ (((sb >> 9) & 1) << 5); R = (st >> 1) * 16 + swz / 64; C = (st & 1) * 32 + (swz % 64) / 2; }
__host__ __device__ __forceinline__ int perm32(int rho) { const int n = rho >> 4, i = rho & 15; return 8 * (i >> 2) + 4 * n + (i & 3); }

struct Unit { int pm, pn, e, j, rh; };

__device__ __forceinline__ int xcd_remap(int wgid, int nwg) { const int q = nwg / NXCD, r = nwg % NXCD, xcd = wgid % NXCD, off = wgid / NXCD; return (xcd < r ? xcd * (q + 1) : r * (q + 1) + (xcd - r) * q) + off; }

struct DenseOrder {
    static constexpr bool GATHER = false, HAS_HALF = true, HAS_RH = false, LISTS = false;
    const char* A; const char* Bt; int K, nM, nN, nwg, G, c, nhalf;
    __device__ void init(const void* A_, const void* Bt_, int M, int N, int K_, int G_, int c_, int half_tile = 0) { A = (const char*)A_; Bt = (const char*)Bt_; K = K_; nM = M / BM; nN = N / BM - half_tile; nwg = nM * nN; G = G_; c = c_; nhalf = half_tile ? nM : 0; }
    __device__ bool next(int i, Unit& u) const {
        const long L = (long)i * G + c; if (L >= nwg + nhalf) return false;
        u.e = 0; u.j = 0; u.rh = -1;
        if (L >= nwg) { u.pm = (int)(L - nwg); u.pn = nN; return true; }
        const int wgid = xcd_remap((int)L, nwg);
        const int nig = WGM * nN, gid = wgid / nig, fm = gid * WGM, gsz = (nM - fm) < WGM ? (nM - fm) : WGM;
        u.pm = fm + ((wgid % nig) % gsz); u.pn = (wgid % nig) / gsz; return true;
    }
    __device__ __forceinline__ bool is_half(const Unit& u) const { return u.pn >= nN; }
    __device__ __forceinline__ int row_half(const Unit&) const { return -1; }
    __device__ __forceinline__ const char* a_tile(const Unit& u) const { return A + (size_t)u.pm * BM * K * 2; }
    __device__ __forceinline__ const char* b_tile(const Unit& u) const { return Bt + (size_t)u.pn * BM * K * 2; }
    __device__ __forceinline__ unsigned a_row_off(const Unit&, int r) const { return (unsigned)(r * K * 2); }
};
struct DenseRowsOrder : DenseOrder {
    static constexpr bool GATHER = true, HAS_HALF = false;
    __device__ __forceinline__ const char* a_tile(const Unit&) const { return A; }
    __device__ __forceinline__ unsigned a_row_off(const Unit& u, int r) const { return (unsigned)(u.pm * BM + r) * (unsigned)(K * 2); }
};
struct MoeOrder {
    static constexpr bool HAS_HALF = false, HAS_RH = true, LISTS = false;
    __device__ __forceinline__ bool is_half(const Unit&) const { return false; }
    const char* A; const char* Bt; size_t bexp; int K, nN, nwg, G, c; const PG8_LAS int* tab; const int* lists;
    __device__ bool next(int i, Unit& u) const {
        const int L = i * G + c, nfull = (nwg / G) * G, rem = nwg - nfull;
        int uidx = L; u.rh = -1;
        if (L >= nfull) { if (2 * rem <= G) { if (L >= nfull + 2 * rem) return false; uidx = nfull + ((L - nfull) >> 1); u.rh = (L - nfull) & 1; } else if (L >= nwg) return false; }
        const int wgid = xcd_remap(uidx, nwg);
        const int t = wgid / nN; u.pn = wgid % nN; u.pm = t;
        const int e = tab[80 + t];
        u.e = e; u.j = t - tab[e]; return true;
    }
    __device__ __forceinline__ int row_half(const Unit& u) const { return u.rh; }
    __device__ __forceinline__ const char* b_tile(const Unit& u) const { return Bt + (size_t)u.e * bexp + (size_t)u.pn * BM * K * 2; }
};
struct MoeGatherOrder : MoeOrder {
    static constexpr bool GATHER = true, LISTS = true;
    __device__ __forceinline__ unsigned list_off(const Unit& u, int r) const {
        const int idx = u.j * BM + r, cnt = tab[40 + u.e];
        return (unsigned)(u.e * 65536 + (idx < cnt ? idx : cnt - 1)) * 4u; }
    __device__ __forceinline__ const char* a_tile(const Unit&) const { return A; }
    __device__ __forceinline__ unsigned a_row_off(const Unit& u, int r) const {
        const int idx = u.j * BM + r, cnt = tab[40 + u.e];
        const int ii = idx < cnt ? idx : cnt - 1;
        const int tok = lists[(size_t)u.e * 65536 + ii] >> 1;
        return (unsigned)tok * (unsigned)(K * 2);
    }
};
struct MoeRowsOrder : MoeOrder {
    static constexpr bool GATHER = true;
    __device__ __forceinline__ const char* a_tile(const Unit&) const { return A; }
    __device__ __forceinline__ unsigned a_row_off(const Unit& u, int r) const { return (unsigned)(u.pm * BM + r) * (unsigned)(K * 2); }
};
struct MoeDenseOrder : MoeOrder {
    static constexpr bool GATHER = false;
    __device__ __forceinline__ const char* a_tile(const Unit& u) const { return A + (size_t)u.pm * BM * K * 2; }
    __device__ __forceinline__ unsigned a_row_off(const Unit&, int r) const { return (unsigned)(r * K * 2); }
};

__device__ __forceinline__ unsigned cvt_pk_bf16(float lo, float hi) { unsigned r; asm volatile("v_cvt_pk_bf16_f32 %0, %1, %2" : "=v"(r) : "v"(lo), "v"(hi)); return r; }

struct EpiZ {
    static constexpr bool PERM = true;
    bf16* Z;
    __device__ __forceinline__ void operator()(const f32x4 (&acc)[2][2][4][2], const Unit& u, int wr, int wc, int fr, int fq) const {
        const int row0 = u.pm * BM + wr * 64 + fr, cl = wc * 32 + 8 * fq;
        if (u.pn < 6) {
            const bool sg = u.pn >= 3;
            const int zc = (sg ? 768 + (u.pn - 3) * 128 : 384 + u.pn * 128) + cl;
#pragma unroll
            for (int ai = 0; ai < 2; ++ai)
#pragma unroll
                for (int m = 0; m < 4; ++m) {
                    f32x4 a0 = acc[ai][0][m][0], a1 = acc[ai][0][m][1], g0 = acc[ai][1][m][0], g1 = acc[ai][1][m][1];
                    if (sg) {
#pragma unroll
                        for (int q = 0; q < 4; ++q) { g0[q] = sigmoidf_(g0[q]); g1[q] = sigmoidf_(g1[q]); }
                    }
                    a0 = a0 * g0; a1 = a1 * g1;
                    v4u w; w.x = cvt_pk_bf16(a0[0], a0[1]); w.y = cvt_pk_bf16(a0[2], a0[3]); w.z = cvt_pk_bf16(a1[0], a1[1]); w.w = cvt_pk_bf16(a1[2], a1[3]);
                    *(v4u*)(Z + (size_t)(row0 + ai * HALF + m * 16) * NZ + zc) = w;
                }
        } else {
            int zb0, zb1;
            if (u.pn == 6) { zb0 = 0; zb1 = 128; } else if (u.pn == 7) { zb0 = 256; zb1 = 1152; } else { zb0 = 1280; zb1 = -1; }
#pragma unroll
            for (int ai = 0; ai < 2; ++ai)
#pragma unroll
                for (int m = 0; m < 4; ++m) {
                    bf16* rowp = Z + (size_t)(row0 + ai * HALF + m * 16) * NZ + cl;
#pragma unroll
                    for (int bj = 0; bj < 2; ++bj) {
                        const int zb = bj ? zb1 : zb0;
                        if (zb >= 0) { const f32x4 a0 = acc[ai][bj][m][0], a1 = acc[ai][bj][m][1];
                            v4u w; w.x = cvt_pk_bf16(a0[0], a0[1]); w.y = cvt_pk_bf16(a0[2], a0[3]); w.z = cvt_pk_bf16(a1[0], a1[1]); w.w = cvt_pk_bf16(a1[2], a1[3]);
                            *(v4u*)(rowp + zb) = w; }
                    }
                }
        }
    }
};
struct EpiZq {
    static constexpr bool PERM = true;
    bf16* Z; const float* hs; const float* cs;
    __device__ __forceinline__ void operator()(f32x4 (&acc)[2][2][4][2], const Unit& u, int wr, int wc, int fr, int fq) const {
        const int row0 = u.pm * BM + wr * 64 + fr, cl = wc * 32 + 8 * fq;
        {
            float rs[2][4]; f32x4 cv[2][2];
#pragma unroll
            for (int ai = 0; ai < 2; ++ai)
#pragma unroll
                for (int m = 0; m < 4; ++m) rs[ai][m] = hs[row0 + ai * HALF + m * 16];
#pragma unroll
            for (int bj = 0; bj < 2; ++bj)
#pragma unroll
                for (int n = 0; n < 2; ++n) cv[bj][n] = *(const f32x4*)(cs + u.pn * BM + bj * HALF + cl + 4 * n) * (1.f / 127.f);
#pragma unroll
            for (int ai = 0; ai < 2; ++ai)
#pragma unroll
                for (int bj = 0; bj < 2; ++bj)
#pragma unroll
                    for (int m = 0; m < 4; ++m)
#pragma unroll
                        for (int n = 0; n < 2; ++n) { const v4i q = __builtin_bit_cast(v4i, acc[ai][bj][m][n]);
                            acc[ai][bj][m][n] = (f32x4){(float)q.x, (float)q.y, (float)q.z, (float)q.w} * rs[ai][m] * cv[bj][n]; }
        }
        if (u.pn < 6) {
            const bool sg = u.pn >= 3;
            const int zc = (sg ? 768 + (u.pn - 3) * 128 : 384 + u.pn * 128) + cl;
#pragma unroll
            for (int ai = 0; ai < 2; ++ai)
#pragma unroll
                for (int m = 0; m < 4; ++m) {
                    f32x4 a0 = acc[ai][0][m][0], a1 = acc[ai][0][m][1], g0 = acc[ai][1][m][0], g1 = acc[ai][1][m][1];
                    if (sg) {
#pragma unroll
                        for (int q = 0; q < 4; ++q) { g0[q] = sigmoidf_(g0[q]); g1[q] = sigmoidf_(g1[q]); }
                    }
                    a0 = a0 * g0; a1 = a1 * g1;
                    v4u w; w.x = cvt_pk_bf16(a0[0], a0[1]); w.y = cvt_pk_bf16(a0[2], a0[3]); w.z = cvt_pk_bf16(a1[0], a1[1]); w.w = cvt_pk_bf16(a1[2], a1[3]);
                    *(v4u*)(Z + (size_t)(row0 + ai * HALF + m * 16) * NZ + zc) = w;
                }
        } else {
            int zb0, zb1;
            if (u.pn == 6) { zb0 = 0; zb1 = 128; } else if (u.pn == 7) { zb0 = 256; zb1 = 1152; } else { zb0 = 1280; zb1 = -1; }
#pragma unroll
            for (int ai = 0; ai < 2; ++ai)
#pragma unroll
                for (int m = 0; m < 4; ++m) {
                    bf16* rowp = Z + (size_t)(row0 + ai * HALF + m * 16) * NZ + cl;
#pragma unroll
                    for (int bj = 0; bj < 2; ++bj) {
                        const int zb = bj ? zb1 : zb0;
                        if (zb >= 0) { const f32x4 a0 = acc[ai][bj][m][0], a1 = acc[ai][bj][m][1];
                            v4u w; w.x = cvt_pk_bf16(a0[0], a0[1]); w.y = cvt_pk_bf16(a0[2], a0[3]); w.z = cvt_pk_bf16(a1[0], a1[1]); w.w = cvt_pk_bf16(a1[2], a1[3]);
                            *(v4u*)(rowp + zb) = w; }
                    }
                }
        }
    }
};
struct EpiU {
    static constexpr bool PERM = true;
    const bf16* H; bf16* U;
    __device__ __forceinline__ void operator()(const f32x4 (&acc)[2][2][4][2], const Unit& u, int wr, int wc, int fr, int fq) const {
        const int row0 = u.pm * BM + wr * 64 + fr, col0 = u.pn * BM + wc * 32 + 8 * fq;
        v4u hh[2][4][2];
#pragma unroll
        for (int ai = 0; ai < 2; ++ai)
#pragma unroll
            for (int m = 0; m < 4; ++m)
#pragma unroll
                for (int bj = 0; bj < 2; ++bj) hh[ai][m][bj] = *(const v4u*)(H + (size_t)(row0 + ai * HALF + m * 16) * D_ + col0 + bj * HALF);
#pragma unroll
        for (int ai = 0; ai < 2; ++ai)
#pragma unroll
            for (int m = 0; m < 4; ++m) {
                const size_t off = (size_t)(row0 + ai * HALF + m * 16) * D_ + col0;
#pragma unroll
                for (int bj = 0; bj < 2; ++bj) {
                    const v4u h = hh[ai][m][bj];
                    const f32x4 a0 = acc[ai][bj][m][0], a1 = acc[ai][bj][m][1];
                    v4u w;
                    w.x = cvt_pk_bf16(ALPHA * bflo(h.x) + a0[0], ALPHA * bfhi(h.x) + a0[1]); w.y = cvt_pk_bf16(ALPHA * bflo(h.y) + a0[2], ALPHA * bfhi(h.y) + a0[3]);
                    w.z = cvt_pk_bf16(ALPHA * bflo(h.z) + a1[0], ALPHA * bfhi(h.z) + a1[1]); w.w = cvt_pk_bf16(ALPHA * bflo(h.w) + a1[2], ALPHA * bfhi(h.w) + a1[3]);
                    *(v4u*)(U + off + bj * HALF) = w;
                }
            }
    }
};
struct EpiUq {
    static constexpr bool PERM = true;
    const unsigned char* HQ; const float* hs; bf16* U;
    __device__ __forceinline__ void operator()(const f32x4 (&acc)[2][2][4][2], const Unit& u, int wr, int wc, int fr, int fq) const {
        const int row0 = u.pm * BM + wr * 64 + fr, col0 = u.pn * BM + wc * 32 + 8 * fq;
        v2u hq[2][4][2]; float sc[2][4];
#pragma unroll
        for (int ai = 0; ai < 2; ++ai)
#pragma unroll
            for (int m = 0; m < 4; ++m) { sc[ai][m] = hs[row0 + ai * HALF + m * 16];
#pragma unroll
                for (int bj = 0; bj < 2; ++bj) hq[ai][m][bj] = *(const v2u*)(HQ + (size_t)(row0 + ai * HALF + m * 16) * D_ + col0 + bj * HALF); }
#pragma unroll
        for (int ai = 0; ai < 2; ++ai)
#pragma unroll
            for (int m = 0; m < 4; ++m) {
                const size_t off = (size_t)(row0 + ai * HALF + m * 16) * D_ + col0; const float sa = ALPHA * sc[ai][m];
#pragma unroll
                for (int bj = 0; bj < 2; ++bj) {
                    const int h0 = (int)hq[ai][m][bj].x, h1 = (int)hq[ai][m][bj].y;
                    const f32x4 a0 = acc[ai][bj][m][0], a1 = acc[ai][bj][m][1];
                    v4u w;
                    w.x = cvt_pk_bf16(sa * (float)((h0 << 24) >> 24) + a0[0], sa * (float)((h0 << 16) >> 24) + a0[1]); w.y = cvt_pk_bf16(sa * (float)((h0 << 8) >> 24) + a0[2], sa * (float)(h0 >> 24) + a0[3]);
                    w.z = cvt_pk_bf16(sa * (float)((h1 << 24) >> 24) + a1[0], sa * (float)((h1 << 16) >> 24) + a1[1]); w.w = cvt_pk_bf16(sa * (float)((h1 << 8) >> 24) + a1[2], sa * (float)(h1 >> 24) + a1[3]);
                    *(v4u*)(U + off + bj * HALF) = w;
                }
            }
    }
};
struct EpiUq8 {
    static constexpr bool PERM = true;
    const unsigned char* HQ; const float* hs; unsigned char* U8; float* US;
    __device__ __forceinline__ void operator()(const f32x4 (&acc)[2][2][4][2], const Unit& u, int wr, int wc, int fr, int fq) const {
        const int row0 = u.pm * BM + wr * 64 + fr, col0 = u.pn * BM + wc * 32 + 8 * fq;
        v2u hq[2][4][2]; float sc[2][4];
#pragma unroll
        for (int ai = 0; ai < 2; ++ai)
#pragma unroll
            for (int m = 0; m < 4; ++m) { sc[ai][m] = hs[row0 + ai * HALF + m * 16];
#pragma unroll
                for (int bj = 0; bj < 2; ++bj) hq[ai][m][bj] = *(const v2u*)(HQ + (size_t)(row0 + ai * HALF + m * 16) * D_ + col0 + bj * HALF); }
#pragma unroll
        for (int ai = 0; ai < 2; ++ai)
#pragma unroll
            for (int m = 0; m < 4; ++m) {
                const int row = row0 + ai * HALF + m * 16; const float sa = ALPHA * sc[ai][m];
#pragma unroll
                for (int bj = 0; bj < 2; ++bj) {
                    const int h0 = (int)hq[ai][m][bj].x, h1 = (int)hq[ai][m][bj].y;
                    const f32x4 a0 = acc[ai][bj][m][0], a1 = acc[ai][bj][m][1];
                    const float u0 = sa * (float)((h0 << 24) >> 24) + a0[0], u1 = sa * (float)((h0 << 16) >> 24) + a0[1], u2 = sa * (float)((h0 << 8) >> 24) + a0[2], u3 = sa * (float)(h0 >> 24) + a0[3];
                    const float u4 = sa * (float)((h1 << 24) >> 24) + a1[0], u5 = sa * (float)((h1 << 16) >> 24) + a1[1], u6 = sa * (float)((h1 << 8) >> 24) + a1[2], u7 = sa * (float)(h1 >> 24) + a1[3];
                    float mx = fmaxf(fmaxf(fmaxf(fabsf(u0), fabsf(u1)), fmaxf(fabsf(u2), fabsf(u3))), fmaxf(fmaxf(fabsf(u4), fabsf(u5)), fmaxf(fabsf(u6), fabsf(u7))));
                    { const unsigned um = __builtin_bit_cast(unsigned, mx); const auto r16 = __builtin_amdgcn_permlane16_swap(um, um, false, false);
                      mx = fmaxf(__builtin_bit_cast(float, (unsigned)r16[0]), __builtin_bit_cast(float, (unsigned)r16[1]));
                      const unsigned um2 = __builtin_bit_cast(unsigned, mx); const auto r32 = __builtin_amdgcn_permlane32_swap(um2, um2, false, false);
                      mx = fmaxf(__builtin_bit_cast(float, (unsigned)r32[0]), __builtin_bit_cast(float, (unsigned)r32[1])); }
                    const float inv = mx > 0.f ? 127.f / mx : 0.f;
                    v2u w; w.x = pk4_i8(u0 * inv, u1 * inv, u2 * inv, u3 * inv); w.y = pk4_i8(u4 * inv, u5 * inv, u6 * inv, u7 * inv);
                    *(v2u*)(U8 + (size_t)row * D_ + col0 + bj * HALF) = w;
                    if (fq == 0) US[(size_t)row * 32 + u.pn * 8 + bj * 4 + wc] = mx * (1.f / 127.f);
                }
            }
    }
};
__device__ __forceinline__ v4u pair16(v2u wa, v2u wb) {
    const auto rx = __builtin_amdgcn_permlane16_swap(wa.x, wb.x, false, false), ry = __builtin_amdgcn_permlane16_swap(wa.y, wb.y, false, false);
    return (v4u){(unsigned)rx[0], (unsigned)ry[0], (unsigned)rx[1], (unsigned)ry[1]};
}
struct EpiHid {
    static constexpr bool PERM = true;
    unsigned char* HID;
    __device__ __forceinline__ void operator()(const f32x4 (&acc)[2][2][4][2], const Unit& u, int wr, int wc, int fr, int fq) const {
        const int row0 = u.pm * BM + wr * 64 + fr, col0 = u.pn * 128 + wc * 32 + 8 * (fq & ~1);
#pragma unroll
        for (int ai = 0; ai < 2; ++ai) { if (u.rh >= 0 && u.rh != ai) continue;
#pragma unroll
            for (int mp = 0; mp < 4; mp += 2) { v2u w[2];
#pragma unroll
                for (int k = 0; k < 2; ++k) { const int m = mp + k;
                    f32x4 g0 = acc[ai][0][m][0], g1 = acc[ai][0][m][1]; const f32x4 u0 = acc[ai][1][m][0], u1 = acc[ai][1][m][1];
#pragma unroll
                    for (int q = 0; q < 4; ++q) { g0[q] = g0[q] * sigmoidf_(g0[q]); g1[q] = g1[q] * sigmoidf_(g1[q]); }
                    g0 = g0 * u0; g1 = g1 * u1;
                    w[k].x = pk4_fp8(g0[0], g0[1], g0[2], g0[3]); w[k].y = pk4_fp8(g1[0], g1[1], g1[2], g1[3]); }
                *(v4u*)(HID + (size_t)(row0 + ai * HALF + (mp + (fq & 1)) * 16) * DE + col0) = pair16(w[0], w[1]);
            } }
    }
};
struct EpiPlain8 {
    static constexpr bool PERM = true;
    unsigned char* O; int ldc;
    __device__ __forceinline__ void operator()(const f32x4 (&acc)[2][2][4][2], const Unit& u, int wr, int wc, int fr, int fq) const {
        const int row0 = u.pm * BM + wr * 64 + fr, col0 = u.pn * BM + wc * 32 + 8 * (fq & ~1);
#pragma unroll
        for (int ai = 0; ai < 2; ++ai) { if (u.rh >= 0 && u.rh != ai) continue;
#pragma unroll
            for (int mp = 0; mp < 4; mp += 2) {
                unsigned char* rowp = O + (size_t)(row0 + ai * HALF + (mp + (fq & 1)) * 16) * ldc + col0;
#pragma unroll
                for (int bj = 0; bj < 2; ++bj) { v2u w[2];
#pragma unroll
                    for (int k = 0; k < 2; ++k) { const f32x4 a0 = acc[ai][bj][mp + k][0], a1 = acc[ai][bj][mp + k][1];
                        w[k].x = pk4_fp8(a0[0], a0[1], a0[2], a0[3]); w[k].y = pk4_fp8(a1[0], a1[1], a1[2], a1[3]); }
                    *(v4u*)(rowp + bj * HALF) = pair16(w[0], w[1]); }
            } }
    }
};
struct EpiPlain {
    static constexpr bool PERM = true;
    bf16* O; int ldc;
    __device__ __forceinline__ void operator()(const f32x4 (&acc)[2][2][4][2], const Unit& u, int wr, int wc, int fr, int fq) const {
        const int row0 = u.pm * BM + wr * 64 + fr, col0 = u.pn * BM + wc * 32 + 8 * fq;
#pragma unroll
        for (int ai = 0; ai < 2; ++ai)
#pragma unroll
            for (int m = 0; m < 4; ++m) {
                bf16* rowp = O + (size_t)(row0 + ai * HALF + m * 16) * ldc + col0;
#pragma unroll
                for (int bj = 0; bj < 2; ++bj) { const f32x4 a0 = acc[ai][bj][m][0], a1 = acc[ai][bj][m][1];
                    v4u w; w.x = cvt_pk_bf16(a0[0], a0[1]); w.y = cvt_pk_bf16(a0[2], a0[3]); w.z = cvt_pk_bf16(a1[0], a1[1]); w.w = cvt_pk_bf16(a1[2], a1[3]);
                    *(v4u*)(rowp + bj * HALF) = w; }
            }
    }
};

template <class Epi, class Sched>
__device__ __forceinline__ void gemm_phase_simple(const Sched& S, const Epi& E) {
    int tid = threadIdx.x; asm volatile("" : "+v"(tid));
    const int wid = __builtin_amdgcn_readfirstlane(tid >> 6), lane = tid & 63, wr = wid >> 2, wc = wid & 3, fr = lane & 15, fq = lane >> 4;
    const int K = S.K;
    Unit cur;
    for (int ui = 0; S.next(ui, cur); ++ui) {
        f32x4 acc[2][2][4][2];
#pragma unroll
        for (int a = 0; a < 2; ++a)
#pragma unroll
            for (int b = 0; b < 2; ++b)
#pragma unroll
                for (int m = 0; m < 4; ++m)
#pragma unroll
                    for (int n = 0; n < 2; ++n) acc[a][b][m][n] = (f32x4){0.f, 0.f, 0.f, 0.f};
        const char* at = S.a_tile(cur); const char* bt = S.b_tile(cur);
        const char* ap[2][4]; const char* bp[2][2];
#pragma unroll
        for (int ai = 0; ai < 2; ++ai)
#pragma unroll
            for (int m = 0; m < 4; ++m) ap[ai][m] = at + S.a_row_off(cur, ai * HALF + wr * 64 + m * 16 + fr) + fq * 16;
#pragma unroll
        for (int bj = 0; bj < 2; ++bj)
#pragma unroll
            for (int n = 0; n < 2; ++n) { const int rho = n * 16 + fr; bp[bj][n] = bt + (size_t)(bj * HALF + wc * 32 + (Epi::PERM ? perm32(rho) : rho)) * K * 2 + fq * 16; }
        for (int k0 = 0; k0 < K; k0 += 32) {
            bf16x8 a[2][4], b[2][2];
#pragma unroll
            for (int ai = 0; ai < 2; ++ai)
#pragma unroll
                for (int m = 0; m < 4; ++m) a[ai][m] = *(const bf16x8*)(ap[ai][m] + k0 * 2);
#pragma unroll
            for (int bj = 0; bj < 2; ++bj)
#pragma unroll
                for (int n = 0; n < 2; ++n) b[bj][n] = *(const bf16x8*)(bp[bj][n] + k0 * 2);
#pragma unroll
            for (int ai = 0; ai < 2; ++ai)
#pragma unroll
                for (int bj = 0; bj < 2; ++bj)
#pragma unroll
                    for (int m = 0; m < 4; ++m)
#pragma unroll
                        for (int n = 0; n < 2; ++n) acc[ai][bj][m][n] = __builtin_amdgcn_mfma_f32_16x16x32_bf16(b[bj][n], a[ai][m], acc[ai][bj][m][n], 0, 0, 0);
        }
        E(acc, cur, wr, wc, fr, fq);
    }
}

template <int OFF> __device__ __forceinline__ void glds16(const char* base, unsigned voff, unsigned lds_base) {
    asm volatile("s_add_u32 m0, %2, %3\n\ts_nop 0\n\tglobal_load_lds_dwordx4 %0, %1" :: "v"(voff), "s"(base), "s"(lds_base), "n"(OFF) : "memory", "m0", "scc");
}
template <int OFF> __device__ __forceinline__ void glds4(const char* base, unsigned voff, unsigned lds_base) {
    asm volatile("s_add_u32 m0, %2, %3\n\ts_nop 0\n\tglobal_load_lds_dword %0, %1" :: "v"(voff), "s"(base), "s"(lds_base), "n"(OFF) : "memory", "m0", "scc");
}
template <class Epi, class Sched, int MODE = 0  >
__device__ __forceinline__ void gemm_phase(PG8_LAS unsigned char* lds, const Sched& S, const Epi& E) {
    constexpr bool GATHER = Sched::GATHER;
    int tid = threadIdx.x; asm volatile("" : "+v"(tid));
    const int wid = __builtin_amdgcn_readfirstlane(tid >> 6), lane = tid & 63, wr = wid >> 2, wc = wid & 3, fr = lane & 15, fq = lane >> 4;
    const int K = S.K, nt = K / BK;
    unsigned voffB[2], offA[4], nxA[4];
#pragma unroll
    for (int i = 0; i < 2; ++i) { int R, C; stage_rc(tid * 16 + i * 8192, R, C); const int Rb = Epi::PERM ? ((R & ~31) + perm32(R & 31)) : R;
        voffB[i] = (unsigned)(Rb * K + C) * 2u; offA[i] = (unsigned)(R * K + C) * 2u; offA[2 + i] = (unsigned)((R + HALF) * K + C) * 2u; nxA[i] = 0u; nxA[2 + i] = 0u; }
    const size_t kstep = (size_t)(BK * 2);
    const size_t hstep = (size_t)HALF * K * 2;
    const unsigned ldsw = (unsigned)wid * 1024u;
    const unsigned ldsbw = (unsigned)(size_t)lds + ldsw;
    const int aoff = lds_byte(wr * 64 + fr, fq * 8), boff = lds_byte(wc * 32 + fr, fq * 8);
#define PG8_SA(b, h) (((b) * 2 + (h)) * HTB)
#define PG8_SB(b, h) ((4 + (b) * 2 + (h)) * HTB)
#define PG8_STAGE_B(bufoff, gbase) do { glds16<(bufoff)>((const char*)(gbase), voffB[0], ldsbw); glds16<(bufoff) + 8192>((const char*)(gbase), voffB[1], ldsbw); } while (0)
#define PG8_STAGE_A(bufoff, gbase, h) do { glds16<(bufoff)>((const char*)(gbase), offA[(h) * 2], ldsbw); glds16<(bufoff) + 8192>((const char*)(gbase), offA[(h) * 2 + 1], ldsbw); } while (0)
#define PG8_LDA(dst, b, h) do { _Pragma("unroll") for (int m = 0; m < 4; ++m) _Pragma("unroll") for (int k = 0; k < 2; ++k) dst[m][k] = *(const PG8_LAS bf16x8*)(lds + PG8_SA(b, h) + aoff + m * 2048 + k * 1024); } while (0)
#define PG8_LDB(dst, b, h) do { _Pragma("unroll") for (int n = 0; n < 2; ++n) _Pragma("unroll") for (int k = 0; k < 2; ++k) dst[n][k] = *(const PG8_LAS bf16x8*)(lds + PG8_SB(b, h) + boff + n * 2048 + k * 1024); } while (0)
#define PG8_MMA(ai, bj, At, Bt) do { __builtin_amdgcn_s_setprio(1); if constexpr (MODE == 1) { _Pragma("unroll") for (int m = 0; m < 4; ++m) _Pragma("unroll") for (int n = 0; n < 2; ++n) { \
            const v8i _b = __builtin_shufflevector(__builtin_bit_cast(v4i, Bt[n][0]), __builtin_bit_cast(v4i, Bt[n][1]), 0, 1, 2, 3, 4, 5, 6, 7); \
            const v8i _a = __builtin_shufflevector(__builtin_bit_cast(v4i, At[m][0]), __builtin_bit_cast(v4i, At[m][1]), 0, 1, 2, 3, 4, 5, 6, 7); \
            acc[ai][bj][m][n] = __builtin_amdgcn_mfma_scale_f32_16x16x128_f8f6f4(_b, _a, acc[ai][bj][m][n], 0, 0, 0, 0x7A7A7A7A, 0, 0x7F7F7F7F); } } \
        else if constexpr (MODE == 2) { _Pragma("unroll") for (int m = 0; m < 4; ++m) _Pragma("unroll") for (int n = 0; n < 2; ++n) _Pragma("unroll") for (int k = 0; k < 2; ++k) \
        acc[ai][bj][m][n] = __builtin_bit_cast(f32x4, __builtin_amdgcn_mfma_i32_16x16x64_i8(__builtin_bit_cast(v4i, Bt[n][k]), __builtin_bit_cast(v4i, At[m][k]), __builtin_bit_cast(v4i, acc[ai][bj][m][n]), 0, 0, 0)); } \
        else { _Pragma("unroll") for (int m = 0; m < 4; ++m) _Pragma("unroll") for (int n = 0; n < 2; ++n) _Pragma("unroll") for (int k = 0; k < 2; ++k) \
        acc[ai][bj][m][n] = __builtin_amdgcn_mfma_f32_16x16x32_bf16(Bt[n][k], At[m][k], acc[ai][bj][m][n], 0, 0, 0); } __builtin_amdgcn_s_setprio(0); } while (0)
#define PG8_WAIT_V(n) asm volatile("s_waitcnt vmcnt(" #n ")" ::: "memory")
#define PG8_WAIT_L(n) asm volatile("s_waitcnt lgkmcnt(" #n ")" ::: "memory")
#define PG8_BAR __builtin_amdgcn_s_barrier()
#define PG8_SCHED __builtin_amdgcn_sched_barrier(0)
#define PG8_OFFS(dst, u) do { if constexpr (GATHER) { _Pragma("unroll") for (int _h = 0; _h < 2; ++_h) _Pragma("unroll") for (int _i = 0; _i < 2; ++_i) { \
        int _R, _C; stage_rc(tid * 16 + _i * 8192, _R, _C); dst[_h * 2 + _i] = S.a_row_off(u, _h * HALF + _R) + (unsigned)(_C * 2); } } } while (0)
#define PG8_LIST_STAGE(u) do { if constexpr (Sched::LISTS) { glds4<LISTROW_OFF>((const char*)S.lists, S.list_off(u, (wid & 3) * 64 + lane), (unsigned)(size_t)lds + (unsigned)(wid & 3) * 256u); } } while (0)
#define PG8_LIST_READ(dst) do { if constexpr (Sched::LISTS) { _Pragma("unroll") for (int _h = 0; _h < 2; ++_h) _Pragma("unroll") for (int _i = 0; _i < 2; ++_i) { \
        int _R, _C; stage_rc(tid * 16 + _i * 8192, _R, _C); const int _v = *(const PG8_LAS int*)(lds + LISTROW_OFF + (_h * HALF + _R) * 4); \
        dst[_h * 2 + _i] = (unsigned)(_v >> 1) * (unsigned)(K * 2) + (unsigned)(_C * 2); } } } while (0)
    Unit cur, nxt; int ui = 0;
    if (!S.next(0, cur)) return;
    f32x4 acc[2][2][4][2];
#pragma unroll
    for (int a = 0; a < 2; ++a)
#pragma unroll
        for (int b = 0; b < 2; ++b)
#pragma unroll
            for (int m = 0; m < 4; ++m)
#pragma unroll
                for (int n = 0; n < 2; ++n) acc[a][b][m][n] = (f32x4){0.f, 0.f, 0.f, 0.f};
    bf16x8 At[4][2], B0[2][2], B1[2][2];
    const char* cA = S.a_tile(cur); const char* cB = S.b_tile(cur);
    if constexpr (Sched::LISTS) { PG8_LIST_STAGE(cur); PG8_WAIT_V(0); PG8_BAR; PG8_LIST_READ(offA); }
    else PG8_OFFS(offA, cur);
    PG8_STAGE_B(PG8_SB(0, 0), cB); PG8_STAGE_B(PG8_SB(0, 1), cB + hstep); PG8_STAGE_A(PG8_SA(0, 0), cA, 0); PG8_STAGE_A(PG8_SA(0, 1), cA, 1);
    if (wr == 1) PG8_BAR;
    PG8_WAIT_V(2); PG8_BAR;
    PG8_STAGE_B(PG8_SB(1, 0), cB + kstep); PG8_STAGE_A(PG8_SA(1, 0), cA + kstep, 0); PG8_STAGE_B(PG8_SB(1, 1), cB + hstep + kstep);
    PG8_WAIT_V(6); PG8_BAR;
    for (;;) {
        const bool has_next = S.next(ui + 1, nxt);
        const char* nA = has_next ? S.a_tile(nxt) : cA; const char* nB = has_next ? S.b_tile(nxt) : cB;
        if constexpr (Sched::LISTS) { if (has_next) PG8_LIST_STAGE(nxt); }
        else if constexpr (GATHER) { if (has_next) { PG8_OFFS(nxA, nxt); } }
#pragma unroll 1
        for (int t = 0; t < nt; t += 2) {
            const bool last = (t == nt - 2);
            const char* a1 = cA + (size_t)(t + 1) * kstep;
            const char* a2 = last ? nA : cA + (size_t)(t + 2) * kstep; const char* b2 = last ? nB : cB + (size_t)(t + 2) * kstep;
            const char* a3 = a2 + kstep; const char* b3 = b2 + kstep;
            PG8_LDB(B0, 0, 0); PG8_LDB(B1, 0, 1); PG8_SCHED; PG8_LDA(At, 0, 0); PG8_STAGE_A(PG8_SA(1, 1), a1, 1);
            if constexpr (Sched::LISTS) { if (last && has_next) PG8_LIST_READ(offA); }
            else if constexpr (GATHER) { if (last && has_next) {
#pragma unroll
                for (int q = 0; q < 4; ++q) offA[q] = nxA[q]; } }
            PG8_WAIT_V(8); PG8_WAIT_L(0); PG8_BAR; if (!(Sched::HAS_RH && cur.rh == 1)) { PG8_MMA(0, 0, At, B0); if (!(Sched::HAS_HALF && S.is_half(cur))) PG8_MMA(0, 1, At, B1); } PG8_BAR; PG8_SCHED;
            PG8_LDA(At, 0, 1); PG8_STAGE_B(PG8_SB(0, 0), b2); PG8_STAGE_B(PG8_SB(0, 1), b2 + hstep); PG8_STAGE_A(PG8_SA(0, 0), a2, 0);
            PG8_WAIT_V(8); PG8_WAIT_L(0); PG8_BAR; if (!(Sched::HAS_RH && cur.rh == 0)) { PG8_MMA(1, 0, At, B0); if (!(Sched::HAS_HALF && S.is_half(cur))) PG8_MMA(1, 1, At, B1); } PG8_BAR; PG8_SCHED;
            PG8_LDB(B0, 1, 0); PG8_LDB(B1, 1, 1); PG8_SCHED; PG8_LDA(At, 1, 0); PG8_STAGE_A(PG8_SA(0, 1), a2, 1);
            PG8_WAIT_V(8); PG8_WAIT_L(0); PG8_BAR; if (!(Sched::HAS_RH && cur.rh == 1)) { PG8_MMA(0, 0, At, B0); if (!(Sched::HAS_HALF && S.is_half(cur))) PG8_MMA(0, 1, At, B1); } PG8_BAR; PG8_SCHED;
            PG8_LDA(At, 1, 1); PG8_STAGE_B(PG8_SB(1, 0), b3); PG8_STAGE_B(PG8_SB(1, 1), b3 + hstep); PG8_STAGE_A(PG8_SA(1, 0), a3, 0);
            PG8_WAIT_V(8); PG8_WAIT_L(0); PG8_BAR; if (!(Sched::HAS_RH && cur.rh == 0)) { PG8_MMA(1, 0, At, B0); if (!(Sched::HAS_HALF && S.is_half(cur))) PG8_MMA(1, 1, At, B1); } PG8_BAR; PG8_SCHED;
        }
        if (wr == 0) PG8_BAR;
        E(acc, cur, wr, wc, fr, fq);
        if (!has_next) break;
#pragma unroll
        for (int a = 0; a < 2; ++a)
#pragma unroll
            for (int b = 0; b < 2; ++b)
#pragma unroll
                for (int m = 0; m < 4; ++m)
#pragma unroll
                    for (int n = 0; n < 2; ++n) acc[a][b][m][n] = (f32x4){0.f, 0.f, 0.f, 0.f};
        cur = nxt; cA = nA; cB = nB; ++ui;
        if (wr == 1) PG8_BAR;
    }
    PG8_WAIT_V(0);
    PG8_BAR;
#undef PG8_SA
#undef PG8_SB
#undef PG8_STAGE_A
#undef PG8_STAGE_B
#undef PG8_LDA
#undef PG8_LDB
#undef PG8_MMA
#undef PG8_WAIT_V
#undef PG8_WAIT_L
#undef PG8_BAR
#undef PG8_SCHED
#undef PG8_LIST_STAGE
#undef PG8_LIST_READ
#undef PG8_OFFS
}
}

#define XB_TMO      128
#define XB_XCNT(j)  (256  + 64 * (j))
#define XB_XSUB(j)  (1280 + 64 * (j))
#define XB_XGEN(j)  (2304 + 64 * (j))
#define XB_TOP      3328
#define XB_TOPGEN   3392
#define XCD_BAR_WORDS 3456
#define XB_SPIN_CAP (1u << 18)
__device__ __forceinline__ unsigned xb_ld(unsigned* p)              { return __hip_atomic_load(p, __ATOMIC_RELAXED, __HIP_MEMORY_SCOPE_AGENT); }
__device__ __forceinline__ unsigned xb_add(unsigned* p, unsigned v) { return __hip_atomic_fetch_add(p, v, __ATOMIC_RELAXED, __HIP_MEMORY_SCOPE_AGENT); }
__device__ __forceinline__ unsigned xb_xcc_id() { return (unsigned)__builtin_amdgcn_s_getreg((3 << 11) | 20) & 0xFu; }
#define XB_SPIN(cond, bar) do { unsigned _sp = 0; while (cond) { __builtin_amdgcn_s_sleep(1); \
    if ((++_sp & 255u) == 0u) { if (xb_ld(&(bar)[XB_TMO])) break; if (_sp > XB_SPIN_CAP) { atomicAdd(&(bar)[XB_TMO], 1u); break; } } } } while (0)
struct XcdBarrier { unsigned* bar; unsigned x; volatile LAS unsigned* st; };
__device__ __forceinline__ XcdBarrier xcd_barrier_post(unsigned* bar, volatile LAS unsigned* st) {
    XcdBarrier b; b.bar = bar; b.x = xb_xcc_id(); b.st = st;
    if (threadIdx.x == 0) (void)xb_add(&bar[XB_XCNT(b.x)], 1u);
    return b;
}
__device__ __forceinline__ void xcd_barrier_complete(unsigned* bar, unsigned x, unsigned& nloc, unsigned& nx) {
    const unsigned G = gridDim.x * gridDim.y * gridDim.z;
    unsigned sum, cnt, mine, sp = 0u;
    for (;;) {
        sum = 0u; cnt = 0u; mine = 0u;
#pragma unroll
        for (unsigned j = 0; j < 16; ++j) { const unsigned c = xb_ld(&bar[XB_XCNT(j)]); sum += c; cnt += (c > 0u) ? 1u : 0u; mine = (j == x) ? c : mine; }
        if (sum == G) break;
        __builtin_amdgcn_s_sleep(1);
        if ((++sp & 255u) == 0u) { if (xb_ld(&bar[XB_TMO])) break; if (sp > XB_SPIN_CAP) { atomicAdd(&bar[XB_TMO], 1u); break; } }
    }
    nloc = mine > 0u ? mine : 1u; nx = cnt > 0u ? cnt : 1u;
}
__device__ __forceinline__ void xcd_barrier(const XcdBarrier& b) {
    asm volatile("s_waitcnt vmcnt(0)" ::: "memory");
    __syncthreads();
    if (threadIdx.x == 0) {
        unsigned* bar = b.bar;
        __builtin_amdgcn_s_waitcnt(0);
        unsigned nloc = b.st[0], nx = b.st[1];
        if (nloc == 0u) { xcd_barrier_complete(bar, b.x, nloc, nx); b.st[0] = nloc; b.st[1] = nx; }
        const unsigned old = xb_add(&bar[XB_XSUB(b.x)], 1u);
        const unsigned gen = old / nloc;
        if (old + 1u == (gen + 1u) * nloc) {
            __builtin_amdgcn_fence(__ATOMIC_RELEASE, "agent");
            asm volatile("s_waitcnt vmcnt(0)" ::: "memory");
            const unsigned og = xb_add(&bar[XB_TOP], 1u);
            const unsigned tg = og / nx;
            if (og + 1u == (tg + 1u) * nx) xb_add(&bar[XB_TOPGEN], 1u);
            else XB_SPIN(xb_ld(&bar[XB_TOPGEN]) == tg, bar);
            __builtin_amdgcn_fence(__ATOMIC_ACQUIRE, "agent");
            xb_add(&bar[XB_XGEN(b.x)], 1u);
            asm volatile("s_waitcnt vmcnt(0)" ::: "memory");
        } else {
            XB_SPIN(xb_ld(&bar[XB_XGEN(b.x)]) == gen, bar);
            __builtin_amdgcn_fence(__ATOMIC_ACQUIRE, "agent");
            asm volatile("s_waitcnt vmcnt(0)" ::: "memory");
        }
    }
    __syncthreads();
}

constexpr int NWAVES = 8;
struct Args { const float* in[21]; float* out; unsigned char* ws; int ph_lo, ph_hi; };
struct Frame {
    LAS unsigned char* lds;
    unsigned* ctl;
    int tid, lane, wave, vcu, G;
    unsigned char* ws;
};
enum { I_X = 0, I_LNIG, I_LNIB, I_RW, I_RB, I_WIN, I_CAW, I_CBW, I_CBB, I_LCG, I_LCB, I_PW, I_PS, I_WOUT, I_LMG, I_LMB, I_WG, I_WU, I_WDN, I_LFG, I_LFB };

__device__ __forceinline__ void tr_item(const float* src, int srcN, int srccol0, bf16* dst, int dstK, int dstrow0, int k0, LAS float* scr, int lane) {
#pragma unroll 8
    for (int i = 0; i < 32; ++i) { const int kk = 2 * i + (lane >> 5); scr[kk * 33 + (lane & 31)] = src[(size_t)(k0 + kk) * srcN + srccol0 + (lane & 31)]; }
    LDS_WAIT(); asm volatile("" ::: "memory");
    const int c = lane & 7;
#pragma unroll
    for (int j = 0; j < 4; ++j) { const int n = (lane >> 3) + 8 * j; const LAS float* s = scr + (8 * c) * 33 + n;
        v4u o; o.x = pk2(s[0 * 33], s[1 * 33]); o.y = pk2(s[2 * 33], s[3 * 33]); o.z = pk2(s[4 * 33], s[5 * 33]); o.w = pk2(s[6 * 33], s[7 * 33]);
        *(GAS v4u*)(dst + (size_t)(dstrow0 + n) * dstK + k0 + 8 * c) = o; }
    LDS_WAIT(); asm volatile("" ::: "memory");
}
__device__ __forceinline__ void tr_item64(const float* src, int srcN, int srccol0, bf16* dst, int dstK, int dstrow0, int k0, LAS unsigned* scr, int lane) {
    const int kr = lane >> 4, c4 = lane & 15;
    const float* sp = src + (size_t)(k0 + 2 * kr) * srcN + srccol0 + 4 * c4;
    f32x4 A[8], B[8];
#pragma unroll
    for (int i = 0; i < 8; ++i) { A[i] = *(const GAS f32x4*)(sp + (size_t)(8 * i) * srcN); B[i] = *(const GAS f32x4*)(sp + (size_t)(8 * i + 1) * srcN); }
#pragma unroll
    for (int i = 0; i < 8; ++i) { LAS unsigned* w = scr + (4 * i + kr) * 65 + 4 * c4;
        w[0] = pk2(A[i].x, B[i].x); w[1] = pk2(A[i].y, B[i].y); w[2] = pk2(A[i].z, B[i].z); w[3] = pk2(A[i].w, B[i].w); }
    LDS_WAIT(); asm volatile("" ::: "memory");
    const int q = lane & 7, nn = lane >> 3;
#pragma unroll
    for (int j = 0; j < 8; ++j) { const int n = nn + 8 * j; const LAS unsigned* r = scr + (4 * q) * 65 + n;
        v4u o; o.x = r[0]; o.y = r[65]; o.z = r[130]; o.w = r[195];
        *(GAS v4u*)(dst + (size_t)(dstrow0 + n) * dstK + k0 + 8 * q) = o; }
    LDS_WAIT(); asm volatile("" ::: "memory");
}
template <int NS, bool I8 = false>
__device__ __forceinline__ void tr_item64_f8(const float* src, int srcN, int srccol0, unsigned char* dst, int dstKB, int dstrow0, int k0, float scale, LAS unsigned* scr, int lane, bool nostore = false, f32x4 cinv = (f32x4){1.f, 1.f, 1.f, 1.f}) {
    const int kr = lane >> 4, c4 = lane & 15;
    const float* sp = src + (size_t)(k0 + 4 * kr) * srcN + srccol0 + 4 * c4;
    f32x4 A[NS][4][4];
#pragma unroll
    for (int s = 0; s < NS; ++s)
#pragma unroll
        for (int i = 0; i < 4; ++i)
#pragma unroll
            for (int t = 0; t < 4; ++t) A[s][i][t] = __builtin_nontemporal_load((const GAS f32x4*)(sp + (size_t)(64 * s + 16 * i + t) * srcN));
#pragma unroll
    for (int s = 0; s < NS; ++s)
#pragma unroll
        for (int i = 0; i < 4; ++i) { LAS unsigned* w = scr + (16 * s + 4 * i + kr) * 65 + 4 * c4;
            if constexpr (I8) {
            w[0] = pk4_i8(A[s][i][0].x * cinv.x, A[s][i][1].x * cinv.x, A[s][i][2].x * cinv.x, A[s][i][3].x * cinv.x); w[1] = pk4_i8(A[s][i][0].y * cinv.y, A[s][i][1].y * cinv.y, A[s][i][2].y * cinv.y, A[s][i][3].y * cinv.y);
            w[2] = pk4_i8(A[s][i][0].z * cinv.z, A[s][i][1].z * cinv.z, A[s][i][2].z * cinv.z, A[s][i][3].z * cinv.z); w[3] = pk4_i8(A[s][i][0].w * cinv.w, A[s][i][1].w * cinv.w, A[s][i][2].w * cinv.w, A[s][i][3].w * cinv.w); } else {
            w[0] = pk4_fp8(A[s][i][0].x * scale, A[s][i][1].x * scale, A[s][i][2].x * scale, A[s][i][3].x * scale); w[1] = pk4_fp8(A[s][i][0].y * scale, A[s][i][1].y * scale, A[s][i][2].y * scale, A[s][i][3].y * scale);
            w[2] = pk4_fp8(A[s][i][0].z * scale, A[s][i][1].z * scale, A[s][i][2].z * scale, A[s][i][3].z * scale); w[3] = pk4_fp8(A[s][i][0].w * scale, A[s][i][1].w * scale, A[s][i][2].w * scale, A[s][i][3].w * scale); } }
    LDS_WAIT(); asm volatile("" ::: "memory");
    constexpr int QN = 4 * NS, RN = 64 / QN;
    const int q = lane % QN, nn = lane / QN;
#pragma unroll
    for (int j = 0; j < 64 / RN; ++j) { const int n = nn + RN * j; const LAS unsigned* r = scr + (4 * q) * 65 + n;
        v4u o; o.x = r[0]; o.y = r[65]; o.z = r[130]; o.w = r[195];
        if (nostore) asm volatile("" :: "v"(o)); else *(GAS v4u*)(dst + (size_t)(dstrow0 + n) * dstKB + k0 + 16 * q) = o; }
    LDS_WAIT(); asm volatile("" ::: "memory");
}
__device__ __forceinline__ int win_src(int c0) {
    const int pn = c0 >> 8, j = c0 & 255, half = j >> 7, jj = j & 127;
    if (pn < 3) { const int ch = pn * 128 + jj; return half == 0 ? 384 + ch : 768 + ch; }
    if (pn < 6) { const int ch = (pn - 3) * 128 + jj; return half == 0 ? 1152 + ch : 1536 + ch; }
    if (pn < 8) { const int q = (pn - 6) * 256 + j; return q < 384 ? q : 1920 + (q - 384); }
    return j < 128 ? 1920 + 128 + j : -1;
}
__device__ __forceinline__ void p0_prologue(Frame& F, const Args& A) {
    LAS float* scr = (LAS float*)(F.lds + F.wave * 8448);
    LAS unsigned* scu = (LAS unsigned*)scr;
    const int gw = F.vcu * NWAVES + F.wave, NGW = F.G * NWAVES, lane = F.lane;
    bf16* WIN = (bf16*)(F.ws + WS_WIN); bf16* WOUT = (bf16*)(F.ws + WS_WOUT); unsigned char* WGU = F.ws + WS_WGU; unsigned char* WD = F.ws + WS_WD; bf16* WRT = (bf16*)(F.ws + WS_WRT);
    constexpr int I_M = GEMM1_I8 ? NL * 36 * 8 : 0, I_A = GEMM1_I8 ? NL * 36 * 8 : NL * 16 * 36, I_B = NL * 12 * 16, I_C = NL * NE * 128, I_D = NL * NE * 64, I_E = 16, I_F = NL * 4 * 16 * 2;
    constexpr int NITEMS = I_M + I_A + I_B + I_C + I_D + I_E + I_F;
    const int lane0 = lane;
#pragma unroll 1
    for (int prep = 0; prep < ((PROBE_P0 == 1 || PROBE_P0 == 3) ? 2 : 1); ++prep)
    for (int it = gw; it < NITEMS; it += NGW) {
        int lane = lane0; asm volatile("" : "+v"(lane));
        int r = it;
        if (r < I_M) {
            const int l = r / 288, q = r % 288, cb = q >> 3, kq = q & 7, c0 = cb * 64, sc = win_src(c0), kr = lane >> 4, c4 = lane & 15;
            if (sc >= 0) { const float* sp = A.in[I_WIN] + (size_t)l * 1024 * DIN + (size_t)(kq * 128 + kr) * DIN + sc + 4 * c4;
                f32x4 vv[32];
#pragma unroll
                for (int i = 0; i < 32; ++i) vv[i] = *(const GAS f32x4*)(sp + (size_t)(4 * i) * DIN);
                f32x4 mx = (f32x4){0.f, 0.f, 0.f, 0.f};
#pragma unroll
                for (int i = 0; i < 32; ++i) { mx.x = fmaxf(mx.x, fabsf(vv[i].x)); mx.y = fmaxf(mx.y, fabsf(vv[i].y)); mx.z = fmaxf(mx.z, fabsf(vv[i].z)); mx.w = fmaxf(mx.w, fabsf(vv[i].w)); }
#pragma unroll
                for (int o = 16; o <= 32; o <<= 1) { mx.x = fmaxf(mx.x, __shfl_xor(mx.x, o)); mx.y = fmaxf(mx.y, __shfl_xor(mx.y, o)); mx.z = fmaxf(mx.z, __shfl_xor(mx.z, o)); mx.w = fmaxf(mx.w, __shfl_xor(mx.w, o)); }
                if (kr == 0) { unsigned* cm = F.ctl + CW_CMAX + l * N1 + c0 + 4 * c4;
                    __hip_atomic_fetch_max(cm + 0, __float_as_uint(mx.x), RLX_AGENT); __hip_atomic_fetch_max(cm + 1, __float_as_uint(mx.y), RLX_AGENT);
                    __hip_atomic_fetch_max(cm + 2, __float_as_uint(mx.z), RLX_AGENT); __hip_atomic_fetch_max(cm + 3, __float_as_uint(mx.w), RLX_AGENT); } }
            VM_WAIT();
            if (lane == 0) __hip_atomic_fetch_add(F.ctl + CW_CMAXCNT, 1u, RLX_AGENT);
            continue; }
        r -= I_M;
        if (r < I_C) {
            const int le = r >> 7, q = r & 127, kb = q >> 4, nb = q & 15, n0 = nb * 64, pn = n0 >> 8, half = (n0 & 255) >> 7, jj0 = n0 & 127;
            const float* src = (half ? A.in[I_WU] : A.in[I_WG]) + (size_t)le * 1024 * 512;
            tr_item64_f8<2>(src, 512, pn * 128 + jj0, WGU + (size_t)le * 1024 * 1024, 1024, n0, kb * 128, 32.0f, scu, lane, PROBE_P0 == 3 && prep == 1); continue; }
        r -= I_C;
        if (r < I_D) {
            const int le = r >> 6, q = r & 63, kb = q >> 4, nb = q & 15;
            tr_item64_f8<2>(A.in[I_WDN] + (size_t)le * 512 * 1024, 1024, nb * 64, WD + (size_t)le * 1024 * 512, 512, nb * 64, kb * 128, 32.0f, scu, lane, PROBE_P0 == 3 && prep == 1); continue; }
        r -= I_D;
        if (r < I_A) {
            if (GEMM1_I8) {
                const int l = r / 288, q = r % 288, cb = q >> 3, kb = q & 7, c0 = cb * 64, sc = win_src(c0), c4 = lane & 15;
                unsigned char* dst = F.ws + WS_WIN + (size_t)l * N1 * 1024;
                { unsigned spins = 0;
                  while (__hip_atomic_load(F.ctl + CW_CMAXCNT, RLX_AGENT) < (unsigned)I_M * ((PROBE_P0 == 1 || PROBE_P0 == 3) ? (unsigned)(prep + 1) : 1u)) { __builtin_amdgcn_s_sleep(8); if (++spins > (1u << 22)) break; } }
                if (sc >= 0) { const unsigned* cm = F.ctl + CW_CMAX + l * N1 + c0 + 4 * c4;
                    f32x4 mx; mx.x = __uint_as_float(__hip_atomic_load(cm + 0, RLX_AGENT)); mx.y = __uint_as_float(__hip_atomic_load(cm + 1, RLX_AGENT)); mx.z = __uint_as_float(__hip_atomic_load(cm + 2, RLX_AGENT)); mx.w = __uint_as_float(__hip_atomic_load(cm + 3, RLX_AGENT));
                    f32x4 cinv; cinv.x = mx.x > 0.f ? 127.f / mx.x : 0.f; cinv.y = mx.y > 0.f ? 127.f / mx.y : 0.f; cinv.z = mx.z > 0.f ? 127.f / mx.z : 0.f; cinv.w = mx.w > 0.f ? 127.f / mx.w : 0.f;
                    tr_item64_f8<2, true>(A.in[I_WIN] + (size_t)l * 1024 * DIN, DIN, sc, dst, 1024, c0, kb * 128, 1.f, scu, lane, false, cinv);
                } else { for (int qq = lane; qq < 64 * 8; qq += 64) *(GAS v4u*)(dst + (size_t)(c0 + (qq >> 3)) * 1024 + kb * 128 + (qq & 7) * 16) = (v4u){0u, 0u, 0u, 0u}; }
                continue; }
            const int l = r / 576, q = r % 576, kb = q / 36, nb = q % 36, c0 = nb * 64, sc = win_src(c0);
            bf16* dst = WIN + (size_t)l * N1 * 1024;
            if (sc >= 0) tr_item64(A.in[I_WIN] + (size_t)l * 1024 * DIN, DIN, sc, dst, 1024, c0, kb * 64, scu, lane);
            else { const int c = lane & 7;
#pragma unroll
                for (int j = 0; j < 8; ++j) { const int n = (lane >> 3) + 8 * j; *(GAS v4u*)(dst + (size_t)(c0 + n) * 1024 + kb * 64 + 8 * c) = (v4u){0u, 0u, 0u, 0u}; } }
            continue; }
        r -= I_A;
        if (r < I_B) {
            const int l = r / 192, q = r % 192, kb = q >> 4, nb = q & 15;
            if (GEMM2_FP8) tr_item64_f8<1>(A.in[I_WOUT] + (size_t)l * 1024 * 1024, 1024, nb * 64, (unsigned char*)WOUT + (size_t)l * 1024 * 1024, 1024, nb * 64, kb * 64, 32.0f, scu, lane);
            else tr_item64(A.in[I_WOUT] + (size_t)l * 1024 * 1024, 1024, nb * 64, WOUT + (size_t)l * 1024 * 1024, 1024, nb * 64, kb * 64, scu, lane);
            continue; }
        r -= I_B;
        if (r < I_E) { tr_item(A.in[I_RW], 32, 0, WRT, 1024, 0, r * 64, scr, lane); continue; }
        r -= I_E;
        {
            const int l = r >> 7, g = (r >> 5) & 3, nb = (r >> 1) & 15, cb = r & 1, n = nb * 64 + lane;
            const float* wo = A.in[I_WOUT] + (size_t)l * 1024 * 1024 + (size_t)(768 + g * 64) * 1024 + n;
            const float* ps = A.in[I_PS] + l * 256 + g * 64;
            const float* pw = A.in[I_PW] + (size_t)(l * 4 + g) * 64 * 64 + cb * 32 * 64;
#pragma unroll
            for (int i = 0; i < 8; ++i) *(LAS f32x4*)(scr + (i * 64 + lane) * 4) = *(const GAS f32x4*)(pw + (i * 64 + lane) * 4);
            float wv[64];
#pragma unroll
            for (int d = 0; d < 64; ++d) wv[d] = wo[(size_t)d * 1024] * ps[d];
            LDS_WAIT(); asm volatile("" ::: "memory");
            bf16* dst = WOUT + (size_t)l * 1024 * 1024 + (size_t)n * 1024 + 768 + g * 64 + cb * 32;
#pragma unroll 1
            for (int c2 = 0; c2 < 16; ++c2) { float o[2];
#pragma unroll
                for (int cc = 0; cc < 2; ++cc) { const LAS f32x4* pr = (const LAS f32x4*)(scr + (c2 * 2 + cc) * 64); float a = 0.f;
#pragma unroll
                    for (int d4 = 0; d4 < 16; ++d4) { const f32x4 p = pr[d4]; a += p.x * wv[4 * d4] + p.y * wv[4 * d4 + 1] + p.z * wv[4 * d4 + 2] + p.w * wv[4 * d4 + 3]; }
                    o[cc] = a; }
                if (GEMM2_FP8) *(GAS unsigned short*)((unsigned char*)WOUT + (size_t)l * 1024 * 1024 + (size_t)n * 1024 + 768 + g * 64 + cb * 32 + c2 * 2) = (unsigned short)pk4_fp8(o[0] * 32.0f, o[1] * 32.0f, 0.f, 0.f);
                else *(GAS unsigned*)(dst + c2 * 2) = pk2(o[0], o[1]); }
            LDS_WAIT(); asm volatile("" ::: "memory");
        }
    }
    bf16* HB = (bf16*)(F.ws + WS_HB);
    const float* g = A.in[I_LNIG]; const float* b = A.in[I_LNIB];
    f32x4 gv[4], bv[4];
#pragma unroll
    for (int j = 0; j < 4; ++j) { gv[j] = *(const f32x4*)(g + 4 * lane + 256 * j); bv[j] = *(const f32x4*)(b + 4 * lane + 256 * j); }
    __builtin_amdgcn_s_waitcnt(0x0F70);
#pragma unroll 1
    for (int prep2 = 0; prep2 < ((PROBE_P0 == 2) ? 2 : 1); ++prep2)
    for (int m0 = gw * 2; m0 < T_; m0 += NGW * 2) {
        f32x4 v[2][4];
#pragma unroll
        for (int u = 0; u < 2; ++u) { const GAS f32x4* xr = (const GAS f32x4*)(A.in[I_X] + (size_t)(m0 + u) * D_) + lane;
#pragma unroll
            for (int j = 0; j < 4; ++j) v[u][j] = __builtin_nontemporal_load(xr + 64 * j); }
        {
            float s0, s1;
#pragma unroll
            for (int u = 0; u < 2; ++u) { f32x2 sa = (f32x2){0.f, 0.f};
#pragma unroll
                for (int j = 0; j < 4; ++j) { sa += __builtin_shufflevector(v[u][j], v[u][j], 0, 1); sa += __builtin_shufflevector(v[u][j], v[u][j], 2, 3); }
                if (u == 0) s0 = sa.x + sa.y; else s1 = sa.x + sa.y; }
            wave_sum2(s0, s1);
            float q0, q1;
#pragma unroll
            for (int u = 0; u < 2; ++u) { const float mean = (u == 0 ? s0 : s1) * (1.f / D_); f32x2 qa = (f32x2){0.f, 0.f};
#pragma unroll
                for (int j = 0; j < 4; ++j) { v[u][j] = v[u][j] - mean; const f32x2 lo = __builtin_shufflevector(v[u][j], v[u][j], 0, 1), hi = __builtin_shufflevector(v[u][j], v[u][j], 2, 3); qa = lo * lo + qa; qa = hi * hi + qa; }
                if (u == 0) q0 = qa.x + qa.y; else q1 = qa.x + qa.y; }
            wave_sum2(q0, q1);
            float am0 = 0.f, am1 = 0.f;
#pragma unroll
            for (int u = 0; u < 2; ++u) { const float rstd = __builtin_amdgcn_rsqf((u == 0 ? q0 : q1) * (1.f / D_) + LN_EPS);
                GAS v2u* o8 = (GAS v2u*)(HB + (size_t)(m0 + u) * D_) + lane; float amax = 0.f;
#pragma unroll
                for (int j = 0; j < 4; ++j) { const f32x4 o = v[u][j] * rstd * gv[j] + bv[j]; v[u][j] = o; if (!(RESID_I8 && GEMM1_I8)) { v2u w; w.x = pk2(o.x, o.y); w.y = pk2(o.z, o.w); o8[64 * j] = w; }
                    amax = fmaxf(amax, fmaxf(fmaxf(fabsf(o.x), fabsf(o.y)), fmaxf(fabsf(o.z), fabsf(o.w)))); }
                if (u == 0) am0 = amax; else am1 = amax; }
            if (GEMM1_I8) {
                wave_max2(am0, am1);
#pragma unroll
                for (int u = 0; u < 2; ++u) { const float amax = u == 0 ? am0 : am1, inv = amax > 0.f ? 127.f / amax : 0.f;
                    GAS unsigned* q4 = (GAS unsigned*)(F.ws + WS_HQ + (size_t)(m0 + u) * D_) + lane;
#pragma unroll
                    for (int j = 0; j < 4; ++j) q4[64 * j] = pk4_i8(v[u][j].x * inv, v[u][j].y * inv, v[u][j].z * inv, v[u][j].w * inv);
                    if (lane == 0) ((float*)(F.ws + WS_HS))[m0 + u] = amax * (1.f / 127.f); } }
        }
    }
}

__device__ __forceinline__ void p2_mixer(Frame& F, const Args& A, int l) {
    LAS unsigned* BV = (LAS unsigned*)F.lds;
    LAS unsigned* PB = (LAS unsigned*)(F.lds + 47616);
    LAS float* V = (LAS float*)(F.lds + 71680);
    LAS float* LGB = (LAS float*)(F.lds + 120832);
    LAS float* WA = (LAS float*)(F.lds + 123904);
    const bf16* Z = (const bf16*)(F.ws + WS_Z); bf16* Y = (bf16*)(F.ws + WS_Y);
    const float* wB = A.in[I_CBW] + l * 31 * 384; const float* bB = A.in[I_CBB] + l * 384;
    const float* lg = A.in[I_LCG] + l * 384; const float* lb = A.in[I_LCB] + l * 384; const float* wA = A.in[I_CAW] + l * 3 * 384;
    int tid = F.tid; asm volatile("" : "+v"(tid));
    const int lane = tid & 63, wave = F.wave;
    const bool convt = tid < 384; const int cp = tid % 192, tg = tid / 192;
    v4u pre[9];
#define MIX_PREFETCH(ci_, tid_) do { const int _t0 = (ci_) * 32, _s0 = _t0 & (SEQ_ - 1); \
        _Pragma("unroll") for (int _i = 0; _i < 6; ++_i) { const int _q = (tid_) + 512 * _i; const int _qq = _q < 62 * 48 ? _q : 0; const int _r = _qq / 48, _c = _qq % 48; \
            const int _rr = (_s0 - 30 + _r >= 0) ? _r : 30; pre[_i] = __builtin_nontemporal_load((const GAS v4u*)(Z + (size_t)(_t0 - 30 + _rr) * NZ + 768 + _c * 8)); } \
        _Pragma("unroll") for (int _i = 0; _i < 3; ++_i) { const int _q = (tid_) + 512 * _i; const int _qq = _q < 47 * 32 ? _q : 0; const int _r = _qq >> 5, _c = _qq & 31; \
            const int _rr = (_s0 - 15 + _r >= 0) ? _r : 15; pre[6 + _i] = __builtin_nontemporal_load((const GAS v4u*)(Z + (size_t)(_t0 - 15 + _rr) * NZ + 1152 + _c * 8)); } } while (0)
    if (F.vcu < T_ / 32) MIX_PREFETCH(F.vcu, tid);
    f32x2 w[31]; f32x2 bias = (f32x2){0.f, 0.f};
#pragma unroll
    for (int j = 0; j < 31; ++j) w[j] = (f32x2){0.f, 0.f};
    if (convt) {
#pragma unroll
        for (int j = 0; j < 31; ++j) w[j] = *(const f32x2*)(wB + j * 384 + 2 * cp);
        bias = *(const f32x2*)(bB + 2 * cp); }
    for (int q = tid; q < 384; q += 512) { LGB[q] = lg[q]; LGB[384 + q] = lb[q]; }
    for (int q = tid; q < 3 * 384; q += 512) WA[q] = wA[q];
    __builtin_amdgcn_s_waitcnt(0x0F70);
    for (int ci = F.vcu; ci < T_ / 32; ci += F.G) {
        const int t0 = ci * 32, s0 = t0 & (SEQ_ - 1);
#pragma unroll
        for (int i = 0; i < 6; ++i) { const int q = tid + 512 * i; if (q < 62 * 48) { const int r = q / 48, c = q % 48;
            *(LAS v4u*)(BV + r * 192 + c * 4) = (s0 - 30 + r >= 0) ? pre[i] : (v4u){0u, 0u, 0u, 0u}; } }
#pragma unroll
        for (int i = 0; i < 3; ++i) { const int q = tid + 512 * i; if (q < 47 * 32) { const int r = q >> 5, c = q & 31;
            *(LAS v4u*)(PB + r * 128 + c * 4) = (s0 - 15 + r >= 0) ? pre[6 + i] : (v4u){0u, 0u, 0u, 0u}; } }
        __syncthreads();
        { int cn = ci + F.G; asm volatile("" : "+s"(cn)); int tidp = tid; asm volatile("" : "+v"(tidp));
          if (cn < T_ / 32) MIX_PREFETCH(cn, tidp); }
        if (PROBE_MIX == 3) { int cn = ci + F.G; asm volatile("" : "+s"(cn)); int tidp = tid; asm volatile("" : "+v"(tidp));
          if (cn < T_ / 32) { v4u sink[9]; const int _t0 = cn * 32;
#pragma unroll
              for (int i = 0; i < 6; ++i) { const int q = tidp + 512 * i, qq = q < 62 * 48 ? q : 0, r = qq / 48, c = qq % 48; sink[i] = *(const GAS v4u*)(Z + (size_t)(_t0 + r) * NZ + 768 + c * 8 + 8); }
#pragma unroll
              for (int i = 0; i < 3; ++i) { const int q = tidp + 512 * i, qq = q < 47 * 32 ? q : 0, r = qq >> 5, c = qq & 31; sink[6 + i] = *(const GAS v4u*)(Z + (size_t)(_t0 + r) * NZ + 1152 + c * 8); }
#pragma unroll
              for (int i = 0; i < 9; ++i) asm volatile("" :: "v"(sink[i])); } }
#pragma unroll 1
        for (int prep = 0; prep < ((PROBE_MIX == 1) ? 2 : 1); ++prep)
        if (convt) {
#pragma unroll 1
            for (int hh = 0; hh < 2; ++hh) { const int tb = tg * 16 + hh * 8;
                f32x2 x[38];
#pragma unroll
                for (int i = 0; i < 38; ++i) { const unsigned u = BV[(tb + i) * 192 + cp]; x[i] = (f32x2){bflo(u), bfhi(u)}; }
#pragma unroll
                for (int tt = 0; tt < 8; ++tt) { f32x2 a = bias;
#pragma unroll
                    for (int j = 0; j < 31; ++j) a += w[j] * x[tt + j];
                    *(LAS f32x2*)(V + (tb + tt) * 384 + 2 * cp) = a; }
            }
        } else {
            const int p = tid - 384, g = p >> 5, wd = 2 << g;
            f32x2 s = (f32x2){0.f, 0.f};
            for (int i = 1; i < wd; ++i) { const unsigned u = PB[(15 - i) * 128 + p]; s += (f32x2){bflo(u), bfhi(u)}; }
#pragma unroll 1
            for (int blk = 0; blk < 4; ++blk) {
                unsigned xr[23];
#pragma unroll
                for (int i = 0; i < 23; ++i) xr[i] = PB[(8 * blk + i) * 128 + p];
#pragma unroll
                for (int j = 0; j < 8; ++j) { const int tt = 8 * blk + j; const f32x2 xv = (f32x2){bflo(xr[15 + j]), bfhi(xr[15 + j])};
                    s += xv; const int n = (s0 + tt + 1) < wd ? (s0 + tt + 1) : wd; const float inv = __builtin_amdgcn_rcpf((float)n);
                    const f32x2 dd = s * inv - xv;
                    if (GEMM2_FP8) *(GAS unsigned short*)((unsigned char*)Y + (size_t)(t0 + tt) * D_ + 768 + 2 * p) = (unsigned short)pk4_fp8(dd.x, dd.y, 0.f, 0.f);
                    else *(GAS unsigned*)(Y + (size_t)(t0 + tt) * D_ + 768 + 2 * p) = pk2(dd.x, dd.y);
                    const unsigned u2 = xr[15 + j - 1], u4 = xr[15 + j - 3], u8 = xr[15 + j - 7], u16 = xr[j];
                    const unsigned uo = g == 0 ? u2 : (g == 1 ? u4 : (g == 2 ? u8 : u16));
                    s -= (f32x2){bflo(uo), bfhi(uo)}; }
            }
        }
        __syncthreads();
        v4u ya[3][4];
        int t0o = t0; asm volatile("" : "+s"(t0o));
        int tidl = tid; asm volatile("" : "+v"(tidl));
#pragma unroll
        for (int i = 0; i < 3; ++i) { const int q = tidl + 512 * i, tt = q / 48, o8 = q % 48, pos = (t0o & (SEQ_ - 1)) + tt; const size_t row = (size_t)(t0o + tt);
            ya[i][0] = __builtin_nontemporal_load((const GAS v4u*)(Z + row * NZ + o8 * 8));
            ya[i][1] = *(const GAS v4u*)(Z + row * NZ + 384 + o8 * 8);
            ya[i][2] = *(const GAS v4u*)(Z + (row - (pos >= 1 ? 1 : 0)) * NZ + 384 + o8 * 8);
            ya[i][3] = *(const GAS v4u*)(Z + (row - (pos >= 2 ? 2 : 0)) * NZ + 384 + o8 * 8); }
#pragma unroll
        for (int tp = 0; tp < 2; ++tp) {
            f32x2 v[2][3]; float s0, s1;
#pragma unroll
            for (int tk = 0; tk < 2; ++tk) { const int tt = wave * 4 + tp * 2 + tk; f32x2 sa = (f32x2){0.f, 0.f};
#pragma unroll
                for (int i = 0; i < 3; ++i) { v[tk][i] = *(const LAS f32x2*)(V + tt * 384 + 2 * lane + 128 * i); sa += v[tk][i]; }
                if (tk == 0) s0 = sa.x + sa.y; else s1 = sa.x + sa.y; }
            wave_sum2(s0, s1);
            float q0, q1;
#pragma unroll
            for (int tk = 0; tk < 2; ++tk) { const float mean = (tk == 0 ? s0 : s1) * (1.f / 384.f); f32x2 qa = (f32x2){0.f, 0.f};
#pragma unroll
                for (int i = 0; i < 3; ++i) { v[tk][i] = v[tk][i] - mean; qa = v[tk][i] * v[tk][i] + qa; }
                if (tk == 0) q0 = qa.x + qa.y; else q1 = qa.x + qa.y; }
            wave_sum2(q0, q1);
#pragma unroll
            for (int tk = 0; tk < 2; ++tk) { const int tt = wave * 4 + tp * 2 + tk; const float rstd = __builtin_amdgcn_rsqf((tk == 0 ? q0 : q1) * (1.f / 384.f) + LN_EPS);
#pragma unroll
                for (int i = 0; i < 3; ++i) { const int c = 2 * lane + 128 * i; const f32x2 gg = *(const LAS f32x2*)(LGB + c), bb = *(const LAS f32x2*)(LGB + 384 + c);
                    f32x2 o = v[tk][i] * rstd * gg + bb; o.x = o.x * sigmoidf_(o.x); o.y = o.y * sigmoidf_(o.y);
                    if (GEMM2_FP8) *(GAS unsigned short*)((unsigned char*)Y + (size_t)(t0 + tt) * D_ + 384 + c) = (unsigned short)pk4_fp8(o.x, o.y, 0.f, 0.f);
                    else *(GAS unsigned*)(Y + (size_t)(t0 + tt) * D_ + 384 + c) = pk2(o.x, o.y); } }
        }
#pragma unroll
        for (int i = 0; i < 3; ++i) { const int q = tid + 512 * i, tt = q / 48, o8 = q % 48, pos = s0 + tt; const size_t row = (size_t)(t0 + tt);
            const v4u gb = ya[i][0], x0 = ya[i][1]; v4u x1 = ya[i][2], x2 = ya[i][3];
            if (pos < 1) x1 = (v4u){0u, 0u, 0u, 0u};
            if (pos < 2) x2 = (v4u){0u, 0u, 0u, 0u};
            const LAS f32x4* wp = (const LAS f32x4*)(WA + o8 * 8);
            const f32x4 w0a = wp[0], w0b = wp[1], w1a = wp[96], w1b = wp[97], w2a = wp[192], w2b = wp[193];
            float o[8];
            const unsigned gbw[4] = {gb.x, gb.y, gb.z, gb.w}, x0w[4] = {x0.x, x0.y, x0.z, x0.w}, x1w[4] = {x1.x, x1.y, x1.z, x1.w}, x2w[4] = {x2.x, x2.y, x2.z, x2.w};
            const float w2[8] = {w2a.x, w2a.y, w2a.z, w2a.w, w2b.x, w2b.y, w2b.z, w2b.w}, w1[8] = {w1a.x, w1a.y, w1a.z, w1a.w, w1b.x, w1b.y, w1b.z, w1b.w}, w0[8] = {w0a.x, w0a.y, w0a.z, w0a.w, w0b.x, w0b.y, w0b.z, w0b.w};
#pragma unroll
            for (int e = 0; e < 4; ++e) {
                o[2 * e] = bflo(gbw[e]) * (w2[2 * e] * bflo(x0w[e]) + w1[2 * e] * bflo(x1w[e]) + w0[2 * e] * bflo(x2w[e]));
                o[2 * e + 1] = bfhi(gbw[e]) * (w2[2 * e + 1] * bfhi(x0w[e]) + w1[2 * e + 1] * bfhi(x1w[e]) + w0[2 * e + 1] * bfhi(x2w[e])); }
            if (GEMM2_FP8) { v2u ov; ov.x = pk4_fp8(o[0], o[1], o[2], o[3]); ov.y = pk4_fp8(o[4], o[5], o[6], o[7]); *(GAS v2u*)((unsigned char*)Y + row * D_ + o8 * 8) = ov; }
            else { v4u ov; ov.x = pk2(o[0], o[1]); ov.y = pk2(o[2], o[3]); ov.z = pk2(o[4], o[5]); ov.w = pk2(o[6], o[7]);
            *(GAS v4u*)(Y + row * D_ + o8 * 8) = ov; } }
        __syncthreads();
    }
#undef MIX_PREFETCH
}

__device__ __forceinline__ void top2of4(float q0, float q1, float q2, float q3, float& a1, int& i1, float& a2, int& i2) {
    a1 = q0; i1 = 0; a2 = -1.f; i2 = 1;
#define T2STEP(qv, r) { const bool gt = (qv) > a1; const bool g2 = (qv) > a2; const float na2 = gt ? a1 : (g2 ? (qv) : a2); const int ni2 = gt ? i1 : (g2 ? (r) : i2); \
        a1 = gt ? (qv) : a1; i1 = gt ? (r) : i1; a2 = na2; i2 = ni2; }
    T2STEP(q1, 1) T2STEP(q2, 2) T2STEP(q3, 3)
#undef T2STEP
}
__device__ __forceinline__ void p4_ln_router(Frame& F, const Args& A, int l) {
    LAS unsigned char* lds = F.lds;
    constexpr bool UQ = U_I8 && RESID_I8 && GEMM1_I8 && GEMM2_FP8, NOHB = NO_HB1 && UQ;
    LAS int* cntl = (LAS int*)(lds + (NOHB ? 155648 : 66048)); LAS int* basel = cntl + 32; LAS int* sel = cntl + 64; LAS int* lpos = cntl + 64 + 256;
    const bf16* U = (const bf16*)(F.ws + WS_U); bf16* HB = (bf16*)(F.ws + WS_HB); unsigned char* H8 = F.ws + WS_H8; const bf16* WRT = (const bf16*)(F.ws + WS_WRT);
    int* route = (int*)(F.ws + WS_ROUTE); int* lists = (int*)(F.ws + WS_LISTS);
    unsigned* counts = F.ctl + CW_CNT + l * 32 * 64;
    const float* g = A.in[I_LMG] + l * D_; const float* b = A.in[I_LMB] + l * D_; const float* rb = A.in[I_RB];
    int tid = F.tid; asm volatile("" : "+v"(tid));
    const int lane = tid & 63, wave = F.wave, fr = lane & 15, fq = lane >> 4;
    for (int pc = wave; pc < 64; pc += 8) { const int e = pc >> 1, hf = pc & 1;
        pg8::glds16<0>((const char*)WRT, (unsigned)(e * 2048 + hf * 1024 + lane * 16), (unsigned)__builtin_amdgcn_readfirstlane((int)((unsigned)(size_t)lds + (unsigned)(e * 2064 + hf * 1024)))); }
    if (tid < 32) cntl[tid] = 0;
    f32x4 gv[4], bv[4];
#pragma unroll
    for (int j = 0; j < 4; ++j) { gv[j] = *(const f32x4*)(g + 4 * lane + 256 * j); bv[j] = *(const f32x4*)(b + 4 * lane + 256 * j); }
    __builtin_amdgcn_s_waitcnt(0x0F70);
    asm volatile("s_waitcnt lgkmcnt(0)" ::: "memory"); __builtin_amdgcn_s_barrier(); asm volatile("" ::: "memory");
    for (int blk = F.vcu; blk < T_ / 128; blk += F.G) {
        const unsigned char* U8 = F.ws + WS_U8; const float* US = (const float*)(F.ws + WS_U8 + 32 * MiB);
        v2u q[2][4][4];
#define P4_LOADROWS(dst, mm) do { _Pragma("unroll") for (int _u = 0; _u < 4; ++_u) { \
            if (UQ) { const GAS unsigned* _up = (const GAS unsigned*)(U8 + ((mm) + _u) * D_) + lane; const GAS float* _sp = (const GAS float*)(US + ((mm) + _u) * 32) + (lane >> 3); \
                _Pragma("unroll") for (int _j = 0; _j < 4; ++_j) { dst[_u][_j].x = _up[64 * _j]; dst[_u][_j].y = __float_as_uint(_sp[8 * _j]); } } \
            else { const GAS v2u* _up = (const GAS v2u*)(U + ((mm) + _u) * D_) + lane; _Pragma("unroll") for (int _j = 0; _j < 4; ++_j) dst[_u][_j] = _up[64 * _j]; } } } while (0)
        { const size_t m = (size_t)(blk * 128 + wave * 16); P4_LOADROWS(q[0], m); }
        LAS unsigned char* RB = lds + (F.wave < 7 ? 66048 + F.wave * 8192 : 147456);
        f32x4 acc0 = (f32x4){0.f, 0.f, 0.f, 0.f}, acc1 = (f32x4){0.f, 0.f, 0.f, 0.f};
        if (NOHB) { asm volatile("s_waitcnt vmcnt(0)" ::: "memory");
            __builtin_amdgcn_s_barrier(); asm volatile("" ::: "memory"); }
#pragma unroll
        for (int b = 0; b < 4; ++b) { const size_t m = (size_t)(blk * 128 + wave * 16 + b * 4);
            if (b < 3) {
                P4_LOADROWS(q[(b + 1) & 1], m + 4);
                asm volatile("" ::: "memory"); }
            {
                f32x4 vv[4][4]; float s0, s1, s2, s3;
#define P4_HALVES(x) __builtin_shufflevector(x, x, 0, 1), __builtin_shufflevector(x, x, 2, 3)
#pragma unroll
                for (int u = 0; u < 4; ++u) { f32x2 sa = (f32x2){0.f, 0.f};
#pragma unroll
                    for (int j = 0; j < 4; ++j) { const v2u qq = q[b & 1][u][j];
                        if (UQ) { const int qi = (int)qq.x; const float qs = __uint_as_float(qq.y); vv[u][j] = (f32x4){qs * (float)((qi << 24) >> 24), qs * (float)((qi << 16) >> 24), qs * (float)((qi << 8) >> 24), qs * (float)(qi >> 24)}; }
                        else vv[u][j] = (f32x4){bflo(qq.x), bfhi(qq.x), bflo(qq.y), bfhi(qq.y)};
                        const f32x2 lo = __builtin_shufflevector(vv[u][j], vv[u][j], 0, 1), hi = __builtin_shufflevector(vv[u][j], vv[u][j], 2, 3); sa += lo; sa += hi; }
                    const float su = sa.x + sa.y; if (u == 0) s0 = su; else if (u == 1) s1 = su; else if (u == 2) s2 = su; else s3 = su; }
                wave_sum4(s0, s1, s2, s3);
                float q0, q1, q2, q3;
#pragma unroll
                for (int u = 0; u < 4; ++u) { const float mean = (u == 0 ? s0 : u == 1 ? s1 : u == 2 ? s2 : s3) * (1.f / D_); f32x2 qa = (f32x2){0.f, 0.f};
#pragma unroll
                    for (int j = 0; j < 4; ++j) { vv[u][j] = vv[u][j] - mean;
                        const f32x2 lo = __builtin_shufflevector(vv[u][j], vv[u][j], 0, 1), hi = __builtin_shufflevector(vv[u][j], vv[u][j], 2, 3); qa = lo * lo + qa; qa = hi * hi + qa; }
                    const float qu = qa.x + qa.y; if (u == 0) q0 = qu; else if (u == 1) q1 = qu; else if (u == 2) q2 = qu; else q3 = qu; }
                wave_sum4(q0, q1, q2, q3);
#pragma unroll
                for (int u = 0; u < 4; ++u) { const float rstd = __builtin_amdgcn_rsqf((u == 0 ? q0 : u == 1 ? q1 : u == 2 ? q2 : q3) * (1.f / D_) + LN_EPS);
                    if (NOHB && lane == 0) *(GAS f32x2*)((float*)(F.ws + WS_U8 + 36 * MiB) + (m + u) * 2) = (f32x2){(u == 0 ? s0 : u == 1 ? s1 : u == 2 ? s2 : s3) * (1.f / D_), rstd};
                    GAS v2u* o8 = (GAS v2u*)(HB + (m + u) * D_) + lane; GAS unsigned* o4 = (GAS unsigned*)(H8 + (m + u) * D_) + lane;
#pragma unroll
                    for (int j = 0; j < 4; ++j) { const f32x4 o = vv[u][j] * rstd * gv[j] + bv[j]; v2u w; w.x = pk2(o.x, o.y); w.y = pk2(o.z, o.w);
                        if (NOHB) *(LAS v2u*)(RB + u * 2048 + (4 * lane + 256 * j) * 2) = w; else o8[64 * j] = w;
                        o4[64 * j] = pk4_fp8(o.x, o.y, o.z, o.w); } }
#undef P4_HALVES
            }
            if (NOHB) {
                f32x4 t0 = (f32x4){0.f, 0.f, 0.f, 0.f}, t1 = (f32x4){0.f, 0.f, 0.f, 0.f};
                const LAS unsigned char* hrowl = RB + (fr & 3) * 2048 + fq * 16;
#pragma unroll 8
                for (int k = 0; k < 32; ++k) { const int kk = k * 32 + fq * 8;
                    const bf16x8 hf = *(const LAS bf16x8*)(hrowl + k * 64);
                    const bf16x8 w0 = *(const LAS bf16x8*)(lds + fr * 2064 + kk * 2), w1 = *(const LAS bf16x8*)(lds + (16 + fr) * 2064 + kk * 2);
                    t0 = __builtin_amdgcn_mfma_f32_16x16x32_bf16(w0, hf, t0, 0, 0, 0);
                    t1 = __builtin_amdgcn_mfma_f32_16x16x32_bf16(w1, hf, t1, 0, 0, 0); }
                if ((fr >> 2) == b) { acc0 = t0; acc1 = t1; } }
        }
#undef P4_LOADROWS
        const int token = blk * 128 + wave * 16 + fr;
        if (!NOHB) {
        VM_WAIT(); asm volatile("" ::: "memory");
        __syncthreads();
        const bf16* hrow = HB + (size_t)token * D_ + fq * 8;
#pragma unroll 16
        for (int k = 0; k < 32; ++k) { const int kk = k * 32 + fq * 8;
            const bf16x8 hf = *(const GAS bf16x8*)(hrow + k * 32);
            const bf16x8 w0 = *(const LAS bf16x8*)(lds + fr * 2064 + kk * 2), w1 = *(const LAS bf16x8*)(lds + (16 + fr) * 2064 + kk * 2);
            acc0 = __builtin_amdgcn_mfma_f32_16x16x32_bf16(w0, hf, acc0, 0, 0, 0);
            acc1 = __builtin_amdgcn_mfma_f32_16x16x32_bf16(w1, hf, acc1, 0, 0, 0);
        } }
        float p0[4], p1[4]; float mx = -3.0e38f;
#pragma unroll
        for (int r = 0; r < 4; ++r) { p0[r] = acc0[r] + rb[4 * fq + r]; p1[r] = acc1[r] + rb[16 + 4 * fq + r]; mx = fmaxf(mx, fmaxf(p0[r], p1[r])); }
        mx = fmaxf(mx, __shfl_xor(mx, 16)); mx = fmaxf(mx, __shfl_xor(mx, 32));
#pragma unroll
        for (int r = 0; r < 4; ++r) { p0[r] = __expf(p0[r] - mx); p1[r] = __expf(p1[r] - mx); }
        float a1, a2, c1, c2; int ia1, ia2, ic1, ic2;
        top2of4(p0[0], p0[1], p0[2], p0[3], a1, ia1, a2, ia2); top2of4(p1[0], p1[1], p1[2], p1[3], c1, ic1, c2, ic2);
        const float sc0 = a1 + a2, sc1 = c1 + c2;
        float bs = sc0; int bg = fq; if (sc1 > sc0) { bs = sc1; bg = 4 + fq; }
#pragma unroll
        for (int off = 16; off <= 32; off <<= 1) { const float os = __shfl_xor(bs, off); const int og = __shfl_xor(bg, off); if (os > bs || (os == bs && og < bg)) { bs = os; bg = og; } }
        if ((bg & 3) == fq) {
            const bool hi = bg >= 4;
            const float pa = hi ? c1 : a1, pb = hi ? c2 : a2; const int ia = hi ? ic1 : ia1, ib = hi ? ic2 : ia2;
            const int ea = bg * 4 + ia, eb = bg * 4 + ib; const float inv = 1.0f / (pa + pb);
            const int tokl = wave * 16 + fr;
            const int la = atomicAdd((int*)&cntl[ea], 1), lb2 = atomicAdd((int*)&cntl[eb], 1);
            sel[tokl * 2] = ea; sel[tokl * 2 + 1] = eb; lpos[tokl * 2] = la; lpos[tokl * 2 + 1] = lb2;
            int* rt = route + (size_t)token * 8; rt[0] = ea; rt[2] = eb; rt[4] = __float_as_int(pa * inv); rt[5] = __float_as_int(pb * inv);
        }
        __syncthreads();
        if (tid < 32) { const int c = cntl[tid]; basel[tid] = c ? (int)__hip_atomic_fetch_add(counts + tid * 64, (unsigned)c, RLX_AGENT) : 0; }
        __syncthreads();
        if (tid < 256) { const int tokl = tid >> 1, k = tid & 1, e = sel[tid], pos = basel[e] + lpos[tid], tok = blk * 128 + tokl;
            lists[(size_t)e * 65536 + pos] = tok * 2 + k; route[(size_t)tok * 8 + 1 + 2 * k] = pos; }
        __syncthreads();
        if (tid < 32) cntl[tid] = 0;
        __syncthreads();
    }
}

__device__ __forceinline__ void moe_table(Frame& F, int l) {
    LAS int* tab = (LAS int*)(F.lds + TAB_OFF);
    __syncthreads();
    if (F.tid < 32) tab[40 + F.tid] = (int)__hip_atomic_load(F.ctl + CW_CNT + (l * 32 + F.tid) * 64, RLX_AGENT);
    __syncthreads();
    if (F.tid == 0) { int s = 0; for (int e = 0; e < 32; ++e) { tab[e] = s; s += (tab[40 + e] + 255) >> 8; } tab[32] = s; }
    __syncthreads();
    for (int t = F.tid; t < tab[32]; t += NWAVES * 64) { int e = 0; while (e < 31 && tab[e + 1] <= t) ++e; tab[80 + t] = e; }
    __syncthreads();
}

__device__ __forceinline__ void p7_combine_ln(Frame& F, const Args& A, int l) {
    const LAS int* tab = (const LAS int*)(F.lds + TAB_OFF);
    bf16* HB = (bf16*)(F.ws + WS_HB); const unsigned char* Y2S = F.ws + WS_Y2S; const int* route = (const int*)(F.ws + WS_ROUTE);
    const float* g = A.in[I_LFG] + l * D_; const float* b = A.in[I_LFB] + l * D_;
    int lane = F.lane; asm volatile("" : "+v"(lane));
    const int gw = F.vcu * NWAVES + F.wave, NGW = F.G * NWAVES;
    f32x4 gv[4], bv[4];
#pragma unroll
    for (int j = 0; j < 4; ++j) { gv[j] = *(const f32x4*)(g + 4 * lane + 256 * j); bv[j] = *(const f32x4*)(b + 4 * lane + 256 * j); }
    constexpr bool NOHB = NO_HB1 && U_I8 && RESID_I8 && GEMM1_I8 && GEMM2_FP8;
    const unsigned char* U8 = F.ws + WS_U8; const float* US = (const float*)(F.ws + WS_U8 + 32 * MiB);
    f32x4 gm[4], bm[4];
#pragma unroll
    for (int j = 0; j < 4; ++j) { gm[j] = NOHB ? *(const f32x4*)(A.in[I_LMG] + l * D_ + 4 * lane + 256 * j) : (f32x4){0.f, 0.f, 0.f, 0.f}; bm[j] = NOHB ? *(const f32x4*)(A.in[I_LMB] + l * D_ + 4 * lane + 256 * j) : (f32x4){0.f, 0.f, 0.f, 0.f}; }
    __builtin_amdgcn_s_waitcnt(0x0F70);
    const bool last = (l == NL - 1);
    const int step = NGW * 2;
    int R[2][6], Rn[2][6];
    v2u hq[2][4], hn[2][4]; unsigned aq[2][4], cq[2][4], an[2][4], cn[2][4]; f32x2 hst[2], hsn[2];
#define P7_ROUTE(m0_, R_) do { _Pragma("unroll") for (int _u = 0; _u < 2; ++_u) { const int* _rt = route + (size_t)((m0_) + _u) * 8; \
        _Pragma("unroll") for (int _k = 0; _k < 6; ++_k) R_[_u][_k] = _rt[_k]; } } while (0)
#define P7_ROWS(m0_, R_, hq_, aq_, cq_, hs_) do { _Pragma("unroll") for (int _u = 0; _u < 2; ++_u) { const int _m = (m0_) + _u; \
        hs_[_u] = NOHB ? *(const GAS f32x2*)((const float*)(F.ws + WS_U8 + 36 * MiB) + (size_t)_m * 2) : (f32x2){0.f, 0.f}; \
        const size_t _r0 = (size_t)tab[R_[_u][0]] * 256 + R_[_u][1], _r1 = (size_t)tab[R_[_u][2]] * 256 + R_[_u][3]; \
        const GAS v2u* _hp = (const GAS v2u*)(HB + (size_t)_m * D_) + lane; const GAS unsigned* _ya = (const GAS unsigned*)(Y2S + _r0 * D_) + lane; const GAS unsigned* _yb = (const GAS unsigned*)(Y2S + _r1 * D_) + lane; \
        const GAS unsigned* _uq = (const GAS unsigned*)(U8 + (size_t)_m * D_) + lane; const GAS float* _us = (const GAS float*)(US + (size_t)_m * 32) + (lane >> 3); \
        _Pragma("unroll") for (int _j = 0; _j < 4; ++_j) { if (NOHB) { hq_[_u][_j].x = _uq[64 * _j]; hq_[_u][_j].y = __float_as_uint(_us[8 * _j]); } else hq_[_u][_j] = _hp[64 * _j]; aq_[_u][_j] = _ya[64 * _j]; cq_[_u][_j] = _yb[64 * _j]; } } } while (0)
    int m0 = gw * 2;
    if (m0 < T_) { P7_ROUTE(m0, R); P7_ROWS(m0, R, hq, aq, cq, hst); if (m0 + step < T_) P7_ROUTE(m0 + step, Rn); }
    for (; m0 < T_; m0 += step) {
        const bool has_n = m0 + step < T_;
        int Rnn[2][6];
        if (has_n) P7_ROWS(m0 + step, Rn, hn, an, cn, hsn);
        if (m0 + 2 * step < T_) P7_ROUTE(m0 + 2 * step, Rnn);
        {
            f32x4 v[2][4]; float s0, s1;
#pragma unroll
            for (int u = 0; u < 2; ++u) { const float g0 = __int_as_float(R[u][4]), g1 = __int_as_float(R[u][5]), mh = hst[u].x, rh = hst[u].y; f32x2 sa = (f32x2){0.f, 0.f};
#pragma unroll
                for (int j = 0; j < 4; ++j) { f32x4 h1;
                    if (NOHB) { const int qi = (int)hq[u][j].x; const float qs = __uint_as_float(hq[u][j].y);
                        h1 = (f32x4){qs * (float)((qi << 24) >> 24), qs * (float)((qi << 16) >> 24), qs * (float)((qi << 8) >> 24), qs * (float)(qi >> 24)}; h1 = (h1 - mh) * rh * gm[j] + bm[j]; }
                    else { const v2u h = hq[u][j]; h1 = (f32x4){bflo(h.x), bfhi(h.x), bflo(h.y), bfhi(h.y)}; }
                    const unsigned a = aq[u][j], c = cq[u][j];
                    const f32x2 a01 = __builtin_amdgcn_cvt_pk_f32_fp8((int)a, false), a23 = __builtin_amdgcn_cvt_pk_f32_fp8((int)a, true), c01 = __builtin_amdgcn_cvt_pk_f32_fp8((int)c, false), c23 = __builtin_amdgcn_cvt_pk_f32_fp8((int)c, true);
                    const f32x4 a4 = (f32x4){a01.x, a01.y, a23.x, a23.y}, c4 = (f32x4){c01.x, c01.y, c23.x, c23.y};
                    v[u][j] = ALPHA * h1 + g0 * a4 + g1 * c4;
                    const f32x2 lo = __builtin_shufflevector(v[u][j], v[u][j], 0, 1), hi = __builtin_shufflevector(v[u][j], v[u][j], 2, 3); sa += lo; sa += hi; }
                if (u == 0) s0 = sa.x + sa.y; else s1 = sa.x + sa.y; }
            wave_sum2(s0, s1);
            float q0, q1;
#pragma unroll
            for (int u = 0; u < 2; ++u) { const float mean = (u == 0 ? s0 : s1) * (1.f / D_); f32x2 qa = (f32x2){0.f, 0.f};
#pragma unroll
                for (int j = 0; j < 4; ++j) { v[u][j] = v[u][j] - mean;
                    const f32x2 lo = __builtin_shufflevector(v[u][j], v[u][j], 0, 1), hi = __builtin_shufflevector(v[u][j], v[u][j], 2, 3); qa = lo * lo + qa; qa = hi * hi + qa; }
                if (u == 0) q0 = qa.x + qa.y; else q1 = qa.x + qa.y; }
            wave_sum2(q0, q1);
            float am0 = 0.f, am1 = 0.f;
#pragma unroll
            for (int u = 0; u < 2; ++u) { const int m = m0 + u; const float rstd = __builtin_amdgcn_rsqf((u == 0 ? q0 : q1) * (1.f / D_) + LN_EPS);
                if (last) { GAS f32x4* o = (GAS f32x4*)(A.out + (size_t)m * D_) + lane;
#pragma unroll
                    for (int j = 0; j < 4; ++j) o[64 * j] = v[u][j] * rstd * gv[j] + bv[j];
                } else { GAS v2u* o8 = (GAS v2u*)(HB + (size_t)m * D_) + lane; float amax = 0.f;
#pragma unroll
                    for (int j = 0; j < 4; ++j) { const f32x4 o = v[u][j] * rstd * gv[j] + bv[j]; v[u][j] = o; if (!(RESID_I8 && GEMM1_I8)) { v2u w; w.x = pk2(o.x, o.y); w.y = pk2(o.z, o.w); o8[64 * j] = w; }
                        amax = fmaxf(amax, fmaxf(fmaxf(fabsf(o.x), fabsf(o.y)), fmaxf(fabsf(o.z), fabsf(o.w)))); }
                    if (u == 0) am0 = amax; else am1 = amax; } }
            if (!last && GEMM1_I8) { wave_max2(am0, am1);
#pragma unroll
                for (int u = 0; u < 2; ++u) { const int m = m0 + u; const float amax = u == 0 ? am0 : am1, inv = amax > 0.f ? 127.f / amax : 0.f;
                    GAS unsigned* q4 = (GAS unsigned*)(F.ws + WS_HQ + (size_t)m * D_) + lane;
#pragma unroll
                    for (int j = 0; j < 4; ++j) q4[64 * j] = pk4_i8(v[u][j].x * inv, v[u][j].y * inv, v[u][j].z * inv, v[u][j].w * inv);
                    if (lane == 0) ((float*)(F.ws + WS_HS))[m] = amax * (1.f / 127.f); } }
        }
#pragma unroll
        for (int u = 0; u < 2; ++u) {
#pragma unroll
            for (int j = 0; j < 4; ++j) { hq[u][j] = hn[u][j]; aq[u][j] = an[u][j]; cq[u][j] = cn[u][j]; }
            hst[u] = hsn[u];
#pragma unroll
            for (int k = 0; k < 6; ++k) { R[u][k] = Rn[u][k]; Rn[u][k] = Rnn[u][k]; } }
    }
#undef P7_ROUTE
#undef P7_ROWS
}

#ifndef PH_NOINLINE
#define PH_NOINLINE __forceinline__
#endif
PH_NOINLINE __device__ void run_gemm1(LAS unsigned char* lds, unsigned char* ws, int l, int G, int c) {
    pg8::DenseOrder S;
    if (GEMM1_I8) { S.init(ws + WS_HQ, ws + WS_WIN + (size_t)l * N1 * 1024, T_, N1, D_ / 2, G, c, 1);
        pg8::EpiZq E{(bf16*)(ws + WS_Z), (const float*)(ws + WS_HS), (const float*)((unsigned*)(ws + WS_CTL) + CW_CMAX) + l * N1}; pg8::gemm_phase<pg8::EpiZq, pg8::DenseOrder, 2>(lds, S, E); }
    else { S.init(ws + WS_HB, ws + WS_WIN + (size_t)l * N1 * 1024 * 2, T_, N1, D_, G, c, 1); pg8::EpiZ E{(bf16*)(ws + WS_Z)}; pg8::gemm_phase(lds, S, E); }
}
PH_NOINLINE __device__ void run_gemm_probe(LAS unsigned char* lds, unsigned char* ws, int G, int c) {
    pg8::DenseOrder S; S.init(ws + WS_HB, ws + WS_WIN, T_, 256 * (PROBE_EXTRA_NN ? PROBE_EXTRA_NN : 1), D_, G, c);
    pg8::EpiPlain E{(bf16*)(ws + WS_Y), 2048};
    pg8::gemm_phase(lds, S, E);
}
PH_NOINLINE __device__ void run_gemm2(LAS unsigned char* lds, unsigned char* ws, int l, int G, int c) {
    if (U_I8 && RESID_I8 && GEMM1_I8 && GEMM2_FP8) { pg8::EpiUq8 Eq{ws + WS_HQ, (const float*)(ws + WS_HS), ws + WS_U8, (float*)(ws + WS_U8 + 32 * MiB)};
        pg8::DenseRowsOrder S; int kq = D_ / 2; asm volatile("" : "+s"(kq)); S.init(ws + WS_Y, ws + WS_WOUT + (size_t)l * 1024 * 1024, T_, D_, kq, G, c); pg8::gemm_phase<pg8::EpiUq8, pg8::DenseRowsOrder, true>(lds, S, Eq); return; }
    if (RESID_I8 && GEMM1_I8 && GEMM2_FP8) { pg8::EpiUq Eq{ws + WS_HQ, (const float*)(ws + WS_HS), (bf16*)(ws + WS_U)};
        pg8::DenseRowsOrder S; int kq = D_ / 2; asm volatile("" : "+s"(kq)); S.init(ws + WS_Y, ws + WS_WOUT + (size_t)l * 1024 * 1024, T_, D_, kq, G, c); pg8::gemm_phase<pg8::EpiUq, pg8::DenseRowsOrder, true>(lds, S, Eq); return; }
    pg8::EpiU E{(const bf16*)(ws + WS_HB), (bf16*)(ws + WS_U)};
    if (GEMM2_FP8) { pg8::DenseRowsOrder S; int kq = D_ / 2; asm volatile("" : "+s"(kq)); S.init(ws + WS_Y, ws + WS_WOUT + (size_t)l * 1024 * 1024, T_, D_, kq, G, c); pg8::gemm_phase<pg8::EpiU, pg8::DenseRowsOrder, true>(lds, S, E); }
    else { pg8::DenseOrder S; S.init(ws + WS_Y, ws + WS_WOUT + (size_t)l * 1024 * 1024 * 2, T_, D_, D_, G, c); pg8::gemm_phase(lds, S, E); }
}
PH_NOINLINE __device__ void run_gemm5(LAS unsigned char* lds, unsigned char* ws, int l, int G, int c) {
    const LAS int* tab = (const LAS int*)(lds + TAB_OFF);
    pg8::MoeGatherOrder S; S.A = (const char*)(ws + WS_H8); S.Bt = (const char*)(ws + WS_WGU + (size_t)l * NE * 1024 * 1024); S.bexp = (size_t)1024 * 1024;
    int kq = D_ / 2; asm volatile("" : "+s"(kq));
    S.K = kq; S.nN = 4; S.nwg = tab[32] * 4; S.G = G; S.c = c; S.tab = tab; S.lists = (const int*)(ws + WS_LISTS);
    pg8::EpiHid E{ws + WS_HID};
    pg8::gemm_phase<pg8::EpiHid, pg8::MoeGatherOrder, true>(lds, S, E);
}
PH_NOINLINE __device__ void run_gemm6(LAS unsigned char* lds, unsigned char* ws, int l, int G, int c) {
    const LAS int* tab = (const LAS int*)(lds + TAB_OFF);
    pg8::MoeRowsOrder S; S.A = (const char*)(ws + WS_HID); S.Bt = (const char*)(ws + WS_WD + (size_t)l * NE * 1024 * 512); S.bexp = (size_t)1024 * 512;
    int kq = DE / 2; asm volatile("" : "+s"(kq));
    S.K = kq; S.nN = 4; S.nwg = tab[32] * 4; S.G = G; S.c = c; S.tab = tab; S.lists = nullptr;
    pg8::EpiPlain8 E{ws + WS_Y2S, D_};
    pg8::gemm_phase<pg8::EpiPlain8, pg8::MoeRowsOrder, true>(lds, S, E);
}

__global__ void __launch_bounds__(NWAVES * 64, 2) mk_fwd(Args args) {
    extern __shared__ __attribute__((aligned(16))) unsigned char lds_raw[];
    Frame F;
    F.lds = (LAS unsigned char*)lds_raw;
    F.tid = threadIdx.x; F.lane = F.tid & 63; F.wave = __builtin_amdgcn_readfirstlane(F.tid >> 6);
    F.G = gridDim.x; { const int bx = blockIdx.x; F.vcu = (F.G % 8 == 0) ? (bx % 8) * (F.G / 8) + bx / 8 : bx; }
    F.ws = args.ws; F.ctl = (unsigned*)(args.ws + WS_CTL);
    for (int u = F.tid; u < (LDS_BYTES - LDSCTL_OFF) / 4; u += NWAVES * 64) ((LAS unsigned*)(F.lds + LDSCTL_OFF))[u] = 0u;
    __syncthreads();
    volatile LAS unsigned* MISC = (volatile LAS unsigned*)(F.lds + MISC_OFF);
    XcdBarrier bar; bar.bar = F.ctl + CW_BAR; bar.x = 0; bar.st = nullptr;
    if (MK_N_LAUNCHES == 1) bar = xcd_barrier_post(F.ctl + CW_BAR, MISC + 8);
    const int lo = args.ph_lo, hi = args.ph_hi;
#define IN(k) (lo <= (k) && (k) < hi)
#define SEAM(k) do { if (MK_N_LAUNCHES == 1 && (k) + 1 < hi) xcd_barrier(bar); } while (0)
    if (REPEAT_MASK & 256) { for (int rep = 0; rep < 10; ++rep) xcd_barrier(bar); }
    if ((PH_MASK & 1) && IN(0)) { for (int rep = 0; rep < ((REPEAT_MASK & 1) ? 2 : 1); ++rep) { p0_prologue(F, args); SEAM(0); } }
#pragma unroll 1
    for (int l = 0; l < NL; ++l) {
        const int pb = 1 + 7 * l;
        if ((PH_MASK & 2) && IN(pb + 0)) { for (int rep = 0; rep < ((REPEAT_MASK & 2) ? 2 : 1); ++rep) { run_gemm1(F.lds, F.ws, l, F.G, (int)blockIdx.x); SEAM(pb + 0); }
            if (PROBE_EXTRA_NN && l == 0) { run_gemm_probe(F.lds, F.ws, F.G, (int)blockIdx.x); xcd_barrier(bar); } }
        if ((PH_MASK & 4) && IN(pb + 1)) { for (int rep = 0; rep < ((REPEAT_MASK & 4) ? 2 : 1); ++rep) { p2_mixer(F, args, l); SEAM(pb + 1); } }
        if ((PH_MASK & 8) && IN(pb + 2)) { for (int rep = 0; rep < ((REPEAT_MASK & 8) ? 2 : 1); ++rep) { run_gemm2(F.lds, F.ws, l, F.G, (int)blockIdx.x); SEAM(pb + 2); } }
        if ((PH_MASK & 16) && IN(pb + 3)) {
            if (REPEAT_MASK & 16) { p4_ln_router(F, args, l); SEAM(pb + 3);
                if (blockIdx.x == 0 && F.tid < 32) __hip_atomic_store(F.ctl + CW_CNT + (l * 32 + F.tid) * 64, 0u, RLX_AGENT);
                SEAM(pb + 3); }
            p4_ln_router(F, args, l); SEAM(pb + 3); }
        if ((PH_MASK & 32) && IN(pb + 4)) { for (int rep = 0; rep < ((REPEAT_MASK & 32) ? 2 : 1); ++rep) { moe_table(F, l); run_gemm5(F.lds, F.ws, l, F.G, (int)blockIdx.x); SEAM(pb + 4); } }
        if ((PH_MASK & 64) && IN(pb + 5)) { for (int rep = 0; rep < ((REPEAT_MASK & 64) ? 2 : 1); ++rep) { if (MK_N_LAUNCHES != 1 || rep) moe_table(F, l); run_gemm6(F.lds, F.ws, l, F.G, (int)blockIdx.x); SEAM(pb + 5); } }
        if ((PH_MASK & 128) && IN(pb + 6)) { for (int rep = 0; rep < (((REPEAT_MASK & 128) && l == NL - 1) ? 2 : 1); ++rep) { if (MK_N_LAUNCHES != 1) moe_table(F, l); p7_combine_ln(F, args, l); if (rep == 0) SEAM(pb + 6); else xcd_barrier(bar); } }
    }
#undef IN
#undef SEAM
}

extern "C" void kernel_launch(void* const* d_in, const int* in_sizes, int n_in, void* d_out, int out_size, void* d_ws, size_t ws_size, hipStream_t stream) {
    static int grid = 0;
    if (grid == 0) {
        if (n_in != 21 || out_size != T_ * D_ || ws_size < WS_END) { fprintf(stderr, "kernel_launch: unexpected problem (n_in %d, out %d, ws %zu); nothing launched\n", n_in, out_size, ws_size); grid = -1; return; }
        int dev = 0, cus = 0, per_cu = 0;
        if (hipGetDevice(&dev) != hipSuccess || hipDeviceGetAttribute(&cus, hipDeviceAttributeMultiprocessorCount, dev) != hipSuccess) { grid = -1; return; }
        if (hipFuncSetAttribute((const void*)mk_fwd, hipFuncAttributeMaxDynamicSharedMemorySize, LDS_BYTES) != hipSuccess) { fprintf(stderr, "kernel_launch: hipFuncSetAttribute failed\n"); grid = -1; return; }
        if (hipOccupancyMaxActiveBlocksPerMultiprocessor(&per_cu, (const void*)mk_fwd, NWAVES * 64, LDS_BYTES) != hipSuccess || per_cu < 1) { fprintf(stderr, "kernel_launch: occupancy query says %d\n", per_cu); }
        (void)hipGetLastError();
        grid = cus;
    }
    if (grid < 0) return;
    (void)hipMemsetAsync((char*)d_ws + WS_CTL, 0, CTL_ZERO_BYTES, stream);
    Args a{};
    for (int i = 0; i < 21; ++i) a.in[i] = (const float*)d_in[i];
    a.out = (float*)d_out; a.ws = (unsigned char*)d_ws;
    if (MK_N_LAUNCHES == 1) { a.ph_lo = 0; a.ph_hi = NPH; hipLaunchKernelGGL(mk_fwd, dim3(grid), dim3(NWAVES * 64), LDS_BYTES, stream, a); }
    else for (int p = 0; p < NPH; ++p) { a.ph_lo = p; a.ph_hi = p + 1; hipLaunchKernelGGL(mk_fwd, dim3(grid), dim3(NWAVES * 64), LDS_BYTES, stream, a); }
}
```
